# Optimizing an MI355X kernel written in HIP

```python
import numpy as np
import jax
import jax.numpy as jnp
from jax import lax

D_MODEL = 2048
BATCH = 2
SEQ = 8192
DEPTH = 2

GRID_W = 64
CTX_LEN = 256
EPS = 1e-6
N_BRANCH = 3
N_MOD = 6

N_HEADS = 16
N_KV_HEADS = 4
HEAD_DIM = 128
GROUP = N_HEADS // N_KV_HEADS
ROPE_PAIRS = HEAD_DIM // 4
ROPE_THETA = 10000.0
Q_BLOCK = 128
Q_WIDTH = N_HEADS * HEAD_DIM
KV_WIDTH = N_KV_HEADS * HEAD_DIM

LRU_WIDTH = D_MODEL
LRU_BLOCKS = 16
LRU_BLOCK = LRU_WIDTH // LRU_BLOCKS
LRU_CONV = 4
LRU_C = 8.0

SC_WIDTH = D_MODEL
SC_CONV = 3

PEER_HEADS = 8
PEER_NKEYS = 128
PEER_EXPERTS = PEER_NKEYS * PEER_NKEYS
PEER_QDIM = 256
PEER_TOPK = 16
PEER_BLOCK = 64

IN_SPLITS = (Q_WIDTH, KV_WIDTH, KV_WIDTH, LRU_WIDTH, LRU_WIDTH, SC_WIDTH, SC_WIDTH, SC_WIDTH, N_BRANCH * D_MODEL)
IN_WIDTH = Q_WIDTH + 2 * KV_WIDTH + 2 * LRU_WIDTH + 3 * SC_WIDTH + N_BRANCH * D_MODEL

kernel_name = 'hybrid_dit_gqa_rglru_shortconv_peer'


def rmsnorm(x, g):
    xf = x.astype(jnp.float32)
    y = xf * lax.rsqrt(jnp.mean(xf * xf, axis=-1, keepdims=True) + EPS)
    return (y * g.astype(jnp.float32)).astype(x.dtype)


def modulate(h, shift, scale):
    return h * (1.0 + scale) + shift


def split_cols(p):
    offsets = np.cumsum(IN_SPLITS)[:-1].tolist()
    return jnp.split(p, offsets, axis=-1)


def dwconv(x, w, b, left):
    k_w = w.shape[0]
    t = x.shape[1]
    xp = jnp.pad(x, ((0, 0), (left, k_w - 1 - left), (0, 0)))
    return b + sum(w[k] * xp[:, k:k + t] for k in range(k_w))


def axial_rope(rows):
    row = jnp.repeat(jnp.arange(rows, dtype=jnp.float32), GRID_W)
    col = jnp.tile(jnp.arange(GRID_W, dtype=jnp.float32), rows)
    inv = ROPE_THETA ** (-jnp.arange(ROPE_PAIRS, dtype=jnp.float32) / ROPE_PAIRS)
    ang = jnp.stack([row[:, None] * inv, col[:, None] * inv], axis=1)
    return jnp.cos(ang), jnp.sin(ang)


def apply_rope(t, cos, sin):
    b_, n_, h_, d_ = t.shape
    t = t.reshape(b_, n_, h_, 2, 2, ROPE_PAIRS)
    t1, t2 = t[..., 0, :], t[..., 1, :]
    cs = cos[:, None].astype(t.dtype)
    sn = sin[:, None].astype(t.dtype)
    out = jnp.stack([t1 * cs - t2 * sn, t2 * cs + t1 * sn], axis=-2)
    return out.reshape(b_, n_, h_, d_)


def attend(q, k, v):
    s = jnp.einsum('bqhgd,bkhd->bhgqk', q, k, preferred_element_type=jnp.float32) * (HEAD_DIM ** -0.5)
    p = jax.nn.softmax(s, axis=-1).astype(v.dtype)
    return jnp.einsum('bhgqk,bkhd->bqhgd', p, v)


def attention_branch(qx, kx, vx, qc, kc, vc, q_gain, k_gain, cos, sin, with_ctx):
    b_, t_, _ = qx.shape
    tc = kc.shape[1]
    ql = apply_rope(rmsnorm(qx.reshape(b_, t_, N_HEADS, HEAD_DIM), q_gain), cos, sin)
    kl = apply_rope(rmsnorm(kx.reshape(b_, t_, N_KV_HEADS, HEAD_DIM), k_gain), cos, sin)
    vl = vx.reshape(b_, t_, N_KV_HEADS, HEAD_DIM)
    kcn = rmsnorm(kc.reshape(b_, tc, N_KV_HEADS, HEAD_DIM), k_gain)
    vcn = vc.reshape(b_, tc, N_KV_HEADS, HEAD_DIM)
    k_all = jnp.concatenate([kcn, kl], axis=1)
    v_all = jnp.concatenate([vcn, vl], axis=1)
    n_blk = t_ // Q_BLOCK
    qb = ql.reshape(b_, n_blk, Q_BLOCK, N_KV_HEADS, GROUP, HEAD_DIM).transpose(1, 0, 2, 3, 4, 5)
    ob = lax.map(lambda q: attend(q, k_all, v_all), qb)
    y_l = ob.transpose(1, 0, 2, 3, 4, 5).reshape(b_, t_, Q_WIDTH)
    y_c = None
    if with_ctx:
        qcn = rmsnorm(qc.reshape(b_, tc, N_HEADS, HEAD_DIM), q_gain)
        y_c = attend(qcn.reshape(b_, tc, N_KV_HEADS, GROUP, HEAD_DIM), kcn, vcn).reshape(b_, tc, Q_WIDTH)
    return y_l, y_c


def _lin_comb(left, right):
    a_l, b_l = left
    a_r, b_r = right
    return a_l * a_r, a_r * b_l + b_r


def rglru_scan(u, wa, ba, wx, bx, lam, h0, reverse):
    b_, t_, c_ = u.shape
    uf = u.astype(jnp.float32)
    ub = uf.reshape(b_, t_, LRU_BLOCKS, LRU_BLOCK)
    r = jax.nn.sigmoid(jnp.einsum('btnc,ncd->btnd', ub, wa.astype(jnp.float32)).reshape(b_, t_, c_) + ba.astype(jnp.float32))
    i = jax.nn.sigmoid(jnp.einsum('btnc,ncd->btnd', ub, wx.astype(jnp.float32)).reshape(b_, t_, c_) + bx.astype(jnp.float32))
    log_a = -LRU_C * r * jax.nn.softplus(-lam.astype(jnp.float32))
    a = jnp.exp(log_a)
    drive = jnp.sqrt(-jnp.expm1(2.0 * log_a)) * (i * uf)
    edge = t_ - 1 if reverse else 0
    drive = drive.at[:, edge].add(a[:, edge] * h0)
    _, h = lax.associative_scan(_lin_comb, (a, drive), axis=1, reverse=reverse)
    return h


def lru_branch(xl, gl, xc, gc, conv_w, conv_b, wa, ba, wx, bx, lam, with_ctx):
    left = LRU_CONV // 2
    ul = dwconv(xl, conv_w, conv_b, left)
    uc = dwconv(xc, conv_w, conv_b, left)
    h_lat = 0.0
    h_ctx = 0.0
    for d, rev in enumerate((False, True)):
        hc_d = rglru_scan(uc, wa[d], ba[d], wx[d], bx[d], lam[d], jnp.zeros((xc.shape[0], LRU_WIDTH), jnp.float32), rev)
        h0 = hc_d[:, 0] if rev else hc_d[:, -1]
        h_lat = h_lat + rglru_scan(ul, wa[d], ba[d], wx[d], bx[d], lam[d], h0, rev)
        if with_ctx:
            h_ctx = h_ctx + hc_d
    y_l = h_lat.astype(xl.dtype) * jax.nn.gelu(gl)
    y_c = h_ctx.astype(xc.dtype) * jax.nn.gelu(gc) if with_ctx else None
    return y_l, y_c


def short_conv(bg, cg, u, w, b):
    return bg * dwconv(cg * u, w, b, SC_CONV // 2)


def merge_branches(att, lru, sc, gate_logits, w_o_attn, w_o_lru, w_o_sc, w_out):
    g_att, g_lru, g_sc = jnp.split(jax.nn.sigmoid(gate_logits), N_BRANCH, axis=-1)
    y = g_att * (att @ w_o_attn) + g_lru * (lru @ w_o_lru) + g_sc * (sc @ w_o_sc)
    return y @ w_out


def peer_ffn(h, w_q, k1, k2, w_u, w_v):
    b_, t_, d_ = h.shape
    n_blk = t_ // PEER_BLOCK
    hb = h.reshape(b_, n_blk, PEER_BLOCK, d_).transpose(1, 0, 2, 3)

    def block(hblk):
        q = (hblk @ w_q).reshape(b_, PEER_BLOCK, PEER_HEADS, 2, PEER_QDIM // 2)
        s1 = jnp.einsum('bthd,hnd->bthn', q[..., 0, :], k1, preferred_element_type=jnp.float32)
        s2 = jnp.einsum('bthd,hnd->bthn', q[..., 1, :], k2, preferred_element_type=jnp.float32)
        v1, i1 = lax.top_k(s1, PEER_TOPK)
        v2, i2 = lax.top_k(s2, PEER_TOPK)
        cand = (v1[..., :, None] + v2[..., None, :]).reshape(b_, PEER_BLOCK, PEER_HEADS, PEER_TOPK * PEER_TOPK)
        cidx = (i1[..., :, None] * PEER_NKEYS + i2[..., None, :]).reshape(b_, PEER_BLOCK, PEER_HEADS, PEER_TOPK * PEER_TOPK)
        score, pos = lax.top_k(cand, PEER_TOPK)
        idx = jnp.take_along_axis(cidx, pos, axis=-1)
        gate = jax.nn.softmax(score, axis=-1)
        u = w_u[idx]
        act = jax.nn.gelu(jnp.einsum('bthkd,btd->bthk', u, hblk))
        return jnp.einsum('bthk,bthkd->btd', (gate * act).astype(h.dtype), w_v[idx])

    out = lax.map(block, hb)
    return out.transpose(1, 0, 2, 3).reshape(b_, t_, d_)


def setup_inputs(seed: int = 0) -> dict:
    key = jax.random.key(seed)
    ks = iter(jax.random.split(key, 40))

    def nrm(shape, scale):
        return scale * jax.random.normal(next(ks), shape, jnp.float32)

    u = jax.random.uniform(next(ks), (DEPTH, 2, LRU_WIDTH), jnp.float32, minval=0.9, maxval=0.999)
    p = u ** (1.0 / LRU_C)
    lam = jnp.log(p) - jnp.log1p(-p)
    return {
        'x': nrm((BATCH, SEQ, D_MODEL), 1.0),
        'c': nrm((BATCH, D_MODEL), 1.0),
        'ctx': nrm((BATCH, CTX_LEN, D_MODEL), 1.0),
        'c_ctx': nrm((D_MODEL,), 1.0),
        'w_mod': nrm((DEPTH, D_MODEL, N_MOD * D_MODEL), 0.5 * D_MODEL ** -0.5),
        'b_mod': nrm((DEPTH, N_MOD * D_MODEL), 0.01),
        'norm_mix': 1.0 + nrm((DEPTH, D_MODEL), 0.02),
        'norm_ffn': 1.0 + nrm((DEPTH, D_MODEL), 0.02),
        'w_in': nrm((DEPTH, D_MODEL, IN_WIDTH), D_MODEL ** -0.5),
        'q_norm': 1.0 + nrm((DEPTH, HEAD_DIM), 0.02),
        'k_norm': 1.0 + nrm((DEPTH, HEAD_DIM), 0.02),
        'lru_conv_w': nrm((DEPTH, LRU_CONV, LRU_WIDTH), LRU_CONV ** -0.5),
        'lru_conv_b': nrm((DEPTH, LRU_WIDTH), 0.01),
        'lru_wa': nrm((DEPTH, 2, LRU_BLOCKS, LRU_BLOCK, LRU_BLOCK), LRU_BLOCK ** -0.5),
        'lru_ba': nrm((DEPTH, 2, LRU_WIDTH), 0.01),
        'lru_wx': nrm((DEPTH, 2, LRU_BLOCKS, LRU_BLOCK, LRU_BLOCK), LRU_BLOCK ** -0.5),
        'lru_bx': nrm((DEPTH, 2, LRU_WIDTH), 0.01),
        'lru_lambda': lam,
        'sc_conv_w': nrm((DEPTH, SC_CONV, SC_WIDTH), SC_CONV ** -0.5),
        'sc_conv_b': nrm((DEPTH, SC_WIDTH), 0.01),
        'w_o_attn': nrm((DEPTH, Q_WIDTH, D_MODEL), Q_WIDTH ** -0.5),
        'w_o_lru': nrm((DEPTH, LRU_WIDTH, D_MODEL), LRU_WIDTH ** -0.5),
        'w_o_sc': nrm((DEPTH, SC_WIDTH, D_MODEL), SC_WIDTH ** -0.5),
        'w_out': nrm((DEPTH, D_MODEL, D_MODEL), D_MODEL ** -0.5),
        'peer_wq': nrm((DEPTH, D_MODEL, PEER_HEADS * PEER_QDIM), D_MODEL ** -0.5),
        'peer_k1': nrm((DEPTH, PEER_HEADS, PEER_NKEYS, PEER_QDIM // 2), (PEER_QDIM // 2) ** -0.5),
        'peer_k2': nrm((DEPTH, PEER_HEADS, PEER_NKEYS, PEER_QDIM // 2), (PEER_QDIM // 2) ** -0.5),
        'peer_u': nrm((DEPTH, PEER_EXPERTS, D_MODEL), D_MODEL ** -0.5),
        'peer_v': nrm((DEPTH, PEER_EXPERTS, D_MODEL), 0.5),
    }


def reference(x, c, ctx, c_ctx, w_mod, b_mod, norm_mix, norm_ffn, w_in, q_norm, k_norm,
              lru_conv_w, lru_conv_b, lru_wa, lru_ba, lru_wx, lru_bx, lru_lambda,
              sc_conv_w, sc_conv_b, w_o_attn, w_o_lru, w_o_sc, w_out,
              peer_wq, peer_k1, peer_k2, peer_u, peer_v):
    rows = x.shape[1] // GRID_W
    cos, sin = axial_rope(rows)
    s_lat = jax.nn.silu(c)
    s_ctx = jax.nn.silu(c_ctx)
    for l in range(DEPTH):
        with_ctx = l < DEPTH - 1
        m_lat = jnp.split((s_lat @ w_mod[l] + b_mod[l])[:, None, :], N_MOD, axis=-1)
        m_ctx = jnp.split(s_ctx @ w_mod[l] + b_mod[l], N_MOD, axis=-1)

        hx = modulate(rmsnorm(x, norm_mix[l]), m_lat[0], m_lat[1])
        hc = modulate(rmsnorm(ctx, norm_mix[l]), m_ctx[0], m_ctx[1])
        qx, kx, vx, lx, lgx, bgx, cgx, ux, gx = split_cols(hx @ w_in[l])
        qc, kc, vc, lc, lgc, bgc, cgc, uc, gc = split_cols(hc @ w_in[l])
        att_x, att_c = attention_branch(qx, kx, vx, qc, kc, vc, q_norm[l], k_norm[l], cos, sin, with_ctx)
        lru_x, lru_c = lru_branch(lx, lgx, lc, lgc, lru_conv_w[l], lru_conv_b[l], lru_wa[l], lru_ba[l],
                                  lru_wx[l], lru_bx[l], lru_lambda[l], with_ctx)
        sc_x = short_conv(bgx, cgx, ux, sc_conv_w[l], sc_conv_b[l])
        x = x + m_lat[2] * merge_branches(att_x, lru_x, sc_x, gx, w_o_attn[l], w_o_lru[l], w_o_sc[l], w_out[l])
        if with_ctx:
            sc_c = short_conv(bgc, cgc, uc, sc_conv_w[l], sc_conv_b[l])
            ctx = ctx + m_ctx[2] * merge_branches(att_c, lru_c, sc_c, gc, w_o_attn[l], w_o_lru[l], w_o_sc[l], w_out[l])

        hx = modulate(rmsnorm(x, norm_ffn[l]), m_lat[3], m_lat[4])
        x = x + m_lat[5] * peer_ffn(hx, peer_wq[l], peer_k1[l], peer_k2[l], peer_u[l], peer_v[l])
        if with_ctx:
            hc = modulate(rmsnorm(ctx, norm_ffn[l]), m_ctx[3], m_ctx[4])
            ctx = ctx + m_ctx[5] * peer_ffn(hc, peer_wq[l], peer_k1[l], peer_k2[l], peer_u[l], peer_v[l])
    return x
```

```cpp
#include <hip/hip_runtime.h>
#include <cstdio>
#include <cstdint>

#ifndef MK_N_LAUNCHES
#define MK_N_LAUNCHES 1
#endif

#define GAS __attribute__((address_space(1)))
#define LAS __attribute__((address_space(3)))
typedef unsigned short bf16_t;
typedef short bf16x8 __attribute__((ext_vector_type(8)));
typedef short s16x4 __attribute__((ext_vector_type(4)));
typedef float f32x2 __attribute__((ext_vector_type(2)));
typedef float f32x4 __attribute__((ext_vector_type(4)));
typedef float f32x8 __attribute__((ext_vector_type(8)));
typedef float f32x16 __attribute__((ext_vector_type(16)));
typedef unsigned u32x2 __attribute__((ext_vector_type(2)));
typedef unsigned u32x4 __attribute__((ext_vector_type(4)));

constexpr int DM = 2048, NB = 2, SEQ = 8192, NLAYER = 2, CTXL = 256;
constexpr int MLAT = NB * SEQ, MCTX = NB * CTXL, MALL = MLAT + MCTX;
constexpr int NIN = 19456;
constexpr int CQ = 0, CK = 2048, CV = 2560, CLX = 3072, CLG = 5120, CBG = 7168, CCG = 9216, CU = 11264, CGT = 13312;
constexpr int NKEY = SEQ + CTXL;
constexpr int NCHUNK = NKEY / 64;
constexpr int NMOD = 6 * DM;
constexpr float EPS = 1e-6f;
constexpr int NWAVES = 8, NTHREADS = 512;

constexpr size_t MiB = 1u << 20;
constexpr size_t al256(size_t x) { return (x + 255) / 256 * 256; }
constexpr size_t WS_CTL = 0, CTL_ZERO_BYTES = 1 * MiB;
constexpr size_t WS_MOD = WS_CTL + CTL_ZERO_BYTES;
constexpr size_t WS_ROPE = WS_MOD + al256((size_t)NLAYER * 3 * NMOD * 4);
constexpr size_t WS_SP = WS_ROPE + al256(2 * 128 * 32 * 4);
constexpr size_t WS_CTXS = WS_SP + al256(36864 * 4);
constexpr size_t WS_LSUM = WS_CTXS + al256((size_t)MCTX * DM * 4);
constexpr size_t WS_WLRU = WS_LSUM + al256((size_t)2 * 2 * NB * NCHUNK * DM * 4);
constexpr size_t WS_KC = WS_WLRU + al256((size_t)16 * 512 * 128 * 2);
constexpr size_t WS_VC = WS_KC + al256((size_t)NB * 4 * NKEY * 128 * 2);
constexpr size_t WS_WIN = WS_VC + al256((size_t)NB * 4 * NKEY * 128 * 2);
constexpr size_t WS_WO = WS_WIN + al256((size_t)NIN * DM * 2);
constexpr size_t WS_WOUT = WS_WO + al256((size_t)3 * DM * DM * 2);
constexpr size_t WS_WSC = WS_WOUT + al256((size_t)DM * DM * 2);
constexpr size_t WS_PU = WS_WSC + al256((size_t)DM * DM * 2);
constexpr size_t WS_PV = WS_PU + al256((size_t)16384 * DM);
constexpr size_t WS_HX = WS_PV + al256((size_t)16384 * DM);
constexpr size_t WS_YF = WS_HX + al256((size_t)MALL * DM * 2);
constexpr size_t WS_P = WS_YF + al256((size_t)MALL * DM * 4);
constexpr size_t WS_END = WS_P + al256((size_t)MALL * NIN * 2);

constexpr int SP_NMIX = 0, SP_NFFN = 2048, SP_QN = 4096, SP_KN = 4224, SP_LCW = 4352, SP_LCB = 12544, SP_LBA = 14592, SP_LBX = 18688, SP_LSP = 22784, SP_SCW = 26880, SP_SCB = 33024, SP_END = 35072;

constexpr int LDS_BYTES = 147456;
constexpr int MISC_OFF = 147456 - 256;
constexpr int LDS_WORK = MISC_OFF;

__device__ __forceinline__ unsigned cvt_pk_bf16(float lo, float hi) { unsigned r; asm volatile("v_cvt_pk_bf16_f32 %0, %1, %2" : "=v"(r) : "v"(lo), "v"(hi)); return r; }
__device__ __forceinline__ float bf_lo(unsigned w) { return __uint_as_float(w << 16); }
__device__ __forceinline__ float bf_hi(unsigned w) { return __uint_as_float(w & 0xffff0000u); }
__device__ __forceinline__ float bf1(bf16_t h) { return __uint_as_float(((unsigned)h) << 16); }
__device__ __forceinline__ bf16_t f2bf(float f) { return (bf16_t)(cvt_pk_bf16(f, 0.f) & 0xffffu); }
__device__ __forceinline__ float sigmoidf_(float x) { return __builtin_amdgcn_rcpf(1.f + __expf(-x)); }
__device__ __forceinline__ float gelu_tanh(float x) { const float z = 0.7978845608028654f * (x + 0.044715f * x * x * x); const float e = __expf(2.f * z); return 0.5f * x * (2.f - 2.f * __builtin_amdgcn_rcpf(e + 1.f)); }
__device__ __forceinline__ float wave_sum(float v) {
#pragma unroll
    for (int o = 1; o < 64; o <<= 1) v += __shfl_xor(v, o);
    return v;
}
__device__ __forceinline__ float wave_max(float v) {
#pragma unroll
    for (int o = 1; o < 64; o <<= 1) v = fmaxf(v, __shfl_xor(v, o));
    return v;
}
template <class T> __device__ __forceinline__ T* as_global(T* p) { return (T*)(GAS T*)p; }
#define DPPF(v, ctrl) __int_as_float(__builtin_amdgcn_update_dpp(0, __float_as_int(v), ctrl, 0xF, 0xF, true))
#define LDS_WAIT() asm volatile("s_waitcnt lgkmcnt(0)" ::: "memory")
#define VM_WAIT() asm volatile("s_waitcnt vmcnt(0)" ::: "memory")

#define XB_TMO      128
#define XB_XCNT(j)  (256  + 64 * (j))
#define XB_XSUB(j)  (1280 + 64 * (j))
#define XB_XGEN(j)  (2304 + 64 * (j))
#define XB_TOP      3328
#define XB_TOPGEN   3392
#define XCD_BAR_WORDS 3456
#define XB_SPIN_CAP (1u << 23)
__device__ __forceinline__ unsigned xb_ld(unsigned* p)              { return __hip_atomic_load(p, __ATOMIC_RELAXED, __HIP_MEMORY_SCOPE_AGENT); }
__device__ __forceinline__ unsigned xb_add(unsigned* p, unsigned v) { return __hip_atomic_fetch_add(p, v, __ATOMIC_RELAXED, __HIP_MEMORY_SCOPE_AGENT); }
__device__ __forceinline__ unsigned xb_xcc_id() { return (unsigned)__builtin_amdgcn_s_getreg((3 << 11) | 20) & 0xFu; }
#define XB_SPIN(cond, bar) do { unsigned _sp = 0; while (cond) { __builtin_amdgcn_s_sleep(1); \
    if ((++_sp & 255u) == 0u) { if (xb_ld(&(bar)[XB_TMO])) break; if (_sp > XB_SPIN_CAP) { atomicAdd(&(bar)[XB_TMO], 1u); break; } } } } while (0)
struct XcdBarrier { unsigned* bar; unsigned x; volatile LAS unsigned* st; };
__device__ __forceinline__ XcdBarrier xcd_barrier_post(unsigned* bar, volatile LAS unsigned* st) {
    XcdBarrier b; b.bar = bar; b.x = xb_xcc_id(); b.st = st;
    if (threadIdx.x == 0) (void)xb_add(&bar[XB_XCNT(b.x)], 1u);
    return b;
}
__device__ __forceinline__ void xcd_barrier_complete(unsigned* bar, unsigned x, unsigned& nloc, unsigned& nx) {
    const unsigned G = gridDim.x * gridDim.y * gridDim.z;
    unsigned sum, cnt, mine, sp = 0u;
    for (;;) {
        sum = 0u; cnt = 0u; mine = 0u;
#pragma unroll
        for (unsigned j = 0; j < 16; ++j) { const unsigned c = xb_ld(&bar[XB_XCNT(j)]); sum += c; cnt += (c > 0u) ? 1u : 0u; mine = (j == x) ? c : mine; }
        if (sum == G) break;
        __builtin_amdgcn_s_sleep(1);
        if ((++sp & 255u) == 0u) { if (xb_ld(&bar[XB_TMO])) break; if (sp > XB_SPIN_CAP) { atomicAdd(&bar[XB_TMO], 1u); break; } }
    }
    nloc = mine > 0u ? mine : 1u; nx = cnt > 0u ? cnt : 1u;
}
__device__ __forceinline__ void xcd_barrier(const XcdBarrier& b) {
    asm volatile("s_waitcnt vmcnt(0)" ::: "memory");
    __syncthreads();
    if (threadIdx.x == 0) {
        unsigned* bar = b.bar;
        __builtin_amdgcn_s_waitcnt(0);
        unsigned nloc = b.st[0], nx = b.st[1];
        if (nloc == 0u) { xcd_barrier_complete(bar, b.x, nloc, nx); b.st[0] = nloc; b.st[1] = nx; }
        const unsigned old = xb_add(&bar[XB_XSUB(b.x)], 1u);
        const unsigned gen = old / nloc;
        if (old + 1u == (gen + 1u) * nloc) {
            __builtin_amdgcn_fence(__ATOMIC_RELEASE, "agent");
            asm volatile("s_waitcnt vmcnt(0)" ::: "memory");
            const unsigned og = xb_add(&bar[XB_TOP], 1u);
            const unsigned tg = og / nx;
            if (og + 1u == (tg + 1u) * nx) xb_add(&bar[XB_TOPGEN], 1u);
            else XB_SPIN(xb_ld(&bar[XB_TOPGEN]) == tg, bar);
            __builtin_amdgcn_fence(__ATOMIC_ACQUIRE, "agent");
            xb_add(&bar[XB_XGEN(b.x)], 1u);
            asm volatile("s_waitcnt vmcnt(0)" ::: "memory");
        } else {
            XB_SPIN(xb_ld(&bar[XB_XGEN(b.x)]) == gen, bar);
            __builtin_amdgcn_fence(__ATOMIC_ACQUIRE, "agent");
            asm volatile("s_waitcnt vmcnt(0)" ::: "memory");
        }
    }
    __syncthreads();
}
namespace pg8 {
#define PG8_LAS __attribute__((address_space(3)))
constexpr int BM = 256, BK = 64, HALF = 128, HTB = HALF * BK * 2, STAGE_BYTES = 8 * HTB, NXCD = 8, WGM = 8;
__host__ __device__ __forceinline__ int lds_byte(int r, int c) { const int st = (r >> 4) * 2 + (c >> 5), rr = r & 15, cc = c & 31, ob = rr * 64 + cc * 2; return st * 1024 + (ob ^ (((ob >> 9) & 1) << 5)); }
__host__ __device__ __forceinline__ void stage_rc(int b, int& R, int& C) { const int st = b / 1024, sb = b % 1024, swz = sb ^ (((sb >> 9) & 1) << 5); R = (st >> 1) * 16 + swz / 64; C = (st & 1) * 32 + (swz % 64) / 2; }
__host__ __device__ __forceinline__ int perm32(int rho) { const int n = rho >> 4, i = rho & 15; return 8 * (i >> 2) + 4 * n + (i & 3); }

struct Unit { int pm, pn, nh; };
struct Gemm { const bf16_t* A; const bf16_t* Bt; int M, N, K, lda, ldb; };

struct StaticOrder {
    int nM, nN, nwg, G, c;
    __host__ __device__ void init(int M, int N, int G_, int c_) { nM = M / BM; nN = N / BM; nwg = nM * nN; G = G_; c = c_; }
    __host__ __device__ bool next(int i, Unit& u) const {
        const long L = (long)i * G + c; if (L >= nwg) return false;
        int wgid = (int)L; { const int q = nwg / NXCD, r = nwg % NXCD, xcd = wgid % NXCD, off = wgid / NXCD; wgid = (xcd < r ? xcd * (q + 1) : r * (q + 1) + (xcd - r) * q) + off; }
        const int nig = WGM * nN, gid = wgid / nig, fm = gid * WGM, gsz = (nM - fm) < WGM ? (nM - fm) : WGM;
        u.pm = 2 * (fm + ((wgid % nig) % gsz)); u.pn = (wgid % nig) / gsz; u.nh = 2; return true;
    }
    __device__ __forceinline__ void a_ready(const Unit&) const {}
    __device__ __forceinline__ void done(const Unit&) const {}
};

struct MixOrder {
    StaticOrder lat; int nhalf;
    __host__ __device__ void init(int mrows, int G_, int c_) { lat.init(MLAT, 2048, G_, c_); nhalf = ((mrows - MLAT) / HALF) * 8; }
    __host__ __device__ bool next(int i, Unit& u) const {
        if (lat.next(i, u)) return true;
        const long h = (long)i * lat.G + lat.c - lat.nwg; if (h < 0 || h >= nhalf) return false;
        u.pm = MLAT / HALF + (int)(h >> 3); u.pn = (int)(h & 7); u.nh = 1; return true;
    }
    __device__ __forceinline__ void a_ready(const Unit&) const {}
    __device__ __forceinline__ void done(const Unit&) const {}
};

struct EpiBf16 {
    static constexpr bool PERM = true, AFTER_DRAIN = false;
    bf16_t* O; int ldc;
    __device__ __forceinline__ void operator()(const f32x4 (&acc)[2][2][4][2], const Unit& u, int wr, int wc, int fr, int fq) const {
        const int row0 = u.pm * HALF + wr * 64 + fr, col0 = u.pn * BM + wc * 32 + 8 * fq;
#pragma unroll
        for (int ai = 0; ai < 2; ++ai) if (ai < u.nh)
#pragma unroll
            for (int m = 0; m < 4; ++m) { bf16_t* rowp = O + (size_t)(row0 + ai * HALF + m * 16) * ldc + col0;
#pragma unroll
                for (int bj = 0; bj < 2; ++bj) { const f32x4 v0 = acc[ai][bj][m][0], v1 = acc[ai][bj][m][1];
                    u32x4 w; w.x = cvt_pk_bf16(v0[0], v0[1]); w.y = cvt_pk_bf16(v0[2], v0[3]); w.z = cvt_pk_bf16(v1[0], v1[1]); w.w = cvt_pk_bf16(v1[2], v1[3]);
                    *(u32x4*)(rowp + bj * HALF) = w; } }
    }
};
struct EpiF32 {
    static constexpr bool PERM = false, AFTER_DRAIN = false;
    float* C; int ldc;
    __device__ __forceinline__ void operator()(const f32x4 (&acc)[2][2][4][2], const Unit& u, int wr, int wc, int fr, int fq) const {
        const int row0 = u.pm * HALF + wr * 64 + fr, col0 = u.pn * BM + wc * 32 + 4 * fq;
#pragma unroll
        for (int ai = 0; ai < 2; ++ai) if (ai < u.nh)
#pragma unroll
            for (int m = 0; m < 4; ++m) { float* rowp = C + (size_t)(row0 + ai * HALF + m * 16) * ldc + col0;
#pragma unroll
                for (int bj = 0; bj < 2; ++bj)
#pragma unroll
                    for (int n = 0; n < 2; ++n) *(f32x4*)(rowp + bj * HALF + n * 16) = acc[ai][bj][m][n]; }
    }
};
template <int MODE> struct EpiMerge {
    static constexpr bool PERM = true, AFTER_DRAIN = false;
    const bf16_t* Gt; int ldg; float* Y; bf16_t* YB;
    __device__ __forceinline__ void operator()(const f32x4 (&acc)[2][2][4][2], const Unit& u, int wr, int wc, int fr, int fq) const {
        const int row0 = u.pm * HALF + wr * 64 + fr, col0 = u.pn * BM + wc * 32 + 8 * fq;
#pragma unroll
        for (int ai = 0; ai < 2; ++ai) if (ai < u.nh)
#pragma unroll
            for (int m = 0; m < 4; ++m) { const size_t r = (size_t)(row0 + ai * HALF + m * 16);
#pragma unroll
                for (int bj = 0; bj < 2; ++bj) { const int c = col0 + bj * HALF;
                    const u32x4 gw = *(const u32x4*)(Gt + r * ldg + c);
                    f32x4 g0, g1;
                    g0[0] = sigmoidf_(bf_lo(gw.x)); g0[1] = sigmoidf_(bf_hi(gw.x)); g0[2] = sigmoidf_(bf_lo(gw.y)); g0[3] = sigmoidf_(bf_hi(gw.y));
                    g1[0] = sigmoidf_(bf_lo(gw.z)); g1[1] = sigmoidf_(bf_hi(gw.z)); g1[2] = sigmoidf_(bf_lo(gw.w)); g1[3] = sigmoidf_(bf_hi(gw.w));
                    float* yp = Y + r * 2048 + c;
                    f32x4 y0 = g0 * acc[ai][bj][m][0], y1 = g1 * acc[ai][bj][m][1];
                    if (MODE != 0) { y0 += *(const f32x4*)yp; y1 += *(const f32x4*)(yp + 4); }
                    if (MODE != 2) { *(f32x4*)yp = y0; *(f32x4*)(yp + 4) = y1; }
                    else { u32x4 w; w.x = cvt_pk_bf16(y0[0], y0[1]); w.y = cvt_pk_bf16(y0[2], y0[3]); w.z = cvt_pk_bf16(y1[0], y1[1]); w.w = cvt_pk_bf16(y1[2], y1[3]);
                        *(u32x4*)(YB + r * 2048 + c) = w; } } }
    }
};
struct EpiResid {
    static constexpr bool PERM = true, AFTER_DRAIN = false;
    float* xlat; float* xctx; const float* gate;
    __device__ __forceinline__ void operator()(const f32x4 (&acc)[2][2][4][2], const Unit& u, int wr, int wc, int fr, int fq) const {
        const int vec = u.pm < 64 ? 0 : (u.pm < 128 ? 1 : 2);
        float* xb = u.pm < 128 ? xlat + (size_t)u.pm * HALF * 2048 : xctx + (size_t)(u.pm - 128) * HALF * 2048;
        const int lrow0 = wr * 64 + fr, col0 = u.pn * BM + wc * 32 + 8 * fq;
        const float* gp = gate + (size_t)vec * 12288 + col0;
#pragma unroll
        for (int bj = 0; bj < 2; ++bj) { const f32x4 g0 = *(const f32x4*)(gp + bj * HALF), g1 = *(const f32x4*)(gp + bj * HALF + 4);
#pragma unroll
            for (int ai = 0; ai < 2; ++ai) if (ai < u.nh)
#pragma unroll
                for (int m = 0; m < 4; ++m) { float* xp = xb + (size_t)(lrow0 + ai * HALF + m * 16) * 2048 + col0 + bj * HALF;
                    const f32x4 x0 = *(const f32x4*)xp + g0 * acc[ai][bj][m][0], x1 = *(const f32x4*)(xp + 4) + g1 * acc[ai][bj][m][1];
                    *(f32x4*)xp = x0; *(f32x4*)(xp + 4) = x1; } }
    }
};

template <class Epi, class Sched, bool ALIGN_EPI = false, bool SP2 = false, bool HALFU = false>
__device__ __forceinline__ void gemm_phase(PG8_LAS unsigned char* lds, const Gemm g, const Sched& S, const Epi& E) {
    int tid_ = threadIdx.x; asm volatile("" : "+v"(tid_));
    const int tid = tid_, wid = __builtin_amdgcn_readfirstlane(tid >> 6), lane = tid & 63, wr = wid >> 2, wc = wid & 3, fr = lane & 15, fq = lane >> 4;
    const int K = g.K, nt = K / BK;
    unsigned voffA[2], voffB[2];
#pragma unroll
    for (int i = 0; i < 2; ++i) { int R, C; stage_rc(tid * 16 + i * 8192, R, C); const int Rb = Epi::PERM ? ((R & ~31) + perm32(R & 31)) : R;
        voffA[i] = (unsigned)(R * g.lda + C) * 2u; voffB[i] = (unsigned)(Rb * g.ldb + C) * 2u; }
    const size_t kstep = (size_t)(BK * 2);
    const size_t hstepA = (size_t)HALF * g.lda * 2, hstepB = (size_t)HALF * g.ldb * 2;
    const size_t tstepB = 2 * hstepB;
    const unsigned ldsw = (unsigned)wid * 1024u;
    const int aoff = lds_byte(wr * 64 + fr, fq * 8), boff = lds_byte(wc * 32 + fr, fq * 8);
#define PG8_SA(b, h) (((b) * 2 + (h)) * HTB)
#define PG8_SB(b, h) ((4 + (b) * 2 + (h)) * HTB)
#define PG8_STAGE(bufoff, gbase, voff) do { _Pragma("unroll") for (int _i = 0; _i < 2; ++_i) \
        __builtin_amdgcn_global_load_lds((const unsigned*)((const char*)(gbase) + (voff)[_i]), (PG8_LAS unsigned*)(lds + (bufoff) + ldsw + _i * 8192), 16, 0, 0); } while (0)
#define PG8_LDA(dst, b, h) do { _Pragma("unroll") for (int m = 0; m < 4; ++m) _Pragma("unroll") for (int k = 0; k < 2; ++k) dst[m][k] = *(const PG8_LAS bf16x8*)(lds + PG8_SA(b, h) + aoff + m * 2048 + k * 1024); } while (0)
#define PG8_LDB(dst, b, h) do { _Pragma("unroll") for (int n = 0; n < 2; ++n) _Pragma("unroll") for (int k = 0; k < 2; ++k) dst[n][k] = *(const PG8_LAS bf16x8*)(lds + PG8_SB(b, h) + boff + n * 2048 + k * 1024); } while (0)
#define PG8_MMA(ai, bj, At, Bt) do { __builtin_amdgcn_s_setprio(1); _Pragma("unroll") for (int m = 0; m < 4; ++m) _Pragma("unroll") for (int n = 0; n < 2; ++n) _Pragma("unroll") for (int k = 0; k < 2; ++k) \
        acc[ai][bj][m][n] = __builtin_amdgcn_mfma_f32_16x16x32_bf16(Bt[n][k], At[m][k], acc[ai][bj][m][n], 0, 0, 0); __builtin_amdgcn_s_setprio(0); } while (0)
#define PG8_WAIT_V(n) asm volatile("s_waitcnt vmcnt(" #n ")" ::: "memory")
#define PG8_WAIT_L(n) asm volatile("s_waitcnt lgkmcnt(" #n ")" ::: "memory")
#define PG8_BAR __builtin_amdgcn_s_barrier()
#define PG8_SCHED __builtin_amdgcn_sched_barrier(0)
    Unit cur, nxt; int ui = 0;
    if (!S.next(0, cur)) return;
    f32x4 acc[2][2][4][2];
#pragma unroll
    for (int a = 0; a < 2; ++a)
#pragma unroll
        for (int b = 0; b < 2; ++b)
#pragma unroll
            for (int m = 0; m < 4; ++m)
#pragma unroll
                for (int n = 0; n < 2; ++n) acc[a][b][m][n] = (f32x4){0.f, 0.f, 0.f, 0.f};
    bf16x8 At[4][2], B0[2][2], B1[2][2];
    const char* cA = (const char*)g.A + (size_t)cur.pm * hstepA; const char* cB = (const char*)g.Bt + (size_t)cur.pn * tstepB;
    size_t chA = (!HALFU || cur.nh == 2) ? hstepA : 0;
    S.a_ready(cur);
    if constexpr (SP2) {
        PG8_STAGE(PG8_SB(0, 0), cB, voffB); PG8_STAGE(PG8_SB(0, 1), cB + hstepB, voffB); PG8_STAGE(PG8_SA(0, 0), cA, voffA); PG8_STAGE(PG8_SA(0, 1), cA + chA, voffA);
        if (wr == 1) PG8_BAR;
        PG8_WAIT_V(2); PG8_BAR;
        PG8_STAGE(PG8_SB(1, 0), cB + kstep, voffB); PG8_STAGE(PG8_SA(1, 0), cA + kstep, voffA); PG8_STAGE(PG8_SB(1, 1), cB + hstepB + kstep, voffB);
        PG8_WAIT_V(6); PG8_BAR;
    } else {
        PG8_STAGE(PG8_SB(0, 0), cB, voffB); PG8_STAGE(PG8_SA(0, 0), cA, voffA); PG8_STAGE(PG8_SB(0, 1), cB + hstepB, voffB); PG8_STAGE(PG8_SA(0, 1), cA + chA, voffA);
        if (wr == 1) PG8_BAR;
        PG8_WAIT_V(4); PG8_BAR;
        PG8_STAGE(PG8_SB(1, 0), cB + kstep, voffB); PG8_STAGE(PG8_SA(1, 0), cA + kstep, voffA); PG8_STAGE(PG8_SB(1, 1), cB + hstepB + kstep, voffB);
        PG8_WAIT_V(6); PG8_BAR;
    }
    for (;;) {
        const bool has_next = S.next(ui + 1, nxt);
        const char* nA = has_next ? (const char*)g.A + (size_t)nxt.pm * hstepA : cA; const size_t nhA = has_next ? ((!HALFU || nxt.nh == 2) ? hstepA : 0) : chA; const bool full = (!HALFU || cur.nh == 2);
        const char* nA_ = nA; (void)nA_; const char* nB = has_next ? (const char*)g.Bt + (size_t)nxt.pn * tstepB : cB;
        for (int t = 0; t < nt; t += 2) {
            const bool last = (t == nt - 2);
            const char* a1 = cA + (size_t)(t + 1) * kstep;
            const char* a2 = last ? nA : cA + (size_t)(t + 2) * kstep; const char* b2 = last ? nB : cB + (size_t)(t + 2) * kstep;
            const char* a3 = a2 + kstep; const char* b3 = b2 + kstep;
            const size_t h2A = last ? nhA : chA;
            if (last && has_next) S.a_ready(nxt);
            if constexpr (SP2) {
            PG8_LDB(B0, 0, 0); PG8_LDB(B1, 0, 1); PG8_SCHED; PG8_LDA(At, 0, 0); PG8_STAGE(PG8_SA(1, 1), a1 + chA, voffA);
            PG8_WAIT_V(8); PG8_WAIT_L(0); PG8_BAR; PG8_MMA(0, 0, At, B0); PG8_MMA(0, 1, At, B1); PG8_BAR; PG8_SCHED;
            PG8_LDA(At, 0, 1); PG8_STAGE(PG8_SB(0, 0), b2, voffB); PG8_STAGE(PG8_SB(0, 1), b2 + hstepB, voffB); PG8_STAGE(PG8_SA(0, 0), a2, voffA);
            PG8_WAIT_V(8); PG8_WAIT_L(0); PG8_BAR; if (full) { PG8_MMA(1, 0, At, B0); PG8_MMA(1, 1, At, B1); } PG8_BAR; PG8_SCHED;
            PG8_LDB(B0, 1, 0); PG8_LDB(B1, 1, 1); PG8_SCHED; PG8_LDA(At, 1, 0); PG8_STAGE(PG8_SA(0, 1), a2 + h2A, voffA);
            PG8_WAIT_V(8); PG8_WAIT_L(0); PG8_BAR; PG8_MMA(0, 0, At, B0); PG8_MMA(0, 1, At, B1); PG8_BAR; PG8_SCHED;
            PG8_LDA(At, 1, 1); PG8_STAGE(PG8_SB(1, 0), b3, voffB); PG8_STAGE(PG8_SB(1, 1), b3 + hstepB, voffB); PG8_STAGE(PG8_SA(1, 0), a3, voffA);
            PG8_WAIT_V(8); PG8_WAIT_L(0); PG8_BAR; if (full) { PG8_MMA(1, 0, At, B0); PG8_MMA(1, 1, At, B1); } PG8_BAR; PG8_SCHED;
            } else {
            PG8_LDB(B0, 0, 0); PG8_SCHED; PG8_LDA(At, 0, 0); PG8_STAGE(PG8_SA(1, 1), a1 + chA, voffA);
            PG8_WAIT_L(8); PG8_BAR; PG8_WAIT_L(0); PG8_MMA(0, 0, At, B0); PG8_BAR; PG8_SCHED;
            PG8_LDB(B1, 0, 1); PG8_STAGE(PG8_SB(0, 0), b2, voffB);
            PG8_BAR; PG8_WAIT_L(0); PG8_MMA(0, 1, At, B1); PG8_BAR;
            PG8_LDA(At, 0, 1); PG8_STAGE(PG8_SA(0, 0), a2, voffA);
            PG8_BAR; PG8_WAIT_L(0); if (full) PG8_MMA(1, 0, At, B0); PG8_BAR; PG8_SCHED;
            PG8_STAGE(PG8_SB(0, 1), b2 + hstepB, voffB);
            PG8_WAIT_V(6); PG8_BAR; if (full) PG8_MMA(1, 1, At, B1); PG8_BAR;
            PG8_LDB(B0, 1, 0); PG8_SCHED; PG8_LDA(At, 1, 0); PG8_STAGE(PG8_SA(0, 1), a2 + h2A, voffA);
            PG8_WAIT_L(8); PG8_BAR; PG8_WAIT_L(0); PG8_MMA(0, 0, At, B0); PG8_BAR; PG8_SCHED;
            PG8_LDB(B1, 1, 1); PG8_STAGE(PG8_SB(1, 0), b3, voffB);
            PG8_BAR; PG8_WAIT_L(0); PG8_MMA(0, 1, At, B1); PG8_BAR;
            PG8_LDA(At, 1, 1); PG8_STAGE(PG8_SA(1, 0), a3, voffA);
            PG8_BAR; PG8_WAIT_L(0); if (full) PG8_MMA(1, 0, At, B0); PG8_BAR; PG8_SCHED;
            PG8_STAGE(PG8_SB(1, 1), b3 + hstepB, voffB);
            PG8_WAIT_V(6); PG8_BAR; if (full) PG8_MMA(1, 1, At, B1); PG8_BAR;
            }
        }
        if constexpr (ALIGN_EPI) { if (wr == 0) PG8_BAR; }
        if constexpr (!Epi::AFTER_DRAIN) { E(acc, cur, wr, wc, fr, fq); S.done(cur); }
        if (!has_next) break;
#pragma unroll
        for (int a = 0; a < 2; ++a)
#pragma unroll
            for (int b = 0; b < 2; ++b)
#pragma unroll
                for (int m = 0; m < 4; ++m)
#pragma unroll
                    for (int n = 0; n < 2; ++n) acc[a][b][m][n] = (f32x4){0.f, 0.f, 0.f, 0.f};
        cur = nxt; cA = nA; cB = nB; chA = nhA; ++ui;
        if constexpr (ALIGN_EPI) { if (wr == 1) PG8_BAR; }
    }
    PG8_WAIT_V(0);
    if constexpr (!ALIGN_EPI) { if (wr == 0) PG8_BAR; }
    PG8_BAR;
#undef PG8_SA
#undef PG8_SB
#undef PG8_STAGE
#undef PG8_LDA
#undef PG8_LDB
#undef PG8_MMA
#undef PG8_WAIT_V
#undef PG8_WAIT_L
#undef PG8_BAR
#undef PG8_SCHED
}
}
namespace att {
constexpr int D = 128, NW = 8, QBLK = 32, KVBLK = 64;
constexpr float SCALE = 0.088388347648318440f;
constexpr float THR = 8.f;
constexpr int LDQ = NIN, LDK = 128, LDO = NIN;
constexpr size_t SHM_V = KVBLK * D * 2, SHM_K = KVBLK * D * 2, SHM_ATTN = 2 * SHM_V + 2 * SHM_K + NW * 64 * 4;
#define KSWZ(row, colB) ((row) * 256 + ((colB) ^ (((row) & 7) << 4)))
#define SBAR() __builtin_amdgcn_sched_barrier(0)
__device__ __forceinline__ int crow(int r, int hi) { return (r & 3) + 8 * (r >> 2) + 4 * hi; }
__device__ __forceinline__ unsigned cvtpk(float lo, float hi) { unsigned r; asm volatile("v_cvt_pk_bf16_f32 %0, %1, %2" : "=v"(r) : "v"(lo), "v"(hi)); return r; }
__device__ __forceinline__ bf16x8 ld8(const bf16_t* p) { return *reinterpret_cast<const bf16x8*>(p); }

__device__ __forceinline__ void partialSM(f32x16& p0, f32x16& p1, float& m_reg, float& mn, float& alpha) {
  constexpr float C = SCALE * 1.4426950408889634f;
  float pmax = p0[0];
#pragma unroll
  for (int r = 1; r < 16; ++r) pmax = fmaxf(pmax, p0[r]);
#pragma unroll
  for (int r = 0; r < 16; ++r) pmax = fmaxf(pmax, p1[r]);
  { auto rr = __builtin_amdgcn_permlane32_swap(__float_as_uint(pmax), __float_as_uint(pmax), false, false);
    pmax = fmaxf(__uint_as_float(rr[0]), __uint_as_float(rr[1])); }
  if (__builtin_expect(__all(pmax - m_reg <= THR / SCALE), 1)) { mn = m_reg; alpha = 1.f; }
  else { mn = fmaxf(m_reg, pmax); alpha = __builtin_amdgcn_exp2f((m_reg - mn) * C); m_reg = mn; }
  float mnC = -mn * C;
#pragma unroll
  for (int r = 0; r < 16; ++r) p0[r] = fmaf(p0[r], C, mnC);
#pragma unroll
  for (int r = 0; r < 16; ++r) p1[r] = fmaf(p1[r], C, mnC);
#pragma unroll
  for (int r = 0; r < 16; ++r) p0[r] = __builtin_amdgcn_exp2f(p0[r]);
}
__device__ __forceinline__ void finishSM(f32x16& p0, f32x16& p1, float alpha, float& l_reg, bf16x8& pa0, bf16x8& pa1, bf16x8& pa2, bf16x8& pa3) {
#pragma unroll
  for (int r = 0; r < 16; ++r) p1[r] = __builtin_amdgcn_exp2f(p1[r]);
  float ps = 0;
#pragma unroll
  for (int r = 0; r < 16; ++r) ps += p0[r];
#pragma unroll
  for (int r = 0; r < 16; ++r) ps += p1[r];
  { auto rr = __builtin_amdgcn_permlane32_swap(__float_as_uint(ps), __float_as_uint(ps), false, false);
    ps = __uint_as_float(rr[0]) + __uint_as_float(rr[1]); }
  l_reg = l_reg * alpha + ps;
#define PK4(P, BASE, OUT) do { unsigned a0 = cvtpk(P[BASE + 0], P[BASE + 1]), a1 = cvtpk(P[BASE + 2], P[BASE + 3]);   \
    unsigned b0 = cvtpk(P[BASE + 4], P[BASE + 5]), b1 = cvtpk(P[BASE + 6], P[BASE + 7]);                              \
    auto r0 = __builtin_amdgcn_permlane32_swap(a0, b0, false, false); auto r1 = __builtin_amdgcn_permlane32_swap(a1, b1, false, false); \
    u32x4 w = {r0[0], r1[0], r0[1], r1[1]}; OUT = *reinterpret_cast<bf16x8*>(&w); } while (0)
  PK4(p0, 0, pa0); PK4(p0, 8, pa1); PK4(p1, 0, pa2); PK4(p1, 8, pa3);
#undef PK4
}
__device__ __forceinline__ void qkt(f32x16& p0, f32x16& p1, const bf16_t* Ks, const bf16x8* qr, int r32, int hi) {
  p0 = f32x16{}; p1 = f32x16{};
#pragma unroll
  for (int d0 = 0; d0 < 8; ++d0) { int cb = (d0 * 16 + hi * 8) * 2;
    bf16x8 b0 = *reinterpret_cast<const bf16x8*>((const char*)Ks + KSWZ(r32, cb));
    bf16x8 b1 = *reinterpret_cast<const bf16x8*>((const char*)Ks + KSWZ(32 + r32, cb));
    p0 = __builtin_amdgcn_mfma_f32_32x32x16_bf16(b0, qr[d0], p0, 0, 0, 0);
    p1 = __builtin_amdgcn_mfma_f32_32x32x16_bf16(b1, qr[d0], p1, 0, 0, 0); }
}
__device__ __forceinline__ int v_st(int k, int c) { const int kk = (k & ~0xC) | ((k & 4) << 1) | ((k & 8) >> 1); return ((kk >> 3) * 4 + (c >> 5)) * 512 + ((kk & 7) * 32 + (c & 31)) * 2; }
__device__ __forceinline__ int v_rd_base(int lane) { return ((lane & 3) << 3) | (((lane >> 2) & 3) << 6) | (((lane >> 4) & 1) << 5) | (((lane >> 5) & 1) << 8); }
constexpr int v_rd_off(int d0, int ks, int half) { return d0 * 512 + ks * 4096 + half * 2048; }
template <int OFF> __device__ __forceinline__ s16x4 tr_read(int vb) {
  s16x4 r; asm volatile("ds_read_b64_tr_b16 %0, %1 offset:%2" : "=&v"(r) : "v"(vb), "i"(OFF) : "memory"); return r;
}
template <int D0> __device__ __forceinline__ void pv_one(f32x16& od, int vb, bf16x8 pa0, bf16x8 pa1, bf16x8 pa2, bf16x8 pa3) {
  const s16x4 l0 = tr_read<v_rd_off(D0, 0, 0)>(vb), h0 = tr_read<v_rd_off(D0, 0, 1)>(vb), l1 = tr_read<v_rd_off(D0, 1, 0)>(vb), h1 = tr_read<v_rd_off(D0, 1, 1)>(vb);
  const s16x4 l2 = tr_read<v_rd_off(D0, 2, 0)>(vb), h2 = tr_read<v_rd_off(D0, 2, 1)>(vb), l3 = tr_read<v_rd_off(D0, 3, 0)>(vb), h3 = tr_read<v_rd_off(D0, 3, 1)>(vb);
  asm volatile("s_waitcnt lgkmcnt(0)" ::: "memory"); SBAR();
#define PK(L, H) (bf16x8){L[0], L[1], L[2], L[3], H[0], H[1], H[2], H[3]}
  od = __builtin_amdgcn_mfma_f32_32x32x16_bf16(pa0, PK(l0, h0), od, 0, 0, 0);
  od = __builtin_amdgcn_mfma_f32_32x32x16_bf16(pa1, PK(l1, h1), od, 0, 0, 0);
  od = __builtin_amdgcn_mfma_f32_32x32x16_bf16(pa2, PK(l2, h2), od, 0, 0, 0);
  od = __builtin_amdgcn_mfma_f32_32x32x16_bf16(pa3, PK(l3, h3), od, 0, 0, 0);
#undef PK
}
__device__ __forceinline__ void pv_d0(f32x16* o, int vb, bf16x8 pa0, bf16x8 pa1, bf16x8 pa2, bf16x8 pa3) {
  pv_one<0>(o[0], vb, pa0, pa1, pa2, pa3); pv_one<1>(o[1], vb, pa0, pa1, pa2, pa3); pv_one<2>(o[2], vb, pa0, pa1, pa2, pa3); pv_one<3>(o[3], vb, pa0, pa1, pa2, pa3);
}

__device__ __forceinline__ void attn_dense_body(const bf16_t* __restrict__ Qb, const bf16_t* __restrict__ Kh, const bf16_t* __restrict__ Vh,
                                                bf16_t* Ob, int seq, char* lds) {
  constexpr int SDEPTH = 2;
  int tid_ = threadIdx.x; asm volatile("" : "+v"(tid_));
  const int tid = tid_, wid = tid >> 6, lane = tid & 63, r32 = lane & 31, hi = lane >> 5;
  bf16_t* V_lds = (bf16_t*)lds; bf16_t* K_lds = (bf16_t*)(lds + 2 * SHM_V);
  float* ws = (float*)(lds + 2 * SHM_V + 2 * SHM_K) + wid * 64; float* li_l = ws; float* al_l = ws + 32;
  float m_reg = -1e30f, l_reg = 0; f32x16 o[4] = {}; bf16x8 qr[8];
  const bf16_t* Qw = Qb + (long)(wid * QBLK + r32) * LDQ + hi * 8;
#pragma unroll
  for (int d0 = 0; d0 < 8; ++d0) qr[d0] = ld8(Qw + d0 * 16);
  const int sr = tid >> 4, sc = (tid & 15) * 8, vst0 = v_st(sr, sc), vst1 = v_st(32 + sr, sc);
  const int vb0 = (int)(uintptr_t)V_lds + v_rd_base(lane);
  struct { bf16x8 vs0, vs1, ks0, ks1; } sr_[SDEPTH];
#define SLOAD(i, k0) do { sr_[i].vs0 = ld8(&Vh[(long)((k0) + sr) * LDK + sc]); sr_[i].vs1 = ld8(&Vh[(long)((k0) + 32 + sr) * LDK + sc]); \
    sr_[i].ks0 = ld8(&Kh[(long)((k0) + sr) * LDK + sc]); sr_[i].ks1 = ld8(&Kh[(long)((k0) + 32 + sr) * LDK + sc]); } while (0)
#define SWRITE(b, i) do { *(bf16x8*)((char*)V_lds + (b) * SHM_V + vst0) = sr_[i].vs0;          \
    *(bf16x8*)((char*)V_lds + (b) * SHM_V + vst1) = sr_[i].vs1; int kc = sc * 2;               \
    *(bf16x8*)((char*)K_lds + (b) * SHM_K + KSWZ(sr, kc)) = sr_[i].ks0;                       \
    *(bf16x8*)((char*)K_lds + (b) * SHM_K + KSWZ(32 + sr, kc)) = sr_[i].ks1; } while (0)
#define SWAIT() asm volatile("s_waitcnt vmcnt(4)" ::: "memory")
#define RESC(a) do { if (__any((a) < 1.f)) { if (hi == 0) al_l[r32] = (a); asm volatile("s_waitcnt lgkmcnt(0)" ::: "memory"); \
    _Pragma("unroll") for (int d = 0; d < 4; ++d) _Pragma("unroll") for (int r = 0; r < 16; ++r) o[d][r] *= al_l[crow(r, hi)]; } } while (0)
  f32x16 pA0, pA1, pB0, pB1; float mnA, mnB, alA, alB; bf16x8 pa0, pa1, pa2, pa3; const int NT = seq / KVBLK;
  constexpr int SE = 0, SO = SDEPTH - 1;
  SLOAD(SE, 0); asm volatile("s_waitcnt vmcnt(0)" ::: "memory"); SWRITE(0, SE); __syncthreads();
  qkt(pA0, pA1, K_lds, qr, r32, hi); partialSM(pA0, pA1, m_reg, mnA, alA);
  SLOAD(SO, KVBLK); if (2 < NT) SLOAD(SE, 2 * KVBLK);
  SWAIT(); SWRITE(1, SO); __syncthreads();
  for (int j = 1; j + 1 < NT; j += 2) {
    SBAR(); qkt(pB0, pB1, (bf16_t*)((char*)K_lds + SHM_K), qr, r32, hi);
    finishSM(pA0, pA1, alA, l_reg, pa0, pa1, pa2, pa3); SBAR();
    SLOAD(SO, (j + SDEPTH) * KVBLK); SBAR();
    pv_d0(o, vb0, pa0, pa1, pa2, pa3); partialSM(pB0, pB1, m_reg, mnB, alB);
    __syncthreads(); SWAIT(); SWRITE(0, SE);
    RESC(alB); __syncthreads();
    SBAR(); qkt(pA0, pA1, K_lds, qr, r32, hi);
    finishSM(pB0, pB1, alB, l_reg, pa0, pa1, pa2, pa3); SBAR();
    if (j + 3 < NT) SLOAD(SE, (j + 1 + SDEPTH) * KVBLK); SBAR();
    pv_d0(o, vb0 + (int)SHM_V, pa0, pa1, pa2, pa3); partialSM(pA0, pA1, m_reg, mnA, alA);
    __syncthreads(); SWAIT(); SWRITE(1, SO);
    RESC(alA); __syncthreads();
  }
  SBAR(); qkt(pB0, pB1, (bf16_t*)((char*)K_lds + SHM_K), qr, r32, hi);
  finishSM(pA0, pA1, alA, l_reg, pa0, pa1, pa2, pa3); SBAR();
  pv_d0(o, vb0, pa0, pa1, pa2, pa3); partialSM(pB0, pB1, m_reg, mnB, alB);
  __syncthreads(); RESC(alB);
  finishSM(pB0, pB1, alB, l_reg, pa0, pa1, pa2, pa3); SBAR();
  pv_d0(o, vb0 + (int)SHM_V, pa0, pa1, pa2, pa3);
  if (hi == 0) li_l[r32] = l_reg; asm volatile("s_waitcnt lgkmcnt(0)" ::: "memory");
  float rli[16];
#pragma unroll
  for (int r = 0; r < 16; ++r) rli[r] = __builtin_amdgcn_rcpf(li_l[crow(r, hi)]);
  bf16_t* Ow = Ob + (long)(wid * QBLK) * LDO;
#pragma unroll
  for (int r = 0; r < 16; ++r) { int orow = crow(r, hi);
#pragma unroll
    for (int d0 = 0; d0 < 4; ++d0) Ow[(long)orow * LDO + d0 * 32 + r32] = f2bf(o[d0][r] * rli[r]); }
  __syncthreads();
#undef SLOAD
#undef SWRITE
#undef SWAIT
#undef RESC
}
#undef KSWZ
#undef SBAR
}
#define CAS __attribute__((address_space(4)))
#define INP(i) ((const float*)(GAS const float*)in[i])
struct Ctx {
    float* out; unsigned char* ws;
    LAS unsigned char* lds; int tid, lane, wave, wg, G;
};
enum { I_X = 0, I_C, I_CTX, I_CCTX, I_WMOD, I_BMOD, I_NMIX, I_NFFN, I_WIN, I_QN, I_KN, I_LCW, I_LCB, I_LWA, I_LBA, I_LWX, I_LBX, I_LLAM, I_SCW, I_SCB,
       I_WOA, I_WOL, I_WOS, I_WOUT, I_PWQ, I_PK1, I_PK2, I_PU, I_PV };

__device__ __forceinline__ float* xrow_ptr(const Ctx& c, int r) {
    return r < MLAT ? c.out + (size_t)r * DM : (float*)(c.ws + WS_CTXS) + (size_t)(r - MLAT) * DM;
}

__device__ __forceinline__ void transpose_item(const float* W, int K, int N, bf16_t* WT, LAS float* scr, int item, int lane) {
    const int nblk = N / 64, kb = item / nblk, nb = item % nblk, k0 = 64 * kb, n0 = 64 * nb;
    const float* src = W + (size_t)(k0 + (lane >> 4)) * N + n0 + (lane & 15) * 4;
    f32x4 v[16];
#pragma unroll
    for (int i = 0; i < 16; ++i) v[i] = *(const f32x4*)(src + (size_t)(4 * i) * N);
    LAS float* d = scr + (lane >> 4) * 65 + (lane & 15) * 4;
#pragma unroll
    for (int i = 0; i < 16; ++i) { d[(4 * i) * 65 + 0] = v[i][0]; d[(4 * i) * 65 + 1] = v[i][1]; d[(4 * i) * 65 + 2] = v[i][2]; d[(4 * i) * 65 + 3] = v[i][3]; }
    LDS_WAIT(); asm volatile("" ::: "memory");
    const int c = lane & 7;
#pragma unroll
    for (int j = 0; j < 8; ++j) { const int n = (lane >> 3) + 8 * j; const LAS float* s = scr + (8 * c) * 65 + n;
        u32x4 o; o.x = cvt_pk_bf16(s[0 * 65], s[1 * 65]); o.y = cvt_pk_bf16(s[2 * 65], s[3 * 65]); o.z = cvt_pk_bf16(s[4 * 65], s[5 * 65]); o.w = cvt_pk_bf16(s[6 * 65], s[7 * 65]);
        *(u32x4*)(WT + (size_t)(n0 + n) * K + k0 + 8 * c) = o; }
    LDS_WAIT(); asm volatile("" ::: "memory");
}

__device__ __forceinline__ void mod_unit(const Ctx& c, CAS const unsigned long long* in, int l, int cb) {
    LAS float* sv = (LAS float*)c.lds;
    LAS float* red = sv + 3 * DM;
    { const float* cc = INP(I_C); const float* cx = INP(I_CCTX);
      for (int i = c.tid; i < 3 * DM; i += NTHREADS) { const int v = i / DM, k = i % DM; const float x = v < 2 ? cc[v * DM + k] : cx[k]; sv[i] = x * sigmoidf_(x); } }
    __syncthreads();
    const int j4 = (c.tid & 31) * 4, kg = c.tid >> 5;
    const float* w = INP(I_WMOD) + (size_t)l * DM * NMOD + (size_t)(kg * 128) * NMOD + cb * 128 + j4;
    f32x4 a0 = {0.f, 0.f, 0.f, 0.f}, a1 = a0, a2 = a0;
#pragma unroll 8
    for (int k = 0; k < 128; ++k) { const f32x4 wv = *(const f32x4*)(w + (size_t)k * NMOD); const int kk = kg * 128 + k; a0 += wv * sv[kk]; a1 += wv * sv[DM + kk]; a2 += wv * sv[2 * DM + kk]; }
    *(LAS f32x4*)(red + (kg * 3 + 0) * 128 + j4) = a0; *(LAS f32x4*)(red + (kg * 3 + 1) * 128 + j4) = a1; *(LAS f32x4*)(red + (kg * 3 + 2) * 128 + j4) = a2;
    __syncthreads();
    if (c.tid < 384) { const int v = c.tid >> 7, jj = c.tid & 127; float s = INP(I_BMOD)[l * NMOD + cb * 128 + jj];
#pragma unroll
        for (int g = 0; g < 16; ++g) s += red[(g * 3 + v) * 128 + jj];
        ((float*)(c.ws + WS_MOD))[((size_t)l * 3 + v) * NMOD + cb * 128 + jj] = s; }
    __syncthreads();
}

__device__ __forceinline__ void wsc_unit(const Ctx& c, CAS const unsigned long long* in, int l, int u) {
    const int hh = u >> 4, kb = u & 15, h = hh >> 1, half = hh & 1, k0 = kb * 128;
    LAS float* kkL = (LAS float*)c.lds;
    LAS float* wqL = kkL + 128 * 132;
    const float* ksrc = INP(half ? I_PK2 : I_PK1) + ((size_t)(l * 8 + h) * 128) * 128;
    const float* qsrc = INP(I_PWQ) + (size_t)l * DM * DM + (size_t)k0 * DM + hh * 128;
    for (int i = c.tid; i < 128 * 32; i += NTHREADS) { const int r = i >> 5, c4 = (i & 31) * 4;
        *(LAS f32x4*)(kkL + r * 132 + c4) = *(const f32x4*)(ksrc + (size_t)r * 128 + c4);
        *(LAS f32x4*)(wqL + r * 132 + c4) = *(const f32x4*)(qsrc + (size_t)r * DM + c4); }
    __syncthreads();
    const int k = c.tid & 127, ng = c.tid >> 7;
    float acc[32];
#pragma unroll
    for (int j = 0; j < 32; ++j) acc[j] = 0.f;
    for (int d4 = 0; d4 < 32; ++d4) {
        const f32x4 a = *(const LAS f32x4*)(wqL + k * 132 + d4 * 4);
#pragma unroll
        for (int j = 0; j < 32; ++j) { const f32x4 b = *(const LAS f32x4*)(kkL + (ng * 32 + j) * 132 + d4 * 4); acc[j] += (a[0] * b[0] + a[1] * b[1]) + (a[2] * b[2] + a[3] * b[3]); }
    }
    bf16_t* dst = (bf16_t*)(c.ws + WS_WSC) + (size_t)(hh * 128 + ng * 32) * DM + k0 + k;
#pragma unroll
    for (int j = 0; j < 32; ++j) dst[(size_t)j * DM] = f2bf(acc[j]);
    __syncthreads();
}

#define GET_IN() unsigned long long kai_ = (unsigned long long)__builtin_amdgcn_kernarg_segment_ptr(); asm volatile("" : "+s"(kai_)); CAS const unsigned long long* in = (CAS const unsigned long long*)kai_
__device__ __forceinline__ void conv_units(const Ctx& c, int l) {
    GET_IN();
    if (l == 0) for (int u = c.wg; u < 2 * 96; u += c.G) mod_unit(c, in, u / 96, u % 96);
    for (int u = c.wg; u < 256; u += c.G) wsc_unit(c, in, l, u);
}
__device__ __forceinline__ void conv_transposes(const Ctx& c, int l) {
    GET_IN();
    const int gw = c.wg * NWAVES + c.wave, NGW = c.G * NWAVES;
    LAS float* scr = (LAS float*)(c.lds + c.wave * 16640);
    constexpr int I_IN = (DM / 64) * (NIN / 64), I_SQ = (DM / 64) * (DM / 64);
    const float* win = INP(I_WIN) + (size_t)l * DM * NIN;
    for (int it = gw; it < I_IN; it += NGW) transpose_item(win, DM, NIN, (bf16_t*)(c.ws + WS_WIN), scr, it, c.lane);
    for (int s = 0; s < 4; ++s) {
        const float* src = INP(s == 0 ? I_WOA : s == 1 ? I_WOL : s == 2 ? I_WOS : I_WOUT) + (size_t)l * DM * DM;
        bf16_t* dst = s < 3 ? (bf16_t*)(c.ws + WS_WO) + (size_t)s * DM * DM : (bf16_t*)(c.ws + WS_WOUT);
        for (int it = gw; it < I_SQ; it += NGW) transpose_item(src, DM, DM, dst, scr, it, c.lane);
    }
}
__device__ __forceinline__ void conv_tables(const Ctx& c, int l) {
    GET_IN();
    const size_t gt = (size_t)c.wg * NTHREADS + c.tid, NT = (size_t)c.G * NTHREADS;
    constexpr size_t NG16 = (size_t)16384 * DM / 16;
#pragma unroll 1
    for (int tb = 0; tb < 2; ++tb) {
        const float* srcb = INP(tb ? I_PV : I_PU) + (size_t)l * 16384 * DM; unsigned char* dstb = (unsigned char*)(c.ws + (tb ? WS_PV : WS_PU));
        const float sc = tb ? 1.f : 32.f;
        for (size_t j = gt; j < NG16; j += 2 * NT) {
            const size_t j2 = j + NT; const bool has2 = j2 < NG16;
            f32x4 a[4], b[4];
#pragma unroll
            for (int d = 0; d < 4; ++d) a[d] = *(const f32x4*)(srcb + j * 16 + d * 4);
#pragma unroll
            for (int d = 0; d < 4; ++d) b[d] = has2 ? *(const f32x4*)(srcb + j2 * 16 + d * 4) : (f32x4){0.f, 0.f, 0.f, 0.f};
            u32x4 o, o2;
#pragma unroll
            for (int d = 0; d < 4; ++d) { const f32x4 x = a[d] * sc, y = b[d] * sc;
                int w = __builtin_amdgcn_cvt_pk_fp8_f32(x[0], x[1], 0, false); w = __builtin_amdgcn_cvt_pk_fp8_f32(x[2], x[3], w, true); o[d] = (unsigned)w;
                int w2 = __builtin_amdgcn_cvt_pk_fp8_f32(y[0], y[1], 0, false); w2 = __builtin_amdgcn_cvt_pk_fp8_f32(y[2], y[3], w2, true); o2[d] = (unsigned)w2; }
            *(u32x4*)(dstb + (size_t)((j & 127) >> 3) * ((size_t)16384 * 128) + (j >> 7) * 128 + (j & 7) * 16) = o;
            if (has2) *(u32x4*)(dstb + (size_t)((j2 & 127) >> 3) * ((size_t)16384 * 128) + (j2 >> 7) * 128 + (j2 & 7) * 16) = o2; }
    }
    for (size_t i = gt; i < (size_t)16 * 512 * 128; i += NT) { const int ci = (int)(i & 127), j = (int)((i >> 7) & 511), n = (int)(i >> 16), d = j >> 8, which = (j >> 7) & 1, dd = j & 127;
        const float* src = INP(which ? I_LWX : I_LWA) + ((((size_t)(l * 2 + d) * 16 + n) * 128 + ci) * 128 + dd);
        ((bf16_t*)(c.ws + WS_WLRU))[i] = f2bf(*src); }
}
__device__ __forceinline__ void sp_copy(const Ctx& c, const float* src, int sp_off, int n) {
    const size_t gt = (size_t)c.wg * NTHREADS + c.tid, NT = (size_t)c.G * NTHREADS;
    for (size_t i = gt; i < (size_t)n; i += NT) ((float*)(c.ws + WS_SP))[sp_off + i] = src[i];
}
__device__ __forceinline__ void conv_small(const Ctx& c, int l) {
    GET_IN();
    const size_t gt = (size_t)c.wg * NTHREADS + c.tid, NT = (size_t)c.G * NTHREADS;
    sp_copy(c, INP(I_NMIX) + l * DM, SP_NMIX, DM); sp_copy(c, INP(I_NFFN) + l * DM, SP_NFFN, DM);
    sp_copy(c, INP(I_QN) + l * 128, SP_QN, 128); sp_copy(c, INP(I_KN) + l * 128, SP_KN, 128);
    sp_copy(c, INP(I_LCW) + l * 4 * DM, SP_LCW, 4 * DM); sp_copy(c, INP(I_LCB) + l * DM, SP_LCB, DM);
    sp_copy(c, INP(I_LBA) + l * 2 * DM, SP_LBA, 2 * DM); sp_copy(c, INP(I_LBX) + l * 2 * DM, SP_LBX, 2 * DM);
    sp_copy(c, INP(I_SCW) + l * 3 * DM, SP_SCW, 3 * DM); sp_copy(c, INP(I_SCB) + l * DM, SP_SCB, DM);
    { const float* lam = INP(I_LLAM) + l * 2 * DM;
      for (size_t i = gt; i < (size_t)2 * DM; i += NT) ((float*)(c.ws + WS_SP))[SP_LSP + i] = 8.f * log1pf(expf(-lam[i])); }
}
__device__ __forceinline__ void conv_once(const Ctx& c) {
    GET_IN();
    const size_t gt = (size_t)c.wg * NTHREADS + c.tid, NT = (size_t)c.G * NTHREADS;
    for (size_t i = gt; i < 128 * 32; i += NT) { const int pos = (int)(i >> 5), p = (int)(i & 31);
        const float inv = exp2f(-(float)p * (13.287712379549449f / 32.f)); const float ang = (float)pos * inv;
        float sn, cs; sincosf(ang, &sn, &cs);
        ((float*)(c.ws + WS_ROPE))[i] = cs; ((float*)(c.ws + WS_ROPE))[128 * 32 + i] = sn; }
    { const f32x4* xs = (const f32x4*)INP(I_X); for (size_t i = gt; i < (size_t)MLAT * DM / 4; i += NT) ((f32x4*)c.out)[i] = xs[i]; }
    { const f32x4* cs_ = (const f32x4*)INP(I_CTX); for (size_t i = gt; i < (size_t)MCTX * DM / 4; i += NT) ((f32x4*)(c.ws + WS_CTXS))[i] = cs_[i]; }
}

__device__ __forceinline__ void phase_norm(const Ctx& c, int l, int nrows, int sp_gain, int slot_shift, unsigned char* h8 = nullptr) {
    const int gw = c.wg * NWAVES + c.wave, NGW = c.G * NWAVES;
    const float* modl = (const float*)(c.ws + WS_MOD) + (size_t)l * 3 * NMOD;
    bf16_t* HX = (bf16_t*)(c.ws + WS_HX); const float* gain = (const float*)(c.ws + WS_SP) + sp_gain;
    for (int r = gw; r < nrows; r += NGW) {
        const int vec = r < SEQ ? 0 : (r < MLAT ? 1 : 2);
        const float* xr = xrow_ptr(c, r); const float* sh = modl + (size_t)vec * NMOD + slot_shift * DM; const float* sc = sh + DM;
        f32x4 v[8]; float ss = 0.f;
#pragma unroll
        for (int j = 0; j < 8; ++j) { v[j] = *(const f32x4*)(xr + j * 256 + c.lane * 4); ss += (v[j][0] * v[j][0] + v[j][1] * v[j][1]) + (v[j][2] * v[j][2] + v[j][3] * v[j][3]); }
        const float rs = rsqrtf(wave_sum(ss) * (1.f / DM) + EPS);
#pragma unroll
        for (int j = 0; j < 8; ++j) { const int col = j * 256 + c.lane * 4;
            const f32x4 g = *(const f32x4*)(gain + col), s1 = *(const f32x4*)(sc + col), s0 = *(const f32x4*)(sh + col);
            const f32x4 y = (v[j] * rs * g) * (s1 + 1.f) + s0;
            u32x2 o; o.x = cvt_pk_bf16(y[0], y[1]); o.y = cvt_pk_bf16(y[2], y[3]);
            *(u32x2*)(HX + (size_t)r * DM + col) = o;
            if (h8) { int w8 = __builtin_amdgcn_cvt_pk_fp8_f32(y[0], y[1], 0, false); w8 = __builtin_amdgcn_cvt_pk_fp8_f32(y[2], y[3], w8, true); *(unsigned*)(h8 + (size_t)r * DM + col) = (unsigned)w8; } }
    }
}
__device__ __forceinline__ void seg_of_row(int r, bool& is_ctx, int& b, int& t) {
    is_ctx = r >= MLAT; b = is_ctx ? (r - MLAT) >> 8 : r >> 13; t = is_ctx ? (r - MLAT) & 255 : r & (SEQ - 1);
}
__device__ __forceinline__ void qk_row(const Ctx& c, int l, int r, bool do_q, bool dry) {
    bool is_ctx; int b, t; seg_of_row(r, is_ctx, b, t);
    const int key = is_ctx ? t : CTXL + t;
    bf16_t* prow = (bf16_t*)(c.ws + WS_P) + (size_t)r * NIN;
    bf16_t* KC = (bf16_t*)(c.ws + WS_KC); bf16_t* VC = (bf16_t*)(c.ws + WS_VC);
    const int hs = c.lane >> 4, ax = (c.lane >> 3) & 1, p0 = (c.lane & 7) * 4;
    f32x4 cs = {1.f, 1.f, 1.f, 1.f}, sn = {0.f, 0.f, 0.f, 0.f};
    if (!is_ctx) { const int pos = ax ? (t & 63) : (t >> 6); const float* rt = (const float*)(c.ws + WS_ROPE) + pos * 32 + p0; cs = *(const f32x4*)rt; sn = *(const f32x4*)(rt + 128 * 32); }
    u32x2 w1[5], w2[5];
#pragma unroll
    for (int g = 0; g < 5; ++g) { const bool is_k = (g == 4); const int head = is_k ? hs : g * 4 + hs;
        const bf16_t* src = prow + (is_k ? CK : CQ) + head * 128 + ax * 64 + p0;
        if (is_k || do_q) { w1[g] = *(const u32x2*)src; w2[g] = *(const u32x2*)(src + 32); } else { w1[g] = (u32x2){0u, 0u}; w2[g] = (u32x2){0u, 0u}; } }
    const u32x4 vw = *(const u32x4*)(prow + CV + (c.lane >> 4) * 128 + (c.lane & 15) * 8);
#pragma unroll
    for (int g = 0; g < 5; ++g) {
        const bool is_k = (g == 4);
        if (!is_k && !do_q) continue;
        const int head = is_k ? hs : g * 4 + hs;
        bf16_t* src = prow + (is_k ? CK : CQ) + head * 128 + ax * 64 + p0;
        f32x4 t1 = {bf_lo(w1[g].x), bf_hi(w1[g].x), bf_lo(w1[g].y), bf_hi(w1[g].y)}, t2 = {bf_lo(w2[g].x), bf_hi(w2[g].x), bf_lo(w2[g].y), bf_hi(w2[g].y)};
        float ss = (t1[0] * t1[0] + t1[1] * t1[1]) + (t1[2] * t1[2] + t1[3] * t1[3]) + (t2[0] * t2[0] + t2[1] * t2[1]) + (t2[2] * t2[2] + t2[3] * t2[3]);
        ss += DPPF(ss, 0xB1); ss += DPPF(ss, 0x4E); ss += DPPF(ss, 0x141); ss += DPPF(ss, 0x140);
        const float rs = rsqrtf(ss * (1.f / 128.f) + EPS);
        const float* gn = (const float*)(c.ws + WS_SP) + (is_k ? SP_KN : SP_QN) + ax * 64 + p0;
        const f32x4 g1 = *(const f32x4*)gn, g2 = *(const f32x4*)(gn + 32);
        const f32x4 y1 = t1 * rs * g1, y2 = t2 * rs * g2;
        const f32x4 o1 = y1 * cs - y2 * sn, o2 = y2 * cs + y1 * sn;
        bf16_t* dst = is_k ? KC + ((size_t)(b * 4 + head) * NKEY + key) * 128 + ax * 64 + p0 : (dry ? (bf16_t*)(c.ws + WS_YF) + (size_t)r * DM + head * 128 + ax * 64 + p0 : src);
        u32x2 a; a.x = cvt_pk_bf16(o1[0], o1[1]); a.y = cvt_pk_bf16(o1[2], o1[3]);
        u32x2 bq; bq.x = cvt_pk_bf16(o2[0], o2[1]); bq.y = cvt_pk_bf16(o2[2], o2[3]);
        *(u32x2*)dst = a; *(u32x2*)(dst + 32) = bq;
    }
    { const int hv = c.lane >> 4, dd = (c.lane & 15) * 8;
      *(u32x4*)(VC + ((size_t)(b * 4 + hv) * NKEY + key) * 128 + dd) = vw; }
}
__device__ __forceinline__ void unpack8(const u32x4 w, float (&f)[8]) {
    f[0] = bf_lo(w.x); f[1] = bf_hi(w.x); f[2] = bf_lo(w.y); f[3] = bf_hi(w.y); f[4] = bf_lo(w.z); f[5] = bf_hi(w.z); f[6] = bf_lo(w.w); f[7] = bf_hi(w.w);
}
__device__ __forceinline__ void sc_row(const Ctx& c, int l, int r, bool dry) {
    bool is_ctx; int b, t; seg_of_row(r, is_ctx, b, t);
    const int seglen = is_ctx ? CTXL : SEQ;
    bf16_t* prow = (bf16_t*)(c.ws + WS_P) + (size_t)r * NIN;
    const bool hp = t > 0, hn = t < seglen - 1;
    const float* w = (const float*)(c.ws + WS_SP) + SP_SCW; const float* bias = (const float*)(c.ws + WS_SP) + SP_SCB;
    u32x4 xb[4], xc0[4], xu0[4], xcp[4], xup[4], xcn[4], xun[4];
    const u32x4 z = {0u, 0u, 0u, 0u};
#pragma unroll
    for (int it = 0; it < 4; ++it) { const int col = it * 512 + c.lane * 8;
        xb[it] = *(const u32x4*)(prow + CBG + col); xc0[it] = *(const u32x4*)(prow + CCG + col); xu0[it] = *(const u32x4*)(prow + CU + col);
        xcp[it] = hp ? *(const u32x4*)(prow - NIN + CCG + col) : z; xup[it] = hp ? *(const u32x4*)(prow - NIN + CU + col) : z;
        xcn[it] = hn ? *(const u32x4*)(prow + NIN + CCG + col) : z; xun[it] = hn ? *(const u32x4*)(prow + NIN + CU + col) : z; }
#pragma unroll
    for (int it = 0; it < 4; ++it) {
        const int col = it * 512 + c.lane * 8;
        float bg[8], c0[8], u0[8], cp[8], up[8], cn[8], un[8];
        unpack8(xb[it], bg); unpack8(xc0[it], c0); unpack8(xu0[it], u0); unpack8(xcp[it], cp); unpack8(xup[it], up); unpack8(xcn[it], cn); unpack8(xun[it], un);
        float o[8];
#pragma unroll
        for (int hq = 0; hq < 2; ++hq) { const f32x4 w0 = *(const f32x4*)(w + col + hq * 4), w1 = *(const f32x4*)(w + DM + col + hq * 4), w2 = *(const f32x4*)(w + 2 * DM + col + hq * 4), bi = *(const f32x4*)(bias + col + hq * 4);
#pragma unroll
            for (int e = 0; e < 4; ++e) { const int k = hq * 4 + e; o[k] = bg[k] * (bi[e] + w0[e] * (cp[k] * up[k]) + w1[e] * (c0[k] * u0[k]) + w2[e] * (cn[k] * un[k])); } }
        u32x4 ow; ow.x = cvt_pk_bf16(o[0], o[1]); ow.y = cvt_pk_bf16(o[2], o[3]); ow.z = cvt_pk_bf16(o[4], o[5]); ow.w = cvt_pk_bf16(o[6], o[7]);
        *(u32x4*)((dry ? (bf16_t*)(c.ws + WS_YF) + (size_t)(MALL + r) * DM : prow + CBG) + col) = ow;
    }
}

constexpr size_t lsum_idx(int which, int dir, int b, int j) { return ((((size_t)which * 2 + dir) * NB + b) * NCHUNK + j) * DM; }
template <int DIR, int PASS>
__device__ __forceinline__ void lru_chunk(const LAS bf16_t* ub, const LAS float* uf, LAS float* hsd, const bf16x8 (&bfr)[4][4], const float (&ba)[2], const float (&bx)[2], const float (&sp8)[2],
                                          const float (&cin)[2], float (&Atot)[2], float (&Hend)[2], int q, int col16, int quad) {
    float st[2] = {cin[0], cin[1]}, at[2] = {1.f, 1.f};
    const int mysg = DIR ? 3 - quad : quad;
    for (int smt = 0; smt < 4; ++smt) {
        const int mt = DIR ? 3 - smt : smt;
        f32x4 acc[4];
#pragma unroll
        for (int nt = 0; nt < 4; ++nt) acc[nt] = (f32x4){0.f, 0.f, 0.f, 0.f};
#pragma unroll
        for (int ks = 0; ks < 4; ++ks) { const bf16x8 a = *(const LAS bf16x8*)(ub + (mt * 16 + col16) * 136 + ks * 32 + quad * 8);
#pragma unroll
            for (int nt = 0; nt < 4; ++nt) acc[nt] = __builtin_amdgcn_mfma_f32_16x16x32_bf16(a, bfr[nt][ks], acc[nt], 0, 0, 0); }
#pragma unroll
        for (int ct = 0; ct < 2; ++ct) {
            const int ch = q * 32 + ct * 16 + col16;
            float av[4], dv[4];
#pragma unroll
            for (int reg = 0; reg < 4; ++reg) { const int tl = mt * 16 + quad * 4 + reg;
                const float r = sigmoidf_(acc[ct][reg] + ba[ct]), ig = sigmoidf_(acc[2 + ct][reg] + bx[ct]);
                const float a = __expf(-sp8[ct] * r);
                av[reg] = a; dv[reg] = __builtin_amdgcn_sqrtf(fmaxf(1.f - a * a, 0.f)) * ig * uf[tl * 128 + ch]; }
            float Al = 1.f, Hl = 0.f;
#pragma unroll
            for (int sr = 0; sr < 4; ++sr) { const int reg = DIR ? 3 - sr : sr; Hl = av[reg] * Hl + dv[reg]; Al *= av[reg]; }
            float se = st[ct], so = st[ct], ap = 1.f;
#pragma unroll
            for (int sg = 0; sg < 4; ++sg) { const int qp = DIR ? 3 - sg : sg; const float Ag = __shfl(Al, col16 + 16 * qp), Hg = __shfl(Hl, col16 + 16 * qp);
                const float nx = Ag * so + Hg; so = nx; if (sg < mysg) se = nx; ap *= Ag; }
            if (PASS == 2) { float h = se;
#pragma unroll
                for (int sr = 0; sr < 4; ++sr) { const int reg = DIR ? 3 - sr : sr; h = av[reg] * h + dv[reg]; hsd[(mt * 16 + quad * 4 + reg) * 128 + ch] = h; } }
            else at[ct] *= ap;
            st[ct] = so;
        }
    }
    Atot[0] = at[0]; Atot[1] = at[1]; Hend[0] = st[0]; Hend[1] = st[1];
}

template <int PASS>
__device__ __forceinline__ void lru_run(const Ctx& c, int l, int unit, bool dry = false) {
    const int b = unit >> 7, n = (unit >> 3) & 15, run = unit & 7;
    const int c0 = run * 16 + (run < 4 ? run : 4), len = 16 + (run < 4 ? 1 : 0);
    LAS float* xl = (LAS float*)c.lds;
    LAS float* uf = (LAS float*)(c.lds + 34816);
    LAS bf16_t* ub = (LAS bf16_t*)(c.lds + 34816 + 32768);
    LAS float* car = (LAS float*)(c.lds + 34816 + 32768 + 17408);
    LAS float* hsr = (LAS float*)(c.lds + 34816 + 32768 + 17408 + 17408);
    const int d = c.wave >> 2, q = c.wave & 3, col16 = c.lane & 15, quad = c.lane >> 4;
    float* LS = (float*)(c.ws + WS_LSUM);
    bf16_t* P = (bf16_t*)(c.ws + WS_P);
    bf16x8 bfr[4][4];
#pragma unroll
    for (int nt = 0; nt < 4; ++nt) { const int j = d * 256 + (nt >> 1) * 128 + q * 32 + (nt & 1) * 16 + col16;
#pragma unroll
        for (int ks = 0; ks < 4; ++ks) bfr[nt][ks] = *(const bf16x8*)((const bf16_t*)(c.ws + WS_WLRU) + ((size_t)(n * 512 + j) * 128 + ks * 32 + quad * 8)); }
    float ba[2], bx[2], sp8[2];
#pragma unroll
    for (int ct = 0; ct < 2; ++ct) { const int cidx = n * 128 + q * 32 + ct * 16 + col16; const float* sp = (const float*)(c.ws + WS_SP) + d * DM + cidx;
        ba[ct] = sp[SP_LBA]; bx[ct] = sp[SP_LBX]; sp8[ct] = sp[SP_LSP]; }
    if (PASS == 2) {
        if (c.tid < 256) { const int dir = c.tid >> 7, ch = c.tid & 127, cidx = n * 128 + ch; float st = 0.f;
#pragma unroll 1
            for (int k0 = 0; k0 < NCHUNK; k0 += 12) {
                float av[12], hv[12];
#pragma unroll
                for (int kk = 0; kk < 12; ++kk) { const int k = k0 + kk, j = dir ? (k < 4 ? 3 - k : 135 - k) : k; av[kk] = LS[lsum_idx(0, dir, b, j) + cidx]; hv[kk] = LS[lsum_idx(1, dir, b, j) + cidx]; }
#pragma unroll
                for (int kk = 0; kk < 12; ++kk) { const int k = k0 + kk, j = dir ? (k < 4 ? 3 - k : 135 - k) : k;
                    if (j >= c0 && j < c0 + len) car[(dir * 17 + (j - c0)) * 128 + ch] = st;
                    st = av[kk] * st + hv[kk]; } } }
        __syncthreads();
    }
    const float* cw = (const float*)(c.ws + WS_SP) + SP_LCW + n * 128; const float* cb = (const float*)(c.ws + WS_SP) + SP_LCB + n * 128;
#define LRU_GEOM(ci_, jc, is_ctx, rb, t0, seglen) const int jc = c0 + (ci_); const bool is_ctx = jc < 4; \
        const int rb = is_ctx ? MLAT + b * CTXL : b * SEQ, t0 = is_ctx ? jc * 64 : (jc - 4) * 64, seglen = is_ctx ? CTXL : SEQ
#define LRU_LOAD(ci_, XR, LG) do { LRU_GEOM(ci_, jc_, ic_, rb_, t0_, sl_); (void)ic_; \
        _Pragma("unroll") for (int ps = 0; ps < 3; ++ps) { const int i = ps * 32 + (c.tid >> 4); const int t = t0_ - 2 + i; XR[ps] = (u32x4){0u, 0u, 0u, 0u}; \
            if (i < 68 && t >= 0 && t < sl_) XR[ps] = *(const u32x4*)(P + (size_t)(rb_ + t) * NIN + CLX + n * 128 + (c.tid & 15) * 8); } \
        if (PASS == 2) { const bf16_t* gp_ = P + (size_t)(rb_ + t0_ + (c.tid >> 3)) * NIN + CLG + n * 128 + (c.tid & 7) * 16; LG[0] = *(const u32x4*)gp_; LG[1] = *(const u32x4*)(gp_ + 8); } } while (0)
    u32x4 xr[3], lgc[2] = {{0u, 0u, 0u, 0u}, {0u, 0u, 0u, 0u}}, lgn[2] = {{0u, 0u, 0u, 0u}, {0u, 0u, 0u, 0u}};
    LRU_LOAD(0, xr, lgn);
    for (int ci = 0; ci < len; ++ci) {
        LRU_GEOM(ci, jc, is_ctx, rb, t0, seglen); (void)is_ctx; (void)seglen;
#pragma unroll
        for (int ps = 0; ps < 3; ++ps) { const int i = ps * 32 + (c.tid >> 4);
            if (i < 68) { float f[8]; unpack8(xr[ps], f);
                *(LAS f32x4*)(xl + i * 128 + (c.tid & 15) * 8) = (f32x4){f[0], f[1], f[2], f[3]}; *(LAS f32x4*)(xl + i * 128 + (c.tid & 15) * 8 + 4) = (f32x4){f[4], f[5], f[6], f[7]}; } }
        lgc[0] = lgn[0]; lgc[1] = lgn[1];
        __syncthreads();
        if (ci + 1 < len) LRU_LOAD(ci + 1, xr, lgn);
        { const int ch = c.tid & 127, tq = c.tid >> 7; const float w0 = cw[ch], w1 = cw[DM + ch], w2 = cw[2 * DM + ch], w3 = cw[3 * DM + ch], bb = cb[ch];
#pragma unroll 4
          for (int tt = 0; tt < 16; ++tt) { const int tl = tq * 16 + tt;
              const float u = bb + w0 * xl[tl * 128 + ch] + w1 * xl[(tl + 1) * 128 + ch] + w2 * xl[(tl + 2) * 128 + ch] + w3 * xl[(tl + 3) * 128 + ch];
              uf[tl * 128 + ch] = u; ub[tl * 136 + ch] = f2bf(u); } }
        __syncthreads();
        float cin[2] = {0.f, 0.f}, At[2], He[2];
        if (PASS == 2) { cin[0] = car[(d * 17 + ci) * 128 + q * 32 + col16]; cin[1] = car[(d * 17 + ci) * 128 + q * 32 + 16 + col16]; }
        if (d == 0) lru_chunk<0, PASS>(ub, uf, xl, bfr, ba, bx, sp8, cin, At, He, q, col16, quad);
        else lru_chunk<1, PASS>(ub, uf, hsr, bfr, ba, bx, sp8, cin, At, He, q, col16, quad);
        if (PASS == 1) {
            if (quad == 0) {
#pragma unroll
                for (int ct = 0; ct < 2; ++ct) { const int cidx = n * 128 + q * 32 + ct * 16 + col16;
                    LS[lsum_idx(0, d, b, jc) + cidx] = At[ct]; LS[lsum_idx(1, d, b, jc) + cidx] = He[ct]; } }
            __syncthreads();
        } else {
            __syncthreads();
            { const int row = c.tid >> 3, cs = (c.tid & 7) * 16;
              bf16_t* gp = P + (size_t)(rb + t0 + row) * NIN + CLG + n * 128 + cs;
#pragma unroll
              for (int hseg = 0; hseg < 2; ++hseg) { float g[8]; unpack8(lgc[hseg], g);
                  const int o = row * 128 + cs + hseg * 8;
                  const f32x4 h0 = *(const LAS f32x4*)(xl + o) + *(const LAS f32x4*)(hsr + o), h1 = *(const LAS f32x4*)(xl + o + 4) + *(const LAS f32x4*)(hsr + o + 4);
                  u32x4 ow; ow.x = cvt_pk_bf16(h0[0] * gelu_tanh(g[0]), h0[1] * gelu_tanh(g[1])); ow.y = cvt_pk_bf16(h0[2] * gelu_tanh(g[2]), h0[3] * gelu_tanh(g[3]));
                  ow.z = cvt_pk_bf16(h1[0] * gelu_tanh(g[4]), h1[1] * gelu_tanh(g[5])); ow.w = cvt_pk_bf16(h1[2] * gelu_tanh(g[6]), h1[3] * gelu_tanh(g[7]));
                  *(u32x4*)((dry ? gp - CLG + CU : gp) + hseg * 8) = ow; } }
            __syncthreads();
        }
    }
#undef LRU_GEOM
#undef LRU_LOAD
}

__device__ __forceinline__ void phase_qk(const Ctx& c, int l, bool dry = false) {
    const int gw = c.wg * NWAVES + c.wave, NGW = c.G * NWAVES;
    for (int r = gw; r < MALL; r += NGW) qk_row(c, l, r, l == 0 || r < MLAT, dry);
}
__device__ __forceinline__ void phase_sc(const Ctx& c, int l, bool dry = false) {
    const int gw = c.wg * NWAVES + c.wave, NGW = c.G * NWAVES;
    const int nsc = (l == 0) ? MALL : MLAT;
    for (int r = gw; r < nsc; r += NGW) sc_row(c, l, r, dry);
}
__device__ __forceinline__ void phase_lru1(const Ctx& c, int l) {
    for (int u = c.wg; u < 256; u += c.G) lru_run<1>(c, l, u);
}

__device__ __forceinline__ void phase_m2(const Ctx& c, int l, bool dry = false) {
    bf16_t* P = (bf16_t*)(c.ws + WS_P); const bf16_t* KC = (const bf16_t*)(c.ws + WS_KC); const bf16_t* VC = (const bf16_t*)(c.ws + WS_VC);
    const int ntot = 1024 + (l == 0 ? 32 : 0);
    for (int i = 0; i * c.G + c.wg < ntot; ++i) {
        const int L = i * c.G + c.wg; int b, h, seq; size_t qrow;
        if (L < 1024) { int grp, qb;
            if (c.G == 256) { grp = i * 8 + (c.wg & 7); qb = c.wg >> 3; } else { grp = L >> 5; qb = L & 31; }
            b = grp >> 4; h = grp & 15; qrow = (size_t)(b * SEQ + qb * 256); seq = NKEY; }
        else { const int u = L - 1024; b = u >> 4; h = u & 15; qrow = (size_t)(MLAT + b * CTXL); seq = CTXL; }
        bf16_t* q = P + qrow * NIN + CQ + h * 128;
        const size_t kvo = (size_t)(b * 4 + (h >> 2)) * NKEY * 128;
        att::attn_dense_body(q, KC + kvo, VC + kvo, dry ? q - CQ + CCG : q, seq, (char*)c.lds);
    }
}
__device__ __forceinline__ void phase_lru2(const Ctx& c, int l, bool dry = false) {
    for (int u = c.wg; u < 256; u += c.G) lru_run<2>(c, l, u, dry);
}
constexpr float NEGBIG = -3.0e38f;
constexpr float PU_SCALE = 32.f;
__device__ __forceinline__ float wave_max_dpp(float v) {
    v = fmaxf(v, DPPF(v, 0xB1)); v = fmaxf(v, DPPF(v, 0x4E)); v = fmaxf(v, DPPF(v, 0x141)); v = fmaxf(v, DPPF(v, 0x140));
    const float a = __int_as_float(__builtin_amdgcn_readlane(__float_as_int(v), 0)), b = __int_as_float(__builtin_amdgcn_readlane(__float_as_int(v), 16));
    const float c = __int_as_float(__builtin_amdgcn_readlane(__float_as_int(v), 32)), d = __int_as_float(__builtin_amdgcn_readlane(__float_as_int(v), 48));
    return fmaxf(fmaxf(a, b), fmaxf(c, d));
}
#define SWZ_XOR(v, m) __int_as_float(__builtin_amdgcn_ds_swizzle(__float_as_int(v), ((m) << 10) | 0x1F))
__device__ __forceinline__ unsigned fkey(float x) { const unsigned u = __float_as_uint(x); return (u & 0x80000000u) ? ~u : (u | 0x80000000u); }
#define DPPU(v, ctrl) ((unsigned)__builtin_amdgcn_update_dpp(0, (int)(v), ctrl, 0xF, 0xF, true))
__device__ __forceinline__ unsigned wave_max_u32(unsigned v) {
    v = max(v, DPPU(v, 0xB1)); v = max(v, DPPU(v, 0x4E)); v = max(v, DPPU(v, 0x141)); v = max(v, DPPU(v, 0x140));
    const unsigned a = (unsigned)__builtin_amdgcn_readlane((int)v, 0), b = (unsigned)__builtin_amdgcn_readlane((int)v, 16), c = (unsigned)__builtin_amdgcn_readlane((int)v, 32), d = (unsigned)__builtin_amdgcn_readlane((int)v, 48);
    return max(max(a, b), max(c, d));
}
__device__ __forceinline__ unsigned topk16_keys2(unsigned k0, unsigned k1, int lane) {
    unsigned res = 0u;
    for (int it = 0; it < 16; ++it) { const unsigned m = wave_max_u32(max(k0, k1)); k0 = (k0 == m) ? 0u : k0; k1 = (k1 == m) ? 0u : k1; res = (lane == it) ? m : res; }
    return res;
}
__device__ __forceinline__ unsigned topk16_keys1(unsigned k0, int lane) {
    unsigned res = 0u;
    for (int it = 0; it < 16; ++it) { const unsigned m = wave_max_u32(k0); k0 = (k0 == m) ? 0u : k0; res = (lane == it) ? m : res; }
    return res;
}
__device__ __forceinline__ void unpack_fp8x16(const u32x4 w, float (&f)[16]) {
#pragma unroll
    for (int d = 0; d < 4; ++d) { const f32x2 lo = __builtin_amdgcn_cvt_pk_f32_fp8((int)w[d], false), hi = __builtin_amdgcn_cvt_pk_f32_fp8((int)w[d], true);
        f[4 * d] = lo.x; f[4 * d + 1] = lo.y; f[4 * d + 2] = hi.x; f[4 * d + 3] = hi.y; }
}

__device__ __forceinline__ unsigned half_max_u32(unsigned v, bool hi_half) {
    v = max(v, DPPU(v, 0xB1)); v = max(v, DPPU(v, 0x4E)); v = max(v, DPPU(v, 0x141)); v = max(v, DPPU(v, 0x140));
    const unsigned a = max((unsigned)__builtin_amdgcn_readlane((int)v, 0), (unsigned)__builtin_amdgcn_readlane((int)v, 16));
    const unsigned b = max((unsigned)__builtin_amdgcn_readlane((int)v, 32), (unsigned)__builtin_amdgcn_readlane((int)v, 48));
    return hi_half ? b : a;
}
__device__ __forceinline__ unsigned topk16_half4(unsigned (&k)[4], int hl, bool hi_half) {
    unsigned res = 0u;
    for (int it = 0; it < 16; ++it) { const unsigned m = half_max_u32(max(max(k[0], k[1]), max(k[2], k[3])), hi_half);
#pragma unroll
        for (int j = 0; j < 4; ++j) k[j] = (k[j] == m) ? 0u : k[j];
        res = (hl == it) ? m : res; }
    return res;
}
__device__ __forceinline__ unsigned topk16_half2(unsigned k0, unsigned k1, int hl, bool hi_half) {
    unsigned res = 0u;
    for (int it = 0; it < 16; ++it) { const unsigned m = half_max_u32(max(k0, k1), hi_half); k0 = (k0 == m) ? 0u : k0; k1 = (k1 == m) ? 0u : k1; res = (hl == it) ? m : res; }
    return res;
}
__device__ __forceinline__ void cand_ab(int cidx50, int& a, int& b) {
    a = cidx50 < 16 ? 0 : cidx50 < 24 ? 1 : cidx50 < 29 ? 2 : cidx50 < 33 ? 3 : cidx50 < 36 ? 4 : cidx50 < 38 ? 5 : cidx50 < 40 ? 6 : cidx50 < 42 ? 7 : cidx50 - 34;
    const int st = cidx50 < 16 ? 0 : cidx50 < 24 ? 16 : cidx50 < 29 ? 24 : cidx50 < 33 ? 29 : cidx50 < 36 ? 33 : cidx50 < 38 ? 36 : cidx50 < 40 ? 38 : cidx50 < 42 ? 40 : cidx50;
    b = cidx50 - st;
}
__device__ __forceinline__ void peer_topk_pair(const LAS float* srow, int hp, LAS float* gsc, LAS int* isc, int lane) {
    const int hl = lane & 31, hb = lane & 32; const bool hi_half = lane >= 32; const int h = 2 * hp + (hi_half ? 1 : 0);
    const LAS float* sh = srow + h * 256;
    unsigned k1[4], k2[4];
#pragma unroll
    for (int j = 0; j < 4; ++j) { const int idx = hl + 32 * j; k1[j] = (fkey(sh[idx]) & ~127u) | (unsigned)(127 - idx); k2[j] = (fkey(sh[128 + idx]) & ~127u) | (unsigned)(127 - idx); }
    const unsigned r1 = topk16_half4(k1, hl, hi_half), r2 = topk16_half4(k2, hl, hi_half);
    const int i1 = 127 - (int)(r1 & 127u), i2 = 127 - (int)(r2 & 127u);
    const float v1 = sh[i1], v2 = sh[128 + i2];
    int a0, b0, a1, b1; cand_ab(hl, a0, b0); cand_ab(hl + 32, a1, b1);
    const float c0 = __shfl(v1, hb + a0) + __shfl(v2, hb + b0), c1 = __shfl(v1, hb + (a1 & 15)) + __shfl(v2, hb + (b1 & 15));
    const unsigned q0 = (fkey(c0) & ~255u) | (unsigned)(255 - (a0 * 16 + b0)), q1 = (hl + 32 < 50) ? ((fkey(c1) & ~255u) | (unsigned)(255 - (a1 * 16 + b1))) : 0u;
    const unsigned r3 = topk16_half2(q0, q1, hl, hi_half);
    const int ci = 255 - (int)(r3 & 255u);
    const float sc = __shfl(v1, hb + (ci >> 4)) + __shfl(v2, hb + (ci & 15));
    const int e = __shfl(i1, hb + (ci >> 4)) * 128 + __shfl(i2, hb + (ci & 15));
    const float mxa = __int_as_float(__builtin_amdgcn_readlane(__float_as_int(sc), 0)), mxb = __int_as_float(__builtin_amdgcn_readlane(__float_as_int(sc), 32));
    const float ex = hl < 16 ? __expf(sc - (hi_half ? mxb : mxa)) : 0.f;
    float sm = ex; sm += DPPF(sm, 0xB1); sm += DPPF(sm, 0x4E); sm += DPPF(sm, 0x141); sm += DPPF(sm, 0x140);
    if (hl < 16) { gsc[h * 16 + hl] = ex / sm; isc[h * 16 + hl] = e; }
}

constexpr size_t WS_PE_E = WS_P + 160 * MiB, WS_PE_G = WS_PE_E + (size_t)MALL * 128 * 4, WS_PE_CF = WS_PE_G + (size_t)MALL * 128 * 4, WS_PE_H8 = WS_PE_CF + (size_t)MALL * 128 * 4;
constexpr int NSL = 16, SLW = 128;
constexpr size_t SLICE_BYTES = (size_t)16384 * SLW;
__device__ __forceinline__ void phase_peer_topk(const Ctx& c, int nrows) {
    const int gw = c.wg * NWAVES + c.wave, NGW = c.G * NWAVES, lane = c.lane;
    LAS float* gsc = (LAS float*)(c.lds + c.wave * 1024); LAS int* isc = (LAS int*)(c.lds + c.wave * 1024 + 512); LAS float* snb = (LAS float*)(c.lds + 16384 + c.wave * 8192);
    for (int r = gw; r < nrows; r += NGW) {
        const float* S = (const float*)(c.ws + WS_P) + (size_t)r * DM;
#pragma unroll
        for (int q = 0; q < 8; ++q) *(LAS f32x4*)(snb + q * 256 + lane * 4) = *(const f32x4*)(S + q * 256 + lane * 4);
        LDS_WAIT(); asm volatile("" ::: "memory");
#pragma unroll 1
        for (int hp = 0; hp < 4; ++hp) peer_topk_pair(snb, hp, gsc, isc, lane);
        LDS_WAIT(); asm volatile("" ::: "memory");
        int* E = (int*)(c.ws + WS_PE_E) + (size_t)r * 128; float* Gt = (float*)(c.ws + WS_PE_G) + (size_t)r * 128;
        E[lane] = isc[lane]; E[64 + lane] = isc[64 + lane]; Gt[lane] = gsc[lane]; Gt[64 + lane] = gsc[64 + lane];
        LDS_WAIT(); asm volatile("" ::: "memory");
    }
}
#define PEER_SLICE_BEGIN() { const int grp = c.wg & 7, wi = (c.wg >> 3) * NWAVES + c.wave, nwi = ((c.G - grp + 7) >> 3) * NWAVES; \
    _Pragma("unroll 1") for (int ps = 0; ps < 2; ++ps) { const int s = grp + 8 * ps; _Pragma("unroll 1") for (int r = wi; r < nrows; r += nwi) {
#define PEER_SLICE_END() } } }
__device__ __forceinline__ long lo64(const u32x4 v) { return (long)(((unsigned long long)v[1] << 32) | v[0]); }
__device__ __forceinline__ long hi64(const u32x4 v) { return (long)(((unsigned long long)v[3] << 32) | v[2]); }
__device__ __forceinline__ void phase_peer_u(const Ctx& c, int nrows) {
    const int lane = c.lane, r16 = lane & 15, g = lane >> 4;
    const unsigned char* PU = (const unsigned char*)(c.ws + WS_PU); const unsigned char* H8 = (const unsigned char*)(c.ws + WS_PE_H8);
    const int* Eb = (const int*)(c.ws + WS_PE_E); float* PD = (float*)(c.ws + WS_YF);
    PEER_SLICE_BEGIN()
        const int e0 = Eb[(size_t)r * 128 + lane], e1 = Eb[(size_t)r * 128 + 64 + lane];
        const unsigned char* hq = H8 + (size_t)r * DM + s * SLW + g * 16;
        const u32x4 hb0 = *(const u32x4*)hq, hb1 = *(const u32x4*)(hq + 64);
        u32x4 w[8][2];
#pragma unroll
        for (int i = 0; i < 8; ++i) { const int e = __shfl(i < 4 ? e0 : e1, (16 * i + r16) & 63);
            const unsigned char* base = PU + (size_t)s * SLICE_BYTES + (size_t)e * SLW + g * 16; w[i][0] = *(const u32x4*)base; w[i][1] = *(const u32x4*)(base + 64); }
        float* pd = PD + ((size_t)s * MALL + r) * 128;
#pragma unroll
        for (int i = 0; i < 8; ++i) {
            f32x4 acc = {0.f, 0.f, 0.f, 0.f};
            acc = __builtin_amdgcn_mfma_f32_16x16x32_fp8_fp8(lo64(w[i][0]), lo64(hb0), acc, 0, 0, 0);
            acc = __builtin_amdgcn_mfma_f32_16x16x32_fp8_fp8(hi64(w[i][0]), hi64(hb0), acc, 0, 0, 0);
            acc = __builtin_amdgcn_mfma_f32_16x16x32_fp8_fp8(lo64(w[i][1]), lo64(hb1), acc, 0, 0, 0);
            acc = __builtin_amdgcn_mfma_f32_16x16x32_fp8_fp8(hi64(w[i][1]), hi64(hb1), acc, 0, 0, 0);
            if (r16 == 0) *(f32x4*)(pd + 16 * i + 4 * g) = acc; }
    PEER_SLICE_END()
}
__device__ __forceinline__ void phase_peer_cf(const Ctx& c, int nrows) {
    const int gw = c.wg * NWAVES + c.wave, NGW = c.G * NWAVES, lane = c.lane;
    const float* PD = (const float*)(c.ws + WS_YF); const float* Gt = (const float*)(c.ws + WS_PE_G); float* CF = (float*)(c.ws + WS_PE_CF);
    for (int r = gw; r < nrows; r += NGW) {
        float a0 = 0.f, a1 = 0.f;
#pragma unroll
        for (int s = 0; s < NSL; ++s) { const float* pd = PD + ((size_t)s * MALL + r) * 128; a0 += pd[lane]; a1 += pd[64 + lane]; }
        CF[(size_t)r * 128 + lane] = Gt[(size_t)r * 128 + lane] * gelu_tanh(a0 * (1.f / PU_SCALE));
        CF[(size_t)r * 128 + 64 + lane] = Gt[(size_t)r * 128 + 64 + lane] * gelu_tanh(a1 * (1.f / PU_SCALE));
    }
}
__device__ __forceinline__ void phase_peer_v(const Ctx& c, int l, int nrows, bool dry) {
    const int lane = c.lane, rg = lane >> 3, ch = lane & 7;
    const unsigned char* PV = (const unsigned char*)(c.ws + WS_PV);
    const int* Eb = (const int*)(c.ws + WS_PE_E); const float* CF = (const float*)(c.ws + WS_PE_CF);
    PEER_SLICE_BEGIN()
        const int e0 = Eb[(size_t)r * 128 + lane], e1 = Eb[(size_t)r * 128 + 64 + lane];
        const float c0 = CF[(size_t)r * 128 + lane], c1 = CF[(size_t)r * 128 + 64 + lane];
        u32x4 w[16]; float cf[16];
#pragma unroll
        for (int i = 0; i < 16; ++i) { const int k = 8 * i + rg; const int e = __shfl(k < 64 ? e0 : e1, k & 63); cf[i] = __shfl(k < 64 ? c0 : c1, k & 63);
            w[i] = *(const u32x4*)(PV + (size_t)s * SLICE_BYTES + (size_t)e * SLW + ch * 16); }
        float o[16];
#pragma unroll
        for (int j = 0; j < 16; ++j) o[j] = 0.f;
#pragma unroll
        for (int i = 0; i < 16; ++i) {
            asm volatile("" : "+v"(w[i]), "+v"(cf[i]));
            float f[16]; unpack_fp8x16(w[i], f);
#pragma unroll
            for (int j = 0; j < 16; ++j) o[j] += cf[i] * f[j];
            asm volatile("" : "+v"(o[0])); }
        const bool b3 = lane & 8, b4 = lane & 16, b5 = lane & 32;
        float q8[8], q4[4], q2[2];
#pragma unroll
        for (int j = 0; j < 8; ++j) q8[j] = (b3 ? o[8 + j] : o[j]) + DPPF(b3 ? o[j] : o[8 + j], 0x128);
#pragma unroll
        for (int j = 0; j < 4; ++j) q4[j] = (b4 ? q8[4 + j] : q8[j]) + SWZ_XOR(b4 ? q8[j] : q8[4 + j], 16);
#pragma unroll
        for (int j = 0; j < 2; ++j) q2[j] = (b5 ? q4[2 + j] : q4[j]) + __shfl_xor(b5 ? q4[j] : q4[2 + j], 32);
        const int col = s * SLW + ch * 16 + (b3 ? 8 : 0) + (b4 ? 4 : 0) + (b5 ? 2 : 0);
        const int vec = r < SEQ ? 0 : (r < MLAT ? 1 : 2);
        float* xr = (dry ? (float*)(c.ws + WS_YF) + (size_t)r * DM : xrow_ptr(c, r)) + col; const float* g5 = (const float*)(c.ws + WS_MOD) + ((size_t)l * 3 + vec) * NMOD + 5 * DM + col;
        const f32x2 gg = *(const f32x2*)g5; f32x2 xx = *(const f32x2*)xr;
        xx[0] += gg[0] * q2[0]; xx[1] += gg[1] * q2[1];
        *(f32x2*)xr = xx;
    PEER_SLICE_END()
}
struct Args { const float* in[29]; float* out; unsigned char* ws; int ph_lo, ph_hi; };
constexpr int PH_PER_LAYER = 10, N_PHASES = NLAYER * PH_PER_LAYER;
constexpr int CW_BAR = 4096;

__global__ void __launch_bounds__(NTHREADS, 2) mk_fwd(Args args) {
    extern __shared__ __attribute__((aligned(16))) unsigned char lds_raw[];
    Ctx c0;
    c0.out = args.out; c0.ws = args.ws; c0.lds = (LAS unsigned char*)lds_raw;
    c0.tid = threadIdx.x; c0.lane = c0.tid & 63; c0.wave = __builtin_amdgcn_readfirstlane(c0.tid >> 6); c0.wg = blockIdx.x; c0.G = gridDim.x;
    volatile LAS unsigned* MISC = (volatile LAS unsigned*)(c0.lds + MISC_OFF);
    if (c0.tid < 64) MISC[c0.tid] = 0u;
    __syncthreads();
    const int lo = args.ph_lo, hi = args.ph_hi;
    XcdBarrier bar; bar.bar = (unsigned*)(c0.ws + WS_CTL) + CW_BAR; bar.x = 0; bar.st = MISC + 8;
    if (hi - lo > 1) bar = xcd_barrier_post((unsigned*)(c0.ws + WS_CTL) + CW_BAR, MISC + 8);
#ifndef ONLY_PH
#define ONLY_PH -1
#endif
#define IN(k) ((ONLY_PH < 0 || ((k) % PH_PER_LAYER) == ONLY_PH) && lo <= (k) && (k) < hi)
#define PH_BEGIN() Ctx c = c0; unsigned long long wsi_ = (unsigned long long)c0.ws, outi_ = (unsigned long long)c0.out; asm volatile("" : "+s"(wsi_), "+s"(outi_), "+s"(c.wg), "+s"(c.G), "+s"(c.wave), "+v"(c.tid)); \
    c.lane = c.tid & 63; c.ws = (unsigned char*)(GAS unsigned char*)wsi_; c.out = (float*)(GAS float*)outi_;     \
    bf16_t* P = (bf16_t*)(c.ws + WS_P); bf16_t* HX = (bf16_t*)(c.ws + WS_HX); float* YF = (float*)(c.ws + WS_YF); (void)P; (void)HX; (void)YF
#ifndef PROBE_DUP
#define PROBE_DUP -1
#endif
#define REPS(k) for (int rep = 0, dry = (PROBE_DUP == (k)); rep < (PROBE_DUP == (k) ? 2 : 1); ++rep, dry = 0)
#define SEAM(k) do { if (IN(k) && IN((k) + 1)) { xcd_barrier(bar); if (PROBE_DUP == 20) xcd_barrier(bar); } } while (0)
    for (int l = 0; l < NLAYER; ++l) {
        const int pb = l * PH_PER_LAYER;
        const int mrows = (l == 0) ? MALL : MLAT;
        if (IN(pb + 0)) REPS(0) {
            { PH_BEGIN(); conv_units(c, l); } { PH_BEGIN(); conv_transposes(c, l); } { PH_BEGIN(); conv_tables(c, l); } { PH_BEGIN(); conv_small(c, l); }
            if (l == 0) { PH_BEGIN(); conv_once(c); } }
        SEAM(pb + 0);
        if (IN(pb + 1)) REPS(1) { PH_BEGIN(); phase_norm(c, l, MALL, SP_NMIX, 0); }
        SEAM(pb + 1);
        if (IN(pb + 2)) REPS(2) { PH_BEGIN();
            pg8::Gemm g{HX, (const bf16_t*)(c.ws + WS_WIN), MALL, NIN, DM, DM, DM}; pg8::StaticOrder S; S.init(MALL, NIN, c.G, c.wg);
            pg8::EpiBf16 E{P, NIN};
            pg8::gemm_phase<pg8::EpiBf16, pg8::StaticOrder, true, true>(c.lds, g, S, E);
        }
        SEAM(pb + 2);
        if (IN(pb + 3)) REPS(3) { { PH_BEGIN(); phase_qk(c, l, dry); } { PH_BEGIN(); phase_sc(c, l, dry); } __syncthreads(); { PH_BEGIN(); phase_lru1(c, l); } if (PROBE_DUP == 30) { PH_BEGIN(); phase_lru1(c, l); } }
        SEAM(pb + 3);
        if (IN(pb + 4)) REPS(4) { { PH_BEGIN(); phase_m2(c, l, dry); } __syncthreads(); if (PROBE_DUP == 31) { PH_BEGIN(); phase_lru2(c, l, true); } { PH_BEGIN(); phase_lru2(c, l, dry); } }
        SEAM(pb + 4);
        if (IN(pb + 5)) REPS(5) { PH_BEGIN();
            pg8::MixOrder S; S.init(mrows, c.G, c.wg);
            const bf16_t* WO = (const bf16_t*)(c.ws + WS_WO);
            { pg8::Gemm g{P + CQ, WO, mrows, DM, DM, NIN, DM}; pg8::EpiMerge<0> E{P + CGT, NIN, YF, HX};
              pg8::gemm_phase<pg8::EpiMerge<0>, pg8::MixOrder, true, true, true>(c.lds, g, S, E); }
            { pg8::Gemm g{P + CLG, WO + (size_t)DM * DM, mrows, DM, DM, NIN, DM}; pg8::EpiMerge<1> E{P + CGT + DM, NIN, YF, HX};
              pg8::gemm_phase<pg8::EpiMerge<1>, pg8::MixOrder, true, true, true>(c.lds, g, S, E); }
            { pg8::Gemm g{P + CBG, WO + (size_t)2 * DM * DM, mrows, DM, DM, NIN, DM}; pg8::EpiMerge<2> E{P + CGT + 2 * DM, NIN, YF, HX};
              pg8::gemm_phase<pg8::EpiMerge<2>, pg8::MixOrder, true, true, true>(c.lds, g, S, E); }
        }
        SEAM(pb + 5);
        if (IN(pb + 6)) REPS(6) { PH_BEGIN();
            pg8::Gemm g{HX, (const bf16_t*)(c.ws + WS_WOUT), mrows, DM, DM, DM, DM}; pg8::MixOrder S; S.init(mrows, c.G, c.wg);
            pg8::EpiResid E{dry ? YF : c.out, dry ? YF + (size_t)MLAT * DM : (float*)(c.ws + WS_CTXS), (const float*)(c.ws + WS_MOD) + (size_t)l * 3 * NMOD + 2 * DM};
            pg8::gemm_phase<pg8::EpiResid, pg8::MixOrder, true, true, true>(c.lds, g, S, E);
        }
        SEAM(pb + 6);
        if (IN(pb + 7)) REPS(7) { PH_BEGIN(); phase_norm(c, l, mrows, SP_NFFN, 3, c.ws + WS_PE_H8); }
        SEAM(pb + 7);
        if (IN(pb + 8)) REPS(8) { PH_BEGIN();
            pg8::Gemm g{HX, (const bf16_t*)(c.ws + WS_WSC), mrows, DM, DM, DM, DM}; pg8::MixOrder S; S.init(mrows, c.G, c.wg);
            pg8::EpiF32 E{(float*)(c.ws + WS_P), DM};
            pg8::gemm_phase<pg8::EpiF32, pg8::MixOrder, true, true, true>(c.lds, g, S, E);
        }
        SEAM(pb + 8);
        if (IN(pb + 9)) REPS(9) {
            { PH_BEGIN(); phase_peer_topk(c, mrows); } xcd_barrier(bar);
            { PH_BEGIN(); phase_peer_u(c, mrows); } xcd_barrier(bar);
            { PH_BEGIN(); phase_peer_cf(c, mrows); } xcd_barrier(bar);
            { PH_BEGIN(); phase_peer_v(c, l, mrows, dry); } }
        SEAM(pb + 9);
    }
#undef IN
#undef SEAM
}

extern "C" void kernel_launch(void* const* d_in, const int* in_sizes, int n_in, void* d_out, int out_size, void* d_ws, size_t ws_size, hipStream_t stream) {
    static int grid = 0;
    if (grid == 0) {
        if (n_in != 29 || in_sizes[0] != MLAT * DM || out_size != MLAT * DM || ws_size < WS_END) {
            fprintf(stderr, "kernel_launch: built for 29 inputs, x/out of %d floats, >= %zu bytes of workspace; got n_in %d, in0 %d, out %d, ws %zu; nothing launched\n", MLAT * DM, (size_t)WS_END, n_in, n_in > 0 ? in_sizes[0] : -1, out_size, ws_size);
            grid = -1; return; }
        int dev = 0, cus = 0, per_cu = 0;
        if (hipGetDevice(&dev) != hipSuccess || hipDeviceGetAttribute(&cus, hipDeviceAttributeMultiprocessorCount, dev) != hipSuccess) { fprintf(stderr, "kernel_launch: device query failed\n"); grid = -1; return; }
        if (hipFuncSetAttribute((const void*)mk_fwd, hipFuncAttributeMaxDynamicSharedMemorySize, LDS_BYTES) != hipSuccess) { fprintf(stderr, "kernel_launch: hipFuncSetAttribute failed\n"); grid = -1; return; }
        if (hipOccupancyMaxActiveBlocksPerMultiprocessor(&per_cu, (const void*)mk_fwd, NTHREADS, LDS_BYTES) != hipSuccess || per_cu < 1)
            fprintf(stderr, "kernel_launch: note: occupancy query reports %d workgroups per CU\n", per_cu);
        (void)hipGetLastError();
        grid = cus;
    }
    if (grid < 0) return;
    if (hipMemsetAsync((char*)d_ws + WS_CTL, 0, CTL_ZERO_BYTES, stream) != hipSuccess) { fprintf(stderr, "kernel_launch: memset failed\n"); return; }
    Args a{};
    for (int i = 0; i < 29; ++i) a.in[i] = (const float*)d_in[i];
    a.out = (float*)d_out; a.ws = (unsigned char*)d_ws;
#if MK_N_LAUNCHES == 1
    a.ph_lo = 0; a.ph_hi = N_PHASES;
    hipLaunchKernelGGL(mk_fwd, dim3(grid), dim3(NTHREADS), LDS_BYTES, stream, a);
#else
    for (int k = 0; k < N_PHASES; ++k) { a.ph_lo = k; a.ph_hi = k + 1; hipLaunchKernelGGL(mk_fwd, dim3(grid), dim3(NTHREADS), LDS_BYTES, stream, a); }
#endif
    const hipError_t le = hipPeekAtLastError();
    if (le != hipSuccess) fprintf(stderr, "kernel_launch: launch failed: %s\n", hipGetErrorName(le));
}
```

```cpp
#include <hip/hip_runtime.h>
#include <cstdio>
#include <cstdint>

#ifndef MK_N_LAUNCHES
#define MK_N_LAUNCHES 1
#endif

#define GAS __attribute__((address_space(1)))
#define LAS __attribute__((address_space(3)))
typedef unsigned short bf16_t;
typedef short bf16x8 __attribute__((ext_vector_type(8)));
typedef short s16x4 __attribute__((ext_vector_type(4)));
typedef float f32x2 __attribute__((ext_vector_type(2)));
typedef float f32x4 __attribute__((ext_vector_type(4)));
typedef float f32x8 __attribute__((ext_vector_type(8)));
typedef float f32x16 __attribute__((ext_vector_type(16)));
typedef unsigned u32x2 __attribute__((ext_vector_type(2)));
typedef unsigned u32x4 __attribute__((ext_vector_type(4)));

constexpr int DM = 2048, NB = 2, SEQ = 8192, NLAYER = 2, CTXL = 256;
constexpr int MLAT = NB * SEQ, MCTX = NB * CTXL, MALL = MLAT + MCTX;
constexpr int NIN = 19456;
constexpr int CQ = 0, CK = 2048, CV = 2560, CLX = 3072, CLG = 5120, CBG = 7168, CCG = 9216, CU = 11264, CGT = 13312;
constexpr int NKEY = SEQ + CTXL;
constexpr int NCHUNK = NKEY / 64;
constexpr int NMOD = 6 * DM;
constexpr float EPS = 1e-6f;
constexpr int NWAVES = 8, NTHREADS = 512;

constexpr size_t MiB = 1u << 20;
constexpr size_t al256(size_t x) { return (x + 255) / 256 * 256; }
constexpr size_t WS_CTL = 0, CTL_ZERO_BYTES = 1 * MiB;
constexpr size_t WS_MOD = WS_CTL + CTL_ZERO_BYTES;
constexpr size_t WS_ROPE = WS_MOD + al256((size_t)NLAYER * 3 * NMOD * 4);
constexpr size_t WS_SP = WS_ROPE + al256(2 * 128 * 32 * 4);
constexpr size_t WS_CTXS = WS_SP + al256(36864 * 4);
constexpr size_t WS_LSUM = WS_CTXS + al256((size_t)MCTX * DM * 4);
constexpr size_t WS_WLRU = WS_LSUM + al256((size_t)2 * 2 * NB * NCHUNK * DM * 4);
constexpr size_t WS_KC = WS_WLRU + al256((size_t)16 * 512 * 128 * 2);
constexpr size_t WS_VC = WS_KC + al256((size_t)NB * 4 * NKEY * 128 * 2);
constexpr size_t WS_WIN = WS_VC + al256((size_t)NB * 4 * NKEY * 128 * 2);
constexpr size_t WS_WO = WS_WIN + al256((size_t)NIN * DM * 2);
constexpr size_t WS_WOUT = WS_WO + al256((size_t)3 * DM * DM * 2);
constexpr size_t WS_WSC = WS_WOUT + al256((size_t)DM * DM * 2);
constexpr size_t WS_PU = WS_WSC + al256((size_t)DM * DM * 2);
constexpr size_t WS_PV = WS_PU + al256((size_t)16384 * DM);
constexpr size_t WS_HX = WS_PV + al256((size_t)16384 * DM);
constexpr size_t WS_YF = WS_HX + al256((size_t)MALL * DM * 2);
constexpr size_t WS_P = WS_YF + al256((size_t)MALL * DM * 4);
constexpr size_t WS_END = WS_P + al256((size_t)MALL * NIN * 2);

constexpr int SP_NMIX = 0, SP_NFFN = 2048, SP_QN = 4096, SP_KN = 4224, SP_LCW = 4352, SP_LCB = 12544, SP_LBA = 14592, SP_LBX = 18688, SP_LSP = 22784, SP_SCW = 26880, SP_SCB = 33024, SP_END = 35072;

constexpr int LDS_BYTES = 147456;
constexpr int MISC_OFF = 147456 - 256;
constexpr int LDS_WORK = MISC_OFF;

__device__ __forceinline__ unsigned cvt_pk_bf16(float lo, float hi) { unsigned r; asm volatile("v_cvt_pk_bf16_f32 %0, %1, %2" : "=v"(r) : "v"(lo), "v"(hi)); return r; }
__device__ __forceinline__ float bf_lo(unsigned w) { return __uint_as_float(w << 16); }
__device__ __forceinline__ float bf_hi(unsigned w) { return __uint_as_float(w & 0xffff0000u); }
__device__ __forceinline__ float bf1(bf16_t h) { return __uint_as_float(((unsigned)h) << 16); }
__device__ __forceinline__ bf16_t f2bf(float f) { return (bf16_t)(cvt_pk_bf16(f, 0.f) & 0xffffu); }
__device__ __forceinline__ float sigmoidf_(float x) { return __builtin_amdgcn_rcpf(1.f + __expf(-x)); }
__device__ __forceinline__ float gelu_tanh(float x) { const float z = 0.7978845608028654f * (x + 0.044715f * x * x * x); const float e = __expf(2.f * z); return 0.5f * x * (2.f - 2.f * __builtin_amdgcn_rcpf(e + 1.f)); }
__device__ __forceinline__ float wave_sum(float v) {
#pragma unroll
    for (int o = 1; o < 64; o <<= 1) v += __shfl_xor(v, o);
    return v;
}
__device__ __forceinline__ float wave_max(float v) {
#pragma unroll
    for (int o = 1; o < 64; o <<= 1) v = fmaxf(v, __shfl_xor(v, o));
    return v;
}
template <class T> __device__ __forceinline__ T* as_global(T* p) { return (T*)(GAS T*)p; }
#define DPPF(v, ctrl) __int_as_float(__builtin_amdgcn_update_dpp(0, __float_as_int(v), ctrl, 0xF, 0xF, true))
#define LDS_WAIT() asm volatile("s_waitcnt lgkmcnt(0)" ::: "memory")
#define VM_WAIT() asm volatile("s_waitcnt vmcnt(0)" ::: "memory")

#define XB_TMO      128
#define XB_XCNT(j)  (256  + 64 * (j))
#define XB_XSUB(j)  (1280 + 64 * (j))
#define XB_XGEN(j)  (2304 + 64 * (j))
#define XB_TOP      3328
#define XB_TOPGEN   3392
#define XCD_BAR_WORDS 3456
#define XB_SPIN_CAP (1u << 23)
__device__ __forceinline__ unsigned xb_ld(unsigned* p)              { return __hip_atomic_load(p, __ATOMIC_RELAXED, __HIP_MEMORY_SCOPE_AGENT); }
__device__ __forceinline__ unsigned xb_add(unsigned* p, unsigned v) { return __hip_atomic_fetch_add(p, v, __ATOMIC_RELAXED, __HIP_MEMORY_SCOPE_AGENT); }
__device__ __forceinline__ unsigned xb_xcc_id() { return (unsigned)__builtin_amdgcn_s_getreg((3 << 11) | 20) & 0xFu; }
#define XB_SPIN(cond, bar) do { unsigned _sp = 0; while (cond) { __builtin_amdgcn_s_sleep(1); \
    if ((++_sp & 255u) == 0u) { if (xb_ld(&(bar)[XB_TMO])) break; if (_sp > XB_SPIN_CAP) { atomicAdd(&(bar)[XB_TMO], 1u); break; } } } } while (0)
struct XcdBarrier { unsigned* bar; unsigned x; volatile LAS unsigned* st; };
__device__ __forceinline__ XcdBarrier xcd_barrier_post(unsigned* bar, volatile LAS unsigned* st) {
    XcdBarrier b; b.bar = bar; b.x = xb_xcc_id(); b.st = st;
    if (threadIdx.x == 0) (void)xb_add(&bar[XB_XCNT(b.x)], 1u);
    return b;
}
__device__ __forceinline__ void xcd_barrier_complete(unsigned* bar, unsigned x, unsigned& nloc, unsigned& nx) {
    const unsigned G = gridDim.x * gridDim.y * gridDim.z;
    unsigned sum, cnt, mine, sp = 0u;
    for (;;) {
        sum = 0u; cnt = 0u; mine = 0u;
#pragma unroll
        for (unsigned j = 0; j < 16; ++j) { const unsigned c = xb_ld(&bar[XB_XCNT(j)]); sum += c; cnt += (c > 0u) ? 1u : 0u; mine = (j == x) ? c : mine; }
        if (sum == G) break;
        __builtin_amdgcn_s_sleep(1);
        if ((++sp & 255u) == 0u) { if (xb_ld(&bar[XB_TMO])) break; if (sp > XB_SPIN_CAP) { atomicAdd(&bar[XB_TMO], 1u); break; } }
    }
    nloc = mine > 0u ? mine : 1u; nx = cnt > 0u ? cnt : 1u;
}
__device__ __forceinline__ void xcd_barrier(const XcdBarrier& b) {
    asm volatile("s_waitcnt vmcnt(0)" ::: "memory");
    __syncthreads();
    if (threadIdx.x == 0) {
        unsigned* bar = b.bar;
        __builtin_amdgcn_s_waitcnt(0);
        unsigned nloc = b.st[0], nx = b.st[1];
        if (nloc == 0u) { xcd_barrier_complete(bar, b.x, nloc, nx); b.st[0] = nloc; b.st[1] = nx; }
        const unsigned old = xb_add(&bar[XB_XSUB(b.x)], 1u);
        const unsigned gen = old / nloc;
        if (old + 1u == (gen + 1u) * nloc) {
            __builtin_amdgcn_fence(__ATOMIC_RELEASE, "agent");
            asm volatile("s_waitcnt vmcnt(0)" ::: "memory");
            const unsigned og = xb_add(&bar[XB_TOP], 1u);
            const unsigned tg = og / nx;
            if (og + 1u == (tg + 1u) * nx) xb_add(&bar[XB_TOPGEN], 1u);
            else XB_SPIN(xb_ld(&bar[XB_TOPGEN]) == tg, bar);
            __builtin_amdgcn_fence(__ATOMIC_ACQUIRE, "agent");
            xb_add(&bar[XB_XGEN(b.x)], 1u);
            asm volatile("s_waitcnt vmcnt(0)" ::: "memory");
        } else {
            XB_SPIN(xb_ld(&bar[XB_XGEN(b.x)]) == gen, bar);
            __builtin_amdgcn_fence(__ATOMIC_ACQUIRE, "agent");
            asm volatile("s_waitcnt vmcnt(0)" ::: "memory");
        }
    }
    __syncthreads();
}
namespace pg8 {
#define PG8_LAS __attribute__((address_space(3)))
constexpr int BM = 256, BK = 64, HALF = 128, HTB = HALF * BK * 2, STAGE_BYTES = 8 * HTB, NXCD = 8, WGM = 8;
__host__ __device__ __forceinline__ int lds_byte(int r, int c) { const int st = (r >> 4) * 2 + (c >> 5), rr = r & 15, cc = c & 31, ob = rr * 64 + cc * 2; return st * 1024 + (ob ^ (((ob >> 9) & 1) << 5)); }
__host__ __device__ __forceinline__ void stage_rc(int b, int& R, int& C) { const int st = b / 1024, sb = b % 1024, swz = sb ^ (((sb >> 9) & 1) << 5); R = (st >> 1) * 16 + swz / 64; C = (st & 1) * 32 + (swz % 64) / 2; }
__host__ __device__ __forceinline__ int perm32(int rho) { const int n = rho >> 4, i = rho & 15; return 8 * (i >> 2) + 4 * n + (i & 3); }

struct Unit { int pm, pn, nh; };
struct Gemm { const bf16_t* A; const bf16_t* Bt; int M, N, K, lda, ldb; };

struct StaticOrder {
    int nM, nN, nwg, G, c;
    __host__ __device__ void init(int M, int N, int G_, int c_) { nM = M / BM; nN = N / BM; nwg = nM * nN; G = G_; c = c_; }
    __host__ __device__ bool next(int i, Unit& u) const {
        const long L = (long)i * G + c; if (L >= nwg) return false;
        int wgid = (int)L; { const int q = nwg / NXCD, r = nwg % NXCD, xcd = wgid % NXCD, off = wgid / NXCD; wgid = (xcd < r ? xcd * (q + 1) : r * (q + 1) + (xcd - r) * q) + off; }
        const int nig = WGM * nN, gid = wgid / nig, fm = gid * WGM, gsz = (nM - fm) < WGM ? (nM - fm) : WGM;
        u.pm = 2 * (fm + ((wgid % nig) % gsz)); u.pn = (wgid % nig) / gsz; u.nh = 2; return true;
    }
    __device__ __forceinline__ void a_ready(const Unit&) const {}
    __device__ __forceinline__ void done(const Unit&) const {}
};

struct MixOrder {
    StaticOrder lat; int nhalf;
    __host__ __device__ void init(int mrows, int G_, int c_) { lat.init(MLAT, 2048, G_, c_); nhalf = ((mrows - MLAT) / HALF) * 8; }
    __host__ __device__ bool next(int i, Unit& u) const {
        if (lat.next(i, u)) return true;
        const long h = (long)i * lat.G + lat.c - lat.nwg; if (h < 0 || h >= nhalf) return false;
        u.pm = MLAT / HALF + (int)(h >> 3); u.pn = (int)(h & 7); u.nh = 1; return true;
    }
    __device__ __forceinline__ void a_ready(const Unit&) const {}
    __device__ __forceinline__ void done(const Unit&) const {}
};

struct EpiBf16 {
    static constexpr bool PERM = true, AFTER_DRAIN = false;
    bf16_t* O; int ldc;
    __device__ __forceinline__ void operator()(const f32x4 (&acc)[2][2][4][2], const Unit& u, int wr, int wc, int fr, int fq) const {
        const int row0 = u.pm * HALF + wr * 64 + fr, col0 = u.pn * BM + wc * 32 + 8 * fq;
#pragma unroll
        for (int ai = 0; ai < 2; ++ai) if (ai < u.nh)
#pragma unroll
            for (int m = 0; m < 4; ++m) { bf16_t* rowp = O + (size_t)(row0 + ai * HALF + m * 16) * ldc + col0;
#pragma unroll
                for (int bj = 0; bj < 2; ++bj) { const f32x4 v0 = acc[ai][bj][m][0], v1 = acc[ai][bj][m][1];
                    u32x4 w; w.x = cvt_pk_bf16(v0[0], v0[1]); w.y = cvt_pk_bf16(v0[2], v0[3]); w.z = cvt_pk_bf16(v1[0], v1[1]); w.w = cvt_pk_bf16(v1[2], v1[3]);
                    *(u32x4*)(rowp + bj * HALF) = w; } }
    }
};
struct EpiF32 {
    static constexpr bool PERM = false, AFTER_DRAIN = false;
    float* C; int ldc;
    __device__ __forceinline__ void operator()(const f32x4 (&acc)[2][2][4][2], const Unit& u, int wr, int wc, int fr, int fq) const {
        const int row0 = u.pm * HALF + wr * 64 + fr, col0 = u.pn * BM + wc * 32 + 4 * fq;
#pragma unroll
        for (int ai = 0; ai < 2; ++ai) if (ai < u.nh)
#pragma unroll
            for (int m = 0; m < 4; ++m) { float* rowp = C + (size_t)(row0 + ai * HALF + m * 16) * ldc + col0;
#pragma unroll
                for (int bj = 0; bj < 2; ++bj)
#pragma unroll
                    for (int n = 0; n < 2; ++n) *(f32x4*)(rowp + bj * HALF + n * 16) = acc[ai][bj][m][n]; }
    }
};
template <int MODE> struct EpiMerge {
    static constexpr bool PERM = true, AFTER_DRAIN = false;
    const bf16_t* Gt; int ldg; float* Y; bf16_t* YB;
    __device__ __forceinline__ void operator()(const f32x4 (&acc)[2][2][4][2], const Unit& u, int wr, int wc, int fr, int fq) const {
        const int row0 = u.pm * HALF + wr * 64 + fr, col0 = u.pn * BM + wc * 32 + 8 * fq;
#pragma unroll
        for (int ai = 0; ai < 2; ++ai) if (ai < u.nh)
#pragma unroll
            for (int m = 0; m < 4; ++m) { const size_t r = (size_t)(row0 + ai * HALF + m * 16);
#pragma unroll
                for (int bj = 0; bj < 2; ++bj) { const int c = col0 + bj * HALF;
                    const u32x4 gw = *(const u32x4*)(Gt + r * ldg + c);
                    f32x4 g0, g1;
                    g0[0] = sigmoidf_(bf_lo(gw.x)); g0[1] = sigmoidf_(bf_hi(gw.x)); g0[2] = sigmoidf_(bf_lo(gw.y)); g0[3] = sigmoidf_(bf_hi(gw.y));
                    g1[0] = sigmoidf_(bf_lo(gw.z)); g1[1] = sigmoidf_(bf_hi(gw.z)); g1[2] = sigmoidf_(bf_lo(gw.w)); g1[3] = sigmoidf_(bf_hi(gw.w));
                    float* yp = Y + r * 2048 + c;
                    f32x4 y0 = g0 * acc[ai][bj][m][0], y1 = g1 * acc[ai][bj][m][1];
                    if (MODE != 0) { y0 += *(const f32x4*)yp; y1 += *(const f32x4*)(yp + 4); }
                    if (MODE != 2) { *(f32x4*)yp = y0; *(f32x4*)(yp + 4) = y1; }
                    else { u32x4 w; w.x = cvt_pk_bf16(y0[0], y0[1]); w.y = cvt_pk_bf16(y0[2], y0[3]); w.z = cvt_pk_bf16(y1[0], y1[1]); w.w = cvt_pk_bf16(y1[2], y1[3]);
                        *(u32x4*)(YB + r * 2048 + c) = w; } } }
    }
};
struct EpiResid {
    static constexpr bool PERM = true, AFTER_DRAIN = false;
    float* xlat; float* xctx; const float* gate;
    __device__ __forceinline__ void operator()(const f32x4 (&acc)[2][2][4][2], const Unit& u, int wr, int wc, int fr, int fq) const {
        const int vec = u.pm < 64 ? 0 : (u.pm < 128 ? 1 : 2);
        float* xb = u.pm < 128 ? xlat + (size_t)u.pm * HALF * 2048 : xctx + (size_t)(u.pm - 128) * HALF * 2048;
        const int lrow0 = wr * 64 + fr, col0 = u.pn * BM + wc * 32 + 8 * fq;
        const float* gp = gate + (size_t)vec * 12288 + col0;
#pragma unroll
        for (int bj = 0; bj < 2; ++bj) { const f32x4 g0 = *(const f32x4*)(gp + bj * HALF), g1 = *(const f32x4*)(gp + bj * HALF + 4);
#pragma unroll
            for (int ai = 0; ai < 2; ++ai) if (ai < u.nh)
#pragma unroll
                for (int m = 0; m < 4; ++m) { float* xp = xb + (size_t)(lrow0 + ai * HALF + m * 16) * 2048 + col0 + bj * HALF;
                    const f32x4 x0 = *(const f32x4*)xp + g0 * acc[ai][bj][m][0], x1 = *(const f32x4*)(xp + 4) + g1 * acc[ai][bj][m][1];
                    *(f32x4*)xp = x0; *(f32x4*)(xp + 4) = x1; } }
    }
};

template <class Epi, class Sched, bool ALIGN_EPI = false, bool SP2 = false, bool HALFU = false>
__device__ __forceinline__ void gemm_phase(PG8_LAS unsigned char* lds, const Gemm g, const Sched& S, const Epi& E) {
    int tid_ = threadIdx.x; asm volatile("" : "+v"(tid_));
    const int tid = tid_, wid = __builtin_amdgcn_readfirstlane(tid >> 6), lane = tid & 63, wr = wid >> 2, wc = wid & 3, fr = lane & 15, fq = lane >> 4;
    const int K = g.K, nt = K / BK;
    unsigned voffA[2], voffB[2];
#pragma unroll
    for (int i = 0; i < 2; ++i) { int R, C; stage_rc(tid * 16 + i * 8192, R, C); const int Rb = Epi::PERM ? ((R & ~31) + perm32(R & 31)) : R;
        voffA[i] = (unsigned)(R * g.lda + C) * 2u; voffB[i] = (unsigned)(Rb * g.ldb + C) * 2u; }
    const size_t kstep = (size_t)(BK * 2);
    const size_t hstepA = (size_t)HALF * g.lda * 2, hstepB = (size_t)HALF * g.ldb * 2;
    const size_t tstepB = 2 * hstepB;
    const unsigned ldsw = (unsigned)wid * 1024u;
    const int aoff = lds_byte(wr * 64 + fr, fq * 8), boff = lds_byte(wc * 32 + fr, fq * 8);
#define PG8_SA(b, h) (((b) * 2 + (h)) * HTB)
#define PG8_SB(b, h) ((4 + (b) * 2 + (h)) * HTB)
#define PG8_STAGE(bufoff, gbase, voff) do { _Pragma("unroll") for (int _i = 0; _i < 2; ++_i) \
        __builtin_amdgcn_global_load_lds((const unsigned*)((const char*)(gbase) + (voff)[_i]), (PG8_LAS unsigned*)(lds + (bufoff) + ldsw + _i * 8192), 16, 0, 0); } while (0)
#define PG8_LDA(dst, b, h) do { _Pragma("unroll") for (int m = 0; m < 4; ++m) _Pragma("unroll") for (int k = 0; k < 2; ++k) dst[m][k] = *(const PG8_LAS bf16x8*)(lds + PG8_SA(b, h) + aoff + m * 2048 + k * 1024); } while (0)
#define PG8_LDB(dst, b, h) do { _Pragma("unroll") for (int n = 0; n < 2; ++n) _Pragma("unroll") for (int k = 0; k < 2; ++k) dst[n][k] = *(const PG8_LAS bf16x8*)(lds + PG8_SB(b, h) + boff + n * 2048 + k * 1024); } while (0)
#define PG8_MMA(ai, bj, At, Bt) do { __builtin_amdgcn_s_setprio(1); _Pragma("unroll") for (int m = 0; m < 4; ++m) _Pragma("unroll") for (int n = 0; n < 2; ++n) _Pragma("unroll") for (int k = 0; k < 2; ++k) \
        acc[ai][bj][m][n] = __builtin_amdgcn_mfma_f32_16x16x32_bf16(Bt[n][k], At[m][k], acc[ai][bj][m][n], 0, 0, 0); __builtin_amdgcn_s_setprio(0); } while (0)
#define PG8_WAIT_V(n) asm volatile("s_waitcnt vmcnt(" #n ")" ::: "memory")
#define PG8_WAIT_L(n) asm volatile("s_waitcnt lgkmcnt(" #n ")" ::: "memory")
#define PG8_BAR __builtin_amdgcn_s_barrier()
#define PG8_SCHED __builtin_amdgcn_sched_barrier(0)
    Unit cur, nxt; int ui = 0;
    if (!S.next(0, cur)) return;
    f32x4 acc[2][2][4][2];
#pragma unroll
    for (int a = 0; a < 2; ++a)
#pragma unroll
        for (int b = 0; b < 2; ++b)
#pragma unroll
            for (int m = 0; m < 4; ++m)
#pragma unroll
                for (int n = 0; n < 2; ++n) acc[a][b][m][n] = (f32x4){0.f, 0.f, 0.f, 0.f};
    bf16x8 At[4][2], B0[2][2], B1[2][2];
    const char* cA = (const char*)g.A + (size_t)cur.pm * hstepA; const char* cB = (const char*)g.Bt + (size_t)cur.pn * tstepB;
    size_t chA = (!HALFU || cur.nh == 2) ? hstepA : 0;
    S.a_ready(cur);
    if constexpr (SP2) {
        PG8_STAGE(PG8_SB(0, 0), cB, voffB); PG8_STAGE(PG8_SB(0, 1), cB + hstepB, voffB); PG8_STAGE(PG8_SA(0, 0), cA, voffA); PG8_STAGE(PG8_SA(0, 1), cA + chA, voffA);
        if (wr == 1) PG8_BAR;
        PG8_WAIT_V(2); PG8_BAR;
        PG8_STAGE(PG8_SB(1, 0), cB + kstep, voffB); PG8_STAGE(PG8_SA(1, 0), cA + kstep, voffA); PG8_STAGE(PG8_SB(1, 1), cB + hstepB + kstep, voffB);
        PG8_WAIT_V(6); PG8_BAR;
    } else {
        PG8_STAGE(PG8_SB(0, 0), cB, voffB); PG8_STAGE(PG8_SA(0, 0), cA, voffA); PG8_STAGE(PG8_SB(0, 1), cB + hstepB, voffB); PG8_STAGE(PG8_SA(0, 1), cA + chA, voffA);
        if (wr == 1) PG8_BAR;
        PG8_WAIT_V(4); PG8_BAR;
        PG8_STAGE(PG8_SB(1, 0), cB + kstep, voffB); PG8_STAGE(PG8_SA(1, 0), cA + kstep, voffA); PG8_STAGE(PG8_SB(1, 1), cB + hstepB + kstep, voffB);
        PG8_WAIT_V(6); PG8_BAR;
    }
    for (;;) {
        const bool has_next = S.next(ui + 1, nxt);
        const char* nA = has_next ? (const char*)g.A + (size_t)nxt.pm * hstepA : cA; const size_t nhA = has_next ? ((!HALFU || nxt.nh == 2) ? hstepA : 0) : chA; const bool full = (!HALFU || cur.nh == 2);
        const char* nA_ = nA; (void)nA_; const char* nB = has_next ? (const char*)g.Bt + (size_t)nxt.pn * tstepB : cB;
        for (int t = 0; t < nt; t += 2) {
            const bool last = (t == nt - 2);
            const char* a1 = cA + (size_t)(t + 1) * kstep;
            const char* a2 = last ? nA : cA + (size_t)(t + 2) * kstep; const char* b2 = last ? nB : cB + (size_t)(t + 2) * kstep;
            const char* a3 = a2 + kstep; const char* b3 = b2 + kstep;
            const size_t h2A = last ? nhA : chA;
            if (last && has_next) S.a_ready(nxt);
            if constexpr (SP2) {
            PG8_LDB(B0, 0, 0); PG8_LDB(B1, 0, 1); PG8_SCHED; PG8_LDA(At, 0, 0); PG8_STAGE(PG8_SA(1, 1), a1 + chA, voffA);
            PG8_WAIT_V(8); PG8_WAIT_L(0); PG8_BAR; PG8_MMA(0, 0, At, B0); PG8_MMA(0, 1, At, B1); PG8_BAR; PG8_SCHED;
            PG8_LDA(At, 0, 1); PG8_STAGE(PG8_SB(0, 0), b2, voffB); PG8_STAGE(PG8_SB(0, 1), b2 + hstepB, voffB); PG8_STAGE(PG8_SA(0, 0), a2, voffA);
            PG8_WAIT_V(8); PG8_WAIT_L(0); PG8_BAR; if (full) { PG8_MMA(1, 0, At, B0); PG8_MMA(1, 1, At, B1); } PG8_BAR; PG8_SCHED;
            PG8_LDB(B0, 1, 0); PG8_LDB(B1, 1, 1); PG8_SCHED; PG8_LDA(At, 1, 0); PG8_STAGE(PG8_SA(0, 1), a2 + h2A, voffA);
            PG8_WAIT_V(8); PG8_WAIT_L(0); PG8_BAR; PG8_MMA(0, 0, At, B0); PG8_MMA(0, 1, At, B1); PG8_BAR; PG8_SCHED;
            PG8_LDA(At, 1, 1); PG8_STAGE(PG8_SB(1, 0), b3, voffB); PG8_STAGE(PG8_SB(1, 1), b3 + hstepB, voffB); PG8_STAGE(PG8_SA(1, 0), a3, voffA);
            PG8_WAIT_V(8); PG8_WAIT_L(0); PG8_BAR; if (full) { PG8_MMA(1, 0, At, B0); PG8_MMA(1, 1, At, B1); } PG8_BAR; PG8_SCHED;
            } else {
            PG8_LDB(B0, 0, 0); PG8_SCHED; PG8_LDA(At, 0, 0); PG8_STAGE(PG8_SA(1, 1), a1 + chA, voffA);
            PG8_WAIT_L(8); PG8_BAR; PG8_WAIT_L(0); PG8_MMA(0, 0, At, B0); PG8_BAR; PG8_SCHED;
            PG8_LDB(B1, 0, 1); PG8_STAGE(PG8_SB(0, 0), b2, voffB);
            PG8_BAR; PG8_WAIT_L(0); PG8_MMA(0, 1, At, B1); PG8_BAR;
            PG8_LDA(At, 0, 1); PG8_STAGE(PG8_SA(0, 0), a2, voffA);
            PG8_BAR; PG8_WAIT_L(0); if (full) PG8_MMA(1, 0, At, B0); PG8_BAR; PG8_SCHED;
            PG8_STAGE(PG8_SB(0, 1), b2 + hstepB, voffB);
            PG8_WAIT_V(6); PG8_BAR; if (full) PG8_MMA(1, 1, At, B1); PG8_BAR;
            PG8_LDB(B0, 1, 0); PG8_SCHED; PG8_LDA(At, 1, 0); PG8_STAGE(PG8_SA(0, 1), a2 + h2A, voffA);
            PG8_WAIT_L(8); PG8_BAR; PG8_WAIT_L(0); PG8_MMA(0, 0, At, B0); PG8_BAR; PG8_SCHED;
            PG8_LDB(B1, 1, 1); PG8_STAGE(PG8_SB(1, 0), b3, voffB);
            PG8_BAR; PG8_WAIT_L(0); PG8_MMA(0, 1, At, B1); PG8_BAR;
            PG8_LDA(At, 1, 1); PG8_STAGE(PG8_SA(1, 0), a3, voffA);
            PG8_BAR; PG8_WAIT_L(0); if (full) PG8_MMA(1, 0, At, B0); PG8_BAR; PG8_SCHED;
            PG8_STAGE(PG8_SB(1, 1), b3 + hstepB, voffB);
            PG8_WAIT_V(6); PG8_BAR; if (full) PG8_MMA(1, 1, At, B1); PG8_BAR;
            }
        }
        if constexpr (ALIGN_EPI) { if (wr == 0) PG8_BAR; }
        if constexpr (!Epi::AFTER_DRAIN) { E(acc, cur, wr, wc, fr, fq); S.done(cur); }
        if (!has_next) break;
#pragma unroll
        for (int a = 0; a < 2; ++a)
#pragma unroll
            for (int b = 0; b < 2; ++b)
#pragma unroll
                for (int m = 0; m < 4; ++m)
#pragma unroll
                    for (int n = 0; n < 2; ++n) acc[a][b][m][n] = (f32x4){0.f, 0.f, 0.f, 0.f};
        cur = nxt; cA = nA; cB = nB; chA = nhA; ++ui;
        if constexpr (ALIGN_EPI) { if (wr == 1) PG8_BAR; }
    }
    PG8_WAIT_V(0);
    if constexpr (!ALIGN_EPI) { if (wr == 0) PG8_BAR; }
    PG8_BAR;
#undef PG8_SA
#undef PG8_SB
#undef PG8_STAGE
#undef PG8_LDA
#undef PG8_LDB
#undef PG8_MMA
#undef PG8_WAIT_V
#undef PG8_WAIT_L
#undef PG8_BAR
#undef PG8_SCHED
}
}
namespace att {
constexpr int D = 128, NW = 8, QBLK = 32, KVBLK = 64;
constexpr float SCALE = 0.088388347648318440f;
constexpr float THR = 8.f;
constexpr int LDQ = NIN, LDK = 128, LDO = NIN;
constexpr size_t SHM_V = KVBLK * D * 2, SHM_K = KVBLK * D * 2, SHM_ATTN = 2 * SHM_V + 2 * SHM_K + NW * 64 * 4;
#define KSWZ(row, colB) ((row) * 256 + ((colB) ^ (((row) & 7) << 4)))
#define SBAR() __builtin_amdgcn_sched_barrier(0)
__device__ __forceinline__ int crow(int r, int hi) { return (r & 3) + 8 * (r >> 2) + 4 * hi; }
__device__ __forceinline__ unsigned cvtpk(float lo, float hi) { unsigned r; asm volatile("v_cvt_pk_bf16_f32 %0, %1, %2" : "=v"(r) : "v"(lo), "v"(hi)); return r; }
__device__ __forceinline__ bf16x8 ld8(const bf16_t* p) { return *reinterpret_cast<const bf16x8*>(p); }

__device__ __forceinline__ void partialSM(f32x16& p0, f32x16& p1, float& m_reg, float& mn, float& alpha) {
  constexpr float C = SCALE * 1.4426950408889634f;
  float pmax = p0[0];
#pragma unroll
  for (int r = 1; r < 16; ++r) pmax = fmaxf(pmax, p0[r]);
#pragma unroll
  for (int r = 0; r < 16; ++r) pmax = fmaxf(pmax, p1[r]);
  { auto rr = __builtin_amdgcn_permlane32_swap(__float_as_uint(pmax), __float_as_uint(pmax), false, false);
    pmax = fmaxf(__uint_as_float(rr[0]), __uint_as_float(rr[1])); }
  if (__builtin_expect(__all(pmax - m_reg <= THR / SCALE), 1)) { mn = m_reg; alpha = 1.f; }
  else { mn = fmaxf(m_reg, pmax); alpha = __builtin_amdgcn_exp2f((m_reg - mn) * C); m_reg = mn; }
  float mnC = -mn * C;
#pragma unroll
  for (int r = 0; r < 16; ++r) p0[r] = fmaf(p0[r], C, mnC);
#pragma unroll
  for (int r = 0; r < 16; ++r) p1[r] = fmaf(p1[r], C, mnC);
#pragma unroll
  for (int r = 0; r < 16; ++r) p0[r] = __builtin_amdgcn_exp2f(p0[r]);
}
__device__ __forceinline__ void finishSM(f32x16& p0, f32x16& p1, float alpha, float& l_reg, bf16x8& pa0, bf16x8& pa1, bf16x8& pa2, bf16x8& pa3) {
#pragma unroll
  for (int r = 0; r < 16; ++r) p1[r] = __builtin_amdgcn_exp2f(p1[r]);
  float ps = 0;
#pragma unroll
  for (int r = 0; r < 16; ++r) ps += p0[r];
#pragma unroll
  for (int r = 0; r < 16; ++r) ps += p1[r];
  { auto rr = __builtin_amdgcn_permlane32_swap(__float_as_uint(ps), __float_as_uint(ps), false, false);
    ps = __uint_as_float(rr[0]) + __uint_as_float(rr[1]); }
  l_reg = l_reg * alpha + ps;
#define PK4(P, BASE, OUT) do { unsigned a0 = cvtpk(P[BASE + 0], P[BASE + 1]), a1 = cvtpk(P[BASE + 2], P[BASE + 3]);   \
    unsigned b0 = cvtpk(P[BASE + 4], P[BASE + 5]), b1 = cvtpk(P[BASE + 6], P[BASE + 7]);                              \
    auto r0 = __builtin_amdgcn_permlane32_swap(a0, b0, false, false); auto r1 = __builtin_amdgcn_permlane32_swap(a1, b1, false, false); \
    u32x4 w = {r0[0], r1[0], r0[1], r1[1]}; OUT = *reinterpret_cast<bf16x8*>(&w); } while (0)
  PK4(p0, 0, pa0); PK4(p0, 8, pa1); PK4(p1, 0, pa2); PK4(p1, 8, pa3);
#undef PK4
}
__device__ __forceinline__ void qkt(f32x16& p0, f32x16& p1, const bf16_t* Ks, const bf16x8* qr, int r32, int hi) {
  p0 = f32x16{}; p1 = f32x16{};
#pragma unroll
  for (int d0 = 0; d0 < 8; ++d0) { int cb = (d0 * 16 + hi * 8) * 2;
    bf16x8 b0 = *reinterpret_cast<const bf16x8*>((const char*)Ks + KSWZ(r32, cb));
    bf16x8 b1 = *reinterpret_cast<const bf16x8*>((const char*)Ks + KSWZ(32 + r32, cb));
    p0 = __builtin_amdgcn_mfma_f32_32x32x16_bf16(b0, qr[d0], p0, 0, 0, 0);
    p1 = __builtin_amdgcn_mfma_f32_32x32x16_bf16(b1, qr[d0], p1, 0, 0, 0); }
}
__device__ __forceinline__ int v_st(int k, int c) { const int kk = (k & ~0xC) | ((k & 4) << 1) | ((k & 8) >> 1); return ((kk >> 3) * 4 + (c >> 5)) * 512 + ((kk & 7) * 32 + (c & 31)) * 2; }
__device__ __forceinline__ int v_rd_base(int lane) { return ((lane & 3) << 3) | (((lane >> 2) & 3) << 6) | (((lane >> 4) & 1) << 5) | (((lane >> 5) & 1) << 8); }
constexpr int v_rd_off(int d0, int ks, int half) { return d0 * 512 + ks * 4096 + half * 2048; }
template <int OFF> __device__ __forceinline__ s16x4 tr_read(int vb) {
  s16x4 r; asm volatile("ds_read_b64_tr_b16 %0, %1 offset:%2" : "=&v"(r) : "v"(vb), "i"(OFF) : "memory"); return r;
}
template <int D0> __device__ __forceinline__ void pv_one(f32x16& od, int vb, bf16x8 pa0, bf16x8 pa1, bf16x8 pa2, bf16x8 pa3) {
  const s16x4 l0 = tr_read<v_rd_off(D0, 0, 0)>(vb), h0 = tr_read<v_rd_off(D0, 0, 1)>(vb), l1 = tr_read<v_rd_off(D0, 1, 0)>(vb), h1 = tr_read<v_rd_off(D0, 1, 1)>(vb);
  const s16x4 l2 = tr_read<v_rd_off(D0, 2, 0)>(vb), h2 = tr_read<v_rd_off(D0, 2, 1)>(vb), l3 = tr_read<v_rd_off(D0, 3, 0)>(vb), h3 = tr_read<v_rd_off(D0, 3, 1)>(vb);
  asm volatile("s_waitcnt lgkmcnt(0)" ::: "memory"); SBAR();
#define PK(L, H) (bf16x8){L[0], L[1], L[2], L[3], H[0], H[1], H[2], H[3]}
  od = __builtin_amdgcn_mfma_f32_32x32x16_bf16(pa0, PK(l0, h0), od, 0, 0, 0);
  od = __builtin_amdgcn_mfma_f32_32x32x16_bf16(pa1, PK(l1, h1), od, 0, 0, 0);
  od = __builtin_amdgcn_mfma_f32_32x32x16_bf16(pa2, PK(l2, h2), od, 0, 0, 0);
  od = __builtin_amdgcn_mfma_f32_32x32x16_bf16(pa3, PK(l3, h3), od, 0, 0, 0);
#undef PK
}
__device__ __forceinline__ void pv_d0(f32x16* o, int vb, bf16x8 pa0, bf16x8 pa1, bf16x8 pa2, bf16x8 pa3) {
  pv_one<0>(o[0], vb, pa0, pa1, pa2, pa3); pv_one<1>(o[1], vb, pa0, pa1, pa2, pa3); pv_one<2>(o[2], vb, pa0, pa1, pa2, pa3); pv_one<3>(o[3], vb, pa0, pa1, pa2, pa3);
}

__device__ __forceinline__ void attn_dense_body(const bf16_t* __restrict__ Qb, const bf16_t* __restrict__ Kh, const bf16_t* __restrict__ Vh,
                                                bf16_t* Ob, int seq, char* lds) {
  constexpr int SDEPTH = 2;
  int tid_ = threadIdx.x; asm volatile("" : "+v"(tid_));
  const int tid = tid_, wid = tid >> 6, lane = tid & 63, r32 = lane & 31, hi = lane >> 5;
  bf16_t* V_lds = (bf16_t*)lds; bf16_t* K_lds = (bf16_t*)(lds + 2 * SHM_V);
  float* ws = (float*)(lds + 2 * SHM_V + 2 * SHM_K) + wid * 64; float* li_l = ws; float* al_l = ws + 32;
  float m_reg = -1e30f, l_reg = 0; f32x16 o[4] = {}; bf16x8 qr[8];
  const bf16_t* Qw = Qb + (long)(wid * QBLK + r32) * LDQ + hi * 8;
#pragma unroll
  for (int d0 = 0; d0 < 8; ++d0) qr[d0] = ld8(Qw + d0 * 16);
  const int sr = tid >> 4, sc = (tid & 15) * 8, vst0 = v_st(sr, sc), vst1 = v_st(32 + sr, sc);
  const int vb0 = (int)(uintptr_t)V_lds + v_rd_base(lane);
  struct { bf16x8 vs0, vs1, ks0, ks1; } sr_[SDEPTH];
#define SLOAD(i, k0) do { sr_[i].vs0 = ld8(&Vh[(long)((k0) + sr) * LDK + sc]); sr_[i].vs1 = ld8(&Vh[(long)((k0) + 32 + sr) * LDK + sc]); \
    sr_[i].ks0 = ld8(&Kh[(long)((k0) + sr) * LDK + sc]); sr_[i].ks1 = ld8(&Kh[(long)((k0) + 32 + sr) * LDK + sc]); } while (0)
#define SWRITE(b, i) do { *(bf16x8*)((char*)V_lds + (b) * SHM_V + vst0) = sr_[i].vs0;          \
    *(bf16x8*)((char*)V_lds + (b) * SHM_V + vst1) = sr_[i].vs1; int kc = sc * 2;               \
    *(bf16x8*)((char*)K_lds + (b) * SHM_K + KSWZ(sr, kc)) = sr_[i].ks0;                       \
    *(bf16x8*)((char*)K_lds + (b) * SHM_K + KSWZ(32 + sr, kc)) = sr_[i].ks1; } while (0)
#define SWAIT() asm volatile("s_waitcnt vmcnt(4)" ::: "memory")
#define RESC(a) do { if (__any((a) < 1.f)) { if (hi == 0) al_l[r32] = (a); asm volatile("s_waitcnt lgkmcnt(0)" ::: "memory"); \
    _Pragma("unroll") for (int d = 0; d < 4; ++d) _Pragma("unroll") for (int r = 0; r < 16; ++r) o[d][r] *= al_l[crow(r, hi)]; } } while (0)
  f32x16 pA0, pA1, pB0, pB1; float mnA, mnB, alA, alB; bf16x8 pa0, pa1, pa2, pa3; const int NT = seq / KVBLK;
  constexpr int SE = 0, SO = SDEPTH - 1;
  SLOAD(SE, 0); asm volatile("s_waitcnt vmcnt(0)" ::: "memory"); SWRITE(0, SE); __syncthreads();
  qkt(pA0, pA1, K_lds, qr, r32, hi); partialSM(pA0, pA1, m_reg, mnA, alA);
  SLOAD(SO, KVBLK); if (2 < NT) SLOAD(SE, 2 * KVBLK);
  SWAIT(); SWRITE(1, SO); __syncthreads();
  for (int j = 1; j + 1 < NT; j += 2) {
    SBAR(); qkt(pB0, pB1, (bf16_t*)((char*)K_lds + SHM_K), qr, r32, hi);
    finishSM(pA0, pA1, alA, l_reg, pa0, pa1, pa2, pa3); SBAR();
    SLOAD(SO, (j + SDEPTH) * KVBLK); SBAR();
    pv_d0(o, vb0, pa0, pa1, pa2, pa3); partialSM(pB0, pB1, m_reg, mnB, alB);
    __syncthreads(); SWAIT(); SWRITE(0, SE);
    RESC(alB); __syncthreads();
    SBAR(); qkt(pA0, pA1, K_lds, qr, r32, hi);
    finishSM(pB0, pB1, alB, l_reg, pa0, pa1, pa2, pa3); SBAR();
    if (j + 3 < NT) SLOAD(SE, (j + 1 + SDEPTH) * KVBLK); SBAR();
    pv_d0(o, vb0 + (int)SHM_V, pa0, pa1, pa2, pa3); partialSM(pA0, pA1, m_reg, mnA, alA);
    __syncthreads(); SWAIT(); SWRITE(1, SO);
    RESC(alA); __syncthreads();
  }
  SBAR(); qkt(pB0, pB1, (bf16_t*)((char*)K_lds + SHM_K), qr, r32, hi);
  finishSM(pA0, pA1, alA, l_reg, pa0, pa1, pa2, pa3); SBAR();
  pv_d0(o, vb0, pa0, pa1, pa2, pa3); partialSM(pB0, pB1, m_reg, mnB, alB);
  __syncthreads(); RESC(alB);
  finishSM(pB0, pB1, alB, l_reg, pa0, pa1, pa2, pa3); SBAR();
  pv_d0(o, vb0 + (int)SHM_V, pa0, pa1, pa2, pa3);
  if (hi == 0) li_l[r32] = l_reg; asm volatile("s_waitcnt lgkmcnt(0)" ::: "memory");
  float rli[16];
#pragma unroll
  for (int r = 0; r < 16; ++r) rli[r] = __builtin_amdgcn_rcpf(li_l[crow(r, hi)]);
  bf16_t* Ow = Ob + (long)(wid * QBLK) * LDO;
#pragma unroll
  for (int r = 0; r < 16; ++r) { int orow = crow(r, hi);
#pragma unroll
    for (int d0 = 0; d0 < 4; ++d0) Ow[(long)orow * LDO + d0 * 32 + r32] = f2bf(o[d0][r] * rli[r]); }
  __syncthreads();
#undef SLOAD
#undef SWRITE
#undef SWAIT
#undef RESC
}
#undef KSWZ
#undef SBAR
}
#define CAS __attribute__((address_space(4)))
#define INP(i) ((const float*)(GAS const float*)in[i])
struct Ctx {
    float* out; unsigned char* ws;
    LAS unsigned char* lds; int tid, lane, wave, wg, G;
};
enum { I_X = 0, I_C, I_CTX, I_CCTX, I_WMOD, I_BMOD, I_NMIX, I_NFFN, I_WIN, I_QN, I_KN, I_LCW, I_LCB, I_LWA, I_LBA, I_LWX, I_LBX, I_LLAM, I_SCW, I_SCB,
       I_WOA, I_WOL, I_WOS, I_WOUT, I_PWQ, I_PK1, I_PK2, I_PU, I_PV };

__device__ __forceinline__ float* xrow_ptr(const Ctx& c, int r) {
    return r < MLAT ? c.out + (size_t)r * DM : (float*)(c.ws + WS_CTXS) + (size_t)(r - MLAT) * DM;
}

__device__ __forceinline__ void transpose_item(const float* W, int K, int N, bf16_t* WT, LAS float* scr, int item, int lane) {
    const int nblk = N / 64, kb = item / nblk, nb = item % nblk, k0 = 64 * kb, n0 = 64 * nb;
    const float* src = W + (size_t)(k0 + (lane >> 4)) * N + n0 + (lane & 15) * 4;
    f32x4 v[16];
#pragma unroll
    for (int i = 0; i < 16; ++i) v[i] = *(const f32x4*)(src + (size_t)(4 * i) * N);
    LAS float* d = scr + (lane >> 4) * 65 + (lane & 15) * 4;
#pragma unroll
    for (int i = 0; i < 16; ++i) { d[(4 * i) * 65 + 0] = v[i][0]; d[(4 * i) * 65 + 1] = v[i][1]; d[(4 * i) * 65 + 2] = v[i][2]; d[(4 * i) * 65 + 3] = v[i][3]; }
    LDS_WAIT(); asm volatile("" ::: "memory");
    const int c = lane & 7;
#pragma unroll
    for (int j = 0; j < 8; ++j) { const int n = (lane >> 3) + 8 * j; const LAS float* s = scr + (8 * c) * 65 + n;
        u32x4 o; o.x = cvt_pk_bf16(s[0 * 65], s[1 * 65]); o.y = cvt_pk_bf16(s[2 * 65], s[3 * 65]); o.z = cvt_pk_bf16(s[4 * 65], s[5 * 65]); o.w = cvt_pk_bf16(s[6 * 65], s[7 * 65]);
        *(u32x4*)(WT + (size_t)(n0 + n) * K + k0 + 8 * c) = o; }
    LDS_WAIT(); asm volatile("" ::: "memory");
}

__device__ __forceinline__ void mod_unit(const Ctx& c, CAS const unsigned long long* in, int l, int cb) {
    LAS float* sv = (LAS float*)c.lds;
    LAS float* red = sv + 3 * DM;
    { const float* cc = INP(I_C); const float* cx = INP(I_CCTX);
      for (int i = c.tid; i < 3 * DM; i += NTHREADS) { const int v = i / DM, k = i % DM; const float x = v < 2 ? cc[v * DM + k] : cx[k]; sv[i] = x * sigmoidf_(x); } }
    __syncthreads();
    const int j4 = (c.tid & 31) * 4, kg = c.tid >> 5;
    const float* w = INP(I_WMOD) + (size_t)l * DM * NMOD + (size_t)(kg * 128) * NMOD + cb * 128 + j4;
    f32x4 a0 = {0.f, 0.f, 0.f, 0.f}, a1 = a0, a2 = a0;
#pragma unroll 8
    for (int k = 0; k < 128; ++k) { const f32x4 wv = *(const f32x4*)(w + (size_t)k * NMOD); const int kk = kg * 128 + k; a0 += wv * sv[kk]; a1 += wv * sv[DM + kk]; a2 += wv * sv[2 * DM + kk]; }
    *(LAS f32x4*)(red + (kg * 3 + 0) * 128 + j4) = a0; *(LAS f32x4*)(red + (kg * 3 + 1) * 128 + j4) = a1; *(LAS f32x4*)(red + (kg * 3 + 2) * 128 + j4) = a2;
    __syncthreads();
    if (c.tid < 384) { const int v = c.tid >> 7, jj = c.tid & 127; float s = INP(I_BMOD)[l * NMOD + cb * 128 + jj];
#pragma unroll
        for (int g = 0; g < 16; ++g) s += red[(g * 3 + v) * 128 + jj];
        ((float*)(c.ws + WS_MOD))[((size_t)l * 3 + v) * NMOD + cb * 128 + jj] = s; }
    __syncthreads();
}

__device__ __forceinline__ void wsc_unit(const Ctx& c, CAS const unsigned long long* in, int l, int u) {
    const int hh = u >> 4, kb = u & 15, h = hh >> 1, half = hh & 1, k0 = kb * 128;
    LAS float* kkL = (LAS float*)c.lds;
    LAS float* wqL = kkL + 128 * 132;
    const float* ksrc = INP(half ? I_PK2 : I_PK1) + ((size_t)(l * 8 + h) * 128) * 128;
    const float* qsrc = INP(I_PWQ) + (size_t)l * DM * DM + (size_t)k0 * DM + hh * 128;
    for (int i = c.tid; i < 128 * 32; i += NTHREADS) { const int r = i >> 5, c4 = (i & 31) * 4;
        *(LAS f32x4*)(kkL + r * 132 + c4) = *(const f32x4*)(ksrc + (size_t)r * 128 + c4);
        *(LAS f32x4*)(wqL + r * 132 + c4) = *(const f32x4*)(qsrc + (size_t)r * DM + c4); }
    __syncthreads();
    const int k = c.tid & 127, ng = c.tid >> 7;
    float acc[32];
#pragma unroll
    for (int j = 0; j < 32; ++j) acc[j] = 0.f;
    for (int d4 = 0; d4 < 32; ++d4) {
        const f32x4 a = *(const LAS f32x4*)(wqL + k * 132 + d4 * 4);
#pragma unroll
        for (int j = 0; j < 32; ++j) { const f32x4 b = *(const LAS f32x4*)(kkL + (ng * 32 + j) * 132 + d4 * 4); acc[j] += (a[0] * b[0] + a[1] * b[1]) + (a[2] * b[2] + a[3] * b[3]); }
    }
    bf16_t* dst = (bf16_t*)(c.ws + WS_WSC) + (size_t)(hh * 128 + ng * 32) * DM + k0 + k;
#pragma unroll
    for (int j = 0; j < 32; ++j) dst[(size_t)j * DM] = f2bf(acc[j]);
    __syncthreads();
}

#define GET_IN() unsigned long long kai_ = (unsigned long long)__builtin_amdgcn_kernarg_segment_ptr(); asm volatile("" : "+s"(kai_)); CAS const unsigned long long* in = (CAS const unsigned long long*)kai_
__device__ __forceinline__ void conv_units(const Ctx& c, int l) {
    GET_IN();
    if (l == 0) for (int u = c.wg; u < 2 * 96; u += c.G) mod_unit(c, in, u / 96, u % 96);
    for (int u = c.wg; u < 256; u += c.G) wsc_unit(c, in, l, u);
}
__device__ __forceinline__ void conv_transposes(const Ctx& c, int l) {
    GET_IN();
    const int gw = c.wg * NWAVES + c.wave, NGW = c.G * NWAVES;
    LAS float* scr = (LAS float*)(c.lds + c.wave * 16640);
    constexpr int I_IN = (DM / 64) * (NIN / 64), I_SQ = (DM / 64) * (DM / 64);
    const float* win = INP(I_WIN) + (size_t)l * DM * NIN;
    for (int it = gw; it < I_IN; it += NGW) transpose_item(win, DM, NIN, (bf16_t*)(c.ws + WS_WIN), scr, it, c.lane);
    for (int s = 0; s < 4; ++s) {
        const float* src = INP(s == 0 ? I_WOA : s == 1 ? I_WOL : s == 2 ? I_WOS : I_WOUT) + (size_t)l * DM * DM;
        bf16_t* dst = s < 3 ? (bf16_t*)(c.ws + WS_WO) + (size_t)s * DM * DM : (bf16_t*)(c.ws + WS_WOUT);
        for (int it = gw; it < I_SQ; it += NGW) transpose_item(src, DM, DM, dst, scr, it, c.lane);
    }
}
__device__ __forceinline__ void conv_tables(const Ctx& c, int l) {
    GET_IN();
    const size_t gt = (size_t)c.wg * NTHREADS + c.tid, NT = (size_t)c.G * NTHREADS;
    constexpr size_t NG16 = (size_t)16384 * DM / 16;
#pragma unroll 1
    for (int tb = 0; tb < 2; ++tb) {
        const float* srcb = INP(tb ? I_PV : I_PU) + (size_t)l * 16384 * DM; unsigned char* dstb = (unsigned char*)(c.ws + (tb ? WS_PV : WS_PU));
        const float sc = tb ? 1.f : 32.f;
        for (size_t j = gt; j < NG16; j += 2 * NT) {
            const size_t j2 = j + NT; const bool has2 = j2 < NG16;
            f32x4 a[4], b[4];
#pragma unroll
            for (int d = 0; d < 4; ++d) a[d] = *(const f32x4*)(srcb + j * 16 + d * 4);
#pragma unroll
            for (int d = 0; d < 4; ++d) b[d] = has2 ? *(const f32x4*)(srcb + j2 * 16 + d * 4) : (f32x4){0.f, 0.f, 0.f, 0.f};
            u32x4 o, o2;
#pragma unroll
            for (int d = 0; d < 4; ++d) { const f32x4 x = a[d] * sc, y = b[d] * sc;
                int w = __builtin_amdgcn_cvt_pk_fp8_f32(x[0], x[1], 0, false); w = __builtin_amdgcn_cvt_pk_fp8_f32(x[2], x[3], w, true); o[d] = (unsigned)w;
                int w2 = __builtin_amdgcn_cvt_pk_fp8_f32(y[0], y[1], 0, false); w2 = __builtin_amdgcn_cvt_pk_fp8_f32(y[2], y[3], w2, true); o2[d] = (unsigned)w2; }
            if (tb == 0) { *(u32x4*)(dstb + j * 16) = o; if (has2) *(u32x4*)(dstb + j2 * 16) = o2; }
            else {
                *(u32x4*)(dstb + (size_t)((j & 127) >> 3) * ((size_t)16384 * 128) + (j >> 7) * 128 + (j & 7) * 16) = o;
                if (has2) *(u32x4*)(dstb + (size_t)((j2 & 127) >> 3) * ((size_t)16384 * 128) + (j2 >> 7) * 128 + (j2 & 7) * 16) = o2; } }
    }
    for (size_t i = gt; i < (size_t)16 * 512 * 128; i += NT) { const int ci = (int)(i & 127), j = (int)((i >> 7) & 511), n = (int)(i >> 16), d = j >> 8, which = (j >> 7) & 1, dd = j & 127;
        const float* src = INP(which ? I_LWX : I_LWA) + ((((size_t)(l * 2 + d) * 16 + n) * 128 + ci) * 128 + dd);
        ((bf16_t*)(c.ws + WS_WLRU))[i] = f2bf(*src); }
}
__device__ __forceinline__ void sp_copy(const Ctx& c, const float* src, int sp_off, int n) {
    const size_t gt = (size_t)c.wg * NTHREADS + c.tid, NT = (size_t)c.G * NTHREADS;
    for (size_t i = gt; i < (size_t)n; i += NT) ((float*)(c.ws + WS_SP))[sp_off + i] = src[i];
}
__device__ __forceinline__ void conv_small(const Ctx& c, int l) {
    GET_IN();
    const size_t gt = (size_t)c.wg * NTHREADS + c.tid, NT = (size_t)c.G * NTHREADS;
    sp_copy(c, INP(I_NMIX) + l * DM, SP_NMIX, DM); sp_copy(c, INP(I_NFFN) + l * DM, SP_NFFN, DM);
    sp_copy(c, INP(I_QN) + l * 128, SP_QN, 128); sp_copy(c, INP(I_KN) + l * 128, SP_KN, 128);
    sp_copy(c, INP(I_LCW) + l * 4 * DM, SP_LCW, 4 * DM); sp_copy(c, INP(I_LCB) + l * DM, SP_LCB, DM);
    sp_copy(c, INP(I_LBA) + l * 2 * DM, SP_LBA, 2 * DM); sp_copy(c, INP(I_LBX) + l * 2 * DM, SP_LBX, 2 * DM);
    sp_copy(c, INP(I_SCW) + l * 3 * DM, SP_SCW, 3 * DM); sp_copy(c, INP(I_SCB) + l * DM, SP_SCB, DM);
    { const float* lam = INP(I_LLAM) + l * 2 * DM;
      for (size_t i = gt; i < (size_t)2 * DM; i += NT) ((float*)(c.ws + WS_SP))[SP_LSP + i] = 8.f * log1pf(expf(-lam[i])); }
}
__device__ __forceinline__ void conv_once(const Ctx& c) {
    GET_IN();
    const size_t gt = (size_t)c.wg * NTHREADS + c.tid, NT = (size_t)c.G * NTHREADS;
    for (size_t i = gt; i < 128 * 32; i += NT) { const int pos = (int)(i >> 5), p = (int)(i & 31);
        const float inv = exp2f(-(float)p * (13.287712379549449f / 32.f)); const float ang = (float)pos * inv;
        float sn, cs; sincosf(ang, &sn, &cs);
        ((float*)(c.ws + WS_ROPE))[i] = cs; ((float*)(c.ws + WS_ROPE))[128 * 32 + i] = sn; }
    { const f32x4* xs = (const f32x4*)INP(I_X); for (size_t i = gt; i < (size_t)MLAT * DM / 4; i += NT) ((f32x4*)c.out)[i] = xs[i]; }
    { const f32x4* cs_ = (const f32x4*)INP(I_CTX); for (size_t i = gt; i < (size_t)MCTX * DM / 4; i += NT) ((f32x4*)(c.ws + WS_CTXS))[i] = cs_[i]; }
}

__device__ __forceinline__ void phase_norm(const Ctx& c, int l, int nrows, int sp_gain, int slot_shift) {
    const int gw = c.wg * NWAVES + c.wave, NGW = c.G * NWAVES;
    const float* modl = (const float*)(c.ws + WS_MOD) + (size_t)l * 3 * NMOD;
    bf16_t* HX = (bf16_t*)(c.ws + WS_HX); const float* gain = (const float*)(c.ws + WS_SP) + sp_gain;
    for (int r = gw; r < nrows; r += NGW) {
        const int vec = r < SEQ ? 0 : (r < MLAT ? 1 : 2);
        const float* xr = xrow_ptr(c, r); const float* sh = modl + (size_t)vec * NMOD + slot_shift * DM; const float* sc = sh + DM;
        f32x4 v[8]; float ss = 0.f;
#pragma unroll
        for (int j = 0; j < 8; ++j) { v[j] = *(const f32x4*)(xr + j * 256 + c.lane * 4); ss += (v[j][0] * v[j][0] + v[j][1] * v[j][1]) + (v[j][2] * v[j][2] + v[j][3] * v[j][3]); }
        const float rs = rsqrtf(wave_sum(ss) * (1.f / DM) + EPS);
#pragma unroll
        for (int j = 0; j < 8; ++j) { const int col = j * 256 + c.lane * 4;
            const f32x4 g = *(const f32x4*)(gain + col), s1 = *(const f32x4*)(sc + col), s0 = *(const f32x4*)(sh + col);
            const f32x4 y = (v[j] * rs * g) * (s1 + 1.f) + s0;
            u32x2 o; o.x = cvt_pk_bf16(y[0], y[1]); o.y = cvt_pk_bf16(y[2], y[3]);
            *(u32x2*)(HX + (size_t)r * DM + col) = o; }
    }
}
__device__ __forceinline__ void seg_of_row(int r, bool& is_ctx, int& b, int& t) {
    is_ctx = r >= MLAT; b = is_ctx ? (r - MLAT) >> 8 : r >> 13; t = is_ctx ? (r - MLAT) & 255 : r & (SEQ - 1);
}
__device__ __forceinline__ void qk_row(const Ctx& c, int l, int r, bool do_q, bool dry) {
    bool is_ctx; int b, t; seg_of_row(r, is_ctx, b, t);
    const int key = is_ctx ? t : CTXL + t;
    bf16_t* prow = (bf16_t*)(c.ws + WS_P) + (size_t)r * NIN;
    bf16_t* KC = (bf16_t*)(c.ws + WS_KC); bf16_t* VC = (bf16_t*)(c.ws + WS_VC);
    const int hs = c.lane >> 4, ax = (c.lane >> 3) & 1, p0 = (c.lane & 7) * 4;
    f32x4 cs = {1.f, 1.f, 1.f, 1.f}, sn = {0.f, 0.f, 0.f, 0.f};
    if (!is_ctx) { const int pos = ax ? (t & 63) : (t >> 6); const float* rt = (const float*)(c.ws + WS_ROPE) + pos * 32 + p0; cs = *(const f32x4*)rt; sn = *(const f32x4*)(rt + 128 * 32); }
    u32x2 w1[5], w2[5];
#pragma unroll
    for (int g = 0; g < 5; ++g) { const bool is_k = (g == 4); const int head = is_k ? hs : g * 4 + hs;
        const bf16_t* src = prow + (is_k ? CK : CQ) + head * 128 + ax * 64 + p0;
        if (is_k || do_q) { w1[g] = *(const u32x2*)src; w2[g] = *(const u32x2*)(src + 32); } else { w1[g] = (u32x2){0u, 0u}; w2[g] = (u32x2){0u, 0u}; } }
    const u32x4 vw = *(const u32x4*)(prow + CV + (c.lane >> 4) * 128 + (c.lane & 15) * 8);
#pragma unroll
    for (int g = 0; g < 5; ++g) {
        const bool is_k = (g == 4);
        if (!is_k && !do_q) continue;
        const int head = is_k ? hs : g * 4 + hs;
        bf16_t* src = prow + (is_k ? CK : CQ) + head * 128 + ax * 64 + p0;
        f32x4 t1 = {bf_lo(w1[g].x), bf_hi(w1[g].x), bf_lo(w1[g].y), bf_hi(w1[g].y)}, t2 = {bf_lo(w2[g].x), bf_hi(w2[g].x), bf_lo(w2[g].y), bf_hi(w2[g].y)};
        float ss = (t1[0] * t1[0] + t1[1] * t1[1]) + (t1[2] * t1[2] + t1[3] * t1[3]) + (t2[0] * t2[0] + t2[1] * t2[1]) + (t2[2] * t2[2] + t2[3] * t2[3]);
        ss += DPPF(ss, 0xB1); ss += DPPF(ss, 0x4E); ss += DPPF(ss, 0x141); ss += DPPF(ss, 0x140);
        const float rs = rsqrtf(ss * (1.f / 128.f) + EPS);
        const float* gn = (const float*)(c.ws + WS_SP) + (is_k ? SP_KN : SP_QN) + ax * 64 + p0;
        const f32x4 g1 = *(const f32x4*)gn, g2 = *(const f32x4*)(gn + 32);
        const f32x4 y1 = t1 * rs * g1, y2 = t2 * rs * g2;
        const f32x4 o1 = y1 * cs - y2 * sn, o2 = y2 * cs + y1 * sn;
        bf16_t* dst = is_k ? KC + ((size_t)(b * 4 + head) * NKEY + key) * 128 + ax * 64 + p0 : (dry ? (bf16_t*)(c.ws + WS_YF) + (size_t)r * DM + head * 128 + ax * 64 + p0 : src);
        u32x2 a; a.x = cvt_pk_bf16(o1[0], o1[1]); a.y = cvt_pk_bf16(o1[2], o1[3]);
        u32x2 bq; bq.x = cvt_pk_bf16(o2[0], o2[1]); bq.y = cvt_pk_bf16(o2[2], o2[3]);
        *(u32x2*)dst = a; *(u32x2*)(dst + 32) = bq;
    }
    { const int hv = c.lane >> 4, dd = (c.lane & 15) * 8;
      *(u32x4*)(VC + ((size_t)(b * 4 + hv) * NKEY + key) * 128 + dd) = vw; }
}
__device__ __forceinline__ void unpack8(const u32x4 w, float (&f)[8]) {
    f[0] = bf_lo(w.x); f[1] = bf_hi(w.x); f[2] = bf_lo(w.y); f[3] = bf_hi(w.y); f[4] = bf_lo(w.z); f[5] = bf_hi(w.z); f[6] = bf_lo(w.w); f[7] = bf_hi(w.w);
}
__device__ __forceinline__ void sc_row(const Ctx& c, int l, int r, bool dry) {
    bool is_ctx; int b, t; seg_of_row(r, is_ctx, b, t);
    const int seglen = is_ctx ? CTXL : SEQ;
    bf16_t* prow = (bf16_t*)(c.ws + WS_P) + (size_t)r * NIN;
    const bool hp = t > 0, hn = t < seglen - 1;
    const float* w = (const float*)(c.ws + WS_SP) + SP_SCW; const float* bias = (const float*)(c.ws + WS_SP) + SP_SCB;
    u32x4 xb[4], xc0[4], xu0[4], xcp[4], xup[4], xcn[4], xun[4];
    const u32x4 z = {0u, 0u, 0u, 0u};
#pragma unroll
    for (int it = 0; it < 4; ++it) { const int col = it * 512 + c.lane * 8;
        xb[it] = *(const u32x4*)(prow + CBG + col); xc0[it] = *(const u32x4*)(prow + CCG + col); xu0[it] = *(const u32x4*)(prow + CU + col);
        xcp[it] = hp ? *(const u32x4*)(prow - NIN + CCG + col) : z; xup[it] = hp ? *(const u32x4*)(prow - NIN + CU + col) : z;
        xcn[it] = hn ? *(const u32x4*)(prow + NIN + CCG + col) : z; xun[it] = hn ? *(const u32x4*)(prow + NIN + CU + col) : z; }
#pragma unroll
    for (int it = 0; it < 4; ++it) {
        const int col = it * 512 + c.lane * 8;
        float bg[8], c0[8], u0[8], cp[8], up[8], cn[8], un[8];
        unpack8(xb[it], bg); unpack8(xc0[it], c0); unpack8(xu0[it], u0); unpack8(xcp[it], cp); unpack8(xup[it], up); unpack8(xcn[it], cn); unpack8(xun[it], un);
        float o[8];
#pragma unroll
        for (int hq = 0; hq < 2; ++hq) { const f32x4 w0 = *(const f32x4*)(w + col + hq * 4), w1 = *(const f32x4*)(w + DM + col + hq * 4), w2 = *(const f32x4*)(w + 2 * DM + col + hq * 4), bi = *(const f32x4*)(bias + col + hq * 4);
#pragma unroll
            for (int e = 0; e < 4; ++e) { const int k = hq * 4 + e; o[k] = bg[k] * (bi[e] + w0[e] * (cp[k] * up[k]) + w1[e] * (c0[k] * u0[k]) + w2[e] * (cn[k] * un[k])); } }
        u32x4 ow; ow.x = cvt_pk_bf16(o[0], o[1]); ow.y = cvt_pk_bf16(o[2], o[3]); ow.z = cvt_pk_bf16(o[4], o[5]); ow.w = cvt_pk_bf16(o[6], o[7]);
        *(u32x4*)((dry ? (bf16_t*)(c.ws + WS_YF) + (size_t)(MALL + r) * DM : prow + CBG) + col) = ow;
    }
}

constexpr size_t lsum_idx(int which, int dir, int b, int j) { return ((((size_t)which * 2 + dir) * NB + b) * NCHUNK + j) * DM; }
template <int DIR, int PASS>
__device__ __forceinline__ void lru_chunk(const LAS bf16_t* ub, const LAS float* uf, LAS float* hsd, const bf16x8 (&bfr)[4][4], const float (&ba)[2], const float (&bx)[2], const float (&sp8)[2],
                                          const float (&cin)[2], float (&Atot)[2], float (&Hend)[2], int q, int col16, int quad) {
    float st[2] = {cin[0], cin[1]}, at[2] = {1.f, 1.f};
    const int mysg = DIR ? 3 - quad : quad;
    for (int smt = 0; smt < 4; ++smt) {
        const int mt = DIR ? 3 - smt : smt;
        f32x4 acc[4];
#pragma unroll
        for (int nt = 0; nt < 4; ++nt) acc[nt] = (f32x4){0.f, 0.f, 0.f, 0.f};
#pragma unroll
        for (int ks = 0; ks < 4; ++ks) { const bf16x8 a = *(const LAS bf16x8*)(ub + (mt * 16 + col16) * 136 + ks * 32 + quad * 8);
#pragma unroll
            for (int nt = 0; nt < 4; ++nt) acc[nt] = __builtin_amdgcn_mfma_f32_16x16x32_bf16(a, bfr[nt][ks], acc[nt], 0, 0, 0); }
#pragma unroll
        for (int ct = 0; ct < 2; ++ct) {
            const int ch = q * 32 + ct * 16 + col16;
            float av[4], dv[4];
#pragma unroll
            for (int reg = 0; reg < 4; ++reg) { const int tl = mt * 16 + quad * 4 + reg;
                const float r = sigmoidf_(acc[ct][reg] + ba[ct]), ig = sigmoidf_(acc[2 + ct][reg] + bx[ct]);
                const float a = __expf(-sp8[ct] * r);
                av[reg] = a; dv[reg] = __builtin_amdgcn_sqrtf(fmaxf(1.f - a * a, 0.f)) * ig * uf[tl * 128 + ch]; }
            float Al = 1.f, Hl = 0.f;
#pragma unroll
            for (int sr = 0; sr < 4; ++sr) { const int reg = DIR ? 3 - sr : sr; Hl = av[reg] * Hl + dv[reg]; Al *= av[reg]; }
            float se = st[ct], so = st[ct], ap = 1.f;
#pragma unroll
            for (int sg = 0; sg < 4; ++sg) { const int qp = DIR ? 3 - sg : sg; const float Ag = __shfl(Al, col16 + 16 * qp), Hg = __shfl(Hl, col16 + 16 * qp);
                const float nx = Ag * so + Hg; so = nx; if (sg < mysg) se = nx; ap *= Ag; }
            if (PASS == 2) { float h = se;
#pragma unroll
                for (int sr = 0; sr < 4; ++sr) { const int reg = DIR ? 3 - sr : sr; h = av[reg] * h + dv[reg]; hsd[(mt * 16 + quad * 4 + reg) * 128 + ch] = h; } }
            else at[ct] *= ap;
            st[ct] = so;
        }
    }
    Atot[0] = at[0]; Atot[1] = at[1]; Hend[0] = st[0]; Hend[1] = st[1];
}

template <int PASS>
__device__ __forceinline__ void lru_run(const Ctx& c, int l, int unit, bool dry = false) {
    const int b = unit >> 7, n = (unit >> 3) & 15, run = unit & 7;
    const int c0 = run * 16 + (run < 4 ? run : 4), len = 16 + (run < 4 ? 1 : 0);
    LAS float* xl = (LAS float*)c.lds;
    LAS float* uf = (LAS float*)(c.lds + 34816);
    LAS bf16_t* ub = (LAS bf16_t*)(c.lds + 34816 + 32768);
    LAS float* car = (LAS float*)(c.lds + 34816 + 32768 + 17408);
    LAS float* hsr = (LAS float*)(c.lds + 34816 + 32768 + 17408 + 17408);
    const int d = c.wave >> 2, q = c.wave & 3, col16 = c.lane & 15, quad = c.lane >> 4;
    float* LS = (float*)(c.ws + WS_LSUM);
    bf16_t* P = (bf16_t*)(c.ws + WS_P);
    bf16x8 bfr[4][4];
#pragma unroll
    for (int nt = 0; nt < 4; ++nt) { const int j = d * 256 + (nt >> 1) * 128 + q * 32 + (nt & 1) * 16 + col16;
#pragma unroll
        for (int ks = 0; ks < 4; ++ks) bfr[nt][ks] = *(const bf16x8*)((const bf16_t*)(c.ws + WS_WLRU) + ((size_t)(n * 512 + j) * 128 + ks * 32 + quad * 8)); }
    float ba[2], bx[2], sp8[2];
#pragma unroll
    for (int ct = 0; ct < 2; ++ct) { const int cidx = n * 128 + q * 32 + ct * 16 + col16; const float* sp = (const float*)(c.ws + WS_SP) + d * DM + cidx;
        ba[ct] = sp[SP_LBA]; bx[ct] = sp[SP_LBX]; sp8[ct] = sp[SP_LSP]; }
    if (PASS == 2) {
        if (c.tid < 256) { const int dir = c.tid >> 7, ch = c.tid & 127, cidx = n * 128 + ch; float st = 0.f;
#pragma unroll 1
            for (int k0 = 0; k0 < NCHUNK; k0 += 12) {
                float av[12], hv[12];
#pragma unroll
                for (int kk = 0; kk < 12; ++kk) { const int k = k0 + kk, j = dir ? (k < 4 ? 3 - k : 135 - k) : k; av[kk] = LS[lsum_idx(0, dir, b, j) + cidx]; hv[kk] = LS[lsum_idx(1, dir, b, j) + cidx]; }
#pragma unroll
                for (int kk = 0; kk < 12; ++kk) { const int k = k0 + kk, j = dir ? (k < 4 ? 3 - k : 135 - k) : k;
                    if (j >= c0 && j < c0 + len) car[(dir * 17 + (j - c0)) * 128 + ch] = st;
                    st = av[kk] * st + hv[kk]; } } }
        __syncthreads();
    }
    const float* cw = (const float*)(c.ws + WS_SP) + SP_LCW + n * 128; const float* cb = (const float*)(c.ws + WS_SP) + SP_LCB + n * 128;
#define LRU_GEOM(ci_, jc, is_ctx, rb, t0, seglen) const int jc = c0 + (ci_); const bool is_ctx = jc < 4; \
        const int rb = is_ctx ? MLAT + b * CTXL : b * SEQ, t0 = is_ctx ? jc * 64 : (jc - 4) * 64, seglen = is_ctx ? CTXL : SEQ
#define LRU_LOAD(ci_, XR, LG) do { LRU_GEOM(ci_, jc_, ic_, rb_, t0_, sl_); (void)ic_; \
        _Pragma("unroll") for (int ps = 0; ps < 3; ++ps) { const int i = ps * 32 + (c.tid >> 4); const int t = t0_ - 2 + i; XR[ps] = (u32x4){0u, 0u, 0u, 0u}; \
            if (i < 68 && t >= 0 && t < sl_) XR[ps] = *(const u32x4*)(P + (size_t)(rb_ + t) * NIN + CLX + n * 128 + (c.tid & 15) * 8); } \
        if (PASS == 2) { const bf16_t* gp_ = P + (size_t)(rb_ + t0_ + (c.tid >> 3)) * NIN + CLG + n * 128 + (c.tid & 7) * 16; LG[0] = *(const u32x4*)gp_; LG[1] = *(const u32x4*)(gp_ + 8); } } while (0)
    u32x4 xr[3], lgc[2] = {{0u, 0u, 0u, 0u}, {0u, 0u, 0u, 0u}}, lgn[2] = {{0u, 0u, 0u, 0u}, {0u, 0u, 0u, 0u}};
    LRU_LOAD(0, xr, lgn);
    for (int ci = 0; ci < len; ++ci) {
        LRU_GEOM(ci, jc, is_ctx, rb, t0, seglen); (void)is_ctx; (void)seglen;
#pragma unroll
        for (int ps = 0; ps < 3; ++ps) { const int i = ps * 32 + (c.tid >> 4);
            if (i < 68) { float f[8]; unpack8(xr[ps], f);
                *(LAS f32x4*)(xl + i * 128 + (c.tid & 15) * 8) = (f32x4){f[0], f[1], f[2], f[3]}; *(LAS f32x4*)(xl + i * 128 + (c.tid & 15) * 8 + 4) = (f32x4){f[4], f[5], f[6], f[7]}; } }
        lgc[0] = lgn[0]; lgc[1] = lgn[1];
        __syncthreads();
        if (ci + 1 < len) LRU_LOAD(ci + 1, xr, lgn);
        { const int ch = c.tid & 127, tq = c.tid >> 7; const float w0 = cw[ch], w1 = cw[DM + ch], w2 = cw[2 * DM + ch], w3 = cw[3 * DM + ch], bb = cb[ch];
#pragma unroll 4
          for (int tt = 0; tt < 16; ++tt) { const int tl = tq * 16 + tt;
              const float u = bb + w0 * xl[tl * 128 + ch] + w1 * xl[(tl + 1) * 128 + ch] + w2 * xl[(tl + 2) * 128 + ch] + w3 * xl[(tl + 3) * 128 + ch];
              uf[tl * 128 + ch] = u; ub[tl * 136 + ch] = f2bf(u); } }
        __syncthreads();
        float cin[2] = {0.f, 0.f}, At[2], He[2];
        if (PASS == 2) { cin[0] = car[(d * 17 + ci) * 128 + q * 32 + col16]; cin[1] = car[(d * 17 + ci) * 128 + q * 32 + 16 + col16]; }
        if (d == 0) lru_chunk<0, PASS>(ub, uf, xl, bfr, ba, bx, sp8, cin, At, He, q, col16, quad);
        else lru_chunk<1, PASS>(ub, uf, hsr, bfr, ba, bx, sp8, cin, At, He, q, col16, quad);
        if (PASS == 1) {
            if (quad == 0) {
#pragma unroll
                for (int ct = 0; ct < 2; ++ct) { const int cidx = n * 128 + q * 32 + ct * 16 + col16;
                    LS[lsum_idx(0, d, b, jc) + cidx] = At[ct]; LS[lsum_idx(1, d, b, jc) + cidx] = He[ct]; } }
            __syncthreads();
        } else {
            __syncthreads();
            { const int row = c.tid >> 3, cs = (c.tid & 7) * 16;
              bf16_t* gp = P + (size_t)(rb + t0 + row) * NIN + CLG + n * 128 + cs;
#pragma unroll
              for (int hseg = 0; hseg < 2; ++hseg) { float g[8]; unpack8(lgc[hseg], g);
                  const int o = row * 128 + cs + hseg * 8;
                  const f32x4 h0 = *(const LAS f32x4*)(xl + o) + *(const LAS f32x4*)(hsr + o), h1 = *(const LAS f32x4*)(xl + o + 4) + *(const LAS f32x4*)(hsr + o + 4);
                  u32x4 ow; ow.x = cvt_pk_bf16(h0[0] * gelu_tanh(g[0]), h0[1] * gelu_tanh(g[1])); ow.y = cvt_pk_bf16(h0[2] * gelu_tanh(g[2]), h0[3] * gelu_tanh(g[3]));
                  ow.z = cvt_pk_bf16(h1[0] * gelu_tanh(g[4]), h1[1] * gelu_tanh(g[5])); ow.w = cvt_pk_bf16(h1[2] * gelu_tanh(g[6]), h1[3] * gelu_tanh(g[7]));
                  *(u32x4*)((dry ? gp - CLG + CU : gp) + hseg * 8) = ow; } }
            __syncthreads();
        }
    }
#undef LRU_GEOM
#undef LRU_LOAD
}

__device__ __forceinline__ void phase_qk(const Ctx& c, int l, bool dry = false) {
    const int gw = c.wg * NWAVES + c.wave, NGW = c.G * NWAVES;
    for (int r = gw; r < MALL; r += NGW) qk_row(c, l, r, l == 0 || r < MLAT, dry);
}
__device__ __forceinline__ void phase_sc(const Ctx& c, int l, bool dry = false) {
    const int gw = c.wg * NWAVES + c.wave, NGW = c.G * NWAVES;
    const int nsc = (l == 0) ? MALL : MLAT;
    for (int r = gw; r < nsc; r += NGW) sc_row(c, l, r, dry);
}
__device__ __forceinline__ void phase_lru1(const Ctx& c, int l) {
    for (int u = c.wg; u < 256; u += c.G) lru_run<1>(c, l, u);
}

__device__ __forceinline__ void phase_m2(const Ctx& c, int l, bool dry = false) {
    bf16_t* P = (bf16_t*)(c.ws + WS_P); const bf16_t* KC = (const bf16_t*)(c.ws + WS_KC); const bf16_t* VC = (const bf16_t*)(c.ws + WS_VC);
    const int ntot = 1024 + (l == 0 ? 32 : 0);
    for (int i = 0; i * c.G + c.wg < ntot; ++i) {
        const int L = i * c.G + c.wg; int b, h, seq; size_t qrow;
        if (L < 1024) { int grp, qb;
            if (c.G == 256) { grp = i * 8 + (c.wg & 7); qb = c.wg >> 3; } else { grp = L >> 5; qb = L & 31; }
            b = grp >> 4; h = grp & 15; qrow = (size_t)(b * SEQ + qb * 256); seq = NKEY; }
        else { const int u = L - 1024; b = u >> 4; h = u & 15; qrow = (size_t)(MLAT + b * CTXL); seq = CTXL; }
        bf16_t* q = P + qrow * NIN + CQ + h * 128;
        const size_t kvo = (size_t)(b * 4 + (h >> 2)) * NKEY * 128;
        att::attn_dense_body(q, KC + kvo, VC + kvo, dry ? q - CQ + CCG : q, seq, (char*)c.lds);
    }
}
__device__ __forceinline__ void phase_lru2(const Ctx& c, int l, bool dry = false) {
    for (int u = c.wg; u < 256; u += c.G) lru_run<2>(c, l, u, dry);
}
constexpr float NEGBIG = -3.0e38f;
constexpr float PU_SCALE = 32.f;
__device__ __forceinline__ float wave_max_dpp(float v) {
    v = fmaxf(v, DPPF(v, 0xB1)); v = fmaxf(v, DPPF(v, 0x4E)); v = fmaxf(v, DPPF(v, 0x141)); v = fmaxf(v, DPPF(v, 0x140));
    const float a = __int_as_float(__builtin_amdgcn_readlane(__float_as_int(v), 0)), b = __int_as_float(__builtin_amdgcn_readlane(__float_as_int(v), 16));
    const float c = __int_as_float(__builtin_amdgcn_readlane(__float_as_int(v), 32)), d = __int_as_float(__builtin_amdgcn_readlane(__float_as_int(v), 48));
    return fmaxf(fmaxf(a, b), fmaxf(c, d));
}
#define SWZ_XOR(v, m) __int_as_float(__builtin_amdgcn_ds_swizzle(__float_as_int(v), ((m) << 10) | 0x1F))
__device__ __forceinline__ unsigned fkey(float x) { const unsigned u = __float_as_uint(x); return (u & 0x80000000u) ? ~u : (u | 0x80000000u); }
#define DPPU(v, ctrl) ((unsigned)__builtin_amdgcn_update_dpp(0, (int)(v), ctrl, 0xF, 0xF, true))
__device__ __forceinline__ unsigned wave_max_u32(unsigned v) {
    v = max(v, DPPU(v, 0xB1)); v = max(v, DPPU(v, 0x4E)); v = max(v, DPPU(v, 0x141)); v = max(v, DPPU(v, 0x140));
    const unsigned a = (unsigned)__builtin_amdgcn_readlane((int)v, 0), b = (unsigned)__builtin_amdgcn_readlane((int)v, 16), c = (unsigned)__builtin_amdgcn_readlane((int)v, 32), d = (unsigned)__builtin_amdgcn_readlane((int)v, 48);
    return max(max(a, b), max(c, d));
}
__device__ __forceinline__ unsigned topk16_keys2(unsigned k0, unsigned k1, int lane) {
    unsigned res = 0u;
    for (int it = 0; it < 16; ++it) { const unsigned m = wave_max_u32(max(k0, k1)); k0 = (k0 == m) ? 0u : k0; k1 = (k1 == m) ? 0u : k1; res = (lane == it) ? m : res; }
    return res;
}
__device__ __forceinline__ unsigned topk16_keys1(unsigned k0, int lane) {
    unsigned res = 0u;
    for (int it = 0; it < 16; ++it) { const unsigned m = wave_max_u32(k0); k0 = (k0 == m) ? 0u : k0; res = (lane == it) ? m : res; }
    return res;
}
__device__ __forceinline__ void unpack_fp8x16(const u32x4 w, float (&f)[16]) {
#pragma unroll
    for (int d = 0; d < 4; ++d) { const f32x2 lo = __builtin_amdgcn_cvt_pk_f32_fp8((int)w[d], false), hi = __builtin_amdgcn_cvt_pk_f32_fp8((int)w[d], true);
        f[4 * d] = lo.x; f[4 * d + 1] = lo.y; f[4 * d + 2] = hi.x; f[4 * d + 3] = hi.y; }
}

__device__ __forceinline__ unsigned half_max_u32(unsigned v, bool hi_half) {
    v = max(v, DPPU(v, 0xB1)); v = max(v, DPPU(v, 0x4E)); v = max(v, DPPU(v, 0x141)); v = max(v, DPPU(v, 0x140));
    const unsigned a = max((unsigned)__builtin_amdgcn_readlane((int)v, 0), (unsigned)__builtin_amdgcn_readlane((int)v, 16));
    const unsigned b = max((unsigned)__builtin_amdgcn_readlane((int)v, 32), (unsigned)__builtin_amdgcn_readlane((int)v, 48));
    return hi_half ? b : a;
}
__device__ __forceinline__ unsigned topk16_half4(unsigned (&k)[4], int hl, bool hi_half) {
    unsigned res = 0u;
    for (int it = 0; it < 16; ++it) { const unsigned m = half_max_u32(max(max(k[0], k[1]), max(k[2], k[3])), hi_half);
#pragma unroll
        for (int j = 0; j < 4; ++j) k[j] = (k[j] == m) ? 0u : k[j];
        res = (hl == it) ? m : res; }
    return res;
}
__device__ __forceinline__ unsigned topk16_half2(unsigned k0, unsigned k1, int hl, bool hi_half) {
    unsigned res = 0u;
    for (int it = 0; it < 16; ++it) { const unsigned m = half_max_u32(max(k0, k1), hi_half); k0 = (k0 == m) ? 0u : k0; k1 = (k1 == m) ? 0u : k1; res = (hl == it) ? m : res; }
    return res;
}
__device__ __forceinline__ void cand_ab(int cidx50, int& a, int& b) {
    a = cidx50 < 16 ? 0 : cidx50 < 24 ? 1 : cidx50 < 29 ? 2 : cidx50 < 33 ? 3 : cidx50 < 36 ? 4 : cidx50 < 38 ? 5 : cidx50 < 40 ? 6 : cidx50 < 42 ? 7 : cidx50 - 34;
    const int st = cidx50 < 16 ? 0 : cidx50 < 24 ? 16 : cidx50 < 29 ? 24 : cidx50 < 33 ? 29 : cidx50 < 36 ? 33 : cidx50 < 38 ? 36 : cidx50 < 40 ? 38 : cidx50 < 42 ? 40 : cidx50;
    b = cidx50 - st;
}
__device__ __forceinline__ void peer_topk_pair(const LAS float* srow, int hp, LAS float* gsc, LAS int* isc, int lane) {
    const int hl = lane & 31, hb = lane & 32; const bool hi_half = lane >= 32; const int h = 2 * hp + (hi_half ? 1 : 0);
    const LAS float* sh = srow + h * 256;
    unsigned k1[4], k2[4];
#pragma unroll
    for (int j = 0; j < 4; ++j) { const int idx = hl + 32 * j; k1[j] = (fkey(sh[idx]) & ~127u) | (unsigned)(127 - idx); k2[j] = (fkey(sh[128 + idx]) & ~127u) | (unsigned)(127 - idx); }
    const unsigned r1 = topk16_half4(k1, hl, hi_half), r2 = topk16_half4(k2, hl, hi_half);
    const int i1 = 127 - (int)(r1 & 127u), i2 = 127 - (int)(r2 & 127u);
    const float v1 = sh[i1], v2 = sh[128 + i2];
    int a0, b0, a1, b1; cand_ab(hl, a0, b0); cand_ab(hl + 32, a1, b1);
    const float c0 = __shfl(v1, hb + a0) + __shfl(v2, hb + b0), c1 = __shfl(v1, hb + (a1 & 15)) + __shfl(v2, hb + (b1 & 15));
    const unsigned q0 = (fkey(c0) & ~255u) | (unsigned)(255 - (a0 * 16 + b0)), q1 = (hl + 32 < 50) ? ((fkey(c1) & ~255u) | (unsigned)(255 - (a1 * 16 + b1))) : 0u;
    const unsigned r3 = topk16_half2(q0, q1, hl, hi_half);
    const int ci = 255 - (int)(r3 & 255u);
    const float sc = __shfl(v1, hb + (ci >> 4)) + __shfl(v2, hb + (ci & 15));
    const int e = __shfl(i1, hb + (ci >> 4)) * 128 + __shfl(i2, hb + (ci & 15));
    const float mxa = __int_as_float(__builtin_amdgcn_readlane(__float_as_int(sc), 0)), mxb = __int_as_float(__builtin_amdgcn_readlane(__float_as_int(sc), 32));
    const float ex = hl < 16 ? __expf(sc - (hi_half ? mxb : mxa)) : 0.f;
    float sm = ex; sm += DPPF(sm, 0xB1); sm += DPPF(sm, 0x4E); sm += DPPF(sm, 0x141); sm += DPPF(sm, 0x140);
    if (hl < 16) { gsc[h * 16 + hl] = ex / sm; isc[h * 16 + hl] = e; }
}

constexpr size_t WS_PE_E = WS_P + 160 * MiB, WS_PE_CF = WS_PE_E + (size_t)MALL * 128 * 4;
constexpr int NSL = 16, SLW = 128;
constexpr size_t SLICE_BYTES = (size_t)16384 * SLW;
__device__ __forceinline__ void peer_token(const Ctx& c, int l, int r, int rn, int b, bool dry) {
    LAS float* gsc = (LAS float*)(c.lds + c.wave * 2048 + b * 1024);
    LAS int* isc = (LAS int*)(c.lds + c.wave * 2048 + b * 1024 + 512);
    LAS float* gscn = (LAS float*)(c.lds + c.wave * 2048 + (b ^ 1) * 1024); LAS int* iscn = (LAS int*)(c.lds + c.wave * 2048 + (b ^ 1) * 1024 + 512);
    const float* Sn = (const float*)(c.ws + WS_P) + (size_t)(rn < 0 ? r : rn) * DM;
    const int lane = c.lane;
    LAS float* snb = (LAS float*)(c.lds + 16384 + c.wave * 8192);
    f32x4 sv[8];
#pragma unroll
    for (int q = 0; q < 8; ++q) sv[q] = (rn >= 0) ? *(const f32x4*)(Sn + q * 256 + lane * 4) : (f32x4){0.f, 0.f, 0.f, 0.f};
    LDS_WAIT(); asm volatile("" ::: "memory");
    const bf16_t* hx = (const bf16_t*)(c.ws + WS_HX) + (size_t)r * DM;
    float hv[2][16];
#pragma unroll
    for (int j = 0; j < 2; ++j) { float t0[8], t1[8]; unpack8(*(const u32x4*)(hx + j * 1024 + lane * 16), t0); unpack8(*(const u32x4*)(hx + j * 1024 + lane * 16 + 8), t1);
#pragma unroll
        for (int k = 0; k < 8; ++k) { hv[j][k] = t0[k]; hv[j][8 + k] = t1[k]; } }
    const unsigned char* PU = (const unsigned char*)(c.ws + WS_PU); const unsigned char* PV = (const unsigned char*)(c.ws + WS_PV);
#define PEER_LOADROW(tab, wk, e_) do { const unsigned char* row_ = (tab) + (size_t)__builtin_amdgcn_readfirstlane(e_) * DM + lane * 16; wk[0] = *(const u32x4*)row_; wk[1] = *(const u32x4*)(row_ + 1024); } while (0)
#define PEER_IDX8(dst, i_) const u32x4 ia_##dst = *(const LAS u32x4*)(isc + (i_)), ib_##dst = *(const LAS u32x4*)(isc + (i_) + 4); \
        const int dst[8] = {(int)ia_##dst[0], (int)ia_##dst[1], (int)ia_##dst[2], (int)ia_##dst[3], (int)ib_##dst[0], (int)ib_##dst[1], (int)ib_##dst[2], (int)ib_##dst[3]}
    u32x4 w[8][2];
    { PEER_IDX8(e0, 0);
#pragma unroll
      for (int k = 0; k < 8; ++k) PEER_LOADROW(PU, w[k], e0[k]); }
    if (rn >= 0) {
#pragma unroll
        for (int q = 0; q < 8; ++q) *(LAS f32x4*)(snb + q * 256 + lane * 4) = sv[q];
        LDS_WAIT(); asm volatile("" ::: "memory"); }
#pragma unroll 1
    for (int i = 0; i < 128; i += 8) {
        const bool has_next = i + 8 < 128;
        PEER_IDX8(en, has_next ? i + 8 : i);
        if (rn >= 0 && (i & 24) == 0) peer_topk_pair(snb, i >> 5, gscn, iscn, lane);
        float p[8];
#pragma unroll
        for (int k = 0; k < 8; ++k) {
            asm volatile("" : "+v"(w[k][0]), "+v"(w[k][1]));
            float s = 0.f;
#pragma unroll
            for (int j = 0; j < 2; ++j) { float f[16]; unpack_fp8x16(w[k][j], f);
#pragma unroll
                for (int e2 = 0; e2 < 16; ++e2) s += f[e2] * hv[j][e2]; }
            p[k] = s; asm volatile("" : "+v"(p[k]));
            if (has_next) PEER_LOADROW(PU, w[k], en[k]); }
        const bool b0 = lane & 1, b1 = lane & 2, b2 = lane & 4;
        float q[4], t[2];
#pragma unroll
        for (int m = 0; m < 4; ++m) q[m] = (b0 ? p[2 * m + 1] : p[2 * m]) + DPPF(b0 ? p[2 * m] : p[2 * m + 1], 0xB1);
#pragma unroll
        for (int m = 0; m < 2; ++m) t[m] = (b1 ? q[2 * m + 1] : q[2 * m]) + DPPF(b1 ? q[2 * m] : q[2 * m + 1], 0x4E);
        float s = (b2 ? t[1] : t[0]) + SWZ_XOR(b2 ? t[0] : t[1], 4);
        s += SWZ_XOR(s, 8); s += SWZ_XOR(s, 16); s += __shfl_xor(s, 32);
        if (lane < 8) gsc[i + lane] = gsc[i + lane] * gelu_tanh(s * (1.f / PU_SCALE));
    }
#undef PEER_LOADROW
#undef PEER_IDX8
    LDS_WAIT(); asm volatile("" ::: "memory");
    { int* E = (int*)(c.ws + WS_PE_E) + (size_t)r * 128; float* CF = (float*)(c.ws + WS_PE_CF) + (size_t)r * 128;
      E[lane] = isc[lane]; E[64 + lane] = isc[64 + lane]; CF[lane] = gsc[lane]; CF[64 + lane] = gsc[64 + lane]; }
    LDS_WAIT(); asm volatile("" ::: "memory");
}
__device__ __forceinline__ void phase_peer(const Ctx& c, int l, int nrows, bool dry = false) {
    const int gw = c.wg * NWAVES + c.wave, NGW = c.G * NWAVES;
    int r = gw; if (r >= nrows) return;
    { const float* S0 = (const float*)(c.ws + WS_P) + (size_t)r * DM; LAS float* snb0 = (LAS float*)(c.lds + 16384 + c.wave * 8192);
#pragma unroll
      for (int q = 0; q < 8; ++q) *(LAS f32x4*)(snb0 + q * 256 + c.lane * 4) = *(const f32x4*)(S0 + q * 256 + c.lane * 4);
      LDS_WAIT(); asm volatile("" ::: "memory");
#pragma unroll 1
      for (int hp = 0; hp < 4; ++hp) peer_topk_pair(snb0, hp, (LAS float*)(c.lds + c.wave * 2048), (LAS int*)(c.lds + c.wave * 2048 + 512), c.lane);
      LDS_WAIT(); asm volatile("" ::: "memory"); }
    int b = 0;
#pragma unroll 1
    for (; r < nrows; r += NGW, b ^= 1) { const int rn = r + NGW; peer_token(c, l, r, rn < nrows ? rn : -1, b, dry); }
}
#define PEER_SLICE_BEGIN() { const int grp = c.wg & 7, wi = (c.wg >> 3) * NWAVES + c.wave, nwi = ((c.G - grp + 7) >> 3) * NWAVES; \
    _Pragma("unroll 1") for (int ps = 0; ps < 2; ++ps) { const int s = grp + 8 * ps; _Pragma("unroll 1") for (int r = wi; r < nrows; r += nwi) {
#define PEER_SLICE_END() } } }
__device__ __forceinline__ void phase_peer_v(const Ctx& c, int l, int nrows, bool dry) {
    const int lane = c.lane, rg = lane >> 3, ch = lane & 7;
    const unsigned char* PV = (const unsigned char*)(c.ws + WS_PV);
    const int* Eb = (const int*)(c.ws + WS_PE_E); const float* CF = (const float*)(c.ws + WS_PE_CF);
    PEER_SLICE_BEGIN()
        const int e0 = Eb[(size_t)r * 128 + lane], e1 = Eb[(size_t)r * 128 + 64 + lane];
        const float c0 = CF[(size_t)r * 128 + lane], c1 = CF[(size_t)r * 128 + 64 + lane];
        u32x4 w[16]; float cf[16];
#pragma unroll
        for (int i = 0; i < 16; ++i) { const int k = 8 * i + rg; const int e = __shfl(k < 64 ? e0 : e1, k & 63); cf[i] = __shfl(k < 64 ? c0 : c1, k & 63);
            w[i] = *(const u32x4*)(PV + (size_t)s * SLICE_BYTES + (size_t)e * SLW + ch * 16); }
        float o[16];
#pragma unroll
        for (int j = 0; j < 16; ++j) o[j] = 0.f;
#pragma unroll
        for (int i = 0; i < 16; ++i) {
            asm volatile("" : "+v"(w[i]), "+v"(cf[i]));
            float f[16]; unpack_fp8x16(w[i], f);
#pragma unroll
            for (int j = 0; j < 16; ++j) o[j] += cf[i] * f[j];
            asm volatile("" : "+v"(o[0])); }
        const bool b3 = lane & 8, b4 = lane & 16, b5 = lane & 32;
        float q8[8], q4[4], q2[2];
#pragma unroll
        for (int j = 0; j < 8; ++j) q8[j] = (b3 ? o[8 + j] : o[j]) + DPPF(b3 ? o[j] : o[8 + j], 0x128);
#pragma unroll
        for (int j = 0; j < 4; ++j) q4[j] = (b4 ? q8[4 + j] : q8[j]) + SWZ_XOR(b4 ? q8[j] : q8[4 + j], 16);
#pragma unroll
        for (int j = 0; j < 2; ++j) q2[j] = (b5 ? q4[2 + j] : q4[j]) + __shfl_xor(b5 ? q4[j] : q4[2 + j], 32);
        const int col = s * SLW + ch * 16 + (b3 ? 8 : 0) + (b4 ? 4 : 0) + (b5 ? 2 : 0);
        const int vec = r < SEQ ? 0 : (r < MLAT ? 1 : 2);
        float* xr = (dry ? (float*)(c.ws + WS_YF) + (size_t)r * DM : xrow_ptr(c, r)) + col; const float* g5 = (const float*)(c.ws + WS_MOD) + ((size_t)l * 3 + vec) * NMOD + 5 * DM + col;
        const f32x2 gg = *(const f32x2*)g5; f32x2 xx = *(const f32x2*)xr;
        xx[0] += gg[0] * q2[0]; xx[1] += gg[1] * q2[1];
        *(f32x2*)xr = xx;
    PEER_SLICE_END()
}
struct Args { const float* in[29]; float* out; unsigned char* ws; int ph_lo, ph_hi; };
constexpr int PH_PER_LAYER = 10, N_PHASES = NLAYER * PH_PER_LAYER;
constexpr int CW_BAR = 4096;

__global__ void __launch_bounds__(NTHREADS, 2) mk_fwd(Args args) {
    extern __shared__ __attribute__((aligned(16))) unsigned char lds_raw[];
    Ctx c0;
    c0.out = args.out; c0.ws = args.ws; c0.lds = (LAS unsigned char*)lds_raw;
    c0.tid = threadIdx.x; c0.lane = c0.tid & 63; c0.wave = __builtin_amdgcn_readfirstlane(c0.tid >> 6); c0.wg = blockIdx.x; c0.G = gridDim.x;
    volatile LAS unsigned* MISC = (volatile LAS unsigned*)(c0.lds + MISC_OFF);
    if (c0.tid < 64) MISC[c0.tid] = 0u;
    __syncthreads();
    const int lo = args.ph_lo, hi = args.ph_hi;
    XcdBarrier bar; bar.bar = (unsigned*)(c0.ws + WS_CTL) + CW_BAR; bar.x = 0; bar.st = MISC + 8;
    if (hi - lo > 1) bar = xcd_barrier_post((unsigned*)(c0.ws + WS_CTL) + CW_BAR, MISC + 8);
#ifndef ONLY_PH
#define ONLY_PH -1
#endif
#define IN(k) ((ONLY_PH < 0 || ((k) % PH_PER_LAYER) == ONLY_PH) && lo <= (k) && (k) < hi)
#define PH_BEGIN() Ctx c = c0; unsigned long long wsi_ = (unsigned long long)c0.ws, outi_ = (unsigned long long)c0.out; asm volatile("" : "+s"(wsi_), "+s"(outi_), "+s"(c.wg), "+s"(c.G), "+s"(c.wave), "+v"(c.tid)); \
    c.lane = c.tid & 63; c.ws = (unsigned char*)(GAS unsigned char*)wsi_; c.out = (float*)(GAS float*)outi_;     \
    bf16_t* P = (bf16_t*)(c.ws + WS_P); bf16_t* HX = (bf16_t*)(c.ws + WS_HX); float* YF = (float*)(c.ws + WS_YF); (void)P; (void)HX; (void)YF
#ifndef PROBE_DUP
#define PROBE_DUP -1
#endif
#define REPS(k) for (int rep = 0, dry = (PROBE_DUP == (k)); rep < (PROBE_DUP == (k) ? 2 : 1); ++rep, dry = 0)
#define SEAM(k) do { if (IN(k) && IN((k) + 1)) { xcd_barrier(bar); if (PROBE_DUP == 20) xcd_barrier(bar); } } while (0)
    for (int l = 0; l < NLAYER; ++l) {
        const int pb = l * PH_PER_LAYER;
        const int mrows = (l == 0) ? MALL : MLAT;
        if (IN(pb + 0)) REPS(0) {
            { PH_BEGIN(); conv_units(c, l); } { PH_BEGIN(); conv_transposes(c, l); } { PH_BEGIN(); conv_tables(c, l); } { PH_BEGIN(); conv_small(c, l); }
            if (l == 0) { PH_BEGIN(); conv_once(c); } }
        SEAM(pb + 0);
        if (IN(pb + 1)) REPS(1) { PH_BEGIN(); phase_norm(c, l, MALL, SP_NMIX, 0); }
        SEAM(pb + 1);
        if (IN(pb + 2)) REPS(2) { PH_BEGIN();
            pg8::Gemm g{HX, (const bf16_t*)(c.ws + WS_WIN), MALL, NIN, DM, DM, DM}; pg8::StaticOrder S; S.init(MALL, NIN, c.G, c.wg);
            pg8::EpiBf16 E{P, NIN};
            pg8::gemm_phase<pg8::EpiBf16, pg8::StaticOrder, true, true>(c.lds, g, S, E);
        }
        SEAM(pb + 2);
        if (IN(pb + 3)) REPS(3) { { PH_BEGIN(); phase_qk(c, l, dry); } { PH_BEGIN(); phase_sc(c, l, dry); } __syncthreads(); { PH_BEGIN(); phase_lru1(c, l); } if (PROBE_DUP == 30) { PH_BEGIN(); phase_lru1(c, l); } }
        SEAM(pb + 3);
        if (IN(pb + 4)) REPS(4) { { PH_BEGIN(); phase_m2(c, l, dry); } __syncthreads(); if (PROBE_DUP == 31) { PH_BEGIN(); phase_lru2(c, l, true); } { PH_BEGIN(); phase_lru2(c, l, dry); } }
        SEAM(pb + 4);
        if (IN(pb + 5)) REPS(5) { PH_BEGIN();
            pg8::MixOrder S; S.init(mrows, c.G, c.wg);
            const bf16_t* WO = (const bf16_t*)(c.ws + WS_WO);
            { pg8::Gemm g{P + CQ, WO, mrows, DM, DM, NIN, DM}; pg8::EpiMerge<0> E{P + CGT, NIN, YF, HX};
              pg8::gemm_phase<pg8::EpiMerge<0>, pg8::MixOrder, true, true, true>(c.lds, g, S, E); }
            { pg8::Gemm g{P + CLG, WO + (size_t)DM * DM, mrows, DM, DM, NIN, DM}; pg8::EpiMerge<1> E{P + CGT + DM, NIN, YF, HX};
              pg8::gemm_phase<pg8::EpiMerge<1>, pg8::MixOrder, true, true, true>(c.lds, g, S, E); }
            { pg8::Gemm g{P + CBG, WO + (size_t)2 * DM * DM, mrows, DM, DM, NIN, DM}; pg8::EpiMerge<2> E{P + CGT + 2 * DM, NIN, YF, HX};
              pg8::gemm_phase<pg8::EpiMerge<2>, pg8::MixOrder, true, true, true>(c.lds, g, S, E); }
        }
        SEAM(pb + 5);
        if (IN(pb + 6)) REPS(6) { PH_BEGIN();
            pg8::Gemm g{HX, (const bf16_t*)(c.ws + WS_WOUT), mrows, DM, DM, DM, DM}; pg8::MixOrder S; S.init(mrows, c.G, c.wg);
            pg8::EpiResid E{dry ? YF : c.out, dry ? YF + (size_t)MLAT * DM : (float*)(c.ws + WS_CTXS), (const float*)(c.ws + WS_MOD) + (size_t)l * 3 * NMOD + 2 * DM};
            pg8::gemm_phase<pg8::EpiResid, pg8::MixOrder, true, true, true>(c.lds, g, S, E);
        }
        SEAM(pb + 6);
        if (IN(pb + 7)) REPS(7) { PH_BEGIN(); phase_norm(c, l, mrows, SP_NFFN, 3); }
        SEAM(pb + 7);
        if (IN(pb + 8)) REPS(8) { PH_BEGIN();
            pg8::Gemm g{HX, (const bf16_t*)(c.ws + WS_WSC), mrows, DM, DM, DM, DM}; pg8::MixOrder S; S.init(mrows, c.G, c.wg);
            pg8::EpiF32 E{(float*)(c.ws + WS_P), DM};
            pg8::gemm_phase<pg8::EpiF32, pg8::MixOrder, true, true, true>(c.lds, g, S, E);
        }
        SEAM(pb + 8);
        if (IN(pb + 9)) REPS(9) {
            { PH_BEGIN(); phase_peer(c, l, mrows, dry); } xcd_barrier(bar);
            { PH_BEGIN(); phase_peer_v(c, l, mrows, dry); } }
        SEAM(pb + 9);
    }
#undef IN
#undef SEAM
}

extern "C" void kernel_launch(void* const* d_in, const int* in_sizes, int n_in, void* d_out, int out_size, void* d_ws, size_t ws_size, hipStream_t stream) {
    static int grid = 0;
    if (grid == 0) {
        if (n_in != 29 || in_sizes[0] != MLAT * DM || out_size != MLAT * DM || ws_size < WS_END) {
            fprintf(stderr, "kernel_launch: built for 29 inputs, x/out of %d floats, >= %zu bytes of workspace; got n_in %d, in0 %d, out %d, ws %zu; nothing launched\n", MLAT * DM, (size_t)WS_END, n_in, n_in > 0 ? in_sizes[0] : -1, out_size, ws_size);
            grid = -1; return; }
        int dev = 0, cus = 0, per_cu = 0;
        if (hipGetDevice(&dev) != hipSuccess || hipDeviceGetAttribute(&cus, hipDeviceAttributeMultiprocessorCount, dev) != hipSuccess) { fprintf(stderr, "kernel_launch: device query failed\n"); grid = -1; return; }
        if (hipFuncSetAttribute((const void*)mk_fwd, hipFuncAttributeMaxDynamicSharedMemorySize, LDS_BYTES) != hipSuccess) { fprintf(stderr, "kernel_launch: hipFuncSetAttribute failed\n"); grid = -1; return; }
        if (hipOccupancyMaxActiveBlocksPerMultiprocessor(&per_cu, (const void*)mk_fwd, NTHREADS, LDS_BYTES) != hipSuccess || per_cu < 1)
            fprintf(stderr, "kernel_launch: note: occupancy query reports %d workgroups per CU\n", per_cu);
        (void)hipGetLastError();
        grid = cus;
    }
    if (grid < 0) return;
    if (hipMemsetAsync((char*)d_ws + WS_CTL, 0, CTL_ZERO_BYTES, stream) != hipSuccess) { fprintf(stderr, "kernel_launch: memset failed\n"); return; }
    Args a{};
    for (int i = 0; i < 29; ++i) a.in[i] = (const float*)d_in[i];
    a.out = (float*)d_out; a.ws = (unsigned char*)d_ws;
#if MK_N_LAUNCHES == 1
    a.ph_lo = 0; a.ph_hi = N_PHASES;
    hipLaunchKernelGGL(mk_fwd, dim3(grid), dim3(NTHREADS), LDS_BYTES, stream, a);
#else
    for (int k = 0; k < N_PHASES; ++k) { a.ph_lo = k; a.ph_hi = k + 1; hipLaunchKernelGGL(mk_fwd, dim3(grid), dim3(NTHREADS), LDS_BYTES, stream, a); }
#endif
    const hipError_t le = hipPeekAtLastError();
    if (le != hipSuccess) fprintf(stderr, "kernel_launch: launch failed: %s\n", hipGetErrorName(le));
}
```

```cpp
#include <hip/hip_runtime.h>
#include <cstdio>
#include <cstdint>

#ifndef MK_N_LAUNCHES
#define MK_N_LAUNCHES 1
#endif

#define GAS __attribute__((address_space(1)))
#define LAS __attribute__((address_space(3)))
typedef unsigned short bf16_t;
typedef short bf16x8 __attribute__((ext_vector_type(8)));
typedef short s16x4 __attribute__((ext_vector_type(4)));
typedef float f32x2 __attribute__((ext_vector_type(2)));
typedef float f32x4 __attribute__((ext_vector_type(4)));
typedef float f32x8 __attribute__((ext_vector_type(8)));
typedef float f32x16 __attribute__((ext_vector_type(16)));
typedef unsigned u32x2 __attribute__((ext_vector_type(2)));
typedef unsigned u32x4 __attribute__((ext_vector_type(4)));

constexpr int DM = 2048, NB = 2, SEQ = 8192, NLAYER = 2, CTXL = 256;
constexpr int MLAT = NB * SEQ, MCTX = NB * CTXL, MALL = MLAT + MCTX;
constexpr int NIN = 19456;
constexpr int CQ = 0, CK = 2048, CV = 2560, CLX = 3072, CLG = 5120, CBG = 7168, CCG = 9216, CU = 11264, CGT = 13312;
constexpr int NKEY = SEQ + CTXL;
constexpr int NCHUNK = NKEY / 64;
constexpr int NMOD = 6 * DM;
constexpr float EPS = 1e-6f;
constexpr int NWAVES = 8, NTHREADS = 512;

constexpr size_t MiB = 1u << 20;
constexpr size_t al256(size_t x) { return (x + 255) / 256 * 256; }
constexpr size_t WS_CTL = 0, CTL_ZERO_BYTES = 1 * MiB;
constexpr size_t WS_MOD = WS_CTL + CTL_ZERO_BYTES;
constexpr size_t WS_ROPE = WS_MOD + al256((size_t)NLAYER * 3 * NMOD * 4);
constexpr size_t WS_SP = WS_ROPE + al256(2 * 128 * 32 * 4);
constexpr size_t WS_CTXS = WS_SP + al256(36864 * 4);
constexpr size_t WS_LSUM = WS_CTXS + al256((size_t)MCTX * DM * 4);
constexpr size_t WS_WLRU = WS_LSUM + al256((size_t)2 * 2 * NB * NCHUNK * DM * 4);
constexpr size_t WS_KC = WS_WLRU + al256((size_t)16 * 512 * 128 * 2);
constexpr size_t WS_VC = WS_KC + al256((size_t)NB * 4 * NKEY * 128 * 2);
constexpr size_t WS_WIN = WS_VC + al256((size_t)NB * 4 * NKEY * 128 * 2);
constexpr size_t WS_WO = WS_WIN + al256((size_t)NIN * DM * 2);
constexpr size_t WS_WOUT = WS_WO + al256((size_t)3 * DM * DM * 2);
constexpr size_t WS_WSC = WS_WOUT + al256((size_t)DM * DM * 2);
constexpr size_t WS_PU = WS_WSC + al256((size_t)DM * DM * 2);
constexpr size_t WS_PV = WS_PU + al256((size_t)16384 * DM);
constexpr size_t WS_HX = WS_PV + al256((size_t)16384 * DM);
constexpr size_t WS_YF = WS_HX + al256((size_t)MALL * DM * 2);
constexpr size_t WS_P = WS_YF + al256((size_t)MALL * DM * 4);
constexpr size_t WS_END = WS_P + al256((size_t)MALL * NIN * 2);

constexpr int SP_NMIX = 0, SP_NFFN = 2048, SP_QN = 4096, SP_KN = 4224, SP_LCW = 4352, SP_LCB = 12544, SP_LBA = 14592, SP_LBX = 18688, SP_LSP = 22784, SP_SCW = 26880, SP_SCB = 33024, SP_END = 35072;

constexpr int LDS_BYTES = 147456;
constexpr int MISC_OFF = 147456 - 256;
constexpr int LDS_WORK = MISC_OFF;

__device__ __forceinline__ unsigned cvt_pk_bf16(float lo, float hi) { unsigned r; asm volatile("v_cvt_pk_bf16_f32 %0, %1, %2" : "=v"(r) : "v"(lo), "v"(hi)); return r; }
__device__ __forceinline__ float bf_lo(unsigned w) { return __uint_as_float(w << 16); }
__device__ __forceinline__ float bf_hi(unsigned w) { return __uint_as_float(w & 0xffff0000u); }
__device__ __forceinline__ float bf1(bf16_t h) { return __uint_as_float(((unsigned)h) << 16); }
__device__ __forceinline__ bf16_t f2bf(float f) { return (bf16_t)(cvt_pk_bf16(f, 0.f) & 0xffffu); }
__device__ __forceinline__ float sigmoidf_(float x) { return __builtin_amdgcn_rcpf(1.f + __expf(-x)); }
__device__ __forceinline__ float gelu_tanh(float x) { const float z = 0.7978845608028654f * (x + 0.044715f * x * x * x); const float e = __expf(2.f * z); return 0.5f * x * (2.f - 2.f * __builtin_amdgcn_rcpf(e + 1.f)); }
__device__ __forceinline__ float wave_sum(float v) {
#pragma unroll
    for (int o = 1; o < 64; o <<= 1) v += __shfl_xor(v, o);
    return v;
}
__device__ __forceinline__ float wave_max(float v) {
#pragma unroll
    for (int o = 1; o < 64; o <<= 1) v = fmaxf(v, __shfl_xor(v, o));
    return v;
}
template <class T> __device__ __forceinline__ T* as_global(T* p) { return (T*)(GAS T*)p; }
__device__ __forceinline__ int lane_id_fresh() { int l; asm volatile("v_mbcnt_lo_u32_b32 %0, -1, 0\n\tv_mbcnt_hi_u32_b32 %0, -1, %0" : "=v"(l)); return l; }
#define DPPF(v, ctrl) __int_as_float(__builtin_amdgcn_update_dpp(0, __float_as_int(v), ctrl, 0xF, 0xF, true))
#define LDS_WAIT() asm volatile("s_waitcnt lgkmcnt(0)" ::: "memory")
#define VM_WAIT() asm volatile("s_waitcnt vmcnt(0)" ::: "memory")

#define XB_TMO      128
#define XB_XCNT(j)  (256  + 64 * (j))
#define XB_XSUB(j)  (1280 + 64 * (j))
#define XB_XGEN(j)  (2304 + 64 * (j))
#define XB_TOP      3328
#define XB_TOPGEN   3392
#define XCD_BAR_WORDS 3456
#define XB_SPIN_CAP (1u << 23)
__device__ __forceinline__ unsigned xb_ld(unsigned* p)              { return __hip_atomic_load(p, __ATOMIC_RELAXED, __HIP_MEMORY_SCOPE_AGENT); }
__device__ __forceinline__ unsigned xb_add(unsigned* p, unsigned v) { return __hip_atomic_fetch_add(p, v, __ATOMIC_RELAXED, __HIP_MEMORY_SCOPE_AGENT); }
__device__ __forceinline__ unsigned xb_xcc_id() { return (unsigned)__builtin_amdgcn_s_getreg((3 << 11) | 20) & 0xFu; }
#define XB_SPIN(cond, bar) do { unsigned _sp = 0; while (cond) { __builtin_amdgcn_s_sleep(1); \
    if ((++_sp & 255u) == 0u) { if (xb_ld(&(bar)[XB_TMO])) break; if (_sp > XB_SPIN_CAP) { atomicAdd(&(bar)[XB_TMO], 1u); break; } } } } while (0)
struct XcdBarrier { unsigned* bar; unsigned x; volatile LAS unsigned* st; };
__device__ __forceinline__ XcdBarrier xcd_barrier_post(unsigned* bar, volatile LAS unsigned* st) {
    XcdBarrier b; b.bar = bar; b.x = xb_xcc_id(); b.st = st;
    if (threadIdx.x == 0) (void)xb_add(&bar[XB_XCNT(b.x)], 1u);
    return b;
}
__device__ __forceinline__ void xcd_barrier_complete(unsigned* bar, unsigned x, unsigned& nloc, unsigned& nx) {
    const unsigned G = gridDim.x * gridDim.y * gridDim.z;
    unsigned sum, cnt, mine, sp = 0u;
    for (;;) {
        sum = 0u; cnt = 0u; mine = 0u;
#pragma unroll
        for (unsigned j = 0; j < 16; ++j) { const unsigned c = xb_ld(&bar[XB_XCNT(j)]); sum += c; cnt += (c > 0u) ? 1u : 0u; mine = (j == x) ? c : mine; }
        if (sum == G) break;
        __builtin_amdgcn_s_sleep(1);
        if ((++sp & 255u) == 0u) { if (xb_ld(&bar[XB_TMO])) break; if (sp > XB_SPIN_CAP) { atomicAdd(&bar[XB_TMO], 1u); break; } }
    }
    nloc = mine > 0u ? mine : 1u; nx = cnt > 0u ? cnt : 1u;
}
__device__ __forceinline__ void xcd_barrier(const XcdBarrier& b, int wave) {
    asm volatile("s_waitcnt vmcnt(0)" ::: "memory");
    __syncthreads();
    if (wave == 0 && lane_id_fresh() == 0) {
        unsigned* bar = b.bar;
        __builtin_amdgcn_s_waitcnt(0);
        unsigned nloc = b.st[0], nx = b.st[1];
        if (nloc == 0u) { xcd_barrier_complete(bar, b.x, nloc, nx); b.st[0] = nloc; b.st[1] = nx; }
        const unsigned old = xb_add(&bar[XB_XSUB(b.x)], 1u);
        const unsigned gen = old / nloc;
        if (old + 1u == (gen + 1u) * nloc) {
            __builtin_amdgcn_fence(__ATOMIC_RELEASE, "agent");
            asm volatile("s_waitcnt vmcnt(0)" ::: "memory");
            const unsigned og = xb_add(&bar[XB_TOP], 1u);
            const unsigned tg = og / nx;
            if (og + 1u == (tg + 1u) * nx) xb_add(&bar[XB_TOPGEN], 1u);
            else XB_SPIN(xb_ld(&bar[XB_TOPGEN]) == tg, bar);
            __builtin_amdgcn_fence(__ATOMIC_ACQUIRE, "agent");
            xb_add(&bar[XB_XGEN(b.x)], 1u);
            asm volatile("s_waitcnt vmcnt(0)" ::: "memory");
        } else {
            XB_SPIN(xb_ld(&bar[XB_XGEN(b.x)]) == gen, bar);
            __builtin_amdgcn_fence(__ATOMIC_ACQUIRE, "agent");
            asm volatile("s_waitcnt vmcnt(0)" ::: "memory");
        }
    }
    __syncthreads();
}
namespace pg8 {
#define PG8_LAS __attribute__((address_space(3)))
constexpr int BM = 256, BK = 64, HALF = 128, HTB = HALF * BK * 2, STAGE_BYTES = 8 * HTB, NXCD = 8, WGM = 8;
__host__ __device__ __forceinline__ int lds_byte(int r, int c) { const int st = (r >> 4) * 2 + (c >> 5), rr = r & 15, cc = c & 31, ob = rr * 64 + cc * 2; return st * 1024 + (ob ^ (((ob >> 9) & 1) << 5)); }
__host__ __device__ __forceinline__ void stage_rc(int b, int& R, int& C) { const int st = b / 1024, sb = b % 1024, swz = sb ^ (((sb >> 9) & 1) << 5); R = (st >> 1) * 16 + swz / 64; C = (st & 1) * 32 + (swz % 64) / 2; }
__host__ __device__ __forceinline__ int perm32(int rho) { const int n = rho >> 4, i = rho & 15; return 8 * (i >> 2) + 4 * n + (i & 3); }

struct Unit { int pm, pn, nh; };
struct Gemm { const bf16_t* A; const bf16_t* Bt; int M, N, K, lda, ldb; };

struct StaticOrder {
    int nM, nN, nwg, G, c;
    __host__ __device__ void init(int M, int N, int G_, int c_) { nM = M / BM; nN = N / BM; nwg = nM * nN; G = G_; c = c_; }
    __host__ __device__ bool next(int i, Unit& u) const {
        const long L = (long)i * G + c; if (L >= nwg) return false;
        int wgid = (int)L; { const int q = nwg / NXCD, r = nwg % NXCD, xcd = wgid % NXCD, off = wgid / NXCD; wgid = (xcd < r ? xcd * (q + 1) : r * (q + 1) + (xcd - r) * q) + off; }
        const int nig = WGM * nN, gid = wgid / nig, fm = gid * WGM, gsz = (nM - fm) < WGM ? (nM - fm) : WGM;
        u.pm = 2 * (fm + ((wgid % nig) % gsz)); u.pn = (wgid % nig) / gsz; u.nh = 2; return true;
    }
    __device__ __forceinline__ void a_ready(const Unit&) const {}
    __device__ __forceinline__ void done(const Unit&) const {}
};

struct MixOrder {
    StaticOrder lat; int nhalf;
    __host__ __device__ void init(int mrows, int G_, int c_) { lat.init(MLAT, 2048, G_, c_); nhalf = ((mrows - MLAT) / HALF) * 8; }
    __host__ __device__ bool next(int i, Unit& u) const {
        if (lat.next(i, u)) return true;
        const long h = (long)i * lat.G + lat.c - lat.nwg; if (h < 0 || h >= nhalf) return false;
        u.pm = MLAT / HALF + (int)(h >> 3); u.pn = (int)(h & 7); u.nh = 1; return true;
    }
    __device__ __forceinline__ void a_ready(const Unit&) const {}
    __device__ __forceinline__ void done(const Unit&) const {}
};

struct EpiBf16 {
    static constexpr bool PERM = true, AFTER_DRAIN = false;
    bf16_t* O; int ldc;
    __device__ __forceinline__ void operator()(const f32x4 (&acc)[2][2][4][2], const Unit& u, int wr, int wc, int fr, int fq) const {
        const int row0 = u.pm * HALF + wr * 64 + fr, col0 = u.pn * BM + wc * 32 + 8 * fq;
#pragma unroll
        for (int ai = 0; ai < 2; ++ai) if (ai < u.nh)
#pragma unroll
            for (int m = 0; m < 4; ++m) { bf16_t* rowp = O + (size_t)(row0 + ai * HALF + m * 16) * ldc + col0;
#pragma unroll
                for (int bj = 0; bj < 2; ++bj) { const f32x4 v0 = acc[ai][bj][m][0], v1 = acc[ai][bj][m][1];
                    u32x4 w; w.x = cvt_pk_bf16(v0[0], v0[1]); w.y = cvt_pk_bf16(v0[2], v0[3]); w.z = cvt_pk_bf16(v1[0], v1[1]); w.w = cvt_pk_bf16(v1[2], v1[3]);
                    *(u32x4*)(rowp + bj * HALF) = w; } }
    }
};
struct EpiF32 {
    static constexpr bool PERM = false, AFTER_DRAIN = false;
    float* C; int ldc;
    __device__ __forceinline__ void operator()(const f32x4 (&acc)[2][2][4][2], const Unit& u, int wr, int wc, int fr, int fq) const {
        const int row0 = u.pm * HALF + wr * 64 + fr, col0 = u.pn * BM + wc * 32 + 4 * fq;
#pragma unroll
        for (int ai = 0; ai < 2; ++ai) if (ai < u.nh)
#pragma unroll
            for (int m = 0; m < 4; ++m) { float* rowp = C + (size_t)(row0 + ai * HALF + m * 16) * ldc + col0;
#pragma unroll
                for (int bj = 0; bj < 2; ++bj)
#pragma unroll
                    for (int n = 0; n < 2; ++n) *(f32x4*)(rowp + bj * HALF + n * 16) = acc[ai][bj][m][n]; }
    }
};
template <int MODE> struct EpiMerge {
    static constexpr bool PERM = true, AFTER_DRAIN = false;
    const bf16_t* Gt; int ldg; float* Y; bf16_t* YB;
    __device__ __forceinline__ void operator()(const f32x4 (&acc)[2][2][4][2], const Unit& u, int wr, int wc, int fr, int fq) const {
        const int row0 = u.pm * HALF + wr * 64 + fr, col0 = u.pn * BM + wc * 32 + 8 * fq;
#pragma unroll
        for (int ai = 0; ai < 2; ++ai) if (ai < u.nh)
#pragma unroll
            for (int m = 0; m < 4; ++m) { const size_t r = (size_t)(row0 + ai * HALF + m * 16);
#pragma unroll
                for (int bj = 0; bj < 2; ++bj) { const int c = col0 + bj * HALF;
                    const u32x4 gw = *(const u32x4*)(Gt + r * ldg + c);
                    f32x4 g0, g1;
                    g0[0] = sigmoidf_(bf_lo(gw.x)); g0[1] = sigmoidf_(bf_hi(gw.x)); g0[2] = sigmoidf_(bf_lo(gw.y)); g0[3] = sigmoidf_(bf_hi(gw.y));
                    g1[0] = sigmoidf_(bf_lo(gw.z)); g1[1] = sigmoidf_(bf_hi(gw.z)); g1[2] = sigmoidf_(bf_lo(gw.w)); g1[3] = sigmoidf_(bf_hi(gw.w));
                    float* yp = Y + r * 2048 + c;
                    f32x4 y0 = g0 * acc[ai][bj][m][0], y1 = g1 * acc[ai][bj][m][1];
                    if (MODE != 0) { y0 += *(const f32x4*)yp; y1 += *(const f32x4*)(yp + 4); }
                    if (MODE != 2) { *(f32x4*)yp = y0; *(f32x4*)(yp + 4) = y1; }
                    else { u32x4 w; w.x = cvt_pk_bf16(y0[0], y0[1]); w.y = cvt_pk_bf16(y0[2], y0[3]); w.z = cvt_pk_bf16(y1[0], y1[1]); w.w = cvt_pk_bf16(y1[2], y1[3]);
                        *(u32x4*)(YB + r * 2048 + c) = w; } } }
    }
};
struct EpiResid {
    static constexpr bool PERM = true, AFTER_DRAIN = false;
    float* xlat; float* xctx; const float* gate;
    __device__ __forceinline__ void operator()(const f32x4 (&acc)[2][2][4][2], const Unit& u, int wr, int wc, int fr, int fq) const {
        const int vec = u.pm < 64 ? 0 : (u.pm < 128 ? 1 : 2);
        float* xb = u.pm < 128 ? xlat + (size_t)u.pm * HALF * 2048 : xctx + (size_t)(u.pm - 128) * HALF * 2048;
        const int lrow0 = wr * 64 + fr, col0 = u.pn * BM + wc * 32 + 8 * fq;
        const float* gp = gate + (size_t)vec * 12288 + col0;
#pragma unroll
        for (int bj = 0; bj < 2; ++bj) { const f32x4 g0 = *(const f32x4*)(gp + bj * HALF), g1 = *(const f32x4*)(gp + bj * HALF + 4);
#pragma unroll
            for (int ai = 0; ai < 2; ++ai) if (ai < u.nh)
#pragma unroll
                for (int m = 0; m < 4; ++m) { float* xp = xb + (size_t)(lrow0 + ai * HALF + m * 16) * 2048 + col0 + bj * HALF;
                    const f32x4 x0 = *(const f32x4*)xp + g0 * acc[ai][bj][m][0], x1 = *(const f32x4*)(xp + 4) + g1 * acc[ai][bj][m][1];
                    *(f32x4*)xp = x0; *(f32x4*)(xp + 4) = x1; } }
    }
};

template <class Epi, class Sched, bool ALIGN_EPI = false, bool SP2 = false, bool HALFU = false>
__device__ __forceinline__ void gemm_phase(PG8_LAS unsigned char* lds, const Gemm g, const Sched& S, const Epi& E, int wave_) {
    int tid_ = wave_ * 64 + lane_id_fresh();
    const int tid = tid_, wid = __builtin_amdgcn_readfirstlane(tid >> 6), lane = tid & 63, wr = wid >> 2, wc = wid & 3, fr = lane & 15, fq = lane >> 4;
    const int K = g.K, nt = K / BK;
    unsigned voffA[2], voffB[2];
#pragma unroll
    for (int i = 0; i < 2; ++i) { int R, C; stage_rc(tid * 16 + i * 8192, R, C); const int Rb = Epi::PERM ? ((R & ~31) + perm32(R & 31)) : R;
        voffA[i] = (unsigned)(R * g.lda + C) * 2u; voffB[i] = (unsigned)(Rb * g.ldb + C) * 2u; }
    const size_t kstep = (size_t)(BK * 2);
    const size_t hstepA = (size_t)HALF * g.lda * 2, hstepB = (size_t)HALF * g.ldb * 2;
    const size_t tstepB = 2 * hstepB;
    const unsigned ldsw = (unsigned)wid * 1024u;
    const int aoff = lds_byte(wr * 64 + fr, fq * 8), boff = lds_byte(wc * 32 + fr, fq * 8);
#define PG8_SA(b, h) (((b) * 2 + (h)) * HTB)
#define PG8_SB(b, h) ((4 + (b) * 2 + (h)) * HTB)
#define PG8_STAGE(bufoff, gbase, voff) do { _Pragma("unroll") for (int _i = 0; _i < 2; ++_i) \
        __builtin_amdgcn_global_load_lds((const unsigned*)((const char*)(gbase) + (voff)[_i]), (PG8_LAS unsigned*)(lds + (bufoff) + ldsw + _i * 8192), 16, 0, 0); } while (0)
#define PG8_LDA(dst, b, h) do { _Pragma("unroll") for (int m = 0; m < 4; ++m) _Pragma("unroll") for (int k = 0; k < 2; ++k) dst[m][k] = *(const PG8_LAS bf16x8*)(lds + PG8_SA(b, h) + aoff + m * 2048 + k * 1024); } while (0)
#define PG8_LDB(dst, b, h) do { _Pragma("unroll") for (int n = 0; n < 2; ++n) _Pragma("unroll") for (int k = 0; k < 2; ++k) dst[n][k] = *(const PG8_LAS bf16x8*)(lds + PG8_SB(b, h) + boff + n * 2048 + k * 1024); } while (0)
#define PG8_MMA(ai, bj, At, Bt) do { __builtin_amdgcn_s_setprio(1); _Pragma("unroll") for (int m = 0; m < 4; ++m) _Pragma("unroll") for (int n = 0; n < 2; ++n) _Pragma("unroll") for (int k = 0; k < 2; ++k) \
        acc[ai][bj][m][n] = __builtin_amdgcn_mfma_f32_16x16x32_bf16(Bt[n][k], At[m][k], acc[ai][bj][m][n], 0, 0, 0); __builtin_amdgcn_s_setprio(0); } while (0)
#define PG8_WAIT_V(n) asm volatile("s_waitcnt vmcnt(" #n ")" ::: "memory")
#define PG8_WAIT_L(n) asm volatile("s_waitcnt lgkmcnt(" #n ")" ::: "memory")
#define PG8_BAR __builtin_amdgcn_s_barrier()
#define PG8_SCHED __builtin_amdgcn_sched_barrier(0)
    Unit cur, nxt; int ui = 0;
    if (!S.next(0, cur)) return;
    f32x4 acc[2][2][4][2];
#pragma unroll
    for (int a = 0; a < 2; ++a)
#pragma unroll
        for (int b = 0; b < 2; ++b)
#pragma unroll
            for (int m = 0; m < 4; ++m)
#pragma unroll
                for (int n = 0; n < 2; ++n) acc[a][b][m][n] = (f32x4){0.f, 0.f, 0.f, 0.f};
    bf16x8 At[4][2], B0[2][2], B1[2][2];
    const char* cA = (const char*)g.A + (size_t)cur.pm * hstepA; const char* cB = (const char*)g.Bt + (size_t)cur.pn * tstepB;
    size_t chA = (!HALFU || cur.nh == 2) ? hstepA : 0;
    S.a_ready(cur);
    if constexpr (SP2) {
        PG8_STAGE(PG8_SB(0, 0), cB, voffB); PG8_STAGE(PG8_SB(0, 1), cB + hstepB, voffB); PG8_STAGE(PG8_SA(0, 0), cA, voffA); PG8_STAGE(PG8_SA(0, 1), cA + chA, voffA);
        if (wr == 1) PG8_BAR;
        PG8_WAIT_V(2); PG8_BAR;
        PG8_STAGE(PG8_SB(1, 0), cB + kstep, voffB); PG8_STAGE(PG8_SA(1, 0), cA + kstep, voffA); PG8_STAGE(PG8_SB(1, 1), cB + hstepB + kstep, voffB);
        PG8_WAIT_V(6); PG8_BAR;
    } else {
        PG8_STAGE(PG8_SB(0, 0), cB, voffB); PG8_STAGE(PG8_SA(0, 0), cA, voffA); PG8_STAGE(PG8_SB(0, 1), cB + hstepB, voffB); PG8_STAGE(PG8_SA(0, 1), cA + chA, voffA);
        if (wr == 1) PG8_BAR;
        PG8_WAIT_V(4); PG8_BAR;
        PG8_STAGE(PG8_SB(1, 0), cB + kstep, voffB); PG8_STAGE(PG8_SA(1, 0), cA + kstep, voffA); PG8_STAGE(PG8_SB(1, 1), cB + hstepB + kstep, voffB);
        PG8_WAIT_V(6); PG8_BAR;
    }
    for (;;) {
        const bool has_next = S.next(ui + 1, nxt);
        const char* nA = has_next ? (const char*)g.A + (size_t)nxt.pm * hstepA : cA; const size_t nhA = has_next ? ((!HALFU || nxt.nh == 2) ? hstepA : 0) : chA; const bool full = (!HALFU || cur.nh == 2);
        const char* nA_ = nA; (void)nA_; const char* nB = has_next ? (const char*)g.Bt + (size_t)nxt.pn * tstepB : cB;
        for (int t = 0; t < nt; t += 2) {
            const bool last = (t == nt - 2);
            const char* a1 = cA + (size_t)(t + 1) * kstep;
            const char* a2 = last ? nA : cA + (size_t)(t + 2) * kstep; const char* b2 = last ? nB : cB + (size_t)(t + 2) * kstep;
            const char* a3 = a2 + kstep; const char* b3 = b2 + kstep;
            const size_t h2A = last ? nhA : chA;
            if (last && has_next) S.a_ready(nxt);
            if constexpr (SP2) {
            PG8_LDB(B0, 0, 0); PG8_LDB(B1, 0, 1); PG8_SCHED; PG8_LDA(At, 0, 0); PG8_STAGE(PG8_SA(1, 1), a1 + chA, voffA);
            PG8_WAIT_V(8); PG8_WAIT_L(0); PG8_BAR; PG8_MMA(0, 0, At, B0); PG8_MMA(0, 1, At, B1); PG8_BAR; PG8_SCHED;
            PG8_LDA(At, 0, 1); PG8_STAGE(PG8_SB(0, 0), b2, voffB); PG8_STAGE(PG8_SB(0, 1), b2 + hstepB, voffB); PG8_STAGE(PG8_SA(0, 0), a2, voffA);
            PG8_WAIT_V(8); PG8_WAIT_L(0); PG8_BAR; if (full) { PG8_MMA(1, 0, At, B0); PG8_MMA(1, 1, At, B1); } PG8_BAR; PG8_SCHED;
            PG8_LDB(B0, 1, 0); PG8_LDB(B1, 1, 1); PG8_SCHED; PG8_LDA(At, 1, 0); PG8_STAGE(PG8_SA(0, 1), a2 + h2A, voffA);
            PG8_WAIT_V(8); PG8_WAIT_L(0); PG8_BAR; PG8_MMA(0, 0, At, B0); PG8_MMA(0, 1, At, B1); PG8_BAR; PG8_SCHED;
            PG8_LDA(At, 1, 1); PG8_STAGE(PG8_SB(1, 0), b3, voffB); PG8_STAGE(PG8_SB(1, 1), b3 + hstepB, voffB); PG8_STAGE(PG8_SA(1, 0), a3, voffA);
            PG8_WAIT_V(8); PG8_WAIT_L(0); PG8_BAR; if (full) { PG8_MMA(1, 0, At, B0); PG8_MMA(1, 1, At, B1); } PG8_BAR; PG8_SCHED;
            } else {
            PG8_LDB(B0, 0, 0); PG8_SCHED; PG8_LDA(At, 0, 0); PG8_STAGE(PG8_SA(1, 1), a1 + chA, voffA);
            PG8_WAIT_L(8); PG8_BAR; PG8_WAIT_L(0); PG8_MMA(0, 0, At, B0); PG8_BAR; PG8_SCHED;
            PG8_LDB(B1, 0, 1); PG8_STAGE(PG8_SB(0, 0), b2, voffB);
            PG8_BAR; PG8_WAIT_L(0); PG8_MMA(0, 1, At, B1); PG8_BAR;
            PG8_LDA(At, 0, 1); PG8_STAGE(PG8_SA(0, 0), a2, voffA);
            PG8_BAR; PG8_WAIT_L(0); if (full) PG8_MMA(1, 0, At, B0); PG8_BAR; PG8_SCHED;
            PG8_STAGE(PG8_SB(0, 1), b2 + hstepB, voffB);
            PG8_WAIT_V(6); PG8_BAR; if (full) PG8_MMA(1, 1, At, B1); PG8_BAR;
            PG8_LDB(B0, 1, 0); PG8_SCHED; PG8_LDA(At, 1, 0); PG8_STAGE(PG8_SA(0, 1), a2 + h2A, voffA);
            PG8_WAIT_L(8); PG8_BAR; PG8_WAIT_L(0); PG8_MMA(0, 0, At, B0); PG8_BAR; PG8_SCHED;
            PG8_LDB(B1, 1, 1); PG8_STAGE(PG8_SB(1, 0), b3, voffB);
            PG8_BAR; PG8_WAIT_L(0); PG8_MMA(0, 1, At, B1); PG8_BAR;
            PG8_LDA(At, 1, 1); PG8_STAGE(PG8_SA(1, 0), a3, voffA);
            PG8_BAR; PG8_WAIT_L(0); if (full) PG8_MMA(1, 0, At, B0); PG8_BAR; PG8_SCHED;
            PG8_STAGE(PG8_SB(1, 1), b3 + hstepB, voffB);
            PG8_WAIT_V(6); PG8_BAR; if (full) PG8_MMA(1, 1, At, B1); PG8_BAR;
            }
        }
        if constexpr (ALIGN_EPI) { if (wr == 0) PG8_BAR; }
        if constexpr (!Epi::AFTER_DRAIN) { E(acc, cur, wr, wc, fr, fq); S.done(cur); }
        if (!has_next) break;
#pragma unroll
        for (int a = 0; a < 2; ++a)
#pragma unroll
            for (int b = 0; b < 2; ++b)
#pragma unroll
                for (int m = 0; m < 4; ++m)
#pragma unroll
                    for (int n = 0; n < 2; ++n) acc[a][b][m][n] = (f32x4){0.f, 0.f, 0.f, 0.f};
        cur = nxt; cA = nA; cB = nB; chA = nhA; ++ui;
        if constexpr (ALIGN_EPI) { if (wr == 1) PG8_BAR; }
    }
    PG8_WAIT_V(0);
    if constexpr (!ALIGN_EPI) { if (wr == 0) PG8_BAR; }
    PG8_BAR;
#undef PG8_SA
#undef PG8_SB
#undef PG8_STAGE
#undef PG8_LDA
#undef PG8_LDB
#undef PG8_MMA
#undef PG8_WAIT_V
#undef PG8_WAIT_L
#undef PG8_BAR
#undef PG8_SCHED
}
}
namespace att {
constexpr int D = 128, NW = 8, QBLK = 32, KVBLK = 64;
constexpr float SCALE = 0.088388347648318440f;
constexpr float THR = 8.f;
constexpr int LDQ = NIN, LDK = 128, LDO = NIN;
constexpr size_t SHM_V = KVBLK * D * 2, SHM_K = KVBLK * D * 2, SHM_ATTN = 2 * SHM_V + 2 * SHM_K + NW * 64 * 4;
#define KSWZ(row, colB) ((row) * 256 + ((colB) ^ (((row) & 7) << 4)))
#define SBAR() __builtin_amdgcn_sched_barrier(0)
__device__ __forceinline__ int crow(int r, int hi) { return (r & 3) + 8 * (r >> 2) + 4 * hi; }
__device__ __forceinline__ unsigned cvtpk(float lo, float hi) { unsigned r; asm volatile("v_cvt_pk_bf16_f32 %0, %1, %2" : "=v"(r) : "v"(lo), "v"(hi)); return r; }
__device__ __forceinline__ bf16x8 ld8(const bf16_t* p) { return *reinterpret_cast<const bf16x8*>(p); }

__device__ __forceinline__ void partialSM(f32x16& p0, f32x16& p1, float& m_reg, float& mn, float& alpha) {
  constexpr float C = SCALE * 1.4426950408889634f;
  float pmax = p0[0];
#pragma unroll
  for (int r = 1; r < 16; ++r) pmax = fmaxf(pmax, p0[r]);
#pragma unroll
  for (int r = 0; r < 16; ++r) pmax = fmaxf(pmax, p1[r]);
  { auto rr = __builtin_amdgcn_permlane32_swap(__float_as_uint(pmax), __float_as_uint(pmax), false, false);
    pmax = fmaxf(__uint_as_float(rr[0]), __uint_as_float(rr[1])); }
  if (__builtin_expect(__all(pmax - m_reg <= THR / SCALE), 1)) { mn = m_reg; alpha = 1.f; }
  else { mn = fmaxf(m_reg, pmax); alpha = __builtin_amdgcn_exp2f((m_reg - mn) * C); m_reg = mn; }
  float mnC = -mn * C;
#pragma unroll
  for (int r = 0; r < 16; ++r) p0[r] = fmaf(p0[r], C, mnC);
#pragma unroll
  for (int r = 0; r < 16; ++r) p1[r] = fmaf(p1[r], C, mnC);
#pragma unroll
  for (int r = 0; r < 16; ++r) p0[r] = __builtin_amdgcn_exp2f(p0[r]);
}
__device__ __forceinline__ void finishSM(f32x16& p0, f32x16& p1, float alpha, float& l_reg, bf16x8& pa0, bf16x8& pa1, bf16x8& pa2, bf16x8& pa3) {
#pragma unroll
  for (int r = 0; r < 16; ++r) p1[r] = __builtin_amdgcn_exp2f(p1[r]);
  float ps = 0;
#pragma unroll
  for (int r = 0; r < 16; ++r) ps += p0[r];
#pragma unroll
  for (int r = 0; r < 16; ++r) ps += p1[r];
  { auto rr = __builtin_amdgcn_permlane32_swap(__float_as_uint(ps), __float_as_uint(ps), false, false);
    ps = __uint_as_float(rr[0]) + __uint_as_float(rr[1]); }
  l_reg = l_reg * alpha + ps;
#define PK4(P, BASE, OUT) do { unsigned a0 = cvtpk(P[BASE + 0], P[BASE + 1]), a1 = cvtpk(P[BASE + 2], P[BASE + 3]);   \
    unsigned b0 = cvtpk(P[BASE + 4], P[BASE + 5]), b1 = cvtpk(P[BASE + 6], P[BASE + 7]);                              \
    auto r0 = __builtin_amdgcn_permlane32_swap(a0, b0, false, false); auto r1 = __builtin_amdgcn_permlane32_swap(a1, b1, false, false); \
    u32x4 w = {r0[0], r1[0], r0[1], r1[1]}; OUT = *reinterpret_cast<bf16x8*>(&w); } while (0)
  PK4(p0, 0, pa0); PK4(p0, 8, pa1); PK4(p1, 0, pa2); PK4(p1, 8, pa3);
#undef PK4
}
__device__ __forceinline__ void qkt(f32x16& p0, f32x16& p1, const bf16_t* Ks, const bf16x8* qr, int r32, int hi) {
  p0 = f32x16{}; p1 = f32x16{};
#pragma unroll
  for (int d0 = 0; d0 < 8; ++d0) { int cb = (d0 * 16 + hi * 8) * 2;
    bf16x8 b0 = *reinterpret_cast<const bf16x8*>((const char*)Ks + KSWZ(r32, cb));
    bf16x8 b1 = *reinterpret_cast<const bf16x8*>((const char*)Ks + KSWZ(32 + r32, cb));
    p0 = __builtin_amdgcn_mfma_f32_32x32x16_bf16(b0, qr[d0], p0, 0, 0, 0);
    p1 = __builtin_amdgcn_mfma_f32_32x32x16_bf16(b1, qr[d0], p1, 0, 0, 0); }
}
__device__ __forceinline__ int v_st(int k, int c) { const int kk = (k & ~0xC) | ((k & 4) << 1) | ((k & 8) >> 1); return ((kk >> 3) * 4 + (c >> 5)) * 512 + ((kk & 7) * 32 + (c & 31)) * 2; }
__device__ __forceinline__ int v_rd_base(int lane) { return ((lane & 3) << 3) | (((lane >> 2) & 3) << 6) | (((lane >> 4) & 1) << 5) | (((lane >> 5) & 1) << 8); }
constexpr int v_rd_off(int d0, int ks, int half) { return d0 * 512 + ks * 4096 + half * 2048; }
template <int OFF> __device__ __forceinline__ s16x4 tr_read(int vb) {
  s16x4 r; asm volatile("ds_read_b64_tr_b16 %0, %1 offset:%2" : "=&v"(r) : "v"(vb), "i"(OFF) : "memory"); return r;
}
template <int D0> __device__ __forceinline__ void pv_one(f32x16& od, int vb, bf16x8 pa0, bf16x8 pa1, bf16x8 pa2, bf16x8 pa3) {
  const s16x4 l0 = tr_read<v_rd_off(D0, 0, 0)>(vb), h0 = tr_read<v_rd_off(D0, 0, 1)>(vb), l1 = tr_read<v_rd_off(D0, 1, 0)>(vb), h1 = tr_read<v_rd_off(D0, 1, 1)>(vb);
  const s16x4 l2 = tr_read<v_rd_off(D0, 2, 0)>(vb), h2 = tr_read<v_rd_off(D0, 2, 1)>(vb), l3 = tr_read<v_rd_off(D0, 3, 0)>(vb), h3 = tr_read<v_rd_off(D0, 3, 1)>(vb);
  asm volatile("s_waitcnt lgkmcnt(0)" ::: "memory"); SBAR();
#define PK(L, H) (bf16x8){L[0], L[1], L[2], L[3], H[0], H[1], H[2], H[3]}
  od = __builtin_amdgcn_mfma_f32_32x32x16_bf16(pa0, PK(l0, h0), od, 0, 0, 0);
  od = __builtin_amdgcn_mfma_f32_32x32x16_bf16(pa1, PK(l1, h1), od, 0, 0, 0);
  od = __builtin_amdgcn_mfma_f32_32x32x16_bf16(pa2, PK(l2, h2), od, 0, 0, 0);
  od = __builtin_amdgcn_mfma_f32_32x32x16_bf16(pa3, PK(l3, h3), od, 0, 0, 0);
#undef PK
}
__device__ __forceinline__ void pv_d0(f32x16* o, int vb, bf16x8 pa0, bf16x8 pa1, bf16x8 pa2, bf16x8 pa3) {
  pv_one<0>(o[0], vb, pa0, pa1, pa2, pa3); pv_one<1>(o[1], vb, pa0, pa1, pa2, pa3); pv_one<2>(o[2], vb, pa0, pa1, pa2, pa3); pv_one<3>(o[3], vb, pa0, pa1, pa2, pa3);
}

__device__ __forceinline__ void attn_dense_body(const bf16_t* __restrict__ Qb, const bf16_t* __restrict__ Kh, const bf16_t* __restrict__ Vh,
                                                bf16_t* Ob, int seq, char* lds, int wave_) {
  constexpr int SDEPTH = 2;
  int tid_ = wave_ * 64 + lane_id_fresh();
  const int tid = tid_, wid = tid >> 6, lane = tid & 63, r32 = lane & 31, hi = lane >> 5;
  bf16_t* V_lds = (bf16_t*)lds; bf16_t* K_lds = (bf16_t*)(lds + 2 * SHM_V);
  float* ws = (float*)(lds + 2 * SHM_V + 2 * SHM_K) + wid * 64; float* li_l = ws; float* al_l = ws + 32;
  float m_reg = -1e30f, l_reg = 0; f32x16 o[4] = {}; bf16x8 qr[8];
  const bf16_t* Qw = Qb + (long)(wid * QBLK + r32) * LDQ + hi * 8;
#pragma unroll
  for (int d0 = 0; d0 < 8; ++d0) qr[d0] = ld8(Qw + d0 * 16);
  const int sr = tid >> 4, sc = (tid & 15) * 8, vst0 = v_st(sr, sc), vst1 = v_st(32 + sr, sc);
  const int vb0 = (int)(uintptr_t)V_lds + v_rd_base(lane);
  struct { bf16x8 vs0, vs1, ks0, ks1; } sr_[SDEPTH];
#define SLOAD(i, k0) do { sr_[i].vs0 = ld8(&Vh[(long)((k0) + sr) * LDK + sc]); sr_[i].vs1 = ld8(&Vh[(long)((k0) + 32 + sr) * LDK + sc]); \
    sr_[i].ks0 = ld8(&Kh[(long)((k0) + sr) * LDK + sc]); sr_[i].ks1 = ld8(&Kh[(long)((k0) + 32 + sr) * LDK + sc]); } while (0)
#define SWRITE(b, i) do { *(bf16x8*)((char*)V_lds + (b) * SHM_V + vst0) = sr_[i].vs0;          \
    *(bf16x8*)((char*)V_lds + (b) * SHM_V + vst1) = sr_[i].vs1; int kc = sc * 2;               \
    *(bf16x8*)((char*)K_lds + (b) * SHM_K + KSWZ(sr, kc)) = sr_[i].ks0;                       \
    *(bf16x8*)((char*)K_lds + (b) * SHM_K + KSWZ(32 + sr, kc)) = sr_[i].ks1; } while (0)
#define SWAIT() asm volatile("s_waitcnt vmcnt(4)" ::: "memory")
#define RESC(a) do { if (__any((a) < 1.f)) { if (hi == 0) al_l[r32] = (a); asm volatile("s_waitcnt lgkmcnt(0)" ::: "memory"); \
    _Pragma("unroll") for (int d = 0; d < 4; ++d) _Pragma("unroll") for (int r = 0; r < 16; ++r) o[d][r] *= al_l[crow(r, hi)]; } } while (0)
  f32x16 pA0, pA1, pB0, pB1; float mnA, mnB, alA, alB; bf16x8 pa0, pa1, pa2, pa3; const int NT = seq / KVBLK;
  constexpr int SE = 0, SO = SDEPTH - 1;
  SLOAD(SE, 0); asm volatile("s_waitcnt vmcnt(0)" ::: "memory"); SWRITE(0, SE); __syncthreads();
  qkt(pA0, pA1, K_lds, qr, r32, hi); partialSM(pA0, pA1, m_reg, mnA, alA);
  SLOAD(SO, KVBLK); if (2 < NT) SLOAD(SE, 2 * KVBLK);
  SWAIT(); SWRITE(1, SO); __syncthreads();
  for (int j = 1; j + 1 < NT; j += 2) {
    SBAR(); qkt(pB0, pB1, (bf16_t*)((char*)K_lds + SHM_K), qr, r32, hi);
    finishSM(pA0, pA1, alA, l_reg, pa0, pa1, pa2, pa3); SBAR();
    SLOAD(SO, (j + SDEPTH) * KVBLK); SBAR();
    pv_d0(o, vb0, pa0, pa1, pa2, pa3); partialSM(pB0, pB1, m_reg, mnB, alB);
    __syncthreads(); SWAIT(); SWRITE(0, SE);
    RESC(alB); __syncthreads();
    SBAR(); qkt(pA0, pA1, K_lds, qr, r32, hi);
    finishSM(pB0, pB1, alB, l_reg, pa0, pa1, pa2, pa3); SBAR();
    if (j + 3 < NT) SLOAD(SE, (j + 1 + SDEPTH) * KVBLK); SBAR();
    pv_d0(o, vb0 + (int)SHM_V, pa0, pa1, pa2, pa3); partialSM(pA0, pA1, m_reg, mnA, alA);
    __syncthreads(); SWAIT(); SWRITE(1, SO);
    RESC(alA); __syncthreads();
  }
  SBAR(); qkt(pB0, pB1, (bf16_t*)((char*)K_lds + SHM_K), qr, r32, hi);
  finishSM(pA0, pA1, alA, l_reg, pa0, pa1, pa2, pa3); SBAR();
  pv_d0(o, vb0, pa0, pa1, pa2, pa3); partialSM(pB0, pB1, m_reg, mnB, alB);
  __syncthreads(); RESC(alB);
  finishSM(pB0, pB1, alB, l_reg, pa0, pa1, pa2, pa3); SBAR();
  pv_d0(o, vb0 + (int)SHM_V, pa0, pa1, pa2, pa3);
  if (hi == 0) li_l[r32] = l_reg; asm volatile("s_waitcnt lgkmcnt(0)" ::: "memory");
  float rli[16];
#pragma unroll
  for (int r = 0; r < 16; ++r) rli[r] = __builtin_amdgcn_rcpf(li_l[crow(r, hi)]);
  bf16_t* Ow = Ob + (long)(wid * QBLK) * LDO;
#pragma unroll
  for (int r = 0; r < 16; ++r) { int orow = crow(r, hi);
#pragma unroll
    for (int d0 = 0; d0 < 4; ++d0) Ow[(long)orow * LDO + d0 * 32 + r32] = f2bf(o[d0][r] * rli[r]); }
  __syncthreads();
#undef SLOAD
#undef SWRITE
#undef SWAIT
#undef RESC
}
#undef KSWZ
#undef SBAR
}
#define CAS __attribute__((address_space(4)))
#define INP(i) ((const float*)(GAS const float*)in[i])
struct Ctx {
    float* out; unsigned char* ws;
    LAS unsigned char* lds; int tid, lane, wave, wg, G;
};
enum { I_X = 0, I_C, I_CTX, I_CCTX, I_WMOD, I_BMOD, I_NMIX, I_NFFN, I_WIN, I_QN, I_KN, I_LCW, I_LCB, I_LWA, I_LBA, I_LWX, I_LBX, I_LLAM, I_SCW, I_SCB,
       I_WOA, I_WOL, I_WOS, I_WOUT, I_PWQ, I_PK1, I_PK2, I_PU, I_PV };

__device__ __forceinline__ float* xrow_ptr(const Ctx& c, int r) {
    return r < MLAT ? c.out + (size_t)r * DM : (float*)(c.ws + WS_CTXS) + (size_t)(r - MLAT) * DM;
}

__device__ __forceinline__ void transpose_item(const float* W, int K, int N, bf16_t* WT, LAS float* scr, int item, int lane) {
    const int nblk = N / 64, kb = item / nblk, nb = item % nblk, k0 = 64 * kb, n0 = 64 * nb;
    const float* src = W + (size_t)(k0 + (lane >> 4)) * N + n0 + (lane & 15) * 4;
    f32x4 v[16];
#pragma unroll
    for (int i = 0; i < 16; ++i) v[i] = *(const f32x4*)(src + (size_t)(4 * i) * N);
    LAS float* d = scr + (lane >> 4) * 65 + (lane & 15) * 4;
#pragma unroll
    for (int i = 0; i < 16; ++i) { d[(4 * i) * 65 + 0] = v[i][0]; d[(4 * i) * 65 + 1] = v[i][1]; d[(4 * i) * 65 + 2] = v[i][2]; d[(4 * i) * 65 + 3] = v[i][3]; }
    LDS_WAIT(); asm volatile("" ::: "memory");
    const int c = lane & 7;
#pragma unroll
    for (int j = 0; j < 8; ++j) { const int n = (lane >> 3) + 8 * j; const LAS float* s = scr + (8 * c) * 65 + n;
        u32x4 o; o.x = cvt_pk_bf16(s[0 * 65], s[1 * 65]); o.y = cvt_pk_bf16(s[2 * 65], s[3 * 65]); o.z = cvt_pk_bf16(s[4 * 65], s[5 * 65]); o.w = cvt_pk_bf16(s[6 * 65], s[7 * 65]);
        *(u32x4*)(WT + (size_t)(n0 + n) * K + k0 + 8 * c) = o; }
    LDS_WAIT(); asm volatile("" ::: "memory");
}

__device__ __forceinline__ void mod_unit(const Ctx& c, CAS const unsigned long long* in, int l, int cb) {
    LAS float* sv = (LAS float*)c.lds;
    LAS float* red = sv + 3 * DM;
    { const float* cc = INP(I_C); const float* cx = INP(I_CCTX);
      for (int i = c.tid; i < 3 * DM; i += NTHREADS) { const int v = i / DM, k = i % DM; const float x = v < 2 ? cc[v * DM + k] : cx[k]; sv[i] = x * sigmoidf_(x); } }
    __syncthreads();
    const int j4 = (c.tid & 31) * 4, kg = c.tid >> 5;
    const float* w = INP(I_WMOD) + (size_t)l * DM * NMOD + (size_t)(kg * 128) * NMOD + cb * 128 + j4;
    f32x4 a0 = {0.f, 0.f, 0.f, 0.f}, a1 = a0, a2 = a0;
#pragma unroll 8
    for (int k = 0; k < 128; ++k) { const f32x4 wv = *(const f32x4*)(w + (size_t)k * NMOD); const int kk = kg * 128 + k; a0 += wv * sv[kk]; a1 += wv * sv[DM + kk]; a2 += wv * sv[2 * DM + kk]; }
    *(LAS f32x4*)(red + (kg * 3 + 0) * 128 + j4) = a0; *(LAS f32x4*)(red + (kg * 3 + 1) * 128 + j4) = a1; *(LAS f32x4*)(red + (kg * 3 + 2) * 128 + j4) = a2;
    __syncthreads();
    if (c.tid < 384) { const int v = c.tid >> 7, jj = c.tid & 127; float s = INP(I_BMOD)[l * NMOD + cb * 128 + jj];
#pragma unroll
        for (int g = 0; g < 16; ++g) s += red[(g * 3 + v) * 128 + jj];
        ((float*)(c.ws + WS_MOD))[((size_t)l * 3 + v) * NMOD + cb * 128 + jj] = s; }
    __syncthreads();
}

__device__ __forceinline__ void wsc_unit(const Ctx& c, CAS const unsigned long long* in, int l, int u) {
    const int hh = u >> 4, kb = u & 15, h = hh >> 1, half = hh & 1, k0 = kb * 128;
    LAS float* kkL = (LAS float*)c.lds;
    LAS float* wqL = kkL + 128 * 132;
    const float* ksrc = INP(half ? I_PK2 : I_PK1) + ((size_t)(l * 8 + h) * 128) * 128;
    const float* qsrc = INP(I_PWQ) + (size_t)l * DM * DM + (size_t)k0 * DM + hh * 128;
    for (int i = c.tid; i < 128 * 32; i += NTHREADS) { const int r = i >> 5, c4 = (i & 31) * 4;
        *(LAS f32x4*)(kkL + r * 132 + c4) = *(const f32x4*)(ksrc + (size_t)r * 128 + c4);
        *(LAS f32x4*)(wqL + r * 132 + c4) = *(const f32x4*)(qsrc + (size_t)r * DM + c4); }
    __syncthreads();
    const int k = c.tid & 127, ng = c.tid >> 7;
    float acc[32];
#pragma unroll
    for (int j = 0; j < 32; ++j) acc[j] = 0.f;
    for (int d4 = 0; d4 < 32; ++d4) {
        const f32x4 a = *(const LAS f32x4*)(wqL + k * 132 + d4 * 4);
#pragma unroll
        for (int j = 0; j < 32; ++j) { const f32x4 b = *(const LAS f32x4*)(kkL + (ng * 32 + j) * 132 + d4 * 4); acc[j] += (a[0] * b[0] + a[1] * b[1]) + (a[2] * b[2] + a[3] * b[3]); }
    }
    bf16_t* dst = (bf16_t*)(c.ws + WS_WSC) + (size_t)(hh * 128 + ng * 32) * DM + k0 + k;
#pragma unroll
    for (int j = 0; j < 32; ++j) dst[(size_t)j * DM] = f2bf(acc[j]);
    __syncthreads();
}

#define GET_IN() unsigned long long kai_ = (unsigned long long)__builtin_amdgcn_kernarg_segment_ptr(); asm volatile("" : "+s"(kai_)); CAS const unsigned long long* in = (CAS const unsigned long long*)kai_
__device__ __forceinline__ void conv_units(const Ctx& c, int l) {
    GET_IN();
    if (l == 0) for (int u = c.wg; u < 2 * 96; u += c.G) mod_unit(c, in, u / 96, u % 96);
    for (int u = c.wg; u < 256; u += c.G) wsc_unit(c, in, l, u);
}
__device__ __forceinline__ void conv_transposes(const Ctx& c, int l) {
    GET_IN();
    const int gw = c.wg * NWAVES + c.wave, NGW = c.G * NWAVES;
    LAS float* scr = (LAS float*)(c.lds + c.wave * 16640);
    constexpr int I_IN = (DM / 64) * (NIN / 64), I_SQ = (DM / 64) * (DM / 64);
    const float* win = INP(I_WIN) + (size_t)l * DM * NIN;
    for (int it = gw; it < I_IN; it += NGW) transpose_item(win, DM, NIN, (bf16_t*)(c.ws + WS_WIN), scr, it, c.lane);
    for (int s = 0; s < 4; ++s) {
        const float* src = INP(s == 0 ? I_WOA : s == 1 ? I_WOL : s == 2 ? I_WOS : I_WOUT) + (size_t)l * DM * DM;
        bf16_t* dst = s < 3 ? (bf16_t*)(c.ws + WS_WO) + (size_t)s * DM * DM : (bf16_t*)(c.ws + WS_WOUT);
        for (int it = gw; it < I_SQ; it += NGW) transpose_item(src, DM, DM, dst, scr, it, c.lane);
    }
}
__device__ __forceinline__ void conv_tables(const Ctx& c, int l) {
    GET_IN();
    const size_t gt = (size_t)c.wg * NTHREADS + c.tid, NT = (size_t)c.G * NTHREADS;
    constexpr size_t NG16 = (size_t)16384 * DM / 16;
#pragma unroll 1
    for (int tb = 0; tb < 2; ++tb) {
        const float* srcb = INP(tb ? I_PV : I_PU) + (size_t)l * 16384 * DM; unsigned char* dstb = (unsigned char*)(c.ws + (tb ? WS_PV : WS_PU));
        const float sc = tb ? 1.f : 32.f;
        for (size_t j = gt; j < NG16; j += 2 * NT) {
            const size_t j2 = j + NT; const bool has2 = j2 < NG16;
            f32x4 a[4], b[4];
#pragma unroll
            for (int d = 0; d < 4; ++d) a[d] = *(const f32x4*)(srcb + j * 16 + d * 4);
#pragma unroll
            for (int d = 0; d < 4; ++d) b[d] = has2 ? *(const f32x4*)(srcb + j2 * 16 + d * 4) : (f32x4){0.f, 0.f, 0.f, 0.f};
            u32x4 o, o2;
#pragma unroll
            for (int d = 0; d < 4; ++d) { const f32x4 x = a[d] * sc, y = b[d] * sc;
                int w = __builtin_amdgcn_cvt_pk_fp8_f32(x[0], x[1], 0, false); w = __builtin_amdgcn_cvt_pk_fp8_f32(x[2], x[3], w, true); o[d] = (unsigned)w;
                int w2 = __builtin_amdgcn_cvt_pk_fp8_f32(y[0], y[1], 0, false); w2 = __builtin_amdgcn_cvt_pk_fp8_f32(y[2], y[3], w2, true); o2[d] = (unsigned)w2; }
            if (tb == 0) { *(u32x4*)(dstb + j * 16) = o; if (has2) *(u32x4*)(dstb + j2 * 16) = o2; }
            else {
                *(u32x4*)(dstb + (size_t)((j & 127) >> 3) * ((size_t)16384 * 128) + (j >> 7) * 128 + (j & 7) * 16) = o;
                if (has2) *(u32x4*)(dstb + (size_t)((j2 & 127) >> 3) * ((size_t)16384 * 128) + (j2 >> 7) * 128 + (j2 & 7) * 16) = o2; } }
    }
    for (size_t i = gt; i < (size_t)16 * 512 * 128; i += NT) { const int ci = (int)(i & 127), j = (int)((i >> 7) & 511), n = (int)(i >> 16), d = j >> 8, which = (j >> 7) & 1, dd = j & 127;
        const float* src = INP(which ? I_LWX : I_LWA) + ((((size_t)(l * 2 + d) * 16 + n) * 128 + ci) * 128 + dd);
        ((bf16_t*)(c.ws + WS_WLRU))[i] = f2bf(*src); }
}
__device__ __forceinline__ void sp_copy(const Ctx& c, const float* src, int sp_off, int n) {
    const size_t gt = (size_t)c.wg * NTHREADS + c.tid, NT = (size_t)c.G * NTHREADS;
    for (size_t i = gt; i < (size_t)n; i += NT) ((float*)(c.ws + WS_SP))[sp_off + i] = src[i];
}
__device__ __forceinline__ void conv_small(const Ctx& c, int l) {
    GET_IN();
    const size_t gt = (size_t)c.wg * NTHREADS + c.tid, NT = (size_t)c.G * NTHREADS;
    sp_copy(c, INP(I_NMIX) + l * DM, SP_NMIX, DM); sp_copy(c, INP(I_NFFN) + l * DM, SP_NFFN, DM);
    sp_copy(c, INP(I_QN) + l * 128, SP_QN, 128); sp_copy(c, INP(I_KN) + l * 128, SP_KN, 128);
    sp_copy(c, INP(I_LCW) + l * 4 * DM, SP_LCW, 4 * DM); sp_copy(c, INP(I_LCB) + l * DM, SP_LCB, DM);
    sp_copy(c, INP(I_LBA) + l * 2 * DM, SP_LBA, 2 * DM); sp_copy(c, INP(I_LBX) + l * 2 * DM, SP_LBX, 2 * DM);
    sp_copy(c, INP(I_SCW) + l * 3 * DM, SP_SCW, 3 * DM); sp_copy(c, INP(I_SCB) + l * DM, SP_SCB, DM);
    { const float* lam = INP(I_LLAM) + l * 2 * DM;
      for (size_t i = gt; i < (size_t)2 * DM; i += NT) ((float*)(c.ws + WS_SP))[SP_LSP + i] = 8.f * log1pf(expf(-lam[i])); }
}
__device__ __forceinline__ void conv_once(const Ctx& c) {
    GET_IN();
    const size_t gt = (size_t)c.wg * NTHREADS + c.tid, NT = (size_t)c.G * NTHREADS;
    for (size_t i = gt; i < 128 * 32; i += NT) { const int pos = (int)(i >> 5), p = (int)(i & 31);
        const float inv = exp2f(-(float)p * (13.287712379549449f / 32.f)); const float ang = (float)pos * inv;
        float sn, cs; sincosf(ang, &sn, &cs);
        ((float*)(c.ws + WS_ROPE))[i] = cs; ((float*)(c.ws + WS_ROPE))[128 * 32 + i] = sn; }
    { const f32x4* xs = (const f32x4*)INP(I_X); for (size_t i = gt; i < (size_t)MLAT * DM / 4; i += NT) ((f32x4*)c.out)[i] = xs[i]; }
    { const f32x4* cs_ = (const f32x4*)INP(I_CTX); for (size_t i = gt; i < (size_t)MCTX * DM / 4; i += NT) ((f32x4*)(c.ws + WS_CTXS))[i] = cs_[i]; }
}

__device__ __forceinline__ void phase_norm(const Ctx& c, int l, int nrows, int sp_gain, int slot_shift) {
    const int gw = c.wg * NWAVES + c.wave, NGW = c.G * NWAVES;
    const float* modl = (const float*)(c.ws + WS_MOD) + (size_t)l * 3 * NMOD;
    bf16_t* HX = (bf16_t*)(c.ws + WS_HX); const float* gain = (const float*)(c.ws + WS_SP) + sp_gain;
    for (int r = gw; r < nrows; r += NGW) {
        const int vec = r < SEQ ? 0 : (r < MLAT ? 1 : 2);
        const float* xr = xrow_ptr(c, r); const float* sh = modl + (size_t)vec * NMOD + slot_shift * DM; const float* sc = sh + DM;
        f32x4 v[8]; float ss = 0.f;
#pragma unroll
        for (int j = 0; j < 8; ++j) { v[j] = *(const f32x4*)(xr + j * 256 + c.lane * 4); ss += (v[j][0] * v[j][0] + v[j][1] * v[j][1]) + (v[j][2] * v[j][2] + v[j][3] * v[j][3]); }
        const float rs = rsqrtf(wave_sum(ss) * (1.f / DM) + EPS);
#pragma unroll
        for (int j = 0; j < 8; ++j) { const int col = j * 256 + c.lane * 4;
            const f32x4 g = *(const f32x4*)(gain + col), s1 = *(const f32x4*)(sc + col), s0 = *(const f32x4*)(sh + col);
            const f32x4 y = (v[j] * rs * g) * (s1 + 1.f) + s0;
            u32x2 o; o.x = cvt_pk_bf16(y[0], y[1]); o.y = cvt_pk_bf16(y[2], y[3]);
            *(u32x2*)(HX + (size_t)r * DM + col) = o; }
    }
}
__device__ __forceinline__ void seg_of_row(int r, bool& is_ctx, int& b, int& t) {
    is_ctx = r >= MLAT; b = is_ctx ? (r - MLAT) >> 8 : r >> 13; t = is_ctx ? (r - MLAT) & 255 : r & (SEQ - 1);
}
__device__ __forceinline__ void qk_row(const Ctx& c, int l, int r, bool do_q, bool dry) {
    bool is_ctx; int b, t; seg_of_row(r, is_ctx, b, t);
    const int key = is_ctx ? t : CTXL + t;
    bf16_t* prow = (bf16_t*)(c.ws + WS_P) + (size_t)r * NIN;
    bf16_t* KC = (bf16_t*)(c.ws + WS_KC); bf16_t* VC = (bf16_t*)(c.ws + WS_VC);
    const int hs = c.lane >> 4, ax = (c.lane >> 3) & 1, p0 = (c.lane & 7) * 4;
    f32x4 cs = {1.f, 1.f, 1.f, 1.f}, sn = {0.f, 0.f, 0.f, 0.f};
    if (!is_ctx) { const int pos = ax ? (t & 63) : (t >> 6); const float* rt = (const float*)(c.ws + WS_ROPE) + pos * 32 + p0; cs = *(const f32x4*)rt; sn = *(const f32x4*)(rt + 128 * 32); }
    u32x2 w1[5], w2[5];
#pragma unroll
    for (int g = 0; g < 5; ++g) { const bool is_k = (g == 4); const int head = is_k ? hs : g * 4 + hs;
        const bf16_t* src = prow + (is_k ? CK : CQ) + head * 128 + ax * 64 + p0;
        if (is_k || do_q) { w1[g] = *(const u32x2*)src; w2[g] = *(const u32x2*)(src + 32); } else { w1[g] = (u32x2){0u, 0u}; w2[g] = (u32x2){0u, 0u}; } }
    const u32x4 vw = *(const u32x4*)(prow + CV + (c.lane >> 4) * 128 + (c.lane & 15) * 8);
#pragma unroll
    for (int g = 0; g < 5; ++g) {
        const bool is_k = (g == 4);
        if (!is_k && !do_q) continue;
        const int head = is_k ? hs : g * 4 + hs;
        bf16_t* src = prow + (is_k ? CK : CQ) + head * 128 + ax * 64 + p0;
        f32x4 t1 = {bf_lo(w1[g].x), bf_hi(w1[g].x), bf_lo(w1[g].y), bf_hi(w1[g].y)}, t2 = {bf_lo(w2[g].x), bf_hi(w2[g].x), bf_lo(w2[g].y), bf_hi(w2[g].y)};
        float ss = (t1[0] * t1[0] + t1[1] * t1[1]) + (t1[2] * t1[2] + t1[3] * t1[3]) + (t2[0] * t2[0] + t2[1] * t2[1]) + (t2[2] * t2[2] + t2[3] * t2[3]);
        ss += DPPF(ss, 0xB1); ss += DPPF(ss, 0x4E); ss += DPPF(ss, 0x141); ss += DPPF(ss, 0x140);
        const float rs = rsqrtf(ss * (1.f / 128.f) + EPS);
        const float* gn = (const float*)(c.ws + WS_SP) + (is_k ? SP_KN : SP_QN) + ax * 64 + p0;
        const f32x4 g1 = *(const f32x4*)gn, g2 = *(const f32x4*)(gn + 32);
        const f32x4 y1 = t1 * rs * g1, y2 = t2 * rs * g2;
        const f32x4 o1 = y1 * cs - y2 * sn, o2 = y2 * cs + y1 * sn;
        bf16_t* dst = is_k ? KC + ((size_t)(b * 4 + head) * NKEY + key) * 128 + ax * 64 + p0 : (dry ? (bf16_t*)(c.ws + WS_YF) + (size_t)r * DM + head * 128 + ax * 64 + p0 : src);
        u32x2 a; a.x = cvt_pk_bf16(o1[0], o1[1]); a.y = cvt_pk_bf16(o1[2], o1[3]);
        u32x2 bq; bq.x = cvt_pk_bf16(o2[0], o2[1]); bq.y = cvt_pk_bf16(o2[2], o2[3]);
        *(u32x2*)dst = a; *(u32x2*)(dst + 32) = bq;
    }
    { const int hv = c.lane >> 4, dd = (c.lane & 15) * 8;
      *(u32x4*)(VC + ((size_t)(b * 4 + hv) * NKEY + key) * 128 + dd) = vw; }
}
__device__ __forceinline__ void unpack8(const u32x4 w, float (&f)[8]) {
    f[0] = bf_lo(w.x); f[1] = bf_hi(w.x); f[2] = bf_lo(w.y); f[3] = bf_hi(w.y); f[4] = bf_lo(w.z); f[5] = bf_hi(w.z); f[6] = bf_lo(w.w); f[7] = bf_hi(w.w);
}
__device__ __forceinline__ void sc_row(const Ctx& c, int l, int r, bool dry) {
    bool is_ctx; int b, t; seg_of_row(r, is_ctx, b, t);
    const int seglen = is_ctx ? CTXL : SEQ;
    bf16_t* prow = (bf16_t*)(c.ws + WS_P) + (size_t)r * NIN;
    const bool hp = t > 0, hn = t < seglen - 1;
    const float* w = (const float*)(c.ws + WS_SP) + SP_SCW; const float* bias = (const float*)(c.ws + WS_SP) + SP_SCB;
    u32x4 xb[4], xc0[4], xu0[4], xcp[4], xup[4], xcn[4], xun[4];
    const u32x4 z = {0u, 0u, 0u, 0u};
#pragma unroll
    for (int it = 0; it < 4; ++it) { const int col = it * 512 + c.lane * 8;
        xb[it] = *(const u32x4*)(prow + CBG + col); xc0[it] = *(const u32x4*)(prow + CCG + col); xu0[it] = *(const u32x4*)(prow + CU + col);
        xcp[it] = hp ? *(const u32x4*)(prow - NIN + CCG + col) : z; xup[it] = hp ? *(const u32x4*)(prow - NIN + CU + col) : z;
        xcn[it] = hn ? *(const u32x4*)(prow + NIN + CCG + col) : z; xun[it] = hn ? *(const u32x4*)(prow + NIN + CU + col) : z; }
#pragma unroll
    for (int it = 0; it < 4; ++it) {
        const int col = it * 512 + c.lane * 8;
        float bg[8], c0[8], u0[8], cp[8], up[8], cn[8], un[8];
        unpack8(xb[it], bg); unpack8(xc0[it], c0); unpack8(xu0[it], u0); unpack8(xcp[it], cp); unpack8(xup[it], up); unpack8(xcn[it], cn); unpack8(xun[it], un);
        float o[8];
#pragma unroll
        for (int hq = 0; hq < 2; ++hq) { const f32x4 w0 = *(const f32x4*)(w + col + hq * 4), w1 = *(const f32x4*)(w + DM + col + hq * 4), w2 = *(const f32x4*)(w + 2 * DM + col + hq * 4), bi = *(const f32x4*)(bias + col + hq * 4);
#pragma unroll
            for (int e = 0; e < 4; ++e) { const int k = hq * 4 + e; o[k] = bg[k] * (bi[e] + w0[e] * (cp[k] * up[k]) + w1[e] * (c0[k] * u0[k]) + w2[e] * (cn[k] * un[k])); } }
        u32x4 ow; ow.x = cvt_pk_bf16(o[0], o[1]); ow.y = cvt_pk_bf16(o[2], o[3]); ow.z = cvt_pk_bf16(o[4], o[5]); ow.w = cvt_pk_bf16(o[6], o[7]);
        *(u32x4*)((dry ? (bf16_t*)(c.ws + WS_YF) + (size_t)(MALL + r) * DM : prow + CBG) + col) = ow;
    }
}

constexpr size_t lsum_idx(int which, int dir, int b, int j) { return ((((size_t)which * 2 + dir) * NB + b) * NCHUNK + j) * DM; }
template <int DIR, int PASS>
__device__ __forceinline__ void lru_chunk(const LAS bf16_t* ub, const LAS float* uf, LAS float* hsd, const bf16x8 (&bfr)[4][4], const float (&ba)[2], const float (&bx)[2], const float (&sp8)[2],
                                          const float (&cin)[2], float (&Atot)[2], float (&Hend)[2], int q, int col16, int quad) {
    float st[2] = {cin[0], cin[1]}, at[2] = {1.f, 1.f};
    const int mysg = DIR ? 3 - quad : quad;
    for (int smt = 0; smt < 4; ++smt) {
        const int mt = DIR ? 3 - smt : smt;
        f32x4 acc[4];
#pragma unroll
        for (int nt = 0; nt < 4; ++nt) acc[nt] = (f32x4){0.f, 0.f, 0.f, 0.f};
#pragma unroll
        for (int ks = 0; ks < 4; ++ks) { const bf16x8 a = *(const LAS bf16x8*)(ub + (mt * 16 + col16) * 136 + ks * 32 + quad * 8);
#pragma unroll
            for (int nt = 0; nt < 4; ++nt) acc[nt] = __builtin_amdgcn_mfma_f32_16x16x32_bf16(a, bfr[nt][ks], acc[nt], 0, 0, 0); }
#pragma unroll
        for (int ct = 0; ct < 2; ++ct) {
            const int ch = q * 32 + ct * 16 + col16;
            float av[4], dv[4];
#pragma unroll
            for (int reg = 0; reg < 4; ++reg) { const int tl = mt * 16 + quad * 4 + reg;
                const float r = sigmoidf_(acc[ct][reg] + ba[ct]), ig = sigmoidf_(acc[2 + ct][reg] + bx[ct]);
                const float a = __expf(-sp8[ct] * r);
                av[reg] = a; dv[reg] = __builtin_amdgcn_sqrtf(fmaxf(1.f - a * a, 0.f)) * ig * uf[tl * 128 + ch]; }
            float Al = 1.f, Hl = 0.f;
#pragma unroll
            for (int sr = 0; sr < 4; ++sr) { const int reg = DIR ? 3 - sr : sr; Hl = av[reg] * Hl + dv[reg]; Al *= av[reg]; }
            float se = st[ct], so = st[ct], ap = 1.f;
#pragma unroll
            for (int sg = 0; sg < 4; ++sg) { const int qp = DIR ? 3 - sg : sg; const float Ag = __shfl(Al, col16 + 16 * qp), Hg = __shfl(Hl, col16 + 16 * qp);
                const float nx = Ag * so + Hg; so = nx; if (sg < mysg) se = nx; ap *= Ag; }
            if (PASS == 2) { float h = se;
#pragma unroll
                for (int sr = 0; sr < 4; ++sr) { const int reg = DIR ? 3 - sr : sr; h = av[reg] * h + dv[reg]; hsd[(mt * 16 + quad * 4 + reg) * 128 + ch] = h; } }
            else at[ct] *= ap;
            st[ct] = so;
        }
    }
    Atot[0] = at[0]; Atot[1] = at[1]; Hend[0] = st[0]; Hend[1] = st[1];
}

template <int PASS>
__device__ __forceinline__ void lru_run(const Ctx& c, int l, int unit, bool dry = false) {
    const int b = unit >> 7, n = (unit >> 3) & 15, run = unit & 7;
    const int c0 = run * 16 + (run < 4 ? run : 4), len = 16 + (run < 4 ? 1 : 0);
    LAS float* xl = (LAS float*)c.lds;
    LAS float* uf = (LAS float*)(c.lds + 34816);
    LAS bf16_t* ub = (LAS bf16_t*)(c.lds + 34816 + 32768);
    LAS float* car = (LAS float*)(c.lds + 34816 + 32768 + 17408);
    LAS float* hsr = (LAS float*)(c.lds + 34816 + 32768 + 17408 + 17408);
    const int d = c.wave >> 2, q = c.wave & 3, col16 = c.lane & 15, quad = c.lane >> 4;
    float* LS = (float*)(c.ws + WS_LSUM);
    bf16_t* P = (bf16_t*)(c.ws + WS_P);
    bf16x8 bfr[4][4];
#pragma unroll
    for (int nt = 0; nt < 4; ++nt) { const int j = d * 256 + (nt >> 1) * 128 + q * 32 + (nt & 1) * 16 + col16;
#pragma unroll
        for (int ks = 0; ks < 4; ++ks) bfr[nt][ks] = *(const bf16x8*)((const bf16_t*)(c.ws + WS_WLRU) + ((size_t)(n * 512 + j) * 128 + ks * 32 + quad * 8)); }
    float ba[2], bx[2], sp8[2];
#pragma unroll
    for (int ct = 0; ct < 2; ++ct) { const int cidx = n * 128 + q * 32 + ct * 16 + col16; const float* sp = (const float*)(c.ws + WS_SP) + d * DM + cidx;
        ba[ct] = sp[SP_LBA]; bx[ct] = sp[SP_LBX]; sp8[ct] = sp[SP_LSP]; }
    if (PASS == 2) {
        if (c.tid < 256) { const int dir = c.tid >> 7, ch = c.tid & 127, cidx = n * 128 + ch; float st = 0.f;
#pragma unroll 1
            for (int k0 = 0; k0 < NCHUNK; k0 += 12) {
                float av[12], hv[12];
#pragma unroll
                for (int kk = 0; kk < 12; ++kk) { const int k = k0 + kk, j = dir ? (k < 4 ? 3 - k : 135 - k) : k; av[kk] = LS[lsum_idx(0, dir, b, j) + cidx]; hv[kk] = LS[lsum_idx(1, dir, b, j) + cidx]; }
#pragma unroll
                for (int kk = 0; kk < 12; ++kk) { const int k = k0 + kk, j = dir ? (k < 4 ? 3 - k : 135 - k) : k;
                    if (j >= c0 && j < c0 + len) car[(dir * 17 + (j - c0)) * 128 + ch] = st;
                    st = av[kk] * st + hv[kk]; } } }
        __syncthreads();
    }
    const float* cw = (const float*)(c.ws + WS_SP) + SP_LCW + n * 128; const float* cb = (const float*)(c.ws + WS_SP) + SP_LCB + n * 128;
#define LRU_GEOM(ci_, jc, is_ctx, rb, t0, seglen) const int jc = c0 + (ci_); const bool is_ctx = jc < 4; \
        const int rb = is_ctx ? MLAT + b * CTXL : b * SEQ, t0 = is_ctx ? jc * 64 : (jc - 4) * 64, seglen = is_ctx ? CTXL : SEQ
#define LRU_LOAD(ci_, XR, LG) do { LRU_GEOM(ci_, jc_, ic_, rb_, t0_, sl_); (void)ic_; \
        _Pragma("unroll") for (int ps = 0; ps < 3; ++ps) { const int i = ps * 32 + (c.tid >> 4); const int t = t0_ - 2 + i; XR[ps] = (u32x4){0u, 0u, 0u, 0u}; \
            if (i < 68 && t >= 0 && t < sl_) XR[ps] = *(const u32x4*)(P + (size_t)(rb_ + t) * NIN + CLX + n * 128 + (c.tid & 15) * 8); } \
        if (PASS == 2) { const bf16_t* gp_ = P + (size_t)(rb_ + t0_ + (c.tid >> 3)) * NIN + CLG + n * 128 + (c.tid & 7) * 16; LG[0] = *(const u32x4*)gp_; LG[1] = *(const u32x4*)(gp_ + 8); } } while (0)
    u32x4 xr[3], lgc[2] = {{0u, 0u, 0u, 0u}, {0u, 0u, 0u, 0u}}, lgn[2] = {{0u, 0u, 0u, 0u}, {0u, 0u, 0u, 0u}};
    LRU_LOAD(0, xr, lgn);
    for (int ci = 0; ci < len; ++ci) {
        LRU_GEOM(ci, jc, is_ctx, rb, t0, seglen); (void)is_ctx; (void)seglen;
#pragma unroll
        for (int ps = 0; ps < 3; ++ps) { const int i = ps * 32 + (c.tid >> 4);
            if (i < 68) { float f[8]; unpack8(xr[ps], f);
                *(LAS f32x4*)(xl + i * 128 + (c.tid & 15) * 8) = (f32x4){f[0], f[1], f[2], f[3]}; *(LAS f32x4*)(xl + i * 128 + (c.tid & 15) * 8 + 4) = (f32x4){f[4], f[5], f[6], f[7]}; } }
        lgc[0] = lgn[0]; lgc[1] = lgn[1];
        __syncthreads();
        if (ci + 1 < len) LRU_LOAD(ci + 1, xr, lgn);
        { const int ch = c.tid & 127, tq = c.tid >> 7; const float w0 = cw[ch], w1 = cw[DM + ch], w2 = cw[2 * DM + ch], w3 = cw[3 * DM + ch], bb = cb[ch];
#pragma unroll 4
          for (int tt = 0; tt < 16; ++tt) { const int tl = tq * 16 + tt;
              const float u = bb + w0 * xl[tl * 128 + ch] + w1 * xl[(tl + 1) * 128 + ch] + w2 * xl[(tl + 2) * 128 + ch] + w3 * xl[(tl + 3) * 128 + ch];
              uf[tl * 128 + ch] = u; ub[tl * 136 + ch] = f2bf(u); } }
        __syncthreads();
        float cin[2] = {0.f, 0.f}, At[2], He[2];
        if (PASS == 2) { cin[0] = car[(d * 17 + ci) * 128 + q * 32 + col16]; cin[1] = car[(d * 17 + ci) * 128 + q * 32 + 16 + col16]; }
        if (d == 0) lru_chunk<0, PASS>(ub, uf, xl, bfr, ba, bx, sp8, cin, At, He, q, col16, quad);
        else lru_chunk<1, PASS>(ub, uf, hsr, bfr, ba, bx, sp8, cin, At, He, q, col16, quad);
        if (PASS == 1) {
            if (quad == 0) {
#pragma unroll
                for (int ct = 0; ct < 2; ++ct) { const int cidx = n * 128 + q * 32 + ct * 16 + col16;
                    LS[lsum_idx(0, d, b, jc) + cidx] = At[ct]; LS[lsum_idx(1, d, b, jc) + cidx] = He[ct]; } }
            __syncthreads();
        } else {
            __syncthreads();
            { const int row = c.tid >> 3, cs = (c.tid & 7) * 16;
              bf16_t* gp = P + (size_t)(rb + t0 + row) * NIN + CLG + n * 128 + cs;
#pragma unroll
              for (int hseg = 0; hseg < 2; ++hseg) { float g[8]; unpack8(lgc[hseg], g);
                  const int o = row * 128 + cs + hseg * 8;
                  const f32x4 h0 = *(const LAS f32x4*)(xl + o) + *(const LAS f32x4*)(hsr + o), h1 = *(const LAS f32x4*)(xl + o + 4) + *(const LAS f32x4*)(hsr + o + 4);
                  u32x4 ow; ow.x = cvt_pk_bf16(h0[0] * gelu_tanh(g[0]), h0[1] * gelu_tanh(g[1])); ow.y = cvt_pk_bf16(h0[2] * gelu_tanh(g[2]), h0[3] * gelu_tanh(g[3]));
                  ow.z = cvt_pk_bf16(h1[0] * gelu_tanh(g[4]), h1[1] * gelu_tanh(g[5])); ow.w = cvt_pk_bf16(h1[2] * gelu_tanh(g[6]), h1[3] * gelu_tanh(g[7]));
                  *(u32x4*)((dry ? gp - CLG + CU : gp) + hseg * 8) = ow; } }
            __syncthreads();
        }
    }
#undef LRU_GEOM
#undef LRU_LOAD
}

__device__ __forceinline__ void phase_qk(const Ctx& c, int l, bool dry = false) {
    const int gw = c.wg * NWAVES + c.wave, NGW = c.G * NWAVES;
    for (int r = gw; r < MALL; r += NGW) qk_row(c, l, r, l == 0 || r < MLAT, dry);
}
__device__ __forceinline__ void phase_sc(const Ctx& c, int l, bool dry = false) {
    const int gw = c.wg * NWAVES + c.wave, NGW = c.G * NWAVES;
    const int nsc = (l == 0) ? MALL : MLAT;
    for (int r = gw; r < nsc; r += NGW) sc_row(c, l, r, dry);
}
__device__ __forceinline__ void phase_lru1(const Ctx& c, int l) {
    for (int u = c.wg; u < 256; u += c.G) lru_run<1>(c, l, u);
}

__device__ __forceinline__ void phase_m2(const Ctx& c, int l, bool dry = false) {
    bf16_t* P = (bf16_t*)(c.ws + WS_P); const bf16_t* KC = (const bf16_t*)(c.ws + WS_KC); const bf16_t* VC = (const bf16_t*)(c.ws + WS_VC);
    const int ntot = 1024 + (l == 0 ? 32 : 0);
    for (int i = 0; i * c.G + c.wg < ntot; ++i) {
        const int L = i * c.G + c.wg; int b, h, seq; size_t qrow;
        if (L < 1024) { int grp, qb;
            if (c.G == 256) { grp = i * 8 + (c.wg & 7); qb = c.wg >> 3; } else { grp = L >> 5; qb = L & 31; }
            b = grp >> 4; h = grp & 15; qrow = (size_t)(b * SEQ + qb * 256); seq = NKEY; }
        else { const int u = L - 1024; b = u >> 4; h = u & 15; qrow = (size_t)(MLAT + b * CTXL); seq = CTXL; }
        bf16_t* q = P + qrow * NIN + CQ + h * 128;
        const size_t kvo = (size_t)(b * 4 + (h >> 2)) * NKEY * 128;
        att::attn_dense_body(q, KC + kvo, VC + kvo, dry ? q - CQ + CCG : q, seq, (char*)c.lds, c.wave);
    }
}
__device__ __forceinline__ void phase_lru2(const Ctx& c, int l, bool dry = false) {
    for (int u = c.wg; u < 256; u += c.G) lru_run<2>(c, l, u, dry);
}
constexpr float NEGBIG = -3.0e38f;
constexpr float PU_SCALE = 32.f;
__device__ __forceinline__ float wave_max_dpp(float v) {
    v = fmaxf(v, DPPF(v, 0xB1)); v = fmaxf(v, DPPF(v, 0x4E)); v = fmaxf(v, DPPF(v, 0x141)); v = fmaxf(v, DPPF(v, 0x140));
    const float a = __int_as_float(__builtin_amdgcn_readlane(__float_as_int(v), 0)), b = __int_as_float(__builtin_amdgcn_readlane(__float_as_int(v), 16));
    const float c = __int_as_float(__builtin_amdgcn_readlane(__float_as_int(v), 32)), d = __int_as_float(__builtin_amdgcn_readlane(__float_as_int(v), 48));
    return fmaxf(fmaxf(a, b), fmaxf(c, d));
}
#define SWZ_XOR(v, m) __int_as_float(__builtin_amdgcn_ds_swizzle(__float_as_int(v), ((m) << 10) | 0x1F))
__device__ __forceinline__ unsigned fkey(float x) { const unsigned u = __float_as_uint(x); return (u & 0x80000000u) ? ~u : (u | 0x80000000u); }
#define DPPU(v, ctrl) ((unsigned)__builtin_amdgcn_update_dpp(0, (int)(v), ctrl, 0xF, 0xF, true))
__device__ __forceinline__ unsigned wave_max_u32(unsigned v) {
    v = max(v, DPPU(v, 0xB1)); v = max(v, DPPU(v, 0x4E)); v = max(v, DPPU(v, 0x141)); v = max(v, DPPU(v, 0x140));
    const unsigned a = (unsigned)__builtin_amdgcn_readlane((int)v, 0), b = (unsigned)__builtin_amdgcn_readlane((int)v, 16), c = (unsigned)__builtin_amdgcn_readlane((int)v, 32), d = (unsigned)__builtin_amdgcn_readlane((int)v, 48);
    return max(max(a, b), max(c, d));
}
__device__ __forceinline__ unsigned topk16_keys2(unsigned k0, unsigned k1, int lane) {
    unsigned res = 0u;
    for (int it = 0; it < 16; ++it) { const unsigned m = wave_max_u32(max(k0, k1)); k0 = (k0 == m) ? 0u : k0; k1 = (k1 == m) ? 0u : k1; res = (lane == it) ? m : res; }
    return res;
}
__device__ __forceinline__ unsigned topk16_keys1(unsigned k0, int lane) {
    unsigned res = 0u;
    for (int it = 0; it < 16; ++it) { const unsigned m = wave_max_u32(k0); k0 = (k0 == m) ? 0u : k0; res = (lane == it) ? m : res; }
    return res;
}
__device__ __forceinline__ void unpack_fp8x16(const u32x4 w, float (&f)[16]) {
#pragma unroll
    for (int d = 0; d < 4; ++d) { const f32x2 lo = __builtin_amdgcn_cvt_pk_f32_fp8((int)w[d], false), hi = __builtin_amdgcn_cvt_pk_f32_fp8((int)w[d], true);
        f[4 * d] = lo.x; f[4 * d + 1] = lo.y; f[4 * d + 2] = hi.x; f[4 * d + 3] = hi.y; }
}

__device__ __forceinline__ unsigned half_max_u32(unsigned v, bool hi_half) {
    v = max(v, DPPU(v, 0xB1)); v = max(v, DPPU(v, 0x4E)); v = max(v, DPPU(v, 0x141)); v = max(v, DPPU(v, 0x140));
    const unsigned a = max((unsigned)__builtin_amdgcn_readlane((int)v, 0), (unsigned)__builtin_amdgcn_readlane((int)v, 16));
    const unsigned b = max((unsigned)__builtin_amdgcn_readlane((int)v, 32), (unsigned)__builtin_amdgcn_readlane((int)v, 48));
    return hi_half ? b : a;
}
__device__ __forceinline__ unsigned topk16_half4(unsigned (&k)[4], int hl, bool hi_half) {
    unsigned res = 0u;
    for (int it = 0; it < 16; ++it) { const unsigned m = half_max_u32(max(max(k[0], k[1]), max(k[2], k[3])), hi_half);
#pragma unroll
        for (int j = 0; j < 4; ++j) k[j] = (k[j] == m) ? 0u : k[j];
        res = (hl == it) ? m : res; }
    return res;
}
__device__ __forceinline__ unsigned topk16_half2(unsigned k0, unsigned k1, int hl, bool hi_half) {
    unsigned res = 0u;
    for (int it = 0; it < 16; ++it) { const unsigned m = half_max_u32(max(k0, k1), hi_half); k0 = (k0 == m) ? 0u : k0; k1 = (k1 == m) ? 0u : k1; res = (hl == it) ? m : res; }
    return res;
}
__device__ __forceinline__ void cand_ab(int cidx50, int& a, int& b) {
    a = cidx50 < 16 ? 0 : cidx50 < 24 ? 1 : cidx50 < 29 ? 2 : cidx50 < 33 ? 3 : cidx50 < 36 ? 4 : cidx50 < 38 ? 5 : cidx50 < 40 ? 6 : cidx50 < 42 ? 7 : cidx50 - 34;
    const int st = cidx50 < 16 ? 0 : cidx50 < 24 ? 16 : cidx50 < 29 ? 24 : cidx50 < 33 ? 29 : cidx50 < 36 ? 33 : cidx50 < 38 ? 36 : cidx50 < 40 ? 38 : cidx50 < 42 ? 40 : cidx50;
    b = cidx50 - st;
}
__device__ __forceinline__ void peer_topk_pair(const LAS float* srow, int hp, LAS float* gsc, LAS int* isc, int lane) {
    const int hl = lane & 31, hb = lane & 32; const bool hi_half = lane >= 32; const int h = 2 * hp + (hi_half ? 1 : 0);
    const LAS float* sh = srow + h * 256;
    unsigned k1[4], k2[4];
#pragma unroll
    for (int j = 0; j < 4; ++j) { const int idx = hl + 32 * j; k1[j] = (fkey(sh[idx]) & ~127u) | (unsigned)(127 - idx); k2[j] = (fkey(sh[128 + idx]) & ~127u) | (unsigned)(127 - idx); }
    const unsigned r1 = topk16_half4(k1, hl, hi_half), r2 = topk16_half4(k2, hl, hi_half);
    const int i1 = 127 - (int)(r1 & 127u), i2 = 127 - (int)(r2 & 127u);
    const float v1 = sh[i1], v2 = sh[128 + i2];
    int a0, b0, a1, b1; cand_ab(hl, a0, b0); cand_ab(hl + 32, a1, b1);
    const float c0 = __shfl(v1, hb + a0) + __shfl(v2, hb + b0), c1 = __shfl(v1, hb + (a1 & 15)) + __shfl(v2, hb + (b1 & 15));
    const unsigned q0 = (fkey(c0) & ~255u) | (unsigned)(255 - (a0 * 16 + b0)), q1 = (hl + 32 < 50) ? ((fkey(c1) & ~255u) | (unsigned)(255 - (a1 * 16 + b1))) : 0u;
    const unsigned r3 = topk16_half2(q0, q1, hl, hi_half);
    const int ci = 255 - (int)(r3 & 255u);
    const float sc = __shfl(v1, hb + (ci >> 4)) + __shfl(v2, hb + (ci & 15));
    const int e = __shfl(i1, hb + (ci >> 4)) * 128 + __shfl(i2, hb + (ci & 15));
    const float mxa = __int_as_float(__builtin_amdgcn_readlane(__float_as_int(sc), 0)), mxb = __int_as_float(__builtin_amdgcn_readlane(__float_as_int(sc), 32));
    const float ex = hl < 16 ? __expf(sc - (hi_half ? mxb : mxa)) : 0.f;
    float sm = ex; sm += DPPF(sm, 0xB1); sm += DPPF(sm, 0x4E); sm += DPPF(sm, 0x141); sm += DPPF(sm, 0x140);
    if (hl < 16) { gsc[h * 16 + hl] = ex / sm; isc[h * 16 + hl] = e; }
}

constexpr size_t WS_PE_E = WS_P + 160 * MiB, WS_PE_CF = WS_PE_E + (size_t)MALL * 128 * 4;
constexpr int NSL = 16, SLW = 128;
constexpr size_t SLICE_BYTES = (size_t)16384 * SLW;
__device__ __forceinline__ void peer_token(const Ctx& c, int l, int r, int rn, int b, bool dry) {
    LAS float* gsc = (LAS float*)(c.lds + c.wave * 2048 + b * 1024);
    LAS int* isc = (LAS int*)(c.lds + c.wave * 2048 + b * 1024 + 512);
    LAS float* gscn = (LAS float*)(c.lds + c.wave * 2048 + (b ^ 1) * 1024); LAS int* iscn = (LAS int*)(c.lds + c.wave * 2048 + (b ^ 1) * 1024 + 512);
    const float* Sn = (const float*)(c.ws + WS_P) + (size_t)(rn < 0 ? r : rn) * DM;
    const int lane = c.lane;
    LAS float* snb = (LAS float*)(c.lds + 16384 + c.wave * 8192);
    f32x4 sv[8];
#pragma unroll
    for (int q = 0; q < 8; ++q) sv[q] = (rn >= 0) ? *(const f32x4*)(Sn + q * 256 + lane * 4) : (f32x4){0.f, 0.f, 0.f, 0.f};
    LDS_WAIT(); asm volatile("" ::: "memory");
    const bf16_t* hx = (const bf16_t*)(c.ws + WS_HX) + (size_t)r * DM;
    float hv[2][16];
#pragma unroll
    for (int j = 0; j < 2; ++j) { float t0[8], t1[8]; unpack8(*(const u32x4*)(hx + j * 1024 + lane * 16), t0); unpack8(*(const u32x4*)(hx + j * 1024 + lane * 16 + 8), t1);
#pragma unroll
        for (int k = 0; k < 8; ++k) { hv[j][k] = t0[k]; hv[j][8 + k] = t1[k]; } }
    const unsigned char* PU = (const unsigned char*)(c.ws + WS_PU); const unsigned char* PV = (const unsigned char*)(c.ws + WS_PV);
#define PEER_LOADROW(tab, wk, e_) do { const unsigned char* row_ = (tab) + (size_t)__builtin_amdgcn_readfirstlane(e_) * DM + lane * 16; wk[0] = *(const u32x4*)row_; wk[1] = *(const u32x4*)(row_ + 1024); } while (0)
#define PEER_IDX8(dst, i_) const u32x4 ia_##dst = *(const LAS u32x4*)(isc + (i_)), ib_##dst = *(const LAS u32x4*)(isc + (i_) + 4); \
        const int dst[8] = {(int)ia_##dst[0], (int)ia_##dst[1], (int)ia_##dst[2], (int)ia_##dst[3], (int)ib_##dst[0], (int)ib_##dst[1], (int)ib_##dst[2], (int)ib_##dst[3]}
    u32x4 w[8][2];
    { PEER_IDX8(e0, 0);
#pragma unroll
      for (int k = 0; k < 8; ++k) PEER_LOADROW(PU, w[k], e0[k]); }
    if (rn >= 0) {
#pragma unroll
        for (int q = 0; q < 8; ++q) *(LAS f32x4*)(snb + q * 256 + lane * 4) = sv[q];
        LDS_WAIT(); asm volatile("" ::: "memory"); }
#pragma unroll 1
    for (int i = 0; i < 128; i += 8) {
        const bool has_next = i + 8 < 128;
        PEER_IDX8(en, has_next ? i + 8 : i);
        if (rn >= 0 && (i & 24) == 0) peer_topk_pair(snb, i >> 5, gscn, iscn, lane);
        float p[8];
#pragma unroll
        for (int k = 0; k < 8; ++k) {
            asm volatile("" : "+v"(w[k][0]), "+v"(w[k][1]));
            float s = 0.f;
#pragma unroll
            for (int j = 0; j < 2; ++j) { float f[16]; unpack_fp8x16(w[k][j], f);
#pragma unroll
                for (int e2 = 0; e2 < 16; ++e2) s += f[e2] * hv[j][e2]; }
            p[k] = s; asm volatile("" : "+v"(p[k]));
            if (has_next) PEER_LOADROW(PU, w[k], en[k]); }
        const bool b0 = lane & 1, b1 = lane & 2, b2 = lane & 4;
        float q[4], t[2];
#pragma unroll
        for (int m = 0; m < 4; ++m) q[m] = (b0 ? p[2 * m + 1] : p[2 * m]) + DPPF(b0 ? p[2 * m] : p[2 * m + 1], 0xB1);
#pragma unroll
        for (int m = 0; m < 2; ++m) t[m] = (b1 ? q[2 * m + 1] : q[2 * m]) + DPPF(b1 ? q[2 * m] : q[2 * m + 1], 0x4E);
        float s = (b2 ? t[1] : t[0]) + SWZ_XOR(b2 ? t[0] : t[1], 4);
        s += SWZ_XOR(s, 8); s += SWZ_XOR(s, 16); s += __shfl_xor(s, 32);
        if (lane < 8) gsc[i + lane] = gsc[i + lane] * gelu_tanh(s * (1.f / PU_SCALE));
    }
#undef PEER_LOADROW
#undef PEER_IDX8
    LDS_WAIT(); asm volatile("" ::: "memory");
    { int* E = (int*)(c.ws + WS_PE_E) + (size_t)r * 128; float* CF = (float*)(c.ws + WS_PE_CF) + (size_t)r * 128;
      E[lane] = isc[lane]; E[64 + lane] = isc[64 + lane]; CF[lane] = gsc[lane]; CF[64 + lane] = gsc[64 + lane]; }
    LDS_WAIT(); asm volatile("" ::: "memory");
}
__device__ __forceinline__ void phase_peer(const Ctx& c, int l, int nrows, bool dry = false) {
    const int gw = c.wg * NWAVES + c.wave, NGW = c.G * NWAVES;
    int r = gw; if (r >= nrows) return;
    { const float* S0 = (const float*)(c.ws + WS_P) + (size_t)r * DM; LAS float* snb0 = (LAS float*)(c.lds + 16384 + c.wave * 8192);
#pragma unroll
      for (int q = 0; q < 8; ++q) *(LAS f32x4*)(snb0 + q * 256 + c.lane * 4) = *(const f32x4*)(S0 + q * 256 + c.lane * 4);
      LDS_WAIT(); asm volatile("" ::: "memory");
#pragma unroll 1
      for (int hp = 0; hp < 4; ++hp) peer_topk_pair(snb0, hp, (LAS float*)(c.lds + c.wave * 2048), (LAS int*)(c.lds + c.wave * 2048 + 512), c.lane);
      LDS_WAIT(); asm volatile("" ::: "memory"); }
    int b = 0;
#pragma unroll 1
    for (; r < nrows; r += NGW, b ^= 1) { const int rn = r + NGW; peer_token(c, l, r, rn < nrows ? rn : -1, b, dry); }
}
#define PEER_SLICE_BEGIN() { const int grp = c.wg & 7, wi = (c.wg >> 3) * NWAVES + c.wave, nwi = ((c.G - grp + 7) >> 3) * NWAVES; \
    _Pragma("unroll 1") for (int ps = 0; ps < 2; ++ps) { const int s = grp + 8 * ps; _Pragma("unroll 1") for (int r = wi; r < nrows; r += nwi) {
#define PEER_SLICE_END() } } }
__device__ __forceinline__ void phase_peer_v(const Ctx& c, int l, int nrows, bool dry) {
    const int lane = c.lane, rg = lane >> 3, ch = lane & 7;
    const int* Eb = (const int*)(c.ws + WS_PE_E); const float* CF = (const float*)(c.ws + WS_PE_CF);
    const bool b3 = lane & 8, b4 = lane & 16, b5 = lane & 32;
    const int grp = c.wg & 7, wi = (c.wg >> 3) * NWAVES + c.wave, nwi = ((c.G - grp + 7) >> 3) * NWAVES;
#define V_META(r_, e0_, e1_, c0_, c1_) do { if ((r_) < nrows) { e0_ = Eb[(size_t)(r_) * 128 + lane]; e1_ = Eb[(size_t)(r_) * 128 + 64 + lane]; c0_ = CF[(size_t)(r_) * 128 + lane]; c1_ = CF[(size_t)(r_) * 128 + 64 + lane]; } } while (0)
#pragma unroll 1
    for (int ps = 0; ps < 2; ++ps) { const int s = grp + 8 * ps;
        const unsigned char* tab = (const unsigned char*)(c.ws + WS_PV) + (size_t)s * SLICE_BYTES + ch * 16;
        const int col = s * SLW + ch * 16 + (b3 ? 8 : 0) + (b4 ? 4 : 0) + (b5 ? 2 : 0);
        int r = wi; int e0 = 0, e1 = 0; float c0 = 0.f, c1 = 0.f;
        V_META(r, e0, e1, c0, c1);
#pragma unroll 1
        for (; r < nrows; r += nwi) {
            u32x4 w[16];
#pragma unroll
            for (int i = 0; i < 16; ++i) { const int e = __shfl(i < 8 ? e0 : e1, (8 * i + rg) & 63); w[i] = *(const u32x4*)(tab + (size_t)e * SLW); }
            int f0 = 0, f1 = 0; float d0 = 0.f, d1 = 0.f; V_META(r + nwi, f0, f1, d0, d1);
            const int vec = r < SEQ ? 0 : (r < MLAT ? 1 : 2);
            float* xr = (dry ? (float*)(c.ws + WS_YF) + (size_t)r * DM : xrow_ptr(c, r)) + col;
            const f32x2 gg = *(const f32x2*)((const float*)(c.ws + WS_MOD) + ((size_t)l * 3 + vec) * NMOD + 5 * DM + col); f32x2 xx = *(const f32x2*)xr;
            float o[16];
#pragma unroll
            for (int j = 0; j < 16; ++j) o[j] = 0.f;
#pragma unroll
            for (int i = 0; i < 16; ++i) {
                asm volatile("" : "+v"(w[i]));
                const float ci_ = __shfl(i < 8 ? c0 : c1, (8 * i + rg) & 63);
                float f[16]; unpack_fp8x16(w[i], f);
#pragma unroll
                for (int j = 0; j < 16; ++j) o[j] += ci_ * f[j];
                asm volatile("" : "+v"(o[0])); }
            float q8[8], q4[4], q2[2];
#pragma unroll
            for (int j = 0; j < 8; ++j) q8[j] = (b3 ? o[8 + j] : o[j]) + DPPF(b3 ? o[j] : o[8 + j], 0x128);
#pragma unroll
            for (int j = 0; j < 4; ++j) q4[j] = (b4 ? q8[4 + j] : q8[j]) + SWZ_XOR(b4 ? q8[j] : q8[4 + j], 16);
#pragma unroll
            for (int j = 0; j < 2; ++j) q2[j] = (b5 ? q4[2 + j] : q4[j]) + __shfl_xor(b5 ? q4[j] : q4[2 + j], 32);
            xx[0] += gg[0] * q2[0]; xx[1] += gg[1] * q2[1];
            *(f32x2*)xr = xx;
            e0 = f0; e1 = f1; c0 = d0; c1 = d1;
        }
    }
#undef V_META
}
struct Args { const float* in[29]; float* out; unsigned char* ws; int ph_lo, ph_hi; };
constexpr int PH_PER_LAYER = 10, N_PHASES = NLAYER * PH_PER_LAYER;
constexpr int CW_BAR = 4096;

__global__ void __launch_bounds__(NTHREADS, 2) mk_fwd(Args args) {
    extern __shared__ __attribute__((aligned(16))) unsigned char lds_raw[];
    Ctx c0;
    c0.out = args.out; c0.ws = args.ws; c0.lds = (LAS unsigned char*)lds_raw;
    c0.tid = threadIdx.x; c0.lane = c0.tid & 63; c0.wave = __builtin_amdgcn_readfirstlane((int)(threadIdx.x >> 6)); c0.wg = blockIdx.x; c0.G = gridDim.x;
    volatile LAS unsigned* MISC = (volatile LAS unsigned*)(c0.lds + MISC_OFF);
    if (c0.tid < 64) MISC[c0.tid] = 0u;
    __syncthreads();
    const int lo = args.ph_lo, hi = args.ph_hi;
    XcdBarrier bar; bar.bar = (unsigned*)(c0.ws + WS_CTL) + CW_BAR; bar.x = 0; bar.st = MISC + 8;
    if (hi - lo > 1) bar = xcd_barrier_post((unsigned*)(c0.ws + WS_CTL) + CW_BAR, MISC + 8);
#ifndef ONLY_PH
#define ONLY_PH -1
#endif
#define IN(k) ((ONLY_PH < 0 || ((k) % PH_PER_LAYER) == ONLY_PH) && lo <= (k) && (k) < hi)
#define PH_BEGIN() Ctx c = c0; unsigned long long wsi_ = (unsigned long long)c0.ws, outi_ = (unsigned long long)c0.out; asm volatile("" : "+s"(wsi_), "+s"(outi_), "+s"(c.wg), "+s"(c.G), "+s"(c.wave)); \
    c.lane = lane_id_fresh(); c.tid = c.wave * 64 + c.lane; c.ws = (unsigned char*)(GAS unsigned char*)wsi_; c.out = (float*)(GAS float*)outi_;     \
    bf16_t* P = (bf16_t*)(c.ws + WS_P); bf16_t* HX = (bf16_t*)(c.ws + WS_HX); float* YF = (float*)(c.ws + WS_YF); (void)P; (void)HX; (void)YF
#ifndef PROBE_DUP
#define PROBE_DUP -1
#endif
#define REPS(k) for (int rep = 0, dry = (PROBE_DUP == (k)); rep < (PROBE_DUP == (k) ? 2 : 1); ++rep, dry = 0)
#define SEAM(k) do { if (IN(k) && IN((k) + 1)) { xcd_barrier(bar, c0.wave); if (PROBE_DUP == 20) xcd_barrier(bar, c0.wave); } } while (0)
    for (int l = 0; l < NLAYER; ++l) {
        const int pb = l * PH_PER_LAYER;
        const int mrows = (l == 0) ? MALL : MLAT;
        if (IN(pb + 0)) REPS(0) {
            { PH_BEGIN(); conv_units(c, l); } { PH_BEGIN(); conv_transposes(c, l); } { PH_BEGIN(); conv_tables(c, l); } { PH_BEGIN(); conv_small(c, l); }
            if (l == 0) { PH_BEGIN(); conv_once(c); } }
        SEAM(pb + 0);
        if (IN(pb + 1)) REPS(1) { PH_BEGIN(); phase_norm(c, l, MALL, SP_NMIX, 0); }
        SEAM(pb + 1);
        if (IN(pb + 2)) REPS(2) { PH_BEGIN();
            pg8::Gemm g{HX, (const bf16_t*)(c.ws + WS_WIN), MALL, NIN, DM, DM, DM}; pg8::StaticOrder S; S.init(MALL, NIN, c.G, c.wg);
            pg8::EpiBf16 E{P, NIN};
            pg8::gemm_phase<pg8::EpiBf16, pg8::StaticOrder, true, true>(c.lds, g, S, E, c.wave);
        }
        SEAM(pb + 2);
        if (IN(pb + 3)) REPS(3) { { PH_BEGIN(); phase_qk(c, l, dry); } { PH_BEGIN(); phase_sc(c, l, dry); } __syncthreads(); { PH_BEGIN(); phase_lru1(c, l); } if (PROBE_DUP == 30) { PH_BEGIN(); phase_lru1(c, l); } }
        SEAM(pb + 3);
        if (IN(pb + 4)) REPS(4) { { PH_BEGIN(); phase_m2(c, l, dry); } __syncthreads(); if (PROBE_DUP == 31) { PH_BEGIN(); phase_lru2(c, l, true); } { PH_BEGIN(); phase_lru2(c, l, dry); } }
        SEAM(pb + 4);
        if (IN(pb + 5)) REPS(5) { PH_BEGIN();
            pg8::MixOrder S; S.init(mrows, c.G, c.wg);
            const bf16_t* WO = (const bf16_t*)(c.ws + WS_WO);
            { pg8::Gemm g{P + CQ, WO, mrows, DM, DM, NIN, DM}; pg8::EpiMerge<0> E{P + CGT, NIN, YF, HX};
              pg8::gemm_phase<pg8::EpiMerge<0>, pg8::MixOrder, true, true, true>(c.lds, g, S, E, c.wave); }
            { pg8::Gemm g{P + CLG, WO + (size_t)DM * DM, mrows, DM, DM, NIN, DM}; pg8::EpiMerge<1> E{P + CGT + DM, NIN, YF, HX};
              pg8::gemm_phase<pg8::EpiMerge<1>, pg8::MixOrder, true, true, true>(c.lds, g, S, E, c.wave); }
            { pg8::Gemm g{P + CBG, WO + (size_t)2 * DM * DM, mrows, DM, DM, NIN, DM}; pg8::EpiMerge<2> E{P + CGT + 2 * DM, NIN, YF, HX};
              pg8::gemm_phase<pg8::EpiMerge<2>, pg8::MixOrder, true, true, true>(c.lds, g, S, E, c.wave); }
        }
        SEAM(pb + 5);
        if (IN(pb + 6)) REPS(6) { PH_BEGIN();
            pg8::Gemm g{HX, (const bf16_t*)(c.ws + WS_WOUT), mrows, DM, DM, DM, DM}; pg8::MixOrder S; S.init(mrows, c.G, c.wg);
            pg8::EpiResid E{dry ? YF : c.out, dry ? YF + (size_t)MLAT * DM : (float*)(c.ws + WS_CTXS), (const float*)(c.ws + WS_MOD) + (size_t)l * 3 * NMOD + 2 * DM};
            pg8::gemm_phase<pg8::EpiResid, pg8::MixOrder, true, true, true>(c.lds, g, S, E, c.wave);
        }
        SEAM(pb + 6);
        if (IN(pb + 7)) REPS(7) { PH_BEGIN(); phase_norm(c, l, mrows, SP_NFFN, 3); }
        SEAM(pb + 7);
        if (IN(pb + 8)) REPS(8) { PH_BEGIN();
            pg8::Gemm g{HX, (const bf16_t*)(c.ws + WS_WSC), mrows, DM, DM, DM, DM}; pg8::MixOrder S; S.init(mrows, c.G, c.wg);
            pg8::EpiF32 E{(float*)(c.ws + WS_P), DM};
            pg8::gemm_phase<pg8::EpiF32, pg8::MixOrder, true, true, true>(c.lds, g, S, E, c.wave);
        }
        SEAM(pb + 8);
        if (IN(pb + 9)) REPS(9) {
            { PH_BEGIN(); phase_peer(c, l, mrows, dry); } xcd_barrier(bar, c0.wave);
            { PH_BEGIN(); phase_peer_v(c, l, mrows, dry); } }
        SEAM(pb + 9);
    }
#undef IN
#undef SEAM
}

extern "C" void kernel_launch(void* const* d_in, const int* in_sizes, int n_in, void* d_out, int out_size, void* d_ws, size_t ws_size, hipStream_t stream) {
    static int grid = 0;
    if (grid == 0) {
        if (n_in != 29 || in_sizes[0] != MLAT * DM || out_size != MLAT * DM || ws_size < WS_END) {
            fprintf(stderr, "kernel_launch: built for 29 inputs, x/out of %d floats, >= %zu bytes of workspace; got n_in %d, in0 %d, out %d, ws %zu; nothing launched\n", MLAT * DM, (size_t)WS_END, n_in, n_in > 0 ? in_sizes[0] : -1, out_size, ws_size);
            grid = -1; return; }
        int dev = 0, cus = 0, per_cu = 0;
        if (hipGetDevice(&dev) != hipSuccess || hipDeviceGetAttribute(&cus, hipDeviceAttributeMultiprocessorCount, dev) != hipSuccess) { fprintf(stderr, "kernel_launch: device query failed\n"); grid = -1; return; }
        if (hipFuncSetAttribute((const void*)mk_fwd, hipFuncAttributeMaxDynamicSharedMemorySize, LDS_BYTES) != hipSuccess) { fprintf(stderr, "kernel_launch: hipFuncSetAttribute failed\n"); grid = -1; return; }
        if (hipOccupancyMaxActiveBlocksPerMultiprocessor(&per_cu, (const void*)mk_fwd, NTHREADS, LDS_BYTES) != hipSuccess || per_cu < 1)
            fprintf(stderr, "kernel_launch: note: occupancy query reports %d workgroups per CU\n", per_cu);
        (void)hipGetLastError();
        grid = cus;
    }
    if (grid < 0) return;
    if (hipMemsetAsync((char*)d_ws + WS_CTL, 0, CTL_ZERO_BYTES, stream) != hipSuccess) { fprintf(stderr, "kernel_launch: memset failed\n"); return; }
    Args a{};
    for (int i = 0; i < 29; ++i) a.in[i] = (const float*)d_in[i];
    a.out = (float*)d_out; a.ws = (unsigned char*)d_ws;
#if MK_N_LAUNCHES == 1
    a.ph_lo = 0; a.ph_hi = N_PHASES;
    hipLaunchKernelGGL(mk_fwd, dim3(grid), dim3(NTHREADS), LDS_BYTES, stream, a);
#else
    for (int k = 0; k < N_PHASES; ++k) { a.ph_lo = k; a.ph_hi = k + 1; hipLaunchKernelGGL(mk_fwd, dim3(grid), dim3(NTHREADS), LDS_BYTES, stream, a); }
#endif
    const hipError_t le = hipPeekAtLastError();
    if (le != hipSuccess) fprintf(stderr, "kernel_launch: launch failed: %s\n", hipGetErrorName(le));
}
```

```cpp
#include <hip/hip_runtime.h>
#include <cstdio>
#include <cstdint>

#ifndef MK_N_LAUNCHES
#define MK_N_LAUNCHES 1
#endif
#if MK_N_LAUNCHES != 1
#error "the PEER phase carries a grid barrier of its own: this kernel is one launch only"
#endif

#define GAS __attribute__((address_space(1)))
#define LAS __attribute__((address_space(3)))
typedef unsigned short bf16_t;
typedef short bf16x8 __attribute__((ext_vector_type(8)));
typedef short s16x4 __attribute__((ext_vector_type(4)));
typedef float f32x2 __attribute__((ext_vector_type(2)));
typedef float f32x4 __attribute__((ext_vector_type(4)));
typedef float f32x8 __attribute__((ext_vector_type(8)));
typedef float f32x16 __attribute__((ext_vector_type(16)));
typedef unsigned u32x2 __attribute__((ext_vector_type(2)));
typedef unsigned u32x4 __attribute__((ext_vector_type(4)));
typedef int i32x4 __attribute__((ext_vector_type(4)));

constexpr int DM = 2048, NB = 2, SEQ = 8192, NLAYER = 2, CTXL = 256;
constexpr int MLAT = NB * SEQ, MCTX = NB * CTXL, MALL = MLAT + MCTX;
constexpr int NIN = 19456;
constexpr int CQ = 0, CK = 2048, CV = 2560, CLX = 3072, CLG = 5120, CBG = 7168, CCG = 9216, CU = 11264, CGT = 13312;
constexpr int NKEY = SEQ + CTXL;
constexpr int NCHUNK = NKEY / 64;
constexpr int NMOD = 6 * DM;
constexpr float EPS = 1e-6f;
constexpr int NWAVES = 8, NTHREADS = 512;

constexpr size_t MiB = 1u << 20;
constexpr size_t al256(size_t x) { return (x + 255) / 256 * 256; }
constexpr size_t WS_CTL = 0, CTL_ZERO_BYTES = 1 * MiB;
constexpr size_t WS_MOD = WS_CTL + CTL_ZERO_BYTES;
constexpr size_t WS_ROPE = WS_MOD + al256((size_t)NLAYER * 3 * NMOD * 4);
constexpr size_t WS_SP = WS_ROPE + al256(2 * 128 * 32 * 4);
constexpr size_t WS_CTXS = WS_SP + al256(36864 * 4);
constexpr size_t WS_LSUM = WS_CTXS + al256((size_t)MCTX * DM * 4);
constexpr size_t WS_WLRU = WS_LSUM + al256((size_t)2 * 2 * NB * NCHUNK * DM * 4);
constexpr size_t WS_KC = WS_WLRU + al256((size_t)16 * 512 * 128 * 2);
constexpr size_t WS_VC = WS_KC + al256((size_t)NB * 4 * NKEY * 128 * 2);
constexpr size_t WS_WIN = WS_VC + al256((size_t)NB * 4 * NKEY * 128 * 2);
constexpr size_t WS_CMAX = WS_WIN + (size_t)NIN * DM;
constexpr size_t WS_WDQ = WS_CMAX + al256((size_t)2 * 32 * NIN * 4);
constexpr size_t WS_ADQ = WS_WDQ + al256((size_t)NIN * 4);
constexpr size_t WS_WO = WS_WIN + al256((size_t)NIN * DM * 2);
constexpr size_t WS_WOUT = WS_WO + al256((size_t)3 * DM * DM * 2);
constexpr size_t WS_WSC = WS_WOUT + al256((size_t)DM * DM * 2);
constexpr size_t WS_PU = WS_WSC + al256((size_t)DM * DM * 2);
constexpr size_t WS_PV = WS_PU + al256((size_t)16384 * DM);
constexpr size_t WS_HX = WS_PV + al256((size_t)16384 * DM);
constexpr size_t WS_YF = WS_HX + al256((size_t)MALL * DM * 2);
constexpr size_t WS_P = WS_YF + al256((size_t)MALL * DM * 4);
static_assert(WS_ADQ + (size_t)MALL * 4 <= WS_WO, "the int8 side tables must fit the spare half of the w_in region");
constexpr size_t WS_PU2 = WS_P + al256((size_t)MALL * NIN * 2);
constexpr size_t WS_PV2 = WS_PU2 + al256((size_t)16384 * DM);
constexpr size_t WS_WSC2 = WS_PV2 + al256((size_t)16384 * DM);
constexpr size_t WS_END = WS_WSC2 + al256((size_t)DM * DM * 2);
__host__ __device__ constexpr size_t ws_pu(int l) { return l ? WS_PU2 : WS_PU; }
__host__ __device__ constexpr size_t ws_pv(int l) { return l ? WS_PV2 : WS_PV; }
__host__ __device__ constexpr size_t ws_wsc(int l) { return l ? WS_WSC2 : WS_WSC; }

constexpr int SP_NMIX = 0, SP_NFFN = 2048, SP_QN = 4096, SP_KN = 4224, SP_LCW = 4352, SP_LCB = 12544, SP_LBA = 14592, SP_LBX = 18688, SP_LSP = 22784, SP_SCW = 26880, SP_SCB = 33024, SP_END = 35072;

constexpr int LDS_BYTES = 147456;
constexpr int MISC_OFF = 147456 - 256;
constexpr int LDS_WORK = MISC_OFF;

__device__ __forceinline__ unsigned cvt_pk_bf16(float lo, float hi) { unsigned r; asm volatile("v_cvt_pk_bf16_f32 %0, %1, %2" : "=v"(r) : "v"(lo), "v"(hi)); return r; }
__device__ __forceinline__ unsigned pk4_i8(float a, float b, float c, float d) {
    const int ia = (int)__builtin_rintf(a), ib = (int)__builtin_rintf(b), ic = (int)__builtin_rintf(c), id = (int)__builtin_rintf(d);
    return ((unsigned)ia & 255u) | (((unsigned)ib & 255u) << 8) | (((unsigned)ic & 255u) << 16) | ((unsigned)id << 24); }
__device__ __forceinline__ float bf_lo(unsigned w) { return __uint_as_float(w << 16); }
__device__ __forceinline__ float bf_hi(unsigned w) { return __uint_as_float(w & 0xffff0000u); }
__device__ __forceinline__ float bf1(bf16_t h) { return __uint_as_float(((unsigned)h) << 16); }
__device__ __forceinline__ bf16_t f2bf(float f) { return (bf16_t)(cvt_pk_bf16(f, 0.f) & 0xffffu); }
__device__ __forceinline__ float sigmoidf_(float x) { return __builtin_amdgcn_rcpf(1.f + __expf(-x)); }
__device__ __forceinline__ float gelu_tanh(float x) { const float z = 0.7978845608028654f * (x + 0.044715f * x * x * x); const float e = __expf(2.f * z); return 0.5f * x * (2.f - 2.f * __builtin_amdgcn_rcpf(e + 1.f)); }
__device__ __forceinline__ float wave_sum(float v) {
#pragma unroll
    for (int o = 1; o < 64; o <<= 1) v += __shfl_xor(v, o);
    return v;
}
__device__ __forceinline__ float wave_max(float v) {
#pragma unroll
    for (int o = 1; o < 64; o <<= 1) v = fmaxf(v, __shfl_xor(v, o));
    return v;
}
template <class T> __device__ __forceinline__ T* as_global(T* p) { return (T*)(GAS T*)p; }
__device__ __forceinline__ int lane_id_fresh() { int l; asm volatile("v_mbcnt_lo_u32_b32 %0, -1, 0\n\tv_mbcnt_hi_u32_b32 %0, -1, %0" : "=v"(l)); return l; }
#define DPPF(v, ctrl) __int_as_float(__builtin_amdgcn_update_dpp(0, __float_as_int(v), ctrl, 0xF, 0xF, true))
#define LDS_WAIT() asm volatile("s_waitcnt lgkmcnt(0)" ::: "memory")
#define VM_WAIT() asm volatile("s_waitcnt vmcnt(0)" ::: "memory")

#define XB_TMO      128
#define XB_XCNT(j)  (256  + 64 * (j))
#define XB_XSUB(j)  (1280 + 64 * (j))
#define XB_XGEN(j)  (2304 + 64 * (j))
#define XB_TOP      3328
#define XB_TOPGEN   3392
#define XCD_BAR_WORDS 3456
#define XB_SPIN_CAP (1u << 23)
__device__ __forceinline__ unsigned xb_ld(unsigned* p)              { return __hip_atomic_load(p, __ATOMIC_RELAXED, __HIP_MEMORY_SCOPE_AGENT); }
__device__ __forceinline__ unsigned xb_add(unsigned* p, unsigned v) { return __hip_atomic_fetch_add(p, v, __ATOMIC_RELAXED, __HIP_MEMORY_SCOPE_AGENT); }
__device__ __forceinline__ unsigned xb_xcc_id() { return (unsigned)__builtin_amdgcn_s_getreg((3 << 11) | 20) & 0xFu; }
#define XB_SPIN(cond, bar) do { unsigned _sp = 0; while (cond) { __builtin_amdgcn_s_sleep(1); \
    if ((++_sp & 255u) == 0u) { if (xb_ld(&(bar)[XB_TMO])) break; if (_sp > XB_SPIN_CAP) { atomicAdd(&(bar)[XB_TMO], 1u); break; } } } } while (0)
struct XcdBarrier { unsigned* bar; unsigned x; volatile LAS unsigned* st; };
__device__ __forceinline__ XcdBarrier xcd_barrier_post(unsigned* bar, volatile LAS unsigned* st) {
    XcdBarrier b; b.bar = bar; b.x = xb_xcc_id(); b.st = st;
    if (threadIdx.x == 0) (void)xb_add(&bar[XB_XCNT(b.x)], 1u);
    return b;
}
__device__ __forceinline__ void xcd_barrier_complete(unsigned* bar, unsigned x, unsigned& nloc, unsigned& nx) {
    const unsigned G = gridDim.x * gridDim.y * gridDim.z;
    unsigned sum, cnt, mine, sp = 0u;
    for (;;) {
        sum = 0u; cnt = 0u; mine = 0u;
#pragma unroll
        for (unsigned j = 0; j < 16; ++j) { const unsigned c = xb_ld(&bar[XB_XCNT(j)]); sum += c; cnt += (c > 0u) ? 1u : 0u; mine = (j == x) ? c : mine; }
        if (sum == G) break;
        __builtin_amdgcn_s_sleep(1);
        if ((++sp & 255u) == 0u) { if (xb_ld(&bar[XB_TMO])) break; if (sp > XB_SPIN_CAP) { atomicAdd(&bar[XB_TMO], 1u); break; } }
    }
    nloc = mine > 0u ? mine : 1u; nx = cnt > 0u ? cnt : 1u;
}
__device__ __forceinline__ void xcd_barrier(const XcdBarrier& b, int wave) {
    asm volatile("s_waitcnt vmcnt(0)" ::: "memory");
    __syncthreads();
    if (wave == 0 && lane_id_fresh() == 0) {
        unsigned* bar = b.bar;
        __builtin_amdgcn_s_waitcnt(0);
        unsigned nloc = b.st[0], nx = b.st[1];
        if (nloc == 0u) { xcd_barrier_complete(bar, b.x, nloc, nx); b.st[0] = nloc; b.st[1] = nx; }
        const unsigned old = xb_add(&bar[XB_XSUB(b.x)], 1u);
        const unsigned gen = old / nloc;
        if (old + 1u == (gen + 1u) * nloc) {
            __builtin_amdgcn_fence(__ATOMIC_RELEASE, "agent");
            asm volatile("s_waitcnt vmcnt(0)" ::: "memory");
            const unsigned og = xb_add(&bar[XB_TOP], 1u);
            const unsigned tg = og / nx;
            if (og + 1u == (tg + 1u) * nx) xb_add(&bar[XB_TOPGEN], 1u);
            else XB_SPIN(xb_ld(&bar[XB_TOPGEN]) == tg, bar);
            __builtin_amdgcn_fence(__ATOMIC_ACQUIRE, "agent");
            xb_add(&bar[XB_XGEN(b.x)], 1u);
            asm volatile("s_waitcnt vmcnt(0)" ::: "memory");
        } else {
            XB_SPIN(xb_ld(&bar[XB_XGEN(b.x)]) == gen, bar);
            __builtin_amdgcn_fence(__ATOMIC_ACQUIRE, "agent");
            asm volatile("s_waitcnt vmcnt(0)" ::: "memory");
        }
    }
    __syncthreads();
}
#ifndef MIX_WGM
#define MIX_WGM 8
#endif
namespace pg8 {
#define PG8_LAS __attribute__((address_space(3)))
constexpr int BM = 256, BK = 64, HALF = 128, HTB = HALF * BK * 2, STAGE_BYTES = 8 * HTB, NXCD = 8, WGM = 8;
__host__ __device__ __forceinline__ int lds_byte(int r, int c) { const int st = (r >> 4) * 2 + (c >> 5), rr = r & 15, cc = c & 31, ob = rr * 64 + cc * 2; return st * 1024 + (ob ^ (((ob >> 9) & 1) << 5)); }
__host__ __device__ __forceinline__ void stage_rc(int b, int& R, int& C) { const int st = b / 1024, sb = b % 1024, swz = sb ^ (((sb >> 9) & 1) << 5); R = (st >> 1) * 16 + swz / 64; C = (st & 1) * 32 + (swz % 64) / 2; }
__host__ __device__ __forceinline__ int perm32(int rho) { const int n = rho >> 4, i = rho & 15; return 8 * (i >> 2) + 4 * n + (i & 3); }

struct Unit { int pm, pn, nh; };
struct Gemm { const bf16_t* A; const bf16_t* Bt; int M, N, K, lda, ldb; };

struct StaticOrder {
    int nM, nN, nwg, G, c, wgm = WGM;
    __host__ __device__ void init(int M, int N, int G_, int c_, int wgm_ = WGM) { nM = M / BM; nN = N / BM; nwg = nM * nN; G = G_; c = c_; wgm = wgm_; }
    __host__ __device__ bool next(int i, Unit& u) const {
        const long L = (long)i * G + c; if (L >= nwg) return false;
        int wgid = (int)L; { const int q = nwg / NXCD, r = nwg % NXCD, xcd = wgid % NXCD, off = wgid / NXCD; wgid = (xcd < r ? xcd * (q + 1) : r * (q + 1) + (xcd - r) * q) + off; }
        const int nig = wgm * nN, gid = wgid / nig, fm = gid * wgm, gsz = (nM - fm) < wgm ? (nM - fm) : wgm;
        u.pm = 2 * (fm + ((wgid % nig) % gsz)); u.pn = (wgid % nig) / gsz; u.nh = 2; return true;
    }
    __device__ __forceinline__ void a_ready(const Unit&) const {}
    __device__ __forceinline__ void done(const Unit&) const {}
};

struct MixOrder {
    StaticOrder lat; int nhalf;
    __host__ __device__ void init(int mrows, int G_, int c_) { lat.init(MLAT, 2048, G_, c_, MIX_WGM); nhalf = ((mrows - MLAT) / HALF) * 8; }
    __host__ __device__ bool next(int i, Unit& u) const {
        if (lat.next(i, u)) return true;
        const long h = (long)i * lat.G + lat.c - lat.nwg; if (h < 0 || h >= nhalf) return false;
        u.pm = MLAT / HALF + (int)(h >> 3); u.pn = (int)(h & 7); u.nh = 1; return true;
    }
    __device__ __forceinline__ void a_ready(const Unit&) const {}
    __device__ __forceinline__ void done(const Unit&) const {}
};

struct EpiBf16 {
    static constexpr bool PERM = true, AFTER_DRAIN = false;
    bf16_t* O; int ldc;
    __device__ __forceinline__ void operator()(const f32x4 (&acc)[2][2][4][2], const Unit& u, int wr, int wc, int fr, int fq) const {
        const int row0 = u.pm * HALF + wr * 64 + fr, col0 = u.pn * BM + wc * 32 + 8 * fq;
#pragma unroll
        for (int ai = 0; ai < 2; ++ai) if (ai < u.nh)
#pragma unroll
            for (int m = 0; m < 4; ++m) { bf16_t* rowp = O + (size_t)(row0 + ai * HALF + m * 16) * ldc + col0;
#pragma unroll
                for (int bj = 0; bj < 2; ++bj) { const f32x4 v0 = acc[ai][bj][m][0], v1 = acc[ai][bj][m][1];
                    u32x4 w; w.x = cvt_pk_bf16(v0[0], v0[1]); w.y = cvt_pk_bf16(v0[2], v0[3]); w.z = cvt_pk_bf16(v1[0], v1[1]); w.w = cvt_pk_bf16(v1[2], v1[3]);
                    *(u32x4*)(rowp + bj * HALF) = w; } }
    }
};
struct EpiI8 {
    static constexpr bool PERM = true, AFTER_DRAIN = false;
    bf16_t* O; int ldc; const float* rstep; const float* cstep;
    __device__ __forceinline__ void operator()(const f32x4 (&acc)[2][2][4][2], const Unit& u, int wr, int wc, int fr, int fq) const {
        const int row0 = u.pm * HALF + wr * 64 + fr, col0 = u.pn * BM + wc * 32 + 8 * fq;
        f32x4 cs[2][2];
#pragma unroll
        for (int bj = 0; bj < 2; ++bj) { cs[bj][0] = *(const f32x4*)(cstep + col0 + bj * HALF); cs[bj][1] = *(const f32x4*)(cstep + col0 + bj * HALF + 4); }
#pragma unroll
        for (int ai = 0; ai < 2; ++ai) if (ai < u.nh)
#pragma unroll
            for (int m = 0; m < 4; ++m) { const int r = row0 + ai * HALF + m * 16; bf16_t* rowp = O + (size_t)r * ldc + col0; const float rs = rstep[r];
#pragma unroll
                for (int bj = 0; bj < 2; ++bj) {
                    const f32x4 v0 = __builtin_convertvector(__builtin_bit_cast(i32x4, acc[ai][bj][m][0]), f32x4) * (cs[bj][0] * rs), v1 = __builtin_convertvector(__builtin_bit_cast(i32x4, acc[ai][bj][m][1]), f32x4) * (cs[bj][1] * rs);
                    u32x4 w; w.x = cvt_pk_bf16(v0[0], v0[1]); w.y = cvt_pk_bf16(v0[2], v0[3]); w.z = cvt_pk_bf16(v1[0], v1[1]); w.w = cvt_pk_bf16(v1[2], v1[3]);
                    *(u32x4*)(rowp + bj * HALF) = w; } }
    }
};
struct EpiF32 {
    static constexpr bool PERM = false, AFTER_DRAIN = false;
    float* C; int ldc;
    __device__ __forceinline__ void operator()(const f32x4 (&acc)[2][2][4][2], const Unit& u, int wr, int wc, int fr, int fq) const {
        const int row0 = u.pm * HALF + wr * 64 + fr, col0 = u.pn * BM + wc * 32 + 4 * fq;
#pragma unroll
        for (int ai = 0; ai < 2; ++ai) if (ai < u.nh)
#pragma unroll
            for (int m = 0; m < 4; ++m) { float* rowp = C + (size_t)(row0 + ai * HALF + m * 16) * ldc + col0;
#pragma unroll
                for (int bj = 0; bj < 2; ++bj)
#pragma unroll
                    for (int n = 0; n < 2; ++n) *(f32x4*)(rowp + bj * HALF + n * 16) = acc[ai][bj][m][n]; }
    }
};
template <int MODE> struct EpiMerge {
    static constexpr bool PERM = true, AFTER_DRAIN = false;
    const bf16_t* Gt; int ldg; bf16_t* Y; bf16_t* YB;
    __device__ __forceinline__ void operator()(const f32x4 (&acc)[2][2][4][2], const Unit& u, int wr, int wc, int fr, int fq) const {
        const int row0 = u.pm * HALF + wr * 64 + fr, col0 = u.pn * BM + wc * 32 + 8 * fq;
#pragma unroll
        for (int ai = 0; ai < 2; ++ai) if (ai < u.nh)
#pragma unroll
            for (int m = 0; m < 4; ++m) { const size_t r = (size_t)(row0 + ai * HALF + m * 16);
#pragma unroll
                for (int bj = 0; bj < 2; ++bj) { const int c = col0 + bj * HALF;
                    const u32x4 gw = *(const u32x4*)(Gt + r * ldg + c);
                    f32x4 g0, g1;
                    g0[0] = sigmoidf_(bf_lo(gw.x)); g0[1] = sigmoidf_(bf_hi(gw.x)); g0[2] = sigmoidf_(bf_lo(gw.y)); g0[3] = sigmoidf_(bf_hi(gw.y));
                    g1[0] = sigmoidf_(bf_lo(gw.z)); g1[1] = sigmoidf_(bf_hi(gw.z)); g1[2] = sigmoidf_(bf_lo(gw.w)); g1[3] = sigmoidf_(bf_hi(gw.w));
                    f32x4 y0 = g0 * acc[ai][bj][m][0], y1 = g1 * acc[ai][bj][m][1];
                    if (MODE != 0) { const u32x4 yw = *(const u32x4*)(Y + r * 2048 + c);
                        y0 += (f32x4){bf_lo(yw.x), bf_hi(yw.x), bf_lo(yw.y), bf_hi(yw.y)}; y1 += (f32x4){bf_lo(yw.z), bf_hi(yw.z), bf_lo(yw.w), bf_hi(yw.w)}; }
                    u32x4 w; w.x = cvt_pk_bf16(y0[0], y0[1]); w.y = cvt_pk_bf16(y0[2], y0[3]); w.z = cvt_pk_bf16(y1[0], y1[1]); w.w = cvt_pk_bf16(y1[2], y1[3]);
                    *(u32x4*)((MODE != 2 ? Y : YB) + r * 2048 + c) = w; } }
    }
};
struct EpiResid {
    static constexpr bool PERM = true, AFTER_DRAIN = false;
    float* xlat; float* xctx; const float* gate;
    const float* slat; const float* sctx;
    __device__ __forceinline__ void operator()(const f32x4 (&acc)[2][2][4][2], const Unit& u, int wr, int wc, int fr, int fq) const {
        const int vec = u.pm < 64 ? 0 : (u.pm < 128 ? 1 : 2);
        float* xb = u.pm < 128 ? xlat + (size_t)u.pm * HALF * 2048 : xctx + (size_t)(u.pm - 128) * HALF * 2048;
        const float* sb = u.pm < 128 ? slat + (size_t)u.pm * HALF * 2048 : sctx + (size_t)(u.pm - 128) * HALF * 2048;
        const int lrow0 = wr * 64 + fr, col0 = u.pn * BM + wc * 32 + 8 * fq;
        const float* gp = gate + (size_t)vec * 12288 + col0;
#pragma unroll
        for (int bj = 0; bj < 2; ++bj) { const f32x4 g0 = *(const f32x4*)(gp + bj * HALF), g1 = *(const f32x4*)(gp + bj * HALF + 4);
#pragma unroll
            for (int ai = 0; ai < 2; ++ai) if (ai < u.nh)
#pragma unroll
                for (int m = 0; m < 4; ++m) { const size_t off = (size_t)(lrow0 + ai * HALF + m * 16) * 2048 + col0 + bj * HALF; float* xp = xb + off; const float* sp = sb + off;
                    const f32x4 x0 = *(const f32x4*)sp + g0 * acc[ai][bj][m][0], x1 = *(const f32x4*)(sp + 4) + g1 * acc[ai][bj][m][1];
                    *(f32x4*)xp = x0; *(f32x4*)(xp + 4) = x1; } }
    }
};

template <class Epi, class Sched, bool ALIGN_EPI = false, bool SP2 = false, bool HALFU = false, bool I8 = false>
__device__ __forceinline__ void gemm_phase(PG8_LAS unsigned char* lds, const Gemm g, const Sched& S, const Epi& E, int wave_) {
    int tid_ = wave_ * 64 + lane_id_fresh();
    const int tid = tid_, wid = __builtin_amdgcn_readfirstlane(tid >> 6), lane = tid & 63, wr = wid >> 2, wc = wid & 3, fr = lane & 15, fq = lane >> 4;
    constexpr int ES = I8 ? 1 : 2;
    const int K = g.K, nt = K * ES / (BK * 2);
    unsigned voffA[2], voffB[2];
#pragma unroll
    for (int i = 0; i < 2; ++i) { int R, C; stage_rc(tid * 16 + i * 8192, R, C); const int Rb = Epi::PERM ? ((R & ~31) + perm32(R & 31)) : R;
        voffA[i] = (unsigned)(R * g.lda * ES + C * 2); voffB[i] = (unsigned)(Rb * g.ldb * ES + C * 2); }
    const size_t kstep = (size_t)(BK * 2);
    const size_t hstepA = (size_t)HALF * g.lda * ES, hstepB = (size_t)HALF * g.ldb * ES;
    const size_t tstepB = 2 * hstepB;
    const unsigned ldsw = (unsigned)wid * 1024u;
    const int aoff = lds_byte(wr * 64 + fr, fq * 8), boff = lds_byte(wc * 32 + fr, fq * 8);
#define PG8_SA(b, h) (((b) * 2 + (h)) * HTB)
#define PG8_SB(b, h) ((4 + (b) * 2 + (h)) * HTB)
#define PG8_STAGE(bufoff, gbase, voff) do { _Pragma("unroll") for (int _i = 0; _i < 2; ++_i) \
        __builtin_amdgcn_global_load_lds((const unsigned*)((const char*)(gbase) + (voff)[_i]), (PG8_LAS unsigned*)(lds + (bufoff) + ldsw + _i * 8192), 16, 0, 0); } while (0)
#define PG8_LDA(dst, b, h) do { _Pragma("unroll") for (int m = 0; m < 4; ++m) _Pragma("unroll") for (int k = 0; k < 2; ++k) dst[m][k] = *(const PG8_LAS bf16x8*)(lds + PG8_SA(b, h) + aoff + m * 2048 + k * 1024); } while (0)
#define PG8_LDB(dst, b, h) do { _Pragma("unroll") for (int n = 0; n < 2; ++n) _Pragma("unroll") for (int k = 0; k < 2; ++k) dst[n][k] = *(const PG8_LAS bf16x8*)(lds + PG8_SB(b, h) + boff + n * 2048 + k * 1024); } while (0)
#define PG8_MMA(ai, bj, At, Bt) do { __builtin_amdgcn_s_setprio(1); _Pragma("unroll") for (int m = 0; m < 4; ++m) _Pragma("unroll") for (int n = 0; n < 2; ++n) _Pragma("unroll") for (int k = 0; k < 2; ++k) \
        { if constexpr (I8) acc[ai][bj][m][n] = __builtin_bit_cast(f32x4, __builtin_amdgcn_mfma_i32_16x16x64_i8(__builtin_bit_cast(i32x4, Bt[n][k]), __builtin_bit_cast(i32x4, At[m][k]), __builtin_bit_cast(i32x4, acc[ai][bj][m][n]), 0, 0, 0)); \
          else acc[ai][bj][m][n] = __builtin_amdgcn_mfma_f32_16x16x32_bf16(Bt[n][k], At[m][k], acc[ai][bj][m][n], 0, 0, 0); } __builtin_amdgcn_s_setprio(0); } while (0)
#define PG8_WAIT_V(n) asm volatile("s_waitcnt vmcnt(" #n ")" ::: "memory")
#define PG8_WAIT_L(n) asm volatile("s_waitcnt lgkmcnt(" #n ")" ::: "memory")
#define PG8_BAR __builtin_amdgcn_s_barrier()
#define PG8_SCHED __builtin_amdgcn_sched_barrier(0)
    Unit cur, nxt; int ui = 0;
    if (!S.next(0, cur)) return;
    f32x4 acc[2][2][4][2];
#pragma unroll
    for (int a = 0; a < 2; ++a)
#pragma unroll
        for (int b = 0; b < 2; ++b)
#pragma unroll
            for (int m = 0; m < 4; ++m)
#pragma unroll
                for (int n = 0; n < 2; ++n) acc[a][b][m][n] = (f32x4){0.f, 0.f, 0.f, 0.f};
    bf16x8 At[4][2], B0[2][2], B1[2][2];
    const char* cA = (const char*)g.A + (size_t)cur.pm * hstepA; const char* cB = (const char*)g.Bt + (size_t)cur.pn * tstepB;
    size_t chA = (!HALFU || cur.nh == 2) ? hstepA : 0;
    S.a_ready(cur);
    if constexpr (SP2) {
        PG8_STAGE(PG8_SB(0, 0), cB, voffB); PG8_STAGE(PG8_SB(0, 1), cB + hstepB, voffB); PG8_STAGE(PG8_SA(0, 0), cA, voffA); PG8_STAGE(PG8_SA(0, 1), cA + chA, voffA);
        if (wr == 1) PG8_BAR;
        PG8_WAIT_V(2); PG8_BAR;
        PG8_STAGE(PG8_SB(1, 0), cB + kstep, voffB); PG8_STAGE(PG8_SA(1, 0), cA + kstep, voffA); PG8_STAGE(PG8_SB(1, 1), cB + hstepB + kstep, voffB);
        PG8_WAIT_V(6); PG8_BAR;
    } else {
        PG8_STAGE(PG8_SB(0, 0), cB, voffB); PG8_STAGE(PG8_SA(0, 0), cA, voffA); PG8_STAGE(PG8_SB(0, 1), cB + hstepB, voffB); PG8_STAGE(PG8_SA(0, 1), cA + chA, voffA);
        if (wr == 1) PG8_BAR;
        PG8_WAIT_V(4); PG8_BAR;
        PG8_STAGE(PG8_SB(1, 0), cB + kstep, voffB); PG8_STAGE(PG8_SA(1, 0), cA + kstep, voffA); PG8_STAGE(PG8_SB(1, 1), cB + hstepB + kstep, voffB);
        PG8_WAIT_V(6); PG8_BAR;
    }
    for (;;) {
        const bool has_next = S.next(ui + 1, nxt);
        const char* nA = has_next ? (const char*)g.A + (size_t)nxt.pm * hstepA : cA; const size_t nhA = has_next ? ((!HALFU || nxt.nh == 2) ? hstepA : 0) : chA; const bool full = (!HALFU || cur.nh == 2);
        const char* nA_ = nA; (void)nA_; const char* nB = has_next ? (const char*)g.Bt + (size_t)nxt.pn * tstepB : cB;
        for (int t = 0; t < nt; t += 2) {
            const bool last = (t == nt - 2);
            const char* a1 = cA + (size_t)(t + 1) * kstep;
            const char* a2 = last ? nA : cA + (size_t)(t + 2) * kstep; const char* b2 = last ? nB : cB + (size_t)(t + 2) * kstep;
            const char* a3 = a2 + kstep; const char* b3 = b2 + kstep;
            const size_t h2A = last ? nhA : chA;
            if (last && has_next) S.a_ready(nxt);
            if constexpr (SP2) {
            PG8_LDB(B0, 0, 0); PG8_LDB(B1, 0, 1); PG8_SCHED; PG8_LDA(At, 0, 0); PG8_STAGE(PG8_SA(1, 1), a1 + chA, voffA);
            PG8_WAIT_V(8); PG8_WAIT_L(0); PG8_BAR; PG8_MMA(0, 0, At, B0); PG8_MMA(0, 1, At, B1); PG8_BAR; PG8_SCHED;
            PG8_LDA(At, 0, 1); PG8_STAGE(PG8_SB(0, 0), b2, voffB); PG8_STAGE(PG8_SB(0, 1), b2 + hstepB, voffB); PG8_STAGE(PG8_SA(0, 0), a2, voffA);
            PG8_WAIT_V(8); PG8_WAIT_L(0); PG8_BAR; if (full) { PG8_MMA(1, 0, At, B0); PG8_MMA(1, 1, At, B1); } PG8_BAR; PG8_SCHED;
            PG8_LDB(B0, 1, 0); PG8_LDB(B1, 1, 1); PG8_SCHED; PG8_LDA(At, 1, 0); PG8_STAGE(PG8_SA(0, 1), a2 + h2A, voffA);
            PG8_WAIT_V(8); PG8_WAIT_L(0); PG8_BAR; PG8_MMA(0, 0, At, B0); PG8_MMA(0, 1, At, B1); PG8_BAR; PG8_SCHED;
            PG8_LDA(At, 1, 1); PG8_STAGE(PG8_SB(1, 0), b3, voffB); PG8_STAGE(PG8_SB(1, 1), b3 + hstepB, voffB); PG8_STAGE(PG8_SA(1, 0), a3, voffA);
            PG8_WAIT_V(8); PG8_WAIT_L(0); PG8_BAR; if (full) { PG8_MMA(1, 0, At, B0); PG8_MMA(1, 1, At, B1); } PG8_BAR; PG8_SCHED;
            } else {
            PG8_LDB(B0, 0, 0); PG8_SCHED; PG8_LDA(At, 0, 0); PG8_STAGE(PG8_SA(1, 1), a1 + chA, voffA);
            PG8_WAIT_L(8); PG8_BAR; PG8_WAIT_L(0); PG8_MMA(0, 0, At, B0); PG8_BAR; PG8_SCHED;
            PG8_LDB(B1, 0, 1); PG8_STAGE(PG8_SB(0, 0), b2, voffB);
            PG8_BAR; PG8_WAIT_L(0); PG8_MMA(0, 1, At, B1); PG8_BAR;
            PG8_LDA(At, 0, 1); PG8_STAGE(PG8_SA(0, 0), a2, voffA);
            PG8_BAR; PG8_WAIT_L(0); if (full) PG8_MMA(1, 0, At, B0); PG8_BAR; PG8_SCHED;
            PG8_STAGE(PG8_SB(0, 1), b2 + hstepB, voffB);
            PG8_WAIT_V(6); PG8_BAR; if (full) PG8_MMA(1, 1, At, B1); PG8_BAR;
            PG8_LDB(B0, 1, 0); PG8_SCHED; PG8_LDA(At, 1, 0); PG8_STAGE(PG8_SA(0, 1), a2 + h2A, voffA);
            PG8_WAIT_L(8); PG8_BAR; PG8_WAIT_L(0); PG8_MMA(0, 0, At, B0); PG8_BAR; PG8_SCHED;
            PG8_LDB(B1, 1, 1); PG8_STAGE(PG8_SB(1, 0), b3, voffB);
            PG8_BAR; PG8_WAIT_L(0); PG8_MMA(0, 1, At, B1); PG8_BAR;
            PG8_LDA(At, 1, 1); PG8_STAGE(PG8_SA(1, 0), a3, voffA);
            PG8_BAR; PG8_WAIT_L(0); if (full) PG8_MMA(1, 0, At, B0); PG8_BAR; PG8_SCHED;
            PG8_STAGE(PG8_SB(1, 1), b3 + hstepB, voffB);
            PG8_WAIT_V(6); PG8_BAR; if (full) PG8_MMA(1, 1, At, B1); PG8_BAR;
            }
        }
        if constexpr (ALIGN_EPI) { if (wr == 0) PG8_BAR; }
        if constexpr (!Epi::AFTER_DRAIN) { E(acc, cur, wr, wc, fr, fq); S.done(cur); }
        if (!has_next) break;
#pragma unroll
        for (int a = 0; a < 2; ++a)
#pragma unroll
            for (int b = 0; b < 2; ++b)
#pragma unroll
                for (int m = 0; m < 4; ++m)
#pragma unroll
                    for (int n = 0; n < 2; ++n) acc[a][b][m][n] = (f32x4){0.f, 0.f, 0.f, 0.f};
        cur = nxt; cA = nA; cB = nB; chA = nhA; ++ui;
        if constexpr (ALIGN_EPI) { if (wr == 1) PG8_BAR; }
    }
    PG8_WAIT_V(0);
    if constexpr (!ALIGN_EPI) { if (wr == 0) PG8_BAR; }
    PG8_BAR;
#undef PG8_SA
#undef PG8_SB
#undef PG8_STAGE
#undef PG8_LDA
#undef PG8_LDB
#undef PG8_MMA
#undef PG8_WAIT_V
#undef PG8_WAIT_L
#undef PG8_BAR
#undef PG8_SCHED
}
}
namespace att {
constexpr int D = 128, NW = 8, QBLK = 32, KVBLK = 64;
constexpr float SCALE = 0.088388347648318440f;
constexpr float THR = 8.f;
constexpr int LDQ = NIN, LDK = 128, LDO = NIN;
constexpr size_t SHM_V = KVBLK * D * 2, SHM_K = KVBLK * D * 2, SHM_ATTN = 2 * SHM_V + 2 * SHM_K + NW * 64 * 4;
#define KSWZ(row, colB) ((row) * 256 + ((colB) ^ (((row) & 7) << 4)))
#define SBAR() __builtin_amdgcn_sched_barrier(0)
__device__ __forceinline__ int crow(int r, int hi) { return (r & 3) + 8 * (r >> 2) + 4 * hi; }
__device__ __forceinline__ unsigned cvtpk(float lo, float hi) { unsigned r; asm volatile("v_cvt_pk_bf16_f32 %0, %1, %2" : "=v"(r) : "v"(lo), "v"(hi)); return r; }
__device__ __forceinline__ bf16x8 ld8(const bf16_t* p) { return *reinterpret_cast<const bf16x8*>(p); }

__device__ __forceinline__ void partialSM(f32x16& p0, f32x16& p1, float& m_reg, float& mn, float& alpha) {
  constexpr float C = SCALE * 1.4426950408889634f;
  float pmax = p0[0];
#pragma unroll
  for (int r = 1; r < 16; ++r) pmax = fmaxf(pmax, p0[r]);
#pragma unroll
  for (int r = 0; r < 16; ++r) pmax = fmaxf(pmax, p1[r]);
  { auto rr = __builtin_amdgcn_permlane32_swap(__float_as_uint(pmax), __float_as_uint(pmax), false, false);
    pmax = fmaxf(__uint_as_float(rr[0]), __uint_as_float(rr[1])); }
  if (__builtin_expect(__all(pmax - m_reg <= THR / SCALE), 1)) { mn = m_reg; alpha = 1.f; }
  else { mn = fmaxf(m_reg, pmax); alpha = __builtin_amdgcn_exp2f((m_reg - mn) * C); m_reg = mn; }
  float mnC = -mn * C;
#pragma unroll
  for (int r = 0; r < 16; ++r) p0[r] = fmaf(p0[r], C, mnC);
#pragma unroll
  for (int r = 0; r < 16; ++r) p1[r] = fmaf(p1[r], C, mnC);
#pragma unroll
  for (int r = 0; r < 16; ++r) p0[r] = __builtin_amdgcn_exp2f(p0[r]);
}
__device__ __forceinline__ void finishSM(f32x16& p0, f32x16& p1, float alpha, float& l_reg, bf16x8& pa0, bf16x8& pa1, bf16x8& pa2, bf16x8& pa3) {
#pragma unroll
  for (int r = 0; r < 16; ++r) p1[r] = __builtin_amdgcn_exp2f(p1[r]);
  float ps = 0;
#pragma unroll
  for (int r = 0; r < 16; ++r) ps += p0[r];
#pragma unroll
  for (int r = 0; r < 16; ++r) ps += p1[r];
  { auto rr = __builtin_amdgcn_permlane32_swap(__float_as_uint(ps), __float_as_uint(ps), false, false);
    ps = __uint_as_float(rr[0]) + __uint_as_float(rr[1]); }
  l_reg = l_reg * alpha + ps;
#define PK4(P, BASE, OUT) do { unsigned a0 = cvtpk(P[BASE + 0], P[BASE + 1]), a1 = cvtpk(P[BASE + 2], P[BASE + 3]);   \
    unsigned b0 = cvtpk(P[BASE + 4], P[BASE + 5]), b1 = cvtpk(P[BASE + 6], P[BASE + 7]);                              \
    auto r0 = __builtin_amdgcn_permlane32_swap(a0, b0, false, false); auto r1 = __builtin_amdgcn_permlane32_swap(a1, b1, false, false); \
    u32x4 w = {r0[0], r1[0], r0[1], r1[1]}; OUT = *reinterpret_cast<bf16x8*>(&w); } while (0)
  PK4(p0, 0, pa0); PK4(p0, 8, pa1); PK4(p1, 0, pa2); PK4(p1, 8, pa3);
#undef PK4
}
__device__ __forceinline__ void qkt(f32x16& p0, f32x16& p1, const bf16_t* Ks, const bf16x8* qr, int r32, int hi) {
  p0 = f32x16{}; p1 = f32x16{};
#pragma unroll
  for (int d0 = 0; d0 < 8; ++d0) { int cb = (d0 * 16 + hi * 8) * 2;
    bf16x8 b0 = *reinterpret_cast<const bf16x8*>((const char*)Ks + KSWZ(r32, cb));
    bf16x8 b1 = *reinterpret_cast<const bf16x8*>((const char*)Ks + KSWZ(32 + r32, cb));
    p0 = __builtin_amdgcn_mfma_f32_32x32x16_bf16(b0, qr[d0], p0, 0, 0, 0);
    p1 = __builtin_amdgcn_mfma_f32_32x32x16_bf16(b1, qr[d0], p1, 0, 0, 0); }
}
__device__ __forceinline__ int v_st(int k, int c) { const int kk = (k & ~0xC) | ((k & 4) << 1) | ((k & 8) >> 1); return ((kk >> 3) * 4 + (c >> 5)) * 512 + ((kk & 7) * 32 + (c & 31)) * 2; }
__device__ __forceinline__ int v_rd_base(int lane) { return ((lane & 3) << 3) | (((lane >> 2) & 3) << 6) | (((lane >> 4) & 1) << 5) | (((lane >> 5) & 1) << 8); }
constexpr int v_rd_off(int d0, int ks, int half) { return d0 * 512 + ks * 4096 + half * 2048; }
template <int OFF> __device__ __forceinline__ s16x4 tr_read(int vb) {
  s16x4 r; asm volatile("ds_read_b64_tr_b16 %0, %1 offset:%2" : "=&v"(r) : "v"(vb), "i"(OFF) : "memory"); return r;
}
template <int D0> __device__ __forceinline__ void pv_one(f32x16& od, int vb, bf16x8 pa0, bf16x8 pa1, bf16x8 pa2, bf16x8 pa3) {
  const s16x4 l0 = tr_read<v_rd_off(D0, 0, 0)>(vb), h0 = tr_read<v_rd_off(D0, 0, 1)>(vb), l1 = tr_read<v_rd_off(D0, 1, 0)>(vb), h1 = tr_read<v_rd_off(D0, 1, 1)>(vb);
  const s16x4 l2 = tr_read<v_rd_off(D0, 2, 0)>(vb), h2 = tr_read<v_rd_off(D0, 2, 1)>(vb), l3 = tr_read<v_rd_off(D0, 3, 0)>(vb), h3 = tr_read<v_rd_off(D0, 3, 1)>(vb);
  asm volatile("s_waitcnt lgkmcnt(0)" ::: "memory"); SBAR();
#define PK(L, H) (bf16x8){L[0], L[1], L[2], L[3], H[0], H[1], H[2], H[3]}
  od = __builtin_amdgcn_mfma_f32_32x32x16_bf16(pa0, PK(l0, h0), od, 0, 0, 0);
  od = __builtin_amdgcn_mfma_f32_32x32x16_bf16(pa1, PK(l1, h1), od, 0, 0, 0);
  od = __builtin_amdgcn_mfma_f32_32x32x16_bf16(pa2, PK(l2, h2), od, 0, 0, 0);
  od = __builtin_amdgcn_mfma_f32_32x32x16_bf16(pa3, PK(l3, h3), od, 0, 0, 0);
#undef PK
}
__device__ __forceinline__ void pv_d0(f32x16* o, int vb, bf16x8 pa0, bf16x8 pa1, bf16x8 pa2, bf16x8 pa3) {
  pv_one<0>(o[0], vb, pa0, pa1, pa2, pa3); pv_one<1>(o[1], vb, pa0, pa1, pa2, pa3); pv_one<2>(o[2], vb, pa0, pa1, pa2, pa3); pv_one<3>(o[3], vb, pa0, pa1, pa2, pa3);
}

__device__ __forceinline__ void attn_dense_body(const bf16_t* __restrict__ Qb, const bf16_t* __restrict__ Kh, const bf16_t* __restrict__ Vh,
                                                bf16_t* Ob, int seq, char* lds, int wave_) {
  constexpr int SDEPTH = 2;
  int tid_ = wave_ * 64 + lane_id_fresh();
  const int tid = tid_, wid = tid >> 6, lane = tid & 63, r32 = lane & 31, hi = lane >> 5;
  bf16_t* V_lds = (bf16_t*)lds; bf16_t* K_lds = (bf16_t*)(lds + 2 * SHM_V);
  float* ws = (float*)(lds + 2 * SHM_V + 2 * SHM_K) + wid * 64; float* li_l = ws; float* al_l = ws + 32;
  float m_reg = -1e30f, l_reg = 0; f32x16 o[4] = {}; bf16x8 qr[8];
  const bf16_t* Qw = Qb + (long)(wid * QBLK + r32) * LDQ + hi * 8;
#pragma unroll
  for (int d0 = 0; d0 < 8; ++d0) qr[d0] = ld8(Qw + d0 * 16);
  const int sr = tid >> 4, sc = (tid & 15) * 8, vst0 = v_st(sr, sc), vst1 = v_st(32 + sr, sc);
  const int vb0 = (int)(uintptr_t)V_lds + v_rd_base(lane);
  struct { bf16x8 vs0, vs1, ks0, ks1; } sr_[SDEPTH];
#define SLOAD(i, k0) do { sr_[i].vs0 = ld8(&Vh[(long)((k0) + sr) * LDK + sc]); sr_[i].vs1 = ld8(&Vh[(long)((k0) + 32 + sr) * LDK + sc]); \
    sr_[i].ks0 = ld8(&Kh[(long)((k0) + sr) * LDK + sc]); sr_[i].ks1 = ld8(&Kh[(long)((k0) + 32 + sr) * LDK + sc]); } while (0)
#define SWRITE(b, i) do { *(bf16x8*)((char*)V_lds + (b) * SHM_V + vst0) = sr_[i].vs0;          \
    *(bf16x8*)((char*)V_lds + (b) * SHM_V + vst1) = sr_[i].vs1; int kc = sc * 2;               \
    *(bf16x8*)((char*)K_lds + (b) * SHM_K + KSWZ(sr, kc)) = sr_[i].ks0;                       \
    *(bf16x8*)((char*)K_lds + (b) * SHM_K + KSWZ(32 + sr, kc)) = sr_[i].ks1; } while (0)
#define SWAIT() asm volatile("s_waitcnt vmcnt(4)" ::: "memory")
#define RESC(a) do { if (__any((a) < 1.f)) { if (hi == 0) al_l[r32] = (a); asm volatile("s_waitcnt lgkmcnt(0)" ::: "memory"); \
    _Pragma("unroll") for (int d = 0; d < 4; ++d) _Pragma("unroll") for (int r = 0; r < 16; ++r) o[d][r] *= al_l[crow(r, hi)]; } } while (0)
  f32x16 pA0, pA1, pB0, pB1; float mnA, mnB, alA, alB; bf16x8 pa0, pa1, pa2, pa3; const int NT = seq / KVBLK;
  constexpr int SE = 0, SO = SDEPTH - 1;
  SLOAD(SE, 0); asm volatile("s_waitcnt vmcnt(0)" ::: "memory"); SWRITE(0, SE); __syncthreads();
  qkt(pA0, pA1, K_lds, qr, r32, hi); partialSM(pA0, pA1, m_reg, mnA, alA);
  SLOAD(SO, KVBLK); if (2 < NT) SLOAD(SE, 2 * KVBLK);
  SWAIT(); SWRITE(1, SO); __syncthreads();
  for (int j = 1; j + 1 < NT; j += 2) {
    SBAR(); qkt(pB0, pB1, (bf16_t*)((char*)K_lds + SHM_K), qr, r32, hi);
    finishSM(pA0, pA1, alA, l_reg, pa0, pa1, pa2, pa3); SBAR();
    SLOAD(SO, (j + SDEPTH) * KVBLK); SBAR();
    pv_d0(o, vb0, pa0, pa1, pa2, pa3); partialSM(pB0, pB1, m_reg, mnB, alB);
    __syncthreads(); SWAIT(); SWRITE(0, SE);
    RESC(alB); __syncthreads();
    SBAR(); qkt(pA0, pA1, K_lds, qr, r32, hi);
    finishSM(pB0, pB1, alB, l_reg, pa0, pa1, pa2, pa3); SBAR();
    if (j + 3 < NT) SLOAD(SE, (j + 1 + SDEPTH) * KVBLK); SBAR();
    pv_d0(o, vb0 + (int)SHM_V, pa0, pa1, pa2, pa3); partialSM(pA0, pA1, m_reg, mnA, alA);
    __syncthreads(); SWAIT(); SWRITE(1, SO);
    RESC(alA); __syncthreads();
  }
  SBAR(); qkt(pB0, pB1, (bf16_t*)((char*)K_lds + SHM_K), qr, r32, hi);
  finishSM(pA0, pA1, alA, l_reg, pa0, pa1, pa2, pa3); SBAR();
  pv_d0(o, vb0, pa0, pa1, pa2, pa3); partialSM(pB0, pB1, m_reg, mnB, alB);
  __syncthreads(); RESC(alB);
  finishSM(pB0, pB1, alB, l_reg, pa0, pa1, pa2, pa3); SBAR();
  pv_d0(o, vb0 + (int)SHM_V, pa0, pa1, pa2, pa3);
  if (hi == 0) li_l[r32] = l_reg; asm volatile("s_waitcnt lgkmcnt(0)" ::: "memory");
  float rli[16];
#pragma unroll
  for (int r = 0; r < 16; ++r) rli[r] = __builtin_amdgcn_rcpf(li_l[crow(r, hi)]);
  bf16_t* Ow = Ob + (long)(wid * QBLK) * LDO;
#pragma unroll
  for (int r = 0; r < 16; ++r) { int orow = crow(r, hi);
#pragma unroll
    for (int d0 = 0; d0 < 4; ++d0) Ow[(long)orow * LDO + d0 * 32 + r32] = f2bf(o[d0][r] * rli[r]); }
  __syncthreads();
#undef SLOAD
#undef SWRITE
#undef SWAIT
#undef RESC
}
#undef KSWZ
#undef SBAR
}
#define CAS __attribute__((address_space(4)))
#define INP(i) ((const float*)(GAS const float*)in[i])
struct Ctx {
    float* out; unsigned char* ws;
    LAS unsigned char* lds; int tid, lane, wave, wg, G;
};
enum { I_X = 0, I_C, I_CTX, I_CCTX, I_WMOD, I_BMOD, I_NMIX, I_NFFN, I_WIN, I_QN, I_KN, I_LCW, I_LCB, I_LWA, I_LBA, I_LWX, I_LBX, I_LLAM, I_SCW, I_SCB,
       I_WOA, I_WOL, I_WOS, I_WOUT, I_PWQ, I_PK1, I_PK2, I_PU, I_PV };

__device__ __forceinline__ float* xrow_ptr(const Ctx& c, int r) {
    return r < MLAT ? c.out + (size_t)r * DM : (float*)(c.ws + WS_CTXS) + (size_t)(r - MLAT) * DM;
}

template <bool I8 = false>
__device__ __forceinline__ void transpose_item(const float* W, int K, int N, bf16_t* WT, LAS float* scr, int item, int lane, const float* cmax = nullptr, float* wdq = nullptr, LAS float* scol = nullptr) {
    const int nblk = N / 64, kb = item / nblk, nb = item % nblk, k0 = 64 * kb, n0 = 64 * nb;
    if constexpr (I8) { float mx = 0.f;
#pragma unroll 8
        for (int kc = 0; kc < 32; ++kc) mx = fmaxf(mx, cmax[(size_t)kc * N + n0 + lane]);
        scol[lane] = mx > 0.f ? 127.f / mx : 0.f;
        if (kb == 0) wdq[n0 + lane] = mx * (1.f / 127.f); }
    const float* src = W + (size_t)(k0 + (lane >> 4)) * N + n0 + (lane & 15) * 4;
    f32x4 v[16];
#pragma unroll
    for (int i = 0; i < 16; ++i) v[i] = *(const f32x4*)(src + (size_t)(4 * i) * N);
    LAS float* d = scr + (lane >> 4) * 65 + (lane & 15) * 4;
#pragma unroll
    for (int i = 0; i < 16; ++i) { d[(4 * i) * 65 + 0] = v[i][0]; d[(4 * i) * 65 + 1] = v[i][1]; d[(4 * i) * 65 + 2] = v[i][2]; d[(4 * i) * 65 + 3] = v[i][3]; }
    LDS_WAIT(); asm volatile("" ::: "memory");
    const int c = lane & 7;
#pragma unroll
    for (int j = 0; j < 8; ++j) { const int n = (lane >> 3) + 8 * j; const LAS float* s = scr + (8 * c) * 65 + n;
        if constexpr (I8) { const float q_ = scol[n]; u32x2 o; o.x = pk4_i8(s[0 * 65] * q_, s[1 * 65] * q_, s[2 * 65] * q_, s[3 * 65] * q_); o.y = pk4_i8(s[4 * 65] * q_, s[5 * 65] * q_, s[6 * 65] * q_, s[7 * 65] * q_);
            *(u32x2*)((unsigned char*)WT + (size_t)(n0 + n) * K + k0 + 8 * c) = o; }
        else { u32x4 o; o.x = cvt_pk_bf16(s[0 * 65], s[1 * 65]); o.y = cvt_pk_bf16(s[2 * 65], s[3 * 65]); o.z = cvt_pk_bf16(s[4 * 65], s[5 * 65]); o.w = cvt_pk_bf16(s[6 * 65], s[7 * 65]);
            *(u32x4*)(WT + (size_t)(n0 + n) * K + k0 + 8 * c) = o; } }
    LDS_WAIT(); asm volatile("" ::: "memory");
}

__device__ __forceinline__ void mod_unit(const Ctx& c, CAS const unsigned long long* in, int l, int cb) {
    LAS float* sv = (LAS float*)c.lds;
    LAS float* red = sv + 3 * DM;
    { const float* cc = INP(I_C); const float* cx = INP(I_CCTX);
      for (int i = c.tid; i < 3 * DM; i += NTHREADS) { const int v = i / DM, k = i % DM; const float x = v < 2 ? cc[v * DM + k] : cx[k]; sv[i] = x * sigmoidf_(x); } }
    __syncthreads();
    const int j4 = (c.tid & 31) * 4, kg = c.tid >> 5;
    const float* w = INP(I_WMOD) + (size_t)l * DM * NMOD + (size_t)(kg * 128) * NMOD + cb * 128 + j4;
    f32x4 a0 = {0.f, 0.f, 0.f, 0.f}, a1 = a0, a2 = a0;
#pragma unroll 8
    for (int k = 0; k < 128; ++k) { const f32x4 wv = *(const f32x4*)(w + (size_t)k * NMOD); const int kk = kg * 128 + k; a0 += wv * sv[kk]; a1 += wv * sv[DM + kk]; a2 += wv * sv[2 * DM + kk]; }
    *(LAS f32x4*)(red + (kg * 3 + 0) * 128 + j4) = a0; *(LAS f32x4*)(red + (kg * 3 + 1) * 128 + j4) = a1; *(LAS f32x4*)(red + (kg * 3 + 2) * 128 + j4) = a2;
    __syncthreads();
    if (c.tid < 384) { const int v = c.tid >> 7, jj = c.tid & 127; float s = INP(I_BMOD)[l * NMOD + cb * 128 + jj];
#pragma unroll
        for (int g = 0; g < 16; ++g) s += red[(g * 3 + v) * 128 + jj];
        ((float*)(c.ws + WS_MOD))[((size_t)l * 3 + v) * NMOD + cb * 128 + jj] = s; }
    __syncthreads();
}

__device__ __forceinline__ void wsc_unit(const Ctx& c, CAS const unsigned long long* in, int l, int u) {
    const int hh = u >> 4, kb = u & 15, h = hh >> 1, half = hh & 1, k0 = kb * 128;
    LAS float* kkL = (LAS float*)c.lds;
    LAS float* wqL = kkL + 128 * 132;
    const float* ksrc = INP(half ? I_PK2 : I_PK1) + ((size_t)(l * 8 + h) * 128) * 128;
    const float* qsrc = INP(I_PWQ) + (size_t)l * DM * DM + (size_t)k0 * DM + hh * 128;
    for (int i = c.tid; i < 128 * 32; i += NTHREADS) { const int r = i >> 5, c4 = (i & 31) * 4;
        *(LAS f32x4*)(kkL + r * 132 + c4) = *(const f32x4*)(ksrc + (size_t)r * 128 + c4);
        *(LAS f32x4*)(wqL + r * 132 + c4) = *(const f32x4*)(qsrc + (size_t)r * DM + c4); }
    __syncthreads();
    const int k = c.tid & 127, ng = c.tid >> 7;
    float acc[32];
#pragma unroll
    for (int j = 0; j < 32; ++j) acc[j] = 0.f;
    for (int d4 = 0; d4 < 32; ++d4) {
        const f32x4 a = *(const LAS f32x4*)(wqL + k * 132 + d4 * 4);
#pragma unroll
        for (int j = 0; j < 32; ++j) { const f32x4 b = *(const LAS f32x4*)(kkL + (ng * 32 + j) * 132 + d4 * 4); acc[j] += (a[0] * b[0] + a[1] * b[1]) + (a[2] * b[2] + a[3] * b[3]); }
    }
    bf16_t* dst = (bf16_t*)(c.ws + ws_wsc(l)) + (size_t)(hh * 128 + ng * 32) * DM + k0 + k;
#pragma unroll
    for (int j = 0; j < 32; ++j) dst[(size_t)j * DM] = f2bf(acc[j]);
    __syncthreads();
}

#define GET_IN() unsigned long long kai_ = (unsigned long long)__builtin_amdgcn_kernarg_segment_ptr(); asm volatile("" : "+s"(kai_)); CAS const unsigned long long* in = (CAS const unsigned long long*)kai_
__device__ __forceinline__ void conv_units(const Ctx& c, int l) {
    GET_IN();
    if (l == 0) for (int u = c.wg; u < 2 * 96; u += c.G) mod_unit(c, in, u / 96, u % 96);
    for (int u = c.wg; u < 256; u += c.G) wsc_unit(c, in, l, u);
}
enum { CV_WIN = 1, CV_WO = 2, CV_WOUT = 4, CV_PU = 8, CV_PV = 16, CV_LRU = 32, CV_ALL = 63 };
__device__ __forceinline__ void conv_transposes(const Ctx& c, int l, int what = CV_ALL) {
    GET_IN();
    const int gw = c.wg * NWAVES + c.wave, NGW = c.G * NWAVES;
    LAS float* scr = (LAS float*)(c.lds + c.wave * 16640);
    constexpr int I_IN = (DM / 64) * (NIN / 64), I_SQ = (DM / 64) * (DM / 64);
    const float* win = INP(I_WIN) + (size_t)l * DM * NIN;
    if (what & CV_WIN) for (int it = gw; it < I_IN; it += NGW)
        transpose_item<true>(win, DM, NIN, (bf16_t*)(c.ws + WS_WIN), scr, it, c.lane, (const float*)(c.ws + WS_CMAX) + (size_t)l * 32 * NIN, (float*)(c.ws + WS_WDQ), (LAS float*)(c.lds + 8 * 16640 + c.wave * 256));
    for (int s = 0; s < 4; ++s) { if (!(what & (s < 3 ? CV_WO : CV_WOUT))) continue;
        const float* src = INP(s == 0 ? I_WOA : s == 1 ? I_WOL : s == 2 ? I_WOS : I_WOUT) + (size_t)l * DM * DM;
        bf16_t* dst = s < 3 ? (bf16_t*)(c.ws + WS_WO) + (size_t)s * DM * DM : (bf16_t*)(c.ws + WS_WOUT);
        for (int it = gw; it < I_SQ; it += NGW) transpose_item(src, DM, DM, dst, scr, it, c.lane);
    }
}
__device__ __forceinline__ void conv_colmax(const Ctx& c) {
    GET_IN();
    const size_t gt = (size_t)c.wg * NTHREADS + c.tid, NT = (size_t)c.G * NTHREADS;
    constexpr int C4 = NIN / 4;
    for (size_t u = gt; u < (size_t)NLAYER * 32 * C4; u += NT) { const int c4 = (int)(u % C4), lk = (int)(u / C4);
        const float* src = INP(I_WIN) + (size_t)lk * 64 * NIN + c4 * 4;
        f32x4 m = {0.f, 0.f, 0.f, 0.f};
#pragma unroll 16
        for (int k = 0; k < 64; ++k) { const f32x4 v = *(const f32x4*)(src + (size_t)k * NIN); m[0] = fmaxf(m[0], fabsf(v[0])); m[1] = fmaxf(m[1], fabsf(v[1])); m[2] = fmaxf(m[2], fabsf(v[2])); m[3] = fmaxf(m[3], fabsf(v[3])); }
        *(f32x4*)((float*)(c.ws + WS_CMAX) + (size_t)lk * NIN + c4 * 4) = m; }
}
__device__ __forceinline__ void conv_tables(const Ctx& c, int l, int what = CV_ALL) {
    GET_IN();
    const size_t gt = (size_t)c.wg * NTHREADS + c.tid, NT = (size_t)c.G * NTHREADS;
    constexpr size_t NG16 = (size_t)16384 * DM / 16;
#pragma unroll 1
    for (int tb = 0; tb < 2; ++tb) { if (!(what & (tb ? CV_PV : CV_PU))) continue;
        const float* srcb = INP(tb ? I_PV : I_PU) + (size_t)l * 16384 * DM; unsigned char* dstb = (unsigned char*)(c.ws + (tb ? ws_pv(l) : ws_pu(l)));
        const float sc = tb ? 1.f : 32.f;
        for (size_t j = gt; j < NG16; j += 2 * NT) {
            const size_t j2 = j + NT; const bool has2 = j2 < NG16;
            f32x4 a[4], b[4];
#pragma unroll
            for (int d = 0; d < 4; ++d) a[d] = *(const f32x4*)(srcb + j * 16 + d * 4);
#pragma unroll
            for (int d = 0; d < 4; ++d) b[d] = has2 ? *(const f32x4*)(srcb + j2 * 16 + d * 4) : (f32x4){0.f, 0.f, 0.f, 0.f};
            u32x4 o, o2;
#pragma unroll
            for (int d = 0; d < 4; ++d) { const f32x4 x = a[d] * sc, y = b[d] * sc;
                int w = __builtin_amdgcn_cvt_pk_fp8_f32(x[0], x[1], 0, false); w = __builtin_amdgcn_cvt_pk_fp8_f32(x[2], x[3], w, true); o[d] = (unsigned)w;
                int w2 = __builtin_amdgcn_cvt_pk_fp8_f32(y[0], y[1], 0, false); w2 = __builtin_amdgcn_cvt_pk_fp8_f32(y[2], y[3], w2, true); o2[d] = (unsigned)w2; }
            if (tb == 0) { *(u32x4*)(dstb + j * 16) = o; if (has2) *(u32x4*)(dstb + j2 * 16) = o2; }
            else {
                *(u32x4*)(dstb + (size_t)((j & 127) >> 3) * ((size_t)16384 * 128) + (j >> 7) * 128 + (j & 7) * 16) = o;
                if (has2) *(u32x4*)(dstb + (size_t)((j2 & 127) >> 3) * ((size_t)16384 * 128) + (j2 >> 7) * 128 + (j2 & 7) * 16) = o2; } }
    }
    if (what & CV_LRU) for (size_t i = gt; i < (size_t)16 * 512 * 128; i += NT) { const int ci = (int)(i & 127), j = (int)((i >> 7) & 511), n = (int)(i >> 16), d = j >> 8, which = (j >> 7) & 1, dd = j & 127;
        const float* src = INP(which ? I_LWX : I_LWA) + ((((size_t)(l * 2 + d) * 16 + n) * 128 + ci) * 128 + dd);
        ((bf16_t*)(c.ws + WS_WLRU))[i] = f2bf(*src); }
}
__device__ __forceinline__ void sp_copy(const Ctx& c, const float* src, int sp_off, int n) {
    const size_t gt = (size_t)c.wg * NTHREADS + c.tid, NT = (size_t)c.G * NTHREADS;
    for (size_t i = gt; i < (size_t)n; i += NT) ((float*)(c.ws + WS_SP))[sp_off + i] = src[i];
}
__device__ __forceinline__ void conv_small(const Ctx& c, int l) {
    GET_IN();
    const size_t gt = (size_t)c.wg * NTHREADS + c.tid, NT = (size_t)c.G * NTHREADS;
    sp_copy(c, INP(I_NMIX) + l * DM, SP_NMIX, DM); sp_copy(c, INP(I_NFFN) + l * DM, SP_NFFN, DM);
    sp_copy(c, INP(I_QN) + l * 128, SP_QN, 128); sp_copy(c, INP(I_KN) + l * 128, SP_KN, 128);
    sp_copy(c, INP(I_LCW) + l * 4 * DM, SP_LCW, 4 * DM); sp_copy(c, INP(I_LCB) + l * DM, SP_LCB, DM);
    sp_copy(c, INP(I_LBA) + l * 2 * DM, SP_LBA, 2 * DM); sp_copy(c, INP(I_LBX) + l * 2 * DM, SP_LBX, 2 * DM);
    sp_copy(c, INP(I_SCW) + l * 3 * DM, SP_SCW, 3 * DM); sp_copy(c, INP(I_SCB) + l * DM, SP_SCB, DM);
    { const float* lam = INP(I_LLAM) + l * 2 * DM;
      for (size_t i = gt; i < (size_t)2 * DM; i += NT) ((float*)(c.ws + WS_SP))[SP_LSP + i] = 8.f * log1pf(expf(-lam[i])); }
}
__device__ __forceinline__ void conv_once(const Ctx& c) {
    const size_t gt = (size_t)c.wg * NTHREADS + c.tid, NT = (size_t)c.G * NTHREADS;
    for (size_t i = gt; i < 128 * 32; i += NT) { const int pos = (int)(i >> 5), p = (int)(i & 31);
        const float inv = exp2f(-(float)p * (13.287712379549449f / 32.f)); const float ang = (float)pos * inv;
        float sn, cs; sincosf(ang, &sn, &cs);
        ((float*)(c.ws + WS_ROPE))[i] = cs; ((float*)(c.ws + WS_ROPE))[128 * 32 + i] = sn; }
}

template <bool I8 = false>
__device__ __forceinline__ void phase_norm(const Ctx& c, int l, int nrows, int sp_gain, int slot_shift, const float* xin = nullptr, const float* cin = nullptr) {
    const int gw = c.wg * NWAVES + c.wave, NGW = c.G * NWAVES;
    const float* modl = (const float*)(c.ws + WS_MOD) + (size_t)l * 3 * NMOD;
    bf16_t* HX = (bf16_t*)(c.ws + WS_HX); const float* gain = (const float*)(c.ws + WS_SP) + sp_gain;
    for (int r = gw; r < nrows; r += NGW) {
        const int vec = r < SEQ ? 0 : (r < MLAT ? 1 : 2);
        const float* xr = xin ? (r < MLAT ? xin + (size_t)r * DM : cin + (size_t)(r - MLAT) * DM) : xrow_ptr(c, r); const float* sh = modl + (size_t)vec * NMOD + slot_shift * DM; const float* sc = sh + DM;
        f32x4 v[8]; float ss = 0.f;
#pragma unroll
        for (int j = 0; j < 8; ++j) { v[j] = *(const f32x4*)(xr + j * 256 + c.lane * 4); ss += (v[j][0] * v[j][0] + v[j][1] * v[j][1]) + (v[j][2] * v[j][2] + v[j][3] * v[j][3]); }
        const float rs = rsqrtf(wave_sum(ss) * (1.f / DM) + EPS);
        if constexpr (I8) { float mx = 0.f;
#pragma unroll
            for (int j = 0; j < 8; ++j) { const int col = j * 256 + c.lane * 4;
                const f32x4 g = *(const f32x4*)(gain + col), s1 = *(const f32x4*)(sc + col), s0 = *(const f32x4*)(sh + col);
                v[j] = (v[j] * rs * g) * (s1 + 1.f) + s0;
                mx = fmaxf(fmaxf(mx, fmaxf(fabsf(v[j][0]), fabsf(v[j][1]))), fmaxf(fabsf(v[j][2]), fabsf(v[j][3]))); }
#pragma unroll
            for (int o = 32; o > 0; o >>= 1) mx = fmaxf(mx, __shfl_xor(mx, o));
            const float q_ = mx > 0.f ? 127.f / mx : 0.f;
            if (c.lane == 0) ((float*)(c.ws + WS_ADQ))[r] = mx * (1.f / 127.f);
#pragma unroll
            for (int j = 0; j < 8; ++j) *(unsigned*)((unsigned char*)HX + (size_t)r * DM + j * 256 + c.lane * 4) = pk4_i8(v[j][0] * q_, v[j][1] * q_, v[j][2] * q_, v[j][3] * q_);
        } else {
#pragma unroll
        for (int j = 0; j < 8; ++j) { const int col = j * 256 + c.lane * 4;
            const f32x4 g = *(const f32x4*)(gain + col), s1 = *(const f32x4*)(sc + col), s0 = *(const f32x4*)(sh + col);
            const f32x4 y = (v[j] * rs * g) * (s1 + 1.f) + s0;
            u32x2 o; o.x = cvt_pk_bf16(y[0], y[1]); o.y = cvt_pk_bf16(y[2], y[3]);
            *(u32x2*)(HX + (size_t)r * DM + col) = o; } }
    }
}
__device__ __forceinline__ void seg_of_row(int r, bool& is_ctx, int& b, int& t) {
    is_ctx = r >= MLAT; b = is_ctx ? (r - MLAT) >> 8 : r >> 13; t = is_ctx ? (r - MLAT) & 255 : r & (SEQ - 1);
}
__device__ __forceinline__ void qk_row(const Ctx& c, int l, int r, bool do_q, bool dry) {
    bool is_ctx; int b, t; seg_of_row(r, is_ctx, b, t);
    const int key = is_ctx ? t : CTXL + t;
    bf16_t* prow = (bf16_t*)(c.ws + WS_P) + (size_t)r * NIN;
    bf16_t* KC = (bf16_t*)(c.ws + WS_KC); bf16_t* VC = (bf16_t*)(c.ws + WS_VC);
    const int hs = c.lane >> 4, ax = (c.lane >> 3) & 1, p0 = (c.lane & 7) * 4;
    f32x4 cs = {1.f, 1.f, 1.f, 1.f}, sn = {0.f, 0.f, 0.f, 0.f};
    if (!is_ctx) { const int pos = ax ? (t & 63) : (t >> 6); const float* rt = (const float*)(c.ws + WS_ROPE) + pos * 32 + p0; cs = *(const f32x4*)rt; sn = *(const f32x4*)(rt + 128 * 32); }
    u32x2 w1[5], w2[5];
#pragma unroll
    for (int g = 0; g < 5; ++g) { const bool is_k = (g == 4); const int head = is_k ? hs : g * 4 + hs;
        const bf16_t* src = prow + (is_k ? CK : CQ) + head * 128 + ax * 64 + p0;
        if (is_k || do_q) { w1[g] = *(const u32x2*)src; w2[g] = *(const u32x2*)(src + 32); } else { w1[g] = (u32x2){0u, 0u}; w2[g] = (u32x2){0u, 0u}; } }
    const u32x4 vw = *(const u32x4*)(prow + CV + (c.lane >> 4) * 128 + (c.lane & 15) * 8);
#pragma unroll
    for (int g = 0; g < 5; ++g) {
        const bool is_k = (g == 4);
        if (!is_k && !do_q) continue;
        const int head = is_k ? hs : g * 4 + hs;
        bf16_t* src = prow + (is_k ? CK : CQ) + head * 128 + ax * 64 + p0;
        f32x4 t1 = {bf_lo(w1[g].x), bf_hi(w1[g].x), bf_lo(w1[g].y), bf_hi(w1[g].y)}, t2 = {bf_lo(w2[g].x), bf_hi(w2[g].x), bf_lo(w2[g].y), bf_hi(w2[g].y)};
        float ss = (t1[0] * t1[0] + t1[1] * t1[1]) + (t1[2] * t1[2] + t1[3] * t1[3]) + (t2[0] * t2[0] + t2[1] * t2[1]) + (t2[2] * t2[2] + t2[3] * t2[3]);
        ss += DPPF(ss, 0xB1); ss += DPPF(ss, 0x4E); ss += DPPF(ss, 0x141); ss += DPPF(ss, 0x140);
        const float rs = rsqrtf(ss * (1.f / 128.f) + EPS);
        const float* gn = (const float*)(c.ws + WS_SP) + (is_k ? SP_KN : SP_QN) + ax * 64 + p0;
        const f32x4 g1 = *(const f32x4*)gn, g2 = *(const f32x4*)(gn + 32);
        const f32x4 y1 = t1 * rs * g1, y2 = t2 * rs * g2;
        const f32x4 o1 = y1 * cs - y2 * sn, o2 = y2 * cs + y1 * sn;
        bf16_t* dst = is_k ? KC + ((size_t)(b * 4 + head) * NKEY + key) * 128 + ax * 64 + p0 : (dry ? (bf16_t*)(c.ws + WS_YF) + (size_t)r * DM + head * 128 + ax * 64 + p0 : src);
        u32x2 a; a.x = cvt_pk_bf16(o1[0], o1[1]); a.y = cvt_pk_bf16(o1[2], o1[3]);
        u32x2 bq; bq.x = cvt_pk_bf16(o2[0], o2[1]); bq.y = cvt_pk_bf16(o2[2], o2[3]);
        *(u32x2*)dst = a; *(u32x2*)(dst + 32) = bq;
    }
    { const int hv = c.lane >> 4, dd = (c.lane & 15) * 8;
      *(u32x4*)(VC + ((size_t)(b * 4 + hv) * NKEY + key) * 128 + dd) = vw; }
}
__device__ __forceinline__ void unpack8(const u32x4 w, float (&f)[8]) {
    f[0] = bf_lo(w.x); f[1] = bf_hi(w.x); f[2] = bf_lo(w.y); f[3] = bf_hi(w.y); f[4] = bf_lo(w.z); f[5] = bf_hi(w.z); f[6] = bf_lo(w.w); f[7] = bf_hi(w.w);
}
__device__ __forceinline__ void sc_row(const Ctx& c, int l, int r, bool dry) {
    bool is_ctx; int b, t; seg_of_row(r, is_ctx, b, t);
    const int seglen = is_ctx ? CTXL : SEQ;
    bf16_t* prow = (bf16_t*)(c.ws + WS_P) + (size_t)r * NIN;
    const bool hp = t > 0, hn = t < seglen - 1;
    const float* w = (const float*)(c.ws + WS_SP) + SP_SCW; const float* bias = (const float*)(c.ws + WS_SP) + SP_SCB;
    u32x4 xb[4], xc0[4], xu0[4], xcp[4], xup[4], xcn[4], xun[4];
    const u32x4 z = {0u, 0u, 0u, 0u};
#pragma unroll
    for (int it = 0; it < 4; ++it) { const int col = it * 512 + c.lane * 8;
        xb[it] = *(const u32x4*)(prow + CBG + col); xc0[it] = *(const u32x4*)(prow + CCG + col); xu0[it] = *(const u32x4*)(prow + CU + col);
        xcp[it] = hp ? *(const u32x4*)(prow - NIN + CCG + col) : z; xup[it] = hp ? *(const u32x4*)(prow - NIN + CU + col) : z;
        xcn[it] = hn ? *(const u32x4*)(prow + NIN + CCG + col) : z; xun[it] = hn ? *(const u32x4*)(prow + NIN + CU + col) : z; }
#pragma unroll
    for (int it = 0; it < 4; ++it) {
        const int col = it * 512 + c.lane * 8;
        float bg[8], c0[8], u0[8], cp[8], up[8], cn[8], un[8];
        unpack8(xb[it], bg); unpack8(xc0[it], c0); unpack8(xu0[it], u0); unpack8(xcp[it], cp); unpack8(xup[it], up); unpack8(xcn[it], cn); unpack8(xun[it], un);
        float o[8];
#pragma unroll
        for (int hq = 0; hq < 2; ++hq) { const f32x4 w0 = *(const f32x4*)(w + col + hq * 4), w1 = *(const f32x4*)(w + DM + col + hq * 4), w2 = *(const f32x4*)(w + 2 * DM + col + hq * 4), bi = *(const f32x4*)(bias + col + hq * 4);
#pragma unroll
            for (int e = 0; e < 4; ++e) { const int k = hq * 4 + e; o[k] = bg[k] * (bi[e] + w0[e] * (cp[k] * up[k]) + w1[e] * (c0[k] * u0[k]) + w2[e] * (cn[k] * un[k])); } }
        u32x4 ow; ow.x = cvt_pk_bf16(o[0], o[1]); ow.y = cvt_pk_bf16(o[2], o[3]); ow.z = cvt_pk_bf16(o[4], o[5]); ow.w = cvt_pk_bf16(o[6], o[7]);
        *(u32x4*)((dry ? (bf16_t*)(c.ws + WS_YF) + (size_t)(MALL + r) * DM : prow + CBG) + col) = ow;
    }
}

constexpr size_t lsum_idx(int which, int dir, int b, int j) { return ((((size_t)which * 2 + dir) * NB + b) * NCHUNK + j) * DM; }
template <int DIR, int PASS>
__device__ __forceinline__ void lru_chunk(const LAS bf16_t* ub, const LAS float* uf, LAS float* hsd, const bf16x8 (&bfr)[4][4], const float (&ba)[2], const float (&bx)[2], const float (&sp8)[2],
                                          const float (&cin)[2], float (&Atot)[2], float (&Hend)[2], int q, int col16, int quad) {
    float st[2] = {cin[0], cin[1]}, at[2] = {1.f, 1.f};
    const int mysg = DIR ? 3 - quad : quad;
    for (int smt = 0; smt < 4; ++smt) {
        const int mt = DIR ? 3 - smt : smt;
        f32x4 acc[4];
#pragma unroll
        for (int nt = 0; nt < 4; ++nt) acc[nt] = (f32x4){0.f, 0.f, 0.f, 0.f};
#pragma unroll
        for (int ks = 0; ks < 4; ++ks) { const bf16x8 a = *(const LAS bf16x8*)(ub + (mt * 16 + col16) * 136 + ks * 32 + quad * 8);
#pragma unroll
            for (int nt = 0; nt < 4; ++nt) acc[nt] = __builtin_amdgcn_mfma_f32_16x16x32_bf16(a, bfr[nt][ks], acc[nt], 0, 0, 0); }
#pragma unroll
        for (int ct = 0; ct < 2; ++ct) {
            const int ch = q * 32 + ct * 16 + col16;
            float av[4], dv[4];
#pragma unroll
            for (int reg = 0; reg < 4; ++reg) { const int tl = mt * 16 + quad * 4 + reg;
                const float r = sigmoidf_(acc[ct][reg] + ba[ct]), ig = sigmoidf_(acc[2 + ct][reg] + bx[ct]);
                const float a = __expf(-sp8[ct] * r);
                av[reg] = a; dv[reg] = __builtin_amdgcn_sqrtf(fmaxf(1.f - a * a, 0.f)) * ig * uf[tl * 132 + ch]; }
            float Al = 1.f, Hl = 0.f;
#pragma unroll
            for (int sr = 0; sr < 4; ++sr) { const int reg = DIR ? 3 - sr : sr; Hl = av[reg] * Hl + dv[reg]; Al *= av[reg]; }
            float se = st[ct], so = st[ct], ap = 1.f;
#pragma unroll
            for (int sg = 0; sg < 4; ++sg) { const int qp = DIR ? 3 - sg : sg; const float Ag = __shfl(Al, col16 + 16 * qp), Hg = __shfl(Hl, col16 + 16 * qp);
                const float nx = Ag * so + Hg; so = nx; if (sg < mysg) se = nx; ap *= Ag; }
            if (PASS == 2) { float h = se;
#pragma unroll
                for (int sr = 0; sr < 4; ++sr) { const int reg = DIR ? 3 - sr : sr; h = av[reg] * h + dv[reg]; hsd[(mt * 16 + quad * 4 + reg) * 132 + ch] = h; } }
            else at[ct] *= ap;
            st[ct] = so;
        }
    }
    Atot[0] = at[0]; Atot[1] = at[1]; Hend[0] = st[0]; Hend[1] = st[1];
}

template <int PASS>
__device__ __forceinline__ void lru_run(const Ctx& c, int l, int unit, bool dry = false) {
    const int b = unit >> 7, n = (unit >> 3) & 15, run = unit & 7;
    const int c0 = run * 16 + (run < 4 ? run : 4), len = 16 + (run < 4 ? 1 : 0);
    LAS float* xl = (LAS float*)c.lds;
    LAS float* uf = (LAS float*)(c.lds + 34816);
    LAS bf16_t* ub = (LAS bf16_t*)(c.lds + 34816 + 33792);
    LAS float* car = (LAS float*)(c.lds + 34816 + 33792 + 17408);
    LAS float* hsr = (LAS float*)(c.lds + 34816 + 33792 + 17408 + 17408);
    const int d = c.wave >> 2, q = c.wave & 3, col16 = c.lane & 15, quad = c.lane >> 4;
    float* LS = (float*)(c.ws + WS_LSUM);
    bf16_t* P = (bf16_t*)(c.ws + WS_P);
    bf16x8 bfr[4][4];
#pragma unroll
    for (int nt = 0; nt < 4; ++nt) { const int j = d * 256 + (nt >> 1) * 128 + q * 32 + (nt & 1) * 16 + col16;
#pragma unroll
        for (int ks = 0; ks < 4; ++ks) bfr[nt][ks] = *(const bf16x8*)((const bf16_t*)(c.ws + WS_WLRU) + ((size_t)(n * 512 + j) * 128 + ks * 32 + quad * 8)); }
    float ba[2], bx[2], sp8[2];
#pragma unroll
    for (int ct = 0; ct < 2; ++ct) { const int cidx = n * 128 + q * 32 + ct * 16 + col16; const float* sp = (const float*)(c.ws + WS_SP) + d * DM + cidx;
        ba[ct] = sp[SP_LBA]; bx[ct] = sp[SP_LBX]; sp8[ct] = sp[SP_LSP]; }
    if (PASS == 2) {
        if (c.tid < 256) { const int dir = c.tid >> 7, ch = c.tid & 127, cidx = n * 128 + ch; float st = 0.f;
#pragma unroll 1
            for (int k0 = 0; k0 < NCHUNK; k0 += 12) {
                float av[12], hv[12];
#pragma unroll
                for (int kk = 0; kk < 12; ++kk) { const int k = k0 + kk, j = dir ? (k < 4 ? 3 - k : 135 - k) : k; av[kk] = LS[lsum_idx(0, dir, b, j) + cidx]; hv[kk] = LS[lsum_idx(1, dir, b, j) + cidx]; }
#pragma unroll
                for (int kk = 0; kk < 12; ++kk) { const int k = k0 + kk, j = dir ? (k < 4 ? 3 - k : 135 - k) : k;
                    if (j >= c0 && j < c0 + len) car[(dir * 17 + (j - c0)) * 128 + ch] = st;
                    st = av[kk] * st + hv[kk]; } } }
        __syncthreads();
    }
    const float* cw = (const float*)(c.ws + WS_SP) + SP_LCW + n * 128; const float* cb = (const float*)(c.ws + WS_SP) + SP_LCB + n * 128;
#define LRU_GEOM(ci_, jc, is_ctx, rb, t0, seglen) const int jc = c0 + (ci_); const bool is_ctx = jc < 4; \
        const int rb = is_ctx ? MLAT + b * CTXL : b * SEQ, t0 = is_ctx ? jc * 64 : (jc - 4) * 64, seglen = is_ctx ? CTXL : SEQ
#define LRU_LOAD(ci_, XR, LG) do { LRU_GEOM(ci_, jc_, ic_, rb_, t0_, sl_); (void)ic_; \
        _Pragma("unroll") for (int ps = 0; ps < 3; ++ps) { const int i = ps * 32 + (c.tid >> 4); const int t = t0_ - 2 + i; XR[ps] = (u32x4){0u, 0u, 0u, 0u}; \
            if (i < 68 && t >= 0 && t < sl_) XR[ps] = *(const u32x4*)(P + (size_t)(rb_ + t) * NIN + CLX + n * 128 + (c.tid & 15) * 8); } \
        if (PASS == 2) { const bf16_t* gp_ = P + (size_t)(rb_ + t0_ + (c.tid >> 3)) * NIN + CLG + n * 128 + (c.tid & 7) * 16; LG[0] = *(const u32x4*)gp_; LG[1] = *(const u32x4*)(gp_ + 8); } } while (0)
    u32x4 xr[3], lgc[2] = {{0u, 0u, 0u, 0u}, {0u, 0u, 0u, 0u}}, lgn[2] = {{0u, 0u, 0u, 0u}, {0u, 0u, 0u, 0u}};
    LRU_LOAD(0, xr, lgn);
    for (int ci = 0; ci < len; ++ci) {
        LRU_GEOM(ci, jc, is_ctx, rb, t0, seglen); (void)is_ctx; (void)seglen;
#pragma unroll
        for (int ps = 0; ps < 3; ++ps) { const int i = ps * 32 + (c.tid >> 4);
            if (i < 68) { float f[8]; unpack8(xr[ps], f);
                *(LAS f32x4*)(xl + i * 128 + (c.tid & 15) * 8) = (f32x4){f[0], f[1], f[2], f[3]}; *(LAS f32x4*)(xl + i * 128 + (c.tid & 15) * 8 + 4) = (f32x4){f[4], f[5], f[6], f[7]}; } }
        lgc[0] = lgn[0]; lgc[1] = lgn[1];
        __syncthreads();
        if (ci + 1 < len) LRU_LOAD(ci + 1, xr, lgn);
        { const int ch = c.tid & 127, tq = c.tid >> 7; const float w0 = cw[ch], w1 = cw[DM + ch], w2 = cw[2 * DM + ch], w3 = cw[3 * DM + ch], bb = cb[ch];
#pragma unroll 4
          for (int tt = 0; tt < 16; ++tt) { const int tl = tq * 16 + tt;
              const float u = bb + w0 * xl[tl * 128 + ch] + w1 * xl[(tl + 1) * 128 + ch] + w2 * xl[(tl + 2) * 128 + ch] + w3 * xl[(tl + 3) * 128 + ch];
              uf[tl * 132 + ch] = u; ub[tl * 136 + ch] = f2bf(u); } }
        __syncthreads();
        float cin[2] = {0.f, 0.f}, At[2], He[2];
        if (PASS == 2) { cin[0] = car[(d * 17 + ci) * 128 + q * 32 + col16]; cin[1] = car[(d * 17 + ci) * 128 + q * 32 + 16 + col16]; }
        if (d == 0) lru_chunk<0, PASS>(ub, uf, xl, bfr, ba, bx, sp8, cin, At, He, q, col16, quad);
        else lru_chunk<1, PASS>(ub, uf, hsr, bfr, ba, bx, sp8, cin, At, He, q, col16, quad);
        if (PASS == 1) {
            if (quad == 0) {
#pragma unroll
                for (int ct = 0; ct < 2; ++ct) { const int cidx = n * 128 + q * 32 + ct * 16 + col16;
                    LS[lsum_idx(0, d, b, jc) + cidx] = At[ct]; LS[lsum_idx(1, d, b, jc) + cidx] = He[ct]; } }
            __syncthreads();
        } else {
            __syncthreads();
            { const int row = c.tid >> 3, cs = (c.tid & 7) * 16;
              bf16_t* gp = P + (size_t)(rb + t0 + row) * NIN + CLG + n * 128 + cs;
#pragma unroll
              for (int hseg = 0; hseg < 2; ++hseg) { float g[8]; unpack8(lgc[hseg], g);
                  const int o = row * 132 + cs + hseg * 8;
                  const f32x4 h0 = *(const LAS f32x4*)(xl + o) + *(const LAS f32x4*)(hsr + o), h1 = *(const LAS f32x4*)(xl + o + 4) + *(const LAS f32x4*)(hsr + o + 4);
                  u32x4 ow; ow.x = cvt_pk_bf16(h0[0] * gelu_tanh(g[0]), h0[1] * gelu_tanh(g[1])); ow.y = cvt_pk_bf16(h0[2] * gelu_tanh(g[2]), h0[3] * gelu_tanh(g[3]));
                  ow.z = cvt_pk_bf16(h1[0] * gelu_tanh(g[4]), h1[1] * gelu_tanh(g[5])); ow.w = cvt_pk_bf16(h1[2] * gelu_tanh(g[6]), h1[3] * gelu_tanh(g[7]));
                  *(u32x4*)((dry ? gp - CLG + CU : gp) + hseg * 8) = ow; } }
            __syncthreads();
        }
    }
#undef LRU_GEOM
#undef LRU_LOAD
}

__device__ __forceinline__ void phase_qk(const Ctx& c, int l, bool dry = false) {
    const int gw = c.wg * NWAVES + c.wave, NGW = c.G * NWAVES;
    for (int r = gw; r < MALL; r += NGW) qk_row(c, l, r, l == 0 || r < MLAT, dry);
}
__device__ __forceinline__ void sc_block8(const Ctx& c, int r0, bool dry) {
    const int t0 = r0 & (SEQ - 1);
    bf16_t* prow0 = (bf16_t*)(c.ws + WS_P) + (size_t)r0 * NIN;
    const float* w = (const float*)(c.ws + WS_SP) + SP_SCW; const float* bias = (const float*)(c.ws + WS_SP) + SP_SCB;
    const u32x4 z = {0u, 0u, 0u, 0u};
#pragma unroll 1
    for (int it = 0; it < 4; ++it) {
        const int col = it * 512 + c.lane * 8;
        float w0[8], w1[8], w2[8], bi[8];
#pragma unroll
        for (int hq = 0; hq < 2; ++hq) { const f32x4 a = *(const f32x4*)(w + col + hq * 4), b = *(const f32x4*)(w + DM + col + hq * 4), d = *(const f32x4*)(w + 2 * DM + col + hq * 4), e = *(const f32x4*)(bias + col + hq * 4);
#pragma unroll
            for (int k = 0; k < 4; ++k) { w0[hq * 4 + k] = a[k]; w1[hq * 4 + k] = b[k]; w2[hq * 4 + k] = d[k]; bi[hq * 4 + k] = e[k]; } }
        u32x4 xc[10], xu[10], xb[8];
#pragma unroll
        for (int j = 0; j < 10; ++j) { const int t = t0 - 1 + j; const bool in = t >= 0 && t < SEQ; const bf16_t* pr = prow0 + (ptrdiff_t)(j - 1) * NIN;
            xc[j] = in ? *(const u32x4*)(pr + CCG + col) : z; xu[j] = in ? *(const u32x4*)(pr + CU + col) : z; }
#pragma unroll
        for (int j = 0; j < 8; ++j) xb[j] = *(const u32x4*)(prow0 + (size_t)j * NIN + CBG + col);
        float zp[8], zc[8];
        { float a[8], b[8]; unpack8(xc[0], a); unpack8(xu[0], b);
#pragma unroll
          for (int k = 0; k < 8; ++k) zp[k] = a[k] * b[k];
          unpack8(xc[1], a); unpack8(xu[1], b);
#pragma unroll
          for (int k = 0; k < 8; ++k) zc[k] = a[k] * b[k]; }
#pragma unroll
        for (int j = 0; j < 8; ++j) {
            float a[8], b[8], bg[8], zn[8], o[8]; unpack8(xc[j + 2], a); unpack8(xu[j + 2], b); unpack8(xb[j], bg);
#pragma unroll
            for (int k = 0; k < 8; ++k) { zn[k] = a[k] * b[k]; o[k] = bg[k] * (bi[k] + w0[k] * zp[k] + w1[k] * zc[k] + w2[k] * zn[k]); zp[k] = zc[k]; zc[k] = zn[k]; }
            u32x4 ow; ow.x = cvt_pk_bf16(o[0], o[1]); ow.y = cvt_pk_bf16(o[2], o[3]); ow.z = cvt_pk_bf16(o[4], o[5]); ow.w = cvt_pk_bf16(o[6], o[7]);
            *(u32x4*)((dry ? (bf16_t*)(c.ws + WS_YF) + (size_t)(MALL + r0 + j) * DM : prow0 + (size_t)j * NIN + CBG) + col) = ow; }
    }
}
__device__ __forceinline__ void phase_sc(const Ctx& c, int l, bool dry = false) {
    const int gw = c.wg * NWAVES + c.wave, NGW = c.G * NWAVES;
    for (int r0 = gw * 8; r0 < MLAT; r0 += NGW * 8) sc_block8(c, r0, dry);
    if (l == 0) for (int r = MLAT + gw; r < MALL; r += NGW) sc_row(c, l, r, dry);
}
__device__ __forceinline__ void phase_lru1(const Ctx& c, int l) {
    for (int u = c.wg; u < 256; u += c.G) lru_run<1>(c, l, u);
}

__device__ __forceinline__ void phase_m2(const Ctx& c, int l, bool dry = false) {
    bf16_t* P = (bf16_t*)(c.ws + WS_P); const bf16_t* KC = (const bf16_t*)(c.ws + WS_KC); const bf16_t* VC = (const bf16_t*)(c.ws + WS_VC);
    const int ntot = 1024 + (l == 0 ? 32 : 0);
    for (int i = 0; i * c.G + c.wg < ntot; ++i) {
        const int L = i * c.G + c.wg; int b, h, seq; size_t qrow;
        if (L < 1024) { int grp, qb;
            if (c.G == 256) { grp = i * 8 + (c.wg & 7); qb = c.wg >> 3; } else { grp = L >> 5; qb = L & 31; }
            b = grp >> 4; h = grp & 15; qrow = (size_t)(b * SEQ + qb * 256); seq = NKEY; }
        else { const int u = L - 1024; b = u >> 4; h = u & 15; qrow = (size_t)(MLAT + b * CTXL); seq = CTXL; }
        bf16_t* q = P + qrow * NIN + CQ + h * 128;
        const size_t kvo = (size_t)(b * 4 + (h >> 2)) * NKEY * 128;
        att::attn_dense_body(q, KC + kvo, VC + kvo, dry ? q - CQ + CCG : q, seq, (char*)c.lds, c.wave);
    }
}
__device__ __forceinline__ void phase_lru2(const Ctx& c, int l, bool dry = false) {
    for (int u = c.wg; u < 256; u += c.G) lru_run<2>(c, l, u, dry);
}
constexpr float NEGBIG = -3.0e38f;
constexpr float PU_SCALE = 32.f;
__device__ __forceinline__ float wave_max_dpp(float v) {
    v = fmaxf(v, DPPF(v, 0xB1)); v = fmaxf(v, DPPF(v, 0x4E)); v = fmaxf(v, DPPF(v, 0x141)); v = fmaxf(v, DPPF(v, 0x140));
    const float a = __int_as_float(__builtin_amdgcn_readlane(__float_as_int(v), 0)), b = __int_as_float(__builtin_amdgcn_readlane(__float_as_int(v), 16));
    const float c = __int_as_float(__builtin_amdgcn_readlane(__float_as_int(v), 32)), d = __int_as_float(__builtin_amdgcn_readlane(__float_as_int(v), 48));
    return fmaxf(fmaxf(a, b), fmaxf(c, d));
}
#define SWZ_XOR(v, m) __int_as_float(__builtin_amdgcn_ds_swizzle(__float_as_int(v), ((m) << 10) | 0x1F))
__device__ __forceinline__ unsigned fkey(float x) { const unsigned u = __float_as_uint(x); return (u & 0x80000000u) ? ~u : (u | 0x80000000u); }
#define DPPU(v, ctrl) ((unsigned)__builtin_amdgcn_update_dpp(0, (int)(v), ctrl, 0xF, 0xF, true))
__device__ __forceinline__ unsigned wave_max_u32(unsigned v) {
    v = max(v, DPPU(v, 0xB1)); v = max(v, DPPU(v, 0x4E)); v = max(v, DPPU(v, 0x141)); v = max(v, DPPU(v, 0x140));
    const unsigned a = (unsigned)__builtin_amdgcn_readlane((int)v, 0), b = (unsigned)__builtin_amdgcn_readlane((int)v, 16), c = (unsigned)__builtin_amdgcn_readlane((int)v, 32), d = (unsigned)__builtin_amdgcn_readlane((int)v, 48);
    return max(max(a, b), max(c, d));
}
__device__ __forceinline__ unsigned topk16_keys2(unsigned k0, unsigned k1, int lane) {
    unsigned res = 0u;
    for (int it = 0; it < 16; ++it) { const unsigned m = wave_max_u32(max(k0, k1)); k0 = (k0 == m) ? 0u : k0; k1 = (k1 == m) ? 0u : k1; res = (lane == it) ? m : res; }
    return res;
}
__device__ __forceinline__ unsigned topk16_keys1(unsigned k0, int lane) {
    unsigned res = 0u;
    for (int it = 0; it < 16; ++it) { const unsigned m = wave_max_u32(k0); k0 = (k0 == m) ? 0u : k0; res = (lane == it) ? m : res; }
    return res;
}
__device__ __forceinline__ void unpack_fp8x16(const u32x4 w, float (&f)[16]) {
#pragma unroll
    for (int d = 0; d < 4; ++d) { const f32x2 lo = __builtin_amdgcn_cvt_pk_f32_fp8((int)w[d], false), hi = __builtin_amdgcn_cvt_pk_f32_fp8((int)w[d], true);
        f[4 * d] = lo.x; f[4 * d + 1] = lo.y; f[4 * d + 2] = hi.x; f[4 * d + 3] = hi.y; }
}

__device__ __forceinline__ unsigned half_max_u32(unsigned v, bool hi_half) {
    v = max(v, DPPU(v, 0xB1)); v = max(v, DPPU(v, 0x4E)); v = max(v, DPPU(v, 0x141)); v = max(v, DPPU(v, 0x140));
    const unsigned a = max((unsigned)__builtin_amdgcn_readlane((int)v, 0), (unsigned)__builtin_amdgcn_readlane((int)v, 16));
    const unsigned b = max((unsigned)__builtin_amdgcn_readlane((int)v, 32), (unsigned)__builtin_amdgcn_readlane((int)v, 48));
    return hi_half ? b : a;
}
__device__ __forceinline__ unsigned topk16_half4(unsigned (&k)[4], int hl, bool hi_half) {
    unsigned res = 0u;
    for (int it = 0; it < 16; ++it) { const unsigned m = half_max_u32(max(max(k[0], k[1]), max(k[2], k[3])), hi_half);
#pragma unroll
        for (int j = 0; j < 4; ++j) k[j] = (k[j] == m) ? 0u : k[j];
        res = (hl == it) ? m : res; }
    return res;
}
__device__ __forceinline__ unsigned topk16_half2(unsigned k0, unsigned k1, int hl, bool hi_half) {
    unsigned res = 0u;
    for (int it = 0; it < 16; ++it) { const unsigned m = half_max_u32(max(k0, k1), hi_half); k0 = (k0 == m) ? 0u : k0; k1 = (k1 == m) ? 0u : k1; res = (hl == it) ? m : res; }
    return res;
}
__device__ __forceinline__ void cand_ab(int cidx50, int& a, int& b) {
    a = cidx50 < 16 ? 0 : cidx50 < 24 ? 1 : cidx50 < 29 ? 2 : cidx50 < 33 ? 3 : cidx50 < 36 ? 4 : cidx50 < 38 ? 5 : cidx50 < 40 ? 6 : cidx50 < 42 ? 7 : cidx50 - 34;
    const int st = cidx50 < 16 ? 0 : cidx50 < 24 ? 16 : cidx50 < 29 ? 24 : cidx50 < 33 ? 29 : cidx50 < 36 ? 33 : cidx50 < 38 ? 36 : cidx50 < 40 ? 38 : cidx50 < 42 ? 40 : cidx50;
    b = cidx50 - st;
}
__device__ __forceinline__ void peer_topk_pair(const LAS float* srow, int hp, LAS float* gsc, LAS int* isc, int lane) {
    const int hl = lane & 31, hb = lane & 32; const bool hi_half = lane >= 32; const int h = 2 * hp + (hi_half ? 1 : 0);
    const LAS float* sh = srow + h * 256;
    unsigned k1[4], k2[4];
#pragma unroll
    for (int j = 0; j < 4; ++j) { const int idx = hl + 32 * j; k1[j] = (fkey(sh[idx]) & ~127u) | (unsigned)(127 - idx); k2[j] = (fkey(sh[128 + idx]) & ~127u) | (unsigned)(127 - idx); }
    const unsigned r1 = topk16_half4(k1, hl, hi_half), r2 = topk16_half4(k2, hl, hi_half);
    const int i1 = 127 - (int)(r1 & 127u), i2 = 127 - (int)(r2 & 127u);
    const float v1 = sh[i1], v2 = sh[128 + i2];
    int a0, b0, a1, b1; cand_ab(hl, a0, b0); cand_ab(hl + 32, a1, b1);
    const float c0 = __shfl(v1, hb + a0) + __shfl(v2, hb + b0), c1 = __shfl(v1, hb + (a1 & 15)) + __shfl(v2, hb + (b1 & 15));
    const unsigned q0 = (fkey(c0) & ~255u) | (unsigned)(255 - (a0 * 16 + b0)), q1 = (hl + 32 < 50) ? ((fkey(c1) & ~255u) | (unsigned)(255 - (a1 * 16 + b1))) : 0u;
    const unsigned r3 = topk16_half2(q0, q1, hl, hi_half);
    const int ci = 255 - (int)(r3 & 255u);
    const float sc = __shfl(v1, hb + (ci >> 4)) + __shfl(v2, hb + (ci & 15));
    const int e = __shfl(i1, hb + (ci >> 4)) * 128 + __shfl(i2, hb + (ci & 15));
    const float mxa = __int_as_float(__builtin_amdgcn_readlane(__float_as_int(sc), 0)), mxb = __int_as_float(__builtin_amdgcn_readlane(__float_as_int(sc), 32));
    const float ex = hl < 16 ? __expf(sc - (hi_half ? mxb : mxa)) : 0.f;
    float sm = ex; sm += DPPF(sm, 0xB1); sm += DPPF(sm, 0x4E); sm += DPPF(sm, 0x141); sm += DPPF(sm, 0x140);
    if (hl < 16) { gsc[h * 16 + hl] = ex / sm; isc[h * 16 + hl] = e; }
}

constexpr size_t WS_PE_E = WS_P + 160 * MiB, WS_PE_CF = WS_PE_E + (size_t)MALL * 128 * 4;
constexpr int NSL = 16, SLW = 128;
constexpr size_t SLICE_BYTES = (size_t)16384 * SLW;
__device__ __forceinline__ void peer_token(const Ctx& c, int l, int r, int rn, int b, bool dry) {
    LAS float* gsc = (LAS float*)(c.lds + c.wave * 2048 + b * 1024);
    LAS int* isc = (LAS int*)(c.lds + c.wave * 2048 + b * 1024 + 512);
    LAS float* gscn = (LAS float*)(c.lds + c.wave * 2048 + (b ^ 1) * 1024); LAS int* iscn = (LAS int*)(c.lds + c.wave * 2048 + (b ^ 1) * 1024 + 512);
    const float* Sn = (const float*)(c.ws + WS_P) + (size_t)(rn < 0 ? r : rn) * DM;
    const int lane = c.lane;
    LAS float* snb = (LAS float*)(c.lds + 16384 + c.wave * 8192);
    f32x4 sv[8];
#pragma unroll
    for (int q = 0; q < 8; ++q) sv[q] = (rn >= 0) ? *(const f32x4*)(Sn + q * 256 + lane * 4) : (f32x4){0.f, 0.f, 0.f, 0.f};
    LDS_WAIT(); asm volatile("" ::: "memory");
    const bf16_t* hx = (const bf16_t*)(c.ws + WS_HX) + (size_t)r * DM;
    float hv[2][16];
#pragma unroll
    for (int j = 0; j < 2; ++j) { float t0[8], t1[8]; unpack8(*(const u32x4*)(hx + j * 1024 + lane * 16), t0); unpack8(*(const u32x4*)(hx + j * 1024 + lane * 16 + 8), t1);
#pragma unroll
        for (int k = 0; k < 8; ++k) { hv[j][k] = t0[k]; hv[j][8 + k] = t1[k]; } }
    const unsigned char* PU = (const unsigned char*)(c.ws + ws_pu(l)); const unsigned char* PV = (const unsigned char*)(c.ws + ws_pv(l));
#define PEER_LOADROW(tab, wk, e_) do { const unsigned char* row_ = (tab) + (size_t)__builtin_amdgcn_readfirstlane(e_) * DM + lane * 16; wk[0] = *(const u32x4*)row_; wk[1] = *(const u32x4*)(row_ + 1024); } while (0)
#define PEER_IDX8(dst, i_) const u32x4 ia_##dst = *(const LAS u32x4*)(isc + (i_)), ib_##dst = *(const LAS u32x4*)(isc + (i_) + 4); \
        const int dst[8] = {(int)ia_##dst[0], (int)ia_##dst[1], (int)ia_##dst[2], (int)ia_##dst[3], (int)ib_##dst[0], (int)ib_##dst[1], (int)ib_##dst[2], (int)ib_##dst[3]}
    u32x4 w[8][2];
    { PEER_IDX8(e0, 0);
#pragma unroll
      for (int k = 0; k < 8; ++k) PEER_LOADROW(PU, w[k], e0[k]); }
    if (rn >= 0) {
#pragma unroll
        for (int q = 0; q < 8; ++q) *(LAS f32x4*)(snb + q * 256 + lane * 4) = sv[q];
        LDS_WAIT(); asm volatile("" ::: "memory"); }
#pragma unroll 1
    for (int i = 0; i < 128; i += 8) {
        const bool has_next = i + 8 < 128;
        PEER_IDX8(en, has_next ? i + 8 : i);
        if (rn >= 0 && (i & 24) == 0) peer_topk_pair(snb, i >> 5, gscn, iscn, lane);
        float p[8];
#pragma unroll
        for (int k = 0; k < 8; ++k) {
            asm volatile("" : "+v"(w[k][0]), "+v"(w[k][1]));
            float s = 0.f;
#pragma unroll
            for (int j = 0; j < 2; ++j) { float f[16]; unpack_fp8x16(w[k][j], f);
#pragma unroll
                for (int e2 = 0; e2 < 16; ++e2) s += f[e2] * hv[j][e2]; }
            p[k] = s; asm volatile("" : "+v"(p[k]));
            if (has_next) PEER_LOADROW(PU, w[k], en[k]); }
        const bool b0 = lane & 1, b1 = lane & 2, b2 = lane & 4;
        float q[4], t[2];
#pragma unroll
        for (int m = 0; m < 4; ++m) q[m] = (b0 ? p[2 * m + 1] : p[2 * m]) + DPPF(b0 ? p[2 * m] : p[2 * m + 1], 0xB1);
#pragma unroll
        for (int m = 0; m < 2; ++m) t[m] = (b1 ? q[2 * m + 1] : q[2 * m]) + DPPF(b1 ? q[2 * m] : q[2 * m + 1], 0x4E);
        float s = (b2 ? t[1] : t[0]) + SWZ_XOR(b2 ? t[0] : t[1], 4);
        s += SWZ_XOR(s, 8); s += SWZ_XOR(s, 16); s += __shfl_xor(s, 32);
        if (lane < 8) gsc[i + lane] = gsc[i + lane] * gelu_tanh(s * (1.f / PU_SCALE));
    }
#undef PEER_LOADROW
#undef PEER_IDX8
    LDS_WAIT(); asm volatile("" ::: "memory");
    { int* E = (int*)(c.ws + WS_PE_E) + (size_t)r * 128; float* CF = (float*)(c.ws + WS_PE_CF) + (size_t)r * 128;
      E[lane] = isc[lane]; E[64 + lane] = isc[64 + lane]; CF[lane] = gsc[lane]; CF[64 + lane] = gsc[64 + lane]; }
    LDS_WAIT(); asm volatile("" ::: "memory");
}
__device__ __forceinline__ void phase_peer(const Ctx& c, int l, int nrows, bool dry = false) {
    const int gw = c.wg * NWAVES + c.wave, NGW = c.G * NWAVES;
    int r = gw; if (r >= nrows) return;
    { const float* S0 = (const float*)(c.ws + WS_P) + (size_t)r * DM; LAS float* snb0 = (LAS float*)(c.lds + 16384 + c.wave * 8192);
#pragma unroll
      for (int q = 0; q < 8; ++q) *(LAS f32x4*)(snb0 + q * 256 + c.lane * 4) = *(const f32x4*)(S0 + q * 256 + c.lane * 4);
      LDS_WAIT(); asm volatile("" ::: "memory");
#pragma unroll 1
      for (int hp = 0; hp < 4; ++hp) peer_topk_pair(snb0, hp, (LAS float*)(c.lds + c.wave * 2048), (LAS int*)(c.lds + c.wave * 2048 + 512), c.lane);
      LDS_WAIT(); asm volatile("" ::: "memory"); }
    int b = 0;
#pragma unroll 1
    for (; r < nrows; r += NGW, b ^= 1) { const int rn = r + NGW; peer_token(c, l, r, rn < nrows ? rn : -1, b, dry); }
}
#define PEER_SLICE_BEGIN() { const int grp = c.wg & 7, wi = (c.wg >> 3) * NWAVES + c.wave, nwi = ((c.G - grp + 7) >> 3) * NWAVES; \
    _Pragma("unroll 1") for (int ps = 0; ps < 2; ++ps) { const int s = grp + 8 * ps; _Pragma("unroll 1") for (int r = wi; r < nrows; r += nwi) {
#define PEER_SLICE_END() } } }
__device__ __forceinline__ void phase_peer_v(const Ctx& c, int l, int nrows, bool dry) {
    const int lane = c.lane, rg = lane >> 3, ch = lane & 7;
    const int* Eb = (const int*)(c.ws + WS_PE_E); const float* CF = (const float*)(c.ws + WS_PE_CF);
    const bool b3 = lane & 8, b4 = lane & 16, b5 = lane & 32;
    const int grp = c.wg & 7, wi = (c.wg >> 3) * NWAVES + c.wave, nwi = ((c.G - grp + 7) >> 3) * NWAVES;
#define V_META(r_, e0_, e1_, c0_, c1_) do { if ((r_) < nrows) { e0_ = Eb[(size_t)(r_) * 128 + lane]; e1_ = Eb[(size_t)(r_) * 128 + 64 + lane]; c0_ = CF[(size_t)(r_) * 128 + lane]; c1_ = CF[(size_t)(r_) * 128 + 64 + lane]; } } while (0)
#pragma unroll 1
    for (int ps = 0; ps < 2; ++ps) { const int s = grp + 8 * ps;
        const unsigned char* tab = (const unsigned char*)(c.ws + ws_pv(l)) + (size_t)s * SLICE_BYTES + ch * 16;
        const int col = s * SLW + ch * 16 + (b3 ? 8 : 0) + (b4 ? 4 : 0) + (b5 ? 2 : 0);
        int r = wi; int e0 = 0, e1 = 0; float c0 = 0.f, c1 = 0.f;
        V_META(r, e0, e1, c0, c1);
#pragma unroll 1
        for (; r < nrows; r += nwi) {
            u32x4 w[16];
#pragma unroll
            for (int i = 0; i < 16; ++i) { const int e = __shfl(i < 8 ? e0 : e1, (8 * i + rg) & 63); w[i] = *(const u32x4*)(tab + (size_t)e * SLW); }
            int f0 = 0, f1 = 0; float d0 = 0.f, d1 = 0.f; V_META(r + nwi, f0, f1, d0, d1);
            const int vec = r < SEQ ? 0 : (r < MLAT ? 1 : 2);
            float* xr = (dry ? (float*)(c.ws + WS_YF) + (size_t)r * DM : xrow_ptr(c, r)) + col;
            const f32x2 gg = *(const f32x2*)((const float*)(c.ws + WS_MOD) + ((size_t)l * 3 + vec) * NMOD + 5 * DM + col); f32x2 xx = *(const f32x2*)xr;
            float o[16];
#pragma unroll
            for (int j = 0; j < 16; ++j) o[j] = 0.f;
#pragma unroll
            for (int i = 0; i < 16; ++i) {
                asm volatile("" : "+v"(w[i]));
                const float ci_ = __shfl(i < 8 ? c0 : c1, (8 * i + rg) & 63);
                float f[16]; unpack_fp8x16(w[i], f);
#pragma unroll
                for (int j = 0; j < 16; ++j) o[j] += ci_ * f[j];
                asm volatile("" : "+v"(o[0])); }
            float q8[8], q4[4], q2[2];
#pragma unroll
            for (int j = 0; j < 8; ++j) q8[j] = (b3 ? o[8 + j] : o[j]) + DPPF(b3 ? o[j] : o[8 + j], 0x128);
#pragma unroll
            for (int j = 0; j < 4; ++j) q4[j] = (b4 ? q8[4 + j] : q8[j]) + SWZ_XOR(b4 ? q8[j] : q8[4 + j], 16);
#pragma unroll
            for (int j = 0; j < 2; ++j) q2[j] = (b5 ? q4[2 + j] : q4[j]) + __shfl_xor(b5 ? q4[j] : q4[2 + j], 32);
            xx[0] += gg[0] * q2[0]; xx[1] += gg[1] * q2[1];
            *(f32x2*)xr = xx;
            e0 = f0; e1 = f1; c0 = d0; c1 = d1;
        }
    }
#undef V_META
}
struct Args { const float* in[29]; float* out; unsigned char* ws; int ph_lo, ph_hi; };
constexpr int PH_PER_LAYER = 10, N_PHASES = NLAYER * PH_PER_LAYER;
#ifndef G1_WGM
#define G1_WGM 3
#endif
constexpr int CW_BAR = 4096;

__global__ void __launch_bounds__(NTHREADS, 2) mk_fwd(Args args) {
    extern __shared__ __attribute__((aligned(16))) unsigned char lds_raw[];
    Ctx c0;
    c0.out = args.out; c0.ws = args.ws; c0.lds = (LAS unsigned char*)lds_raw;
    c0.tid = threadIdx.x; c0.lane = c0.tid & 63; c0.wave = __builtin_amdgcn_readfirstlane((int)(threadIdx.x >> 6)); c0.wg = blockIdx.x; c0.G = gridDim.x;
    volatile LAS unsigned* MISC = (volatile LAS unsigned*)(c0.lds + MISC_OFF);
    if (c0.tid < 64) MISC[c0.tid] = 0u;
    __syncthreads();
    const int lo = args.ph_lo, hi = args.ph_hi;
    XcdBarrier bar; bar.bar = (unsigned*)(c0.ws + WS_CTL) + CW_BAR; bar.x = 0; bar.st = MISC + 8;
    if (hi - lo > 1) bar = xcd_barrier_post((unsigned*)(c0.ws + WS_CTL) + CW_BAR, MISC + 8);
#ifndef ONLY_PH
#define ONLY_PH -1
#endif
#define IN(k) ((ONLY_PH < 0 || ((k) % PH_PER_LAYER) == ONLY_PH) && lo <= (k) && (k) < hi)
#define PH_BEGIN() Ctx c = c0; unsigned long long wsi_ = (unsigned long long)c0.ws, outi_ = (unsigned long long)c0.out; asm volatile("" : "+s"(wsi_), "+s"(outi_), "+s"(c.wg), "+s"(c.G), "+s"(c.wave)); \
    c.lane = lane_id_fresh(); c.tid = c.wave * 64 + c.lane; c.ws = (unsigned char*)(GAS unsigned char*)wsi_; c.out = (float*)(GAS float*)outi_;     \
    bf16_t* P = (bf16_t*)(c.ws + WS_P); bf16_t* HX = (bf16_t*)(c.ws + WS_HX); float* YF = (float*)(c.ws + WS_YF); (void)P; (void)HX; (void)YF
#ifndef PROBE_DUP
#define PROBE_DUP -1
#endif
#define REPS(k) for (int rep = 0, dry = (PROBE_DUP == (k)); rep < (PROBE_DUP == (k) ? 2 : 1); ++rep, dry = 0)
#define SEAM(k) do { if (IN(k) && IN((k) + 1)) { xcd_barrier(bar, c0.wave); if (PROBE_DUP == 20) xcd_barrier(bar, c0.wave); } } while (0)
    const bool early = (c0.G == 256);
#define TAIL_BEGIN() PH_BEGIN(); c.wg -= 32; c.G -= 32
    for (int l = 0; l < NLAYER; ++l) {
        const int pb = l * PH_PER_LAYER;
        const int mrows = (l == 0) ? MALL : MLAT;
        if (IN(pb + 0) && !(l == 1 && early)) REPS(0) {
            if (l == 0) { PH_BEGIN(); conv_colmax(c); }
            { PH_BEGIN(); conv_units(c, l); } { PH_BEGIN(); conv_tables(c, l); } { PH_BEGIN(); conv_small(c, l); }
            if (l == 0) { { PH_BEGIN(); conv_once(c); } xcd_barrier(bar, c0.wave); }
            { PH_BEGIN(); conv_transposes(c, l); } }
        if (!(l == 1 && early)) SEAM(pb + 0);
        if (IN(pb + 1)) REPS(1) { PH_BEGIN();
            if (l == 0) { GET_IN(); phase_norm<true>(c, l, MALL, SP_NMIX, 0, INP(I_X), INP(I_CTX)); } else phase_norm<true>(c, l, MALL, SP_NMIX, 0); }
        SEAM(pb + 1);
        if (IN(pb + 2)) REPS(2) { PH_BEGIN();
            pg8::Gemm g{HX, (const bf16_t*)(c.ws + WS_WIN), MALL, NIN, DM, DM, DM}; pg8::StaticOrder S; S.init(MALL, NIN, c.G, c.wg, G1_WGM);
            pg8::EpiI8 E{P, NIN, (const float*)(c.ws + WS_ADQ), (const float*)(c.ws + WS_WDQ)};
            pg8::gemm_phase<pg8::EpiI8, pg8::StaticOrder, true, true, false, true>(c.lds, g, S, E, c.wave);
        }
        SEAM(pb + 2);
        if (IN(pb + 3)) REPS(3) {
            int flip_ = (c0.wg >> 3) & 1; asm volatile("" : "+s"(flip_));
#pragma unroll 1
            for (int st = 0; st < 2; ++st) {
                if ((st ^ flip_) == 0) { { PH_BEGIN(); phase_qk(c, l, dry); } { PH_BEGIN(); phase_sc(c, l, dry); } }
                else { PH_BEGIN(); phase_lru1(c, l); }
                __syncthreads(); }
            if (PROBE_DUP == 30) { PH_BEGIN(); phase_lru1(c, l); } }
        SEAM(pb + 3);
        if (IN(pb + 4)) REPS(4) {
            int flip_ = (c0.wg >> 3) & 1; asm volatile("" : "+s"(flip_));
#pragma unroll 1
            for (int st = 0; st < 2; ++st) {
                if ((st ^ flip_) == 0) { PH_BEGIN(); phase_m2(c, l, dry); }
                else { PH_BEGIN(); phase_lru2(c, l, dry); }
                __syncthreads(); }
            if (PROBE_DUP == 31) { PH_BEGIN(); phase_lru2(c, l, true); } }
        SEAM(pb + 4);
        if (IN(pb + 5)) REPS(5) { { PH_BEGIN();
            pg8::MixOrder S; S.init(mrows, c.G, c.wg);
            const bf16_t* WO = (const bf16_t*)(c.ws + WS_WO);
            { pg8::Gemm g{P + CQ, WO, mrows, DM, DM, NIN, DM}; pg8::EpiMerge<0> E{P + CGT, NIN, (bf16_t*)YF, HX};
              pg8::gemm_phase<pg8::EpiMerge<0>, pg8::MixOrder, true, true, true>(c.lds, g, S, E, c.wave); }
            { pg8::Gemm g{P + CLG, WO + (size_t)DM * DM, mrows, DM, DM, NIN, DM}; pg8::EpiMerge<1> E{P + CGT + DM, NIN, (bf16_t*)YF, HX};
              pg8::gemm_phase<pg8::EpiMerge<1>, pg8::MixOrder, true, true, true>(c.lds, g, S, E, c.wave); }
            { pg8::Gemm g{P + CBG, WO + (size_t)2 * DM * DM, mrows, DM, DM, NIN, DM}; pg8::EpiMerge<2> E{P + CGT + 2 * DM, NIN, (bf16_t*)YF, HX};
              pg8::gemm_phase<pg8::EpiMerge<2>, pg8::MixOrder, true, true, true>(c.lds, g, S, E, c.wave); }
            }
            if (l == 0 && early && c0.wg >= 32 && !dry) { { TAIL_BEGIN(); conv_transposes(c, 1, CV_WIN); } { TAIL_BEGIN(); conv_tables(c, 1, CV_PU); } }
        }
        SEAM(pb + 5);
        if (IN(pb + 6)) REPS(6) { { PH_BEGIN();
            pg8::Gemm g{HX, (const bf16_t*)(c.ws + WS_WOUT), mrows, DM, DM, DM, DM}; pg8::MixOrder S; S.init(mrows, c.G, c.wg);
            float* xl_ = dry ? YF : c.out; float* xc_ = dry ? YF + (size_t)MLAT * DM : (float*)(c.ws + WS_CTXS);
            const float* sl_ = xl_; const float* sc_ = xc_;
            if (l == 0 && !dry) { GET_IN(); sl_ = INP(I_X); sc_ = INP(I_CTX); }
            pg8::EpiResid E{xl_, xc_, (const float*)(c.ws + WS_MOD) + (size_t)l * 3 * NMOD + 2 * DM, sl_, sc_};
            pg8::gemm_phase<pg8::EpiResid, pg8::MixOrder, true, true, true>(c.lds, g, S, E, c.wave);
            }
            if (l == 0 && early && c0.wg >= 32 && !dry) { { TAIL_BEGIN(); conv_units(c, 1); } { TAIL_BEGIN(); conv_transposes(c, 1, CV_WO); } }
        }
        SEAM(pb + 6);
        if (IN(pb + 7)) REPS(7) { PH_BEGIN(); phase_norm(c, l, mrows, SP_NFFN, 3); }
        SEAM(pb + 7);
        if (IN(pb + 8)) REPS(8) { { PH_BEGIN();
            pg8::Gemm g{HX, (const bf16_t*)(c.ws + ws_wsc(l)), mrows, DM, DM, DM, DM}; pg8::MixOrder S; S.init(mrows, c.G, c.wg);
            pg8::EpiF32 E{(float*)(c.ws + WS_P), DM};
            pg8::gemm_phase<pg8::EpiF32, pg8::MixOrder, true, true, true>(c.lds, g, S, E, c.wave);
            }
            if (l == 0 && early && c0.wg >= 32 && !dry) { { TAIL_BEGIN(); conv_transposes(c, 1, CV_WOUT); } { TAIL_BEGIN(); conv_tables(c, 1, CV_PV | CV_LRU); } { TAIL_BEGIN(); conv_small(c, 1); } }
        }
        SEAM(pb + 8);
        if (IN(pb + 9)) REPS(9) {
            { PH_BEGIN(); phase_peer(c, l, mrows, dry); } xcd_barrier(bar, c0.wave);
            { PH_BEGIN(); phase_peer_v(c, l, mrows, dry); } }
        SEAM(pb + 9);
    }
#undef IN
#undef SEAM
}

extern "C" void kernel_launch(void* const* d_in, const int* in_sizes, int n_in, void* d_out, int out_size, void* d_ws, size_t ws_size, hipStream_t stream) {
    static int grid = 0;
    if (grid == 0) {
        if (n_in != 29 || in_sizes[0] != MLAT * DM || out_size != MLAT * DM || ws_size < WS_END) {
            fprintf(stderr, "kernel_launch: built for 29 inputs, x/out of %d floats, >= %zu bytes of workspace; got n_in %d, in0 %d, out %d, ws %zu; nothing launched\n", MLAT * DM, (size_t)WS_END, n_in, n_in > 0 ? in_sizes[0] : -1, out_size, ws_size);
            grid = -1; return; }
        int dev = 0, cus = 0, per_cu = 0;
        if (hipGetDevice(&dev) != hipSuccess || hipDeviceGetAttribute(&cus, hipDeviceAttributeMultiprocessorCount, dev) != hipSuccess) { fprintf(stderr, "kernel_launch: device query failed\n"); grid = -1; return; }
        if (hipFuncSetAttribute((const void*)mk_fwd, hipFuncAttributeMaxDynamicSharedMemorySize, LDS_BYTES) != hipSuccess) { fprintf(stderr, "kernel_launch: hipFuncSetAttribute failed\n"); grid = -1; return; }
        if (hipOccupancyMaxActiveBlocksPerMultiprocessor(&per_cu, (const void*)mk_fwd, NTHREADS, LDS_BYTES) != hipSuccess || per_cu < 1)
            fprintf(stderr, "kernel_launch: note: occupancy query reports %d workgroups per CU\n", per_cu);
        (void)hipGetLastError();
        grid = cus;
    }
    if (grid < 0) return;
    if (hipMemsetAsync((char*)d_ws + WS_CTL, 0, CTL_ZERO_BYTES, stream) != hipSuccess) { fprintf(stderr, "kernel_launch: memset failed\n"); return; }
    Args a{};
    for (int i = 0; i < 29; ++i) a.in[i] = (const float*)d_in[i];
    a.out = (float*)d_out; a.ws = (unsigned char*)d_ws;
#if MK_N_LAUNCHES == 1
    a.ph_lo = 0; a.ph_hi = N_PHASES;
    hipLaunchKernelGGL(mk_fwd, dim3(grid), dim3(NTHREADS), LDS_BYTES, stream, a);
#else
    for (int k = 0; k < N_PHASES; ++k) { a.ph_lo = k; a.ph_hi = k + 1; hipLaunchKernelGGL(mk_fwd, dim3(grid), dim3(NTHREADS), LDS_BYTES, stream, a); }
#endif
    const hipError_t le = hipPeekAtLastError();
    if (le != hipSuccess) fprintf(stderr, "kernel_launch: launch failed: %s\n", hipGetErrorName(le));
}
```

```cpp
#include <hip/hip_runtime.h>
#include <cstdio>
#include <cstdint>

#ifndef MK_N_LAUNCHES
#define MK_N_LAUNCHES 1
#endif
#if MK_N_LAUNCHES != 1
#error "the PEER phase carries a grid barrier of its own: this kernel is one launch only"
#endif

#define GAS __attribute__((address_space(1)))
#define LAS __attribute__((address_space(3)))
typedef unsigned short bf16_t;
typedef short bf16x8 __attribute__((ext_vector_type(8)));
typedef short s16x4 __attribute__((ext_vector_type(4)));
typedef float f32x2 __attribute__((ext_vector_type(2)));
typedef float f32x4 __attribute__((ext_vector_type(4)));
typedef float f32x8 __attribute__((ext_vector_type(8)));
typedef float f32x16 __attribute__((ext_vector_type(16)));
typedef unsigned u32x2 __attribute__((ext_vector_type(2)));
typedef unsigned u32x4 __attribute__((ext_vector_type(4)));
typedef int i32x4 __attribute__((ext_vector_type(4)));

constexpr int DM = 2048, NB = 2, SEQ = 8192, NLAYER = 2, CTXL = 256;
constexpr int MLAT = NB * SEQ, MCTX = NB * CTXL, MALL = MLAT + MCTX;
constexpr int NIN = 19456;
constexpr int CQ = 0, CK = 2048, CV = 2560, CLX = 3072, CLG = 5120, CBG = 7168, CCG = 9216, CU = 11264, CGT = 13312;
constexpr int NKEY = SEQ + CTXL;
constexpr int NCHUNK = NKEY / 64;
constexpr int NMOD = 6 * DM;
constexpr float EPS = 1e-6f;
constexpr int NWAVES = 8, NTHREADS = 512;

constexpr size_t MiB = 1u << 20;
constexpr size_t al256(size_t x) { return (x + 255) / 256 * 256; }
constexpr size_t WS_CTL = 0, CTL_ZERO_BYTES = 1 * MiB;
constexpr size_t WS_MOD = WS_CTL + CTL_ZERO_BYTES;
constexpr size_t WS_ROPE = WS_MOD + al256((size_t)NLAYER * 3 * NMOD * 4);
constexpr size_t WS_SP = WS_ROPE + al256(2 * 128 * 32 * 4);
constexpr size_t WS_CTXS = WS_SP + al256(36864 * 4);
constexpr size_t WS_LSUM = WS_CTXS + al256((size_t)MCTX * DM * 4);
constexpr size_t WS_WLRU = WS_LSUM + al256((size_t)2 * 2 * NB * NCHUNK * DM * 4);
constexpr size_t WS_KC = WS_WLRU + al256((size_t)16 * 512 * 128 * 2);
constexpr size_t WS_VC = WS_KC + al256((size_t)NB * 4 * NKEY * 128 * 2);
constexpr size_t WS_WIN = WS_VC + al256((size_t)NB * 4 * NKEY * 128 * 2);
constexpr size_t WS_CMAX = WS_WIN + (size_t)NIN * DM;
constexpr size_t WS_WDQ = WS_CMAX + al256((size_t)2 * 32 * NIN * 4);
constexpr size_t WS_ADQ = WS_WDQ + al256((size_t)NIN * 4);
constexpr size_t WS_WO = WS_WIN + al256((size_t)NIN * DM * 2);
constexpr size_t WS_WOUT = WS_WO + al256((size_t)3 * DM * DM * 2);
constexpr size_t WS_WSC = WS_WOUT + al256((size_t)DM * DM * 2);
constexpr size_t WS_PU = WS_WSC + al256((size_t)DM * DM * 2);
constexpr size_t WS_PV = WS_PU + al256((size_t)16384 * DM);
constexpr size_t WS_HX = WS_PV + al256((size_t)16384 * DM);
constexpr size_t WS_YF = WS_HX + al256((size_t)MALL * DM * 2);
constexpr size_t WS_P = WS_YF + al256((size_t)MALL * DM * 4);
static_assert(WS_ADQ + (size_t)MALL * 4 <= WS_WO, "the int8 side tables must fit the spare half of the w_in region");
constexpr size_t WS_PU2 = WS_P + al256((size_t)MALL * NIN * 2);
constexpr size_t WS_PV2 = WS_PU2 + al256((size_t)16384 * DM);
constexpr size_t WS_WSC2 = WS_PV2 + al256((size_t)16384 * DM);
constexpr size_t WS_USC = WS_WSC2 + al256((size_t)DM * DM * 2);
constexpr size_t WS_END = WS_USC + al256((size_t)2 * 16384 * 4);
__host__ __device__ constexpr size_t ws_pu(int l) { return l ? WS_PU2 : WS_PU; }
__host__ __device__ constexpr size_t ws_pv(int l) { return l ? WS_PV2 : WS_PV; }
__host__ __device__ constexpr size_t ws_wsc(int l) { return l ? WS_WSC2 : WS_WSC; }

constexpr int SP_NMIX = 0, SP_NFFN = 2048, SP_QN = 4096, SP_KN = 4224, SP_LCW = 4352, SP_LCB = 12544, SP_LBA = 14592, SP_LBX = 18688, SP_LSP = 22784, SP_SCW = 26880, SP_SCB = 33024, SP_END = 35072;

constexpr int LDS_BYTES = 147456;
constexpr int MISC_OFF = 147456 - 256;
constexpr int LDS_WORK = MISC_OFF;

__device__ __forceinline__ unsigned cvt_pk_bf16(float lo, float hi) { unsigned r; asm volatile("v_cvt_pk_bf16_f32 %0, %1, %2" : "=v"(r) : "v"(lo), "v"(hi)); return r; }
__device__ __forceinline__ unsigned pk4_i8(float a, float b, float c, float d) {
    const int ia = (int)__builtin_rintf(a), ib = (int)__builtin_rintf(b), ic = (int)__builtin_rintf(c), id = (int)__builtin_rintf(d);
    return ((unsigned)ia & 255u) | (((unsigned)ib & 255u) << 8) | (((unsigned)ic & 255u) << 16) | ((unsigned)id << 24); }
__device__ __forceinline__ float bf_lo(unsigned w) { return __uint_as_float(w << 16); }
__device__ __forceinline__ float bf_hi(unsigned w) { return __uint_as_float(w & 0xffff0000u); }
__device__ __forceinline__ float bf1(bf16_t h) { return __uint_as_float(((unsigned)h) << 16); }
__device__ __forceinline__ bf16_t f2bf(float f) { return (bf16_t)(cvt_pk_bf16(f, 0.f) & 0xffffu); }
__device__ __forceinline__ float sigmoidf_(float x) { return __builtin_amdgcn_rcpf(1.f + __expf(-x)); }
__device__ __forceinline__ float gelu_tanh(float x) { const float z = 0.7978845608028654f * (x + 0.044715f * x * x * x); const float e = __expf(2.f * z); return 0.5f * x * (2.f - 2.f * __builtin_amdgcn_rcpf(e + 1.f)); }
__device__ __forceinline__ float wave_sum(float v) {
#pragma unroll
    for (int o = 1; o < 64; o <<= 1) v += __shfl_xor(v, o);
    return v;
}
__device__ __forceinline__ float wave_max(float v) {
#pragma unroll
    for (int o = 1; o < 64; o <<= 1) v = fmaxf(v, __shfl_xor(v, o));
    return v;
}
template <class T> __device__ __forceinline__ T* as_global(T* p) { return (T*)(GAS T*)p; }
__device__ __forceinline__ int lane_id_fresh() { int l; asm volatile("v_mbcnt_lo_u32_b32 %0, -1, 0\n\tv_mbcnt_hi_u32_b32 %0, -1, %0" : "=v"(l)); return l; }
#define DPPF(v, ctrl) __int_as_float(__builtin_amdgcn_update_dpp(0, __float_as_int(v), ctrl, 0xF, 0xF, true))
#define LDS_WAIT() asm volatile("s_waitcnt lgkmcnt(0)" ::: "memory")
#define VM_WAIT() asm volatile("s_waitcnt vmcnt(0)" ::: "memory")

#define XB_TMO      128
#define XB_XCNT(j)  (256  + 64 * (j))
#define XB_XSUB(j)  (1280 + 64 * (j))
#define XB_XGEN(j)  (2304 + 64 * (j))
#define XB_TOP      3328
#define XB_TOPGEN   3392
#define XCD_BAR_WORDS 3456
#define XB_SPIN_CAP (1u << 23)
__device__ __forceinline__ unsigned xb_ld(unsigned* p)              { return __hip_atomic_load(p, __ATOMIC_RELAXED, __HIP_MEMORY_SCOPE_AGENT); }
__device__ __forceinline__ unsigned xb_add(unsigned* p, unsigned v) { return __hip_atomic_fetch_add(p, v, __ATOMIC_RELAXED, __HIP_MEMORY_SCOPE_AGENT); }
__device__ __forceinline__ unsigned xb_xcc_id() { return (unsigned)__builtin_amdgcn_s_getreg((3 << 11) | 20) & 0xFu; }
#define XB_SPIN(cond, bar) do { unsigned _sp = 0; while (cond) { __builtin_amdgcn_s_sleep(1); \
    if ((++_sp & 255u) == 0u) { if (xb_ld(&(bar)[XB_TMO])) break; if (_sp > XB_SPIN_CAP) { atomicAdd(&(bar)[XB_TMO], 1u); break; } } } } while (0)
struct XcdBarrier { unsigned* bar; unsigned x; volatile LAS unsigned* st; };
__device__ __forceinline__ XcdBarrier xcd_barrier_post(unsigned* bar, volatile LAS unsigned* st) {
    XcdBarrier b; b.bar = bar; b.x = xb_xcc_id(); b.st = st;
    if (threadIdx.x == 0) (void)xb_add(&bar[XB_XCNT(b.x)], 1u);
    return b;
}
__device__ __forceinline__ void xcd_barrier_complete(unsigned* bar, unsigned x, unsigned& nloc, unsigned& nx) {
    const unsigned G = gridDim.x * gridDim.y * gridDim.z;
    unsigned sum, cnt, mine, sp = 0u;
    for (;;) {
        sum = 0u; cnt = 0u; mine = 0u;
#pragma unroll
        for (unsigned j = 0; j < 16; ++j) { const unsigned c = xb_ld(&bar[XB_XCNT(j)]); sum += c; cnt += (c > 0u) ? 1u : 0u; mine = (j == x) ? c : mine; }
        if (sum == G) break;
        __builtin_amdgcn_s_sleep(1);
        if ((++sp & 255u) == 0u) { if (xb_ld(&bar[XB_TMO])) break; if (sp > XB_SPIN_CAP) { atomicAdd(&bar[XB_TMO], 1u); break; } }
    }
    nloc = mine > 0u ? mine : 1u; nx = cnt > 0u ? cnt : 1u;
}
__device__ __forceinline__ void xcd_barrier(const XcdBarrier& b, int wave) {
    asm volatile("s_waitcnt vmcnt(0)" ::: "memory");
    __syncthreads();
    if (wave == 0 && lane_id_fresh() == 0) {
        unsigned* bar = b.bar;
        __builtin_amdgcn_s_waitcnt(0);
        unsigned nloc = b.st[0], nx = b.st[1];
        if (nloc == 0u) { xcd_barrier_complete(bar, b.x, nloc, nx); b.st[0] = nloc; b.st[1] = nx; }
        const unsigned old = xb_add(&bar[XB_XSUB(b.x)], 1u);
        const unsigned gen = old / nloc;
        if (old + 1u == (gen + 1u) * nloc) {
            __builtin_amdgcn_fence(__ATOMIC_RELEASE, "agent");
            asm volatile("s_waitcnt vmcnt(0)" ::: "memory");
            const unsigned og = xb_add(&bar[XB_TOP], 1u);
            const unsigned tg = og / nx;
            if (og + 1u == (tg + 1u) * nx) xb_add(&bar[XB_TOPGEN], 1u);
            else XB_SPIN(xb_ld(&bar[XB_TOPGEN]) == tg, bar);
            __builtin_amdgcn_fence(__ATOMIC_ACQUIRE, "agent");
            xb_add(&bar[XB_XGEN(b.x)], 1u);
            asm volatile("s_waitcnt vmcnt(0)" ::: "memory");
        } else {
            XB_SPIN(xb_ld(&bar[XB_XGEN(b.x)]) == gen, bar);
            __builtin_amdgcn_fence(__ATOMIC_ACQUIRE, "agent");
            asm volatile("s_waitcnt vmcnt(0)" ::: "memory");
        }
    }
    __syncthreads();
}
#ifndef MIX_WGM
#define MIX_WGM 8
#endif
namespace pg8 {
#define PG8_LAS __attribute__((address_space(3)))
constexpr int BM = 256, BK = 64, HALF = 128, HTB = HALF * BK * 2, STAGE_BYTES = 8 * HTB, NXCD = 8, WGM = 8;
__host__ __device__ __forceinline__ int lds_byte(int r, int c) { const int st = (r >> 4) * 2 + (c >> 5), rr = r & 15, cc = c & 31, ob = rr * 64 + cc * 2; return st * 1024 + (ob ^ (((ob >> 9) & 1) << 5)); }
__host__ __device__ __forceinline__ void stage_rc(int b, int& R, int& C) { const int st = b / 1024, sb = b % 1024, swz = sb ^ (((sb >> 9) & 1) << 5); R = (st >> 1) * 16 + swz / 64; C = (st & 1) * 32 + (swz % 64) / 2; }
__host__ __device__ __forceinline__ int perm32(int rho) { const int n = rho >> 4, i = rho & 15; return 8 * (i >> 2) + 4 * n + (i & 3); }

struct Unit { int pm, pn, nh; };
struct Gemm { const bf16_t* A; const bf16_t* Bt; int M, N, K, lda, ldb; };

struct StaticOrder {
    int nM, nN, nwg, G, c, wgm = WGM;
    __host__ __device__ void init(int M, int N, int G_, int c_, int wgm_ = WGM) { nM = M / BM; nN = N / BM; nwg = nM * nN; G = G_; c = c_; wgm = wgm_; }
    __host__ __device__ bool next(int i, Unit& u) const {
        const long L = (long)i * G + c; if (L >= nwg) return false;
        int wgid = (int)L; { const int q = nwg / NXCD, r = nwg % NXCD, xcd = wgid % NXCD, off = wgid / NXCD; wgid = (xcd < r ? xcd * (q + 1) : r * (q + 1) + (xcd - r) * q) + off; }
        const int nig = wgm * nN, gid = wgid / nig, fm = gid * wgm, gsz = (nM - fm) < wgm ? (nM - fm) : wgm;
        u.pm = 2 * (fm + ((wgid % nig) % gsz)); u.pn = (wgid % nig) / gsz; u.nh = 2; return true;
    }
    __device__ __forceinline__ void a_ready(const Unit&) const {}
    __device__ __forceinline__ void done(const Unit&) const {}
};

struct MixOrder {
    StaticOrder lat; int nhalf;
    __host__ __device__ void init(int mrows, int G_, int c_) { lat.init(MLAT, 2048, G_, c_, MIX_WGM); nhalf = ((mrows - MLAT) / HALF) * 8; }
    __host__ __device__ bool next(int i, Unit& u) const {
        if (lat.next(i, u)) return true;
        const long h = (long)i * lat.G + lat.c - lat.nwg; if (h < 0 || h >= nhalf) return false;
        u.pm = MLAT / HALF + (int)(h >> 3); u.pn = (int)(h & 7); u.nh = 1; return true;
    }
    __device__ __forceinline__ void a_ready(const Unit&) const {}
    __device__ __forceinline__ void done(const Unit&) const {}
};

struct EpiBf16 {
    static constexpr bool PERM = true, AFTER_DRAIN = false;
    bf16_t* O; int ldc;
    __device__ __forceinline__ void operator()(const f32x4 (&acc)[2][2][4][2], const Unit& u, int wr, int wc, int fr, int fq) const {
        const int row0 = u.pm * HALF + wr * 64 + fr, col0 = u.pn * BM + wc * 32 + 8 * fq;
#pragma unroll
        for (int ai = 0; ai < 2; ++ai) if (ai < u.nh)
#pragma unroll
            for (int m = 0; m < 4; ++m) { bf16_t* rowp = O + (size_t)(row0 + ai * HALF + m * 16) * ldc + col0;
#pragma unroll
                for (int bj = 0; bj < 2; ++bj) { const f32x4 v0 = acc[ai][bj][m][0], v1 = acc[ai][bj][m][1];
                    u32x4 w; w.x = cvt_pk_bf16(v0[0], v0[1]); w.y = cvt_pk_bf16(v0[2], v0[3]); w.z = cvt_pk_bf16(v1[0], v1[1]); w.w = cvt_pk_bf16(v1[2], v1[3]);
                    *(u32x4*)(rowp + bj * HALF) = w; } }
    }
};
struct EpiI8 {
    static constexpr bool PERM = true, AFTER_DRAIN = false;
    bf16_t* O; int ldc; const float* rstep; const float* cstep;
    __device__ __forceinline__ void operator()(const f32x4 (&acc)[2][2][4][2], const Unit& u, int wr, int wc, int fr, int fq) const {
        const int row0 = u.pm * HALF + wr * 64 + fr, col0 = u.pn * BM + wc * 32 + 8 * fq;
        f32x4 cs[2][2];
#pragma unroll
        for (int bj = 0; bj < 2; ++bj) { cs[bj][0] = *(const f32x4*)(cstep + col0 + bj * HALF); cs[bj][1] = *(const f32x4*)(cstep + col0 + bj * HALF + 4); }
#pragma unroll
        for (int ai = 0; ai < 2; ++ai) if (ai < u.nh)
#pragma unroll
            for (int m = 0; m < 4; ++m) { const int r = row0 + ai * HALF + m * 16; bf16_t* rowp = O + (size_t)r * ldc + col0; const float rs = rstep[r];
#pragma unroll
                for (int bj = 0; bj < 2; ++bj) {
                    const f32x4 v0 = __builtin_convertvector(__builtin_bit_cast(i32x4, acc[ai][bj][m][0]), f32x4) * (cs[bj][0] * rs), v1 = __builtin_convertvector(__builtin_bit_cast(i32x4, acc[ai][bj][m][1]), f32x4) * (cs[bj][1] * rs);
                    u32x4 w; w.x = cvt_pk_bf16(v0[0], v0[1]); w.y = cvt_pk_bf16(v0[2], v0[3]); w.z = cvt_pk_bf16(v1[0], v1[1]); w.w = cvt_pk_bf16(v1[2], v1[3]);
                    *(u32x4*)(rowp + bj * HALF) = w; } }
    }
};
struct EpiF32 {
    static constexpr bool PERM = false, AFTER_DRAIN = false;
    float* C; int ldc;
    __device__ __forceinline__ void operator()(const f32x4 (&acc)[2][2][4][2], const Unit& u, int wr, int wc, int fr, int fq) const {
        const int row0 = u.pm * HALF + wr * 64 + fr, col0 = u.pn * BM + wc * 32 + 4 * fq;
#pragma unroll
        for (int ai = 0; ai < 2; ++ai) if (ai < u.nh)
#pragma unroll
            for (int m = 0; m < 4; ++m) { float* rowp = C + (size_t)(row0 + ai * HALF + m * 16) * ldc + col0;
#pragma unroll
                for (int bj = 0; bj < 2; ++bj)
#pragma unroll
                    for (int n = 0; n < 2; ++n) *(f32x4*)(rowp + bj * HALF + n * 16) = acc[ai][bj][m][n]; }
    }
};
template <int MODE> struct EpiMerge {
    static constexpr bool PERM = true, AFTER_DRAIN = false;
    const bf16_t* Gt; int ldg; bf16_t* Y; bf16_t* YB;
    __device__ __forceinline__ void operator()(const f32x4 (&acc)[2][2][4][2], const Unit& u, int wr, int wc, int fr, int fq) const {
        const int row0 = u.pm * HALF + wr * 64 + fr, col0 = u.pn * BM + wc * 32 + 8 * fq;
#pragma unroll
        for (int ai = 0; ai < 2; ++ai) if (ai < u.nh)
#pragma unroll
            for (int m = 0; m < 4; ++m) { const size_t r = (size_t)(row0 + ai * HALF + m * 16);
#pragma unroll
                for (int bj = 0; bj < 2; ++bj) { const int c = col0 + bj * HALF;
                    const u32x4 gw = *(const u32x4*)(Gt + r * ldg + c);
                    f32x4 g0, g1;
                    g0[0] = sigmoidf_(bf_lo(gw.x)); g0[1] = sigmoidf_(bf_hi(gw.x)); g0[2] = sigmoidf_(bf_lo(gw.y)); g0[3] = sigmoidf_(bf_hi(gw.y));
                    g1[0] = sigmoidf_(bf_lo(gw.z)); g1[1] = sigmoidf_(bf_hi(gw.z)); g1[2] = sigmoidf_(bf_lo(gw.w)); g1[3] = sigmoidf_(bf_hi(gw.w));
                    f32x4 y0 = g0 * acc[ai][bj][m][0], y1 = g1 * acc[ai][bj][m][1];
                    if (MODE != 0) { const u32x4 yw = *(const u32x4*)(Y + r * 2048 + c);
                        y0 += (f32x4){bf_lo(yw.x), bf_hi(yw.x), bf_lo(yw.y), bf_hi(yw.y)}; y1 += (f32x4){bf_lo(yw.z), bf_hi(yw.z), bf_lo(yw.w), bf_hi(yw.w)}; }
                    u32x4 w; w.x = cvt_pk_bf16(y0[0], y0[1]); w.y = cvt_pk_bf16(y0[2], y0[3]); w.z = cvt_pk_bf16(y1[0], y1[1]); w.w = cvt_pk_bf16(y1[2], y1[3]);
                    *(u32x4*)((MODE != 2 ? Y : YB) + r * 2048 + c) = w; } }
    }
};
struct EpiResid {
    static constexpr bool PERM = true, AFTER_DRAIN = false;
    float* xlat; float* xctx; const float* gate;
    const float* slat; const float* sctx;
    __device__ __forceinline__ void operator()(const f32x4 (&acc)[2][2][4][2], const Unit& u, int wr, int wc, int fr, int fq) const {
        const int vec = u.pm < 64 ? 0 : (u.pm < 128 ? 1 : 2);
        float* xb = u.pm < 128 ? xlat + (size_t)u.pm * HALF * 2048 : xctx + (size_t)(u.pm - 128) * HALF * 2048;
        const float* sb = u.pm < 128 ? slat + (size_t)u.pm * HALF * 2048 : sctx + (size_t)(u.pm - 128) * HALF * 2048;
        const int lrow0 = wr * 64 + fr, col0 = u.pn * BM + wc * 32 + 8 * fq;
        const float* gp = gate + (size_t)vec * 12288 + col0;
#pragma unroll
        for (int bj = 0; bj < 2; ++bj) { const f32x4 g0 = *(const f32x4*)(gp + bj * HALF), g1 = *(const f32x4*)(gp + bj * HALF + 4);
#pragma unroll
            for (int ai = 0; ai < 2; ++ai) if (ai < u.nh)
#pragma unroll
                for (int m = 0; m < 4; ++m) { const size_t off = (size_t)(lrow0 + ai * HALF + m * 16) * 2048 + col0 + bj * HALF; float* xp = xb + off; const float* sp = sb + off;
                    const f32x4 x0 = *(const f32x4*)sp + g0 * acc[ai][bj][m][0], x1 = *(const f32x4*)(sp + 4) + g1 * acc[ai][bj][m][1];
                    *(f32x4*)xp = x0; *(f32x4*)(xp + 4) = x1; } }
    }
};

template <class Epi, class Sched, bool ALIGN_EPI = false, bool SP2 = false, bool HALFU = false, bool I8 = false>
__device__ __forceinline__ void gemm_phase(PG8_LAS unsigned char* lds, const Gemm g, const Sched& S, const Epi& E, int wave_) {
    int tid_ = wave_ * 64 + lane_id_fresh();
    const int tid = tid_, wid = __builtin_amdgcn_readfirstlane(tid >> 6), lane = tid & 63, wr = wid >> 2, wc = wid & 3, fr = lane & 15, fq = lane >> 4;
    constexpr int ES = I8 ? 1 : 2;
    const int K = g.K, nt = K * ES / (BK * 2);
    unsigned voffA[2], voffB[2];
#pragma unroll
    for (int i = 0; i < 2; ++i) { int R, C; stage_rc(tid * 16 + i * 8192, R, C); const int Rb = Epi::PERM ? ((R & ~31) + perm32(R & 31)) : R;
        voffA[i] = (unsigned)(R * g.lda * ES + C * 2); voffB[i] = (unsigned)(Rb * g.ldb * ES + C * 2); }
    const size_t kstep = (size_t)(BK * 2);
    const size_t hstepA = (size_t)HALF * g.lda * ES, hstepB = (size_t)HALF * g.ldb * ES;
    const size_t tstepB = 2 * hstepB;
    const unsigned ldsw = (unsigned)wid * 1024u;
    const int aoff = lds_byte(wr * 64 + fr, fq * 8), boff = lds_byte(wc * 32 + fr, fq * 8);
#define PG8_SA(b, h) (((b) * 2 + (h)) * HTB)
#define PG8_SB(b, h) ((4 + (b) * 2 + (h)) * HTB)
#define PG8_STAGE(bufoff, gbase, voff) do { _Pragma("unroll") for (int _i = 0; _i < 2; ++_i) \
        __builtin_amdgcn_global_load_lds((const unsigned*)((const char*)(gbase) + (voff)[_i]), (PG8_LAS unsigned*)(lds + (bufoff) + ldsw + _i * 8192), 16, 0, 0); } while (0)
#define PG8_LDA(dst, b, h) do { _Pragma("unroll") for (int m = 0; m < 4; ++m) _Pragma("unroll") for (int k = 0; k < 2; ++k) dst[m][k] = *(const PG8_LAS bf16x8*)(lds + PG8_SA(b, h) + aoff + m * 2048 + k * 1024); } while (0)
#define PG8_LDB(dst, b, h) do { _Pragma("unroll") for (int n = 0; n < 2; ++n) _Pragma("unroll") for (int k = 0; k < 2; ++k) dst[n][k] = *(const PG8_LAS bf16x8*)(lds + PG8_SB(b, h) + boff + n * 2048 + k * 1024); } while (0)
#define PG8_MMA(ai, bj, At, Bt) do { __builtin_amdgcn_s_setprio(1); _Pragma("unroll") for (int m = 0; m < 4; ++m) _Pragma("unroll") for (int n = 0; n < 2; ++n) _Pragma("unroll") for (int k = 0; k < 2; ++k) \
        { if constexpr (I8) acc[ai][bj][m][n] = __builtin_bit_cast(f32x4, __builtin_amdgcn_mfma_i32_16x16x64_i8(__builtin_bit_cast(i32x4, Bt[n][k]), __builtin_bit_cast(i32x4, At[m][k]), __builtin_bit_cast(i32x4, acc[ai][bj][m][n]), 0, 0, 0)); \
          else acc[ai][bj][m][n] = __builtin_amdgcn_mfma_f32_16x16x32_bf16(Bt[n][k], At[m][k], acc[ai][bj][m][n], 0, 0, 0); } __builtin_amdgcn_s_setprio(0); } while (0)
#define PG8_WAIT_V(n) asm volatile("s_waitcnt vmcnt(" #n ")" ::: "memory")
#define PG8_WAIT_L(n) asm volatile("s_waitcnt lgkmcnt(" #n ")" ::: "memory")
#define PG8_BAR __builtin_amdgcn_s_barrier()
#define PG8_SCHED __builtin_amdgcn_sched_barrier(0)
    Unit cur, nxt; int ui = 0;
    if (!S.next(0, cur)) return;
    f32x4 acc[2][2][4][2];
#pragma unroll
    for (int a = 0; a < 2; ++a)
#pragma unroll
        for (int b = 0; b < 2; ++b)
#pragma unroll
            for (int m = 0; m < 4; ++m)
#pragma unroll
                for (int n = 0; n < 2; ++n) acc[a][b][m][n] = (f32x4){0.f, 0.f, 0.f, 0.f};
    bf16x8 At[4][2], B0[2][2], B1[2][2];
    const char* cA = (const char*)g.A + (size_t)cur.pm * hstepA; const char* cB = (const char*)g.Bt + (size_t)cur.pn * tstepB;
    size_t chA = (!HALFU || cur.nh == 2) ? hstepA : 0;
    S.a_ready(cur);
    if constexpr (SP2) {
        PG8_STAGE(PG8_SB(0, 0), cB, voffB); PG8_STAGE(PG8_SB(0, 1), cB + hstepB, voffB); PG8_STAGE(PG8_SA(0, 0), cA, voffA); PG8_STAGE(PG8_SA(0, 1), cA + chA, voffA);
        if (wr == 1) PG8_BAR;
        PG8_WAIT_V(2); PG8_BAR;
        PG8_STAGE(PG8_SB(1, 0), cB + kstep, voffB); PG8_STAGE(PG8_SA(1, 0), cA + kstep, voffA); PG8_STAGE(PG8_SB(1, 1), cB + hstepB + kstep, voffB);
        PG8_WAIT_V(6); PG8_BAR;
    } else {
        PG8_STAGE(PG8_SB(0, 0), cB, voffB); PG8_STAGE(PG8_SA(0, 0), cA, voffA); PG8_STAGE(PG8_SB(0, 1), cB + hstepB, voffB); PG8_STAGE(PG8_SA(0, 1), cA + chA, voffA);
        if (wr == 1) PG8_BAR;
        PG8_WAIT_V(4); PG8_BAR;
        PG8_STAGE(PG8_SB(1, 0), cB + kstep, voffB); PG8_STAGE(PG8_SA(1, 0), cA + kstep, voffA); PG8_STAGE(PG8_SB(1, 1), cB + hstepB + kstep, voffB);
        PG8_WAIT_V(6); PG8_BAR;
    }
    for (;;) {
        const bool has_next = S.next(ui + 1, nxt);
        const char* nA = has_next ? (const char*)g.A + (size_t)nxt.pm * hstepA : cA; const size_t nhA = has_next ? ((!HALFU || nxt.nh == 2) ? hstepA : 0) : chA; const bool full = (!HALFU || cur.nh == 2);
        const char* nA_ = nA; (void)nA_; const char* nB = has_next ? (const char*)g.Bt + (size_t)nxt.pn * tstepB : cB;
        for (int t = 0; t < nt; t += 2) {
            const bool last = (t == nt - 2);
            const char* a1 = cA + (size_t)(t + 1) * kstep;
            const char* a2 = last ? nA : cA + (size_t)(t + 2) * kstep; const char* b2 = last ? nB : cB + (size_t)(t + 2) * kstep;
            const char* a3 = a2 + kstep; const char* b3 = b2 + kstep;
            const size_t h2A = last ? nhA : chA;
            if (last && has_next) S.a_ready(nxt);
            if constexpr (SP2) {
            PG8_LDB(B0, 0, 0); PG8_LDB(B1, 0, 1); PG8_SCHED; PG8_LDA(At, 0, 0); PG8_STAGE(PG8_SA(1, 1), a1 + chA, voffA);
            PG8_WAIT_V(8); PG8_WAIT_L(0); PG8_BAR; PG8_MMA(0, 0, At, B0); PG8_MMA(0, 1, At, B1); PG8_BAR; PG8_SCHED;
            PG8_LDA(At, 0, 1); PG8_STAGE(PG8_SB(0, 0), b2, voffB); PG8_STAGE(PG8_SB(0, 1), b2 + hstepB, voffB); PG8_STAGE(PG8_SA(0, 0), a2, voffA);
            PG8_WAIT_V(8); PG8_WAIT_L(0); PG8_BAR; if (full) { PG8_MMA(1, 0, At, B0); PG8_MMA(1, 1, At, B1); } PG8_BAR; PG8_SCHED;
            PG8_LDB(B0, 1, 0); PG8_LDB(B1, 1, 1); PG8_SCHED; PG8_LDA(At, 1, 0); PG8_STAGE(PG8_SA(0, 1), a2 + h2A, voffA);
            PG8_WAIT_V(8); PG8_WAIT_L(0); PG8_BAR; PG8_MMA(0, 0, At, B0); PG8_MMA(0, 1, At, B1); PG8_BAR; PG8_SCHED;
            PG8_LDA(At, 1, 1); PG8_STAGE(PG8_SB(1, 0), b3, voffB); PG8_STAGE(PG8_SB(1, 1), b3 + hstepB, voffB); PG8_STAGE(PG8_SA(1, 0), a3, voffA);
            PG8_WAIT_V(8); PG8_WAIT_L(0); PG8_BAR; if (full) { PG8_MMA(1, 0, At, B0); PG8_MMA(1, 1, At, B1); } PG8_BAR; PG8_SCHED;
            } else {
            PG8_LDB(B0, 0, 0); PG8_SCHED; PG8_LDA(At, 0, 0); PG8_STAGE(PG8_SA(1, 1), a1 + chA, voffA);
            PG8_WAIT_L(8); PG8_BAR; PG8_WAIT_L(0); PG8_MMA(0, 0, At, B0); PG8_BAR; PG8_SCHED;
            PG8_LDB(B1, 0, 1); PG8_STAGE(PG8_SB(0, 0), b2, voffB);
            PG8_BAR; PG8_WAIT_L(0); PG8_MMA(0, 1, At, B1); PG8_BAR;
            PG8_LDA(At, 0, 1); PG8_STAGE(PG8_SA(0, 0), a2, voffA);
            PG8_BAR; PG8_WAIT_L(0); if (full) PG8_MMA(1, 0, At, B0); PG8_BAR; PG8_SCHED;
            PG8_STAGE(PG8_SB(0, 1), b2 + hstepB, voffB);
            PG8_WAIT_V(6); PG8_BAR; if (full) PG8_MMA(1, 1, At, B1); PG8_BAR;
            PG8_LDB(B0, 1, 0); PG8_SCHED; PG8_LDA(At, 1, 0); PG8_STAGE(PG8_SA(0, 1), a2 + h2A, voffA);
            PG8_WAIT_L(8); PG8_BAR; PG8_WAIT_L(0); PG8_MMA(0, 0, At, B0); PG8_BAR; PG8_SCHED;
            PG8_LDB(B1, 1, 1); PG8_STAGE(PG8_SB(1, 0), b3, voffB);
            PG8_BAR; PG8_WAIT_L(0); PG8_MMA(0, 1, At, B1); PG8_BAR;
            PG8_LDA(At, 1, 1); PG8_STAGE(PG8_SA(1, 0), a3, voffA);
            PG8_BAR; PG8_WAIT_L(0); if (full) PG8_MMA(1, 0, At, B0); PG8_BAR; PG8_SCHED;
            PG8_STAGE(PG8_SB(1, 1), b3 + hstepB, voffB);
            PG8_WAIT_V(6); PG8_BAR; if (full) PG8_MMA(1, 1, At, B1); PG8_BAR;
            }
        }
        if constexpr (ALIGN_EPI) { if (wr == 0) PG8_BAR; }
        if constexpr (!Epi::AFTER_DRAIN) { E(acc, cur, wr, wc, fr, fq); S.done(cur); }
        if (!has_next) break;
#pragma unroll
        for (int a = 0; a < 2; ++a)
#pragma unroll
            for (int b = 0; b < 2; ++b)
#pragma unroll
                for (int m = 0; m < 4; ++m)
#pragma unroll
                    for (int n = 0; n < 2; ++n) acc[a][b][m][n] = (f32x4){0.f, 0.f, 0.f, 0.f};
        cur = nxt; cA = nA; cB = nB; chA = nhA; ++ui;
        if constexpr (ALIGN_EPI) { if (wr == 1) PG8_BAR; }
    }
    PG8_WAIT_V(0);
    if constexpr (!ALIGN_EPI) { if (wr == 0) PG8_BAR; }
    PG8_BAR;
#undef PG8_SA
#undef PG8_SB
#undef PG8_STAGE
#undef PG8_LDA
#undef PG8_LDB
#undef PG8_MMA
#undef PG8_WAIT_V
#undef PG8_WAIT_L
#undef PG8_BAR
#undef PG8_SCHED
}
}
namespace att {
constexpr int D = 128, NW = 8, QBLK = 32, KVBLK = 64;
constexpr float SCALE = 0.088388347648318440f;
constexpr float THR = 8.f;
constexpr int LDQ = NIN, LDK = 128, LDO = NIN;
constexpr size_t SHM_V = KVBLK * D * 2, SHM_K = KVBLK * D * 2, SHM_ATTN = 2 * SHM_V + 2 * SHM_K + NW * 64 * 4;
#define KSWZ(row, colB) ((row) * 256 + ((colB) ^ (((row) & 7) << 4)))
#define SBAR() __builtin_amdgcn_sched_barrier(0)
__device__ __forceinline__ int crow(int r, int hi) { return (r & 3) + 8 * (r >> 2) + 4 * hi; }
__device__ __forceinline__ unsigned cvtpk(float lo, float hi) { unsigned r; asm volatile("v_cvt_pk_bf16_f32 %0, %1, %2" : "=v"(r) : "v"(lo), "v"(hi)); return r; }
__device__ __forceinline__ bf16x8 ld8(const bf16_t* p) { return *reinterpret_cast<const bf16x8*>(p); }

__device__ __forceinline__ void partialSM(f32x16& p0, f32x16& p1, float& m_reg, float& mn, float& alpha) {
  constexpr float C = SCALE * 1.4426950408889634f;
  float pmax = p0[0];
#pragma unroll
  for (int r = 1; r < 16; ++r) pmax = fmaxf(pmax, p0[r]);
#pragma unroll
  for (int r = 0; r < 16; ++r) pmax = fmaxf(pmax, p1[r]);
  { auto rr = __builtin_amdgcn_permlane32_swap(__float_as_uint(pmax), __float_as_uint(pmax), false, false);
    pmax = fmaxf(__uint_as_float(rr[0]), __uint_as_float(rr[1])); }
  if (__builtin_expect(__all(pmax - m_reg <= THR / SCALE), 1)) { mn = m_reg; alpha = 1.f; }
  else { mn = fmaxf(m_reg, pmax); alpha = __builtin_amdgcn_exp2f((m_reg - mn) * C); m_reg = mn; }
  float mnC = -mn * C;
#pragma unroll
  for (int r = 0; r < 16; ++r) p0[r] = fmaf(p0[r], C, mnC);
#pragma unroll
  for (int r = 0; r < 16; ++r) p1[r] = fmaf(p1[r], C, mnC);
#pragma unroll
  for (int r = 0; r < 16; ++r) p0[r] = __builtin_amdgcn_exp2f(p0[r]);
}
__device__ __forceinline__ void finishSM(f32x16& p0, f32x16& p1, float alpha, float& l_reg, bf16x8& pa0, bf16x8& pa1, bf16x8& pa2, bf16x8& pa3) {
#pragma unroll
  for (int r = 0; r < 16; ++r) p1[r] = __builtin_amdgcn_exp2f(p1[r]);
  float ps = 0;
#pragma unroll
  for (int r = 0; r < 16; ++r) ps += p0[r];
#pragma unroll
  for (int r = 0; r < 16; ++r) ps += p1[r];
  { auto rr = __builtin_amdgcn_permlane32_swap(__float_as_uint(ps), __float_as_uint(ps), false, false);
    ps = __uint_as_float(rr[0]) + __uint_as_float(rr[1]); }
  l_reg = l_reg * alpha + ps;
#define PK4(P, BASE, OUT) do { unsigned a0 = cvtpk(P[BASE + 0], P[BASE + 1]), a1 = cvtpk(P[BASE + 2], P[BASE + 3]);   \
    unsigned b0 = cvtpk(P[BASE + 4], P[BASE + 5]), b1 = cvtpk(P[BASE + 6], P[BASE + 7]);                              \
    auto r0 = __builtin_amdgcn_permlane32_swap(a0, b0, false, false); auto r1 = __builtin_amdgcn_permlane32_swap(a1, b1, false, false); \
    u32x4 w = {r0[0], r1[0], r0[1], r1[1]}; OUT = *reinterpret_cast<bf16x8*>(&w); } while (0)
  PK4(p0, 0, pa0); PK4(p0, 8, pa1); PK4(p1, 0, pa2); PK4(p1, 8, pa3);
#undef PK4
}
__device__ __forceinline__ void qkt(f32x16& p0, f32x16& p1, const bf16_t* Ks, const bf16x8* qr, int r32, int hi) {
  p0 = f32x16{}; p1 = f32x16{};
#pragma unroll
  for (int d0 = 0; d0 < 8; ++d0) { int cb = (d0 * 16 + hi * 8) * 2;
    bf16x8 b0 = *reinterpret_cast<const bf16x8*>((const char*)Ks + KSWZ(r32, cb));
    bf16x8 b1 = *reinterpret_cast<const bf16x8*>((const char*)Ks + KSWZ(32 + r32, cb));
    p0 = __builtin_amdgcn_mfma_f32_32x32x16_bf16(b0, qr[d0], p0, 0, 0, 0);
    p1 = __builtin_amdgcn_mfma_f32_32x32x16_bf16(b1, qr[d0], p1, 0, 0, 0); }
}
__device__ __forceinline__ int v_st(int k, int c) { const int kk = (k & ~0xC) | ((k & 4) << 1) | ((k & 8) >> 1); return ((kk >> 3) * 4 + (c >> 5)) * 512 + ((kk & 7) * 32 + (c & 31)) * 2; }
__device__ __forceinline__ int v_rd_base(int lane) { return ((lane & 3) << 3) | (((lane >> 2) & 3) << 6) | (((lane >> 4) & 1) << 5) | (((lane >> 5) & 1) << 8); }
constexpr int v_rd_off(int d0, int ks, int half) { return d0 * 512 + ks * 4096 + half * 2048; }
template <int OFF> __device__ __forceinline__ s16x4 tr_read(int vb) {
  s16x4 r; asm volatile("ds_read_b64_tr_b16 %0, %1 offset:%2" : "=&v"(r) : "v"(vb), "i"(OFF) : "memory"); return r;
}
template <int D0> __device__ __forceinline__ void pv_one(f32x16& od, int vb, bf16x8 pa0, bf16x8 pa1, bf16x8 pa2, bf16x8 pa3) {
  const s16x4 l0 = tr_read<v_rd_off(D0, 0, 0)>(vb), h0 = tr_read<v_rd_off(D0, 0, 1)>(vb), l1 = tr_read<v_rd_off(D0, 1, 0)>(vb), h1 = tr_read<v_rd_off(D0, 1, 1)>(vb);
  const s16x4 l2 = tr_read<v_rd_off(D0, 2, 0)>(vb), h2 = tr_read<v_rd_off(D0, 2, 1)>(vb), l3 = tr_read<v_rd_off(D0, 3, 0)>(vb), h3 = tr_read<v_rd_off(D0, 3, 1)>(vb);
  asm volatile("s_waitcnt lgkmcnt(0)" ::: "memory"); SBAR();
#define PK(L, H) (bf16x8){L[0], L[1], L[2], L[3], H[0], H[1], H[2], H[3]}
  od = __builtin_amdgcn_mfma_f32_32x32x16_bf16(pa0, PK(l0, h0), od, 0, 0, 0);
  od = __builtin_amdgcn_mfma_f32_32x32x16_bf16(pa1, PK(l1, h1), od, 0, 0, 0);
  od = __builtin_amdgcn_mfma_f32_32x32x16_bf16(pa2, PK(l2, h2), od, 0, 0, 0);
  od = __builtin_amdgcn_mfma_f32_32x32x16_bf16(pa3, PK(l3, h3), od, 0, 0, 0);
#undef PK
}
__device__ __forceinline__ void pv_d0(f32x16* o, int vb, bf16x8 pa0, bf16x8 pa1, bf16x8 pa2, bf16x8 pa3) {
  pv_one<0>(o[0], vb, pa0, pa1, pa2, pa3); pv_one<1>(o[1], vb, pa0, pa1, pa2, pa3); pv_one<2>(o[2], vb, pa0, pa1, pa2, pa3); pv_one<3>(o[3], vb, pa0, pa1, pa2, pa3);
}

__device__ __forceinline__ void attn_dense_body(const bf16_t* __restrict__ Qb, const bf16_t* __restrict__ Kh, const bf16_t* __restrict__ Vh,
                                                bf16_t* Ob, int seq, char* lds, int wave_) {
  constexpr int SDEPTH = 2;
  int tid_ = wave_ * 64 + lane_id_fresh();
  const int tid = tid_, wid = tid >> 6, lane = tid & 63, r32 = lane & 31, hi = lane >> 5;
  bf16_t* V_lds = (bf16_t*)lds; bf16_t* K_lds = (bf16_t*)(lds + 2 * SHM_V);
  float* ws = (float*)(lds + 2 * SHM_V + 2 * SHM_K) + wid * 64; float* li_l = ws; float* al_l = ws + 32;
  float m_reg = -1e30f, l_reg = 0; f32x16 o[4] = {}; bf16x8 qr[8];
  const bf16_t* Qw = Qb + (long)(wid * QBLK + r32) * LDQ + hi * 8;
#pragma unroll
  for (int d0 = 0; d0 < 8; ++d0) qr[d0] = ld8(Qw + d0 * 16);
  const int sr = tid >> 4, sc = (tid & 15) * 8, vst0 = v_st(sr, sc), vst1 = v_st(32 + sr, sc);
  const int vb0 = (int)(uintptr_t)V_lds + v_rd_base(lane);
  struct { bf16x8 vs0, vs1, ks0, ks1; } sr_[SDEPTH];
#define SLOAD(i, k0) do { sr_[i].vs0 = ld8(&Vh[(long)((k0) + sr) * LDK + sc]); sr_[i].vs1 = ld8(&Vh[(long)((k0) + 32 + sr) * LDK + sc]); \
    sr_[i].ks0 = ld8(&Kh[(long)((k0) + sr) * LDK + sc]); sr_[i].ks1 = ld8(&Kh[(long)((k0) + 32 + sr) * LDK + sc]); } while (0)
#define SWRITE(b, i) do { *(bf16x8*)((char*)V_lds + (b) * SHM_V + vst0) = sr_[i].vs0;          \
    *(bf16x8*)((char*)V_lds + (b) * SHM_V + vst1) = sr_[i].vs1; int kc = sc * 2;               \
    *(bf16x8*)((char*)K_lds + (b) * SHM_K + KSWZ(sr, kc)) = sr_[i].ks0;                       \
    *(bf16x8*)((char*)K_lds + (b) * SHM_K + KSWZ(32 + sr, kc)) = sr_[i].ks1; } while (0)
#define SWAIT() asm volatile("s_waitcnt vmcnt(4)" ::: "memory")
#define RESC(a) do { if (__any((a) < 1.f)) { if (hi == 0) al_l[r32] = (a); asm volatile("s_waitcnt lgkmcnt(0)" ::: "memory"); \
    _Pragma("unroll") for (int d = 0; d < 4; ++d) _Pragma("unroll") for (int r = 0; r < 16; ++r) o[d][r] *= al_l[crow(r, hi)]; } } while (0)
  f32x16 pA0, pA1, pB0, pB1; float mnA, mnB, alA, alB; bf16x8 pa0, pa1, pa2, pa3; const int NT = seq / KVBLK;
  constexpr int SE = 0, SO = SDEPTH - 1;
  SLOAD(SE, 0); asm volatile("s_waitcnt vmcnt(0)" ::: "memory"); SWRITE(0, SE); __syncthreads();
  qkt(pA0, pA1, K_lds, qr, r32, hi); partialSM(pA0, pA1, m_reg, mnA, alA);
  SLOAD(SO, KVBLK); if (2 < NT) SLOAD(SE, 2 * KVBLK);
  SWAIT(); SWRITE(1, SO); __syncthreads();
  for (int j = 1; j + 1 < NT; j += 2) {
    SBAR(); qkt(pB0, pB1, (bf16_t*)((char*)K_lds + SHM_K), qr, r32, hi);
    finishSM(pA0, pA1, alA, l_reg, pa0, pa1, pa2, pa3); SBAR();
    SLOAD(SO, (j + SDEPTH) * KVBLK); SBAR();
    pv_d0(o, vb0, pa0, pa1, pa2, pa3); partialSM(pB0, pB1, m_reg, mnB, alB);
    __syncthreads(); SWAIT(); SWRITE(0, SE);
    RESC(alB); __syncthreads();
    SBAR(); qkt(pA0, pA1, K_lds, qr, r32, hi);
    finishSM(pB0, pB1, alB, l_reg, pa0, pa1, pa2, pa3); SBAR();
    if (j + 3 < NT) SLOAD(SE, (j + 1 + SDEPTH) * KVBLK); SBAR();
    pv_d0(o, vb0 + (int)SHM_V, pa0, pa1, pa2, pa3); partialSM(pA0, pA1, m_reg, mnA, alA);
    __syncthreads(); SWAIT(); SWRITE(1, SO);
    RESC(alA); __syncthreads();
  }
  SBAR(); qkt(pB0, pB1, (bf16_t*)((char*)K_lds + SHM_K), qr, r32, hi);
  finishSM(pA0, pA1, alA, l_reg, pa0, pa1, pa2, pa3); SBAR();
  pv_d0(o, vb0, pa0, pa1, pa2, pa3); partialSM(pB0, pB1, m_reg, mnB, alB);
  __syncthreads(); RESC(alB);
  finishSM(pB0, pB1, alB, l_reg, pa0, pa1, pa2, pa3); SBAR();
  pv_d0(o, vb0 + (int)SHM_V, pa0, pa1, pa2, pa3);
  if (hi == 0) li_l[r32] = l_reg; asm volatile("s_waitcnt lgkmcnt(0)" ::: "memory");
  float rli[16];
#pragma unroll
  for (int r = 0; r < 16; ++r) rli[r] = __builtin_amdgcn_rcpf(li_l[crow(r, hi)]);
  bf16_t* Ow = Ob + (long)(wid * QBLK) * LDO;
#pragma unroll
  for (int r = 0; r < 16; ++r) { int orow = crow(r, hi);
#pragma unroll
    for (int d0 = 0; d0 < 4; ++d0) Ow[(long)orow * LDO + d0 * 32 + r32] = f2bf(o[d0][r] * rli[r]); }
  __syncthreads();
#undef SLOAD
#undef SWRITE
#undef SWAIT
#undef RESC
}
#undef KSWZ
#undef SBAR
}
#define CAS __attribute__((address_space(4)))
#define INP(i) ((const float*)(GAS const float*)in[i])
struct Ctx {
    float* out; unsigned char* ws;
    LAS unsigned char* lds; int tid, lane, wave, wg, G;
};
enum { I_X = 0, I_C, I_CTX, I_CCTX, I_WMOD, I_BMOD, I_NMIX, I_NFFN, I_WIN, I_QN, I_KN, I_LCW, I_LCB, I_LWA, I_LBA, I_LWX, I_LBX, I_LLAM, I_SCW, I_SCB,
       I_WOA, I_WOL, I_WOS, I_WOUT, I_PWQ, I_PK1, I_PK2, I_PU, I_PV };

__device__ __forceinline__ float* xrow_ptr(const Ctx& c, int r) {
    return r < MLAT ? c.out + (size_t)r * DM : (float*)(c.ws + WS_CTXS) + (size_t)(r - MLAT) * DM;
}

template <bool I8 = false>
__device__ __forceinline__ void transpose_item(const float* W, int K, int N, bf16_t* WT, LAS float* scr, int item, int lane, const float* cmax = nullptr, float* wdq = nullptr, LAS float* scol = nullptr) {
    const int nblk = N / 64, kb = item / nblk, nb = item % nblk, k0 = 64 * kb, n0 = 64 * nb;
    if constexpr (I8) { float mx = 0.f;
#pragma unroll 8
        for (int kc = 0; kc < 32; ++kc) mx = fmaxf(mx, cmax[(size_t)kc * N + n0 + lane]);
        scol[lane] = mx > 0.f ? 127.f / mx : 0.f;
        if (kb == 0) wdq[n0 + lane] = mx * (1.f / 127.f); }
    const float* src = W + (size_t)(k0 + (lane >> 4)) * N + n0 + (lane & 15) * 4;
    f32x4 v[16];
#pragma unroll
    for (int i = 0; i < 16; ++i) v[i] = *(const f32x4*)(src + (size_t)(4 * i) * N);
    LAS float* d = scr + (lane >> 4) * 65 + (lane & 15) * 4;
#pragma unroll
    for (int i = 0; i < 16; ++i) { d[(4 * i) * 65 + 0] = v[i][0]; d[(4 * i) * 65 + 1] = v[i][1]; d[(4 * i) * 65 + 2] = v[i][2]; d[(4 * i) * 65 + 3] = v[i][3]; }
    LDS_WAIT(); asm volatile("" ::: "memory");
    const int c = lane & 7;
#pragma unroll
    for (int j = 0; j < 8; ++j) { const int n = (lane >> 3) + 8 * j; const LAS float* s = scr + (8 * c) * 65 + n;
        if constexpr (I8) { const float q_ = scol[n]; u32x2 o; o.x = pk4_i8(s[0 * 65] * q_, s[1 * 65] * q_, s[2 * 65] * q_, s[3 * 65] * q_); o.y = pk4_i8(s[4 * 65] * q_, s[5 * 65] * q_, s[6 * 65] * q_, s[7 * 65] * q_);
            *(u32x2*)((unsigned char*)WT + (size_t)(n0 + n) * K + k0 + 8 * c) = o; }
        else { u32x4 o; o.x = cvt_pk_bf16(s[0 * 65], s[1 * 65]); o.y = cvt_pk_bf16(s[2 * 65], s[3 * 65]); o.z = cvt_pk_bf16(s[4 * 65], s[5 * 65]); o.w = cvt_pk_bf16(s[6 * 65], s[7 * 65]);
            *(u32x4*)(WT + (size_t)(n0 + n) * K + k0 + 8 * c) = o; } }
    LDS_WAIT(); asm volatile("" ::: "memory");
}

__device__ __forceinline__ void mod_unit(const Ctx& c, CAS const unsigned long long* in, int l, int cb) {
    LAS float* sv = (LAS float*)c.lds;
    LAS float* red = sv + 3 * DM;
    { const float* cc = INP(I_C); const float* cx = INP(I_CCTX);
      for (int i = c.tid; i < 3 * DM; i += NTHREADS) { const int v = i / DM, k = i % DM; const float x = v < 2 ? cc[v * DM + k] : cx[k]; sv[i] = x * sigmoidf_(x); } }
    __syncthreads();
    const int j4 = (c.tid & 31) * 4, kg = c.tid >> 5;
    const float* w = INP(I_WMOD) + (size_t)l * DM * NMOD + (size_t)(kg * 128) * NMOD + cb * 128 + j4;
    f32x4 a0 = {0.f, 0.f, 0.f, 0.f}, a1 = a0, a2 = a0;
#pragma unroll 8
    for (int k = 0; k < 128; ++k) { const f32x4 wv = *(const f32x4*)(w + (size_t)k * NMOD); const int kk = kg * 128 + k; a0 += wv * sv[kk]; a1 += wv * sv[DM + kk]; a2 += wv * sv[2 * DM + kk]; }
    *(LAS f32x4*)(red + (kg * 3 + 0) * 128 + j4) = a0; *(LAS f32x4*)(red + (kg * 3 + 1) * 128 + j4) = a1; *(LAS f32x4*)(red + (kg * 3 + 2) * 128 + j4) = a2;
    __syncthreads();
    if (c.tid < 384) { const int v = c.tid >> 7, jj = c.tid & 127; float s = INP(I_BMOD)[l * NMOD + cb * 128 + jj];
#pragma unroll
        for (int g = 0; g < 16; ++g) s += red[(g * 3 + v) * 128 + jj];
        ((float*)(c.ws + WS_MOD))[((size_t)l * 3 + v) * NMOD + cb * 128 + jj] = s; }
    __syncthreads();
}

__device__ __forceinline__ void wsc_unit(const Ctx& c, CAS const unsigned long long* in, int l, int u) {
    const int hh = u >> 4, kb = u & 15, h = hh >> 1, half = hh & 1, k0 = kb * 128;
    LAS float* kkL = (LAS float*)c.lds;
    LAS float* wqL = kkL + 128 * 132;
    const float* ksrc = INP(half ? I_PK2 : I_PK1) + ((size_t)(l * 8 + h) * 128) * 128;
    const float* qsrc = INP(I_PWQ) + (size_t)l * DM * DM + (size_t)k0 * DM + hh * 128;
    for (int i = c.tid; i < 128 * 32; i += NTHREADS) { const int r = i >> 5, c4 = (i & 31) * 4;
        *(LAS f32x4*)(kkL + r * 132 + c4) = *(const f32x4*)(ksrc + (size_t)r * 128 + c4);
        *(LAS f32x4*)(wqL + r * 132 + c4) = *(const f32x4*)(qsrc + (size_t)r * DM + c4); }
    __syncthreads();
    const int k = c.tid & 127, ng = c.tid >> 7;
    float acc[32];
#pragma unroll
    for (int j = 0; j < 32; ++j) acc[j] = 0.f;
    for (int d4 = 0; d4 < 32; ++d4) {
        const f32x4 a = *(const LAS f32x4*)(wqL + k * 132 + d4 * 4);
#pragma unroll
        for (int j = 0; j < 32; ++j) { const f32x4 b = *(const LAS f32x4*)(kkL + (ng * 32 + j) * 132 + d4 * 4); acc[j] += (a[0] * b[0] + a[1] * b[1]) + (a[2] * b[2] + a[3] * b[3]); }
    }
    bf16_t* dst = (bf16_t*)(c.ws + ws_wsc(l)) + (size_t)(hh * 128 + ng * 32) * DM + k0 + k;
#pragma unroll
    for (int j = 0; j < 32; ++j) dst[(size_t)j * DM] = f2bf(acc[j]);
    __syncthreads();
}

#define GET_IN() unsigned long long kai_ = (unsigned long long)__builtin_amdgcn_kernarg_segment_ptr(); asm volatile("" : "+s"(kai_)); CAS const unsigned long long* in = (CAS const unsigned long long*)kai_
__device__ __forceinline__ void conv_units(const Ctx& c, int l) {
    GET_IN();
    if (l == 0) for (int u = c.wg; u < 2 * 96; u += c.G) mod_unit(c, in, u / 96, u % 96);
    for (int u = c.wg; u < 256; u += c.G) wsc_unit(c, in, l, u);
}
enum { CV_WIN = 1, CV_WO = 2, CV_WOUT = 4, CV_PU = 8, CV_PV = 16, CV_LRU = 32, CV_ALL = 63 };
__device__ __forceinline__ void conv_transposes(const Ctx& c, int l, int what = CV_ALL) {
    GET_IN();
    const int gw = c.wg * NWAVES + c.wave, NGW = c.G * NWAVES;
    LAS float* scr = (LAS float*)(c.lds + c.wave * 16640);
    constexpr int I_IN = (DM / 64) * (NIN / 64), I_SQ = (DM / 64) * (DM / 64);
    const float* win = INP(I_WIN) + (size_t)l * DM * NIN;
    if (what & CV_WIN) for (int it = gw; it < I_IN; it += NGW)
        transpose_item<true>(win, DM, NIN, (bf16_t*)(c.ws + WS_WIN), scr, it, c.lane, (const float*)(c.ws + WS_CMAX) + (size_t)l * 32 * NIN, (float*)(c.ws + WS_WDQ), (LAS float*)(c.lds + 8 * 16640 + c.wave * 256));
    for (int s = 0; s < 4; ++s) { if (!(what & (s < 3 ? CV_WO : CV_WOUT))) continue;
        const float* src = INP(s == 0 ? I_WOA : s == 1 ? I_WOL : s == 2 ? I_WOS : I_WOUT) + (size_t)l * DM * DM;
        bf16_t* dst = s < 3 ? (bf16_t*)(c.ws + WS_WO) + (size_t)s * DM * DM : (bf16_t*)(c.ws + WS_WOUT);
        for (int it = gw; it < I_SQ; it += NGW) transpose_item(src, DM, DM, dst, scr, it, c.lane);
    }
}
__device__ __forceinline__ void conv_colmax(const Ctx& c) {
    GET_IN();
    const size_t gt = (size_t)c.wg * NTHREADS + c.tid, NT = (size_t)c.G * NTHREADS;
    constexpr int C4 = NIN / 4;
    for (size_t u = gt; u < (size_t)NLAYER * 32 * C4; u += NT) { const int c4 = (int)(u % C4), lk = (int)(u / C4);
        const float* src = INP(I_WIN) + (size_t)lk * 64 * NIN + c4 * 4;
        f32x4 m = {0.f, 0.f, 0.f, 0.f};
#pragma unroll 16
        for (int k = 0; k < 64; ++k) { const f32x4 v = *(const f32x4*)(src + (size_t)k * NIN); m[0] = fmaxf(m[0], fabsf(v[0])); m[1] = fmaxf(m[1], fabsf(v[1])); m[2] = fmaxf(m[2], fabsf(v[2])); m[3] = fmaxf(m[3], fabsf(v[3])); }
        *(f32x4*)((float*)(c.ws + WS_CMAX) + (size_t)lk * NIN + c4 * 4) = m; }
}
__device__ __forceinline__ void conv_tables(const Ctx& c, int l, int what = CV_ALL) {
    GET_IN();
    const size_t gt = (size_t)c.wg * NTHREADS + c.tid, NT = (size_t)c.G * NTHREADS;
    constexpr size_t NG16 = (size_t)16384 * DM / 16;
    if (what & CV_PU) {
        const int gw = c.wg * NWAVES + c.wave, NGW = c.G * NWAVES;
        const float* srcb = INP(I_PU) + (size_t)l * 16384 * DM; unsigned char* dstb = (unsigned char*)(c.ws + ws_pu(l)); float* usc = (float*)(c.ws + WS_USC) + (size_t)l * 16384;
#pragma unroll 1
        for (int e = gw; e < 16384; e += NGW) { const float* src = srcb + (size_t)e * DM + c.lane * 16;
            f32x4 v[8]; float mx = 0.f;
#pragma unroll
            for (int i = 0; i < 8; ++i) { v[i] = *(const f32x4*)(src + (i >> 2) * 1024 + (i & 3) * 4); mx = fmaxf(fmaxf(mx, fmaxf(fabsf(v[i][0]), fabsf(v[i][1]))), fmaxf(fabsf(v[i][2]), fabsf(v[i][3]))); }
#pragma unroll
            for (int o = 32; o > 0; o >>= 1) mx = fmaxf(mx, __shfl_xor(mx, o));
            const float q_ = mx > 0.f ? 127.f / mx : 0.f;
            if (c.lane == 0) usc[e] = mx * (1.f / 127.f);
            u32x4 o0, o1;
#pragma unroll
            for (int i = 0; i < 4; ++i) { o0[i] = pk4_i8(v[i][0] * q_, v[i][1] * q_, v[i][2] * q_, v[i][3] * q_); o1[i] = pk4_i8(v[4 + i][0] * q_, v[4 + i][1] * q_, v[4 + i][2] * q_, v[4 + i][3] * q_); }
            *(u32x4*)(dstb + (size_t)e * DM + c.lane * 16) = o0; *(u32x4*)(dstb + (size_t)e * DM + 1024 + c.lane * 16) = o1; } }
#pragma unroll 1
    for (int tb = 1; tb < 2; ++tb) { if (!(what & (tb ? CV_PV : CV_PU))) continue;
        const float* srcb = INP(tb ? I_PV : I_PU) + (size_t)l * 16384 * DM; unsigned char* dstb = (unsigned char*)(c.ws + (tb ? ws_pv(l) : ws_pu(l)));
        const float sc = tb ? 1.f : 32.f;
        for (size_t j = gt; j < NG16; j += 2 * NT) {
            const size_t j2 = j + NT; const bool has2 = j2 < NG16;
            f32x4 a[4], b[4];
#pragma unroll
            for (int d = 0; d < 4; ++d) a[d] = *(const f32x4*)(srcb + j * 16 + d * 4);
#pragma unroll
            for (int d = 0; d < 4; ++d) b[d] = has2 ? *(const f32x4*)(srcb + j2 * 16 + d * 4) : (f32x4){0.f, 0.f, 0.f, 0.f};
            u32x4 o, o2;
#pragma unroll
            for (int d = 0; d < 4; ++d) { const f32x4 x = a[d] * sc, y = b[d] * sc;
                int w = __builtin_amdgcn_cvt_pk_fp8_f32(x[0], x[1], 0, false); w = __builtin_amdgcn_cvt_pk_fp8_f32(x[2], x[3], w, true); o[d] = (unsigned)w;
                int w2 = __builtin_amdgcn_cvt_pk_fp8_f32(y[0], y[1], 0, false); w2 = __builtin_amdgcn_cvt_pk_fp8_f32(y[2], y[3], w2, true); o2[d] = (unsigned)w2; }
            if (tb == 0) { *(u32x4*)(dstb + j * 16) = o; if (has2) *(u32x4*)(dstb + j2 * 16) = o2; }
            else {
                *(u32x4*)(dstb + (size_t)((j & 127) >> 3) * ((size_t)16384 * 128) + (j >> 7) * 128 + (j & 7) * 16) = o;
                if (has2) *(u32x4*)(dstb + (size_t)((j2 & 127) >> 3) * ((size_t)16384 * 128) + (j2 >> 7) * 128 + (j2 & 7) * 16) = o2; } }
    }
    if (what & CV_LRU) for (size_t i = gt; i < (size_t)16 * 512 * 128; i += NT) { const int ci = (int)(i & 127), j = (int)((i >> 7) & 511), n = (int)(i >> 16), d = j >> 8, which = (j >> 7) & 1, dd = j & 127;
        const float* src = INP(which ? I_LWX : I_LWA) + ((((size_t)(l * 2 + d) * 16 + n) * 128 + ci) * 128 + dd);
        ((bf16_t*)(c.ws + WS_WLRU))[i] = f2bf(*src); }
}
__device__ __forceinline__ void sp_copy(const Ctx& c, const float* src, int sp_off, int n) {
    const size_t gt = (size_t)c.wg * NTHREADS + c.tid, NT = (size_t)c.G * NTHREADS;
    for (size_t i = gt; i < (size_t)n; i += NT) ((float*)(c.ws + WS_SP))[sp_off + i] = src[i];
}
__device__ __forceinline__ void conv_small(const Ctx& c, int l) {
    GET_IN();
    const size_t gt = (size_t)c.wg * NTHREADS + c.tid, NT = (size_t)c.G * NTHREADS;
    sp_copy(c, INP(I_NMIX) + l * DM, SP_NMIX, DM); sp_copy(c, INP(I_NFFN) + l * DM, SP_NFFN, DM);
    sp_copy(c, INP(I_QN) + l * 128, SP_QN, 128); sp_copy(c, INP(I_KN) + l * 128, SP_KN, 128);
    sp_copy(c, INP(I_LCW) + l * 4 * DM, SP_LCW, 4 * DM); sp_copy(c, INP(I_LCB) + l * DM, SP_LCB, DM);
    sp_copy(c, INP(I_LBA) + l * 2 * DM, SP_LBA, 2 * DM); sp_copy(c, INP(I_LBX) + l * 2 * DM, SP_LBX, 2 * DM);
    sp_copy(c, INP(I_SCW) + l * 3 * DM, SP_SCW, 3 * DM); sp_copy(c, INP(I_SCB) + l * DM, SP_SCB, DM);
    { const float* lam = INP(I_LLAM) + l * 2 * DM;
      for (size_t i = gt; i < (size_t)2 * DM; i += NT) ((float*)(c.ws + WS_SP))[SP_LSP + i] = 8.f * log1pf(expf(-lam[i])); }
}
__device__ __forceinline__ void conv_once(const Ctx& c) {
    const size_t gt = (size_t)c.wg * NTHREADS + c.tid, NT = (size_t)c.G * NTHREADS;
    for (size_t i = gt; i < 128 * 32; i += NT) { const int pos = (int)(i >> 5), p = (int)(i & 31);
        const float inv = exp2f(-(float)p * (13.287712379549449f / 32.f)); const float ang = (float)pos * inv;
        float sn, cs; sincosf(ang, &sn, &cs);
        ((float*)(c.ws + WS_ROPE))[i] = cs; ((float*)(c.ws + WS_ROPE))[128 * 32 + i] = sn; }
}

template <bool I8 = false>
__device__ __forceinline__ void phase_norm(const Ctx& c, int l, int nrows, int sp_gain, int slot_shift, const float* xin = nullptr, const float* cin = nullptr) {
    const int gw = c.wg * NWAVES + c.wave, NGW = c.G * NWAVES;
    const float* modl = (const float*)(c.ws + WS_MOD) + (size_t)l * 3 * NMOD;
    bf16_t* HX = (bf16_t*)(c.ws + WS_HX); const float* gain = (const float*)(c.ws + WS_SP) + sp_gain;
    for (int r = gw; r < nrows; r += NGW) {
        const int vec = r < SEQ ? 0 : (r < MLAT ? 1 : 2);
        const float* xr = xin ? (r < MLAT ? xin + (size_t)r * DM : cin + (size_t)(r - MLAT) * DM) : xrow_ptr(c, r); const float* sh = modl + (size_t)vec * NMOD + slot_shift * DM; const float* sc = sh + DM;
        f32x4 v[8]; float ss = 0.f;
#pragma unroll
        for (int j = 0; j < 8; ++j) { v[j] = *(const f32x4*)(xr + j * 256 + c.lane * 4); ss += (v[j][0] * v[j][0] + v[j][1] * v[j][1]) + (v[j][2] * v[j][2] + v[j][3] * v[j][3]); }
        const float rs = rsqrtf(wave_sum(ss) * (1.f / DM) + EPS);
        if constexpr (I8) { float mx = 0.f;
#pragma unroll
            for (int j = 0; j < 8; ++j) { const int col = j * 256 + c.lane * 4;
                const f32x4 g = *(const f32x4*)(gain + col), s1 = *(const f32x4*)(sc + col), s0 = *(const f32x4*)(sh + col);
                v[j] = (v[j] * rs * g) * (s1 + 1.f) + s0;
                mx = fmaxf(fmaxf(mx, fmaxf(fabsf(v[j][0]), fabsf(v[j][1]))), fmaxf(fabsf(v[j][2]), fabsf(v[j][3]))); }
#pragma unroll
            for (int o = 32; o > 0; o >>= 1) mx = fmaxf(mx, __shfl_xor(mx, o));
            const float q_ = mx > 0.f ? 127.f / mx : 0.f;
            if (c.lane == 0) ((float*)(c.ws + WS_ADQ))[r] = mx * (1.f / 127.f);
#pragma unroll
            for (int j = 0; j < 8; ++j) *(unsigned*)((unsigned char*)HX + (size_t)r * DM + j * 256 + c.lane * 4) = pk4_i8(v[j][0] * q_, v[j][1] * q_, v[j][2] * q_, v[j][3] * q_);
        } else {
#pragma unroll
        for (int j = 0; j < 8; ++j) { const int col = j * 256 + c.lane * 4;
            const f32x4 g = *(const f32x4*)(gain + col), s1 = *(const f32x4*)(sc + col), s0 = *(const f32x4*)(sh + col);
            const f32x4 y = (v[j] * rs * g) * (s1 + 1.f) + s0;
            u32x2 o; o.x = cvt_pk_bf16(y[0], y[1]); o.y = cvt_pk_bf16(y[2], y[3]);
            *(u32x2*)(HX + (size_t)r * DM + col) = o; } }
    }
}
__device__ __forceinline__ void seg_of_row(int r, bool& is_ctx, int& b, int& t) {
    is_ctx = r >= MLAT; b = is_ctx ? (r - MLAT) >> 8 : r >> 13; t = is_ctx ? (r - MLAT) & 255 : r & (SEQ - 1);
}
__device__ __forceinline__ void qk_row(const Ctx& c, int l, int r, bool do_q, bool dry) {
    bool is_ctx; int b, t; seg_of_row(r, is_ctx, b, t);
    const int key = is_ctx ? t : CTXL + t;
    bf16_t* prow = (bf16_t*)(c.ws + WS_P) + (size_t)r * NIN;
    bf16_t* KC = (bf16_t*)(c.ws + WS_KC); bf16_t* VC = (bf16_t*)(c.ws + WS_VC);
    const int hs = c.lane >> 4, ax = (c.lane >> 3) & 1, p0 = (c.lane & 7) * 4;
    f32x4 cs = {1.f, 1.f, 1.f, 1.f}, sn = {0.f, 0.f, 0.f, 0.f};
    if (!is_ctx) { const int pos = ax ? (t & 63) : (t >> 6); const float* rt = (const float*)(c.ws + WS_ROPE) + pos * 32 + p0; cs = *(const f32x4*)rt; sn = *(const f32x4*)(rt + 128 * 32); }
    u32x2 w1[5], w2[5];
#pragma unroll
    for (int g = 0; g < 5; ++g) { const bool is_k = (g == 4); const int head = is_k ? hs : g * 4 + hs;
        const bf16_t* src = prow + (is_k ? CK : CQ) + head * 128 + ax * 64 + p0;
        if (is_k || do_q) { w1[g] = *(const u32x2*)src; w2[g] = *(const u32x2*)(src + 32); } else { w1[g] = (u32x2){0u, 0u}; w2[g] = (u32x2){0u, 0u}; } }
    const u32x4 vw = *(const u32x4*)(prow + CV + (c.lane >> 4) * 128 + (c.lane & 15) * 8);
#pragma unroll
    for (int g = 0; g < 5; ++g) {
        const bool is_k = (g == 4);
        if (!is_k && !do_q) continue;
        const int head = is_k ? hs : g * 4 + hs;
        bf16_t* src = prow + (is_k ? CK : CQ) + head * 128 + ax * 64 + p0;
        f32x4 t1 = {bf_lo(w1[g].x), bf_hi(w1[g].x), bf_lo(w1[g].y), bf_hi(w1[g].y)}, t2 = {bf_lo(w2[g].x), bf_hi(w2[g].x), bf_lo(w2[g].y), bf_hi(w2[g].y)};
        float ss = (t1[0] * t1[0] + t1[1] * t1[1]) + (t1[2] * t1[2] + t1[3] * t1[3]) + (t2[0] * t2[0] + t2[1] * t2[1]) + (t2[2] * t2[2] + t2[3] * t2[3]);
        ss += DPPF(ss, 0xB1); ss += DPPF(ss, 0x4E); ss += DPPF(ss, 0x141); ss += DPPF(ss, 0x140);
        const float rs = rsqrtf(ss * (1.f / 128.f) + EPS);
        const float* gn = (const float*)(c.ws + WS_SP) + (is_k ? SP_KN : SP_QN) + ax * 64 + p0;
        const f32x4 g1 = *(const f32x4*)gn, g2 = *(const f32x4*)(gn + 32);
        const f32x4 y1 = t1 * rs * g1, y2 = t2 * rs * g2;
        const f32x4 o1 = y1 * cs - y2 * sn, o2 = y2 * cs + y1 * sn;
        bf16_t* dst = is_k ? KC + ((size_t)(b * 4 + head) * NKEY + key) * 128 + ax * 64 + p0 : (dry ? (bf16_t*)(c.ws + WS_YF) + (size_t)r * DM + head * 128 + ax * 64 + p0 : src);
        u32x2 a; a.x = cvt_pk_bf16(o1[0], o1[1]); a.y = cvt_pk_bf16(o1[2], o1[3]);
        u32x2 bq; bq.x = cvt_pk_bf16(o2[0], o2[1]); bq.y = cvt_pk_bf16(o2[2], o2[3]);
        *(u32x2*)dst = a; *(u32x2*)(dst + 32) = bq;
    }
    { const int hv = c.lane >> 4, dd = (c.lane & 15) * 8;
      *(u32x4*)(VC + ((size_t)(b * 4 + hv) * NKEY + key) * 128 + dd) = vw; }
}
__device__ __forceinline__ void unpack8(const u32x4 w, float (&f)[8]) {
    f[0] = bf_lo(w.x); f[1] = bf_hi(w.x); f[2] = bf_lo(w.y); f[3] = bf_hi(w.y); f[4] = bf_lo(w.z); f[5] = bf_hi(w.z); f[6] = bf_lo(w.w); f[7] = bf_hi(w.w);
}
__device__ __forceinline__ void sc_row(const Ctx& c, int l, int r, bool dry) {
    bool is_ctx; int b, t; seg_of_row(r, is_ctx, b, t);
    const int seglen = is_ctx ? CTXL : SEQ;
    bf16_t* prow = (bf16_t*)(c.ws + WS_P) + (size_t)r * NIN;
    const bool hp = t > 0, hn = t < seglen - 1;
    const float* w = (const float*)(c.ws + WS_SP) + SP_SCW; const float* bias = (const float*)(c.ws + WS_SP) + SP_SCB;
    u32x4 xb[4], xc0[4], xu0[4], xcp[4], xup[4], xcn[4], xun[4];
    const u32x4 z = {0u, 0u, 0u, 0u};
#pragma unroll
    for (int it = 0; it < 4; ++it) { const int col = it * 512 + c.lane * 8;
        xb[it] = *(const u32x4*)(prow + CBG + col); xc0[it] = *(const u32x4*)(prow + CCG + col); xu0[it] = *(const u32x4*)(prow + CU + col);
        xcp[it] = hp ? *(const u32x4*)(prow - NIN + CCG + col) : z; xup[it] = hp ? *(const u32x4*)(prow - NIN + CU + col) : z;
        xcn[it] = hn ? *(const u32x4*)(prow + NIN + CCG + col) : z; xun[it] = hn ? *(const u32x4*)(prow + NIN + CU + col) : z; }
#pragma unroll
    for (int it = 0; it < 4; ++it) {
        const int col = it * 512 + c.lane * 8;
        float bg[8], c0[8], u0[8], cp[8], up[8], cn[8], un[8];
        unpack8(xb[it], bg); unpack8(xc0[it], c0); unpack8(xu0[it], u0); unpack8(xcp[it], cp); unpack8(xup[it], up); unpack8(xcn[it], cn); unpack8(xun[it], un);
        float o[8];
#pragma unroll
        for (int hq = 0; hq < 2; ++hq) { const f32x4 w0 = *(const f32x4*)(w + col + hq * 4), w1 = *(const f32x4*)(w + DM + col + hq * 4), w2 = *(const f32x4*)(w + 2 * DM + col + hq * 4), bi = *(const f32x4*)(bias + col + hq * 4);
#pragma unroll
            for (int e = 0; e < 4; ++e) { const int k = hq * 4 + e; o[k] = bg[k] * (bi[e] + w0[e] * (cp[k] * up[k]) + w1[e] * (c0[k] * u0[k]) + w2[e] * (cn[k] * un[k])); } }
        u32x4 ow; ow.x = cvt_pk_bf16(o[0], o[1]); ow.y = cvt_pk_bf16(o[2], o[3]); ow.z = cvt_pk_bf16(o[4], o[5]); ow.w = cvt_pk_bf16(o[6], o[7]);
        *(u32x4*)((dry ? (bf16_t*)(c.ws + WS_YF) + (size_t)(MALL + r) * DM : prow + CBG) + col) = ow;
    }
}

constexpr size_t lsum_idx(int which, int dir, int b, int j) { return ((((size_t)which * 2 + dir) * NB + b) * NCHUNK + j) * DM; }
template <int DIR, int PASS>
__device__ __forceinline__ void lru_chunk(const LAS bf16_t* ub, const LAS float* uf, LAS float* hsd, const bf16x8 (&bfr)[4][4], const float (&ba)[2], const float (&bx)[2], const float (&sp8)[2],
                                          const float (&cin)[2], float (&Atot)[2], float (&Hend)[2], int q, int col16, int quad) {
    float st[2] = {cin[0], cin[1]}, at[2] = {1.f, 1.f};
    const int mysg = DIR ? 3 - quad : quad;
    for (int smt = 0; smt < 4; ++smt) {
        const int mt = DIR ? 3 - smt : smt;
        f32x4 acc[4];
#pragma unroll
        for (int nt = 0; nt < 4; ++nt) acc[nt] = (f32x4){0.f, 0.f, 0.f, 0.f};
#pragma unroll
        for (int ks = 0; ks < 4; ++ks) { const bf16x8 a = *(const LAS bf16x8*)(ub + (mt * 16 + col16) * 136 + ks * 32 + quad * 8);
#pragma unroll
            for (int nt = 0; nt < 4; ++nt) acc[nt] = __builtin_amdgcn_mfma_f32_16x16x32_bf16(a, bfr[nt][ks], acc[nt], 0, 0, 0); }
#pragma unroll
        for (int ct = 0; ct < 2; ++ct) {
            const int ch = q * 32 + ct * 16 + col16;
            float av[4], dv[4];
#pragma unroll
            for (int reg = 0; reg < 4; ++reg) { const int tl = mt * 16 + quad * 4 + reg;
                const float r = sigmoidf_(acc[ct][reg] + ba[ct]), ig = sigmoidf_(acc[2 + ct][reg] + bx[ct]);
                const float a = __expf(-sp8[ct] * r);
                av[reg] = a; dv[reg] = __builtin_amdgcn_sqrtf(fmaxf(1.f - a * a, 0.f)) * ig * uf[tl * 132 + ch]; }
            float Al = 1.f, Hl = 0.f;
#pragma unroll
            for (int sr = 0; sr < 4; ++sr) { const int reg = DIR ? 3 - sr : sr; Hl = av[reg] * Hl + dv[reg]; Al *= av[reg]; }
            float se = st[ct], so = st[ct], ap = 1.f;
#pragma unroll
            for (int sg = 0; sg < 4; ++sg) { const int qp = DIR ? 3 - sg : sg; const float Ag = __shfl(Al, col16 + 16 * qp), Hg = __shfl(Hl, col16 + 16 * qp);
                const float nx = Ag * so + Hg; so = nx; if (sg < mysg) se = nx; ap *= Ag; }
            if (PASS == 2) { float h = se;
#pragma unroll
                for (int sr = 0; sr < 4; ++sr) { const int reg = DIR ? 3 - sr : sr; h = av[reg] * h + dv[reg]; hsd[(mt * 16 + quad * 4 + reg) * 132 + ch] = h; } }
            else at[ct] *= ap;
            st[ct] = so;
        }
    }
    Atot[0] = at[0]; Atot[1] = at[1]; Hend[0] = st[0]; Hend[1] = st[1];
}

template <int PASS>
__device__ __forceinline__ void lru_run(const Ctx& c, int l, int unit, bool dry = false) {
    const int b = unit >> 7, n = (unit >> 3) & 15, run = unit & 7;
    const int c0 = run * 16 + (run < 4 ? run : 4), len = 16 + (run < 4 ? 1 : 0);
    LAS float* xl = (LAS float*)c.lds;
    LAS float* uf = (LAS float*)(c.lds + 34816);
    LAS bf16_t* ub = (LAS bf16_t*)(c.lds + 34816 + 33792);
    LAS float* car = (LAS float*)(c.lds + 34816 + 33792 + 17408);
    LAS float* hsr = (LAS float*)(c.lds + 34816 + 33792 + 17408 + 17408);
    const int d = c.wave >> 2, q = c.wave & 3, col16 = c.lane & 15, quad = c.lane >> 4;
    float* LS = (float*)(c.ws + WS_LSUM);
    bf16_t* P = (bf16_t*)(c.ws + WS_P);
    bf16x8 bfr[4][4];
#pragma unroll
    for (int nt = 0; nt < 4; ++nt) { const int j = d * 256 + (nt >> 1) * 128 + q * 32 + (nt & 1) * 16 + col16;
#pragma unroll
        for (int ks = 0; ks < 4; ++ks) bfr[nt][ks] = *(const bf16x8*)((const bf16_t*)(c.ws + WS_WLRU) + ((size_t)(n * 512 + j) * 128 + ks * 32 + quad * 8)); }
    float ba[2], bx[2], sp8[2];
#pragma unroll
    for (int ct = 0; ct < 2; ++ct) { const int cidx = n * 128 + q * 32 + ct * 16 + col16; const float* sp = (const float*)(c.ws + WS_SP) + d * DM + cidx;
        ba[ct] = sp[SP_LBA]; bx[ct] = sp[SP_LBX]; sp8[ct] = sp[SP_LSP]; }
    if (PASS == 2) {
        if (c.tid < 256) { const int dir = c.tid >> 7, ch = c.tid & 127, cidx = n * 128 + ch; float st = 0.f;
#pragma unroll 1
            for (int k0 = 0; k0 < NCHUNK; k0 += 12) {
                float av[12], hv[12];
#pragma unroll
                for (int kk = 0; kk < 12; ++kk) { const int k = k0 + kk, j = dir ? (k < 4 ? 3 - k : 135 - k) : k; av[kk] = LS[lsum_idx(0, dir, b, j) + cidx]; hv[kk] = LS[lsum_idx(1, dir, b, j) + cidx]; }
#pragma unroll
                for (int kk = 0; kk < 12; ++kk) { const int k = k0 + kk, j = dir ? (k < 4 ? 3 - k : 135 - k) : k;
                    if (j >= c0 && j < c0 + len) car[(dir * 17 + (j - c0)) * 128 + ch] = st;
                    st = av[kk] * st + hv[kk]; } } }
        __syncthreads();
    }
    const float* cw = (const float*)(c.ws + WS_SP) + SP_LCW + n * 128; const float* cb = (const float*)(c.ws + WS_SP) + SP_LCB + n * 128;
#define LRU_GEOM(ci_, jc, is_ctx, rb, t0, seglen) const int jc = c0 + (ci_); const bool is_ctx = jc < 4; \
        const int rb = is_ctx ? MLAT + b * CTXL : b * SEQ, t0 = is_ctx ? jc * 64 : (jc - 4) * 64, seglen = is_ctx ? CTXL : SEQ
#define LRU_LOAD(ci_, XR, LG) do { LRU_GEOM(ci_, jc_, ic_, rb_, t0_, sl_); (void)ic_; \
        _Pragma("unroll") for (int ps = 0; ps < 3; ++ps) { const int i = ps * 32 + (c.tid >> 4); const int t = t0_ - 2 + i; XR[ps] = (u32x4){0u, 0u, 0u, 0u}; \
            if (i < 68 && t >= 0 && t < sl_) XR[ps] = *(const u32x4*)(P + (size_t)(rb_ + t) * NIN + CLX + n * 128 + (c.tid & 15) * 8); } \
        if (PASS == 2) { const bf16_t* gp_ = P + (size_t)(rb_ + t0_ + (c.tid >> 3)) * NIN + CLG + n * 128 + (c.tid & 7) * 16; LG[0] = *(const u32x4*)gp_; LG[1] = *(const u32x4*)(gp_ + 8); } } while (0)
    u32x4 xr[3], lgc[2] = {{0u, 0u, 0u, 0u}, {0u, 0u, 0u, 0u}}, lgn[2] = {{0u, 0u, 0u, 0u}, {0u, 0u, 0u, 0u}};
    LRU_LOAD(0, xr, lgn);
    for (int ci = 0; ci < len; ++ci) {
        LRU_GEOM(ci, jc, is_ctx, rb, t0, seglen); (void)is_ctx; (void)seglen;
#pragma unroll
        for (int ps = 0; ps < 3; ++ps) { const int i = ps * 32 + (c.tid >> 4);
            if (i < 68) { float f[8]; unpack8(xr[ps], f);
                *(LAS f32x4*)(xl + i * 128 + (c.tid & 15) * 8) = (f32x4){f[0], f[1], f[2], f[3]}; *(LAS f32x4*)(xl + i * 128 + (c.tid & 15) * 8 + 4) = (f32x4){f[4], f[5], f[6], f[7]}; } }
        lgc[0] = lgn[0]; lgc[1] = lgn[1];
        __syncthreads();
        if (ci + 1 < len) LRU_LOAD(ci + 1, xr, lgn);
        { const int ch = c.tid & 127, tq = c.tid >> 7; const float w0 = cw[ch], w1 = cw[DM + ch], w2 = cw[2 * DM + ch], w3 = cw[3 * DM + ch], bb = cb[ch];
#pragma unroll 4
          for (int tt = 0; tt < 16; ++tt) { const int tl = tq * 16 + tt;
              const float u = bb + w0 * xl[tl * 128 + ch] + w1 * xl[(tl + 1) * 128 + ch] + w2 * xl[(tl + 2) * 128 + ch] + w3 * xl[(tl + 3) * 128 + ch];
              uf[tl * 132 + ch] = u; ub[tl * 136 + ch] = f2bf(u); } }
        __syncthreads();
        float cin[2] = {0.f, 0.f}, At[2], He[2];
        if (PASS == 2) { cin[0] = car[(d * 17 + ci) * 128 + q * 32 + col16]; cin[1] = car[(d * 17 + ci) * 128 + q * 32 + 16 + col16]; }
        if (d == 0) lru_chunk<0, PASS>(ub, uf, xl, bfr, ba, bx, sp8, cin, At, He, q, col16, quad);
        else lru_chunk<1, PASS>(ub, uf, hsr, bfr, ba, bx, sp8, cin, At, He, q, col16, quad);
        if (PASS == 1) {
            if (quad == 0) {
#pragma unroll
                for (int ct = 0; ct < 2; ++ct) { const int cidx = n * 128 + q * 32 + ct * 16 + col16;
                    LS[lsum_idx(0, d, b, jc) + cidx] = At[ct]; LS[lsum_idx(1, d, b, jc) + cidx] = He[ct]; } }
            __syncthreads();
        } else {
            __syncthreads();
            { const int row = c.tid >> 3, cs = (c.tid & 7) * 16;
              bf16_t* gp = P + (size_t)(rb + t0 + row) * NIN + CLG + n * 128 + cs;
#pragma unroll
              for (int hseg = 0; hseg < 2; ++hseg) { float g[8]; unpack8(lgc[hseg], g);
                  const int o = row * 132 + cs + hseg * 8;
                  const f32x4 h0 = *(const LAS f32x4*)(xl + o) + *(const LAS f32x4*)(hsr + o), h1 = *(const LAS f32x4*)(xl + o + 4) + *(const LAS f32x4*)(hsr + o + 4);
                  u32x4 ow; ow.x = cvt_pk_bf16(h0[0] * gelu_tanh(g[0]), h0[1] * gelu_tanh(g[1])); ow.y = cvt_pk_bf16(h0[2] * gelu_tanh(g[2]), h0[3] * gelu_tanh(g[3]));
                  ow.z = cvt_pk_bf16(h1[0] * gelu_tanh(g[4]), h1[1] * gelu_tanh(g[5])); ow.w = cvt_pk_bf16(h1[2] * gelu_tanh(g[6]), h1[3] * gelu_tanh(g[7]));
                  *(u32x4*)((dry ? gp - CLG + CU : gp) + hseg * 8) = ow; } }
            __syncthreads();
        }
    }
#undef LRU_GEOM
#undef LRU_LOAD
}

__device__ __forceinline__ void phase_qk(const Ctx& c, int l, bool dry = false) {
    const int gw = c.wg * NWAVES + c.wave, NGW = c.G * NWAVES;
    for (int r = gw; r < MALL; r += NGW) qk_row(c, l, r, l == 0 || r < MLAT, dry);
}
__device__ __forceinline__ void sc_block8(const Ctx& c, int r0, bool dry) {
    const int t0 = r0 & (SEQ - 1);
    bf16_t* prow0 = (bf16_t*)(c.ws + WS_P) + (size_t)r0 * NIN;
    const float* w = (const float*)(c.ws + WS_SP) + SP_SCW; const float* bias = (const float*)(c.ws + WS_SP) + SP_SCB;
    const u32x4 z = {0u, 0u, 0u, 0u};
#pragma unroll 1
    for (int it = 0; it < 4; ++it) {
        const int col = it * 512 + c.lane * 8;
        float w0[8], w1[8], w2[8], bi[8];
#pragma unroll
        for (int hq = 0; hq < 2; ++hq) { const f32x4 a = *(const f32x4*)(w + col + hq * 4), b = *(const f32x4*)(w + DM + col + hq * 4), d = *(const f32x4*)(w + 2 * DM + col + hq * 4), e = *(const f32x4*)(bias + col + hq * 4);
#pragma unroll
            for (int k = 0; k < 4; ++k) { w0[hq * 4 + k] = a[k]; w1[hq * 4 + k] = b[k]; w2[hq * 4 + k] = d[k]; bi[hq * 4 + k] = e[k]; } }
        u32x4 xc[10], xu[10], xb[8];
#pragma unroll
        for (int j = 0; j < 10; ++j) { const int t = t0 - 1 + j; const bool in = t >= 0 && t < SEQ; const bf16_t* pr = prow0 + (ptrdiff_t)(j - 1) * NIN;
            xc[j] = in ? *(const u32x4*)(pr + CCG + col) : z; xu[j] = in ? *(const u32x4*)(pr + CU + col) : z; }
#pragma unroll
        for (int j = 0; j < 8; ++j) xb[j] = *(const u32x4*)(prow0 + (size_t)j * NIN + CBG + col);
        float zp[8], zc[8];
        { float a[8], b[8]; unpack8(xc[0], a); unpack8(xu[0], b);
#pragma unroll
          for (int k = 0; k < 8; ++k) zp[k] = a[k] * b[k];
          unpack8(xc[1], a); unpack8(xu[1], b);
#pragma unroll
          for (int k = 0; k < 8; ++k) zc[k] = a[k] * b[k]; }
#pragma unroll
        for (int j = 0; j < 8; ++j) {
            float a[8], b[8], bg[8], zn[8], o[8]; unpack8(xc[j + 2], a); unpack8(xu[j + 2], b); unpack8(xb[j], bg);
#pragma unroll
            for (int k = 0; k < 8; ++k) { zn[k] = a[k] * b[k]; o[k] = bg[k] * (bi[k] + w0[k] * zp[k] + w1[k] * zc[k] + w2[k] * zn[k]); zp[k] = zc[k]; zc[k] = zn[k]; }
            u32x4 ow; ow.x = cvt_pk_bf16(o[0], o[1]); ow.y = cvt_pk_bf16(o[2], o[3]); ow.z = cvt_pk_bf16(o[4], o[5]); ow.w = cvt_pk_bf16(o[6], o[7]);
            *(u32x4*)((dry ? (bf16_t*)(c.ws + WS_YF) + (size_t)(MALL + r0 + j) * DM : prow0 + (size_t)j * NIN + CBG) + col) = ow; }
    }
}
__device__ __forceinline__ void phase_sc(const Ctx& c, int l, bool dry = false) {
    const int gw = c.wg * NWAVES + c.wave, NGW = c.G * NWAVES;
    for (int r0 = gw * 8; r0 < MLAT; r0 += NGW * 8) sc_block8(c, r0, dry);
    if (l == 0) for (int r = MLAT + gw; r < MALL; r += NGW) sc_row(c, l, r, dry);
}
__device__ __forceinline__ void phase_lru1(const Ctx& c, int l) {
    for (int u = c.wg; u < 256; u += c.G) lru_run<1>(c, l, u);
}

__device__ __forceinline__ void phase_m2(const Ctx& c, int l, bool dry = false) {
    bf16_t* P = (bf16_t*)(c.ws + WS_P); const bf16_t* KC = (const bf16_t*)(c.ws + WS_KC); const bf16_t* VC = (const bf16_t*)(c.ws + WS_VC);
    const int ntot = 1024 + (l == 0 ? 32 : 0);
    for (int i = 0; i * c.G + c.wg < ntot; ++i) {
        const int L = i * c.G + c.wg; int b, h, seq; size_t qrow;
        if (L < 1024) { int grp, qb;
            if (c.G == 256) { grp = i * 8 + (c.wg & 7); qb = c.wg >> 3; } else { grp = L >> 5; qb = L & 31; }
            b = grp >> 4; h = grp & 15; qrow = (size_t)(b * SEQ + qb * 256); seq = NKEY; }
        else { const int u = L - 1024; b = u >> 4; h = u & 15; qrow = (size_t)(MLAT + b * CTXL); seq = CTXL; }
        bf16_t* q = P + qrow * NIN + CQ + h * 128;
        const size_t kvo = (size_t)(b * 4 + (h >> 2)) * NKEY * 128;
        att::attn_dense_body(q, KC + kvo, VC + kvo, dry ? q - CQ + CCG : q, seq, (char*)c.lds, c.wave);
    }
}
__device__ __forceinline__ void phase_lru2(const Ctx& c, int l, bool dry = false) {
    for (int u = c.wg; u < 256; u += c.G) lru_run<2>(c, l, u, dry);
}
constexpr float NEGBIG = -3.0e38f;
constexpr float PU_SCALE = 32.f;
__device__ __forceinline__ float wave_max_dpp(float v) {
    v = fmaxf(v, DPPF(v, 0xB1)); v = fmaxf(v, DPPF(v, 0x4E)); v = fmaxf(v, DPPF(v, 0x141)); v = fmaxf(v, DPPF(v, 0x140));
    const float a = __int_as_float(__builtin_amdgcn_readlane(__float_as_int(v), 0)), b = __int_as_float(__builtin_amdgcn_readlane(__float_as_int(v), 16));
    const float c = __int_as_float(__builtin_amdgcn_readlane(__float_as_int(v), 32)), d = __int_as_float(__builtin_amdgcn_readlane(__float_as_int(v), 48));
    return fmaxf(fmaxf(a, b), fmaxf(c, d));
}
#define SWZ_XOR(v, m) __int_as_float(__builtin_amdgcn_ds_swizzle(__float_as_int(v), ((m) << 10) | 0x1F))
__device__ __forceinline__ unsigned fkey(float x) { const unsigned u = __float_as_uint(x); return (u & 0x80000000u) ? ~u : (u | 0x80000000u); }
#define DPPU(v, ctrl) ((unsigned)__builtin_amdgcn_update_dpp(0, (int)(v), ctrl, 0xF, 0xF, true))
__device__ __forceinline__ unsigned wave_max_u32(unsigned v) {
    v = max(v, DPPU(v, 0xB1)); v = max(v, DPPU(v, 0x4E)); v = max(v, DPPU(v, 0x141)); v = max(v, DPPU(v, 0x140));
    const unsigned a = (unsigned)__builtin_amdgcn_readlane((int)v, 0), b = (unsigned)__builtin_amdgcn_readlane((int)v, 16), c = (unsigned)__builtin_amdgcn_readlane((int)v, 32), d = (unsigned)__builtin_amdgcn_readlane((int)v, 48);
    return max(max(a, b), max(c, d));
}
__device__ __forceinline__ unsigned topk16_keys2(unsigned k0, unsigned k1, int lane) {
    unsigned res = 0u;
    for (int it = 0; it < 16; ++it) { const unsigned m = wave_max_u32(max(k0, k1)); k0 = (k0 == m) ? 0u : k0; k1 = (k1 == m) ? 0u : k1; res = (lane == it) ? m : res; }
    return res;
}
__device__ __forceinline__ unsigned topk16_keys1(unsigned k0, int lane) {
    unsigned res = 0u;
    for (int it = 0; it < 16; ++it) { const unsigned m = wave_max_u32(k0); k0 = (k0 == m) ? 0u : k0; res = (lane == it) ? m : res; }
    return res;
}
__device__ __forceinline__ void unpack_fp8x16(const u32x4 w, float (&f)[16]) {
#pragma unroll
    for (int d = 0; d < 4; ++d) { const f32x2 lo = __builtin_amdgcn_cvt_pk_f32_fp8((int)w[d], false), hi = __builtin_amdgcn_cvt_pk_f32_fp8((int)w[d], true);
        f[4 * d] = lo.x; f[4 * d + 1] = lo.y; f[4 * d + 2] = hi.x; f[4 * d + 3] = hi.y; }
}

__device__ __forceinline__ unsigned half_max_u32(unsigned v, bool hi_half) {
    v = max(v, DPPU(v, 0xB1)); v = max(v, DPPU(v, 0x4E)); v = max(v, DPPU(v, 0x141)); v = max(v, DPPU(v, 0x140));
    const unsigned a = max((unsigned)__builtin_amdgcn_readlane((int)v, 0), (unsigned)__builtin_amdgcn_readlane((int)v, 16));
    const unsigned b = max((unsigned)__builtin_amdgcn_readlane((int)v, 32), (unsigned)__builtin_amdgcn_readlane((int)v, 48));
    return hi_half ? b : a;
}
__device__ __forceinline__ unsigned topk16_half4(unsigned (&k)[4], int hl, bool hi_half) {
    unsigned res = 0u;
    for (int it = 0; it < 16; ++it) { const unsigned m = half_max_u32(max(max(k[0], k[1]), max(k[2], k[3])), hi_half);
#pragma unroll
        for (int j = 0; j < 4; ++j) k[j] = (k[j] == m) ? 0u : k[j];
        res = (hl == it) ? m : res; }
    return res;
}
__device__ __forceinline__ unsigned topk16_half2(unsigned k0, unsigned k1, int hl, bool hi_half) {
    unsigned res = 0u;
    for (int it = 0; it < 16; ++it) { const unsigned m = half_max_u32(max(k0, k1), hi_half); k0 = (k0 == m) ? 0u : k0; k1 = (k1 == m) ? 0u : k1; res = (hl == it) ? m : res; }
    return res;
}
__device__ __forceinline__ void cand_ab(int cidx50, int& a, int& b) {
    a = cidx50 < 16 ? 0 : cidx50 < 24 ? 1 : cidx50 < 29 ? 2 : cidx50 < 33 ? 3 : cidx50 < 36 ? 4 : cidx50 < 38 ? 5 : cidx50 < 40 ? 6 : cidx50 < 42 ? 7 : cidx50 - 34;
    const int st = cidx50 < 16 ? 0 : cidx50 < 24 ? 16 : cidx50 < 29 ? 24 : cidx50 < 33 ? 29 : cidx50 < 36 ? 33 : cidx50 < 38 ? 36 : cidx50 < 40 ? 38 : cidx50 < 42 ? 40 : cidx50;
    b = cidx50 - st;
}
__device__ __forceinline__ void peer_topk_pair(const LAS float* srow, int hp, LAS float* gsc, LAS int* isc, int lane) {
    const int hl = lane & 31, hb = lane & 32; const bool hi_half = lane >= 32; const int h = 2 * hp + (hi_half ? 1 : 0);
    const LAS float* sh = srow + h * 256;
    unsigned k1[4], k2[4];
#pragma unroll
    for (int j = 0; j < 4; ++j) { const int idx = hl + 32 * j; k1[j] = (fkey(sh[idx]) & ~127u) | (unsigned)(127 - idx); k2[j] = (fkey(sh[128 + idx]) & ~127u) | (unsigned)(127 - idx); }
    const unsigned r1 = topk16_half4(k1, hl, hi_half), r2 = topk16_half4(k2, hl, hi_half);
    const int i1 = 127 - (int)(r1 & 127u), i2 = 127 - (int)(r2 & 127u);
    const float v1 = sh[i1], v2 = sh[128 + i2];
    int a0, b0, a1, b1; cand_ab(hl, a0, b0); cand_ab(hl + 32, a1, b1);
    const float c0 = __shfl(v1, hb + a0) + __shfl(v2, hb + b0), c1 = __shfl(v1, hb + (a1 & 15)) + __shfl(v2, hb + (b1 & 15));
    const unsigned q0 = (fkey(c0) & ~255u) | (unsigned)(255 - (a0 * 16 + b0)), q1 = (hl + 32 < 50) ? ((fkey(c1) & ~255u) | (unsigned)(255 - (a1 * 16 + b1))) : 0u;
    const unsigned r3 = topk16_half2(q0, q1, hl, hi_half);
    const int ci = 255 - (int)(r3 & 255u);
    const float sc = __shfl(v1, hb + (ci >> 4)) + __shfl(v2, hb + (ci & 15));
    const int e = __shfl(i1, hb + (ci >> 4)) * 128 + __shfl(i2, hb + (ci & 15));
    const float mxa = __int_as_float(__builtin_amdgcn_readlane(__float_as_int(sc), 0)), mxb = __int_as_float(__builtin_amdgcn_readlane(__float_as_int(sc), 32));
    const float ex = hl < 16 ? __expf(sc - (hi_half ? mxb : mxa)) : 0.f;
    float sm = ex; sm += DPPF(sm, 0xB1); sm += DPPF(sm, 0x4E); sm += DPPF(sm, 0x141); sm += DPPF(sm, 0x140);
    if (hl < 16) { gsc[h * 16 + hl] = ex / sm; isc[h * 16 + hl] = e; }
}

constexpr size_t WS_PE_E = WS_P + 160 * MiB, WS_PE_CF = WS_PE_E + (size_t)MALL * 128 * 4;
constexpr int NSL = 16, SLW = 128;
constexpr size_t SLICE_BYTES = (size_t)16384 * SLW;
__device__ __forceinline__ void peer_token(const Ctx& c, int l, int r, int rn, int b, bool dry) {
    LAS float* gsc = (LAS float*)(c.lds + c.wave * 2048 + b * 1024);
    LAS int* isc = (LAS int*)(c.lds + c.wave * 2048 + b * 1024 + 512);
    LAS float* gscn = (LAS float*)(c.lds + c.wave * 2048 + (b ^ 1) * 1024); LAS int* iscn = (LAS int*)(c.lds + c.wave * 2048 + (b ^ 1) * 1024 + 512);
    const float* Sn = (const float*)(c.ws + WS_P) + (size_t)(rn < 0 ? r : rn) * DM;
    const int lane = c.lane;
    LAS float* snb = (LAS float*)(c.lds + 16384 + c.wave * 8192);
    f32x4 sv[8];
#pragma unroll
    for (int q = 0; q < 8; ++q) sv[q] = (rn >= 0) ? *(const f32x4*)(Sn + q * 256 + lane * 4) : (f32x4){0.f, 0.f, 0.f, 0.f};
    LDS_WAIT(); asm volatile("" ::: "memory");
    const bf16_t* hx = (const bf16_t*)(c.ws + WS_HX) + (size_t)r * DM;
    int hq[2][4]; float hdq;
    { float hv[2][16]; float mx = 0.f;
#pragma unroll
      for (int j = 0; j < 2; ++j) { float t0[8], t1[8]; unpack8(*(const u32x4*)(hx + j * 1024 + lane * 16), t0); unpack8(*(const u32x4*)(hx + j * 1024 + lane * 16 + 8), t1);
#pragma unroll
          for (int k = 0; k < 8; ++k) { hv[j][k] = t0[k]; hv[j][8 + k] = t1[k]; mx = fmaxf(mx, fmaxf(fabsf(t0[k]), fabsf(t1[k]))); } }
#pragma unroll
      for (int o = 32; o > 0; o >>= 1) mx = fmaxf(mx, __shfl_xor(mx, o));
      const float q_ = mx > 0.f ? 127.f / mx : 0.f; hdq = mx * (1.f / 127.f);
#pragma unroll
      for (int j = 0; j < 2; ++j)
#pragma unroll
          for (int d = 0; d < 4; ++d) hq[j][d] = (int)pk4_i8(hv[j][4 * d] * q_, hv[j][4 * d + 1] * q_, hv[j][4 * d + 2] * q_, hv[j][4 * d + 3] * q_); }
    const float* USC = (const float*)(c.ws + WS_USC) + (size_t)l * 16384;
    const unsigned char* PU = (const unsigned char*)(c.ws + ws_pu(l)); const unsigned char* PV = (const unsigned char*)(c.ws + ws_pv(l));
#define PEER_LOADROW(tab, wk, e_) do { const unsigned char* row_ = (tab) + (size_t)__builtin_amdgcn_readfirstlane(e_) * DM + lane * 16; wk[0] = *(const u32x4*)row_; wk[1] = *(const u32x4*)(row_ + 1024); } while (0)
#define PEER_IDX8(dst, i_) const u32x4 ia_##dst = *(const LAS u32x4*)(isc + (i_)), ib_##dst = *(const LAS u32x4*)(isc + (i_) + 4); \
        const int dst[8] = {(int)ia_##dst[0], (int)ia_##dst[1], (int)ia_##dst[2], (int)ia_##dst[3], (int)ib_##dst[0], (int)ib_##dst[1], (int)ib_##dst[2], (int)ib_##dst[3]}
    u32x4 w[8][2];
    float usc_ = USC[isc[lane & 7]];
    { PEER_IDX8(e0, 0);
#pragma unroll
      for (int k = 0; k < 8; ++k) PEER_LOADROW(PU, w[k], e0[k]); }
    if (rn >= 0) {
#pragma unroll
        for (int q = 0; q < 8; ++q) *(LAS f32x4*)(snb + q * 256 + lane * 4) = sv[q];
        LDS_WAIT(); asm volatile("" ::: "memory"); }
#pragma unroll 1
    for (int i = 0; i < 128; i += 8) {
        const bool has_next = i + 8 < 128;
        PEER_IDX8(en, has_next ? i + 8 : i);
        const float uscn_ = USC[isc[(has_next ? i + 8 : i) + (lane & 7)]];
        if (rn >= 0 && (i & 24) == 0) peer_topk_pair(snb, i >> 5, gscn, iscn, lane);
        float p[8];
#pragma unroll
        for (int k = 0; k < 8; ++k) {
            asm volatile("" : "+v"(w[k][0]), "+v"(w[k][1]));
            int s = 0;
#pragma unroll
            for (int j = 0; j < 2; ++j)
#pragma unroll
                for (int d = 0; d < 4; ++d) s = __builtin_amdgcn_sdot4((int)w[k][j][d], hq[j][d], s, false);
            p[k] = (float)s; asm volatile("" : "+v"(p[k]));
            if (has_next) PEER_LOADROW(PU, w[k], en[k]); }
        const bool b0 = lane & 1, b1 = lane & 2, b2 = lane & 4;
        float q[4], t[2];
#pragma unroll
        for (int m = 0; m < 4; ++m) q[m] = (b0 ? p[2 * m + 1] : p[2 * m]) + DPPF(b0 ? p[2 * m] : p[2 * m + 1], 0xB1);
#pragma unroll
        for (int m = 0; m < 2; ++m) t[m] = (b1 ? q[2 * m + 1] : q[2 * m]) + DPPF(b1 ? q[2 * m] : q[2 * m + 1], 0x4E);
        float s = (b2 ? t[1] : t[0]) + SWZ_XOR(b2 ? t[0] : t[1], 4);
        s += SWZ_XOR(s, 8); s += SWZ_XOR(s, 16); s += __shfl_xor(s, 32);
        if (lane < 8) gsc[i + lane] = gsc[i + lane] * gelu_tanh(s * (usc_ * hdq));
        usc_ = uscn_;
    }
#undef PEER_LOADROW
#undef PEER_IDX8
    LDS_WAIT(); asm volatile("" ::: "memory");
    { int* E = (int*)(c.ws + WS_PE_E) + (size_t)r * 128; float* CF = (float*)(c.ws + WS_PE_CF) + (size_t)r * 128;
      E[lane] = isc[lane]; E[64 + lane] = isc[64 + lane]; CF[lane] = gsc[lane]; CF[64 + lane] = gsc[64 + lane]; }
    LDS_WAIT(); asm volatile("" ::: "memory");
}
__device__ __forceinline__ void phase_peer(const Ctx& c, int l, int nrows, bool dry = false) {
    const int gw = c.wg * NWAVES + c.wave, NGW = c.G * NWAVES;
    int r = gw; if (r >= nrows) return;
    { const float* S0 = (const float*)(c.ws + WS_P) + (size_t)r * DM; LAS float* snb0 = (LAS float*)(c.lds + 16384 + c.wave * 8192);
#pragma unroll
      for (int q = 0; q < 8; ++q) *(LAS f32x4*)(snb0 + q * 256 + c.lane * 4) = *(const f32x4*)(S0 + q * 256 + c.lane * 4);
      LDS_WAIT(); asm volatile("" ::: "memory");
#pragma unroll 1
      for (int hp = 0; hp < 4; ++hp) peer_topk_pair(snb0, hp, (LAS float*)(c.lds + c.wave * 2048), (LAS int*)(c.lds + c.wave * 2048 + 512), c.lane);
      LDS_WAIT(); asm volatile("" ::: "memory"); }
    int b = 0;
#pragma unroll 1
    for (; r < nrows; r += NGW, b ^= 1) { const int rn = r + NGW; peer_token(c, l, r, rn < nrows ? rn : -1, b, dry); }
}
#define PEER_SLICE_BEGIN() { const int grp = c.wg & 7, wi = (c.wg >> 3) * NWAVES + c.wave, nwi = ((c.G - grp + 7) >> 3) * NWAVES; \
    _Pragma("unroll 1") for (int ps = 0; ps < 2; ++ps) { const int s = grp + 8 * ps; _Pragma("unroll 1") for (int r = wi; r < nrows; r += nwi) {
#define PEER_SLICE_END() } } }
__device__ __forceinline__ void phase_peer_v(const Ctx& c, int l, int nrows, bool dry) {
    const int lane = c.lane, rg = lane >> 3, ch = lane & 7;
    const int* Eb = (const int*)(c.ws + WS_PE_E); const float* CF = (const float*)(c.ws + WS_PE_CF);
    const bool b3 = lane & 8, b4 = lane & 16, b5 = lane & 32;
    const int grp = c.wg & 7, wi = (c.wg >> 3) * NWAVES + c.wave, nwi = ((c.G - grp + 7) >> 3) * NWAVES;
#define V_META(r_, e0_, e1_, c0_, c1_) do { if ((r_) < nrows) { e0_ = Eb[(size_t)(r_) * 128 + lane]; e1_ = Eb[(size_t)(r_) * 128 + 64 + lane]; c0_ = CF[(size_t)(r_) * 128 + lane]; c1_ = CF[(size_t)(r_) * 128 + 64 + lane]; } } while (0)
#pragma unroll 1
    for (int ps = 0; ps < 2; ++ps) { const int s = grp + 8 * ps;
        const unsigned char* tab = (const unsigned char*)(c.ws + ws_pv(l)) + (size_t)s * SLICE_BYTES + ch * 16;
        const int col = s * SLW + ch * 16 + (b3 ? 8 : 0) + (b4 ? 4 : 0) + (b5 ? 2 : 0);
        int r = wi; int e0 = 0, e1 = 0; float c0 = 0.f, c1 = 0.f;
        V_META(r, e0, e1, c0, c1);
#pragma unroll 1
        for (; r < nrows; r += nwi) {
            u32x4 w[16];
#pragma unroll
            for (int i = 0; i < 16; ++i) { const int e = __shfl(i < 8 ? e0 : e1, (8 * i + rg) & 63); w[i] = *(const u32x4*)(tab + (size_t)e * SLW); }
            int f0 = 0, f1 = 0; float d0 = 0.f, d1 = 0.f; V_META(r + nwi, f0, f1, d0, d1);
            const int vec = r < SEQ ? 0 : (r < MLAT ? 1 : 2);
            float* xr = (dry ? (float*)(c.ws + WS_YF) + (size_t)r * DM : xrow_ptr(c, r)) + col;
            const f32x2 gg = *(const f32x2*)((const float*)(c.ws + WS_MOD) + ((size_t)l * 3 + vec) * NMOD + 5 * DM + col); f32x2 xx = *(const f32x2*)xr;
            float o[16];
#pragma unroll
            for (int j = 0; j < 16; ++j) o[j] = 0.f;
#pragma unroll
            for (int i = 0; i < 16; ++i) {
                asm volatile("" : "+v"(w[i]));
                const float ci_ = __shfl(i < 8 ? c0 : c1, (8 * i + rg) & 63);
                float f[16]; unpack_fp8x16(w[i], f);
#pragma unroll
                for (int j = 0; j < 16; ++j) o[j] += ci_ * f[j];
                asm volatile("" : "+v"(o[0])); }
            float q8[8], q4[4], q2[2];
#pragma unroll
            for (int j = 0; j < 8; ++j) q8[j] = (b3 ? o[8 + j] : o[j]) + DPPF(b3 ? o[j] : o[8 + j], 0x128);
#pragma unroll
            for (int j = 0; j < 4; ++j) q4[j] = (b4 ? q8[4 + j] : q8[j]) + SWZ_XOR(b4 ? q8[j] : q8[4 + j], 16);
#pragma unroll
            for (int j = 0; j < 2; ++j) q2[j] = (b5 ? q4[2 + j] : q4[j]) + __shfl_xor(b5 ? q4[j] : q4[2 + j], 32);
            xx[0] += gg[0] * q2[0]; xx[1] += gg[1] * q2[1];
            *(f32x2*)xr = xx;
            e0 = f0; e1 = f1; c0 = d0; c1 = d1;
        }
    }
#undef V_META
}
struct Args { const float* in[29]; float* out; unsigned char* ws; int ph_lo, ph_hi; };
constexpr int PH_PER_LAYER = 10, N_PHASES = NLAYER * PH_PER_LAYER;
#ifndef G1_WGM
#define G1_WGM 3
#endif
constexpr int CW_BAR = 4096;

__global__ void __launch_bounds__(NTHREADS, 2) mk_fwd(Args args) {
    extern __shared__ __attribute__((aligned(16))) unsigned char lds_raw[];
    Ctx c0;
    c0.out = args.out; c0.ws = args.ws; c0.lds = (LAS unsigned char*)lds_raw;
    c0.tid = threadIdx.x; c0.lane = c0.tid & 63; c0.wave = __builtin_amdgcn_readfirstlane((int)(threadIdx.x >> 6)); c0.wg = blockIdx.x; c0.G = gridDim.x;
    volatile LAS unsigned* MISC = (volatile LAS unsigned*)(c0.lds + MISC_OFF);
    if (c0.tid < 64) MISC[c0.tid] = 0u;
    __syncthreads();
    const int lo = args.ph_lo, hi = args.ph_hi;
    XcdBarrier bar; bar.bar = (unsigned*)(c0.ws + WS_CTL) + CW_BAR; bar.x = 0; bar.st = MISC + 8;
    if (hi - lo > 1) bar = xcd_barrier_post((unsigned*)(c0.ws + WS_CTL) + CW_BAR, MISC + 8);
#ifndef ONLY_PH
#define ONLY_PH -1
#endif
#define IN(k) ((ONLY_PH < 0 || ((k) % PH_PER_LAYER) == ONLY_PH) && lo <= (k) && (k) < hi)
#define PH_BEGIN() Ctx c = c0; unsigned long long wsi_ = (unsigned long long)c0.ws, outi_ = (unsigned long long)c0.out; asm volatile("" : "+s"(wsi_), "+s"(outi_), "+s"(c.wg), "+s"(c.G), "+s"(c.wave)); \
    c.lane = lane_id_fresh(); c.tid = c.wave * 64 + c.lane; c.ws = (unsigned char*)(GAS unsigned char*)wsi_; c.out = (float*)(GAS float*)outi_;     \
    bf16_t* P = (bf16_t*)(c.ws + WS_P); bf16_t* HX = (bf16_t*)(c.ws + WS_HX); float* YF = (float*)(c.ws + WS_YF); (void)P; (void)HX; (void)YF
#ifndef PROBE_DUP
#define PROBE_DUP -1
#endif
#define REPS(k) for (int rep = 0, dry = (PROBE_DUP == (k)); rep < (PROBE_DUP == (k) ? 2 : 1); ++rep, dry = 0)
#define SEAM(k) do { if (IN(k) && IN((k) + 1)) { xcd_barrier(bar, c0.wave); if (PROBE_DUP == 20) xcd_barrier(bar, c0.wave); } } while (0)
    const bool early = (c0.G == 256);
#define TAIL_BEGIN() PH_BEGIN(); c.wg -= 32; c.G -= 32
    for (int l = 0; l < NLAYER; ++l) {
        const int pb = l * PH_PER_LAYER;
        const int mrows = (l == 0) ? MALL : MLAT;
        if (IN(pb + 0) && !(l == 1 && early)) REPS(0) {
            if (l == 0) { PH_BEGIN(); conv_colmax(c); }
            { PH_BEGIN(); conv_units(c, l); } { PH_BEGIN(); conv_tables(c, l); } { PH_BEGIN(); conv_small(c, l); }
            if (l == 0) { { PH_BEGIN(); conv_once(c); } xcd_barrier(bar, c0.wave); }
            { PH_BEGIN(); conv_transposes(c, l); } }
        if (!(l == 1 && early)) SEAM(pb + 0);
        if (IN(pb + 1)) REPS(1) { PH_BEGIN();
            if (l == 0) { GET_IN(); phase_norm<true>(c, l, MALL, SP_NMIX, 0, INP(I_X), INP(I_CTX)); } else phase_norm<true>(c, l, MALL, SP_NMIX, 0); }
        SEAM(pb + 1);
        if (IN(pb + 2)) REPS(2) { PH_BEGIN();
            pg8::Gemm g{HX, (const bf16_t*)(c.ws + WS_WIN), MALL, NIN, DM, DM, DM}; pg8::StaticOrder S; S.init(MALL, NIN, c.G, c.wg, G1_WGM);
            pg8::EpiI8 E{P, NIN, (const float*)(c.ws + WS_ADQ), (const float*)(c.ws + WS_WDQ)};
            pg8::gemm_phase<pg8::EpiI8, pg8::StaticOrder, true, true, false, true>(c.lds, g, S, E, c.wave);
        }
        SEAM(pb + 2);
        if (IN(pb + 3)) REPS(3) {
            int flip_ = (c0.wg >> 3) & 1; asm volatile("" : "+s"(flip_));
#pragma unroll 1
            for (int st = 0; st < 2; ++st) {
                if ((st ^ flip_) == 0) { { PH_BEGIN(); phase_qk(c, l, dry); } { PH_BEGIN(); phase_sc(c, l, dry); } }
                else { PH_BEGIN(); phase_lru1(c, l); }
                __syncthreads(); }
            if (PROBE_DUP == 30) { PH_BEGIN(); phase_lru1(c, l); } }
        SEAM(pb + 3);
        if (IN(pb + 4)) REPS(4) { { PH_BEGIN(); phase_m2(c, l, dry); } __syncthreads(); if (PROBE_DUP == 31) { PH_BEGIN(); phase_lru2(c, l, true); } { PH_BEGIN(); phase_lru2(c, l, dry); } }
        SEAM(pb + 4);
        if (IN(pb + 5)) REPS(5) { { PH_BEGIN();
            pg8::MixOrder S; S.init(mrows, c.G, c.wg);
            const bf16_t* WO = (const bf16_t*)(c.ws + WS_WO);
            { pg8::Gemm g{P + CQ, WO, mrows, DM, DM, NIN, DM}; pg8::EpiMerge<0> E{P + CGT, NIN, (bf16_t*)YF, HX};
              pg8::gemm_phase<pg8::EpiMerge<0>, pg8::MixOrder, true, true, true>(c.lds, g, S, E, c.wave); }
            { pg8::Gemm g{P + CLG, WO + (size_t)DM * DM, mrows, DM, DM, NIN, DM}; pg8::EpiMerge<1> E{P + CGT + DM, NIN, (bf16_t*)YF, HX};
              pg8::gemm_phase<pg8::EpiMerge<1>, pg8::MixOrder, true, true, true>(c.lds, g, S, E, c.wave); }
            { pg8::Gemm g{P + CBG, WO + (size_t)2 * DM * DM, mrows, DM, DM, NIN, DM}; pg8::EpiMerge<2> E{P + CGT + 2 * DM, NIN, (bf16_t*)YF, HX};
              pg8::gemm_phase<pg8::EpiMerge<2>, pg8::MixOrder, true, true, true>(c.lds, g, S, E, c.wave); }
            }
            if (l == 0 && early && c0.wg >= 32 && !dry) { { TAIL_BEGIN(); conv_transposes(c, 1, CV_WIN); } { TAIL_BEGIN(); conv_tables(c, 1, CV_PU); } }
        }
        SEAM(pb + 5);
        if (IN(pb + 6)) REPS(6) { { PH_BEGIN();
            pg8::Gemm g{HX, (const bf16_t*)(c.ws + WS_WOUT), mrows, DM, DM, DM, DM}; pg8::MixOrder S; S.init(mrows, c.G, c.wg);
            float* xl_ = dry ? YF : c.out; float* xc_ = dry ? YF + (size_t)MLAT * DM : (float*)(c.ws + WS_CTXS);
            const float* sl_ = xl_; const float* sc_ = xc_;
            if (l == 0 && !dry) { GET_IN(); sl_ = INP(I_X); sc_ = INP(I_CTX); }
            pg8::EpiResid E{xl_, xc_, (const float*)(c.ws + WS_MOD) + (size_t)l * 3 * NMOD + 2 * DM, sl_, sc_};
            pg8::gemm_phase<pg8::EpiResid, pg8::MixOrder, true, true, true>(c.lds, g, S, E, c.wave);
            }
            if (l == 0 && early && c0.wg >= 32 && !dry) { { TAIL_BEGIN(); conv_units(c, 1); } { TAIL_BEGIN(); conv_transposes(c, 1, CV_WO); } }
        }
        SEAM(pb + 6);
        if (IN(pb + 7)) REPS(7) { PH_BEGIN(); phase_norm(c, l, mrows, SP_NFFN, 3); }
        SEAM(pb + 7);
        if (IN(pb + 8)) REPS(8) { { PH_BEGIN();
            pg8::Gemm g{HX, (const bf16_t*)(c.ws + ws_wsc(l)), mrows, DM, DM, DM, DM}; pg8::MixOrder S; S.init(mrows, c.G, c.wg);
            pg8::EpiF32 E{(float*)(c.ws + WS_P), DM};
            pg8::gemm_phase<pg8::EpiF32, pg8::MixOrder, true, true, true>(c.lds, g, S, E, c.wave);
            }
            if (l == 0 && early && c0.wg >= 32 && !dry) { { TAIL_BEGIN(); conv_transposes(c, 1, CV_WOUT); } { TAIL_BEGIN(); conv_tables(c, 1, CV_PV | CV_LRU); } { TAIL_BEGIN(); conv_small(c, 1); } }
        }
        SEAM(pb + 8);
        if (IN(pb + 9)) REPS(9) {
            { PH_BEGIN(); phase_peer(c, l, mrows, dry); } xcd_barrier(bar, c0.wave);
            { PH_BEGIN(); phase_peer_v(c, l, mrows, dry); } }
        SEAM(pb + 9);
    }
#undef IN
#undef SEAM
}

extern "C" void kernel_launch(void* const* d_in, const int* in_sizes, int n_in, void* d_out, int out_size, void* d_ws, size_t ws_size, hipStream_t stream) {
    static int grid = 0;
    if (grid == 0) {
        if (n_in != 29 || in_sizes[0] != MLAT * DM || out_size != MLAT * DM || ws_size < WS_END) {
            fprintf(stderr, "kernel_launch: built for 29 inputs, x/out of %d floats, >= %zu bytes of workspace; got n_in %d, in0 %d, out %d, ws %zu; nothing launched\n", MLAT * DM, (size_t)WS_END, n_in, n_in > 0 ? in_sizes[0] : -1, out_size, ws_size);
            grid = -1; return; }
        int dev = 0, cus = 0, per_cu = 0;
        if (hipGetDevice(&dev) != hipSuccess || hipDeviceGetAttribute(&cus, hipDeviceAttributeMultiprocessorCount, dev) != hipSuccess) { fprintf(stderr, "kernel_launch: device query failed\n"); grid = -1; return; }
        if (hipFuncSetAttribute((const void*)mk_fwd, hipFuncAttributeMaxDynamicSharedMemorySize, LDS_BYTES) != hipSuccess) { fprintf(stderr, "kernel_launch: hipFuncSetAttribute failed\n"); grid = -1; return; }
        if (hipOccupancyMaxActiveBlocksPerMultiprocessor(&per_cu, (const void*)mk_fwd, NTHREADS, LDS_BYTES) != hipSuccess || per_cu < 1)
            fprintf(stderr, "kernel_launch: note: occupancy query reports %d workgroups per CU\n", per_cu);
        (void)hipGetLastError();
        grid = cus;
    }
    if (grid < 0) return;
    if (hipMemsetAsync((char*)d_ws + WS_CTL, 0, CTL_ZERO_BYTES, stream) != hipSuccess) { fprintf(stderr, "kernel_launch: memset failed\n"); return; }
    Args a{};
    for (int i = 0; i < 29; ++i) a.in[i] = (const float*)d_in[i];
    a.out = (float*)d_out; a.ws = (unsigned char*)d_ws;
#if MK_N_LAUNCHES == 1
    a.ph_lo = 0; a.ph_hi = N_PHASES;
    hipLaunchKernelGGL(mk_fwd, dim3(grid), dim3(NTHREADS), LDS_BYTES, stream, a);
#else
    for (int k = 0; k < N_PHASES; ++k) { a.ph_lo = k; a.ph_hi = k + 1; hipLaunchKernelGGL(mk_fwd, dim3(grid), dim3(NTHREADS), LDS_BYTES, stream, a); }
#endif
    const hipError_t le = hipPeekAtLastError();
    if (le != hipSuccess) fprintf(stderr, "kernel_launch: launch failed: %s\n", hipGetErrorName(le));
}
```

```cpp
#include <hip/hip_runtime.h>
#include <cstdio>
#include <cstdint>

#ifndef MK_N_LAUNCHES
#define MK_N_LAUNCHES 1
#endif
#if MK_N_LAUNCHES != 1
#error "the PEER phase carries a grid barrier of its own: this kernel is one launch only"
#endif

#define GAS __attribute__((address_space(1)))
#define LAS __attribute__((address_space(3)))
typedef unsigned short bf16_t;
typedef short bf16x8 __attribute__((ext_vector_type(8)));
typedef short s16x4 __attribute__((ext_vector_type(4)));
typedef float f32x2 __attribute__((ext_vector_type(2)));
typedef _Float16 h16x2 __attribute__((ext_vector_type(2)));
typedef float f32x4 __attribute__((ext_vector_type(4)));
typedef float f32x8 __attribute__((ext_vector_type(8)));
typedef float f32x16 __attribute__((ext_vector_type(16)));
typedef unsigned u32x2 __attribute__((ext_vector_type(2)));
typedef unsigned u32x4 __attribute__((ext_vector_type(4)));
typedef int i32x4 __attribute__((ext_vector_type(4)));

constexpr int DM = 2048, NB = 2, SEQ = 8192, NLAYER = 2, CTXL = 256;
constexpr int MLAT = NB * SEQ, MCTX = NB * CTXL, MALL = MLAT + MCTX;
constexpr int NIN = 19456;
constexpr int CQ = 0, CK = 2048, CV = 2560, CLX = 3072, CLG = 5120, CBG = 7168, CCG = 9216, CU = 11264, CGT = 13312;
constexpr int NKEY = SEQ + CTXL;
constexpr int NCHUNK = NKEY / 64;
constexpr int NMOD = 6 * DM;
constexpr float EPS = 1e-6f;
constexpr int NWAVES = 8, NTHREADS = 512;

constexpr size_t MiB = 1u << 20;
constexpr size_t al256(size_t x) { return (x + 255) / 256 * 256; }
constexpr size_t WS_CTL = 0, CTL_ZERO_BYTES = 1 * MiB;
constexpr size_t WS_MOD = WS_CTL + CTL_ZERO_BYTES;
constexpr size_t WS_ROPE = WS_MOD + al256((size_t)NLAYER * 3 * NMOD * 4);
constexpr size_t WS_SP = WS_ROPE + al256(2 * 128 * 32 * 4);
constexpr size_t WS_CTXS = WS_SP + al256(36864 * 4);
constexpr size_t WS_LSUM = WS_CTXS + al256((size_t)MCTX * DM * 4);
constexpr size_t WS_WLRU = WS_LSUM + al256((size_t)2 * 2 * NB * NCHUNK * DM * 4);
constexpr size_t WS_KC = WS_WLRU + al256((size_t)16 * 512 * 128 * 2);
constexpr size_t WS_VC = WS_KC + al256((size_t)NB * 4 * NKEY * 128 * 2);
constexpr size_t WS_WIN = WS_VC + al256((size_t)NB * 4 * NKEY * 128 * 2);
constexpr size_t WS_CMAX = WS_WIN + (size_t)NIN * DM;
constexpr size_t WS_WDQ = WS_CMAX + al256((size_t)2 * 32 * NIN * 4);
constexpr size_t WS_ADQ = WS_WDQ + al256((size_t)NIN * 4);
constexpr size_t WS_WO = WS_WIN + al256((size_t)NIN * DM * 2);
constexpr size_t WS_WOUT = WS_WO + al256((size_t)3 * DM * DM * 2);
constexpr size_t WS_WSC = WS_WOUT + al256((size_t)DM * DM * 2);
constexpr size_t WS_PU = WS_WSC + al256((size_t)DM * DM * 2);
constexpr size_t WS_PV = WS_PU + al256((size_t)16384 * DM);
constexpr size_t WS_HX = WS_PV + al256((size_t)16384 * DM);
constexpr size_t WS_YF = WS_HX + al256((size_t)MALL * DM * 2);
constexpr size_t WS_P = WS_YF + al256((size_t)MALL * DM * 4);
static_assert(WS_ADQ + (size_t)MALL * 4 <= WS_WO, "the int8 side tables must fit the spare half of the w_in region");
constexpr size_t WS_PU2 = WS_P + al256((size_t)MALL * NIN * 2);
constexpr size_t WS_PV2 = WS_PU2 + al256((size_t)16384 * DM);
constexpr size_t WS_WSC2 = WS_PV2 + al256((size_t)16384 * DM);
constexpr size_t WS_USC = WS_WSC2 + al256((size_t)DM * DM * 2);
constexpr size_t WS_END = WS_USC + al256((size_t)2 * 16384 * 4);
__host__ __device__ constexpr size_t ws_pu(int l) { return l ? WS_PU2 : WS_PU; }
__host__ __device__ constexpr size_t ws_pv(int l) { return l ? WS_PV2 : WS_PV; }
__host__ __device__ constexpr size_t ws_wsc(int l) { return l ? WS_WSC2 : WS_WSC; }

constexpr int SP_NMIX = 0, SP_NFFN = 2048, SP_QN = 4096, SP_KN = 4224, SP_LCW = 4352, SP_LCB = 12544, SP_LBA = 14592, SP_LBX = 18688, SP_LSP = 22784, SP_SCW = 26880, SP_SCB = 33024, SP_END = 35072;

constexpr int LDS_BYTES = 147456;
constexpr int MISC_OFF = 147456 - 256;
constexpr int LDS_WORK = MISC_OFF;

__device__ __forceinline__ unsigned cvt_pk_bf16(float lo, float hi) { unsigned r; asm volatile("v_cvt_pk_bf16_f32 %0, %1, %2" : "=v"(r) : "v"(lo), "v"(hi)); return r; }
__device__ __forceinline__ unsigned pk4_i8(float a, float b, float c, float d) {
    const int ia = (int)__builtin_rintf(a), ib = (int)__builtin_rintf(b), ic = (int)__builtin_rintf(c), id = (int)__builtin_rintf(d);
    return ((unsigned)ia & 255u) | (((unsigned)ib & 255u) << 8) | (((unsigned)ic & 255u) << 16) | ((unsigned)id << 24); }
__device__ __forceinline__ float bf_lo(unsigned w) { return __uint_as_float(w << 16); }
__device__ __forceinline__ float bf_hi(unsigned w) { return __uint_as_float(w & 0xffff0000u); }
__device__ __forceinline__ float bf1(bf16_t h) { return __uint_as_float(((unsigned)h) << 16); }
__device__ __forceinline__ bf16_t f2bf(float f) { return (bf16_t)(cvt_pk_bf16(f, 0.f) & 0xffffu); }
__device__ __forceinline__ float sigmoidf_(float x) { return __builtin_amdgcn_rcpf(1.f + __expf(-x)); }
__device__ __forceinline__ float gelu_tanh(float x) { const float z = 0.7978845608028654f * (x + 0.044715f * x * x * x); const float e = __expf(2.f * z); return 0.5f * x * (2.f - 2.f * __builtin_amdgcn_rcpf(e + 1.f)); }
__device__ __forceinline__ float wave_sum(float v) {
#pragma unroll
    for (int o = 1; o < 64; o <<= 1) v += __shfl_xor(v, o);
    return v;
}
__device__ __forceinline__ float wave_max(float v) {
#pragma unroll
    for (int o = 1; o < 64; o <<= 1) v = fmaxf(v, __shfl_xor(v, o));
    return v;
}
template <class T> __device__ __forceinline__ T* as_global(T* p) { return (T*)(GAS T*)p; }
__device__ __forceinline__ int lane_id_fresh() { int l; asm volatile("v_mbcnt_lo_u32_b32 %0, -1, 0\n\tv_mbcnt_hi_u32_b32 %0, -1, %0" : "=v"(l)); return l; }
#define DPPF(v, ctrl) __int_as_float(__builtin_amdgcn_update_dpp(0, __float_as_int(v), ctrl, 0xF, 0xF, true))
#define LDS_WAIT() asm volatile("s_waitcnt lgkmcnt(0)" ::: "memory")
#define VM_WAIT() asm volatile("s_waitcnt vmcnt(0)" ::: "memory")

#define XB_TMO      128
#define XB_XCNT(j)  (256  + 64 * (j))
#define XB_XSUB(j)  (1280 + 64 * (j))
#define XB_XGEN(j)  (2304 + 64 * (j))
#define XB_TOP      3328
#define XB_TOPGEN   3392
#define XCD_BAR_WORDS 3456
#define XB_SPIN_CAP (1u << 23)
__device__ __forceinline__ unsigned xb_ld(unsigned* p)              { return __hip_atomic_load(p, __ATOMIC_RELAXED, __HIP_MEMORY_SCOPE_AGENT); }
__device__ __forceinline__ unsigned xb_add(unsigned* p, unsigned v) { return __hip_atomic_fetch_add(p, v, __ATOMIC_RELAXED, __HIP_MEMORY_SCOPE_AGENT); }
__device__ __forceinline__ unsigned xb_xcc_id() { return (unsigned)__builtin_amdgcn_s_getreg((3 << 11) | 20) & 0xFu; }
#define XB_SPIN(cond, bar) do { unsigned _sp = 0; while (cond) { __builtin_amdgcn_s_sleep(1); \
    if ((++_sp & 255u) == 0u) { if (xb_ld(&(bar)[XB_TMO])) break; if (_sp > XB_SPIN_CAP) { atomicAdd(&(bar)[XB_TMO], 1u); break; } } } } while (0)
struct XcdBarrier { unsigned* bar; unsigned x; volatile LAS unsigned* st; };
__device__ __forceinline__ XcdBarrier xcd_barrier_post(unsigned* bar, volatile LAS unsigned* st) {
    XcdBarrier b; b.bar = bar; b.x = xb_xcc_id(); b.st = st;
    if (threadIdx.x == 0) (void)xb_add(&bar[XB_XCNT(b.x)], 1u);
    return b;
}
__device__ __forceinline__ void xcd_barrier_complete(unsigned* bar, unsigned x, unsigned& nloc, unsigned& nx) {
    const unsigned G = gridDim.x * gridDim.y * gridDim.z;
    unsigned sum, cnt, mine, sp = 0u;
    for (;;) {
        sum = 0u; cnt = 0u; mine = 0u;
#pragma unroll
        for (unsigned j = 0; j < 16; ++j) { const unsigned c = xb_ld(&bar[XB_XCNT(j)]); sum += c; cnt += (c > 0u) ? 1u : 0u; mine = (j == x) ? c : mine; }
        if (sum == G) break;
        __builtin_amdgcn_s_sleep(1);
        if ((++sp & 255u) == 0u) { if (xb_ld(&bar[XB_TMO])) break; if (sp > XB_SPIN_CAP) { atomicAdd(&bar[XB_TMO], 1u); break; } }
    }
    nloc = mine > 0u ? mine : 1u; nx = cnt > 0u ? cnt : 1u;
}
__device__ __forceinline__ void xcd_barrier(const XcdBarrier& b, int wave) {
    asm volatile("s_waitcnt vmcnt(0)" ::: "memory");
    __syncthreads();
    if (wave == 0 && lane_id_fresh() == 0) {
        unsigned* bar = b.bar;
        __builtin_amdgcn_s_waitcnt(0);
        unsigned nloc = b.st[0], nx = b.st[1];
        if (nloc == 0u) { xcd_barrier_complete(bar, b.x, nloc, nx); b.st[0] = nloc; b.st[1] = nx; }
        const unsigned old = xb_add(&bar[XB_XSUB(b.x)], 1u);
        const unsigned gen = old / nloc;
        if (old + 1u == (gen + 1u) * nloc) {
            __builtin_amdgcn_fence(__ATOMIC_RELEASE, "agent");
            asm volatile("s_waitcnt vmcnt(0)" ::: "memory");
            const unsigned og = xb_add(&bar[XB_TOP], 1u);
            const unsigned tg = og / nx;
            if (og + 1u == (tg + 1u) * nx) xb_add(&bar[XB_TOPGEN], 1u);
            else XB_SPIN(xb_ld(&bar[XB_TOPGEN]) == tg, bar);
            __builtin_amdgcn_fence(__ATOMIC_ACQUIRE, "agent");
            xb_add(&bar[XB_XGEN(b.x)], 1u);
            asm volatile("s_waitcnt vmcnt(0)" ::: "memory");
        } else {
            XB_SPIN(xb_ld(&bar[XB_XGEN(b.x)]) == gen, bar);
            __builtin_amdgcn_fence(__ATOMIC_ACQUIRE, "agent");
            asm volatile("s_waitcnt vmcnt(0)" ::: "memory");
        }
    }
    __syncthreads();
}
#ifndef MIX_WGM
#define MIX_WGM 8
#endif
namespace pg8 {
#define PG8_LAS __attribute__((address_space(3)))
constexpr int BM = 256, BK = 64, HALF = 128, HTB = HALF * BK * 2, STAGE_BYTES = 8 * HTB, NXCD = 8, WGM = 8;
__host__ __device__ __forceinline__ int lds_byte(int r, int c) { const int st = (r >> 4) * 2 + (c >> 5), rr = r & 15, cc = c & 31, ob = rr * 64 + cc * 2; return st * 1024 + (ob ^ (((ob >> 9) & 1) << 5)); }
__host__ __device__ __forceinline__ void stage_rc(int b, int& R, int& C) { const int st = b / 1024, sb = b % 1024, swz = sb ^ (((sb >> 9) & 1) << 5); R = (st >> 1) * 16 + swz / 64; C = (st & 1) * 32 + (swz % 64) / 2; }
__host__ __device__ __forceinline__ int perm32(int rho) { const int n = rho >> 4, i = rho & 15; return 8 * (i >> 2) + 4 * n + (i & 3); }

struct Unit { int pm, pn, nh; };
struct Gemm { const bf16_t* A; const bf16_t* Bt; int M, N, K, lda, ldb; };

struct StaticOrder {
    int nM, nN, nwg, G, c, wgm = WGM;
    __host__ __device__ void init(int M, int N, int G_, int c_, int wgm_ = WGM) { nM = M / BM; nN = N / BM; nwg = nM * nN; G = G_; c = c_; wgm = wgm_; }
    __host__ __device__ bool next(int i, Unit& u) const {
        const long L = (long)i * G + c; if (L >= nwg) return false;
        int wgid = (int)L; { const int q = nwg / NXCD, r = nwg % NXCD, xcd = wgid % NXCD, off = wgid / NXCD; wgid = (xcd < r ? xcd * (q + 1) : r * (q + 1) + (xcd - r) * q) + off; }
        const int nig = wgm * nN, gid = wgid / nig, fm = gid * wgm, gsz = (nM - fm) < wgm ? (nM - fm) : wgm;
        u.pm = 2 * (fm + ((wgid % nig) % gsz)); u.pn = (wgid % nig) / gsz; u.nh = 2; return true;
    }
    __device__ __forceinline__ void a_ready(const Unit&) const {}
    __device__ __forceinline__ void done(const Unit&) const {}
};

struct MixOrder {
    StaticOrder lat; int nhalf;
    __host__ __device__ void init(int mrows, int G_, int c_) { lat.init(MLAT, 2048, G_, c_, MIX_WGM); nhalf = ((mrows - MLAT) / HALF) * 8; }
    __host__ __device__ bool next(int i, Unit& u) const {
        if (lat.next(i, u)) return true;
        const long h = (long)i * lat.G + lat.c - lat.nwg; if (h < 0 || h >= nhalf) return false;
        u.pm = MLAT / HALF + (int)(h >> 3); u.pn = (int)(h & 7); u.nh = 1; return true;
    }
    __device__ __forceinline__ void a_ready(const Unit&) const {}
    __device__ __forceinline__ void done(const Unit&) const {}
};

struct EpiBf16 {
    static constexpr bool PERM = true, AFTER_DRAIN = false;
    bf16_t* O; int ldc;
    __device__ __forceinline__ void operator()(const f32x4 (&acc)[2][2][4][2], const Unit& u, int wr, int wc, int fr, int fq) const {
        const int row0 = u.pm * HALF + wr * 64 + fr, col0 = u.pn * BM + wc * 32 + 8 * fq;
#pragma unroll
        for (int ai = 0; ai < 2; ++ai) if (ai < u.nh)
#pragma unroll
            for (int m = 0; m < 4; ++m) { bf16_t* rowp = O + (size_t)(row0 + ai * HALF + m * 16) * ldc + col0;
#pragma unroll
                for (int bj = 0; bj < 2; ++bj) { const f32x4 v0 = acc[ai][bj][m][0], v1 = acc[ai][bj][m][1];
                    u32x4 w; w.x = cvt_pk_bf16(v0[0], v0[1]); w.y = cvt_pk_bf16(v0[2], v0[3]); w.z = cvt_pk_bf16(v1[0], v1[1]); w.w = cvt_pk_bf16(v1[2], v1[3]);
                    *(u32x4*)(rowp + bj * HALF) = w; } }
    }
};
struct EpiI8 {
    static constexpr bool PERM = true, AFTER_DRAIN = false;
    bf16_t* O; int ldc; const float* rstep; const float* cstep;
    __device__ __forceinline__ void operator()(const f32x4 (&acc)[2][2][4][2], const Unit& u, int wr, int wc, int fr, int fq) const {
        const int row0 = u.pm * HALF + wr * 64 + fr, col0 = u.pn * BM + wc * 32 + 8 * fq;
        f32x4 cs[2][2];
#pragma unroll
        for (int bj = 0; bj < 2; ++bj) { cs[bj][0] = *(const f32x4*)(cstep + col0 + bj * HALF); cs[bj][1] = *(const f32x4*)(cstep + col0 + bj * HALF + 4); }
#pragma unroll
        for (int ai = 0; ai < 2; ++ai) if (ai < u.nh)
#pragma unroll
            for (int m = 0; m < 4; ++m) { const int r = row0 + ai * HALF + m * 16; bf16_t* rowp = O + (size_t)r * ldc + col0; const float rs = rstep[r];
#pragma unroll
                for (int bj = 0; bj < 2; ++bj) {
                    const f32x4 v0 = __builtin_convertvector(__builtin_bit_cast(i32x4, acc[ai][bj][m][0]), f32x4) * (cs[bj][0] * rs), v1 = __builtin_convertvector(__builtin_bit_cast(i32x4, acc[ai][bj][m][1]), f32x4) * (cs[bj][1] * rs);
                    u32x4 w; w.x = cvt_pk_bf16(v0[0], v0[1]); w.y = cvt_pk_bf16(v0[2], v0[3]); w.z = cvt_pk_bf16(v1[0], v1[1]); w.w = cvt_pk_bf16(v1[2], v1[3]);
                    *(u32x4*)(rowp + bj * HALF) = w; } }
    }
};
struct EpiF32 {
    static constexpr bool PERM = false, AFTER_DRAIN = false;
    float* C; int ldc;
    __device__ __forceinline__ void operator()(const f32x4 (&acc)[2][2][4][2], const Unit& u, int wr, int wc, int fr, int fq) const {
        const int row0 = u.pm * HALF + wr * 64 + fr, col0 = u.pn * BM + wc * 32 + 4 * fq;
#pragma unroll
        for (int ai = 0; ai < 2; ++ai) if (ai < u.nh)
#pragma unroll
            for (int m = 0; m < 4; ++m) { float* rowp = C + (size_t)(row0 + ai * HALF + m * 16) * ldc + col0;
#pragma unroll
                for (int bj = 0; bj < 2; ++bj)
#pragma unroll
                    for (int n = 0; n < 2; ++n) *(f32x4*)(rowp + bj * HALF + n * 16) = acc[ai][bj][m][n]; }
    }
};
template <int MODE> struct EpiMerge {
    static constexpr bool PERM = true, AFTER_DRAIN = false;
    const bf16_t* Gt; int ldg; bf16_t* Y; bf16_t* YB;
    __device__ __forceinline__ void operator()(const f32x4 (&acc)[2][2][4][2], const Unit& u, int wr, int wc, int fr, int fq) const {
        const int row0 = u.pm * HALF + wr * 64 + fr, col0 = u.pn * BM + wc * 32 + 8 * fq;
#pragma unroll
        for (int ai = 0; ai < 2; ++ai) if (ai < u.nh)
#pragma unroll
            for (int m = 0; m < 4; ++m) { const size_t r = (size_t)(row0 + ai * HALF + m * 16);
#pragma unroll
                for (int bj = 0; bj < 2; ++bj) { const int c = col0 + bj * HALF;
                    const u32x4 gw = *(const u32x4*)(Gt + r * ldg + c);
                    f32x4 g0, g1;
                    g0[0] = sigmoidf_(bf_lo(gw.x)); g0[1] = sigmoidf_(bf_hi(gw.x)); g0[2] = sigmoidf_(bf_lo(gw.y)); g0[3] = sigmoidf_(bf_hi(gw.y));
                    g1[0] = sigmoidf_(bf_lo(gw.z)); g1[1] = sigmoidf_(bf_hi(gw.z)); g1[2] = sigmoidf_(bf_lo(gw.w)); g1[3] = sigmoidf_(bf_hi(gw.w));
                    f32x4 y0 = g0 * acc[ai][bj][m][0], y1 = g1 * acc[ai][bj][m][1];
                    if (MODE != 0) { const u32x4 yw = *(const u32x4*)(Y + r * 2048 + c);
                        y0 += (f32x4){bf_lo(yw.x), bf_hi(yw.x), bf_lo(yw.y), bf_hi(yw.y)}; y1 += (f32x4){bf_lo(yw.z), bf_hi(yw.z), bf_lo(yw.w), bf_hi(yw.w)}; }
                    u32x4 w; w.x = cvt_pk_bf16(y0[0], y0[1]); w.y = cvt_pk_bf16(y0[2], y0[3]); w.z = cvt_pk_bf16(y1[0], y1[1]); w.w = cvt_pk_bf16(y1[2], y1[3]);
                    *(u32x4*)((MODE != 2 ? Y : YB) + r * 2048 + c) = w; } }
    }
};
struct EpiResid {
    static constexpr bool PERM = true, AFTER_DRAIN = false;
    float* xlat; float* xctx; const float* gate;
    const float* slat; const float* sctx;
    __device__ __forceinline__ void operator()(const f32x4 (&acc)[2][2][4][2], const Unit& u, int wr, int wc, int fr, int fq) const {
        const int vec = u.pm < 64 ? 0 : (u.pm < 128 ? 1 : 2);
        float* xb = u.pm < 128 ? xlat + (size_t)u.pm * HALF * 2048 : xctx + (size_t)(u.pm - 128) * HALF * 2048;
        const float* sb = u.pm < 128 ? slat + (size_t)u.pm * HALF * 2048 : sctx + (size_t)(u.pm - 128) * HALF * 2048;
        const int lrow0 = wr * 64 + fr, col0 = u.pn * BM + wc * 32 + 8 * fq;
        const float* gp = gate + (size_t)vec * 12288 + col0;
#pragma unroll
        for (int bj = 0; bj < 2; ++bj) { const f32x4 g0 = *(const f32x4*)(gp + bj * HALF), g1 = *(const f32x4*)(gp + bj * HALF + 4);
#pragma unroll
            for (int ai = 0; ai < 2; ++ai) if (ai < u.nh)
#pragma unroll
                for (int m = 0; m < 4; ++m) { const size_t off = (size_t)(lrow0 + ai * HALF + m * 16) * 2048 + col0 + bj * HALF; float* xp = xb + off; const float* sp = sb + off;
                    const f32x4 x0 = *(const f32x4*)sp + g0 * acc[ai][bj][m][0], x1 = *(const f32x4*)(sp + 4) + g1 * acc[ai][bj][m][1];
                    *(f32x4*)xp = x0; *(f32x4*)(xp + 4) = x1; } }
    }
};

template <class Epi, class Sched, bool ALIGN_EPI = false, bool SP2 = false, bool HALFU = false, bool I8 = false>
__device__ __forceinline__ void gemm_phase(PG8_LAS unsigned char* lds, const Gemm g, const Sched& S, const Epi& E, int wave_) {
    int tid_ = wave_ * 64 + lane_id_fresh();
    const int tid = tid_, wid = __builtin_amdgcn_readfirstlane(tid >> 6), lane = tid & 63, wr = wid >> 2, wc = wid & 3, fr = lane & 15, fq = lane >> 4;
    constexpr int ES = I8 ? 1 : 2;
    const int K = g.K, nt = K * ES / (BK * 2);
    unsigned voffA[2], voffB[2];
#pragma unroll
    for (int i = 0; i < 2; ++i) { int R, C; stage_rc(tid * 16 + i * 8192, R, C); const int Rb = Epi::PERM ? ((R & ~31) + perm32(R & 31)) : R;
        voffA[i] = (unsigned)(R * g.lda * ES + C * 2); voffB[i] = (unsigned)(Rb * g.ldb * ES + C * 2); }
    const size_t kstep = (size_t)(BK * 2);
    const size_t hstepA = (size_t)HALF * g.lda * ES, hstepB = (size_t)HALF * g.ldb * ES;
    const size_t tstepB = 2 * hstepB;
    const unsigned ldsw = (unsigned)wid * 1024u;
    const int aoff = lds_byte(wr * 64 + fr, fq * 8), boff = lds_byte(wc * 32 + fr, fq * 8);
#define PG8_SA(b, h) (((b) * 2 + (h)) * HTB)
#define PG8_SB(b, h) ((4 + (b) * 2 + (h)) * HTB)
#define PG8_STAGE(bufoff, gbase, voff) do { _Pragma("unroll") for (int _i = 0; _i < 2; ++_i) \
        __builtin_amdgcn_global_load_lds((const unsigned*)((const char*)(gbase) + (voff)[_i]), (PG8_LAS unsigned*)(lds + (bufoff) + ldsw + _i * 8192), 16, 0, 0); } while (0)
#define PG8_LDA(dst, b, h) do { _Pragma("unroll") for (int m = 0; m < 4; ++m) _Pragma("unroll") for (int k = 0; k < 2; ++k) dst[m][k] = *(const PG8_LAS bf16x8*)(lds + PG8_SA(b, h) + aoff + m * 2048 + k * 1024); } while (0)
#define PG8_LDB(dst, b, h) do { _Pragma("unroll") for (int n = 0; n < 2; ++n) _Pragma("unroll") for (int k = 0; k < 2; ++k) dst[n][k] = *(const PG8_LAS bf16x8*)(lds + PG8_SB(b, h) + boff + n * 2048 + k * 1024); } while (0)
#define PG8_MMA(ai, bj, At, Bt) do { __builtin_amdgcn_s_setprio(1); _Pragma("unroll") for (int m = 0; m < 4; ++m) _Pragma("unroll") for (int n = 0; n < 2; ++n) _Pragma("unroll") for (int k = 0; k < 2; ++k) \
        { if constexpr (I8) acc[ai][bj][m][n] = __builtin_bit_cast(f32x4, __builtin_amdgcn_mfma_i32_16x16x64_i8(__builtin_bit_cast(i32x4, Bt[n][k]), __builtin_bit_cast(i32x4, At[m][k]), __builtin_bit_cast(i32x4, acc[ai][bj][m][n]), 0, 0, 0)); \
          else acc[ai][bj][m][n] = __builtin_amdgcn_mfma_f32_16x16x32_bf16(Bt[n][k], At[m][k], acc[ai][bj][m][n], 0, 0, 0); } __builtin_amdgcn_s_setprio(0); } while (0)
#define PG8_WAIT_V(n) asm volatile("s_waitcnt vmcnt(" #n ")" ::: "memory")
#define PG8_WAIT_L(n) asm volatile("s_waitcnt lgkmcnt(" #n ")" ::: "memory")
#define PG8_BAR __builtin_amdgcn_s_barrier()
#define PG8_SCHED __builtin_amdgcn_sched_barrier(0)
    Unit cur, nxt; int ui = 0;
    if (!S.next(0, cur)) return;
    f32x4 acc[2][2][4][2];
#pragma unroll
    for (int a = 0; a < 2; ++a)
#pragma unroll
        for (int b = 0; b < 2; ++b)
#pragma unroll
            for (int m = 0; m < 4; ++m)
#pragma unroll
                for (int n = 0; n < 2; ++n) acc[a][b][m][n] = (f32x4){0.f, 0.f, 0.f, 0.f};
    bf16x8 At[4][2], B0[2][2], B1[2][2];
    const char* cA = (const char*)g.A + (size_t)cur.pm * hstepA; const char* cB = (const char*)g.Bt + (size_t)cur.pn * tstepB;
    size_t chA = (!HALFU || cur.nh == 2) ? hstepA : 0;
    S.a_ready(cur);
    if constexpr (SP2) {
        PG8_STAGE(PG8_SB(0, 0), cB, voffB); PG8_STAGE(PG8_SB(0, 1), cB + hstepB, voffB); PG8_STAGE(PG8_SA(0, 0), cA, voffA); PG8_STAGE(PG8_SA(0, 1), cA + chA, voffA);
        if (wr == 1) PG8_BAR;
        PG8_WAIT_V(2); PG8_BAR;
        PG8_STAGE(PG8_SB(1, 0), cB + kstep, voffB); PG8_STAGE(PG8_SA(1, 0), cA + kstep, voffA); PG8_STAGE(PG8_SB(1, 1), cB + hstepB + kstep, voffB);
        PG8_WAIT_V(6); PG8_BAR;
    } else {
        PG8_STAGE(PG8_SB(0, 0), cB, voffB); PG8_STAGE(PG8_SA(0, 0), cA, voffA); PG8_STAGE(PG8_SB(0, 1), cB + hstepB, voffB); PG8_STAGE(PG8_SA(0, 1), cA + chA, voffA);
        if (wr == 1) PG8_BAR;
        PG8_WAIT_V(4); PG8_BAR;
        PG8_STAGE(PG8_SB(1, 0), cB + kstep, voffB); PG8_STAGE(PG8_SA(1, 0), cA + kstep, voffA); PG8_STAGE(PG8_SB(1, 1), cB + hstepB + kstep, voffB);
        PG8_WAIT_V(6); PG8_BAR;
    }
    for (;;) {
        const bool has_next = S.next(ui + 1, nxt);
        const char* nA = has_next ? (const char*)g.A + (size_t)nxt.pm * hstepA : cA; const size_t nhA = has_next ? ((!HALFU || nxt.nh == 2) ? hstepA : 0) : chA; const bool full = (!HALFU || cur.nh == 2);
        const char* nA_ = nA; (void)nA_; const char* nB = has_next ? (const char*)g.Bt + (size_t)nxt.pn * tstepB : cB;
        for (int t = 0; t < nt; t += 2) {
            const bool last = (t == nt - 2);
            const char* a1 = cA + (size_t)(t + 1) * kstep;
            const char* a2 = last ? nA : cA + (size_t)(t + 2) * kstep; const char* b2 = last ? nB : cB + (size_t)(t + 2) * kstep;
            const char* a3 = a2 + kstep; const char* b3 = b2 + kstep;
            const size_t h2A = last ? nhA : chA;
            if (last && has_next) S.a_ready(nxt);
            if constexpr (SP2) {
            PG8_LDB(B0, 0, 0); PG8_LDB(B1, 0, 1); PG8_SCHED; PG8_LDA(At, 0, 0); PG8_STAGE(PG8_SA(1, 1), a1 + chA, voffA);
            PG8_WAIT_V(8); PG8_WAIT_L(0); PG8_BAR; PG8_MMA(0, 0, At, B0); PG8_MMA(0, 1, At, B1); PG8_BAR; PG8_SCHED;
            PG8_LDA(At, 0, 1); PG8_STAGE(PG8_SB(0, 0), b2, voffB); PG8_STAGE(PG8_SB(0, 1), b2 + hstepB, voffB); PG8_STAGE(PG8_SA(0, 0), a2, voffA);
            PG8_WAIT_V(8); PG8_WAIT_L(0); PG8_BAR; if (full) { PG8_MMA(1, 0, At, B0); PG8_MMA(1, 1, At, B1); } PG8_BAR; PG8_SCHED;
            PG8_LDB(B0, 1, 0); PG8_LDB(B1, 1, 1); PG8_SCHED; PG8_LDA(At, 1, 0); PG8_STAGE(PG8_SA(0, 1), a2 + h2A, voffA);
            PG8_WAIT_V(8); PG8_WAIT_L(0); PG8_BAR; PG8_MMA(0, 0, At, B0); PG8_MMA(0, 1, At, B1); PG8_BAR; PG8_SCHED;
            PG8_LDA(At, 1, 1); PG8_STAGE(PG8_SB(1, 0), b3, voffB); PG8_STAGE(PG8_SB(1, 1), b3 + hstepB, voffB); PG8_STAGE(PG8_SA(1, 0), a3, voffA);
            PG8_WAIT_V(8); PG8_WAIT_L(0); PG8_BAR; if (full) { PG8_MMA(1, 0, At, B0); PG8_MMA(1, 1, At, B1); } PG8_BAR; PG8_SCHED;
            } else {
            PG8_LDB(B0, 0, 0); PG8_SCHED; PG8_LDA(At, 0, 0); PG8_STAGE(PG8_SA(1, 1), a1 + chA, voffA);
            PG8_WAIT_L(8); PG8_BAR; PG8_WAIT_L(0); PG8_MMA(0, 0, At, B0); PG8_BAR; PG8_SCHED;
            PG8_LDB(B1, 0, 1); PG8_STAGE(PG8_SB(0, 0), b2, voffB);
            PG8_BAR; PG8_WAIT_L(0); PG8_MMA(0, 1, At, B1); PG8_BAR;
            PG8_LDA(At, 0, 1); PG8_STAGE(PG8_SA(0, 0), a2, voffA);
            PG8_BAR; PG8_WAIT_L(0); if (full) PG8_MMA(1, 0, At, B0); PG8_BAR; PG8_SCHED;
            PG8_STAGE(PG8_SB(0, 1), b2 + hstepB, voffB);
            PG8_WAIT_V(6); PG8_BAR; if (full) PG8_MMA(1, 1, At, B1); PG8_BAR;
            PG8_LDB(B0, 1, 0); PG8_SCHED; PG8_LDA(At, 1, 0); PG8_STAGE(PG8_SA(0, 1), a2 + h2A, voffA);
            PG8_WAIT_L(8); PG8_BAR; PG8_WAIT_L(0); PG8_MMA(0, 0, At, B0); PG8_BAR; PG8_SCHED;
            PG8_LDB(B1, 1, 1); PG8_STAGE(PG8_SB(1, 0), b3, voffB);
            PG8_BAR; PG8_WAIT_L(0); PG8_MMA(0, 1, At, B1); PG8_BAR;
            PG8_LDA(At, 1, 1); PG8_STAGE(PG8_SA(1, 0), a3, voffA);
            PG8_BAR; PG8_WAIT_L(0); if (full) PG8_MMA(1, 0, At, B0); PG8_BAR; PG8_SCHED;
            PG8_STAGE(PG8_SB(1, 1), b3 + hstepB, voffB);
            PG8_WAIT_V(6); PG8_BAR; if (full) PG8_MMA(1, 1, At, B1); PG8_BAR;
            }
        }
        if constexpr (ALIGN_EPI) { if (wr == 0) PG8_BAR; }
        if constexpr (!Epi::AFTER_DRAIN) { E(acc, cur, wr, wc, fr, fq); S.done(cur); }
        if (!has_next) break;
#pragma unroll
        for (int a = 0; a < 2; ++a)
#pragma unroll
            for (int b = 0; b < 2; ++b)
#pragma unroll
                for (int m = 0; m < 4; ++m)
#pragma unroll
                    for (int n = 0; n < 2; ++n) acc[a][b][m][n] = (f32x4){0.f, 0.f, 0.f, 0.f};
        cur = nxt; cA = nA; cB = nB; chA = nhA; ++ui;
        if constexpr (ALIGN_EPI) { if (wr == 1) PG8_BAR; }
    }
    PG8_WAIT_V(0);
    if constexpr (!ALIGN_EPI) { if (wr == 0) PG8_BAR; }
    PG8_BAR;
#undef PG8_SA
#undef PG8_SB
#undef PG8_STAGE
#undef PG8_LDA
#undef PG8_LDB
#undef PG8_MMA
#undef PG8_WAIT_V
#undef PG8_WAIT_L
#undef PG8_BAR
#undef PG8_SCHED
}
}
namespace att {
constexpr int D = 128, NW = 8, QBLK = 32, KVBLK = 64;
constexpr float SCALE = 0.088388347648318440f;
constexpr float THR = 8.f;
constexpr int LDQ = NIN, LDK = 128, LDO = NIN;
constexpr size_t SHM_V = KVBLK * D * 2, SHM_K = KVBLK * D * 2, SHM_ATTN = 2 * SHM_V + 2 * SHM_K + NW * 64 * 4;
#define KSWZ(row, colB) ((row) * 256 + ((colB) ^ (((row) & 7) << 4)))
#define SBAR() __builtin_amdgcn_sched_barrier(0)
__device__ __forceinline__ int crow(int r, int hi) { return (r & 3) + 8 * (r >> 2) + 4 * hi; }
__device__ __forceinline__ unsigned cvtpk(float lo, float hi) { unsigned r; asm volatile("v_cvt_pk_bf16_f32 %0, %1, %2" : "=v"(r) : "v"(lo), "v"(hi)); return r; }
__device__ __forceinline__ bf16x8 ld8(const bf16_t* p) { return *reinterpret_cast<const bf16x8*>(p); }

__device__ __forceinline__ void partialSM(f32x16& p0, f32x16& p1, float& m_reg, float& mn, float& alpha) {
  constexpr float C = SCALE * 1.4426950408889634f;
  float pmax = p0[0];
#pragma unroll
  for (int r = 1; r < 16; ++r) pmax = fmaxf(pmax, p0[r]);
#pragma unroll
  for (int r = 0; r < 16; ++r) pmax = fmaxf(pmax, p1[r]);
  { auto rr = __builtin_amdgcn_permlane32_swap(__float_as_uint(pmax), __float_as_uint(pmax), false, false);
    pmax = fmaxf(__uint_as_float(rr[0]), __uint_as_float(rr[1])); }
  if (__builtin_expect(__all(pmax - m_reg <= THR / SCALE), 1)) { mn = m_reg; alpha = 1.f; }
  else { mn = fmaxf(m_reg, pmax); alpha = __builtin_amdgcn_exp2f((m_reg - mn) * C); m_reg = mn; }
  float mnC = -mn * C;
#pragma unroll
  for (int r = 0; r < 16; ++r) p0[r] = fmaf(p0[r], C, mnC);
#pragma unroll
  for (int r = 0; r < 16; ++r) p1[r] = fmaf(p1[r], C, mnC);
#pragma unroll
  for (int r = 0; r < 16; ++r) p0[r] = __builtin_amdgcn_exp2f(p0[r]);
}
__device__ __forceinline__ void finishSM(f32x16& p0, f32x16& p1, float alpha, float& l_reg, bf16x8& pa0, bf16x8& pa1, bf16x8& pa2, bf16x8& pa3) {
#pragma unroll
  for (int r = 0; r < 16; ++r) p1[r] = __builtin_amdgcn_exp2f(p1[r]);
  float ps = 0;
#pragma unroll
  for (int r = 0; r < 16; ++r) ps += p0[r];
#pragma unroll
  for (int r = 0; r < 16; ++r) ps += p1[r];
  { auto rr = __builtin_amdgcn_permlane32_swap(__float_as_uint(ps), __float_as_uint(ps), false, false);
    ps = __uint_as_float(rr[0]) + __uint_as_float(rr[1]); }
  l_reg = l_reg * alpha + ps;
#define PK4(P, BASE, OUT) do { unsigned a0 = cvtpk(P[BASE + 0], P[BASE + 1]), a1 = cvtpk(P[BASE + 2], P[BASE + 3]);   \
    unsigned b0 = cvtpk(P[BASE + 4], P[BASE + 5]), b1 = cvtpk(P[BASE + 6], P[BASE + 7]);                              \
    auto r0 = __builtin_amdgcn_permlane32_swap(a0, b0, false, false); auto r1 = __builtin_amdgcn_permlane32_swap(a1, b1, false, false); \
    u32x4 w = {r0[0], r1[0], r0[1], r1[1]}; OUT = *reinterpret_cast<bf16x8*>(&w); } while (0)
  PK4(p0, 0, pa0); PK4(p0, 8, pa1); PK4(p1, 0, pa2); PK4(p1, 8, pa3);
#undef PK4
}
__device__ __forceinline__ void qkt(f32x16& p0, f32x16& p1, const bf16_t* Ks, const bf16x8* qr, int r32, int hi) {
  p0 = f32x16{}; p1 = f32x16{};
#pragma unroll
  for (int d0 = 0; d0 < 8; ++d0) { int cb = (d0 * 16 + hi * 8) * 2;
    bf16x8 b0 = *reinterpret_cast<const bf16x8*>((const char*)Ks + KSWZ(r32, cb));
    bf16x8 b1 = *reinterpret_cast<const bf16x8*>((const char*)Ks + KSWZ(32 + r32, cb));
    p0 = __builtin_amdgcn_mfma_f32_32x32x16_bf16(b0, qr[d0], p0, 0, 0, 0);
    p1 = __builtin_amdgcn_mfma_f32_32x32x16_bf16(b1, qr[d0], p1, 0, 0, 0); }
}
__device__ __forceinline__ int v_st(int k, int c) { const int kk = (k & ~0xC) | ((k & 4) << 1) | ((k & 8) >> 1); return ((kk >> 3) * 4 + (c >> 5)) * 512 + ((kk & 7) * 32 + (c & 31)) * 2; }
__device__ __forceinline__ int v_rd_base(int lane) { return ((lane & 3) << 3) | (((lane >> 2) & 3) << 6) | (((lane >> 4) & 1) << 5) | (((lane >> 5) & 1) << 8); }
constexpr int v_rd_off(int d0, int ks, int half) { return d0 * 512 + ks * 4096 + half * 2048; }
template <int OFF> __device__ __forceinline__ s16x4 tr_read(int vb) {
  s16x4 r; asm volatile("ds_read_b64_tr_b16 %0, %1 offset:%2" : "=&v"(r) : "v"(vb), "i"(OFF) : "memory"); return r;
}
template <int D0> __device__ __forceinline__ void pv_one(f32x16& od, int vb, bf16x8 pa0, bf16x8 pa1, bf16x8 pa2, bf16x8 pa3) {
  const s16x4 l0 = tr_read<v_rd_off(D0, 0, 0)>(vb), h0 = tr_read<v_rd_off(D0, 0, 1)>(vb), l1 = tr_read<v_rd_off(D0, 1, 0)>(vb), h1 = tr_read<v_rd_off(D0, 1, 1)>(vb);
  const s16x4 l2 = tr_read<v_rd_off(D0, 2, 0)>(vb), h2 = tr_read<v_rd_off(D0, 2, 1)>(vb), l3 = tr_read<v_rd_off(D0, 3, 0)>(vb), h3 = tr_read<v_rd_off(D0, 3, 1)>(vb);
  asm volatile("s_waitcnt lgkmcnt(0)" ::: "memory"); SBAR();
#define PK(L, H) (bf16x8){L[0], L[1], L[2], L[3], H[0], H[1], H[2], H[3]}
  od = __builtin_amdgcn_mfma_f32_32x32x16_bf16(pa0, PK(l0, h0), od, 0, 0, 0);
  od = __builtin_amdgcn_mfma_f32_32x32x16_bf16(pa1, PK(l1, h1), od, 0, 0, 0);
  od = __builtin_amdgcn_mfma_f32_32x32x16_bf16(pa2, PK(l2, h2), od, 0, 0, 0);
  od = __builtin_amdgcn_mfma_f32_32x32x16_bf16(pa3, PK(l3, h3), od, 0, 0, 0);
#undef PK
}
__device__ __forceinline__ void pv_d0(f32x16* o, int vb, bf16x8 pa0, bf16x8 pa1, bf16x8 pa2, bf16x8 pa3) {
  pv_one<0>(o[0], vb, pa0, pa1, pa2, pa3); pv_one<1>(o[1], vb, pa0, pa1, pa2, pa3); pv_one<2>(o[2], vb, pa0, pa1, pa2, pa3); pv_one<3>(o[3], vb, pa0, pa1, pa2, pa3);
}

__device__ __forceinline__ void attn_dense_body(const bf16_t* __restrict__ Qb, const bf16_t* __restrict__ Kh, const bf16_t* __restrict__ Vh,
                                                bf16_t* Ob, int seq, char* lds, int wave_) {
  constexpr int SDEPTH = 2;
  int tid_ = wave_ * 64 + lane_id_fresh();
  const int tid = tid_, wid = tid >> 6, lane = tid & 63, r32 = lane & 31, hi = lane >> 5;
  bf16_t* V_lds = (bf16_t*)lds; bf16_t* K_lds = (bf16_t*)(lds + 2 * SHM_V);
  float* ws = (float*)(lds + 2 * SHM_V + 2 * SHM_K) + wid * 64; float* li_l = ws; float* al_l = ws + 32;
  float m_reg = -1e30f, l_reg = 0; f32x16 o[4] = {}; bf16x8 qr[8];
  const bf16_t* Qw = Qb + (long)(wid * QBLK + r32) * LDQ + hi * 8;
#pragma unroll
  for (int d0 = 0; d0 < 8; ++d0) qr[d0] = ld8(Qw + d0 * 16);
  const int sr = tid >> 4, sc = (tid & 15) * 8, vst0 = v_st(sr, sc), vst1 = v_st(32 + sr, sc);
  const int vb0 = (int)(uintptr_t)V_lds + v_rd_base(lane);
  struct { bf16x8 vs0, vs1, ks0, ks1; } sr_[SDEPTH];
#define SLOAD(i, k0) do { sr_[i].vs0 = ld8(&Vh[(long)((k0) + sr) * LDK + sc]); sr_[i].vs1 = ld8(&Vh[(long)((k0) + 32 + sr) * LDK + sc]); \
    sr_[i].ks0 = ld8(&Kh[(long)((k0) + sr) * LDK + sc]); sr_[i].ks1 = ld8(&Kh[(long)((k0) + 32 + sr) * LDK + sc]); } while (0)
#define SWRITE(b, i) do { *(bf16x8*)((char*)V_lds + (b) * SHM_V + vst0) = sr_[i].vs0;          \
    *(bf16x8*)((char*)V_lds + (b) * SHM_V + vst1) = sr_[i].vs1; int kc = sc * 2;               \
    *(bf16x8*)((char*)K_lds + (b) * SHM_K + KSWZ(sr, kc)) = sr_[i].ks0;                       \
    *(bf16x8*)((char*)K_lds + (b) * SHM_K + KSWZ(32 + sr, kc)) = sr_[i].ks1; } while (0)
#define SWAIT() asm volatile("s_waitcnt vmcnt(4)" ::: "memory")
#define RESC(a) do { if (__any((a) < 1.f)) { if (hi == 0) al_l[r32] = (a); asm volatile("s_waitcnt lgkmcnt(0)" ::: "memory"); \
    _Pragma("unroll") for (int d = 0; d < 4; ++d) _Pragma("unroll") for (int r = 0; r < 16; ++r) o[d][r] *= al_l[crow(r, hi)]; } } while (0)
  f32x16 pA0, pA1, pB0, pB1; float mnA, mnB, alA, alB; bf16x8 pa0, pa1, pa2, pa3; const int NT = seq / KVBLK;
  constexpr int SE = 0, SO = SDEPTH - 1;
  SLOAD(SE, 0); asm volatile("s_waitcnt vmcnt(0)" ::: "memory"); SWRITE(0, SE); __syncthreads();
  qkt(pA0, pA1, K_lds, qr, r32, hi); partialSM(pA0, pA1, m_reg, mnA, alA);
  SLOAD(SO, KVBLK); if (2 < NT) SLOAD(SE, 2 * KVBLK);
  SWAIT(); SWRITE(1, SO); __syncthreads();
  for (int j = 1; j + 1 < NT; j += 2) {
    SBAR(); qkt(pB0, pB1, (bf16_t*)((char*)K_lds + SHM_K), qr, r32, hi);
    finishSM(pA0, pA1, alA, l_reg, pa0, pa1, pa2, pa3); SBAR();
    SLOAD(SO, (j + SDEPTH) * KVBLK); SBAR();
    pv_d0(o, vb0, pa0, pa1, pa2, pa3); partialSM(pB0, pB1, m_reg, mnB, alB);
    __syncthreads(); SWAIT(); SWRITE(0, SE);
    RESC(alB); __syncthreads();
    SBAR(); qkt(pA0, pA1, K_lds, qr, r32, hi);
    finishSM(pB0, pB1, alB, l_reg, pa0, pa1, pa2, pa3); SBAR();
    if (j + 3 < NT) SLOAD(SE, (j + 1 + SDEPTH) * KVBLK); SBAR();
    pv_d0(o, vb0 + (int)SHM_V, pa0, pa1, pa2, pa3); partialSM(pA0, pA1, m_reg, mnA, alA);
    __syncthreads(); SWAIT(); SWRITE(1, SO);
    RESC(alA); __syncthreads();
  }
  SBAR(); qkt(pB0, pB1, (bf16_t*)((char*)K_lds + SHM_K), qr, r32, hi);
  finishSM(pA0, pA1, alA, l_reg, pa0, pa1, pa2, pa3); SBAR();
  pv_d0(o, vb0, pa0, pa1, pa2, pa3); partialSM(pB0, pB1, m_reg, mnB, alB);
  __syncthreads(); RESC(alB);
  finishSM(pB0, pB1, alB, l_reg, pa0, pa1, pa2, pa3); SBAR();
  pv_d0(o, vb0 + (int)SHM_V, pa0, pa1, pa2, pa3);
  if (hi == 0) li_l[r32] = l_reg; asm volatile("s_waitcnt lgkmcnt(0)" ::: "memory");
  float rli[16];
#pragma unroll
  for (int r = 0; r < 16; ++r) rli[r] = __builtin_amdgcn_rcpf(li_l[crow(r, hi)]);
  bf16_t* Ow = Ob + (long)(wid * QBLK) * LDO;
#pragma unroll
  for (int r = 0; r < 16; ++r) { int orow = crow(r, hi);
#pragma unroll
    for (int d0 = 0; d0 < 4; ++d0) Ow[(long)orow * LDO + d0 * 32 + r32] = f2bf(o[d0][r] * rli[r]); }
  __syncthreads();
#undef SLOAD
#undef SWRITE
#undef SWAIT
#undef RESC
}
#undef KSWZ
#undef SBAR
}
#define CAS __attribute__((address_space(4)))
#define INP(i) ((const float*)(GAS const float*)in[i])
struct Ctx {
    float* out; unsigned char* ws;
    LAS unsigned char* lds; int tid, lane, wave, wg, G;
};
enum { I_X = 0, I_C, I_CTX, I_CCTX, I_WMOD, I_BMOD, I_NMIX, I_NFFN, I_WIN, I_QN, I_KN, I_LCW, I_LCB, I_LWA, I_LBA, I_LWX, I_LBX, I_LLAM, I_SCW, I_SCB,
       I_WOA, I_WOL, I_WOS, I_WOUT, I_PWQ, I_PK1, I_PK2, I_PU, I_PV };

__device__ __forceinline__ float* xrow_ptr(const Ctx& c, int r) {
    return r < MLAT ? c.out + (size_t)r * DM : (float*)(c.ws + WS_CTXS) + (size_t)(r - MLAT) * DM;
}

template <bool I8 = false>
__device__ __forceinline__ void transpose_item(const float* W, int K, int N, bf16_t* WT, LAS float* scr, int item, int lane, const float* cmax = nullptr, float* wdq = nullptr, LAS float* scol = nullptr) {
    const int nblk = N / 64, kb = item / nblk, nb = item % nblk, k0 = 64 * kb, n0 = 64 * nb;
    if constexpr (I8) { float mx = 0.f;
#pragma unroll 8
        for (int kc = 0; kc < 32; ++kc) mx = fmaxf(mx, cmax[(size_t)kc * N + n0 + lane]);
        scol[lane] = mx > 0.f ? 127.f / mx : 0.f;
        if (kb == 0) wdq[n0 + lane] = mx * (1.f / 127.f); }
    const float* src = W + (size_t)(k0 + (lane >> 4)) * N + n0 + (lane & 15) * 4;
    f32x4 v[16];
#pragma unroll
    for (int i = 0; i < 16; ++i) v[i] = *(const f32x4*)(src + (size_t)(4 * i) * N);
    LAS float* d = scr + (lane >> 4) * 65 + (lane & 15) * 4;
#pragma unroll
    for (int i = 0; i < 16; ++i) { d[(4 * i) * 65 + 0] = v[i][0]; d[(4 * i) * 65 + 1] = v[i][1]; d[(4 * i) * 65 + 2] = v[i][2]; d[(4 * i) * 65 + 3] = v[i][3]; }
    LDS_WAIT(); asm volatile("" ::: "memory");
    const int c = lane & 7;
#pragma unroll
    for (int j = 0; j < 8; ++j) { const int n = (lane >> 3) + 8 * j; const LAS float* s = scr + (8 * c) * 65 + n;
        if constexpr (I8) { const float q_ = scol[n]; u32x2 o; o.x = pk4_i8(s[0 * 65] * q_, s[1 * 65] * q_, s[2 * 65] * q_, s[3 * 65] * q_); o.y = pk4_i8(s[4 * 65] * q_, s[5 * 65] * q_, s[6 * 65] * q_, s[7 * 65] * q_);
            *(u32x2*)((unsigned char*)WT + (size_t)(n0 + n) * K + k0 + 8 * c) = o; }
        else { u32x4 o; o.x = cvt_pk_bf16(s[0 * 65], s[1 * 65]); o.y = cvt_pk_bf16(s[2 * 65], s[3 * 65]); o.z = cvt_pk_bf16(s[4 * 65], s[5 * 65]); o.w = cvt_pk_bf16(s[6 * 65], s[7 * 65]);
            *(u32x4*)(WT + (size_t)(n0 + n) * K + k0 + 8 * c) = o; } }
    LDS_WAIT(); asm volatile("" ::: "memory");
}

__device__ __forceinline__ void mod_unit(const Ctx& c, CAS const unsigned long long* in, int l, int cb) {
    LAS float* sv = (LAS float*)c.lds;
    LAS float* red = sv + 3 * DM;
    { const float* cc = INP(I_C); const float* cx = INP(I_CCTX);
      for (int i = c.tid; i < 3 * DM; i += NTHREADS) { const int v = i / DM, k = i % DM; const float x = v < 2 ? cc[v * DM + k] : cx[k]; sv[i] = x * sigmoidf_(x); } }
    __syncthreads();
    const int j4 = (c.tid & 31) * 4, kg = c.tid >> 5;
    const float* w = INP(I_WMOD) + (size_t)l * DM * NMOD + (size_t)(kg * 128) * NMOD + cb * 128 + j4;
    f32x4 a0 = {0.f, 0.f, 0.f, 0.f}, a1 = a0, a2 = a0;
#pragma unroll 8
    for (int k = 0; k < 128; ++k) { const f32x4 wv = *(const f32x4*)(w + (size_t)k * NMOD); const int kk = kg * 128 + k; a0 += wv * sv[kk]; a1 += wv * sv[DM + kk]; a2 += wv * sv[2 * DM + kk]; }
    *(LAS f32x4*)(red + (kg * 3 + 0) * 128 + j4) = a0; *(LAS f32x4*)(red + (kg * 3 + 1) * 128 + j4) = a1; *(LAS f32x4*)(red + (kg * 3 + 2) * 128 + j4) = a2;
    __syncthreads();
    if (c.tid < 384) { const int v = c.tid >> 7, jj = c.tid & 127; float s = INP(I_BMOD)[l * NMOD + cb * 128 + jj];
#pragma unroll
        for (int g = 0; g < 16; ++g) s += red[(g * 3 + v) * 128 + jj];
        ((float*)(c.ws + WS_MOD))[((size_t)l * 3 + v) * NMOD + cb * 128 + jj] = s; }
    __syncthreads();
}

__device__ __forceinline__ void wsc_unit(const Ctx& c, CAS const unsigned long long* in, int l, int u) {
    const int hh = u >> 4, kb = u & 15, h = hh >> 1, half = hh & 1, k0 = kb * 128;
    LAS float* kkL = (LAS float*)c.lds;
    LAS float* wqL = kkL + 128 * 132;
    const float* ksrc = INP(half ? I_PK2 : I_PK1) + ((size_t)(l * 8 + h) * 128) * 128;
    const float* qsrc = INP(I_PWQ) + (size_t)l * DM * DM + (size_t)k0 * DM + hh * 128;
    for (int i = c.tid; i < 128 * 32; i += NTHREADS) { const int r = i >> 5, c4 = (i & 31) * 4;
        *(LAS f32x4*)(kkL + r * 132 + c4) = *(const f32x4*)(ksrc + (size_t)r * 128 + c4);
        *(LAS f32x4*)(wqL + r * 132 + c4) = *(const f32x4*)(qsrc + (size_t)r * DM + c4); }
    __syncthreads();
    const int k = c.tid & 127, ng = c.tid >> 7;
    float acc[32];
#pragma unroll
    for (int j = 0; j < 32; ++j) acc[j] = 0.f;
    for (int d4 = 0; d4 < 32; ++d4) {
        const f32x4 a = *(const LAS f32x4*)(wqL + k * 132 + d4 * 4);
#pragma unroll
        for (int j = 0; j < 32; ++j) { const f32x4 b = *(const LAS f32x4*)(kkL + (ng * 32 + j) * 132 + d4 * 4); acc[j] += (a[0] * b[0] + a[1] * b[1]) + (a[2] * b[2] + a[3] * b[3]); }
    }
    bf16_t* dst = (bf16_t*)(c.ws + ws_wsc(l)) + (size_t)(hh * 128 + ng * 32) * DM + k0 + k;
#pragma unroll
    for (int j = 0; j < 32; ++j) dst[(size_t)j * DM] = f2bf(acc[j]);
    __syncthreads();
}

#define GET_IN() unsigned long long kai_ = (unsigned long long)__builtin_amdgcn_kernarg_segment_ptr(); asm volatile("" : "+s"(kai_)); CAS const unsigned long long* in = (CAS const unsigned long long*)kai_
__device__ __forceinline__ void conv_units(const Ctx& c, int l) {
    GET_IN();
    if (l == 0) for (int u = c.wg; u < 2 * 96; u += c.G) mod_unit(c, in, u / 96, u % 96);
    for (int u = c.wg; u < 256; u += c.G) wsc_unit(c, in, l, u);
}
enum { CV_WIN = 1, CV_WO = 2, CV_WOUT = 4, CV_PU = 8, CV_PV = 16, CV_LRU = 32, CV_ALL = 63 };
__device__ __forceinline__ void conv_transposes(const Ctx& c, int l, int what = CV_ALL) {
    GET_IN();
    const int gw = c.wg * NWAVES + c.wave, NGW = c.G * NWAVES;
    LAS float* scr = (LAS float*)(c.lds + c.wave * 16640);
    constexpr int I_IN = (DM / 64) * (NIN / 64), I_SQ = (DM / 64) * (DM / 64);
    const float* win = INP(I_WIN) + (size_t)l * DM * NIN;
    if (what & CV_WIN) for (int it = gw; it < I_IN; it += NGW)
        transpose_item<true>(win, DM, NIN, (bf16_t*)(c.ws + WS_WIN), scr, it, c.lane, (const float*)(c.ws + WS_CMAX) + (size_t)l * 32 * NIN, (float*)(c.ws + WS_WDQ), (LAS float*)(c.lds + 8 * 16640 + c.wave * 256));
    for (int s = 0; s < 4; ++s) { if (!(what & (s < 3 ? CV_WO : CV_WOUT))) continue;
        const float* src = INP(s == 0 ? I_WOA : s == 1 ? I_WOL : s == 2 ? I_WOS : I_WOUT) + (size_t)l * DM * DM;
        bf16_t* dst = s < 3 ? (bf16_t*)(c.ws + WS_WO) + (size_t)s * DM * DM : (bf16_t*)(c.ws + WS_WOUT);
        for (int it = gw; it < I_SQ; it += NGW) transpose_item(src, DM, DM, dst, scr, it, c.lane);
    }
}
__device__ __forceinline__ void conv_colmax(const Ctx& c) {
    GET_IN();
    const size_t gt = (size_t)c.wg * NTHREADS + c.tid, NT = (size_t)c.G * NTHREADS;
    constexpr int C4 = NIN / 4;
    for (size_t u = gt; u < (size_t)NLAYER * 32 * C4; u += NT) { const int c4 = (int)(u % C4), lk = (int)(u / C4);
        const float* src = INP(I_WIN) + (size_t)lk * 64 * NIN + c4 * 4;
        f32x4 m = {0.f, 0.f, 0.f, 0.f};
#pragma unroll 16
        for (int k = 0; k < 64; ++k) { const f32x4 v = *(const f32x4*)(src + (size_t)k * NIN); m[0] = fmaxf(m[0], fabsf(v[0])); m[1] = fmaxf(m[1], fabsf(v[1])); m[2] = fmaxf(m[2], fabsf(v[2])); m[3] = fmaxf(m[3], fabsf(v[3])); }
        *(f32x4*)((float*)(c.ws + WS_CMAX) + (size_t)lk * NIN + c4 * 4) = m; }
}
__device__ __forceinline__ void conv_tables(const Ctx& c, int l, int what = CV_ALL) {
    GET_IN();
    const size_t gt = (size_t)c.wg * NTHREADS + c.tid, NT = (size_t)c.G * NTHREADS;
    constexpr size_t NG16 = (size_t)16384 * DM / 16;
    if (what & CV_PU) {
        const int gw = c.wg * NWAVES + c.wave, NGW = c.G * NWAVES;
        const float* srcb = INP(I_PU) + (size_t)l * 16384 * DM; unsigned char* dstb = (unsigned char*)(c.ws + ws_pu(l)); float* usc = (float*)(c.ws + WS_USC) + (size_t)l * 16384;
#pragma unroll 1
        for (int e = gw; e < 16384; e += NGW) { const float* src = srcb + (size_t)e * DM + c.lane * 16;
            f32x4 v[8]; float mx = 0.f;
#pragma unroll
            for (int i = 0; i < 8; ++i) { v[i] = *(const f32x4*)(src + (i >> 2) * 1024 + (i & 3) * 4); mx = fmaxf(fmaxf(mx, fmaxf(fabsf(v[i][0]), fabsf(v[i][1]))), fmaxf(fabsf(v[i][2]), fabsf(v[i][3]))); }
#pragma unroll
            for (int o = 32; o > 0; o >>= 1) mx = fmaxf(mx, __shfl_xor(mx, o));
            const float q_ = mx > 0.f ? 127.f / mx : 0.f;
            if (c.lane == 0) usc[e] = mx * (1.f / 127.f);
            u32x4 o0, o1;
#pragma unroll
            for (int i = 0; i < 4; ++i) { o0[i] = pk4_i8(v[i][0] * q_, v[i][1] * q_, v[i][2] * q_, v[i][3] * q_); o1[i] = pk4_i8(v[4 + i][0] * q_, v[4 + i][1] * q_, v[4 + i][2] * q_, v[4 + i][3] * q_); }
            *(u32x4*)(dstb + (size_t)e * DM + c.lane * 16) = o0; *(u32x4*)(dstb + (size_t)e * DM + 1024 + c.lane * 16) = o1; } }
#pragma unroll 1
    for (int tb = 1; tb < 2; ++tb) { if (!(what & (tb ? CV_PV : CV_PU))) continue;
        const float* srcb = INP(tb ? I_PV : I_PU) + (size_t)l * 16384 * DM; unsigned char* dstb = (unsigned char*)(c.ws + (tb ? ws_pv(l) : ws_pu(l)));
        const float sc = tb ? 1.f : 32.f;
        for (size_t j = gt; j < NG16; j += 2 * NT) {
            const size_t j2 = j + NT; const bool has2 = j2 < NG16;
            f32x4 a[4], b[4];
#pragma unroll
            for (int d = 0; d < 4; ++d) a[d] = *(const f32x4*)(srcb + j * 16 + d * 4);
#pragma unroll
            for (int d = 0; d < 4; ++d) b[d] = has2 ? *(const f32x4*)(srcb + j2 * 16 + d * 4) : (f32x4){0.f, 0.f, 0.f, 0.f};
            u32x4 o, o2;
#pragma unroll
            for (int d = 0; d < 4; ++d) { const f32x4 x = a[d] * sc, y = b[d] * sc;
                int w = __builtin_amdgcn_cvt_pk_fp8_f32(x[0], x[1], 0, false); w = __builtin_amdgcn_cvt_pk_fp8_f32(x[2], x[3], w, true); o[d] = (unsigned)w;
                int w2 = __builtin_amdgcn_cvt_pk_fp8_f32(y[0], y[1], 0, false); w2 = __builtin_amdgcn_cvt_pk_fp8_f32(y[2], y[3], w2, true); o2[d] = (unsigned)w2; }
            if (tb == 0) { *(u32x4*)(dstb + j * 16) = o; if (has2) *(u32x4*)(dstb + j2 * 16) = o2; }
            else {
                *(u32x4*)(dstb + (size_t)((j & 127) >> 3) * ((size_t)16384 * 128) + (j >> 7) * 128 + (j & 7) * 16) = o;
                if (has2) *(u32x4*)(dstb + (size_t)((j2 & 127) >> 3) * ((size_t)16384 * 128) + (j2 >> 7) * 128 + (j2 & 7) * 16) = o2; } }
    }
    if (what & CV_LRU) for (size_t i = gt; i < (size_t)16 * 512 * 128; i += NT) { const int ci = (int)(i & 127), j = (int)((i >> 7) & 511), n = (int)(i >> 16), d = j >> 8, which = (j >> 7) & 1, dd = j & 127;
        const float* src = INP(which ? I_LWX : I_LWA) + ((((size_t)(l * 2 + d) * 16 + n) * 128 + ci) * 128 + dd);
        ((bf16_t*)(c.ws + WS_WLRU))[i] = f2bf(*src); }
}
__device__ __forceinline__ void sp_copy(const Ctx& c, const float* src, int sp_off, int n) {
    const size_t gt = (size_t)c.wg * NTHREADS + c.tid, NT = (size_t)c.G * NTHREADS;
    for (size_t i = gt; i < (size_t)n; i += NT) ((float*)(c.ws + WS_SP))[sp_off + i] = src[i];
}
__device__ __forceinline__ void conv_small(const Ctx& c, int l) {
    GET_IN();
    const size_t gt = (size_t)c.wg * NTHREADS + c.tid, NT = (size_t)c.G * NTHREADS;
    sp_copy(c, INP(I_NMIX) + l * DM, SP_NMIX, DM); sp_copy(c, INP(I_NFFN) + l * DM, SP_NFFN, DM);
    sp_copy(c, INP(I_QN) + l * 128, SP_QN, 128); sp_copy(c, INP(I_KN) + l * 128, SP_KN, 128);
    sp_copy(c, INP(I_LCW) + l * 4 * DM, SP_LCW, 4 * DM); sp_copy(c, INP(I_LCB) + l * DM, SP_LCB, DM);
    sp_copy(c, INP(I_LBA) + l * 2 * DM, SP_LBA, 2 * DM); sp_copy(c, INP(I_LBX) + l * 2 * DM, SP_LBX, 2 * DM);
    sp_copy(c, INP(I_SCW) + l * 3 * DM, SP_SCW, 3 * DM); sp_copy(c, INP(I_SCB) + l * DM, SP_SCB, DM);
    { const float* lam = INP(I_LLAM) + l * 2 * DM;
      for (size_t i = gt; i < (size_t)2 * DM; i += NT) ((float*)(c.ws + WS_SP))[SP_LSP + i] = 8.f * log1pf(expf(-lam[i])); }
}
__device__ __forceinline__ void conv_once(const Ctx& c) {
    const size_t gt = (size_t)c.wg * NTHREADS + c.tid, NT = (size_t)c.G * NTHREADS;
    for (size_t i = gt; i < 128 * 32; i += NT) { const int pos = (int)(i >> 5), p = (int)(i & 31);
        const float inv = exp2f(-(float)p * (13.287712379549449f / 32.f)); const float ang = (float)pos * inv;
        float sn, cs; sincosf(ang, &sn, &cs);
        ((float*)(c.ws + WS_ROPE))[i] = cs; ((float*)(c.ws + WS_ROPE))[128 * 32 + i] = sn; }
}

template <bool I8 = false>
__device__ __forceinline__ void phase_norm(const Ctx& c, int l, int nrows, int sp_gain, int slot_shift, const float* xin = nullptr, const float* cin = nullptr) {
    const int gw = c.wg * NWAVES + c.wave, NGW = c.G * NWAVES;
    const float* modl = (const float*)(c.ws + WS_MOD) + (size_t)l * 3 * NMOD;
    bf16_t* HX = (bf16_t*)(c.ws + WS_HX); const float* gain = (const float*)(c.ws + WS_SP) + sp_gain;
    for (int r = gw; r < nrows; r += NGW) {
        const int vec = r < SEQ ? 0 : (r < MLAT ? 1 : 2);
        const float* xr = xin ? (r < MLAT ? xin + (size_t)r * DM : cin + (size_t)(r - MLAT) * DM) : xrow_ptr(c, r); const float* sh = modl + (size_t)vec * NMOD + slot_shift * DM; const float* sc = sh + DM;
        f32x4 v[8]; float ss = 0.f;
#pragma unroll
        for (int j = 0; j < 8; ++j) { v[j] = *(const f32x4*)(xr + j * 256 + c.lane * 4); ss += (v[j][0] * v[j][0] + v[j][1] * v[j][1]) + (v[j][2] * v[j][2] + v[j][3] * v[j][3]); }
        const float rs = rsqrtf(wave_sum(ss) * (1.f / DM) + EPS);
        if constexpr (I8) { float mx = 0.f;
#pragma unroll
            for (int j = 0; j < 8; ++j) { const int col = j * 256 + c.lane * 4;
                const f32x4 g = *(const f32x4*)(gain + col), s1 = *(const f32x4*)(sc + col), s0 = *(const f32x4*)(sh + col);
                v[j] = (v[j] * rs * g) * (s1 + 1.f) + s0;
                mx = fmaxf(fmaxf(mx, fmaxf(fabsf(v[j][0]), fabsf(v[j][1]))), fmaxf(fabsf(v[j][2]), fabsf(v[j][3]))); }
#pragma unroll
            for (int o = 32; o > 0; o >>= 1) mx = fmaxf(mx, __shfl_xor(mx, o));
            const float q_ = mx > 0.f ? 127.f / mx : 0.f;
            if (c.lane == 0) ((float*)(c.ws + WS_ADQ))[r] = mx * (1.f / 127.f);
#pragma unroll
            for (int j = 0; j < 8; ++j) *(unsigned*)((unsigned char*)HX + (size_t)r * DM + j * 256 + c.lane * 4) = pk4_i8(v[j][0] * q_, v[j][1] * q_, v[j][2] * q_, v[j][3] * q_);
        } else {
#pragma unroll
        for (int j = 0; j < 8; ++j) { const int col = j * 256 + c.lane * 4;
            const f32x4 g = *(const f32x4*)(gain + col), s1 = *(const f32x4*)(sc + col), s0 = *(const f32x4*)(sh + col);
            const f32x4 y = (v[j] * rs * g) * (s1 + 1.f) + s0;
            u32x2 o; o.x = cvt_pk_bf16(y[0], y[1]); o.y = cvt_pk_bf16(y[2], y[3]);
            *(u32x2*)(HX + (size_t)r * DM + col) = o; } }
    }
}
__device__ __forceinline__ void seg_of_row(int r, bool& is_ctx, int& b, int& t) {
    is_ctx = r >= MLAT; b = is_ctx ? (r - MLAT) >> 8 : r >> 13; t = is_ctx ? (r - MLAT) & 255 : r & (SEQ - 1);
}
__device__ __forceinline__ void qk_row(const Ctx& c, int l, int r, bool do_q, bool dry) {
    bool is_ctx; int b, t; seg_of_row(r, is_ctx, b, t);
    const int key = is_ctx ? t : CTXL + t;
    bf16_t* prow = (bf16_t*)(c.ws + WS_P) + (size_t)r * NIN;
    bf16_t* KC = (bf16_t*)(c.ws + WS_KC); bf16_t* VC = (bf16_t*)(c.ws + WS_VC);
    const int hs = c.lane >> 4, ax = (c.lane >> 3) & 1, p0 = (c.lane & 7) * 4;
    f32x4 cs = {1.f, 1.f, 1.f, 1.f}, sn = {0.f, 0.f, 0.f, 0.f};
    if (!is_ctx) { const int pos = ax ? (t & 63) : (t >> 6); const float* rt = (const float*)(c.ws + WS_ROPE) + pos * 32 + p0; cs = *(const f32x4*)rt; sn = *(const f32x4*)(rt + 128 * 32); }
    u32x2 w1[5], w2[5];
#pragma unroll
    for (int g = 0; g < 5; ++g) { const bool is_k = (g == 4); const int head = is_k ? hs : g * 4 + hs;
        const bf16_t* src = prow + (is_k ? CK : CQ) + head * 128 + ax * 64 + p0;
        if (is_k || do_q) { w1[g] = *(const u32x2*)src; w2[g] = *(const u32x2*)(src + 32); } else { w1[g] = (u32x2){0u, 0u}; w2[g] = (u32x2){0u, 0u}; } }
    const u32x4 vw = *(const u32x4*)(prow + CV + (c.lane >> 4) * 128 + (c.lane & 15) * 8);
#pragma unroll
    for (int g = 0; g < 5; ++g) {
        const bool is_k = (g == 4);
        if (!is_k && !do_q) continue;
        const int head = is_k ? hs : g * 4 + hs;
        bf16_t* src = prow + (is_k ? CK : CQ) + head * 128 + ax * 64 + p0;
        f32x4 t1 = {bf_lo(w1[g].x), bf_hi(w1[g].x), bf_lo(w1[g].y), bf_hi(w1[g].y)}, t2 = {bf_lo(w2[g].x), bf_hi(w2[g].x), bf_lo(w2[g].y), bf_hi(w2[g].y)};
        float ss = (t1[0] * t1[0] + t1[1] * t1[1]) + (t1[2] * t1[2] + t1[3] * t1[3]) + (t2[0] * t2[0] + t2[1] * t2[1]) + (t2[2] * t2[2] + t2[3] * t2[3]);
        ss += DPPF(ss, 0xB1); ss += DPPF(ss, 0x4E); ss += DPPF(ss, 0x141); ss += DPPF(ss, 0x140);
        const float rs = rsqrtf(ss * (1.f / 128.f) + EPS);
        const float* gn = (const float*)(c.ws + WS_SP) + (is_k ? SP_KN : SP_QN) + ax * 64 + p0;
        const f32x4 g1 = *(const f32x4*)gn, g2 = *(const f32x4*)(gn + 32);
        const f32x4 y1 = t1 * rs * g1, y2 = t2 * rs * g2;
        const f32x4 o1 = y1 * cs - y2 * sn, o2 = y2 * cs + y1 * sn;
        bf16_t* dst = is_k ? KC + ((size_t)(b * 4 + head) * NKEY + key) * 128 + ax * 64 + p0 : (dry ? (bf16_t*)(c.ws + WS_YF) + (size_t)r * DM + head * 128 + ax * 64 + p0 : src);
        u32x2 a; a.x = cvt_pk_bf16(o1[0], o1[1]); a.y = cvt_pk_bf16(o1[2], o1[3]);
        u32x2 bq; bq.x = cvt_pk_bf16(o2[0], o2[1]); bq.y = cvt_pk_bf16(o2[2], o2[3]);
        *(u32x2*)dst = a; *(u32x2*)(dst + 32) = bq;
    }
    { const int hv = c.lane >> 4, dd = (c.lane & 15) * 8;
      *(u32x4*)(VC + ((size_t)(b * 4 + hv) * NKEY + key) * 128 + dd) = vw; }
}
__device__ __forceinline__ void unpack8(const u32x4 w, float (&f)[8]) {
    f[0] = bf_lo(w.x); f[1] = bf_hi(w.x); f[2] = bf_lo(w.y); f[3] = bf_hi(w.y); f[4] = bf_lo(w.z); f[5] = bf_hi(w.z); f[6] = bf_lo(w.w); f[7] = bf_hi(w.w);
}
__device__ __forceinline__ void sc_row(const Ctx& c, int l, int r, bool dry) {
    bool is_ctx; int b, t; seg_of_row(r, is_ctx, b, t);
    const int seglen = is_ctx ? CTXL : SEQ;
    bf16_t* prow = (bf16_t*)(c.ws + WS_P) + (size_t)r * NIN;
    const bool hp = t > 0, hn = t < seglen - 1;
    const float* w = (const float*)(c.ws + WS_SP) + SP_SCW; const float* bias = (const float*)(c.ws + WS_SP) + SP_SCB;
    u32x4 xb[4], xc0[4], xu0[4], xcp[4], xup[4], xcn[4], xun[4];
    const u32x4 z = {0u, 0u, 0u, 0u};
#pragma unroll
    for (int it = 0; it < 4; ++it) { const int col = it * 512 + c.lane * 8;
        xb[it] = *(const u32x4*)(prow + CBG + col); xc0[it] = *(const u32x4*)(prow + CCG + col); xu0[it] = *(const u32x4*)(prow + CU + col);
        xcp[it] = hp ? *(const u32x4*)(prow - NIN + CCG + col) : z; xup[it] = hp ? *(const u32x4*)(prow - NIN + CU + col) : z;
        xcn[it] = hn ? *(const u32x4*)(prow + NIN + CCG + col) : z; xun[it] = hn ? *(const u32x4*)(prow + NIN + CU + col) : z; }
#pragma unroll
    for (int it = 0; it < 4; ++it) {
        const int col = it * 512 + c.lane * 8;
        float bg[8], c0[8], u0[8], cp[8], up[8], cn[8], un[8];
        unpack8(xb[it], bg); unpack8(xc0[it], c0); unpack8(xu0[it], u0); unpack8(xcp[it], cp); unpack8(xup[it], up); unpack8(xcn[it], cn); unpack8(xun[it], un);
        float o[8];
#pragma unroll
        for (int hq = 0; hq < 2; ++hq) { const f32x4 w0 = *(const f32x4*)(w + col + hq * 4), w1 = *(const f32x4*)(w + DM + col + hq * 4), w2 = *(const f32x4*)(w + 2 * DM + col + hq * 4), bi = *(const f32x4*)(bias + col + hq * 4);
#pragma unroll
            for (int e = 0; e < 4; ++e) { const int k = hq * 4 + e; o[k] = bg[k] * (bi[e] + w0[e] * (cp[k] * up[k]) + w1[e] * (c0[k] * u0[k]) + w2[e] * (cn[k] * un[k])); } }
        u32x4 ow; ow.x = cvt_pk_bf16(o[0], o[1]); ow.y = cvt_pk_bf16(o[2], o[3]); ow.z = cvt_pk_bf16(o[4], o[5]); ow.w = cvt_pk_bf16(o[6], o[7]);
        *(u32x4*)((dry ? (bf16_t*)(c.ws + WS_YF) + (size_t)(MALL + r) * DM : prow + CBG) + col) = ow;
    }
}

constexpr size_t lsum_idx(int which, int dir, int b, int j) { return ((((size_t)which * 2 + dir) * NB + b) * NCHUNK + j) * DM; }
template <int DIR, int PASS>
__device__ __forceinline__ void lru_chunk(const LAS bf16_t* ub, const LAS float* uf, LAS float* hsd, const bf16x8 (&bfr)[4][4], const float (&ba)[2], const float (&bx)[2], const float (&sp8)[2],
                                          const float (&cin)[2], float (&Atot)[2], float (&Hend)[2], int q, int col16, int quad) {
    float st[2] = {cin[0], cin[1]}, at[2] = {1.f, 1.f};
    const int mysg = DIR ? 3 - quad : quad;
    for (int smt = 0; smt < 4; ++smt) {
        const int mt = DIR ? 3 - smt : smt;
        f32x4 acc[4];
#pragma unroll
        for (int nt = 0; nt < 4; ++nt) acc[nt] = (f32x4){0.f, 0.f, 0.f, 0.f};
#pragma unroll
        for (int ks = 0; ks < 4; ++ks) { const bf16x8 a = *(const LAS bf16x8*)(ub + (mt * 16 + col16) * 136 + ks * 32 + quad * 8);
#pragma unroll
            for (int nt = 0; nt < 4; ++nt) acc[nt] = __builtin_amdgcn_mfma_f32_16x16x32_bf16(a, bfr[nt][ks], acc[nt], 0, 0, 0); }
#pragma unroll
        for (int ct = 0; ct < 2; ++ct) {
            const int ch = q * 32 + ct * 16 + col16;
            float av[4], dv[4];
#pragma unroll
            for (int reg = 0; reg < 4; ++reg) { const int tl = mt * 16 + quad * 4 + reg;
                const float r = sigmoidf_(acc[ct][reg] + ba[ct]), ig = sigmoidf_(acc[2 + ct][reg] + bx[ct]);
                const float a = __expf(-sp8[ct] * r);
                av[reg] = a; dv[reg] = __builtin_amdgcn_sqrtf(fmaxf(1.f - a * a, 0.f)) * ig * uf[tl * 132 + ch]; }
            float Al = 1.f, Hl = 0.f;
#pragma unroll
            for (int sr = 0; sr < 4; ++sr) { const int reg = DIR ? 3 - sr : sr; Hl = av[reg] * Hl + dv[reg]; Al *= av[reg]; }
            float se = st[ct], so = st[ct], ap = 1.f;
#pragma unroll
            for (int sg = 0; sg < 4; ++sg) { const int qp = DIR ? 3 - sg : sg; const float Ag = __shfl(Al, col16 + 16 * qp), Hg = __shfl(Hl, col16 + 16 * qp);
                const float nx = Ag * so + Hg; so = nx; if (sg < mysg) se = nx; ap *= Ag; }
            if (PASS == 2) { float h = se;
#pragma unroll
                for (int sr = 0; sr < 4; ++sr) { const int reg = DIR ? 3 - sr : sr; h = av[reg] * h + dv[reg]; hsd[(mt * 16 + quad * 4 + reg) * 132 + ch] = h; } }
            else at[ct] *= ap;
            st[ct] = so;
        }
    }
    Atot[0] = at[0]; Atot[1] = at[1]; Hend[0] = st[0]; Hend[1] = st[1];
}

template <int PASS>
__device__ __forceinline__ void lru_run(const Ctx& c, int l, int unit, bool dry = false) {
    const int b = unit >> 7, n = (unit >> 3) & 15, run = unit & 7;
    const int c0 = run * 16 + (run < 4 ? run : 4), len = 16 + (run < 4 ? 1 : 0);
    LAS float* xl = (LAS float*)c.lds;
    LAS float* uf = (LAS float*)(c.lds + 34816);
    LAS bf16_t* ub = (LAS bf16_t*)(c.lds + 34816 + 33792);
    LAS float* car = (LAS float*)(c.lds + 34816 + 33792 + 17408);
    LAS float* hsr = (LAS float*)(c.lds + 34816 + 33792 + 17408 + 17408);
    const int d = c.wave >> 2, q = c.wave & 3, col16 = c.lane & 15, quad = c.lane >> 4;
    float* LS = (float*)(c.ws + WS_LSUM);
    bf16_t* P = (bf16_t*)(c.ws + WS_P);
    bf16x8 bfr[4][4];
#pragma unroll
    for (int nt = 0; nt < 4; ++nt) { const int j = d * 256 + (nt >> 1) * 128 + q * 32 + (nt & 1) * 16 + col16;
#pragma unroll
        for (int ks = 0; ks < 4; ++ks) bfr[nt][ks] = *(const bf16x8*)((const bf16_t*)(c.ws + WS_WLRU) + ((size_t)(n * 512 + j) * 128 + ks * 32 + quad * 8)); }
    float ba[2], bx[2], sp8[2];
#pragma unroll
    for (int ct = 0; ct < 2; ++ct) { const int cidx = n * 128 + q * 32 + ct * 16 + col16; const float* sp = (const float*)(c.ws + WS_SP) + d * DM + cidx;
        ba[ct] = sp[SP_LBA]; bx[ct] = sp[SP_LBX]; sp8[ct] = sp[SP_LSP]; }
    if (PASS == 2) {
        if (c.tid < 256) { const int dir = c.tid >> 7, ch = c.tid & 127, cidx = n * 128 + ch; float st = 0.f;
#pragma unroll 1
            for (int k0 = 0; k0 < NCHUNK; k0 += 12) {
                float av[12], hv[12];
#pragma unroll
                for (int kk = 0; kk < 12; ++kk) { const int k = k0 + kk, j = dir ? (k < 4 ? 3 - k : 135 - k) : k; av[kk] = LS[lsum_idx(0, dir, b, j) + cidx]; hv[kk] = LS[lsum_idx(1, dir, b, j) + cidx]; }
#pragma unroll
                for (int kk = 0; kk < 12; ++kk) { const int k = k0 + kk, j = dir ? (k < 4 ? 3 - k : 135 - k) : k;
                    if (j >= c0 && j < c0 + len) car[(dir * 17 + (j - c0)) * 128 + ch] = st;
                    st = av[kk] * st + hv[kk]; } } }
        __syncthreads();
    }
    const float* cw = (const float*)(c.ws + WS_SP) + SP_LCW + n * 128; const float* cb = (const float*)(c.ws + WS_SP) + SP_LCB + n * 128;
#define LRU_GEOM(ci_, jc, is_ctx, rb, t0, seglen) const int jc = c0 + (ci_); const bool is_ctx = jc < 4; \
        const int rb = is_ctx ? MLAT + b * CTXL : b * SEQ, t0 = is_ctx ? jc * 64 : (jc - 4) * 64, seglen = is_ctx ? CTXL : SEQ
#define LRU_LOAD(ci_, XR, LG) do { LRU_GEOM(ci_, jc_, ic_, rb_, t0_, sl_); (void)ic_; \
        _Pragma("unroll") for (int ps = 0; ps < 3; ++ps) { const int i = ps * 32 + (c.tid >> 4); const int t = t0_ - 2 + i; XR[ps] = (u32x4){0u, 0u, 0u, 0u}; \
            if (i < 68 && t >= 0 && t < sl_) XR[ps] = *(const u32x4*)(P + (size_t)(rb_ + t) * NIN + CLX + n * 128 + (c.tid & 15) * 8); } \
        if (PASS == 2) { const bf16_t* gp_ = P + (size_t)(rb_ + t0_ + (c.tid >> 3)) * NIN + CLG + n * 128 + (c.tid & 7) * 16; LG[0] = *(const u32x4*)gp_; LG[1] = *(const u32x4*)(gp_ + 8); } } while (0)
    u32x4 xr[3], lgc[2] = {{0u, 0u, 0u, 0u}, {0u, 0u, 0u, 0u}}, lgn[2] = {{0u, 0u, 0u, 0u}, {0u, 0u, 0u, 0u}};
    LRU_LOAD(0, xr, lgn);
    for (int ci = 0; ci < len; ++ci) {
        LRU_GEOM(ci, jc, is_ctx, rb, t0, seglen); (void)is_ctx; (void)seglen;
#pragma unroll
        for (int ps = 0; ps < 3; ++ps) { const int i = ps * 32 + (c.tid >> 4);
            if (i < 68) { float f[8]; unpack8(xr[ps], f);
                *(LAS f32x4*)(xl + i * 128 + (c.tid & 15) * 8) = (f32x4){f[0], f[1], f[2], f[3]}; *(LAS f32x4*)(xl + i * 128 + (c.tid & 15) * 8 + 4) = (f32x4){f[4], f[5], f[6], f[7]}; } }
        lgc[0] = lgn[0]; lgc[1] = lgn[1];
        __syncthreads();
        if (ci + 1 < len) LRU_LOAD(ci + 1, xr, lgn);
        { const int ch = c.tid & 127, tq = c.tid >> 7; const float w0 = cw[ch], w1 = cw[DM + ch], w2 = cw[2 * DM + ch], w3 = cw[3 * DM + ch], bb = cb[ch];
#pragma unroll 4
          for (int tt = 0; tt < 16; ++tt) { const int tl = tq * 16 + tt;
              const float u = bb + w0 * xl[tl * 128 + ch] + w1 * xl[(tl + 1) * 128 + ch] + w2 * xl[(tl + 2) * 128 + ch] + w3 * xl[(tl + 3) * 128 + ch];
              uf[tl * 132 + ch] = u; ub[tl * 136 + ch] = f2bf(u); } }
        __syncthreads();
        float cin[2] = {0.f, 0.f}, At[2], He[2];
        if (PASS == 2) { cin[0] = car[(d * 17 + ci) * 128 + q * 32 + col16]; cin[1] = car[(d * 17 + ci) * 128 + q * 32 + 16 + col16]; }
        if (d == 0) lru_chunk<0, PASS>(ub, uf, xl, bfr, ba, bx, sp8, cin, At, He, q, col16, quad);
        else lru_chunk<1, PASS>(ub, uf, hsr, bfr, ba, bx, sp8, cin, At, He, q, col16, quad);
        if (PASS == 1) {
            if (quad == 0) {
#pragma unroll
                for (int ct = 0; ct < 2; ++ct) { const int cidx = n * 128 + q * 32 + ct * 16 + col16;
                    LS[lsum_idx(0, d, b, jc) + cidx] = At[ct]; LS[lsum_idx(1, d, b, jc) + cidx] = He[ct]; } }
            __syncthreads();
        } else {
            __syncthreads();
            { const int row = c.tid >> 3, cs = (c.tid & 7) * 16;
              bf16_t* gp = P + (size_t)(rb + t0 + row) * NIN + CLG + n * 128 + cs;
#pragma unroll
              for (int hseg = 0; hseg < 2; ++hseg) { float g[8]; unpack8(lgc[hseg], g);
                  const int o = row * 132 + cs + hseg * 8;
                  const f32x4 h0 = *(const LAS f32x4*)(xl + o) + *(const LAS f32x4*)(hsr + o), h1 = *(const LAS f32x4*)(xl + o + 4) + *(const LAS f32x4*)(hsr + o + 4);
                  u32x4 ow; ow.x = cvt_pk_bf16(h0[0] * gelu_tanh(g[0]), h0[1] * gelu_tanh(g[1])); ow.y = cvt_pk_bf16(h0[2] * gelu_tanh(g[2]), h0[3] * gelu_tanh(g[3]));
                  ow.z = cvt_pk_bf16(h1[0] * gelu_tanh(g[4]), h1[1] * gelu_tanh(g[5])); ow.w = cvt_pk_bf16(h1[2] * gelu_tanh(g[6]), h1[3] * gelu_tanh(g[7]));
                  *(u32x4*)((dry ? gp - CLG + CU : gp) + hseg * 8) = ow; } }
            __syncthreads();
        }
    }
#undef LRU_GEOM
#undef LRU_LOAD
}

__device__ __forceinline__ void phase_qk(const Ctx& c, int l, bool dry = false) {
    const int gw = c.wg * NWAVES + c.wave, NGW = c.G * NWAVES;
    for (int r = gw; r < MALL; r += NGW) qk_row(c, l, r, l == 0 || r < MLAT, dry);
}
__device__ __forceinline__ void sc_block8(const Ctx& c, int r0, bool dry) {
    const int t0 = r0 & (SEQ - 1);
    bf16_t* prow0 = (bf16_t*)(c.ws + WS_P) + (size_t)r0 * NIN;
    const float* w = (const float*)(c.ws + WS_SP) + SP_SCW; const float* bias = (const float*)(c.ws + WS_SP) + SP_SCB;
    const u32x4 z = {0u, 0u, 0u, 0u};
#pragma unroll 1
    for (int it = 0; it < 4; ++it) {
        const int col = it * 512 + c.lane * 8;
        float w0[8], w1[8], w2[8], bi[8];
#pragma unroll
        for (int hq = 0; hq < 2; ++hq) { const f32x4 a = *(const f32x4*)(w + col + hq * 4), b = *(const f32x4*)(w + DM + col + hq * 4), d = *(const f32x4*)(w + 2 * DM + col + hq * 4), e = *(const f32x4*)(bias + col + hq * 4);
#pragma unroll
            for (int k = 0; k < 4; ++k) { w0[hq * 4 + k] = a[k]; w1[hq * 4 + k] = b[k]; w2[hq * 4 + k] = d[k]; bi[hq * 4 + k] = e[k]; } }
        u32x4 xc[10], xu[10], xb[8];
#pragma unroll
        for (int j = 0; j < 10; ++j) { const int t = t0 - 1 + j; const bool in = t >= 0 && t < SEQ; const bf16_t* pr = prow0 + (ptrdiff_t)(j - 1) * NIN;
            xc[j] = in ? *(const u32x4*)(pr + CCG + col) : z; xu[j] = in ? *(const u32x4*)(pr + CU + col) : z; }
#pragma unroll
        for (int j = 0; j < 8; ++j) xb[j] = *(const u32x4*)(prow0 + (size_t)j * NIN + CBG + col);
        float zp[8], zc[8];
        { float a[8], b[8]; unpack8(xc[0], a); unpack8(xu[0], b);
#pragma unroll
          for (int k = 0; k < 8; ++k) zp[k] = a[k] * b[k];
          unpack8(xc[1], a); unpack8(xu[1], b);
#pragma unroll
          for (int k = 0; k < 8; ++k) zc[k] = a[k] * b[k]; }
#pragma unroll
        for (int j = 0; j < 8; ++j) {
            float a[8], b[8], bg[8], zn[8], o[8]; unpack8(xc[j + 2], a); unpack8(xu[j + 2], b); unpack8(xb[j], bg);
#pragma unroll
            for (int k = 0; k < 8; ++k) { zn[k] = a[k] * b[k]; o[k] = bg[k] * (bi[k] + w0[k] * zp[k] + w1[k] * zc[k] + w2[k] * zn[k]); zp[k] = zc[k]; zc[k] = zn[k]; }
            u32x4 ow; ow.x = cvt_pk_bf16(o[0], o[1]); ow.y = cvt_pk_bf16(o[2], o[3]); ow.z = cvt_pk_bf16(o[4], o[5]); ow.w = cvt_pk_bf16(o[6], o[7]);
            *(u32x4*)((dry ? (bf16_t*)(c.ws + WS_YF) + (size_t)(MALL + r0 + j) * DM : prow0 + (size_t)j * NIN + CBG) + col) = ow; }
    }
}
__device__ __forceinline__ void phase_sc(const Ctx& c, int l, bool dry = false) {
    const int gw = c.wg * NWAVES + c.wave, NGW = c.G * NWAVES;
    for (int r0 = gw * 8; r0 < MLAT; r0 += NGW * 8) sc_block8(c, r0, dry);
    if (l == 0) for (int r = MLAT + gw; r < MALL; r += NGW) sc_row(c, l, r, dry);
}
__device__ __forceinline__ void phase_lru1(const Ctx& c, int l) {
    for (int u = c.wg; u < 256; u += c.G) lru_run<1>(c, l, u);
}

__device__ __forceinline__ void phase_m2(const Ctx& c, int l, bool dry = false) {
    bf16_t* P = (bf16_t*)(c.ws + WS_P); const bf16_t* KC = (const bf16_t*)(c.ws + WS_KC); const bf16_t* VC = (const bf16_t*)(c.ws + WS_VC);
    const int ntot = 1024 + (l == 0 ? 32 : 0);
    for (int i = 0; i * c.G + c.wg < ntot; ++i) {
        const int L = i * c.G + c.wg; int b, h, seq; size_t qrow;
        if (L < 1024) { int grp, qb;
            if (c.G == 256) { grp = i * 8 + (c.wg & 7); qb = c.wg >> 3; } else { grp = L >> 5; qb = L & 31; }
            b = grp >> 4; h = grp & 15; qrow = (size_t)(b * SEQ + qb * 256); seq = NKEY; }
        else { const int u = L - 1024; b = u >> 4; h = u & 15; qrow = (size_t)(MLAT + b * CTXL); seq = CTXL; }
        bf16_t* q = P + qrow * NIN + CQ + h * 128;
        const size_t kvo = (size_t)(b * 4 + (h >> 2)) * NKEY * 128;
        att::attn_dense_body(q, KC + kvo, VC + kvo, dry ? q - CQ + CCG : q, seq, (char*)c.lds, c.wave);
    }
}
__device__ __forceinline__ void phase_lru2(const Ctx& c, int l, bool dry = false) {
    for (int u = c.wg; u < 256; u += c.G) lru_run<2>(c, l, u, dry);
}
constexpr float NEGBIG = -3.0e38f;
constexpr float PU_SCALE = 32.f;
__device__ __forceinline__ float wave_max_dpp(float v) {
    v = fmaxf(v, DPPF(v, 0xB1)); v = fmaxf(v, DPPF(v, 0x4E)); v = fmaxf(v, DPPF(v, 0x141)); v = fmaxf(v, DPPF(v, 0x140));
    const float a = __int_as_float(__builtin_amdgcn_readlane(__float_as_int(v), 0)), b = __int_as_float(__builtin_amdgcn_readlane(__float_as_int(v), 16));
    const float c = __int_as_float(__builtin_amdgcn_readlane(__float_as_int(v), 32)), d = __int_as_float(__builtin_amdgcn_readlane(__float_as_int(v), 48));
    return fmaxf(fmaxf(a, b), fmaxf(c, d));
}
#define SWZ_XOR(v, m) __int_as_float(__builtin_amdgcn_ds_swizzle(__float_as_int(v), ((m) << 10) | 0x1F))
__device__ __forceinline__ unsigned fkey(float x) { const unsigned u = __float_as_uint(x); return (u & 0x80000000u) ? ~u : (u | 0x80000000u); }
#define DPPU(v, ctrl) ((unsigned)__builtin_amdgcn_update_dpp(0, (int)(v), ctrl, 0xF, 0xF, true))
__device__ __forceinline__ unsigned wave_max_u32(unsigned v) {
    v = max(v, DPPU(v, 0xB1)); v = max(v, DPPU(v, 0x4E)); v = max(v, DPPU(v, 0x141)); v = max(v, DPPU(v, 0x140));
    const unsigned a = (unsigned)__builtin_amdgcn_readlane((int)v, 0), b = (unsigned)__builtin_amdgcn_readlane((int)v, 16), c = (unsigned)__builtin_amdgcn_readlane((int)v, 32), d = (unsigned)__builtin_amdgcn_readlane((int)v, 48);
    return max(max(a, b), max(c, d));
}
__device__ __forceinline__ unsigned topk16_keys2(unsigned k0, unsigned k1, int lane) {
    unsigned res = 0u;
    for (int it = 0; it < 16; ++it) { const unsigned m = wave_max_u32(max(k0, k1)); k0 = (k0 == m) ? 0u : k0; k1 = (k1 == m) ? 0u : k1; res = (lane == it) ? m : res; }
    return res;
}
__device__ __forceinline__ unsigned topk16_keys1(unsigned k0, int lane) {
    unsigned res = 0u;
    for (int it = 0; it < 16; ++it) { const unsigned m = wave_max_u32(k0); k0 = (k0 == m) ? 0u : k0; res = (lane == it) ? m : res; }
    return res;
}
__device__ __forceinline__ void unpack_fp8x16(const u32x4 w, float (&f)[16]) {
#pragma unroll
    for (int d = 0; d < 4; ++d) { const f32x2 lo = __builtin_amdgcn_cvt_pk_f32_fp8((int)w[d], false), hi = __builtin_amdgcn_cvt_pk_f32_fp8((int)w[d], true);
        f[4 * d] = lo.x; f[4 * d + 1] = lo.y; f[4 * d + 2] = hi.x; f[4 * d + 3] = hi.y; }
}

__device__ __forceinline__ unsigned half_max_u32(unsigned v, bool hi_half) {
    v = max(v, DPPU(v, 0xB1)); v = max(v, DPPU(v, 0x4E)); v = max(v, DPPU(v, 0x141)); v = max(v, DPPU(v, 0x140));
    const unsigned a = max((unsigned)__builtin_amdgcn_readlane((int)v, 0), (unsigned)__builtin_amdgcn_readlane((int)v, 16));
    const unsigned b = max((unsigned)__builtin_amdgcn_readlane((int)v, 32), (unsigned)__builtin_amdgcn_readlane((int)v, 48));
    return hi_half ? b : a;
}
__device__ __forceinline__ unsigned topk16_half4(unsigned (&k)[4], int hl, bool hi_half) {
    unsigned res = 0u;
    for (int it = 0; it < 16; ++it) { const unsigned m = half_max_u32(max(max(k[0], k[1]), max(k[2], k[3])), hi_half);
#pragma unroll
        for (int j = 0; j < 4; ++j) k[j] = (k[j] == m) ? 0u : k[j];
        res = (hl == it) ? m : res; }
    return res;
}
__device__ __forceinline__ unsigned topk16_half2(unsigned k0, unsigned k1, int hl, bool hi_half) {
    unsigned res = 0u;
    for (int it = 0; it < 16; ++it) { const unsigned m = half_max_u32(max(k0, k1), hi_half); k0 = (k0 == m) ? 0u : k0; k1 = (k1 == m) ? 0u : k1; res = (hl == it) ? m : res; }
    return res;
}
__device__ __forceinline__ void cand_ab(int cidx50, int& a, int& b) {
    a = cidx50 < 16 ? 0 : cidx50 < 24 ? 1 : cidx50 < 29 ? 2 : cidx50 < 33 ? 3 : cidx50 < 36 ? 4 : cidx50 < 38 ? 5 : cidx50 < 40 ? 6 : cidx50 < 42 ? 7 : cidx50 - 34;
    const int st = cidx50 < 16 ? 0 : cidx50 < 24 ? 16 : cidx50 < 29 ? 24 : cidx50 < 33 ? 29 : cidx50 < 36 ? 33 : cidx50 < 38 ? 36 : cidx50 < 40 ? 38 : cidx50 < 42 ? 40 : cidx50;
    b = cidx50 - st;
}
__device__ __forceinline__ void peer_topk_pair(const LAS float* srow, int hp, LAS float* gsc, LAS int* isc, int lane) {
    const int hl = lane & 31, hb = lane & 32; const bool hi_half = lane >= 32; const int h = 2 * hp + (hi_half ? 1 : 0);
    const LAS float* sh = srow + h * 256;
    unsigned k1[4], k2[4];
#pragma unroll
    for (int j = 0; j < 4; ++j) { const int idx = hl + 32 * j; k1[j] = (fkey(sh[idx]) & ~127u) | (unsigned)(127 - idx); k2[j] = (fkey(sh[128 + idx]) & ~127u) | (unsigned)(127 - idx); }
    const unsigned r1 = topk16_half4(k1, hl, hi_half), r2 = topk16_half4(k2, hl, hi_half);
    const int i1 = 127 - (int)(r1 & 127u), i2 = 127 - (int)(r2 & 127u);
    const float v1 = sh[i1], v2 = sh[128 + i2];
    int a0, b0, a1, b1; cand_ab(hl, a0, b0); cand_ab(hl + 32, a1, b1);
    const float c0 = __shfl(v1, hb + a0) + __shfl(v2, hb + b0), c1 = __shfl(v1, hb + (a1 & 15)) + __shfl(v2, hb + (b1 & 15));
    const unsigned q0 = (fkey(c0) & ~255u) | (unsigned)(255 - (a0 * 16 + b0)), q1 = (hl + 32 < 50) ? ((fkey(c1) & ~255u) | (unsigned)(255 - (a1 * 16 + b1))) : 0u;
    const unsigned r3 = topk16_half2(q0, q1, hl, hi_half);
    const int ci = 255 - (int)(r3 & 255u);
    const float sc = __shfl(v1, hb + (ci >> 4)) + __shfl(v2, hb + (ci & 15));
    const int e = __shfl(i1, hb + (ci >> 4)) * 128 + __shfl(i2, hb + (ci & 15));
    const float mxa = __int_as_float(__builtin_amdgcn_readlane(__float_as_int(sc), 0)), mxb = __int_as_float(__builtin_amdgcn_readlane(__float_as_int(sc), 32));
    const float ex = hl < 16 ? __expf(sc - (hi_half ? mxb : mxa)) : 0.f;
    float sm = ex; sm += DPPF(sm, 0xB1); sm += DPPF(sm, 0x4E); sm += DPPF(sm, 0x141); sm += DPPF(sm, 0x140);
    if (hl < 16) { gsc[h * 16 + hl] = ex / sm; isc[h * 16 + hl] = e; }
}

constexpr size_t WS_PE_E = WS_P + 160 * MiB, WS_PE_CF = WS_PE_E + (size_t)MALL * 128 * 4;
constexpr int NSL = 16, SLW = 128;
constexpr size_t SLICE_BYTES = (size_t)16384 * SLW;
__device__ __forceinline__ void peer_token(const Ctx& c, int l, int r, int rn, int b, bool dry) {
    LAS float* gsc = (LAS float*)(c.lds + c.wave * 2048 + b * 1024);
    LAS int* isc = (LAS int*)(c.lds + c.wave * 2048 + b * 1024 + 512);
    LAS float* gscn = (LAS float*)(c.lds + c.wave * 2048 + (b ^ 1) * 1024); LAS int* iscn = (LAS int*)(c.lds + c.wave * 2048 + (b ^ 1) * 1024 + 512);
    const float* Sn = (const float*)(c.ws + WS_P) + (size_t)(rn < 0 ? r : rn) * DM;
    const int lane = c.lane;
    LAS float* snb = (LAS float*)(c.lds + 16384 + c.wave * 8192);
    f32x4 sv[8];
#pragma unroll
    for (int q = 0; q < 8; ++q) sv[q] = (rn >= 0) ? *(const f32x4*)(Sn + q * 256 + lane * 4) : (f32x4){0.f, 0.f, 0.f, 0.f};
    LDS_WAIT(); asm volatile("" ::: "memory");
    const bf16_t* hx = (const bf16_t*)(c.ws + WS_HX) + (size_t)r * DM;
    int hq[2][4]; float hdq;
    { float hv[2][16]; float mx = 0.f;
#pragma unroll
      for (int j = 0; j < 2; ++j) { float t0[8], t1[8]; unpack8(*(const u32x4*)(hx + j * 1024 + lane * 16), t0); unpack8(*(const u32x4*)(hx + j * 1024 + lane * 16 + 8), t1);
#pragma unroll
          for (int k = 0; k < 8; ++k) { hv[j][k] = t0[k]; hv[j][8 + k] = t1[k]; mx = fmaxf(mx, fmaxf(fabsf(t0[k]), fabsf(t1[k]))); } }
#pragma unroll
      for (int o = 32; o > 0; o >>= 1) mx = fmaxf(mx, __shfl_xor(mx, o));
      const float q_ = mx > 0.f ? 127.f / mx : 0.f; hdq = mx * (1.f / 127.f);
#pragma unroll
      for (int j = 0; j < 2; ++j)
#pragma unroll
          for (int d = 0; d < 4; ++d) hq[j][d] = (int)pk4_i8(hv[j][4 * d] * q_, hv[j][4 * d + 1] * q_, hv[j][4 * d + 2] * q_, hv[j][4 * d + 3] * q_); }
    const float* USC = (const float*)(c.ws + WS_USC) + (size_t)l * 16384;
    const unsigned char* PU = (const unsigned char*)(c.ws + ws_pu(l)); const unsigned char* PV = (const unsigned char*)(c.ws + ws_pv(l));
#define PEER_LOADROW(tab, wk, e_) do { const unsigned char* row_ = (tab) + (size_t)__builtin_amdgcn_readfirstlane(e_) * DM + lane * 16; wk[0] = *(const u32x4*)row_; wk[1] = *(const u32x4*)(row_ + 1024); } while (0)
#define PEER_IDX8(dst, i_) const u32x4 ia_##dst = *(const LAS u32x4*)(isc + (i_)), ib_##dst = *(const LAS u32x4*)(isc + (i_) + 4); \
        const int dst[8] = {(int)ia_##dst[0], (int)ia_##dst[1], (int)ia_##dst[2], (int)ia_##dst[3], (int)ib_##dst[0], (int)ib_##dst[1], (int)ib_##dst[2], (int)ib_##dst[3]}
    u32x4 w[8][2];
    float usc_ = USC[isc[lane & 7]];
    { PEER_IDX8(e0, 0);
#pragma unroll
      for (int k = 0; k < 8; ++k) PEER_LOADROW(PU, w[k], e0[k]); }
    if (rn >= 0) {
#pragma unroll
        for (int q = 0; q < 8; ++q) *(LAS f32x4*)(snb + q * 256 + lane * 4) = sv[q];
        LDS_WAIT(); asm volatile("" ::: "memory"); }
#pragma unroll 1
    for (int i = 0; i < 128; i += 8) {
        const bool has_next = i + 8 < 128;
        PEER_IDX8(en, has_next ? i + 8 : i);
        const float uscn_ = USC[isc[(has_next ? i + 8 : i) + (lane & 7)]];
        if (rn >= 0 && (i & 24) == 0) peer_topk_pair(snb, i >> 5, gscn, iscn, lane);
        float p[8];
#pragma unroll
        for (int k = 0; k < 8; ++k) {
            asm volatile("" : "+v"(w[k][0]), "+v"(w[k][1]));
            int s = 0;
#pragma unroll
            for (int j = 0; j < 2; ++j)
#pragma unroll
                for (int d = 0; d < 4; ++d) s = __builtin_amdgcn_sdot4((int)w[k][j][d], hq[j][d], s, false);
            p[k] = (float)s; asm volatile("" : "+v"(p[k]));
            if (has_next) PEER_LOADROW(PU, w[k], en[k]); }
        const bool b0 = lane & 1, b1 = lane & 2, b2 = lane & 4;
        float q[4], t[2];
#pragma unroll
        for (int m = 0; m < 4; ++m) q[m] = (b0 ? p[2 * m + 1] : p[2 * m]) + DPPF(b0 ? p[2 * m] : p[2 * m + 1], 0xB1);
#pragma unroll
        for (int m = 0; m < 2; ++m) t[m] = (b1 ? q[2 * m + 1] : q[2 * m]) + DPPF(b1 ? q[2 * m] : q[2 * m + 1], 0x4E);
        float s = (b2 ? t[1] : t[0]) + SWZ_XOR(b2 ? t[0] : t[1], 4);
        s += SWZ_XOR(s, 8); s += SWZ_XOR(s, 16); s += __shfl_xor(s, 32);
        if (lane < 8) gsc[i + lane] = gsc[i + lane] * gelu_tanh(s * (usc_ * hdq));
        usc_ = uscn_;
    }
#undef PEER_LOADROW
#undef PEER_IDX8
    LDS_WAIT(); asm volatile("" ::: "memory");
    { int* E = (int*)(c.ws + WS_PE_E) + (size_t)r * 128; float* CF = (float*)(c.ws + WS_PE_CF) + (size_t)r * 128;
      E[lane] = isc[lane]; E[64 + lane] = isc[64 + lane]; CF[lane] = gsc[lane]; CF[64 + lane] = gsc[64 + lane]; }
    LDS_WAIT(); asm volatile("" ::: "memory");
}
__device__ __forceinline__ void phase_peer(const Ctx& c, int l, int nrows, bool dry = false) {
    const int gw = c.wg * NWAVES + c.wave, NGW = c.G * NWAVES;
    int r = gw; if (r >= nrows) return;
    { const float* S0 = (const float*)(c.ws + WS_P) + (size_t)r * DM; LAS float* snb0 = (LAS float*)(c.lds + 16384 + c.wave * 8192);
#pragma unroll
      for (int q = 0; q < 8; ++q) *(LAS f32x4*)(snb0 + q * 256 + c.lane * 4) = *(const f32x4*)(S0 + q * 256 + c.lane * 4);
      LDS_WAIT(); asm volatile("" ::: "memory");
#pragma unroll 1
      for (int hp = 0; hp < 4; ++hp) peer_topk_pair(snb0, hp, (LAS float*)(c.lds + c.wave * 2048), (LAS int*)(c.lds + c.wave * 2048 + 512), c.lane);
      LDS_WAIT(); asm volatile("" ::: "memory"); }
    int b = 0;
#pragma unroll 1
    for (; r < nrows; r += NGW, b ^= 1) { const int rn = r + NGW; peer_token(c, l, r, rn < nrows ? rn : -1, b, dry); }
}
#define PEER_SLICE_BEGIN() { const int grp = c.wg & 7, wi = (c.wg >> 3) * NWAVES + c.wave, nwi = ((c.G - grp + 7) >> 3) * NWAVES; \
    _Pragma("unroll 1") for (int ps = 0; ps < 2; ++ps) { const int s = grp + 8 * ps; _Pragma("unroll 1") for (int r = wi; r < nrows; r += nwi) {
#define PEER_SLICE_END() } } }
__device__ __forceinline__ void phase_peer_v(const Ctx& c, int l, int nrows, bool dry) {
    const int lane = c.lane, rg = lane >> 3, ch = lane & 7;
    const int* Eb = (const int*)(c.ws + WS_PE_E); const float* CF = (const float*)(c.ws + WS_PE_CF);
    const bool b3 = lane & 8, b4 = lane & 16, b5 = lane & 32;
    const int grp = c.wg & 7, wi = (c.wg >> 3) * NWAVES + c.wave, nwi = ((c.G - grp + 7) >> 3) * NWAVES;
#define V_META(r_, e0_, e1_, c0_, c1_) do { if ((r_) < nrows) { e0_ = Eb[(size_t)(r_) * 128 + lane]; e1_ = Eb[(size_t)(r_) * 128 + 64 + lane]; c0_ = CF[(size_t)(r_) * 128 + lane]; c1_ = CF[(size_t)(r_) * 128 + 64 + lane]; } } while (0)
#pragma unroll 1
    for (int ps = 0; ps < 2; ++ps) { const int s = grp + 8 * ps;
        const unsigned char* tab = (const unsigned char*)(c.ws + ws_pv(l)) + (size_t)s * SLICE_BYTES + ch * 16;
        const int col = s * SLW + ch * 16 + (b3 ? 8 : 0) + (b4 ? 4 : 0) + (b5 ? 2 : 0);
        int r = wi; int e0 = 0, e1 = 0; float c0 = 0.f, c1 = 0.f;
        V_META(r, e0, e1, c0, c1);
#pragma unroll 1
        for (; r < nrows; r += nwi) {
            u32x4 w[16];
#pragma unroll
            for (int i = 0; i < 16; ++i) { const int e = __shfl(i < 8 ? e0 : e1, (8 * i + rg) & 63); w[i] = *(const u32x4*)(tab + (size_t)e * SLW); }
            int f0 = 0, f1 = 0; float d0 = 0.f, d1 = 0.f; V_META(r + nwi, f0, f1, d0, d1);
            const int vec = r < SEQ ? 0 : (r < MLAT ? 1 : 2);
            float* xr = (dry ? (float*)(c.ws + WS_YF) + (size_t)r * DM : xrow_ptr(c, r)) + col;
            const f32x2 gg = *(const f32x2*)((const float*)(c.ws + WS_MOD) + ((size_t)l * 3 + vec) * NMOD + 5 * DM + col); f32x2 xx = *(const f32x2*)xr;
            h16x2 o2[8];
#pragma unroll
            for (int j = 0; j < 8; ++j) o2[j] = (h16x2){(_Float16)0.f, (_Float16)0.f};
#pragma unroll
            for (int i = 0; i < 16; ++i) {
                asm volatile("" : "+v"(w[i]));
                const float ci_ = __shfl(i < 8 ? c0 : c1, (8 * i + rg) & 63);
                const h16x2 ci2 = {(_Float16)ci_, (_Float16)ci_};
#pragma unroll
                for (int d = 0; d < 4; ++d) {
                    const h16x2 lo_ = __builtin_bit_cast(h16x2, __builtin_amdgcn_cvt_scalef32_pk_f16_fp8((int)w[i][d], 1.0f, false)), hi_ = __builtin_bit_cast(h16x2, __builtin_amdgcn_cvt_scalef32_pk_f16_fp8((int)w[i][d], 1.0f, true));
                    o2[2 * d] = __builtin_elementwise_fma(lo_, ci2, o2[2 * d]); o2[2 * d + 1] = __builtin_elementwise_fma(hi_, ci2, o2[2 * d + 1]); }
                asm volatile("" : "+v"(o2[0])); }
            float o[16];
#pragma unroll
            for (int j = 0; j < 8; ++j) { o[2 * j] = (float)o2[j][0]; o[2 * j + 1] = (float)o2[j][1]; }
            float q8[8], q4[4], q2[2];
#pragma unroll
            for (int j = 0; j < 8; ++j) q8[j] = (b3 ? o[8 + j] : o[j]) + DPPF(b3 ? o[j] : o[8 + j], 0x128);
#pragma unroll
            for (int j = 0; j < 4; ++j) q4[j] = (b4 ? q8[4 + j] : q8[j]) + SWZ_XOR(b4 ? q8[j] : q8[4 + j], 16);
#pragma unroll
            for (int j = 0; j < 2; ++j) q2[j] = (b5 ? q4[2 + j] : q4[j]) + __shfl_xor(b5 ? q4[j] : q4[2 + j], 32);
            xx[0] += gg[0] * q2[0]; xx[1] += gg[1] * q2[1];
            *(f32x2*)xr = xx;
            e0 = f0; e1 = f1; c0 = d0; c1 = d1;
        }
    }
#undef V_META
}
struct Args { const float* in[29]; float* out; unsigned char* ws; int ph_lo, ph_hi; };
constexpr int PH_PER_LAYER = 10, N_PHASES = NLAYER * PH_PER_LAYER;
#ifndef G1_WGM
#define G1_WGM 3
#endif
constexpr int CW_BAR = 4096;

__global__ void __launch_bounds__(NTHREADS, 2) mk_fwd(Args args) {
    extern __shared__ __attribute__((aligned(16))) unsigned char lds_raw[];
    Ctx c0;
    c0.out = args.out; c0.ws = args.ws; c0.lds = (LAS unsigned char*)lds_raw;
    c0.tid = threadIdx.x; c0.lane = c0.tid & 63; c0.wave = __builtin_amdgcn_readfirstlane((int)(threadIdx.x >> 6)); c0.wg = blockIdx.x; c0.G = gridDim.x;
    volatile LAS unsigned* MISC = (volatile LAS unsigned*)(c0.lds + MISC_OFF);
    if (c0.tid < 64) MISC[c0.tid] = 0u;
    __syncthreads();
    const int lo = args.ph_lo, hi = args.ph_hi;
    XcdBarrier bar; bar.bar = (unsigned*)(c0.ws + WS_CTL) + CW_BAR; bar.x = 0; bar.st = MISC + 8;
    if (hi - lo > 1) bar = xcd_barrier_post((unsigned*)(c0.ws + WS_CTL) + CW_BAR, MISC + 8);
#ifndef ONLY_PH
#define ONLY_PH -1
#endif
#define IN(k) ((ONLY_PH < 0 || ((k) % PH_PER_LAYER) == ONLY_PH) && lo <= (k) && (k) < hi)
#define PH_BEGIN() Ctx c = c0; unsigned long long wsi_ = (unsigned long long)c0.ws, outi_ = (unsigned long long)c0.out; asm volatile("" : "+s"(wsi_), "+s"(outi_), "+s"(c.wg), "+s"(c.G), "+s"(c.wave)); \
    c.lane = lane_id_fresh(); c.tid = c.wave * 64 + c.lane; c.ws = (unsigned char*)(GAS unsigned char*)wsi_; c.out = (float*)(GAS float*)outi_;     \
    bf16_t* P = (bf16_t*)(c.ws + WS_P); bf16_t* HX = (bf16_t*)(c.ws + WS_HX); float* YF = (float*)(c.ws + WS_YF); (void)P; (void)HX; (void)YF
#ifndef PROBE_DUP
#define PROBE_DUP -1
#endif
#define REPS(k) for (int rep = 0, dry = (PROBE_DUP == (k)); rep < (PROBE_DUP == (k) ? 2 : 1); ++rep, dry = 0)
#define SEAM(k) do { if (IN(k) && IN((k) + 1)) { xcd_barrier(bar, c0.wave); if (PROBE_DUP == 20) xcd_barrier(bar, c0.wave); } } while (0)
    const bool early = (c0.G == 256);
#define TAIL_BEGIN() PH_BEGIN(); c.wg -= 32; c.G -= 32
    for (int l = 0; l < NLAYER; ++l) {
        const int pb = l * PH_PER_LAYER;
        const int mrows = (l == 0) ? MALL : MLAT;
        if (IN(pb + 0) && !(l == 1 && early)) REPS(0) {
            if (l == 0) { PH_BEGIN(); conv_colmax(c); }
            { PH_BEGIN(); conv_units(c, l); } { PH_BEGIN(); conv_tables(c, l); } { PH_BEGIN(); conv_small(c, l); }
            if (l == 0) { { PH_BEGIN(); conv_once(c); } xcd_barrier(bar, c0.wave); }
            { PH_BEGIN(); conv_transposes(c, l); } }
        if (!(l == 1 && early)) SEAM(pb + 0);
        if (IN(pb + 1)) REPS(1) { PH_BEGIN();
            if (l == 0) { GET_IN(); phase_norm<true>(c, l, MALL, SP_NMIX, 0, INP(I_X), INP(I_CTX)); } else phase_norm<true>(c, l, MALL, SP_NMIX, 0); }
        SEAM(pb + 1);
        if (IN(pb + 2)) REPS(2) { PH_BEGIN();
            pg8::Gemm g{HX, (const bf16_t*)(c.ws + WS_WIN), MALL, NIN, DM, DM, DM}; pg8::StaticOrder S; S.init(MALL, NIN, c.G, c.wg, G1_WGM);
            pg8::EpiI8 E{P, NIN, (const float*)(c.ws + WS_ADQ), (const float*)(c.ws + WS_WDQ)};
            pg8::gemm_phase<pg8::EpiI8, pg8::StaticOrder, true, true, false, true>(c.lds, g, S, E, c.wave);
        }
        SEAM(pb + 2);
        if (IN(pb + 3)) REPS(3) {
            int flip_ = (c0.wg >> 3) & 1; asm volatile("" : "+s"(flip_));
#pragma unroll 1
            for (int st = 0; st < 2; ++st) {
                if ((st ^ flip_) == 0) { { PH_BEGIN(); phase_qk(c, l, dry); } { PH_BEGIN(); phase_sc(c, l, dry); } }
                else { PH_BEGIN(); phase_lru1(c, l); }
                __syncthreads(); }
            if (PROBE_DUP == 30) { PH_BEGIN(); phase_lru1(c, l); } }
        SEAM(pb + 3);
        if (IN(pb + 4)) REPS(4) { { PH_BEGIN(); phase_m2(c, l, dry); } __syncthreads(); if (PROBE_DUP == 31) { PH_BEGIN(); phase_lru2(c, l, true); } { PH_BEGIN(); phase_lru2(c, l, dry); } }
        SEAM(pb + 4);
        if (IN(pb + 5)) REPS(5) { { PH_BEGIN();
            pg8::MixOrder S; S.init(mrows, c.G, c.wg);
            const bf16_t* WO = (const bf16_t*)(c.ws + WS_WO);
            { pg8::Gemm g{P + CQ, WO, mrows, DM, DM, NIN, DM}; pg8::EpiMerge<0> E{P + CGT, NIN, (bf16_t*)YF, HX};
              pg8::gemm_phase<pg8::EpiMerge<0>, pg8::MixOrder, true, true, true>(c.lds, g, S, E, c.wave); }
            { pg8::Gemm g{P + CLG, WO + (size_t)DM * DM, mrows, DM, DM, NIN, DM}; pg8::EpiMerge<1> E{P + CGT + DM, NIN, (bf16_t*)YF, HX};
              pg8::gemm_phase<pg8::EpiMerge<1>, pg8::MixOrder, true, true, true>(c.lds, g, S, E, c.wave); }
            { pg8::Gemm g{P + CBG, WO + (size_t)2 * DM * DM, mrows, DM, DM, NIN, DM}; pg8::EpiMerge<2> E{P + CGT + 2 * DM, NIN, (bf16_t*)YF, HX};
              pg8::gemm_phase<pg8::EpiMerge<2>, pg8::MixOrder, true, true, true>(c.lds, g, S, E, c.wave); }
            }
            if (l == 0 && early && c0.wg >= 32 && !dry) { { TAIL_BEGIN(); conv_transposes(c, 1, CV_WIN); } { TAIL_BEGIN(); conv_tables(c, 1, CV_PU); } }
        }
        SEAM(pb + 5);
        if (IN(pb + 6)) REPS(6) { { PH_BEGIN();
            pg8::Gemm g{HX, (const bf16_t*)(c.ws + WS_WOUT), mrows, DM, DM, DM, DM}; pg8::MixOrder S; S.init(mrows, c.G, c.wg);
            float* xl_ = dry ? YF : c.out; float* xc_ = dry ? YF + (size_t)MLAT * DM : (float*)(c.ws + WS_CTXS);
            const float* sl_ = xl_; const float* sc_ = xc_;
            if (l == 0 && !dry) { GET_IN(); sl_ = INP(I_X); sc_ = INP(I_CTX); }
            pg8::EpiResid E{xl_, xc_, (const float*)(c.ws + WS_MOD) + (size_t)l * 3 * NMOD + 2 * DM, sl_, sc_};
            pg8::gemm_phase<pg8::EpiResid, pg8::MixOrder, true, true, true>(c.lds, g, S, E, c.wave);
            }
            if (l == 0 && early && c0.wg >= 32 && !dry) { { TAIL_BEGIN(); conv_units(c, 1); } { TAIL_BEGIN(); conv_transposes(c, 1, CV_WO); } }
        }
        SEAM(pb + 6);
        if (IN(pb + 7)) REPS(7) { PH_BEGIN(); phase_norm(c, l, mrows, SP_NFFN, 3); }
        SEAM(pb + 7);
        if (IN(pb + 8)) REPS(8) { { PH_BEGIN();
            pg8::Gemm g{HX, (const bf16_t*)(c.ws + ws_wsc(l)), mrows, DM, DM, DM, DM}; pg8::MixOrder S; S.init(mrows, c.G, c.wg);
            pg8::EpiF32 E{(float*)(c.ws + WS_P), DM};
            pg8::gemm_phase<pg8::EpiF32, pg8::MixOrder, true, true, true>(c.lds, g, S, E, c.wave);
            }
            if (l == 0 && early && c0.wg >= 32 && !dry) { { TAIL_BEGIN(); conv_transposes(c, 1, CV_WOUT); } { TAIL_BEGIN(); conv_tables(c, 1, CV_PV | CV_LRU); } { TAIL_BEGIN(); conv_small(c, 1); } }
        }
        SEAM(pb + 8);
        if (IN(pb + 9)) REPS(9) {
            { PH_BEGIN(); phase_peer(c, l, mrows, dry); } xcd_barrier(bar, c0.wave);
            { PH_BEGIN(); phase_peer_v(c, l, mrows, dry); } }
        SEAM(pb + 9);
    }
#undef IN
#undef SEAM
}

extern "C" void kernel_launch(void* const* d_in, const int* in_sizes, int n_in, void* d_out, int out_size, void* d_ws, size_t ws_size, hipStream_t stream) {
    static int grid = 0;
    if (grid == 0) {
        if (n_in != 29 || in_sizes[0] != MLAT * DM || out_size != MLAT * DM || ws_size < WS_END) {
            fprintf(stderr, "kernel_launch: built for 29 inputs, x/out of %d floats, >= %zu bytes of workspace; got n_in %d, in0 %d, out %d, ws %zu; nothing launched\n", MLAT * DM, (size_t)WS_END, n_in, n_in > 0 ? in_sizes[0] : -1, out_size, ws_size);
            grid = -1; return; }
        int dev = 0, cus = 0, per_cu = 0;
        if (hipGetDevice(&dev) != hipSuccess || hipDeviceGetAttribute(&cus, hipDeviceAttributeMultiprocessorCount, dev) != hipSuccess) { fprintf(stderr, "kernel_launch: device query failed\n"); grid = -1; return; }
        if (hipFuncSetAttribute((const void*)mk_fwd, hipFuncAttributeMaxDynamicSharedMemorySize, LDS_BYTES) != hipSuccess) { fprintf(stderr, "kernel_launch: hipFuncSetAttribute failed\n"); grid = -1; return; }
        if (hipOccupancyMaxActiveBlocksPerMultiprocessor(&per_cu, (const void*)mk_fwd, NTHREADS, LDS_BYTES) != hipSuccess || per_cu < 1)
            fprintf(stderr, "kernel_launch: note: occupancy query reports %d workgroups per CU\n", per_cu);
        (void)hipGetLastError();
        grid = cus;
    }
    if (grid < 0) return;
    if (hipMemsetAsync((char*)d_ws + WS_CTL, 0, CTL_ZERO_BYTES, stream) != hipSuccess) { fprintf(stderr, "kernel_launch: memset failed\n"); return; }
    Args a{};
    for (int i = 0; i < 29; ++i) a.in[i] = (const float*)d_in[i];
    a.out = (float*)d_out; a.ws = (unsigned char*)d_ws;
#if MK_N_LAUNCHES == 1
    a.ph_lo = 0; a.ph_hi = N_PHASES;
    hipLaunchKernelGGL(mk_fwd, dim3(grid), dim3(NTHREADS), LDS_BYTES, stream, a);
#else
    for (int k = 0; k < N_PHASES; ++k) { a.ph_lo = k; a.ph_hi = k + 1; hipLaunchKernelGGL(mk_fwd, dim3(grid), dim3(NTHREADS), LDS_BYTES, stream, a); }
#endif
    const hipError_t le = hipPeekAtLastError();
    if (le != hipSuccess) fprintf(stderr, "kernel_launch: launch failed: %s\n", hipGetErrorName(le));
}
```

```cpp
#include <hip/hip_runtime.h>
#include <cstdio>
#include <cstdint>

#ifndef MK_N_LAUNCHES
#define MK_N_LAUNCHES 1
#endif
#if MK_N_LAUNCHES != 1
#error "the PEER phase carries a grid barrier of its own: this kernel is one launch only"
#endif

#define GAS __attribute__((address_space(1)))
#define LAS __attribute__((address_space(3)))
typedef unsigned short bf16_t;
typedef short bf16x8 __attribute__((ext_vector_type(8)));
typedef short s16x4 __attribute__((ext_vector_type(4)));
typedef float f32x2 __attribute__((ext_vector_type(2)));
typedef _Float16 h16x2 __attribute__((ext_vector_type(2)));
typedef float f32x4 __attribute__((ext_vector_type(4)));
typedef float f32x8 __attribute__((ext_vector_type(8)));
typedef float f32x16 __attribute__((ext_vector_type(16)));
typedef unsigned u32x2 __attribute__((ext_vector_type(2)));
typedef unsigned u32x4 __attribute__((ext_vector_type(4)));
typedef int i32x4 __attribute__((ext_vector_type(4)));

constexpr int DM = 2048, NB = 2, SEQ = 8192, NLAYER = 2, CTXL = 256;
constexpr int MLAT = NB * SEQ, MCTX = NB * CTXL, MALL = MLAT + MCTX;
constexpr int NIN = 19456;
constexpr int CQ = 0, CK = 2048, CV = 2560, CLX = 3072, CLG = 5120, CBG = 7168, CCG = 9216, CU = 11264, CGT = 13312;
constexpr int NKEY = SEQ + CTXL;
constexpr int NCHUNK = NKEY / 64;
constexpr int NMOD = 6 * DM;
constexpr float EPS = 1e-6f;
constexpr int NWAVES = 8, NTHREADS = 512;

constexpr size_t MiB = 1u << 20;
constexpr size_t al256(size_t x) { return (x + 255) / 256 * 256; }
constexpr size_t WS_CTL = 0, CTL_ZERO_BYTES = 1 * MiB;
constexpr size_t WS_MOD = WS_CTL + CTL_ZERO_BYTES;
constexpr size_t WS_ROPE = WS_MOD + al256((size_t)NLAYER * 3 * NMOD * 4);
constexpr size_t WS_SP = WS_ROPE + al256(2 * 128 * 32 * 4);
constexpr size_t WS_CTXS = WS_SP + al256(36864 * 4);
constexpr size_t WS_LSUM = WS_CTXS + al256((size_t)MCTX * DM * 4);
constexpr size_t WS_WLRU = WS_LSUM + al256((size_t)2 * 2 * NB * NCHUNK * DM * 4);
constexpr size_t WS_KC = WS_WLRU + al256((size_t)16 * 512 * 128 * 2);
constexpr size_t WS_VC = WS_KC + al256((size_t)NB * 4 * NKEY * 128 * 2);
constexpr size_t WS_WIN = WS_VC + al256((size_t)NB * 4 * NKEY * 128 * 2);
constexpr size_t WS_CMAX = WS_WIN + (size_t)NIN * DM;
constexpr size_t WS_WDQ = WS_CMAX + al256((size_t)2 * 32 * NIN * 4);
constexpr size_t WS_ADQ = WS_WDQ + al256((size_t)NIN * 4);
constexpr size_t WS_WO = WS_WIN + al256((size_t)NIN * DM * 2);
constexpr size_t WS_WOUT = WS_WO + al256((size_t)3 * DM * DM * 2);
constexpr size_t WS_WSC = WS_WOUT + al256((size_t)DM * DM * 2);
constexpr size_t WS_PU = WS_WSC + al256((size_t)DM * DM * 2);
constexpr size_t WS_PV = WS_PU + al256((size_t)16384 * DM);
constexpr size_t WS_HX = WS_PV + al256((size_t)16384 * DM);
constexpr size_t WS_YF = WS_HX + al256((size_t)MALL * DM * 2);
constexpr size_t WS_P = WS_YF + al256((size_t)MALL * DM * 4);
static_assert(WS_ADQ + (size_t)MALL * 4 <= WS_WO, "the int8 side tables must fit the spare half of the w_in region");
constexpr size_t WS_PU2 = WS_P + al256((size_t)MALL * NIN * 2);
constexpr size_t WS_PV2 = WS_PU2 + al256((size_t)16384 * DM);
constexpr size_t WS_WSC2 = WS_PV2 + al256((size_t)16384 * DM);
constexpr size_t WS_USC = WS_WSC2 + al256((size_t)DM * DM * 2);
constexpr size_t WS_END = WS_USC + al256((size_t)2 * 16384 * 4);
__host__ __device__ constexpr size_t ws_pu(int l) { return l ? WS_PU2 : WS_PU; }
__host__ __device__ constexpr size_t ws_pv(int l) { return l ? WS_PV2 : WS_PV; }
__host__ __device__ constexpr size_t ws_wsc(int l) { return l ? WS_WSC2 : WS_WSC; }

constexpr int SP_NMIX = 0, SP_NFFN = 2048, SP_QN = 4096, SP_KN = 4224, SP_LCW = 4352, SP_LCB = 12544, SP_LBA = 14592, SP_LBX = 18688, SP_LSP = 22784, SP_SCW = 26880, SP_SCB = 33024, SP_END = 35072;

constexpr int LDS_BYTES = 147456;
constexpr int MISC_OFF = 147456 - 256;
constexpr int LDS_WORK = MISC_OFF;

__device__ __forceinline__ unsigned cvt_pk_bf16(float lo, float hi) { unsigned r; asm volatile("v_cvt_pk_bf16_f32 %0, %1, %2" : "=v"(r) : "v"(lo), "v"(hi)); return r; }
__device__ __forceinline__ unsigned pk4_i8(float a, float b, float c, float d) {
    const int ia = (int)__builtin_rintf(a), ib = (int)__builtin_rintf(b), ic = (int)__builtin_rintf(c), id = (int)__builtin_rintf(d);
    return ((unsigned)ia & 255u) | (((unsigned)ib & 255u) << 8) | (((unsigned)ic & 255u) << 16) | ((unsigned)id << 24); }
__device__ __forceinline__ float bf_lo(unsigned w) { return __uint_as_float(w << 16); }
__device__ __forceinline__ float bf_hi(unsigned w) { return __uint_as_float(w & 0xffff0000u); }
__device__ __forceinline__ float bf1(bf16_t h) { return __uint_as_float(((unsigned)h) << 16); }
__device__ __forceinline__ bf16_t f2bf(float f) { return (bf16_t)(cvt_pk_bf16(f, 0.f) & 0xffffu); }
__device__ __forceinline__ float sigmoidf_(float x) { return __builtin_amdgcn_rcpf(1.f + __expf(-x)); }
__device__ __forceinline__ float gelu_tanh(float x) { const float z = 0.7978845608028654f * (x + 0.044715f * x * x * x); const float e = __expf(2.f * z); return 0.5f * x * (2.f - 2.f * __builtin_amdgcn_rcpf(e + 1.f)); }
__device__ __forceinline__ float wave_sum(float v) {
#pragma unroll
    for (int o = 1; o < 64; o <<= 1) v += __shfl_xor(v, o);
    return v;
}
__device__ __forceinline__ float wave_max(float v) {
#pragma unroll
    for (int o = 1; o < 64; o <<= 1) v = fmaxf(v, __shfl_xor(v, o));
    return v;
}
template <class T> __device__ __forceinline__ T* as_global(T* p) { return (T*)(GAS T*)p; }
__device__ __forceinline__ int lane_id_fresh() { int l; asm volatile("v_mbcnt_lo_u32_b32 %0, -1, 0\n\tv_mbcnt_hi_u32_b32 %0, -1, %0" : "=v"(l)); return l; }
#define DPPF(v, ctrl) __int_as_float(__builtin_amdgcn_update_dpp(0, __float_as_int(v), ctrl, 0xF, 0xF, true))
#define LDS_WAIT() asm volatile("s_waitcnt lgkmcnt(0)" ::: "memory")
#define VM_WAIT() asm volatile("s_waitcnt vmcnt(0)" ::: "memory")

#define XB_TMO      128
#define XB_XCNT(j)  (256  + 64 * (j))
#define XB_XSUB(j)  (1280 + 64 * (j))
#define XB_XGEN(j)  (2304 + 64 * (j))
#define XB_TOP      3328
#define XB_TOPGEN   3392
#define XCD_BAR_WORDS 3456
#define XB_SPIN_CAP (1u << 23)
__device__ __forceinline__ unsigned xb_ld(unsigned* p)              { return __hip_atomic_load(p, __ATOMIC_RELAXED, __HIP_MEMORY_SCOPE_AGENT); }
__device__ __forceinline__ unsigned xb_add(unsigned* p, unsigned v) { return __hip_atomic_fetch_add(p, v, __ATOMIC_RELAXED, __HIP_MEMORY_SCOPE_AGENT); }
__device__ __forceinline__ unsigned xb_xcc_id() { return (unsigned)__builtin_amdgcn_s_getreg((3 << 11) | 20) & 0xFu; }
#define XB_SPIN(cond, bar) do { unsigned _sp = 0; while (cond) { __builtin_amdgcn_s_sleep(1); \
    if ((++_sp & 255u) == 0u) { if (xb_ld(&(bar)[XB_TMO])) break; if (_sp > XB_SPIN_CAP) { atomicAdd(&(bar)[XB_TMO], 1u); break; } } } } while (0)
struct XcdBarrier { unsigned* bar; unsigned x; volatile LAS unsigned* st; };
__device__ __forceinline__ XcdBarrier xcd_barrier_post(unsigned* bar, volatile LAS unsigned* st) {
    XcdBarrier b; b.bar = bar; b.x = xb_xcc_id(); b.st = st;
    if (threadIdx.x == 0) (void)xb_add(&bar[XB_XCNT(b.x)], 1u);
    return b;
}
__device__ __forceinline__ void xcd_barrier_complete(unsigned* bar, unsigned x, unsigned& nloc, unsigned& nx) {
    const unsigned G = gridDim.x * gridDim.y * gridDim.z;
    unsigned sum, cnt, mine, sp = 0u;
    for (;;) {
        sum = 0u; cnt = 0u; mine = 0u;
#pragma unroll
        for (unsigned j = 0; j < 16; ++j) { const unsigned c = xb_ld(&bar[XB_XCNT(j)]); sum += c; cnt += (c > 0u) ? 1u : 0u; mine = (j == x) ? c : mine; }
        if (sum == G) break;
        __builtin_amdgcn_s_sleep(1);
        if ((++sp & 255u) == 0u) { if (xb_ld(&bar[XB_TMO])) break; if (sp > XB_SPIN_CAP) { atomicAdd(&bar[XB_TMO], 1u); break; } }
    }
    nloc = mine > 0u ? mine : 1u; nx = cnt > 0u ? cnt : 1u;
}
__device__ __forceinline__ void xcd_barrier(const XcdBarrier& b, int wave) {
    asm volatile("s_waitcnt vmcnt(0)" ::: "memory");
    __syncthreads();
    if (wave == 0 && lane_id_fresh() == 0) {
        unsigned* bar = b.bar;
        __builtin_amdgcn_s_waitcnt(0);
        unsigned nloc = b.st[0], nx = b.st[1];
        if (nloc == 0u) { xcd_barrier_complete(bar, b.x, nloc, nx); b.st[0] = nloc; b.st[1] = nx; }
        const unsigned old = xb_add(&bar[XB_XSUB(b.x)], 1u);
        const unsigned gen = old / nloc;
        if (old + 1u == (gen + 1u) * nloc) {
            __builtin_amdgcn_fence(__ATOMIC_RELEASE, "agent");
            asm volatile("s_waitcnt vmcnt(0)" ::: "memory");
            const unsigned og = xb_add(&bar[XB_TOP], 1u);
            const unsigned tg = og / nx;
            if (og + 1u == (tg + 1u) * nx) xb_add(&bar[XB_TOPGEN], 1u);
            else XB_SPIN(xb_ld(&bar[XB_TOPGEN]) == tg, bar);
            __builtin_amdgcn_fence(__ATOMIC_ACQUIRE, "agent");
            xb_add(&bar[XB_XGEN(b.x)], 1u);
            asm volatile("s_waitcnt vmcnt(0)" ::: "memory");
        } else {
            XB_SPIN(xb_ld(&bar[XB_XGEN(b.x)]) == gen, bar);
            __builtin_amdgcn_fence(__ATOMIC_ACQUIRE, "agent");
            asm volatile("s_waitcnt vmcnt(0)" ::: "memory");
        }
    }
    __syncthreads();
}
#ifndef MIX_WGM
#define MIX_WGM 8
#endif
namespace pg8 {
#define PG8_LAS __attribute__((address_space(3)))
constexpr int BM = 256, BK = 64, HALF = 128, HTB = HALF * BK * 2, STAGE_BYTES = 8 * HTB, NXCD = 8, WGM = 8;
__host__ __device__ __forceinline__ int lds_byte(int r, int c) { const int st = (r >> 4) * 2 + (c >> 5), rr = r & 15, cc = c & 31, ob = rr * 64 + cc * 2; return st * 1024 + (ob ^ (((ob >> 9) & 1) << 5)); }
__host__ __device__ __forceinline__ void stage_rc(int b, int& R, int& C) { const int st = b / 1024, sb = b % 1024, swz = sb ^ (((sb >> 9) & 1) << 5); R = (st >> 1) * 16 + swz / 64; C = (st & 1) * 32 + (swz % 64) / 2; }
__host__ __device__ __forceinline__ int perm32(int rho) { const int n = rho >> 4, i = rho & 15; return 8 * (i >> 2) + 4 * n + (i & 3); }

struct Unit { int pm, pn, nh; };
struct Gemm { const bf16_t* A; const bf16_t* Bt; int M, N, K, lda, ldb; };

struct StaticOrder {
    int nM, nN, nwg, G, c, wgm = WGM;
    __host__ __device__ void init(int M, int N, int G_, int c_, int wgm_ = WGM) { nM = M / BM; nN = N / BM; nwg = nM * nN; G = G_; c = c_; wgm = wgm_; }
    __host__ __device__ bool next(int i, Unit& u) const {
        const long L = (long)i * G + c; if (L >= nwg) return false;
        int wgid = (int)L; { const int q = nwg / NXCD, r = nwg % NXCD, xcd = wgid % NXCD, off = wgid / NXCD; wgid = (xcd < r ? xcd * (q + 1) : r * (q + 1) + (xcd - r) * q) + off; }
        const int nig = wgm * nN, gid = wgid / nig, fm = gid * wgm, gsz = (nM - fm) < wgm ? (nM - fm) : wgm;
        u.pm = 2 * (fm + ((wgid % nig) % gsz)); u.pn = (wgid % nig) / gsz; u.nh = 2; return true;
    }
    __device__ __forceinline__ void a_ready(const Unit&) const {}
    __device__ __forceinline__ void done(const Unit&) const {}
};

struct MixOrder {
    StaticOrder lat; int nhalf;
    __host__ __device__ void init(int mrows, int G_, int c_) { lat.init(MLAT, 2048, G_, c_, MIX_WGM); nhalf = ((mrows - MLAT) / HALF) * 8; }
    __host__ __device__ bool next(int i, Unit& u) const {
        if (lat.next(i, u)) return true;
        const long h = (long)i * lat.G + lat.c - lat.nwg; if (h < 0 || h >= nhalf) return false;
        u.pm = MLAT / HALF + (int)(h >> 3); u.pn = (int)(h & 7); u.nh = 1; return true;
    }
    __device__ __forceinline__ void a_ready(const Unit&) const {}
    __device__ __forceinline__ void done(const Unit&) const {}
};

struct EpiBf16 {
    static constexpr bool PERM = true, AFTER_DRAIN = false;
    bf16_t* O; int ldc;
    __device__ __forceinline__ void operator()(const f32x4 (&acc)[2][2][4][2], const Unit& u, int wr, int wc, int fr, int fq) const {
        const int row0 = u.pm * HALF + wr * 64 + fr, col0 = u.pn * BM + wc * 32 + 8 * fq;
#pragma unroll
        for (int ai = 0; ai < 2; ++ai) if (ai < u.nh)
#pragma unroll
            for (int m = 0; m < 4; ++m) { bf16_t* rowp = O + (size_t)(row0 + ai * HALF + m * 16) * ldc + col0;
#pragma unroll
                for (int bj = 0; bj < 2; ++bj) { const f32x4 v0 = acc[ai][bj][m][0], v1 = acc[ai][bj][m][1];
                    u32x4 w; w.x = cvt_pk_bf16(v0[0], v0[1]); w.y = cvt_pk_bf16(v0[2], v0[3]); w.z = cvt_pk_bf16(v1[0], v1[1]); w.w = cvt_pk_bf16(v1[2], v1[3]);
                    *(u32x4*)(rowp + bj * HALF) = w; } }
    }
};
struct EpiI8 {
    static constexpr bool PERM = true, AFTER_DRAIN = false;
    bf16_t* O; int ldc; const float* rstep; const float* cstep;
    __device__ __forceinline__ void operator()(const f32x4 (&acc)[2][2][4][2], const Unit& u, int wr, int wc, int fr, int fq) const {
        const int row0 = u.pm * HALF + wr * 64 + fr, col0 = u.pn * BM + wc * 32 + 8 * fq;
        f32x4 cs[2][2];
#pragma unroll
        for (int bj = 0; bj < 2; ++bj) { cs[bj][0] = *(const f32x4*)(cstep + col0 + bj * HALF); cs[bj][1] = *(const f32x4*)(cstep + col0 + bj * HALF + 4); }
#pragma unroll
        for (int ai = 0; ai < 2; ++ai) if (ai < u.nh)
#pragma unroll
            for (int m = 0; m < 4; ++m) { const int r = row0 + ai * HALF + m * 16; bf16_t* rowp = O + (size_t)r * ldc + col0; const float rs = rstep[r];
#pragma unroll
                for (int bj = 0; bj < 2; ++bj) {
                    const f32x4 v0 = __builtin_convertvector(__builtin_bit_cast(i32x4, acc[ai][bj][m][0]), f32x4) * (cs[bj][0] * rs), v1 = __builtin_convertvector(__builtin_bit_cast(i32x4, acc[ai][bj][m][1]), f32x4) * (cs[bj][1] * rs);
                    u32x4 w; w.x = cvt_pk_bf16(v0[0], v0[1]); w.y = cvt_pk_bf16(v0[2], v0[3]); w.z = cvt_pk_bf16(v1[0], v1[1]); w.w = cvt_pk_bf16(v1[2], v1[3]);
                    *(u32x4*)(rowp + bj * HALF) = w; } }
    }
};
struct EpiF32 {
    static constexpr bool PERM = false, AFTER_DRAIN = false;
    float* C; int ldc;
    __device__ __forceinline__ void operator()(const f32x4 (&acc)[2][2][4][2], const Unit& u, int wr, int wc, int fr, int fq) const {
        const int row0 = u.pm * HALF + wr * 64 + fr, col0 = u.pn * BM + wc * 32 + 4 * fq;
#pragma unroll
        for (int ai = 0; ai < 2; ++ai) if (ai < u.nh)
#pragma unroll
            for (int m = 0; m < 4; ++m) { float* rowp = C + (size_t)(row0 + ai * HALF + m * 16) * ldc + col0;
#pragma unroll
                for (int bj = 0; bj < 2; ++bj)
#pragma unroll
                    for (int n = 0; n < 2; ++n) *(f32x4*)(rowp + bj * HALF + n * 16) = acc[ai][bj][m][n]; }
    }
};
template <int MODE> struct EpiMerge {
    static constexpr bool PERM = true, AFTER_DRAIN = false;
    const bf16_t* Gt; int ldg; bf16_t* Y; bf16_t* YB;
    __device__ __forceinline__ void operator()(const f32x4 (&acc)[2][2][4][2], const Unit& u, int wr, int wc, int fr, int fq) const {
        const int row0 = u.pm * HALF + wr * 64 + fr, col0 = u.pn * BM + wc * 32 + 8 * fq;
#pragma unroll
        for (int ai = 0; ai < 2; ++ai) if (ai < u.nh)
#pragma unroll
            for (int m = 0; m < 4; ++m) { const size_t r = (size_t)(row0 + ai * HALF + m * 16);
#pragma unroll
                for (int bj = 0; bj < 2; ++bj) { const int c = col0 + bj * HALF;
                    const u32x4 gw = *(const u32x4*)(Gt + r * ldg + c);
                    f32x4 g0, g1;
                    g0[0] = sigmoidf_(bf_lo(gw.x)); g0[1] = sigmoidf_(bf_hi(gw.x)); g0[2] = sigmoidf_(bf_lo(gw.y)); g0[3] = sigmoidf_(bf_hi(gw.y));
                    g1[0] = sigmoidf_(bf_lo(gw.z)); g1[1] = sigmoidf_(bf_hi(gw.z)); g1[2] = sigmoidf_(bf_lo(gw.w)); g1[3] = sigmoidf_(bf_hi(gw.w));
                    f32x4 y0 = g0 * acc[ai][bj][m][0], y1 = g1 * acc[ai][bj][m][1];
                    if (MODE != 0) { const u32x4 yw = *(const u32x4*)(Y + r * 2048 + c);
                        y0 += (f32x4){bf_lo(yw.x), bf_hi(yw.x), bf_lo(yw.y), bf_hi(yw.y)}; y1 += (f32x4){bf_lo(yw.z), bf_hi(yw.z), bf_lo(yw.w), bf_hi(yw.w)}; }
                    u32x4 w; w.x = cvt_pk_bf16(y0[0], y0[1]); w.y = cvt_pk_bf16(y0[2], y0[3]); w.z = cvt_pk_bf16(y1[0], y1[1]); w.w = cvt_pk_bf16(y1[2], y1[3]);
                    *(u32x4*)((MODE != 2 ? Y : YB) + r * 2048 + c) = w; } }
    }
};
struct EpiResid {
    static constexpr bool PERM = true, AFTER_DRAIN = false;
    float* xlat; float* xctx; const float* gate;
    const float* slat; const float* sctx;
    __device__ __forceinline__ void operator()(const f32x4 (&acc)[2][2][4][2], const Unit& u, int wr, int wc, int fr, int fq) const {
        const int vec = u.pm < 64 ? 0 : (u.pm < 128 ? 1 : 2);
        float* xb = u.pm < 128 ? xlat + (size_t)u.pm * HALF * 2048 : xctx + (size_t)(u.pm - 128) * HALF * 2048;
        const float* sb = u.pm < 128 ? slat + (size_t)u.pm * HALF * 2048 : sctx + (size_t)(u.pm - 128) * HALF * 2048;
        const int lrow0 = wr * 64 + fr, col0 = u.pn * BM + wc * 32 + 8 * fq;
        const float* gp = gate + (size_t)vec * 12288 + col0;
#pragma unroll
        for (int bj = 0; bj < 2; ++bj) { const f32x4 g0 = *(const f32x4*)(gp + bj * HALF), g1 = *(const f32x4*)(gp + bj * HALF + 4);
#pragma unroll
            for (int ai = 0; ai < 2; ++ai) if (ai < u.nh)
#pragma unroll
                for (int m = 0; m < 4; ++m) { const size_t off = (size_t)(lrow0 + ai * HALF + m * 16) * 2048 + col0 + bj * HALF; float* xp = xb + off; const float* sp = sb + off;
                    const f32x4 x0 = *(const f32x4*)sp + g0 * acc[ai][bj][m][0], x1 = *(const f32x4*)(sp + 4) + g1 * acc[ai][bj][m][1];
                    *(f32x4*)xp = x0; *(f32x4*)(xp + 4) = x1; } }
    }
};

template <class Epi, class Sched, bool ALIGN_EPI = false, bool SP2 = false, bool HALFU = false, bool I8 = false>
__device__ __forceinline__ void gemm_phase(PG8_LAS unsigned char* lds, const Gemm g, const Sched& S, const Epi& E, int wave_) {
    int tid_ = wave_ * 64 + lane_id_fresh();
    const int tid = tid_, wid = __builtin_amdgcn_readfirstlane(tid >> 6), lane = tid & 63, wr = wid >> 2, wc = wid & 3, fr = lane & 15, fq = lane >> 4;
    constexpr int ES = I8 ? 1 : 2;
    const int K = g.K, nt = K * ES / (BK * 2);
    unsigned voffA[2], voffB[2];
#pragma unroll
    for (int i = 0; i < 2; ++i) { int R, C; stage_rc(tid * 16 + i * 8192, R, C); const int Rb = Epi::PERM ? ((R & ~31) + perm32(R & 31)) : R;
        voffA[i] = (unsigned)(R * g.lda * ES + C * 2); voffB[i] = (unsigned)(Rb * g.ldb * ES + C * 2); }
    const size_t kstep = (size_t)(BK * 2);
    const size_t hstepA = (size_t)HALF * g.lda * ES, hstepB = (size_t)HALF * g.ldb * ES;
    const size_t tstepB = 2 * hstepB;
    const unsigned ldsw = (unsigned)wid * 1024u;
    const int aoff = lds_byte(wr * 64 + fr, fq * 8), boff = lds_byte(wc * 32 + fr, fq * 8);
#define PG8_SA(b, h) (((b) * 2 + (h)) * HTB)
#define PG8_SB(b, h) ((4 + (b) * 2 + (h)) * HTB)
#define PG8_STAGE(bufoff, gbase, voff) do { _Pragma("unroll") for (int _i = 0; _i < 2; ++_i) \
        __builtin_amdgcn_global_load_lds((const unsigned*)((const char*)(gbase) + (voff)[_i]), (PG8_LAS unsigned*)(lds + (bufoff) + ldsw + _i * 8192), 16, 0, 0); } while (0)
#define PG8_LDA(dst, b, h) do { _Pragma("unroll") for (int m = 0; m < 4; ++m) _Pragma("unroll") for (int k = 0; k < 2; ++k) dst[m][k] = *(const PG8_LAS bf16x8*)(lds + PG8_SA(b, h) + aoff + m * 2048 + k * 1024); } while (0)
#define PG8_LDB(dst, b, h) do { _Pragma("unroll") for (int n = 0; n < 2; ++n) _Pragma("unroll") for (int k = 0; k < 2; ++k) dst[n][k] = *(const PG8_LAS bf16x8*)(lds + PG8_SB(b, h) + boff + n * 2048 + k * 1024); } while (0)
#define PG8_MMA(ai, bj, At, Bt) do { __builtin_amdgcn_s_setprio(1); _Pragma("unroll") for (int m = 0; m < 4; ++m) _Pragma("unroll") for (int n = 0; n < 2; ++n) _Pragma("unroll") for (int k = 0; k < 2; ++k) \
        { if constexpr (I8) acc[ai][bj][m][n] = __builtin_bit_cast(f32x4, __builtin_amdgcn_mfma_i32_16x16x64_i8(__builtin_bit_cast(i32x4, Bt[n][k]), __builtin_bit_cast(i32x4, At[m][k]), __builtin_bit_cast(i32x4, acc[ai][bj][m][n]), 0, 0, 0)); \
          else acc[ai][bj][m][n] = __builtin_amdgcn_mfma_f32_16x16x32_bf16(Bt[n][k], At[m][k], acc[ai][bj][m][n], 0, 0, 0); } __builtin_amdgcn_s_setprio(0); } while (0)
#define PG8_WAIT_V(n) asm volatile("s_waitcnt vmcnt(" #n ")" ::: "memory")
#define PG8_WAIT_L(n) asm volatile("s_waitcnt lgkmcnt(" #n ")" ::: "memory")
#define PG8_BAR __builtin_amdgcn_s_barrier()
#define PG8_SCHED __builtin_amdgcn_sched_barrier(0)
    Unit cur, nxt; int ui = 0;
    if (!S.next(0, cur)) return;
    f32x4 acc[2][2][4][2];
#pragma unroll
    for (int a = 0; a < 2; ++a)
#pragma unroll
        for (int b = 0; b < 2; ++b)
#pragma unroll
            for (int m = 0; m < 4; ++m)
#pragma unroll
                for (int n = 0; n < 2; ++n) acc[a][b][m][n] = (f32x4){0.f, 0.f, 0.f, 0.f};
    bf16x8 At[4][2], B0[2][2], B1[2][2];
    const char* cA = (const char*)g.A + (size_t)cur.pm * hstepA; const char* cB = (const char*)g.Bt + (size_t)cur.pn * tstepB;
    size_t chA = (!HALFU || cur.nh == 2) ? hstepA : 0;
    S.a_ready(cur);
    if constexpr (SP2) {
        PG8_STAGE(PG8_SB(0, 0), cB, voffB); PG8_STAGE(PG8_SB(0, 1), cB + hstepB, voffB); PG8_STAGE(PG8_SA(0, 0), cA, voffA); PG8_STAGE(PG8_SA(0, 1), cA + chA, voffA);
        if (wr == 1) PG8_BAR;
        PG8_WAIT_V(2); PG8_BAR;
        PG8_STAGE(PG8_SB(1, 0), cB + kstep, voffB); PG8_STAGE(PG8_SA(1, 0), cA + kstep, voffA); PG8_STAGE(PG8_SB(1, 1), cB + hstepB + kstep, voffB);
        PG8_WAIT_V(6); PG8_BAR;
    } else {
        PG8_STAGE(PG8_SB(0, 0), cB, voffB); PG8_STAGE(PG8_SA(0, 0), cA, voffA); PG8_STAGE(PG8_SB(0, 1), cB + hstepB, voffB); PG8_STAGE(PG8_SA(0, 1), cA + chA, voffA);
        if (wr == 1) PG8_BAR;
        PG8_WAIT_V(4); PG8_BAR;
        PG8_STAGE(PG8_SB(1, 0), cB + kstep, voffB); PG8_STAGE(PG8_SA(1, 0), cA + kstep, voffA); PG8_STAGE(PG8_SB(1, 1), cB + hstepB + kstep, voffB);
        PG8_WAIT_V(6); PG8_BAR;
    }
    for (;;) {
        const bool has_next = S.next(ui + 1, nxt);
        const char* nA = has_next ? (const char*)g.A + (size_t)nxt.pm * hstepA : cA; const size_t nhA = has_next ? ((!HALFU || nxt.nh == 2) ? hstepA : 0) : chA; const bool full = (!HALFU || cur.nh == 2);
        const char* nA_ = nA; (void)nA_; const char* nB = has_next ? (const char*)g.Bt + (size_t)nxt.pn * tstepB : cB;
        for (int t = 0; t < nt; t += 2) {
            const bool last = (t == nt - 2);
            const char* a1 = cA + (size_t)(t + 1) * kstep;
            const char* a2 = last ? nA : cA + (size_t)(t + 2) * kstep; const char* b2 = last ? nB : cB + (size_t)(t + 2) * kstep;
            const char* a3 = a2 + kstep; const char* b3 = b2 + kstep;
            const size_t h2A = last ? nhA : chA;
            if (last && has_next) S.a_ready(nxt);
            if constexpr (SP2) {
            PG8_LDB(B0, 0, 0); PG8_LDB(B1, 0, 1); PG8_SCHED; PG8_LDA(At, 0, 0); PG8_STAGE(PG8_SA(1, 1), a1 + chA, voffA);
            PG8_WAIT_V(8); PG8_WAIT_L(0); PG8_BAR; PG8_MMA(0, 0, At, B0); PG8_MMA(0, 1, At, B1); PG8_BAR; PG8_SCHED;
            PG8_LDA(At, 0, 1); PG8_STAGE(PG8_SB(0, 0), b2, voffB); PG8_STAGE(PG8_SB(0, 1), b2 + hstepB, voffB); PG8_STAGE(PG8_SA(0, 0), a2, voffA);
            PG8_WAIT_V(8); PG8_WAIT_L(0); PG8_BAR; if (full) { PG8_MMA(1, 0, At, B0); PG8_MMA(1, 1, At, B1); } PG8_BAR; PG8_SCHED;
            PG8_LDB(B0, 1, 0); PG8_LDB(B1, 1, 1); PG8_SCHED; PG8_LDA(At, 1, 0); PG8_STAGE(PG8_SA(0, 1), a2 + h2A, voffA);
            PG8_WAIT_V(8); PG8_WAIT_L(0); PG8_BAR; PG8_MMA(0, 0, At, B0); PG8_MMA(0, 1, At, B1); PG8_BAR; PG8_SCHED;
            PG8_LDA(At, 1, 1); PG8_STAGE(PG8_SB(1, 0), b3, voffB); PG8_STAGE(PG8_SB(1, 1), b3 + hstepB, voffB); PG8_STAGE(PG8_SA(1, 0), a3, voffA);
            PG8_WAIT_V(8); PG8_WAIT_L(0); PG8_BAR; if (full) { PG8_MMA(1, 0, At, B0); PG8_MMA(1, 1, At, B1); } PG8_BAR; PG8_SCHED;
            } else {
            PG8_LDB(B0, 0, 0); PG8_SCHED; PG8_LDA(At, 0, 0); PG8_STAGE(PG8_SA(1, 1), a1 + chA, voffA);
            PG8_WAIT_L(8); PG8_BAR; PG8_WAIT_L(0); PG8_MMA(0, 0, At, B0); PG8_BAR; PG8_SCHED;
            PG8_LDB(B1, 0, 1); PG8_STAGE(PG8_SB(0, 0), b2, voffB);
            PG8_BAR; PG8_WAIT_L(0); PG8_MMA(0, 1, At, B1); PG8_BAR;
            PG8_LDA(At, 0, 1); PG8_STAGE(PG8_SA(0, 0), a2, voffA);
            PG8_BAR; PG8_WAIT_L(0); if (full) PG8_MMA(1, 0, At, B0); PG8_BAR; PG8_SCHED;
            PG8_STAGE(PG8_SB(0, 1), b2 + hstepB, voffB);
            PG8_WAIT_V(6); PG8_BAR; if (full) PG8_MMA(1, 1, At, B1); PG8_BAR;
            PG8_LDB(B0, 1, 0); PG8_SCHED; PG8_LDA(At, 1, 0); PG8_STAGE(PG8_SA(0, 1), a2 + h2A, voffA);
            PG8_WAIT_L(8); PG8_BAR; PG8_WAIT_L(0); PG8_MMA(0, 0, At, B0); PG8_BAR; PG8_SCHED;
            PG8_LDB(B1, 1, 1); PG8_STAGE(PG8_SB(1, 0), b3, voffB);
            PG8_BAR; PG8_WAIT_L(0); PG8_MMA(0, 1, At, B1); PG8_BAR;
            PG8_LDA(At, 1, 1); PG8_STAGE(PG8_SA(1, 0), a3, voffA);
            PG8_BAR; PG8_WAIT_L(0); if (full) PG8_MMA(1, 0, At, B0); PG8_BAR; PG8_SCHED;
            PG8_STAGE(PG8_SB(1, 1), b3 + hstepB, voffB);
            PG8_WAIT_V(6); PG8_BAR; if (full) PG8_MMA(1, 1, At, B1); PG8_BAR;
            }
        }
        if constexpr (ALIGN_EPI) { if (wr == 0) PG8_BAR; }
        if constexpr (!Epi::AFTER_DRAIN) { E(acc, cur, wr, wc, fr, fq); S.done(cur); }
        if (!has_next) break;
#pragma unroll
        for (int a = 0; a < 2; ++a)
#pragma unroll
            for (int b = 0; b < 2; ++b)
#pragma unroll
                for (int m = 0; m < 4; ++m)
#pragma unroll
                    for (int n = 0; n < 2; ++n) acc[a][b][m][n] = (f32x4){0.f, 0.f, 0.f, 0.f};
        cur = nxt; cA = nA; cB = nB; chA = nhA; ++ui;
        if constexpr (ALIGN_EPI) { if (wr == 1) PG8_BAR; }
    }
    PG8_WAIT_V(0);
    if constexpr (!ALIGN_EPI) { if (wr == 0) PG8_BAR; }
    PG8_BAR;
#undef PG8_SA
#undef PG8_SB
#undef PG8_STAGE
#undef PG8_LDA
#undef PG8_LDB
#undef PG8_MMA
#undef PG8_WAIT_V
#undef PG8_WAIT_L
#undef PG8_BAR
#undef PG8_SCHED
}
}
namespace att {
constexpr int D = 128, NW = 8, QBLK = 32, KVBLK = 64;
constexpr float SCALE = 0.088388347648318440f;
constexpr float THR = 8.f;
constexpr int LDQ = NIN, LDK = 128, LDO = NIN;
constexpr size_t SHM_V = KVBLK * D * 2, SHM_K = KVBLK * D * 2, SHM_ATTN = 2 * SHM_V + 2 * SHM_K + NW * 64 * 4;
#define KSWZ(row, colB) ((row) * 256 + ((colB) ^ (((row) & 7) << 4)))
#define SBAR() __builtin_amdgcn_sched_barrier(0)
__device__ __forceinline__ int crow(int r, int hi) { return (r & 3) + 8 * (r >> 2) + 4 * hi; }
__device__ __forceinline__ unsigned cvtpk(float lo, float hi) { unsigned r; asm volatile("v_cvt_pk_bf16_f32 %0, %1, %2" : "=v"(r) : "v"(lo), "v"(hi)); return r; }
__device__ __forceinline__ bf16x8 ld8(const bf16_t* p) { return *reinterpret_cast<const bf16x8*>(p); }

__device__ __forceinline__ void partialSM(f32x16& p0, f32x16& p1, float& m_reg, float& mn, float& alpha) {
  constexpr float C = SCALE * 1.4426950408889634f;
  float pmax = p0[0];
#pragma unroll
  for (int r = 1; r < 16; ++r) pmax = fmaxf(pmax, p0[r]);
#pragma unroll
  for (int r = 0; r < 16; ++r) pmax = fmaxf(pmax, p1[r]);
  { auto rr = __builtin_amdgcn_permlane32_swap(__float_as_uint(pmax), __float_as_uint(pmax), false, false);
    pmax = fmaxf(__uint_as_float(rr[0]), __uint_as_float(rr[1])); }
  if (__builtin_expect(__all(pmax - m_reg <= THR / SCALE), 1)) { mn = m_reg; alpha = 1.f; }
  else { mn = fmaxf(m_reg, pmax); alpha = __builtin_amdgcn_exp2f((m_reg - mn) * C); m_reg = mn; }
  float mnC = -mn * C;
#pragma unroll
  for (int r = 0; r < 16; ++r) p0[r] = fmaf(p0[r], C, mnC);
#pragma unroll
  for (int r = 0; r < 16; ++r) p1[r] = fmaf(p1[r], C, mnC);
#pragma unroll
  for (int r = 0; r < 16; ++r) p0[r] = __builtin_amdgcn_exp2f(p0[r]);
}
__device__ __forceinline__ void finishSM(f32x16& p0, f32x16& p1, float alpha, float& l_reg, bf16x8& pa0, bf16x8& pa1, bf16x8& pa2, bf16x8& pa3) {
#pragma unroll
  for (int r = 0; r < 16; ++r) p1[r] = __builtin_amdgcn_exp2f(p1[r]);
  float ps = 0;
#pragma unroll
  for (int r = 0; r < 16; ++r) ps += p0[r];
#pragma unroll
  for (int r = 0; r < 16; ++r) ps += p1[r];
  { auto rr = __builtin_amdgcn_permlane32_swap(__float_as_uint(ps), __float_as_uint(ps), false, false);
    ps = __uint_as_float(rr[0]) + __uint_as_float(rr[1]); }
  l_reg = l_reg * alpha + ps;
#define PK4(P, BASE, OUT) do { unsigned a0 = cvtpk(P[BASE + 0], P[BASE + 1]), a1 = cvtpk(P[BASE + 2], P[BASE + 3]);   \
    unsigned b0 = cvtpk(P[BASE + 4], P[BASE + 5]), b1 = cvtpk(P[BASE + 6], P[BASE + 7]);                              \
    auto r0 = __builtin_amdgcn_permlane32_swap(a0, b0, false, false); auto r1 = __builtin_amdgcn_permlane32_swap(a1, b1, false, false); \
    u32x4 w = {r0[0], r1[0], r0[1], r1[1]}; OUT = *reinterpret_cast<bf16x8*>(&w); } while (0)
  PK4(p0, 0, pa0); PK4(p0, 8, pa1); PK4(p1, 0, pa2); PK4(p1, 8, pa3);
#undef PK4
}
__device__ __forceinline__ void qkt(f32x16& p0, f32x16& p1, const bf16_t* Ks, const bf16x8* qr, int r32, int hi) {
  p0 = f32x16{}; p1 = f32x16{};
#pragma unroll
  for (int d0 = 0; d0 < 8; ++d0) { int cb = (d0 * 16 + hi * 8) * 2;
    bf16x8 b0 = *reinterpret_cast<const bf16x8*>((const char*)Ks + KSWZ(r32, cb));
    bf16x8 b1 = *reinterpret_cast<const bf16x8*>((const char*)Ks + KSWZ(32 + r32, cb));
    p0 = __builtin_amdgcn_mfma_f32_32x32x16_bf16(b0, qr[d0], p0, 0, 0, 0);
    p1 = __builtin_amdgcn_mfma_f32_32x32x16_bf16(b1, qr[d0], p1, 0, 0, 0); }
}
__device__ __forceinline__ int v_st(int k, int c) { const int kk = (k & ~0xC) | ((k & 4) << 1) | ((k & 8) >> 1); return ((kk >> 3) * 4 + (c >> 5)) * 512 + ((kk & 7) * 32 + (c & 31)) * 2; }
__device__ __forceinline__ int v_rd_base(int lane) { return ((lane & 3) << 3) | (((lane >> 2) & 3) << 6) | (((lane >> 4) & 1) << 5) | (((lane >> 5) & 1) << 8); }
constexpr int v_rd_off(int d0, int ks, int half) { return d0 * 512 + ks * 4096 + half * 2048; }
template <int OFF> __device__ __forceinline__ s16x4 tr_read(int vb) {
  s16x4 r; asm volatile("ds_read_b64_tr_b16 %0, %1 offset:%2" : "=&v"(r) : "v"(vb), "i"(OFF) : "memory"); return r;
}
template <int D0> __device__ __forceinline__ void pv_one(f32x16& od, int vb, bf16x8 pa0, bf16x8 pa1, bf16x8 pa2, bf16x8 pa3) {
  const s16x4 l0 = tr_read<v_rd_off(D0, 0, 0)>(vb), h0 = tr_read<v_rd_off(D0, 0, 1)>(vb), l1 = tr_read<v_rd_off(D0, 1, 0)>(vb), h1 = tr_read<v_rd_off(D0, 1, 1)>(vb);
  const s16x4 l2 = tr_read<v_rd_off(D0, 2, 0)>(vb), h2 = tr_read<v_rd_off(D0, 2, 1)>(vb), l3 = tr_read<v_rd_off(D0, 3, 0)>(vb), h3 = tr_read<v_rd_off(D0, 3, 1)>(vb);
  asm volatile("s_waitcnt lgkmcnt(0)" ::: "memory"); SBAR();
#define PK(L, H) (bf16x8){L[0], L[1], L[2], L[3], H[0], H[1], H[2], H[3]}
  od = __builtin_amdgcn_mfma_f32_32x32x16_bf16(pa0, PK(l0, h0), od, 0, 0, 0);
  od = __builtin_amdgcn_mfma_f32_32x32x16_bf16(pa1, PK(l1, h1), od, 0, 0, 0);
  od = __builtin_amdgcn_mfma_f32_32x32x16_bf16(pa2, PK(l2, h2), od, 0, 0, 0);
  od = __builtin_amdgcn_mfma_f32_32x32x16_bf16(pa3, PK(l3, h3), od, 0, 0, 0);
#undef PK
}
__device__ __forceinline__ void pv_d0(f32x16* o, int vb, bf16x8 pa0, bf16x8 pa1, bf16x8 pa2, bf16x8 pa3) {
  pv_one<0>(o[0], vb, pa0, pa1, pa2, pa3); pv_one<1>(o[1], vb, pa0, pa1, pa2, pa3); pv_one<2>(o[2], vb, pa0, pa1, pa2, pa3); pv_one<3>(o[3], vb, pa0, pa1, pa2, pa3);
}

__device__ __forceinline__ void attn_dense_body(const bf16_t* __restrict__ Qb, const bf16_t* __restrict__ Kh, const bf16_t* __restrict__ Vh,
                                                bf16_t* Ob, int seq, char* lds, int wave_) {
  constexpr int SDEPTH = 2;
  int tid_ = wave_ * 64 + lane_id_fresh();
  const int tid = tid_, wid = tid >> 6, lane = tid & 63, r32 = lane & 31, hi = lane >> 5;
  bf16_t* V_lds = (bf16_t*)lds; bf16_t* K_lds = (bf16_t*)(lds + 2 * SHM_V);
  float* ws = (float*)(lds + 2 * SHM_V + 2 * SHM_K) + wid * 64; float* li_l = ws; float* al_l = ws + 32;
  float m_reg = -1e30f, l_reg = 0; f32x16 o[4] = {}; bf16x8 qr[8];
  const bf16_t* Qw = Qb + (long)(wid * QBLK + r32) * LDQ + hi * 8;
#pragma unroll
  for (int d0 = 0; d0 < 8; ++d0) qr[d0] = ld8(Qw + d0 * 16);
  const int sr = tid >> 4, sc = (tid & 15) * 8, vst0 = v_st(sr, sc), vst1 = v_st(32 + sr, sc);
  const int vb0 = (int)(uintptr_t)V_lds + v_rd_base(lane);
  struct { bf16x8 vs0, vs1, ks0, ks1; } sr_[SDEPTH];
#define SLOAD(i, k0) do { sr_[i].vs0 = ld8(&Vh[(long)((k0) + sr) * LDK + sc]); sr_[i].vs1 = ld8(&Vh[(long)((k0) + 32 + sr) * LDK + sc]); \
    sr_[i].ks0 = ld8(&Kh[(long)((k0) + sr) * LDK + sc]); sr_[i].ks1 = ld8(&Kh[(long)((k0) + 32 + sr) * LDK + sc]); } while (0)
#define SWRITE(b, i) do { *(bf16x8*)((char*)V_lds + (b) * SHM_V + vst0) = sr_[i].vs0;          \
    *(bf16x8*)((char*)V_lds + (b) * SHM_V + vst1) = sr_[i].vs1; int kc = sc * 2;               \
    *(bf16x8*)((char*)K_lds + (b) * SHM_K + KSWZ(sr, kc)) = sr_[i].ks0;                       \
    *(bf16x8*)((char*)K_lds + (b) * SHM_K + KSWZ(32 + sr, kc)) = sr_[i].ks1; } while (0)
#define SWAIT() asm volatile("s_waitcnt vmcnt(4)" ::: "memory")
#define RESC(a) do { if (__any((a) < 1.f)) { if (hi == 0) al_l[r32] = (a); asm volatile("s_waitcnt lgkmcnt(0)" ::: "memory"); \
    _Pragma("unroll") for (int d = 0; d < 4; ++d) _Pragma("unroll") for (int r = 0; r < 16; ++r) o[d][r] *= al_l[crow(r, hi)]; } } while (0)
  f32x16 pA0, pA1, pB0, pB1; float mnA, mnB, alA, alB; bf16x8 pa0, pa1, pa2, pa3; const int NT = seq / KVBLK;
  constexpr int SE = 0, SO = SDEPTH - 1;
  SLOAD(SE, 0); asm volatile("s_waitcnt vmcnt(0)" ::: "memory"); SWRITE(0, SE); __syncthreads();
  qkt(pA0, pA1, K_lds, qr, r32, hi); partialSM(pA0, pA1, m_reg, mnA, alA);
  SLOAD(SO, KVBLK); if (2 < NT) SLOAD(SE, 2 * KVBLK);
  SWAIT(); SWRITE(1, SO); __syncthreads();
  for (int j = 1; j + 1 < NT; j += 2) {
    SBAR(); qkt(pB0, pB1, (bf16_t*)((char*)K_lds + SHM_K), qr, r32, hi);
    finishSM(pA0, pA1, alA, l_reg, pa0, pa1, pa2, pa3); SBAR();
    SLOAD(SO, (j + SDEPTH) * KVBLK); SBAR();
    pv_d0(o, vb0, pa0, pa1, pa2, pa3); partialSM(pB0, pB1, m_reg, mnB, alB);
    __syncthreads(); SWAIT(); SWRITE(0, SE);
    RESC(alB); __syncthreads();
    SBAR(); qkt(pA0, pA1, K_lds, qr, r32, hi);
    finishSM(pB0, pB1, alB, l_reg, pa0, pa1, pa2, pa3); SBAR();
    if (j + 3 < NT) SLOAD(SE, (j + 1 + SDEPTH) * KVBLK); SBAR();
    pv_d0(o, vb0 + (int)SHM_V, pa0, pa1, pa2, pa3); partialSM(pA0, pA1, m_reg, mnA, alA);
    __syncthreads(); SWAIT(); SWRITE(1, SO);
    RESC(alA); __syncthreads();
  }
  SBAR(); qkt(pB0, pB1, (bf16_t*)((char*)K_lds + SHM_K), qr, r32, hi);
  finishSM(pA0, pA1, alA, l_reg, pa0, pa1, pa2, pa3); SBAR();
  pv_d0(o, vb0, pa0, pa1, pa2, pa3); partialSM(pB0, pB1, m_reg, mnB, alB);
  __syncthreads(); RESC(alB);
  finishSM(pB0, pB1, alB, l_reg, pa0, pa1, pa2, pa3); SBAR();
  pv_d0(o, vb0 + (int)SHM_V, pa0, pa1, pa2, pa3);
  if (hi == 0) li_l[r32] = l_reg; asm volatile("s_waitcnt lgkmcnt(0)" ::: "memory");
  float rli[16];
#pragma unroll
  for (int r = 0; r < 16; ++r) rli[r] = __builtin_amdgcn_rcpf(li_l[crow(r, hi)]);
  bf16_t* Ow = Ob + (long)(wid * QBLK) * LDO;
#pragma unroll
  for (int r = 0; r < 16; ++r) { int orow = crow(r, hi);
#pragma unroll
    for (int d0 = 0; d0 < 4; ++d0) Ow[(long)orow * LDO + d0 * 32 + r32] = f2bf(o[d0][r] * rli[r]); }
  __syncthreads();
#undef SLOAD
#undef SWRITE
#undef SWAIT
#undef RESC
}
#undef KSWZ
#undef SBAR
}
#define CAS __attribute__((address_space(4)))
#define INP(i) ((const float*)(GAS const float*)in[i])
struct Ctx {
    float* out; unsigned char* ws;
    LAS unsigned char* lds; int tid, lane, wave, wg, G;
};
enum { I_X = 0, I_C, I_CTX, I_CCTX, I_WMOD, I_BMOD, I_NMIX, I_NFFN, I_WIN, I_QN, I_KN, I_LCW, I_LCB, I_LWA, I_LBA, I_LWX, I_LBX, I_LLAM, I_SCW, I_SCB,
       I_WOA, I_WOL, I_WOS, I_WOUT, I_PWQ, I_PK1, I_PK2, I_PU, I_PV };

__device__ __forceinline__ float* xrow_ptr(const Ctx& c, int r) {
    return r < MLAT ? c.out + (size_t)r * DM : (float*)(c.ws + WS_CTXS) + (size_t)(r - MLAT) * DM;
}

template <bool I8 = false>
__device__ __forceinline__ void transpose_item(const float* W, int K, int N, bf16_t* WT, LAS float* scr, int item, int lane, const float* cmax = nullptr, float* wdq = nullptr, LAS float* scol = nullptr) {
    const int nblk = N / 64, kb = item / nblk, nb = item % nblk, k0 = 64 * kb, n0 = 64 * nb;
    if constexpr (I8) { float mx = 0.f;
#pragma unroll 8
        for (int kc = 0; kc < 32; ++kc) mx = fmaxf(mx, cmax[(size_t)kc * N + n0 + lane]);
        scol[lane] = mx > 0.f ? 127.f / mx : 0.f;
        if (kb == 0) wdq[n0 + lane] = mx * (1.f / 127.f); }
    const float* src = W + (size_t)(k0 + (lane >> 4)) * N + n0 + (lane & 15) * 4;
    f32x4 v[16];
#pragma unroll
    for (int i = 0; i < 16; ++i) v[i] = *(const f32x4*)(src + (size_t)(4 * i) * N);
    LAS float* d = scr + (lane >> 4) * 65 + (lane & 15) * 4;
#pragma unroll
    for (int i = 0; i < 16; ++i) { d[(4 * i) * 65 + 0] = v[i][0]; d[(4 * i) * 65 + 1] = v[i][1]; d[(4 * i) * 65 + 2] = v[i][2]; d[(4 * i) * 65 + 3] = v[i][3]; }
    LDS_WAIT(); asm volatile("" ::: "memory");
    const int c = lane & 7;
#pragma unroll
    for (int j = 0; j < 8; ++j) { const int n = (lane >> 3) + 8 * j; const LAS float* s = scr + (8 * c) * 65 + n;
        if constexpr (I8) { const float q_ = scol[n]; u32x2 o; o.x = pk4_i8(s[0 * 65] * q_, s[1 * 65] * q_, s[2 * 65] * q_, s[3 * 65] * q_); o.y = pk4_i8(s[4 * 65] * q_, s[5 * 65] * q_, s[6 * 65] * q_, s[7 * 65] * q_);
            *(u32x2*)((unsigned char*)WT + (size_t)(n0 + n) * K + k0 + 8 * c) = o; }
        else { u32x4 o; o.x = cvt_pk_bf16(s[0 * 65], s[1 * 65]); o.y = cvt_pk_bf16(s[2 * 65], s[3 * 65]); o.z = cvt_pk_bf16(s[4 * 65], s[5 * 65]); o.w = cvt_pk_bf16(s[6 * 65], s[7 * 65]);
            *(u32x4*)(WT + (size_t)(n0 + n) * K + k0 + 8 * c) = o; } }
    LDS_WAIT(); asm volatile("" ::: "memory");
}

__device__ __forceinline__ void mod_unit(const Ctx& c, CAS const unsigned long long* in, int l, int cb) {
    LAS float* sv = (LAS float*)c.lds;
    LAS float* red = sv + 3 * DM;
    { const float* cc = INP(I_C); const float* cx = INP(I_CCTX);
      for (int i = c.tid; i < 3 * DM; i += NTHREADS) { const int v = i / DM, k = i % DM; const float x = v < 2 ? cc[v * DM + k] : cx[k]; sv[i] = x * sigmoidf_(x); } }
    __syncthreads();
    const int j4 = (c.tid & 31) * 4, kg = c.tid >> 5;
    const float* w = INP(I_WMOD) + (size_t)l * DM * NMOD + (size_t)(kg * 128) * NMOD + cb * 128 + j4;
    f32x4 a0 = {0.f, 0.f, 0.f, 0.f}, a1 = a0, a2 = a0;
#pragma unroll 8
    for (int k = 0; k < 128; ++k) { const f32x4 wv = *(const f32x4*)(w + (size_t)k * NMOD); const int kk = kg * 128 + k; a0 += wv * sv[kk]; a1 += wv * sv[DM + kk]; a2 += wv * sv[2 * DM + kk]; }
    *(LAS f32x4*)(red + (kg * 3 + 0) * 128 + j4) = a0; *(LAS f32x4*)(red + (kg * 3 + 1) * 128 + j4) = a1; *(LAS f32x4*)(red + (kg * 3 + 2) * 128 + j4) = a2;
    __syncthreads();
    if (c.tid < 384) { const int v = c.tid >> 7, jj = c.tid & 127; float s = INP(I_BMOD)[l * NMOD + cb * 128 + jj];
#pragma unroll
        for (int g = 0; g < 16; ++g) s += red[(g * 3 + v) * 128 + jj];
        ((float*)(c.ws + WS_MOD))[((size_t)l * 3 + v) * NMOD + cb * 128 + jj] = s; }
    __syncthreads();
}

__device__ __forceinline__ void wsc_unit(const Ctx& c, CAS const unsigned long long* in, int l, int u) {
    const int hh = u >> 4, kb = u & 15, h = hh >> 1, half = hh & 1, k0 = kb * 128;
    LAS float* kkL = (LAS float*)c.lds;
    LAS float* wqL = kkL + 128 * 132;
    const float* ksrc = INP(half ? I_PK2 : I_PK1) + ((size_t)(l * 8 + h) * 128) * 128;
    const float* qsrc = INP(I_PWQ) + (size_t)l * DM * DM + (size_t)k0 * DM + hh * 128;
    for (int i = c.tid; i < 128 * 32; i += NTHREADS) { const int r = i >> 5, c4 = (i & 31) * 4;
        *(LAS f32x4*)(kkL + r * 132 + c4) = *(const f32x4*)(ksrc + (size_t)r * 128 + c4);
        *(LAS f32x4*)(wqL + r * 132 + c4) = *(const f32x4*)(qsrc + (size_t)r * DM + c4); }
    __syncthreads();
    const int k = c.tid & 127, ng = c.tid >> 7;
    float acc[32];
#pragma unroll
    for (int j = 0; j < 32; ++j) acc[j] = 0.f;
    for (int d4 = 0; d4 < 32; ++d4) {
        const f32x4 a = *(const LAS f32x4*)(wqL + k * 132 + d4 * 4);
#pragma unroll
        for (int j = 0; j < 32; ++j) { const f32x4 b = *(const LAS f32x4*)(kkL + (ng * 32 + j) * 132 + d4 * 4); acc[j] += (a[0] * b[0] + a[1] * b[1]) + (a[2] * b[2] + a[3] * b[3]); }
    }
    bf16_t* dst = (bf16_t*)(c.ws + ws_wsc(l)) + (size_t)(hh * 128 + ng * 32) * DM + k0 + k;
#pragma unroll
    for (int j = 0; j < 32; ++j) dst[(size_t)j * DM] = f2bf(acc[j]);
    __syncthreads();
}

#define GET_IN() unsigned long long kai_ = (unsigned long long)__builtin_amdgcn_kernarg_segment_ptr(); asm volatile("" : "+s"(kai_)); CAS const unsigned long long* in = (CAS const unsigned long long*)kai_
__device__ __forceinline__ void conv_units(const Ctx& c, int l) {
    GET_IN();
    if (l == 0) for (int u = c.wg; u < 2 * 96; u += c.G) mod_unit(c, in, u / 96, u % 96);
    for (int u = c.wg; u < 256; u += c.G) wsc_unit(c, in, l, u);
}
enum { CV_WIN = 1, CV_WO = 2, CV_WOUT = 4, CV_PU = 8, CV_PV = 16, CV_LRU = 32, CV_ALL = 63 };
__device__ __forceinline__ void conv_transposes(const Ctx& c, int l, int what = CV_ALL) {
    GET_IN();
    const int gw = c.wg * NWAVES + c.wave, NGW = c.G * NWAVES;
    LAS float* scr = (LAS float*)(c.lds + c.wave * 16640);
    constexpr int I_IN = (DM / 64) * (NIN / 64), I_SQ = (DM / 64) * (DM / 64);
    const float* win = INP(I_WIN) + (size_t)l * DM * NIN;
    if (what & CV_WIN) for (int it = gw; it < I_IN; it += NGW)
        transpose_item<true>(win, DM, NIN, (bf16_t*)(c.ws + WS_WIN), scr, it, c.lane, (const float*)(c.ws + WS_CMAX) + (size_t)l * 32 * NIN, (float*)(c.ws + WS_WDQ), (LAS float*)(c.lds + 8 * 16640 + c.wave * 256));
    for (int s = 0; s < 4; ++s) { if (!(what & (s < 3 ? CV_WO : CV_WOUT))) continue;
        const float* src = INP(s == 0 ? I_WOA : s == 1 ? I_WOL : s == 2 ? I_WOS : I_WOUT) + (size_t)l * DM * DM;
        bf16_t* dst = s < 3 ? (bf16_t*)(c.ws + WS_WO) + (size_t)s * DM * DM : (bf16_t*)(c.ws + WS_WOUT);
        for (int it = gw; it < I_SQ; it += NGW) transpose_item(src, DM, DM, dst, scr, it, c.lane);
    }
}
__device__ __forceinline__ void conv_colmax(const Ctx& c) {
    GET_IN();
    const size_t gt = (size_t)c.wg * NTHREADS + c.tid, NT = (size_t)c.G * NTHREADS;
    constexpr int C4 = NIN / 4;
    for (size_t u = gt; u < (size_t)NLAYER * 32 * C4; u += NT) { const int c4 = (int)(u % C4), lk = (int)(u / C4);
        const float* src = INP(I_WIN) + (size_t)lk * 64 * NIN + c4 * 4;
        f32x4 m = {0.f, 0.f, 0.f, 0.f};
#pragma unroll 16
        for (int k = 0; k < 64; ++k) { const f32x4 v = *(const f32x4*)(src + (size_t)k * NIN); m[0] = fmaxf(m[0], fabsf(v[0])); m[1] = fmaxf(m[1], fabsf(v[1])); m[2] = fmaxf(m[2], fabsf(v[2])); m[3] = fmaxf(m[3], fabsf(v[3])); }
        *(f32x4*)((float*)(c.ws + WS_CMAX) + (size_t)lk * NIN + c4 * 4) = m; }
}
__device__ __forceinline__ void conv_tables(const Ctx& c, int l, int what = CV_ALL) {
    GET_IN();
    const size_t gt = (size_t)c.wg * NTHREADS + c.tid, NT = (size_t)c.G * NTHREADS;
    constexpr size_t NG16 = (size_t)16384 * DM / 16;
    if (what & CV_PU) {
        const int gw = c.wg * NWAVES + c.wave, NGW = c.G * NWAVES;
        const float* srcb = INP(I_PU) + (size_t)l * 16384 * DM; unsigned char* dstb = (unsigned char*)(c.ws + ws_pu(l)); float* usc = (float*)(c.ws + WS_USC) + (size_t)l * 16384;
#pragma unroll 1
        for (int e = gw; e < 16384; e += NGW) { const float* src = srcb + (size_t)e * DM + c.lane * 16;
            f32x4 v[8]; float mx = 0.f;
#pragma unroll
            for (int i = 0; i < 8; ++i) { v[i] = *(const f32x4*)(src + (i >> 2) * 1024 + (i & 3) * 4); mx = fmaxf(fmaxf(mx, fmaxf(fabsf(v[i][0]), fabsf(v[i][1]))), fmaxf(fabsf(v[i][2]), fabsf(v[i][3]))); }
#pragma unroll
            for (int o = 32; o > 0; o >>= 1) mx = fmaxf(mx, __shfl_xor(mx, o));
            const float q_ = mx > 0.f ? 127.f / mx : 0.f;
            if (c.lane == 0) usc[e] = mx * (1.f / 127.f);
            u32x4 o0, o1;
#pragma unroll
            for (int i = 0; i < 4; ++i) { o0[i] = pk4_i8(v[i][0] * q_, v[i][1] * q_, v[i][2] * q_, v[i][3] * q_); o1[i] = pk4_i8(v[4 + i][0] * q_, v[4 + i][1] * q_, v[4 + i][2] * q_, v[4 + i][3] * q_); }
            *(u32x4*)(dstb + (size_t)e * DM + c.lane * 16) = o0; *(u32x4*)(dstb + (size_t)e * DM + 1024 + c.lane * 16) = o1; } }
#pragma unroll 1
    for (int tb = 1; tb < 2; ++tb) { if (!(what & (tb ? CV_PV : CV_PU))) continue;
        const float* srcb = INP(tb ? I_PV : I_PU) + (size_t)l * 16384 * DM; unsigned char* dstb = (unsigned char*)(c.ws + (tb ? ws_pv(l) : ws_pu(l)));
        const float sc = tb ? 1.f : 32.f;
        for (size_t j = gt; j < NG16; j += 2 * NT) {
            const size_t j2 = j + NT; const bool has2 = j2 < NG16;
            f32x4 a[4], b[4];
#pragma unroll
            for (int d = 0; d < 4; ++d) a[d] = *(const f32x4*)(srcb + j * 16 + d * 4);
#pragma unroll
            for (int d = 0; d < 4; ++d) b[d] = has2 ? *(const f32x4*)(srcb + j2 * 16 + d * 4) : (f32x4){0.f, 0.f, 0.f, 0.f};
            u32x4 o, o2;
#pragma unroll
            for (int d = 0; d < 4; ++d) { const f32x4 x = a[d] * sc, y = b[d] * sc;
                int w = __builtin_amdgcn_cvt_pk_fp8_f32(x[0], x[1], 0, false); w = __builtin_amdgcn_cvt_pk_fp8_f32(x[2], x[3], w, true); o[d] = (unsigned)w;
                int w2 = __builtin_amdgcn_cvt_pk_fp8_f32(y[0], y[1], 0, false); w2 = __builtin_amdgcn_cvt_pk_fp8_f32(y[2], y[3], w2, true); o2[d] = (unsigned)w2; }
            if (tb == 0) { *(u32x4*)(dstb + j * 16) = o; if (has2) *(u32x4*)(dstb + j2 * 16) = o2; }
            else {
                *(u32x4*)(dstb + (size_t)((j & 127) >> 3) * ((size_t)16384 * 128) + (j >> 7) * 128 + (j & 7) * 16) = o;
                if (has2) *(u32x4*)(dstb + (size_t)((j2 & 127) >> 3) * ((size_t)16384 * 128) + (j2 >> 7) * 128 + (j2 & 7) * 16) = o2; } }
    }
    if (what & CV_LRU) for (size_t i = gt; i < (size_t)16 * 512 * 128; i += NT) { const int ci = (int)(i & 127), j = (int)((i >> 7) & 511), n = (int)(i >> 16), d = j >> 8, which = (j >> 7) & 1, dd = j & 127;
        const float* src = INP(which ? I_LWX : I_LWA) + ((((size_t)(l * 2 + d) * 16 + n) * 128 + ci) * 128 + dd);
        ((bf16_t*)(c.ws + WS_WLRU))[i] = f2bf(*src); }
}
__device__ __forceinline__ void sp_copy(const Ctx& c, const float* src, int sp_off, int n) {
    const size_t gt = (size_t)c.wg * NTHREADS + c.tid, NT = (size_t)c.G * NTHREADS;
    for (size_t i = gt; i < (size_t)n; i += NT) ((float*)(c.ws + WS_SP))[sp_off + i] = src[i];
}
__device__ __forceinline__ void conv_small(const Ctx& c, int l) {
    GET_IN();
    const size_t gt = (size_t)c.wg * NTHREADS + c.tid, NT = (size_t)c.G * NTHREADS;
    sp_copy(c, INP(I_NMIX) + l * DM, SP_NMIX, DM); sp_copy(c, INP(I_NFFN) + l * DM, SP_NFFN, DM);
    sp_copy(c, INP(I_QN) + l * 128, SP_QN, 128); sp_copy(c, INP(I_KN) + l * 128, SP_KN, 128);
    sp_copy(c, INP(I_LCW) + l * 4 * DM, SP_LCW, 4 * DM); sp_copy(c, INP(I_LCB) + l * DM, SP_LCB, DM);
    sp_copy(c, INP(I_LBA) + l * 2 * DM, SP_LBA, 2 * DM); sp_copy(c, INP(I_LBX) + l * 2 * DM, SP_LBX, 2 * DM);
    sp_copy(c, INP(I_SCW) + l * 3 * DM, SP_SCW, 3 * DM); sp_copy(c, INP(I_SCB) + l * DM, SP_SCB, DM);
    { const float* lam = INP(I_LLAM) + l * 2 * DM;
      for (size_t i = gt; i < (size_t)2 * DM; i += NT) ((float*)(c.ws + WS_SP))[SP_LSP + i] = 8.f * log1pf(expf(-lam[i])); }
}
__device__ __forceinline__ void conv_once(const Ctx& c) {
    const size_t gt = (size_t)c.wg * NTHREADS + c.tid, NT = (size_t)c.G * NTHREADS;
    for (size_t i = gt; i < 128 * 32; i += NT) { const int pos = (int)(i >> 5), p = (int)(i & 31);
        const float inv = exp2f(-(float)p * (13.287712379549449f / 32.f)); const float ang = (float)pos * inv;
        float sn, cs; sincosf(ang, &sn, &cs);
        ((float*)(c.ws + WS_ROPE))[i] = cs; ((float*)(c.ws + WS_ROPE))[128 * 32 + i] = sn; }
}

template <bool I8 = false>
__device__ __forceinline__ void phase_norm(const Ctx& c, int l, int nrows, int sp_gain, int slot_shift, const float* xin = nullptr, const float* cin = nullptr) {
    const int gw = c.wg * NWAVES + c.wave, NGW = c.G * NWAVES;
    const float* modl = (const float*)(c.ws + WS_MOD) + (size_t)l * 3 * NMOD;
    bf16_t* HX = (bf16_t*)(c.ws + WS_HX); const float* gain = (const float*)(c.ws + WS_SP) + sp_gain;
    for (int r = gw; r < nrows; r += NGW) {
        const int vec = r < SEQ ? 0 : (r < MLAT ? 1 : 2);
        const float* xr = xin ? (r < MLAT ? xin + (size_t)r * DM : cin + (size_t)(r - MLAT) * DM) : xrow_ptr(c, r); const float* sh = modl + (size_t)vec * NMOD + slot_shift * DM; const float* sc = sh + DM;
        f32x4 v[8]; float ss = 0.f;
#pragma unroll
        for (int j = 0; j < 8; ++j) { v[j] = *(const f32x4*)(xr + j * 256 + c.lane * 4); ss += (v[j][0] * v[j][0] + v[j][1] * v[j][1]) + (v[j][2] * v[j][2] + v[j][3] * v[j][3]); }
        const float rs = rsqrtf(wave_sum(ss) * (1.f / DM) + EPS);
        if constexpr (I8) { float mx = 0.f;
#pragma unroll
            for (int j = 0; j < 8; ++j) { const int col = j * 256 + c.lane * 4;
                const f32x4 g = *(const f32x4*)(gain + col), s1 = *(const f32x4*)(sc + col), s0 = *(const f32x4*)(sh + col);
                v[j] = (v[j] * rs * g) * (s1 + 1.f) + s0;
                mx = fmaxf(fmaxf(mx, fmaxf(fabsf(v[j][0]), fabsf(v[j][1]))), fmaxf(fabsf(v[j][2]), fabsf(v[j][3]))); }
#pragma unroll
            for (int o = 32; o > 0; o >>= 1) mx = fmaxf(mx, __shfl_xor(mx, o));
            const float q_ = mx > 0.f ? 127.f / mx : 0.f;
            if (c.lane == 0) ((float*)(c.ws + WS_ADQ))[r] = mx * (1.f / 127.f);
#pragma unroll
            for (int j = 0; j < 8; ++j) *(unsigned*)((unsigned char*)HX + (size_t)r * DM + j * 256 + c.lane * 4) = pk4_i8(v[j][0] * q_, v[j][1] * q_, v[j][2] * q_, v[j][3] * q_);
        } else {
#pragma unroll
        for (int j = 0; j < 8; ++j) { const int col = j * 256 + c.lane * 4;
            const f32x4 g = *(const f32x4*)(gain + col), s1 = *(const f32x4*)(sc + col), s0 = *(const f32x4*)(sh + col);
            const f32x4 y = (v[j] * rs * g) * (s1 + 1.f) + s0;
            u32x2 o; o.x = cvt_pk_bf16(y[0], y[1]); o.y = cvt_pk_bf16(y[2], y[3]);
            *(u32x2*)(HX + (size_t)r * DM + col) = o; } }
    }
}
__device__ __forceinline__ void seg_of_row(int r, bool& is_ctx, int& b, int& t) {
    is_ctx = r >= MLAT; b = is_ctx ? (r - MLAT) >> 8 : r >> 13; t = is_ctx ? (r - MLAT) & 255 : r & (SEQ - 1);
}
__device__ __forceinline__ void qk_row(const Ctx& c, int l, int r, bool do_q, bool dry) {
    bool is_ctx; int b, t; seg_of_row(r, is_ctx, b, t);
    const int key = is_ctx ? t : CTXL + t;
    bf16_t* prow = (bf16_t*)(c.ws + WS_P) + (size_t)r * NIN;
    bf16_t* KC = (bf16_t*)(c.ws + WS_KC); bf16_t* VC = (bf16_t*)(c.ws + WS_VC);
    const int hs = c.lane >> 4, ax = (c.lane >> 3) & 1, p0 = (c.lane & 7) * 4;
    f32x4 cs = {1.f, 1.f, 1.f, 1.f}, sn = {0.f, 0.f, 0.f, 0.f};
    if (!is_ctx) { const int pos = ax ? (t & 63) : (t >> 6); const float* rt = (const float*)(c.ws + WS_ROPE) + pos * 32 + p0; cs = *(const f32x4*)rt; sn = *(const f32x4*)(rt + 128 * 32); }
    u32x2 w1[5], w2[5];
#pragma unroll
    for (int g = 0; g < 5; ++g) { const bool is_k = (g == 4); const int head = is_k ? hs : g * 4 + hs;
        const bf16_t* src = prow + (is_k ? CK : CQ) + head * 128 + ax * 64 + p0;
        if (is_k || do_q) { w1[g] = *(const u32x2*)src; w2[g] = *(const u32x2*)(src + 32); } else { w1[g] = (u32x2){0u, 0u}; w2[g] = (u32x2){0u, 0u}; } }
    const u32x4 vw = *(const u32x4*)(prow + CV + (c.lane >> 4) * 128 + (c.lane & 15) * 8);
#pragma unroll
    for (int g = 0; g < 5; ++g) {
        const bool is_k = (g == 4);
        if (!is_k && !do_q) continue;
        const int head = is_k ? hs : g * 4 + hs;
        bf16_t* src = prow + (is_k ? CK : CQ) + head * 128 + ax * 64 + p0;
        f32x4 t1 = {bf_lo(w1[g].x), bf_hi(w1[g].x), bf_lo(w1[g].y), bf_hi(w1[g].y)}, t2 = {bf_lo(w2[g].x), bf_hi(w2[g].x), bf_lo(w2[g].y), bf_hi(w2[g].y)};
        float ss = (t1[0] * t1[0] + t1[1] * t1[1]) + (t1[2] * t1[2] + t1[3] * t1[3]) + (t2[0] * t2[0] + t2[1] * t2[1]) + (t2[2] * t2[2] + t2[3] * t2[3]);
        ss += DPPF(ss, 0xB1); ss += DPPF(ss, 0x4E); ss += DPPF(ss, 0x141); ss += DPPF(ss, 0x140);
        const float rs = rsqrtf(ss * (1.f / 128.f) + EPS);
        const float* gn = (const float*)(c.ws + WS_SP) + (is_k ? SP_KN : SP_QN) + ax * 64 + p0;
        const f32x4 g1 = *(const f32x4*)gn, g2 = *(const f32x4*)(gn + 32);
        const f32x4 y1 = t1 * rs * g1, y2 = t2 * rs * g2;
        const f32x4 o1 = y1 * cs - y2 * sn, o2 = y2 * cs + y1 * sn;
        bf16_t* dst = is_k ? KC + ((size_t)(b * 4 + head) * NKEY + key) * 128 + ax * 64 + p0 : (dry ? (bf16_t*)(c.ws + WS_YF) + (size_t)r * DM + head * 128 + ax * 64 + p0 : src);
        u32x2 a; a.x = cvt_pk_bf16(o1[0], o1[1]); a.y = cvt_pk_bf16(o1[2], o1[3]);
        u32x2 bq; bq.x = cvt_pk_bf16(o2[0], o2[1]); bq.y = cvt_pk_bf16(o2[2], o2[3]);
        *(u32x2*)dst = a; *(u32x2*)(dst + 32) = bq;
    }
    { const int hv = c.lane >> 4, dd = (c.lane & 15) * 8;
      *(u32x4*)(VC + ((size_t)(b * 4 + hv) * NKEY + key) * 128 + dd) = vw; }
}
__device__ __forceinline__ void unpack8(const u32x4 w, float (&f)[8]) {
    f[0] = bf_lo(w.x); f[1] = bf_hi(w.x); f[2] = bf_lo(w.y); f[3] = bf_hi(w.y); f[4] = bf_lo(w.z); f[5] = bf_hi(w.z); f[6] = bf_lo(w.w); f[7] = bf_hi(w.w);
}
__device__ __forceinline__ void sc_row(const Ctx& c, int l, int r, bool dry) {
    bool is_ctx; int b, t; seg_of_row(r, is_ctx, b, t);
    const int seglen = is_ctx ? CTXL : SEQ;
    bf16_t* prow = (bf16_t*)(c.ws + WS_P) + (size_t)r * NIN;
    const bool hp = t > 0, hn = t < seglen - 1;
    const float* w = (const float*)(c.ws + WS_SP) + SP_SCW; const float* bias = (const float*)(c.ws + WS_SP) + SP_SCB;
    u32x4 xb[4], xc0[4], xu0[4], xcp[4], xup[4], xcn[4], xun[4];
    const u32x4 z = {0u, 0u, 0u, 0u};
#pragma unroll
    for (int it = 0; it < 4; ++it) { const int col = it * 512 + c.lane * 8;
        xb[it] = *(const u32x4*)(prow + CBG + col); xc0[it] = *(const u32x4*)(prow + CCG + col); xu0[it] = *(const u32x4*)(prow + CU + col);
        xcp[it] = hp ? *(const u32x4*)(prow - NIN + CCG + col) : z; xup[it] = hp ? *(const u32x4*)(prow - NIN + CU + col) : z;
        xcn[it] = hn ? *(const u32x4*)(prow + NIN + CCG + col) : z; xun[it] = hn ? *(const u32x4*)(prow + NIN + CU + col) : z; }
#pragma unroll
    for (int it = 0; it < 4; ++it) {
        const int col = it * 512 + c.lane * 8;
        float bg[8], c0[8], u0[8], cp[8], up[8], cn[8], un[8];
        unpack8(xb[it], bg); unpack8(xc0[it], c0); unpack8(xu0[it], u0); unpack8(xcp[it], cp); unpack8(xup[it], up); unpack8(xcn[it], cn); unpack8(xun[it], un);
        float o[8];
#pragma unroll
        for (int hq = 0; hq < 2; ++hq) { const f32x4 w0 = *(const f32x4*)(w + col + hq * 4), w1 = *(const f32x4*)(w + DM + col + hq * 4), w2 = *(const f32x4*)(w + 2 * DM + col + hq * 4), bi = *(const f32x4*)(bias + col + hq * 4);
#pragma unroll
            for (int e = 0; e < 4; ++e) { const int k = hq * 4 + e; o[k] = bg[k] * (bi[e] + w0[e] * (cp[k] * up[k]) + w1[e] * (c0[k] * u0[k]) + w2[e] * (cn[k] * un[k])); } }
        u32x4 ow; ow.x = cvt_pk_bf16(o[0], o[1]); ow.y = cvt_pk_bf16(o[2], o[3]); ow.z = cvt_pk_bf16(o[4], o[5]); ow.w = cvt_pk_bf16(o[6], o[7]);
        *(u32x4*)((dry ? (bf16_t*)(c.ws + WS_YF) + (size_t)(MALL + r) * DM : prow + CBG) + col) = ow;
    }
}

constexpr size_t lsum_idx(int which, int dir, int b, int j) { return ((((size_t)which * 2 + dir) * NB + b) * NCHUNK + j) * DM; }
template <int DIR, int PASS>
__device__ __forceinline__ void lru_chunk(const LAS bf16_t* ub, const LAS float* uf, LAS float* hsd, const bf16x8 (&bfr)[4][4], const float (&ba)[2], const float (&bx)[2], const float (&sp8)[2],
                                          const float (&cin)[2], float (&Atot)[2], float (&Hend)[2], int q, int col16, int quad) {
    float st[2] = {cin[0], cin[1]}, at[2] = {1.f, 1.f};
    const int mysg = DIR ? 3 - quad : quad;
    for (int smt = 0; smt < 4; ++smt) {
        const int mt = DIR ? 3 - smt : smt;
        f32x4 acc[4];
#pragma unroll
        for (int nt = 0; nt < 4; ++nt) acc[nt] = (f32x4){0.f, 0.f, 0.f, 0.f};
#pragma unroll
        for (int ks = 0; ks < 4; ++ks) { const bf16x8 a = *(const LAS bf16x8*)(ub + (mt * 16 + col16) * 136 + ks * 32 + quad * 8);
#pragma unroll
            for (int nt = 0; nt < 4; ++nt) acc[nt] = __builtin_amdgcn_mfma_f32_16x16x32_bf16(a, bfr[nt][ks], acc[nt], 0, 0, 0); }
#pragma unroll
        for (int ct = 0; ct < 2; ++ct) {
            const int ch = q * 32 + ct * 16 + col16;
            float av[4], dv[4];
#pragma unroll
            for (int reg = 0; reg < 4; ++reg) { const int tl = mt * 16 + quad * 4 + reg;
                const float r = sigmoidf_(acc[ct][reg] + ba[ct]), ig = sigmoidf_(acc[2 + ct][reg] + bx[ct]);
                const float a = __expf(-sp8[ct] * r);
                av[reg] = a; dv[reg] = __builtin_amdgcn_sqrtf(fmaxf(1.f - a * a, 0.f)) * ig * uf[tl * 132 + ch]; }
            float Al = 1.f, Hl = 0.f;
#pragma unroll
            for (int sr = 0; sr < 4; ++sr) { const int reg = DIR ? 3 - sr : sr; Hl = av[reg] * Hl + dv[reg]; Al *= av[reg]; }
            float se = st[ct], so = st[ct], ap = 1.f;
#pragma unroll
            for (int sg = 0; sg < 4; ++sg) { const int qp = DIR ? 3 - sg : sg; const float Ag = __shfl(Al, col16 + 16 * qp), Hg = __shfl(Hl, col16 + 16 * qp);
                const float nx = Ag * so + Hg; so = nx; if (sg < mysg) se = nx; ap *= Ag; }
            if (PASS == 2) { float h = se;
#pragma unroll
                for (int sr = 0; sr < 4; ++sr) { const int reg = DIR ? 3 - sr : sr; h = av[reg] * h + dv[reg]; hsd[(mt * 16 + quad * 4 + reg) * 132 + ch] = h; } }
            else at[ct] *= ap;
            st[ct] = so;
        }
    }
    Atot[0] = at[0]; Atot[1] = at[1]; Hend[0] = st[0]; Hend[1] = st[1];
}

template <int PASS>
__device__ __forceinline__ void lru_run(const Ctx& c, int l, int unit, bool dry = false) {
    const int b = unit >> 7, n = (unit >> 3) & 15, run = unit & 7;
    const int c0 = run * 16 + (run < 4 ? run : 4), len = 16 + (run < 4 ? 1 : 0);
    LAS float* xl = (LAS float*)c.lds;
    LAS float* uf = (LAS float*)(c.lds + 34816);
    LAS bf16_t* ub = (LAS bf16_t*)(c.lds + 34816 + 33792);
    LAS float* car = (LAS float*)(c.lds + 34816 + 33792 + 17408);
    LAS float* hsr = (LAS float*)(c.lds + 34816 + 33792 + 17408 + 17408);
    const int d = c.wave >> 2, q = c.wave & 3, col16 = c.lane & 15, quad = c.lane >> 4;
    float* LS = (float*)(c.ws + WS_LSUM);
    bf16_t* P = (bf16_t*)(c.ws + WS_P);
    bf16x8 bfr[4][4];
#pragma unroll
    for (int nt = 0; nt < 4; ++nt) { const int j = d * 256 + (nt >> 1) * 128 + q * 32 + (nt & 1) * 16 + col16;
#pragma unroll
        for (int ks = 0; ks < 4; ++ks) bfr[nt][ks] = *(const bf16x8*)((const bf16_t*)(c.ws + WS_WLRU) + ((size_t)(n * 512 + j) * 128 + ks * 32 + quad * 8)); }
    float ba[2], bx[2], sp8[2];
#pragma unroll
    for (int ct = 0; ct < 2; ++ct) { const int cidx = n * 128 + q * 32 + ct * 16 + col16; const float* sp = (const float*)(c.ws + WS_SP) + d * DM + cidx;
        ba[ct] = sp[SP_LBA]; bx[ct] = sp[SP_LBX]; sp8[ct] = sp[SP_LSP]; }
    if (PASS == 2) {
        if (c.tid < 256) { const int dir = c.tid >> 7, ch = c.tid & 127, cidx = n * 128 + ch; float st = 0.f;
#pragma unroll 1
            for (int k0 = 0; k0 < NCHUNK; k0 += 12) {
                float av[12], hv[12];
#pragma unroll
                for (int kk = 0; kk < 12; ++kk) { const int k = k0 + kk, j = dir ? (k < 4 ? 3 - k : 135 - k) : k; av[kk] = LS[lsum_idx(0, dir, b, j) + cidx]; hv[kk] = LS[lsum_idx(1, dir, b, j) + cidx]; }
#pragma unroll
                for (int kk = 0; kk < 12; ++kk) { const int k = k0 + kk, j = dir ? (k < 4 ? 3 - k : 135 - k) : k;
                    if (j >= c0 && j < c0 + len) car[(dir * 17 + (j - c0)) * 128 + ch] = st;
                    st = av[kk] * st + hv[kk]; } } }
        __syncthreads();
    }
    const float* cw = (const float*)(c.ws + WS_SP) + SP_LCW + n * 128; const float* cb = (const float*)(c.ws + WS_SP) + SP_LCB + n * 128;
#define LRU_GEOM(ci_, jc, is_ctx, rb, t0, seglen) const int jc = c0 + (ci_); const bool is_ctx = jc < 4; \
        const int rb = is_ctx ? MLAT + b * CTXL : b * SEQ, t0 = is_ctx ? jc * 64 : (jc - 4) * 64, seglen = is_ctx ? CTXL : SEQ
#define LRU_LOAD(ci_, XR, LG) do { LRU_GEOM(ci_, jc_, ic_, rb_, t0_, sl_); (void)ic_; \
        _Pragma("unroll") for (int ps = 0; ps < 3; ++ps) { const int i = ps * 32 + (c.tid >> 4); const int t = t0_ - 2 + i; XR[ps] = (u32x4){0u, 0u, 0u, 0u}; \
            if (i < 68 && t >= 0 && t < sl_) XR[ps] = *(const u32x4*)(P + (size_t)(rb_ + t) * NIN + CLX + n * 128 + (c.tid & 15) * 8); } \
        if (PASS == 2) { const bf16_t* gp_ = P + (size_t)(rb_ + t0_ + (c.tid >> 3)) * NIN + CLG + n * 128 + (c.tid & 7) * 16; LG[0] = *(const u32x4*)gp_; LG[1] = *(const u32x4*)(gp_ + 8); } } while (0)
    u32x4 xr[3], lgc[2] = {{0u, 0u, 0u, 0u}, {0u, 0u, 0u, 0u}}, lgn[2] = {{0u, 0u, 0u, 0u}, {0u, 0u, 0u, 0u}};
    LRU_LOAD(0, xr, lgn);
    for (int ci = 0; ci < len; ++ci) {
        LRU_GEOM(ci, jc, is_ctx, rb, t0, seglen); (void)is_ctx; (void)seglen;
#pragma unroll
        for (int ps = 0; ps < 3; ++ps) { const int i = ps * 32 + (c.tid >> 4);
            if (i < 68) { float f[8]; unpack8(xr[ps], f);
                *(LAS f32x4*)(xl + i * 128 + (c.tid & 15) * 8) = (f32x4){f[0], f[1], f[2], f[3]}; *(LAS f32x4*)(xl + i * 128 + (c.tid & 15) * 8 + 4) = (f32x4){f[4], f[5], f[6], f[7]}; } }
        lgc[0] = lgn[0]; lgc[1] = lgn[1];
        __syncthreads();
        if (ci + 1 < len) LRU_LOAD(ci + 1, xr, lgn);
        { const int ch = c.tid & 127, tq = c.tid >> 7; const float w0 = cw[ch], w1 = cw[DM + ch], w2 = cw[2 * DM + ch], w3 = cw[3 * DM + ch], bb = cb[ch];
#pragma unroll 4
          for (int tt = 0; tt < 16; ++tt) { const int tl = tq * 16 + tt;
              const float u = bb + w0 * xl[tl * 128 + ch] + w1 * xl[(tl + 1) * 128 + ch] + w2 * xl[(tl + 2) * 128 + ch] + w3 * xl[(tl + 3) * 128 + ch];
              uf[tl * 132 + ch] = u; ub[tl * 136 + ch] = f2bf(u); } }
        __syncthreads();
        float cin[2] = {0.f, 0.f}, At[2], He[2];
        if (PASS == 2) { cin[0] = car[(d * 17 + ci) * 128 + q * 32 + col16]; cin[1] = car[(d * 17 + ci) * 128 + q * 32 + 16 + col16]; }
        if (d == 0) lru_chunk<0, PASS>(ub, uf, xl, bfr, ba, bx, sp8, cin, At, He, q, col16, quad);
        else lru_chunk<1, PASS>(ub, uf, hsr, bfr, ba, bx, sp8, cin, At, He, q, col16, quad);
        if (PASS == 1) {
            if (quad == 0) {
#pragma unroll
                for (int ct = 0; ct < 2; ++ct) { const int cidx = n * 128 + q * 32 + ct * 16 + col16;
                    LS[lsum_idx(0, d, b, jc) + cidx] = At[ct]; LS[lsum_idx(1, d, b, jc) + cidx] = He[ct]; } }
            __syncthreads();
        } else {
            __syncthreads();
            { const int row = c.tid >> 3, cs = (c.tid & 7) * 16;
              bf16_t* gp = P + (size_t)(rb + t0 + row) * NIN + CLG + n * 128 + cs;
#pragma unroll
              for (int hseg = 0; hseg < 2; ++hseg) { float g[8]; unpack8(lgc[hseg], g);
                  const int o = row * 132 + cs + hseg * 8;
                  const f32x4 h0 = *(const LAS f32x4*)(xl + o) + *(const LAS f32x4*)(hsr + o), h1 = *(const LAS f32x4*)(xl + o + 4) + *(const LAS f32x4*)(hsr + o + 4);
                  u32x4 ow; ow.x = cvt_pk_bf16(h0[0] * gelu_tanh(g[0]), h0[1] * gelu_tanh(g[1])); ow.y = cvt_pk_bf16(h0[2] * gelu_tanh(g[2]), h0[3] * gelu_tanh(g[3]));
                  ow.z = cvt_pk_bf16(h1[0] * gelu_tanh(g[4]), h1[1] * gelu_tanh(g[5])); ow.w = cvt_pk_bf16(h1[2] * gelu_tanh(g[6]), h1[3] * gelu_tanh(g[7]));
                  *(u32x4*)((dry ? gp - CLG + CU : gp) + hseg * 8) = ow; } }
            __syncthreads();
        }
    }
#undef LRU_GEOM
#undef LRU_LOAD
}

__device__ __forceinline__ void phase_qk(const Ctx& c, int l, bool dry = false) {
    const int gw = c.wg * NWAVES + c.wave, NGW = c.G * NWAVES;
    for (int r = gw; r < MALL; r += NGW) qk_row(c, l, r, l == 0 || r < MLAT, dry);
}
__device__ __forceinline__ void sc_block8(const Ctx& c, int r0, bool dry) {
    const int t0 = r0 & (SEQ - 1);
    bf16_t* prow0 = (bf16_t*)(c.ws + WS_P) + (size_t)r0 * NIN;
    const float* w = (const float*)(c.ws + WS_SP) + SP_SCW; const float* bias = (const float*)(c.ws + WS_SP) + SP_SCB;
    const u32x4 z = {0u, 0u, 0u, 0u};
#pragma unroll 1
    for (int it = 0; it < 4; ++it) {
        const int col = it * 512 + c.lane * 8;
        float w0[8], w1[8], w2[8], bi[8];
#pragma unroll
        for (int hq = 0; hq < 2; ++hq) { const f32x4 a = *(const f32x4*)(w + col + hq * 4), b = *(const f32x4*)(w + DM + col + hq * 4), d = *(const f32x4*)(w + 2 * DM + col + hq * 4), e = *(const f32x4*)(bias + col + hq * 4);
#pragma unroll
            for (int k = 0; k < 4; ++k) { w0[hq * 4 + k] = a[k]; w1[hq * 4 + k] = b[k]; w2[hq * 4 + k] = d[k]; bi[hq * 4 + k] = e[k]; } }
        u32x4 xc[10], xu[10], xb[8];
#pragma unroll
        for (int j = 0; j < 10; ++j) { const int t = t0 - 1 + j; const bool in = t >= 0 && t < SEQ; const bf16_t* pr = prow0 + (ptrdiff_t)(j - 1) * NIN;
            xc[j] = in ? *(const u32x4*)(pr + CCG + col) : z; xu[j] = in ? *(const u32x4*)(pr + CU + col) : z; }
#pragma unroll
        for (int j = 0; j < 8; ++j) xb[j] = *(const u32x4*)(prow0 + (size_t)j * NIN + CBG + col);
        float zp[8], zc[8];
        { float a[8], b[8]; unpack8(xc[0], a); unpack8(xu[0], b);
#pragma unroll
          for (int k = 0; k < 8; ++k) zp[k] = a[k] * b[k];
          unpack8(xc[1], a); unpack8(xu[1], b);
#pragma unroll
          for (int k = 0; k < 8; ++k) zc[k] = a[k] * b[k]; }
#pragma unroll
        for (int j = 0; j < 8; ++j) {
            float a[8], b[8], bg[8], zn[8], o[8]; unpack8(xc[j + 2], a); unpack8(xu[j + 2], b); unpack8(xb[j], bg);
#pragma unroll
            for (int k = 0; k < 8; ++k) { zn[k] = a[k] * b[k]; o[k] = bg[k] * (bi[k] + w0[k] * zp[k] + w1[k] * zc[k] + w2[k] * zn[k]); zp[k] = zc[k]; zc[k] = zn[k]; }
            u32x4 ow; ow.x = cvt_pk_bf16(o[0], o[1]); ow.y = cvt_pk_bf16(o[2], o[3]); ow.z = cvt_pk_bf16(o[4], o[5]); ow.w = cvt_pk_bf16(o[6], o[7]);
            *(u32x4*)((dry ? (bf16_t*)(c.ws + WS_YF) + (size_t)(MALL + r0 + j) * DM : prow0 + (size_t)j * NIN + CBG) + col) = ow; }
    }
}
__device__ __forceinline__ void phase_sc(const Ctx& c, int l, bool dry = false) {
    const int gw = c.wg * NWAVES + c.wave, NGW = c.G * NWAVES;
    for (int r0 = gw * 8; r0 < MLAT; r0 += NGW * 8) sc_block8(c, r0, dry);
    if (l == 0) for (int r = MLAT + gw; r < MALL; r += NGW) sc_row(c, l, r, dry);
}
__device__ __forceinline__ void phase_lru1(const Ctx& c, int l) {
    for (int u = c.wg; u < 256; u += c.G) lru_run<1>(c, l, u);
}

__device__ __forceinline__ void phase_m2(const Ctx& c, int l, bool dry = false) {
    bf16_t* P = (bf16_t*)(c.ws + WS_P); const bf16_t* KC = (const bf16_t*)(c.ws + WS_KC); const bf16_t* VC = (const bf16_t*)(c.ws + WS_VC);
    const int ntot = 1024 + (l == 0 ? 32 : 0);
    for (int i = 0; i * c.G + c.wg < ntot; ++i) {
        const int L = i * c.G + c.wg; int b, h, seq; size_t qrow;
        if (L < 1024) { int grp, qb;
            if (c.G == 256) { grp = i * 8 + (c.wg & 7); qb = c.wg >> 3; } else { grp = L >> 5; qb = L & 31; }
            b = grp >> 4; h = grp & 15; qrow = (size_t)(b * SEQ + qb * 256); seq = NKEY; }
        else { const int u = L - 1024; b = u >> 4; h = u & 15; qrow = (size_t)(MLAT + b * CTXL); seq = CTXL; }
        bf16_t* q = P + qrow * NIN + CQ + h * 128;
        const size_t kvo = (size_t)(b * 4 + (h >> 2)) * NKEY * 128;
        att::attn_dense_body(q, KC + kvo, VC + kvo, dry ? q - CQ + CCG : q, seq, (char*)c.lds, c.wave);
    }
}
__device__ __forceinline__ void phase_lru2(const Ctx& c, int l, bool dry = false) {
    for (int u = c.wg; u < 256; u += c.G) lru_run<2>(c, l, u, dry);
}
constexpr float NEGBIG = -3.0e38f;
constexpr float PU_SCALE = 32.f;
__device__ __forceinline__ float wave_max_dpp(float v) {
    v = fmaxf(v, DPPF(v, 0xB1)); v = fmaxf(v, DPPF(v, 0x4E)); v = fmaxf(v, DPPF(v, 0x141)); v = fmaxf(v, DPPF(v, 0x140));
    const float a = __int_as_float(__builtin_amdgcn_readlane(__float_as_int(v), 0)), b = __int_as_float(__builtin_amdgcn_readlane(__float_as_int(v), 16));
    const float c = __int_as_float(__builtin_amdgcn_readlane(__float_as_int(v), 32)), d = __int_as_float(__builtin_amdgcn_readlane(__float_as_int(v), 48));
    return fmaxf(fmaxf(a, b), fmaxf(c, d));
}
#define SWZ_XOR(v, m) __int_as_float(__builtin_amdgcn_ds_swizzle(__float_as_int(v), ((m) << 10) | 0x1F))
__device__ __forceinline__ unsigned fkey(float x) { const unsigned u = __float_as_uint(x); return (u & 0x80000000u) ? ~u : (u | 0x80000000u); }
#define DPPU(v, ctrl) ((unsigned)__builtin_amdgcn_update_dpp(0, (int)(v), ctrl, 0xF, 0xF, true))
__device__ __forceinline__ unsigned wave_max_u32(unsigned v) {
    v = max(v, DPPU(v, 0xB1)); v = max(v, DPPU(v, 0x4E)); v = max(v, DPPU(v, 0x141)); v = max(v, DPPU(v, 0x140));
    const unsigned a = (unsigned)__builtin_amdgcn_readlane((int)v, 0), b = (unsigned)__builtin_amdgcn_readlane((int)v, 16), c = (unsigned)__builtin_amdgcn_readlane((int)v, 32), d = (unsigned)__builtin_amdgcn_readlane((int)v, 48);
    return max(max(a, b), max(c, d));
}
__device__ __forceinline__ unsigned topk16_keys2(unsigned k0, unsigned k1, int lane) {
    unsigned res = 0u;
    for (int it = 0; it < 16; ++it) { const unsigned m = wave_max_u32(max(k0, k1)); k0 = (k0 == m) ? 0u : k0; k1 = (k1 == m) ? 0u : k1; res = (lane == it) ? m : res; }
    return res;
}
__device__ __forceinline__ unsigned topk16_keys1(unsigned k0, int lane) {
    unsigned res = 0u;
    for (int it = 0; it < 16; ++it) { const unsigned m = wave_max_u32(k0); k0 = (k0 == m) ? 0u : k0; res = (lane == it) ? m : res; }
    return res;
}
__device__ __forceinline__ void unpack_fp8x16(const u32x4 w, float (&f)[16]) {
#pragma unroll
    for (int d = 0; d < 4; ++d) { const f32x2 lo = __builtin_amdgcn_cvt_pk_f32_fp8((int)w[d], false), hi = __builtin_amdgcn_cvt_pk_f32_fp8((int)w[d], true);
        f[4 * d] = lo.x; f[4 * d + 1] = lo.y; f[4 * d + 2] = hi.x; f[4 * d + 3] = hi.y; }
}

__device__ __forceinline__ unsigned half_max_u32(unsigned v, bool hi_half) {
    v = max(v, DPPU(v, 0xB1)); v = max(v, DPPU(v, 0x4E)); v = max(v, DPPU(v, 0x141)); v = max(v, DPPU(v, 0x140));
    const unsigned a = max((unsigned)__builtin_amdgcn_readlane((int)v, 0), (unsigned)__builtin_amdgcn_readlane((int)v, 16));
    const unsigned b = max((unsigned)__builtin_amdgcn_readlane((int)v, 32), (unsigned)__builtin_amdgcn_readlane((int)v, 48));
    return hi_half ? b : a;
}
__device__ __forceinline__ unsigned topk16_half4(unsigned (&k)[4], int hl, bool hi_half) {
    unsigned res = 0u;
    for (int it = 0; it < 16; ++it) { const unsigned m = half_max_u32(max(max(k[0], k[1]), max(k[2], k[3])), hi_half);
#pragma unroll
        for (int j = 0; j < 4; ++j) k[j] = (k[j] == m) ? 0u : k[j];
        res = (hl == it) ? m : res; }
    return res;
}
__device__ __forceinline__ unsigned topk16_half2(unsigned k0, unsigned k1, int hl, bool hi_half) {
    unsigned res = 0u;
    for (int it = 0; it < 16; ++it) { const unsigned m = half_max_u32(max(k0, k1), hi_half); k0 = (k0 == m) ? 0u : k0; k1 = (k1 == m) ? 0u : k1; res = (hl == it) ? m : res; }
    return res;
}
__device__ __forceinline__ void cand_ab(int cidx50, int& a, int& b) {
    a = cidx50 < 16 ? 0 : cidx50 < 24 ? 1 : cidx50 < 29 ? 2 : cidx50 < 33 ? 3 : cidx50 < 36 ? 4 : cidx50 < 38 ? 5 : cidx50 < 40 ? 6 : cidx50 < 42 ? 7 : cidx50 - 34;
    const int st = cidx50 < 16 ? 0 : cidx50 < 24 ? 16 : cidx50 < 29 ? 24 : cidx50 < 33 ? 29 : cidx50 < 36 ? 33 : cidx50 < 38 ? 36 : cidx50 < 40 ? 38 : cidx50 < 42 ? 40 : cidx50;
    b = cidx50 - st;
}
__device__ __forceinline__ void peer_topk_pair(const LAS float* srow, int hp, LAS float* gsc, LAS int* isc, int lane) {
    const int hl = lane & 31, hb = lane & 32; const bool hi_half = lane >= 32; const int h = 2 * hp + (hi_half ? 1 : 0);
    const LAS float* sh = srow + h * 256;
    unsigned k1[4], k2[4];
#pragma unroll
    for (int j = 0; j < 4; ++j) { const int idx = hl + 32 * j; k1[j] = (fkey(sh[idx]) & ~127u) | (unsigned)(127 - idx); k2[j] = (fkey(sh[128 + idx]) & ~127u) | (unsigned)(127 - idx); }
    const unsigned r1 = topk16_half4(k1, hl, hi_half), r2 = topk16_half4(k2, hl, hi_half);
    const int i1 = 127 - (int)(r1 & 127u), i2 = 127 - (int)(r2 & 127u);
    const float v1 = sh[i1], v2 = sh[128 + i2];
    int a0, b0, a1, b1; cand_ab(hl, a0, b0); cand_ab(hl + 32, a1, b1);
    const float c0 = __shfl(v1, hb + a0) + __shfl(v2, hb + b0), c1 = __shfl(v1, hb + (a1 & 15)) + __shfl(v2, hb + (b1 & 15));
    const unsigned q0 = (fkey(c0) & ~255u) | (unsigned)(255 - (a0 * 16 + b0)), q1 = (hl + 32 < 50) ? ((fkey(c1) & ~255u) | (unsigned)(255 - (a1 * 16 + b1))) : 0u;
    const unsigned r3 = topk16_half2(q0, q1, hl, hi_half);
    const int ci = 255 - (int)(r3 & 255u);
    const float sc = __shfl(v1, hb + (ci >> 4)) + __shfl(v2, hb + (ci & 15));
    const int e = __shfl(i1, hb + (ci >> 4)) * 128 + __shfl(i2, hb + (ci & 15));
    const float mxa = __int_as_float(__builtin_amdgcn_readlane(__float_as_int(sc), 0)), mxb = __int_as_float(__builtin_amdgcn_readlane(__float_as_int(sc), 32));
    const float ex = hl < 16 ? __expf(sc - (hi_half ? mxb : mxa)) : 0.f;
    float sm = ex; sm += DPPF(sm, 0xB1); sm += DPPF(sm, 0x4E); sm += DPPF(sm, 0x141); sm += DPPF(sm, 0x140);
    if (hl < 16) { gsc[h * 16 + hl] = ex / sm; isc[h * 16 + hl] = e; }
}

__device__ __forceinline__ unsigned row_max_u32(unsigned v) { v = max(v, DPPU(v, 0xB1)); v = max(v, DPPU(v, 0x4E)); v = max(v, DPPU(v, 0x141)); v = max(v, DPPU(v, 0x140)); return v; }
__device__ __forceinline__ unsigned topk16_row8(unsigned (&k)[8], int rl) {
    unsigned res = 0u;
    for (int it = 0; it < 16; ++it) { const unsigned m = row_max_u32(max(max(max(k[0], k[1]), max(k[2], k[3])), max(max(k[4], k[5]), max(k[6], k[7]))));
#pragma unroll
        for (int j = 0; j < 8; ++j) k[j] = (k[j] == m) ? 0u : k[j];
        res = (rl == it) ? m : res; }
    return res;
}
__device__ __forceinline__ unsigned topk16_row4(unsigned (&k)[4], int rl) {
    unsigned res = 0u;
    for (int it = 0; it < 16; ++it) { const unsigned m = row_max_u32(max(max(k[0], k[1]), max(k[2], k[3])));
#pragma unroll
        for (int j = 0; j < 4; ++j) k[j] = (k[j] == m) ? 0u : k[j];
        res = (rl == it) ? m : res; }
    return res;
}
__device__ __forceinline__ void peer_topk_quad(const LAS float* srow, int hq, LAS float* gsc, LAS int* isc, int lane) {
    const int rl = lane & 15, rb = lane & 48, h = 4 * hq + (lane >> 4);
    const LAS float* sh = srow + h * 256;
    unsigned k1[8], k2[8];
#pragma unroll
    for (int j = 0; j < 8; ++j) { const int idx = rl + 16 * j; k1[j] = (fkey(sh[idx]) & ~127u) | (unsigned)(127 - idx); k2[j] = (fkey(sh[128 + idx]) & ~127u) | (unsigned)(127 - idx); }
    const unsigned r1 = topk16_row8(k1, rl), r2 = topk16_row8(k2, rl);
    const int i1 = 127 - (int)(r1 & 127u), i2 = 127 - (int)(r2 & 127u);
    const float v1 = sh[i1], v2 = sh[128 + i2];
    unsigned q[4];
#pragma unroll
    for (int j = 0; j < 4; ++j) { const int cidx = rl + 16 * j; int a, b; cand_ab(cidx < 50 ? cidx : 0, a, b);
        const float cs = __shfl(v1, rb + (a & 15)) + __shfl(v2, rb + (b & 15));
        q[j] = (cidx < 50) ? ((fkey(cs) & ~255u) | (unsigned)(255 - (a * 16 + b))) : 0u; }
    const unsigned r3 = topk16_row4(q, rl);
    const int ci = 255 - (int)(r3 & 255u);
    const float sc = __shfl(v1, rb + (ci >> 4)) + __shfl(v2, rb + (ci & 15));
    const int e = __shfl(i1, rb + (ci >> 4)) * 128 + __shfl(i2, rb + (ci & 15));
    const float mx = __shfl(sc, rb);
    const float ex = __expf(sc - mx);
    float sm = ex; sm += DPPF(sm, 0xB1); sm += DPPF(sm, 0x4E); sm += DPPF(sm, 0x141); sm += DPPF(sm, 0x140);
    gsc[h * 16 + rl] = ex / sm; isc[h * 16 + rl] = e;
}

constexpr size_t WS_PE_E = WS_P + 160 * MiB, WS_PE_CF = WS_PE_E + (size_t)MALL * 128 * 4;
constexpr int NSL = 16, SLW = 128;
constexpr size_t SLICE_BYTES = (size_t)16384 * SLW;
__device__ __forceinline__ void peer_token(const Ctx& c, int l, int r, int rn, int b, bool dry) {
    LAS float* gsc = (LAS float*)(c.lds + c.wave * 2048 + b * 1024);
    LAS int* isc = (LAS int*)(c.lds + c.wave * 2048 + b * 1024 + 512);
    LAS float* gscn = (LAS float*)(c.lds + c.wave * 2048 + (b ^ 1) * 1024); LAS int* iscn = (LAS int*)(c.lds + c.wave * 2048 + (b ^ 1) * 1024 + 512);
    const float* Sn = (const float*)(c.ws + WS_P) + (size_t)(rn < 0 ? r : rn) * DM;
    const int lane = c.lane;
    LAS float* snb = (LAS float*)(c.lds + 16384 + c.wave * 8192);
    f32x4 sv[8];
#pragma unroll
    for (int q = 0; q < 8; ++q) sv[q] = (rn >= 0) ? *(const f32x4*)(Sn + q * 256 + lane * 4) : (f32x4){0.f, 0.f, 0.f, 0.f};
    LDS_WAIT(); asm volatile("" ::: "memory");
    const bf16_t* hx = (const bf16_t*)(c.ws + WS_HX) + (size_t)r * DM;
    int hq[2][4]; float hdq;
    { float hv[2][16]; float mx = 0.f;
#pragma unroll
      for (int j = 0; j < 2; ++j) { float t0[8], t1[8]; unpack8(*(const u32x4*)(hx + j * 1024 + lane * 16), t0); unpack8(*(const u32x4*)(hx + j * 1024 + lane * 16 + 8), t1);
#pragma unroll
          for (int k = 0; k < 8; ++k) { hv[j][k] = t0[k]; hv[j][8 + k] = t1[k]; mx = fmaxf(mx, fmaxf(fabsf(t0[k]), fabsf(t1[k]))); } }
#pragma unroll
      for (int o = 32; o > 0; o >>= 1) mx = fmaxf(mx, __shfl_xor(mx, o));
      const float q_ = mx > 0.f ? 127.f / mx : 0.f; hdq = mx * (1.f / 127.f);
#pragma unroll
      for (int j = 0; j < 2; ++j)
#pragma unroll
          for (int d = 0; d < 4; ++d) hq[j][d] = (int)pk4_i8(hv[j][4 * d] * q_, hv[j][4 * d + 1] * q_, hv[j][4 * d + 2] * q_, hv[j][4 * d + 3] * q_); }
    const float* USC = (const float*)(c.ws + WS_USC) + (size_t)l * 16384;
    const unsigned char* PU = (const unsigned char*)(c.ws + ws_pu(l)); const unsigned char* PV = (const unsigned char*)(c.ws + ws_pv(l));
#define PEER_LOADROW(tab, wk, e_) do { const unsigned char* row_ = (tab) + (size_t)__builtin_amdgcn_readfirstlane(e_) * DM + lane * 16; wk[0] = *(const u32x4*)row_; wk[1] = *(const u32x4*)(row_ + 1024); } while (0)
#define PEER_IDX8(dst, i_) const u32x4 ia_##dst = *(const LAS u32x4*)(isc + (i_)), ib_##dst = *(const LAS u32x4*)(isc + (i_) + 4); \
        const int dst[8] = {(int)ia_##dst[0], (int)ia_##dst[1], (int)ia_##dst[2], (int)ia_##dst[3], (int)ib_##dst[0], (int)ib_##dst[1], (int)ib_##dst[2], (int)ib_##dst[3]}
    u32x4 w[8][2];
    float usc_ = USC[isc[lane & 7]];
    { PEER_IDX8(e0, 0);
#pragma unroll
      for (int k = 0; k < 8; ++k) PEER_LOADROW(PU, w[k], e0[k]); }
    if (rn >= 0) {
#pragma unroll
        for (int q = 0; q < 8; ++q) *(LAS f32x4*)(snb + q * 256 + lane * 4) = sv[q];
        LDS_WAIT(); asm volatile("" ::: "memory"); }
#pragma unroll 1
    for (int i = 0; i < 128; i += 8) {
        const bool has_next = i + 8 < 128;
        PEER_IDX8(en, has_next ? i + 8 : i);
        const float uscn_ = USC[isc[(has_next ? i + 8 : i) + (lane & 7)]];
        if (rn >= 0 && (i & 56) == 0) peer_topk_quad(snb, i >> 6, gscn, iscn, lane);
        float p[8];
#pragma unroll
        for (int k = 0; k < 8; ++k) {
            asm volatile("" : "+v"(w[k][0]), "+v"(w[k][1]));
            int s = 0;
#pragma unroll
            for (int j = 0; j < 2; ++j)
#pragma unroll
                for (int d = 0; d < 4; ++d) s = __builtin_amdgcn_sdot4((int)w[k][j][d], hq[j][d], s, false);
            p[k] = (float)s; asm volatile("" : "+v"(p[k]));
            if (has_next) PEER_LOADROW(PU, w[k], en[k]); }
        const bool b0 = lane & 1, b1 = lane & 2, b2 = lane & 4;
        float q[4], t[2];
#pragma unroll
        for (int m = 0; m < 4; ++m) q[m] = (b0 ? p[2 * m + 1] : p[2 * m]) + DPPF(b0 ? p[2 * m] : p[2 * m + 1], 0xB1);
#pragma unroll
        for (int m = 0; m < 2; ++m) t[m] = (b1 ? q[2 * m + 1] : q[2 * m]) + DPPF(b1 ? q[2 * m] : q[2 * m + 1], 0x4E);
        float s = (b2 ? t[1] : t[0]) + SWZ_XOR(b2 ? t[0] : t[1], 4);
        s += SWZ_XOR(s, 8); s += SWZ_XOR(s, 16); s += __shfl_xor(s, 32);
        if (lane < 8) gsc[i + lane] = gsc[i + lane] * gelu_tanh(s * (usc_ * hdq));
        usc_ = uscn_;
    }
#undef PEER_LOADROW
#undef PEER_IDX8
    LDS_WAIT(); asm volatile("" ::: "memory");
    { int* E = (int*)(c.ws + WS_PE_E) + (size_t)r * 128; float* CF = (float*)(c.ws + WS_PE_CF) + (size_t)r * 128;
      E[lane] = isc[lane]; E[64 + lane] = isc[64 + lane]; CF[lane] = gsc[lane]; CF[64 + lane] = gsc[64 + lane]; }
    LDS_WAIT(); asm volatile("" ::: "memory");
}
__device__ __forceinline__ void phase_peer(const Ctx& c, int l, int nrows, bool dry = false) {
    const int gw = c.wg * NWAVES + c.wave, NGW = c.G * NWAVES;
    int r = gw; if (r >= nrows) return;
    { const float* S0 = (const float*)(c.ws + WS_P) + (size_t)r * DM; LAS float* snb0 = (LAS float*)(c.lds + 16384 + c.wave * 8192);
#pragma unroll
      for (int q = 0; q < 8; ++q) *(LAS f32x4*)(snb0 + q * 256 + c.lane * 4) = *(const f32x4*)(S0 + q * 256 + c.lane * 4);
      LDS_WAIT(); asm volatile("" ::: "memory");
#pragma unroll 1
      for (int hq = 0; hq < 2; ++hq) peer_topk_quad(snb0, hq, (LAS float*)(c.lds + c.wave * 2048), (LAS int*)(c.lds + c.wave * 2048 + 512), c.lane);
      LDS_WAIT(); asm volatile("" ::: "memory"); }
    int b = 0;
#pragma unroll 1
    for (; r < nrows; r += NGW, b ^= 1) { const int rn = r + NGW; peer_token(c, l, r, rn < nrows ? rn : -1, b, dry); }
}
#define PEER_SLICE_BEGIN() { const int grp = c.wg & 7, wi = (c.wg >> 3) * NWAVES + c.wave, nwi = ((c.G - grp + 7) >> 3) * NWAVES; \
    _Pragma("unroll 1") for (int ps = 0; ps < 2; ++ps) { const int s = grp + 8 * ps; _Pragma("unroll 1") for (int r = wi; r < nrows; r += nwi) {
#define PEER_SLICE_END() } } }
__device__ __forceinline__ void phase_peer_v(const Ctx& c, int l, int nrows, bool dry) {
    const int lane = c.lane, rg = lane >> 3, ch = lane & 7;
    const int* Eb = (const int*)(c.ws + WS_PE_E); const float* CF = (const float*)(c.ws + WS_PE_CF);
    const bool b3 = lane & 8, b4 = lane & 16, b5 = lane & 32;
    const int grp = c.wg & 7, wi = (c.wg >> 3) * NWAVES + c.wave, nwi = ((c.G - grp + 7) >> 3) * NWAVES;
#define V_META(r_, e0_, e1_, c0_, c1_) do { if ((r_) < nrows) { e0_ = Eb[(size_t)(r_) * 128 + lane]; e1_ = Eb[(size_t)(r_) * 128 + 64 + lane]; c0_ = CF[(size_t)(r_) * 128 + lane]; c1_ = CF[(size_t)(r_) * 128 + 64 + lane]; } } while (0)
#pragma unroll 1
    for (int ps = 0; ps < 2; ++ps) { const int s = grp + 8 * ps;
        const unsigned char* tab = (const unsigned char*)(c.ws + ws_pv(l)) + (size_t)s * SLICE_BYTES + ch * 16;
        const int col = s * SLW + ch * 16 + (b3 ? 8 : 0) + (b4 ? 4 : 0) + (b5 ? 2 : 0);
        int r = wi; int e0 = 0, e1 = 0; float c0 = 0.f, c1 = 0.f;
        V_META(r, e0, e1, c0, c1);
#pragma unroll 1
        for (; r < nrows; r += nwi) {
            u32x4 w[16];
#pragma unroll
            for (int i = 0; i < 16; ++i) { const int e = __shfl(i < 8 ? e0 : e1, (8 * i + rg) & 63); w[i] = *(const u32x4*)(tab + (size_t)e * SLW); }
            int f0 = 0, f1 = 0; float d0 = 0.f, d1 = 0.f; V_META(r + nwi, f0, f1, d0, d1);
            const int vec = r < SEQ ? 0 : (r < MLAT ? 1 : 2);
            float* xr = (dry ? (float*)(c.ws + WS_YF) + (size_t)r * DM : xrow_ptr(c, r)) + col;
            const f32x2 gg = *(const f32x2*)((const float*)(c.ws + WS_MOD) + ((size_t)l * 3 + vec) * NMOD + 5 * DM + col); f32x2 xx = *(const f32x2*)xr;
            h16x2 o2[8];
#pragma unroll
            for (int j = 0; j < 8; ++j) o2[j] = (h16x2){(_Float16)0.f, (_Float16)0.f};
#pragma unroll
            for (int i = 0; i < 16; ++i) {
                asm volatile("" : "+v"(w[i]));
                const float ci_ = __shfl(i < 8 ? c0 : c1, (8 * i + rg) & 63);
                const h16x2 ci2 = {(_Float16)ci_, (_Float16)ci_};
#pragma unroll
                for (int d = 0; d < 4; ++d) {
                    const h16x2 lo_ = __builtin_bit_cast(h16x2, __builtin_amdgcn_cvt_scalef32_pk_f16_fp8((int)w[i][d], 1.0f, false)), hi_ = __builtin_bit_cast(h16x2, __builtin_amdgcn_cvt_scalef32_pk_f16_fp8((int)w[i][d], 1.0f, true));
                    o2[2 * d] = __builtin_elementwise_fma(lo_, ci2, o2[2 * d]); o2[2 * d + 1] = __builtin_elementwise_fma(hi_, ci2, o2[2 * d + 1]); }
                asm volatile("" : "+v"(o2[0])); }
            float o[16];
#pragma unroll
            for (int j = 0; j < 8; ++j) { o[2 * j] = (float)o2[j][0]; o[2 * j + 1] = (float)o2[j][1]; }
            float q8[8], q4[4], q2[2];
#pragma unroll
            for (int j = 0; j < 8; ++j) q8[j] = (b3 ? o[8 + j] : o[j]) + DPPF(b3 ? o[j] : o[8 + j], 0x128);
#pragma unroll
            for (int j = 0; j < 4; ++j) q4[j] = (b4 ? q8[4 + j] : q8[j]) + SWZ_XOR(b4 ? q8[j] : q8[4 + j], 16);
#pragma unroll
            for (int j = 0; j < 2; ++j) q2[j] = (b5 ? q4[2 + j] : q4[j]) + __shfl_xor(b5 ? q4[j] : q4[2 + j], 32);
            xx[0] += gg[0] * q2[0]; xx[1] += gg[1] * q2[1];
            *(f32x2*)xr = xx;
            e0 = f0; e1 = f1; c0 = d0; c1 = d1;
        }
    }
#undef V_META
}
struct Args { const float* in[29]; float* out; unsigned char* ws; int ph_lo, ph_hi; };
constexpr int PH_PER_LAYER = 10, N_PHASES = NLAYER * PH_PER_LAYER;
#ifndef G1_WGM
#define G1_WGM 3
#endif
constexpr int CW_BAR = 4096;

__global__ void __launch_bounds__(NTHREADS, 2) mk_fwd(Args args) {
    extern __shared__ __attribute__((aligned(16))) unsigned char lds_raw[];
    Ctx c0;
    c0.out = args.out; c0.ws = args.ws; c0.lds = (LAS unsigned char*)lds_raw;
    c0.tid = threadIdx.x; c0.lane = c0.tid & 63; c0.wave = __builtin_amdgcn_readfirstlane((int)(threadIdx.x >> 6)); c0.wg = blockIdx.x; c0.G = gridDim.x;
    volatile LAS unsigned* MISC = (volatile LAS unsigned*)(c0.lds + MISC_OFF);
    if (c0.tid < 64) MISC[c0.tid] = 0u;
    __syncthreads();
    const int lo = args.ph_lo, hi = args.ph_hi;
    XcdBarrier bar; bar.bar = (unsigned*)(c0.ws + WS_CTL) + CW_BAR; bar.x = 0; bar.st = MISC + 8;
    if (hi - lo > 1) bar = xcd_barrier_post((unsigned*)(c0.ws + WS_CTL) + CW_BAR, MISC + 8);
#ifndef ONLY_PH
#define ONLY_PH -1
#endif
#define IN(k) ((ONLY_PH < 0 || ((k) % PH_PER_LAYER) == ONLY_PH) && lo <= (k) && (k) < hi)
#define PH_BEGIN() Ctx c = c0; unsigned long long wsi_ = (unsigned long long)c0.ws, outi_ = (unsigned long long)c0.out; asm volatile("" : "+s"(wsi_), "+s"(outi_), "+s"(c.wg), "+s"(c.G), "+s"(c.wave)); \
    c.lane = lane_id_fresh(); c.tid = c.wave * 64 + c.lane; c.ws = (unsigned char*)(GAS unsigned char*)wsi_; c.out = (float*)(GAS float*)outi_;     \
    bf16_t* P = (bf16_t*)(c.ws + WS_P); bf16_t* HX = (bf16_t*)(c.ws + WS_HX); float* YF = (float*)(c.ws + WS_YF); (void)P; (void)HX; (void)YF
#ifndef PROBE_DUP
#define PROBE_DUP -1
#endif
#define REPS(k) for (int rep = 0, dry = (PROBE_DUP == (k)); rep < (PROBE_DUP == (k) ? 2 : 1); ++rep, dry = 0)
#define SEAM(k) do { if (IN(k) && IN((k) + 1)) { xcd_barrier(bar, c0.wave); if (PROBE_DUP == 20) xcd_barrier(bar, c0.wave); } } while (0)
    const bool early = (c0.G == 256);
#define TAIL_BEGIN() PH_BEGIN(); c.wg -= 32; c.G -= 32
    for (int l = 0; l < NLAYER; ++l) {
        const int pb = l * PH_PER_LAYER;
        const int mrows = (l == 0) ? MALL : MLAT;
        if (IN(pb + 0) && !(l == 1 && early)) REPS(0) {
            if (l == 0) { PH_BEGIN(); conv_colmax(c); }
            { PH_BEGIN(); conv_units(c, l); } { PH_BEGIN(); conv_tables(c, l); } { PH_BEGIN(); conv_small(c, l); }
            if (l == 0) { { PH_BEGIN(); conv_once(c); } xcd_barrier(bar, c0.wave); }
            { PH_BEGIN(); conv_transposes(c, l); } }
        if (!(l == 1 && early)) SEAM(pb + 0);
        if (IN(pb + 1)) REPS(1) { PH_BEGIN();
            if (l == 0) { GET_IN(); phase_norm<true>(c, l, MALL, SP_NMIX, 0, INP(I_X), INP(I_CTX)); } else phase_norm<true>(c, l, MALL, SP_NMIX, 0); }
        SEAM(pb + 1);
        if (IN(pb + 2)) REPS(2) { PH_BEGIN();
            pg8::Gemm g{HX, (const bf16_t*)(c.ws + WS_WIN), MALL, NIN, DM, DM, DM}; pg8::StaticOrder S; S.init(MALL, NIN, c.G, c.wg, G1_WGM);
            pg8::EpiI8 E{P, NIN, (const float*)(c.ws + WS_ADQ), (const float*)(c.ws + WS_WDQ)};
            pg8::gemm_phase<pg8::EpiI8, pg8::StaticOrder, true, true, false, true>(c.lds, g, S, E, c.wave);
        }
        SEAM(pb + 2);
        if (IN(pb + 3)) REPS(3) {
            int flip_ = (c0.wg >> 3) & 1; asm volatile("" : "+s"(flip_));
#pragma unroll 1
            for (int st = 0; st < 2; ++st) {
                if ((st ^ flip_) == 0) { { PH_BEGIN(); phase_qk(c, l, dry); } { PH_BEGIN(); phase_sc(c, l, dry); } }
                else { PH_BEGIN(); phase_lru1(c, l); }
                __syncthreads(); }
            if (PROBE_DUP == 30) { PH_BEGIN(); phase_lru1(c, l); } }
        SEAM(pb + 3);
        if (IN(pb + 4)) REPS(4) { { PH_BEGIN(); phase_m2(c, l, dry); } __syncthreads(); if (PROBE_DUP == 31) { PH_BEGIN(); phase_lru2(c, l, true); } { PH_BEGIN(); phase_lru2(c, l, dry); } }
        SEAM(pb + 4);
        if (IN(pb + 5)) REPS(5) { { PH_BEGIN();
            pg8::MixOrder S; S.init(mrows, c.G, c.wg);
            const bf16_t* WO = (const bf16_t*)(c.ws + WS_WO);
            { pg8::Gemm g{P + CQ, WO, mrows, DM, DM, NIN, DM}; pg8::EpiMerge<0> E{P + CGT, NIN, (bf16_t*)YF, HX};
              pg8::gemm_phase<pg8::EpiMerge<0>, pg8::MixOrder, true, true, true>(c.lds, g, S, E, c.wave); }
            { pg8::Gemm g{P + CLG, WO + (size_t)DM * DM, mrows, DM, DM, NIN, DM}; pg8::EpiMerge<1> E{P + CGT + DM, NIN, (bf16_t*)YF, HX};
              pg8::gemm_phase<pg8::EpiMerge<1>, pg8::MixOrder, true, true, true>(c.lds, g, S, E, c.wave); }
            { pg8::Gemm g{P + CBG, WO + (size_t)2 * DM * DM, mrows, DM, DM, NIN, DM}; pg8::EpiMerge<2> E{P + CGT + 2 * DM, NIN, (bf16_t*)YF, HX};
              pg8::gemm_phase<pg8::EpiMerge<2>, pg8::MixOrder, true, true, true>(c.lds, g, S, E, c.wave); }
            }
            if (l == 0 && early && c0.wg >= 32 && !dry) { { TAIL_BEGIN(); conv_transposes(c, 1, CV_WIN); } { TAIL_BEGIN(); conv_tables(c, 1, CV_PU); } }
        }
        SEAM(pb + 5);
        if (IN(pb + 6)) REPS(6) { { PH_BEGIN();
            pg8::Gemm g{HX, (const bf16_t*)(c.ws + WS_WOUT), mrows, DM, DM, DM, DM}; pg8::MixOrder S; S.init(mrows, c.G, c.wg);
            float* xl_ = dry ? YF : c.out; float* xc_ = dry ? YF + (size_t)MLAT * DM : (float*)(c.ws + WS_CTXS);
            const float* sl_ = xl_; const float* sc_ = xc_;
            if (l == 0 && !dry) { GET_IN(); sl_ = INP(I_X); sc_ = INP(I_CTX); }
            pg8::EpiResid E{xl_, xc_, (const float*)(c.ws + WS_MOD) + (size_t)l * 3 * NMOD + 2 * DM, sl_, sc_};
            pg8::gemm_phase<pg8::EpiResid, pg8::MixOrder, true, true, true>(c.lds, g, S, E, c.wave);
            }
            if (l == 0 && early && c0.wg >= 32 && !dry) { { TAIL_BEGIN(); conv_units(c, 1); } { TAIL_BEGIN(); conv_transposes(c, 1, CV_WO); } }
        }
        SEAM(pb + 6);
        if (IN(pb + 7)) REPS(7) { PH_BEGIN(); phase_norm(c, l, mrows, SP_NFFN, 3); }
        SEAM(pb + 7);
        if (IN(pb + 8)) REPS(8) { { PH_BEGIN();
            pg8::Gemm g{HX, (const bf16_t*)(c.ws + ws_wsc(l)), mrows, DM, DM, DM, DM}; pg8::MixOrder S; S.init(mrows, c.G, c.wg);
            pg8::EpiF32 E{(float*)(c.ws + WS_P), DM};
            pg8::gemm_phase<pg8::EpiF32, pg8::MixOrder, true, true, true>(c.lds, g, S, E, c.wave);
            }
            if (l == 0 && early && c0.wg >= 32 && !dry) { { TAIL_BEGIN(); conv_transposes(c, 1, CV_WOUT); } { TAIL_BEGIN(); conv_tables(c, 1, CV_PV | CV_LRU); } { TAIL_BEGIN(); conv_small(c, 1); } }
        }
        SEAM(pb + 8);
        if (IN(pb + 9)) REPS(9) {
            { PH_BEGIN(); phase_peer(c, l, mrows, dry); } xcd_barrier(bar, c0.wave);
            { PH_BEGIN(); phase_peer_v(c, l, mrows, dry); } }
        SEAM(pb + 9);
    }
#undef IN
#undef SEAM
}

extern "C" void kernel_launch(void* const* d_in, const int* in_sizes, int n_in, void* d_out, int out_size, void* d_ws, size_t ws_size, hipStream_t stream) {
    static int grid = 0;
    if (grid == 0) {
        if (n_in != 29 || in_sizes[0] != MLAT * DM || out_size != MLAT * DM || ws_size < WS_END) {
            fprintf(stderr, "kernel_launch: built for 29 inputs, x/out of %d floats, >= %zu bytes of workspace; got n_in %d, in0 %d, out %d, ws %zu; nothing launched\n", MLAT * DM, (size_t)WS_END, n_in, n_in > 0 ? in_sizes[0] : -1, out_size, ws_size);
            grid = -1; return; }
        int dev = 0, cus = 0, per_cu = 0;
        if (hipGetDevice(&dev) != hipSuccess || hipDeviceGetAttribute(&cus, hipDeviceAttributeMultiprocessorCount, dev) != hipSuccess) { fprintf(stderr, "kernel_launch: device query failed\n"); grid = -1; return; }
        if (hipFuncSetAttribute((const void*)mk_fwd, hipFuncAttributeMaxDynamicSharedMemorySize, LDS_BYTES) != hipSuccess) { fprintf(stderr, "kernel_launch: hipFuncSetAttribute failed\n"); grid = -1; return; }
        if (hipOccupancyMaxActiveBlocksPerMultiprocessor(&per_cu, (const void*)mk_fwd, NTHREADS, LDS_BYTES) != hipSuccess || per_cu < 1)
            fprintf(stderr, "kernel_launch: note: occupancy query reports %d workgroups per CU\n", per_cu);
        (void)hipGetLastError();
        grid = cus;
    }
    if (grid < 0) return;
    if (hipMemsetAsync((char*)d_ws + WS_CTL, 0, CTL_ZERO_BYTES, stream) != hipSuccess) { fprintf(stderr, "kernel_launch: memset failed\n"); return; }
    Args a{};
    for (int i = 0; i < 29; ++i) a.in[i] = (const float*)d_in[i];
    a.out = (float*)d_out; a.ws = (unsigned char*)d_ws;
#if MK_N_LAUNCHES == 1
    a.ph_lo = 0; a.ph_hi = N_PHASES;
    hipLaunchKernelGGL(mk_fwd, dim3(grid), dim3(NTHREADS), LDS_BYTES, stream, a);
#else
    for (int k = 0; k < N_PHASES; ++k) { a.ph_lo = k; a.ph_hi = k + 1; hipLaunchKernelGGL(mk_fwd, dim3(grid), dim3(NTHREADS), LDS_BYTES, stream, a); }
#endif
    const hipError_t le = hipPeekAtLastError();
    if (le != hipSuccess) fprintf(stderr, "kernel_launch: launch failed: %s\n", hipGetErrorName(le));
}
```

```cpp
#include <hip/hip_runtime.h>
#include <cstdio>
#include <cstdint>

#ifndef MK_N_LAUNCHES
#define MK_N_LAUNCHES 1
#endif
#if MK_N_LAUNCHES != 1
#error "the PEER phase carries a grid barrier of its own: this kernel is one launch only"
#endif

#define GAS __attribute__((address_space(1)))
#define LAS __attribute__((address_space(3)))
typedef unsigned short bf16_t;
typedef short bf16x8 __attribute__((ext_vector_type(8)));
typedef short s16x4 __attribute__((ext_vector_type(4)));
typedef float f32x2 __attribute__((ext_vector_type(2)));
typedef _Float16 h16x2 __attribute__((ext_vector_type(2)));
typedef float f32x4 __attribute__((ext_vector_type(4)));
typedef float f32x8 __attribute__((ext_vector_type(8)));
typedef float f32x16 __attribute__((ext_vector_type(16)));
typedef unsigned u32x2 __attribute__((ext_vector_type(2)));
typedef unsigned u32x4 __attribute__((ext_vector_type(4)));
typedef int i32x4 __attribute__((ext_vector_type(4)));

constexpr int DM = 2048, NB = 2, SEQ = 8192, NLAYER = 2, CTXL = 256;
constexpr int MLAT = NB * SEQ, MCTX = NB * CTXL, MALL = MLAT + MCTX;
constexpr int NIN = 19456;
constexpr int CQ = 0, CK = 2048, CV = 2560, CLX = 3072, CLG = 5120, CBG = 7168, CCG = 9216, CU = 11264, CGT = 13312;
constexpr int NKEY = SEQ + CTXL;
constexpr int NCHUNK = NKEY / 64;
constexpr int NMOD = 6 * DM;
constexpr float EPS = 1e-6f;
constexpr int NWAVES = 8, NTHREADS = 512;

constexpr size_t MiB = 1u << 20;
constexpr size_t al256(size_t x) { return (x + 255) / 256 * 256; }
constexpr size_t WS_CTL = 0, CTL_ZERO_BYTES = 1 * MiB;
constexpr size_t WS_MOD = WS_CTL + CTL_ZERO_BYTES;
constexpr size_t WS_ROPE = WS_MOD + al256((size_t)NLAYER * 3 * NMOD * 4);
constexpr size_t WS_SP = WS_ROPE + al256(2 * 128 * 32 * 4);
constexpr size_t WS_CTXS = WS_SP + al256(36864 * 4);
constexpr size_t WS_LSUM = WS_CTXS + al256((size_t)MCTX * DM * 4);
constexpr size_t WS_WLRU = WS_LSUM + al256((size_t)2 * 2 * NB * NCHUNK * DM * 4);
constexpr size_t WS_KC = WS_WLRU + al256((size_t)16 * 512 * 128 * 2);
constexpr size_t WS_VC = WS_KC + al256((size_t)NB * 4 * NKEY * 128 * 2);
constexpr size_t WS_WIN = WS_VC + al256((size_t)NB * 4 * NKEY * 128 * 2);
constexpr size_t WS_CMAX = WS_WIN + (size_t)NIN * DM;
constexpr size_t WS_WDQ = WS_CMAX + al256((size_t)2 * 32 * NIN * 4);
constexpr size_t WS_ADQ = WS_WDQ + al256((size_t)NIN * 4);
constexpr size_t WS_WO = WS_WIN + al256((size_t)NIN * DM * 2);
constexpr size_t WS_WOUT = WS_WO + al256((size_t)3 * DM * DM * 2);
constexpr size_t WS_WSC = WS_WOUT + al256((size_t)DM * DM * 2);
constexpr size_t WS_PU = WS_WSC + al256((size_t)DM * DM * 2);
constexpr size_t WS_PV = WS_PU + al256((size_t)16384 * DM);
constexpr size_t WS_HX = WS_PV + al256((size_t)16384 * DM);
constexpr size_t WS_YF = WS_HX + al256((size_t)MALL * DM * 2);
constexpr size_t WS_P = WS_YF + al256((size_t)MALL * DM * 4);
static_assert(WS_ADQ + (size_t)MALL * 4 <= WS_WO, "the int8 side tables must fit the spare half of the w_in region");
constexpr size_t WS_PU2 = WS_P + al256((size_t)MALL * NIN * 2);
constexpr size_t WS_PV2 = WS_PU2 + al256((size_t)16384 * DM);
constexpr size_t WS_WSC2 = WS_PV2 + al256((size_t)16384 * DM);
constexpr size_t WS_USC = WS_WSC2 + al256((size_t)DM * DM * 2);
constexpr size_t WS_END = WS_USC + al256((size_t)2 * 16384 * 4);
__host__ __device__ constexpr size_t ws_pu(int l) { return l ? WS_PU2 : WS_PU; }
__host__ __device__ constexpr size_t ws_pv(int l) { return l ? WS_PV2 : WS_PV; }
__host__ __device__ constexpr size_t ws_wsc(int l) { return l ? WS_WSC2 : WS_WSC; }

constexpr int SP_NMIX = 0, SP_NFFN = 2048, SP_QN = 4096, SP_KN = 4224, SP_LCW = 4352, SP_LCB = 12544, SP_LBA = 14592, SP_LBX = 18688, SP_LSP = 22784, SP_SCW = 26880, SP_SCB = 33024, SP_END = 35072;

constexpr int LDS_BYTES = 147456;
constexpr int MISC_OFF = 147456 - 256;
constexpr int LDS_WORK = MISC_OFF;

__device__ __forceinline__ unsigned cvt_pk_bf16(float lo, float hi) { unsigned r; asm volatile("v_cvt_pk_bf16_f32 %0, %1, %2" : "=v"(r) : "v"(lo), "v"(hi)); return r; }
__device__ __forceinline__ unsigned pk4_i8(float a, float b, float c, float d) {
    const int ia = (int)__builtin_rintf(a), ib = (int)__builtin_rintf(b), ic = (int)__builtin_rintf(c), id = (int)__builtin_rintf(d);
    return ((unsigned)ia & 255u) | (((unsigned)ib & 255u) << 8) | (((unsigned)ic & 255u) << 16) | ((unsigned)id << 24); }
__device__ __forceinline__ float bf_lo(unsigned w) { return __uint_as_float(w << 16); }
__device__ __forceinline__ float bf_hi(unsigned w) { return __uint_as_float(w & 0xffff0000u); }
__device__ __forceinline__ float bf1(bf16_t h) { return __uint_as_float(((unsigned)h) << 16); }
__device__ __forceinline__ bf16_t f2bf(float f) { return (bf16_t)(cvt_pk_bf16(f, 0.f) & 0xffffu); }
__device__ __forceinline__ float sigmoidf_(float x) { return __builtin_amdgcn_rcpf(1.f + __expf(-x)); }
__device__ __forceinline__ float gelu_tanh(float x) { const float z = 0.7978845608028654f * (x + 0.044715f * x * x * x); const float e = __expf(2.f * z); return 0.5f * x * (2.f - 2.f * __builtin_amdgcn_rcpf(e + 1.f)); }
__device__ __forceinline__ float wave_sum(float v) {
#pragma unroll
    for (int o = 1; o < 64; o <<= 1) v += __shfl_xor(v, o);
    return v;
}
__device__ __forceinline__ float wave_max(float v) {
#pragma unroll
    for (int o = 1; o < 64; o <<= 1) v = fmaxf(v, __shfl_xor(v, o));
    return v;
}
template <class T> __device__ __forceinline__ T* as_global(T* p) { return (T*)(GAS T*)p; }
__device__ __forceinline__ int lane_id_fresh() { int l; asm volatile("v_mbcnt_lo_u32_b32 %0, -1, 0\n\tv_mbcnt_hi_u32_b32 %0, -1, %0" : "=v"(l)); return l; }
#define DPPF(v, ctrl) __int_as_float(__builtin_amdgcn_update_dpp(0, __float_as_int(v), ctrl, 0xF, 0xF, true))
#define LDS_WAIT() asm volatile("s_waitcnt lgkmcnt(0)" ::: "memory")
#define VM_WAIT() asm volatile("s_waitcnt vmcnt(0)" ::: "memory")

#define XB_TMO      128
#define XB_XCNT(j)  (256  + 64 * (j))
#define XB_XSUB(j)  (1280 + 64 * (j))
#define XB_XGEN(j)  (2304 + 64 * (j))
#define XB_TOP      3328
#define XB_TOPGEN   3392
#define XCD_BAR_WORDS 3456
#define XB_SPIN_CAP (1u << 23)
__device__ __forceinline__ unsigned xb_ld(unsigned* p)              { return __hip_atomic_load(p, __ATOMIC_RELAXED, __HIP_MEMORY_SCOPE_AGENT); }
__device__ __forceinline__ unsigned xb_add(unsigned* p, unsigned v) { return __hip_atomic_fetch_add(p, v, __ATOMIC_RELAXED, __HIP_MEMORY_SCOPE_AGENT); }
__device__ __forceinline__ unsigned xb_xcc_id() { return (unsigned)__builtin_amdgcn_s_getreg((3 << 11) | 20) & 0xFu; }
#define XB_SPIN(cond, bar) do { unsigned _sp = 0; while (cond) { __builtin_amdgcn_s_sleep(1); \
    if ((++_sp & 255u) == 0u) { if (xb_ld(&(bar)[XB_TMO])) break; if (_sp > XB_SPIN_CAP) { atomicAdd(&(bar)[XB_TMO], 1u); break; } } } } while (0)
struct XcdBarrier { unsigned* bar; unsigned x; volatile LAS unsigned* st; };
__device__ __forceinline__ XcdBarrier xcd_barrier_post(unsigned* bar, volatile LAS unsigned* st) {
    XcdBarrier b; b.bar = bar; b.x = xb_xcc_id(); b.st = st;
    if (threadIdx.x == 0) (void)xb_add(&bar[XB_XCNT(b.x)], 1u);
    return b;
}
__device__ __forceinline__ void xcd_barrier_complete(unsigned* bar, unsigned x, unsigned& nloc, unsigned& nx) {
    const unsigned G = gridDim.x * gridDim.y * gridDim.z;
    unsigned sum, cnt, mine, sp = 0u;
    for (;;) {
        sum = 0u; cnt = 0u; mine = 0u;
#pragma unroll
        for (unsigned j = 0; j < 16; ++j) { const unsigned c = xb_ld(&bar[XB_XCNT(j)]); sum += c; cnt += (c > 0u) ? 1u : 0u; mine = (j == x) ? c : mine; }
        if (sum == G) break;
        __builtin_amdgcn_s_sleep(1);
        if ((++sp & 255u) == 0u) { if (xb_ld(&bar[XB_TMO])) break; if (sp > XB_SPIN_CAP) { atomicAdd(&bar[XB_TMO], 1u); break; } }
    }
    nloc = mine > 0u ? mine : 1u; nx = cnt > 0u ? cnt : 1u;
}
__device__ __forceinline__ void xcd_barrier(const XcdBarrier& b, int wave) {
    asm volatile("s_waitcnt vmcnt(0)" ::: "memory");
    __syncthreads();
    if (wave == 0 && lane_id_fresh() == 0) {
        unsigned* bar = b.bar;
        __builtin_amdgcn_s_waitcnt(0);
        unsigned nloc = b.st[0], nx = b.st[1];
        if (nloc == 0u) { xcd_barrier_complete(bar, b.x, nloc, nx); b.st[0] = nloc; b.st[1] = nx; }
        const unsigned old = xb_add(&bar[XB_XSUB(b.x)], 1u);
        const unsigned gen = old / nloc;
        if (old + 1u == (gen + 1u) * nloc) {
            __builtin_amdgcn_fence(__ATOMIC_RELEASE, "agent");
            asm volatile("s_waitcnt vmcnt(0)" ::: "memory");
            const unsigned og = xb_add(&bar[XB_TOP], 1u);
            const unsigned tg = og / nx;
            if (og + 1u == (tg + 1u) * nx) xb_add(&bar[XB_TOPGEN], 1u);
            else XB_SPIN(xb_ld(&bar[XB_TOPGEN]) == tg, bar);
            __builtin_amdgcn_fence(__ATOMIC_ACQUIRE, "agent");
            xb_add(&bar[XB_XGEN(b.x)], 1u);
            asm volatile("s_waitcnt vmcnt(0)" ::: "memory");
        } else {
            XB_SPIN(xb_ld(&bar[XB_XGEN(b.x)]) == gen, bar);
            __builtin_amdgcn_fence(__ATOMIC_ACQUIRE, "agent");
            asm volatile("s_waitcnt vmcnt(0)" ::: "memory");
        }
    }
    __syncthreads();
}
#ifndef MIX_WGM
#define MIX_WGM 8
#endif
namespace pg8 {
#define PG8_LAS __attribute__((address_space(3)))
constexpr int BM = 256, BK = 64, HALF = 128, HTB = HALF * BK * 2, STAGE_BYTES = 8 * HTB, NXCD = 8, WGM = 8;
__host__ __device__ __forceinline__ int lds_byte(int r, int c) { const int st = (r >> 4) * 2 + (c >> 5), rr = r & 15, cc = c & 31, ob = rr * 64 + cc * 2; return st * 1024 + (ob ^ (((ob >> 9) & 1) << 5)); }
__host__ __device__ __forceinline__ void stage_rc(int b, int& R, int& C) { const int st = b / 1024, sb = b % 1024, swz = sb ^ (((sb >> 9) & 1) << 5); R = (st >> 1) * 16 + swz / 64; C = (st & 1) * 32 + (swz % 64) / 2; }
__host__ __device__ __forceinline__ int perm32(int rho) { const int n = rho >> 4, i = rho & 15; return 8 * (i >> 2) + 4 * n + (i & 3); }

struct Unit { int pm, pn, nh; };
struct Gemm { const bf16_t* A; const bf16_t* Bt; int M, N, K, lda, ldb; };

struct StaticOrder {
    int nM, nN, nwg, G, c, wgm = WGM;
    __host__ __device__ void init(int M, int N, int G_, int c_, int wgm_ = WGM) { nM = M / BM; nN = N / BM; nwg = nM * nN; G = G_; c = c_; wgm = wgm_; }
    __host__ __device__ bool next(int i, Unit& u) const {
        const long L = (long)i * G + c; if (L >= nwg) return false;
        int wgid = (int)L; { const int q = nwg / NXCD, r = nwg % NXCD, xcd = wgid % NXCD, off = wgid / NXCD; wgid = (xcd < r ? xcd * (q + 1) : r * (q + 1) + (xcd - r) * q) + off; }
        const int nig = wgm * nN, gid = wgid / nig, fm = gid * wgm, gsz = (nM - fm) < wgm ? (nM - fm) : wgm;
        u.pm = 2 * (fm + ((wgid % nig) % gsz)); u.pn = (wgid % nig) / gsz; u.nh = 2; return true;
    }
    __device__ __forceinline__ void a_ready(const Unit&) const {}
    __device__ __forceinline__ void done(const Unit&) const {}
};

struct MixOrder {
    StaticOrder lat; int nhalf;
    __host__ __device__ void init(int mrows, int G_, int c_) { lat.init(MLAT, 2048, G_, c_, MIX_WGM); nhalf = ((mrows - MLAT) / HALF) * 8; }
    __host__ __device__ bool next(int i, Unit& u) const {
        if (lat.next(i, u)) return true;
        const long h = (long)i * lat.G + lat.c - lat.nwg; if (h < 0 || h >= nhalf) return false;
        u.pm = MLAT / HALF + (int)(h >> 3); u.pn = (int)(h & 7); u.nh = 1; return true;
    }
    __device__ __forceinline__ void a_ready(const Unit&) const {}
    __device__ __forceinline__ void done(const Unit&) const {}
};

struct EpiBf16 {
    static constexpr bool PERM = true, AFTER_DRAIN = false;
    bf16_t* O; int ldc;
    __device__ __forceinline__ void operator()(const f32x4 (&acc)[2][2][4][2], const Unit& u, int wr, int wc, int fr, int fq) const {
        const int row0 = u.pm * HALF + wr * 64 + fr, col0 = u.pn * BM + wc * 32 + 8 * fq;
#pragma unroll
        for (int ai = 0; ai < 2; ++ai) if (ai < u.nh)
#pragma unroll
            for (int m = 0; m < 4; ++m) { bf16_t* rowp = O + (size_t)(row0 + ai * HALF + m * 16) * ldc + col0;
#pragma unroll
                for (int bj = 0; bj < 2; ++bj) { const f32x4 v0 = acc[ai][bj][m][0], v1 = acc[ai][bj][m][1];
                    u32x4 w; w.x = cvt_pk_bf16(v0[0], v0[1]); w.y = cvt_pk_bf16(v0[2], v0[3]); w.z = cvt_pk_bf16(v1[0], v1[1]); w.w = cvt_pk_bf16(v1[2], v1[3]);
                    *(u32x4*)(rowp + bj * HALF) = w; } }
    }
};
struct EpiI8 {
    static constexpr bool PERM = true, AFTER_DRAIN = false;
    bf16_t* O; int ldc; const float* rstep; const float* cstep;
    __device__ __forceinline__ void operator()(const f32x4 (&acc)[2][2][4][2], const Unit& u, int wr, int wc, int fr, int fq) const {
        const int row0 = u.pm * HALF + wr * 64 + fr, col0 = u.pn * BM + wc * 32 + 8 * fq;
        f32x4 cs[2][2];
#pragma unroll
        for (int bj = 0; bj < 2; ++bj) { cs[bj][0] = *(const f32x4*)(cstep + col0 + bj * HALF); cs[bj][1] = *(const f32x4*)(cstep + col0 + bj * HALF + 4); }
#pragma unroll
        for (int ai = 0; ai < 2; ++ai) if (ai < u.nh)
#pragma unroll
            for (int m = 0; m < 4; ++m) { const int r = row0 + ai * HALF + m * 16; bf16_t* rowp = O + (size_t)r * ldc + col0; const float rs = rstep[r];
#pragma unroll
                for (int bj = 0; bj < 2; ++bj) {
                    const f32x4 v0 = __builtin_convertvector(__builtin_bit_cast(i32x4, acc[ai][bj][m][0]), f32x4) * (cs[bj][0] * rs), v1 = __builtin_convertvector(__builtin_bit_cast(i32x4, acc[ai][bj][m][1]), f32x4) * (cs[bj][1] * rs);
                    u32x4 w; w.x = cvt_pk_bf16(v0[0], v0[1]); w.y = cvt_pk_bf16(v0[2], v0[3]); w.z = cvt_pk_bf16(v1[0], v1[1]); w.w = cvt_pk_bf16(v1[2], v1[3]);
                    *(u32x4*)(rowp + bj * HALF) = w; } }
    }
};
struct EpiF32 {
    static constexpr bool PERM = false, AFTER_DRAIN = false;
    float* C; int ldc;
    __device__ __forceinline__ void operator()(const f32x4 (&acc)[2][2][4][2], const Unit& u, int wr, int wc, int fr, int fq) const {
        const int row0 = u.pm * HALF + wr * 64 + fr, col0 = u.pn * BM + wc * 32 + 4 * fq;
#pragma unroll
        for (int ai = 0; ai < 2; ++ai) if (ai < u.nh)
#pragma unroll
            for (int m = 0; m < 4; ++m) { float* rowp = C + (size_t)(row0 + ai * HALF + m * 16) * ldc + col0;
#pragma unroll
                for (int bj = 0; bj < 2; ++bj)
#pragma unroll
                    for (int n = 0; n < 2; ++n) *(f32x4*)(rowp + bj * HALF + n * 16) = acc[ai][bj][m][n]; }
    }
};
template <int MODE> struct EpiMerge {
    static constexpr bool PERM = true, AFTER_DRAIN = false;
    const bf16_t* Gt; int ldg; bf16_t* Y; bf16_t* YB;
    __device__ __forceinline__ void operator()(const f32x4 (&acc)[2][2][4][2], const Unit& u, int wr, int wc, int fr, int fq) const {
        const int row0 = u.pm * HALF + wr * 64 + fr, col0 = u.pn * BM + wc * 32 + 8 * fq;
#pragma unroll
        for (int ai = 0; ai < 2; ++ai) if (ai < u.nh)
#pragma unroll
            for (int m = 0; m < 4; ++m) { const size_t r = (size_t)(row0 + ai * HALF + m * 16);
#pragma unroll
                for (int bj = 0; bj < 2; ++bj) { const int c = col0 + bj * HALF;
                    const u32x4 gw = *(const u32x4*)(Gt + r * ldg + c);
                    f32x4 g0, g1;
                    g0[0] = sigmoidf_(bf_lo(gw.x)); g0[1] = sigmoidf_(bf_hi(gw.x)); g0[2] = sigmoidf_(bf_lo(gw.y)); g0[3] = sigmoidf_(bf_hi(gw.y));
                    g1[0] = sigmoidf_(bf_lo(gw.z)); g1[1] = sigmoidf_(bf_hi(gw.z)); g1[2] = sigmoidf_(bf_lo(gw.w)); g1[3] = sigmoidf_(bf_hi(gw.w));
                    f32x4 y0 = g0 * acc[ai][bj][m][0], y1 = g1 * acc[ai][bj][m][1];
                    if (MODE != 0) { const u32x4 yw = *(const u32x4*)(Y + r * 2048 + c);
                        y0 += (f32x4){bf_lo(yw.x), bf_hi(yw.x), bf_lo(yw.y), bf_hi(yw.y)}; y1 += (f32x4){bf_lo(yw.z), bf_hi(yw.z), bf_lo(yw.w), bf_hi(yw.w)}; }
                    u32x4 w; w.x = cvt_pk_bf16(y0[0], y0[1]); w.y = cvt_pk_bf16(y0[2], y0[3]); w.z = cvt_pk_bf16(y1[0], y1[1]); w.w = cvt_pk_bf16(y1[2], y1[3]);
                    *(u32x4*)((MODE != 2 ? Y : YB) + r * 2048 + c) = w; } }
    }
};
struct EpiResid {
    static constexpr bool PERM = true, AFTER_DRAIN = false;
    float* xlat; float* xctx; const float* gate;
    const float* slat; const float* sctx;
    __device__ __forceinline__ void operator()(const f32x4 (&acc)[2][2][4][2], const Unit& u, int wr, int wc, int fr, int fq) const {
        const int vec = u.pm < 64 ? 0 : (u.pm < 128 ? 1 : 2);
        float* xb = u.pm < 128 ? xlat + (size_t)u.pm * HALF * 2048 : xctx + (size_t)(u.pm - 128) * HALF * 2048;
        const float* sb = u.pm < 128 ? slat + (size_t)u.pm * HALF * 2048 : sctx + (size_t)(u.pm - 128) * HALF * 2048;
        const int lrow0 = wr * 64 + fr, col0 = u.pn * BM + wc * 32 + 8 * fq;
        const float* gp = gate + (size_t)vec * 12288 + col0;
#pragma unroll
        for (int bj = 0; bj < 2; ++bj) { const f32x4 g0 = *(const f32x4*)(gp + bj * HALF), g1 = *(const f32x4*)(gp + bj * HALF + 4);
#pragma unroll
            for (int ai = 0; ai < 2; ++ai) if (ai < u.nh)
#pragma unroll
                for (int m = 0; m < 4; ++m) { const size_t off = (size_t)(lrow0 + ai * HALF + m * 16) * 2048 + col0 + bj * HALF; float* xp = xb + off; const float* sp = sb + off;
                    const f32x4 x0 = *(const f32x4*)sp + g0 * acc[ai][bj][m][0], x1 = *(const f32x4*)(sp + 4) + g1 * acc[ai][bj][m][1];
                    *(f32x4*)xp = x0; *(f32x4*)(xp + 4) = x1; } }
    }
};

template <class Epi, class Sched, bool ALIGN_EPI = false, bool SP2 = false, bool HALFU = false, bool I8 = false>
__device__ __forceinline__ void gemm_phase(PG8_LAS unsigned char* lds, const Gemm g, const Sched& S, const Epi& E, int wave_) {
    int tid_ = wave_ * 64 + lane_id_fresh();
    const int tid = tid_, wid = __builtin_amdgcn_readfirstlane(tid >> 6), lane = tid & 63, wr = wid >> 2, wc = wid & 3, fr = lane & 15, fq = lane >> 4;
    constexpr int ES = I8 ? 1 : 2;
    const int K = g.K, nt = K * ES / (BK * 2);
    unsigned voffA[2], voffB[2];
#pragma unroll
    for (int i = 0; i < 2; ++i) { int R, C; stage_rc(tid * 16 + i * 8192, R, C); const int Rb = Epi::PERM ? ((R & ~31) + perm32(R & 31)) : R;
        voffA[i] = (unsigned)(R * g.lda * ES + C * 2); voffB[i] = (unsigned)(Rb * g.ldb * ES + C * 2); }
    const size_t kstep = (size_t)(BK * 2);
    const size_t hstepA = (size_t)HALF * g.lda * ES, hstepB = (size_t)HALF * g.ldb * ES;
    const size_t tstepB = 2 * hstepB;
    const unsigned ldsw = (unsigned)wid * 1024u;
    const int aoff = lds_byte(wr * 64 + fr, fq * 8), boff = lds_byte(wc * 32 + fr, fq * 8);
#define PG8_SA(b, h) (((b) * 2 + (h)) * HTB)
#define PG8_SB(b, h) ((4 + (b) * 2 + (h)) * HTB)
#define PG8_STAGE(bufoff, gbase, voff) do { _Pragma("unroll") for (int _i = 0; _i < 2; ++_i) \
        __builtin_amdgcn_global_load_lds((const unsigned*)((const char*)(gbase) + (voff)[_i]), (PG8_LAS unsigned*)(lds + (bufoff) + ldsw + _i * 8192), 16, 0, 0); } while (0)
#define PG8_LDA(dst, b, h) do { _Pragma("unroll") for (int m = 0; m < 4; ++m) _Pragma("unroll") for (int k = 0; k < 2; ++k) dst[m][k] = *(const PG8_LAS bf16x8*)(lds + PG8_SA(b, h) + aoff + m * 2048 + k * 1024); } while (0)
#define PG8_LDB(dst, b, h) do { _Pragma("unroll") for (int n = 0; n < 2; ++n) _Pragma("unroll") for (int k = 0; k < 2; ++k) dst[n][k] = *(const PG8_LAS bf16x8*)(lds + PG8_SB(b, h) + boff + n * 2048 + k * 1024); } while (0)
#define PG8_MMA(ai, bj, At, Bt) do { __builtin_amdgcn_s_setprio(1); _Pragma("unroll") for (int m = 0; m < 4; ++m) _Pragma("unroll") for (int n = 0; n < 2; ++n) _Pragma("unroll") for (int k = 0; k < 2; ++k) \
        { if constexpr (I8) acc[ai][bj][m][n] = __builtin_bit_cast(f32x4, __builtin_amdgcn_mfma_i32_16x16x64_i8(__builtin_bit_cast(i32x4, Bt[n][k]), __builtin_bit_cast(i32x4, At[m][k]), __builtin_bit_cast(i32x4, acc[ai][bj][m][n]), 0, 0, 0)); \
          else acc[ai][bj][m][n] = __builtin_amdgcn_mfma_f32_16x16x32_bf16(Bt[n][k], At[m][k], acc[ai][bj][m][n], 0, 0, 0); } __builtin_amdgcn_s_setprio(0); } while (0)
#define PG8_WAIT_V(n) asm volatile("s_waitcnt vmcnt(" #n ")" ::: "memory")
#define PG8_WAIT_L(n) asm volatile("s_waitcnt lgkmcnt(" #n ")" ::: "memory")
#define PG8_BAR __builtin_amdgcn_s_barrier()
#define PG8_SCHED __builtin_amdgcn_sched_barrier(0)
    Unit cur, nxt; int ui = 0;
    if (!S.next(0, cur)) return;
    f32x4 acc[2][2][4][2];
#pragma unroll
    for (int a = 0; a < 2; ++a)
#pragma unroll
        for (int b = 0; b < 2; ++b)
#pragma unroll
            for (int m = 0; m < 4; ++m)
#pragma unroll
                for (int n = 0; n < 2; ++n) acc[a][b][m][n] = (f32x4){0.f, 0.f, 0.f, 0.f};
    bf16x8 At[4][2], B0[2][2], B1[2][2];
    const char* cA = (const char*)g.A + (size_t)cur.pm * hstepA; const char* cB = (const char*)g.Bt + (size_t)cur.pn * tstepB;
    size_t chA = (!HALFU || cur.nh == 2) ? hstepA : 0;
    S.a_ready(cur);
    if constexpr (SP2) {
        PG8_STAGE(PG8_SB(0, 0), cB, voffB); PG8_STAGE(PG8_SB(0, 1), cB + hstepB, voffB); PG8_STAGE(PG8_SA(0, 0), cA, voffA); PG8_STAGE(PG8_SA(0, 1), cA + chA, voffA);
        if (wr == 1) PG8_BAR;
        PG8_WAIT_V(2); PG8_BAR;
        PG8_STAGE(PG8_SB(1, 0), cB + kstep, voffB); PG8_STAGE(PG8_SA(1, 0), cA + kstep, voffA); PG8_STAGE(PG8_SB(1, 1), cB + hstepB + kstep, voffB);
        PG8_WAIT_V(6); PG8_BAR;
    } else {
        PG8_STAGE(PG8_SB(0, 0), cB, voffB); PG8_STAGE(PG8_SA(0, 0), cA, voffA); PG8_STAGE(PG8_SB(0, 1), cB + hstepB, voffB); PG8_STAGE(PG8_SA(0, 1), cA + chA, voffA);
        if (wr == 1) PG8_BAR;
        PG8_WAIT_V(4); PG8_BAR;
        PG8_STAGE(PG8_SB(1, 0), cB + kstep, voffB); PG8_STAGE(PG8_SA(1, 0), cA + kstep, voffA); PG8_STAGE(PG8_SB(1, 1), cB + hstepB + kstep, voffB);
        PG8_WAIT_V(6); PG8_BAR;
    }
    for (;;) {
        const bool has_next = S.next(ui + 1, nxt);
        const char* nA = has_next ? (const char*)g.A + (size_t)nxt.pm * hstepA : cA; const size_t nhA = has_next ? ((!HALFU || nxt.nh == 2) ? hstepA : 0) : chA; const bool full = (!HALFU || cur.nh == 2);
        const char* nA_ = nA; (void)nA_; const char* nB = has_next ? (const char*)g.Bt + (size_t)nxt.pn * tstepB : cB;
        for (int t = 0; t < nt; t += 2) {
            const bool last = (t == nt - 2);
            const char* a1 = cA + (size_t)(t + 1) * kstep;
            const char* a2 = last ? nA : cA + (size_t)(t + 2) * kstep; const char* b2 = last ? nB : cB + (size_t)(t + 2) * kstep;
            const char* a3 = a2 + kstep; const char* b3 = b2 + kstep;
            const size_t h2A = last ? nhA : chA;
            if (last && has_next) S.a_ready(nxt);
            if constexpr (SP2) {
            PG8_LDB(B0, 0, 0); PG8_LDB(B1, 0, 1); PG8_SCHED; PG8_LDA(At, 0, 0); PG8_STAGE(PG8_SA(1, 1), a1 + chA, voffA);
            PG8_WAIT_V(8); PG8_WAIT_L(0); PG8_BAR; PG8_MMA(0, 0, At, B0); PG8_MMA(0, 1, At, B1); PG8_BAR; PG8_SCHED;
            PG8_LDA(At, 0, 1); PG8_STAGE(PG8_SB(0, 0), b2, voffB); PG8_STAGE(PG8_SB(0, 1), b2 + hstepB, voffB); PG8_STAGE(PG8_SA(0, 0), a2, voffA);
            PG8_WAIT_V(8); PG8_WAIT_L(0); PG8_BAR; if (full) { PG8_MMA(1, 0, At, B0); PG8_MMA(1, 1, At, B1); } PG8_BAR; PG8_SCHED;
            PG8_LDB(B0, 1, 0); PG8_LDB(B1, 1, 1); PG8_SCHED; PG8_LDA(At, 1, 0); PG8_STAGE(PG8_SA(0, 1), a2 + h2A, voffA);
            PG8_WAIT_V(8); PG8_WAIT_L(0); PG8_BAR; PG8_MMA(0, 0, At, B0); PG8_MMA(0, 1, At, B1); PG8_BAR; PG8_SCHED;
            PG8_LDA(At, 1, 1); PG8_STAGE(PG8_SB(1, 0), b3, voffB); PG8_STAGE(PG8_SB(1, 1), b3 + hstepB, voffB); PG8_STAGE(PG8_SA(1, 0), a3, voffA);
            PG8_WAIT_V(8); PG8_WAIT_L(0); PG8_BAR; if (full) { PG8_MMA(1, 0, At, B0); PG8_MMA(1, 1, At, B1); } PG8_BAR; PG8_SCHED;
            } else {
            PG8_LDB(B0, 0, 0); PG8_SCHED; PG8_LDA(At, 0, 0); PG8_STAGE(PG8_SA(1, 1), a1 + chA, voffA);
            PG8_WAIT_L(8); PG8_BAR; PG8_WAIT_L(0); PG8_MMA(0, 0, At, B0); PG8_BAR; PG8_SCHED;
            PG8_LDB(B1, 0, 1); PG8_STAGE(PG8_SB(0, 0), b2, voffB);
            PG8_BAR; PG8_WAIT_L(0); PG8_MMA(0, 1, At, B1); PG8_BAR;
            PG8_LDA(At, 0, 1); PG8_STAGE(PG8_SA(0, 0), a2, voffA);
            PG8_BAR; PG8_WAIT_L(0); if (full) PG8_MMA(1, 0, At, B0); PG8_BAR; PG8_SCHED;
            PG8_STAGE(PG8_SB(0, 1), b2 + hstepB, voffB);
            PG8_WAIT_V(6); PG8_BAR; if (full) PG8_MMA(1, 1, At, B1); PG8_BAR;
            PG8_LDB(B0, 1, 0); PG8_SCHED; PG8_LDA(At, 1, 0); PG8_STAGE(PG8_SA(0, 1), a2 + h2A, voffA);
            PG8_WAIT_L(8); PG8_BAR; PG8_WAIT_L(0); PG8_MMA(0, 0, At, B0); PG8_BAR; PG8_SCHED;
            PG8_LDB(B1, 1, 1); PG8_STAGE(PG8_SB(1, 0), b3, voffB);
            PG8_BAR; PG8_WAIT_L(0); PG8_MMA(0, 1, At, B1); PG8_BAR;
            PG8_LDA(At, 1, 1); PG8_STAGE(PG8_SA(1, 0), a3, voffA);
            PG8_BAR; PG8_WAIT_L(0); if (full) PG8_MMA(1, 0, At, B0); PG8_BAR; PG8_SCHED;
            PG8_STAGE(PG8_SB(1, 1), b3 + hstepB, voffB);
            PG8_WAIT_V(6); PG8_BAR; if (full) PG8_MMA(1, 1, At, B1); PG8_BAR;
            }
        }
        if constexpr (ALIGN_EPI) { if (wr == 0) PG8_BAR; }
        if constexpr (!Epi::AFTER_DRAIN) { E(acc, cur, wr, wc, fr, fq); S.done(cur); }
        if (!has_next) break;
#pragma unroll
        for (int a = 0; a < 2; ++a)
#pragma unroll
            for (int b = 0; b < 2; ++b)
#pragma unroll
                for (int m = 0; m < 4; ++m)
#pragma unroll
                    for (int n = 0; n < 2; ++n) acc[a][b][m][n] = (f32x4){0.f, 0.f, 0.f, 0.f};
        cur = nxt; cA = nA; cB = nB; chA = nhA; ++ui;
        if constexpr (ALIGN_EPI) { if (wr == 1) PG8_BAR; }
    }
    PG8_WAIT_V(0);
    if constexpr (!ALIGN_EPI) { if (wr == 0) PG8_BAR; }
    PG8_BAR;
#undef PG8_SA
#undef PG8_SB
#undef PG8_STAGE
#undef PG8_LDA
#undef PG8_LDB
#undef PG8_MMA
#undef PG8_WAIT_V
#undef PG8_WAIT_L
#undef PG8_BAR
#undef PG8_SCHED
}
}
namespace att {
constexpr int D = 128, NW = 8, QBLK = 32, KVBLK = 64;
constexpr float SCALE = 0.088388347648318440f;
constexpr float THR = 8.f;
constexpr int LDQ = NIN, LDK = 128, LDO = NIN;
constexpr size_t SHM_V = KVBLK * D * 2, SHM_K = KVBLK * D * 2, SHM_ATTN = 2 * SHM_V + 2 * SHM_K + NW * 64 * 4;
#define KSWZ(row, colB) ((row) * 256 + ((colB) ^ (((row) & 7) << 4)))
#define SBAR() __builtin_amdgcn_sched_barrier(0)
__device__ __forceinline__ int crow(int r, int hi) { return (r & 3) + 8 * (r >> 2) + 4 * hi; }
__device__ __forceinline__ unsigned cvtpk(float lo, float hi) { unsigned r; asm volatile("v_cvt_pk_bf16_f32 %0, %1, %2" : "=v"(r) : "v"(lo), "v"(hi)); return r; }
__device__ __forceinline__ bf16x8 ld8(const bf16_t* p) { return *reinterpret_cast<const bf16x8*>(p); }

__device__ __forceinline__ void partialSM(f32x16& p0, f32x16& p1, float& m_reg, float& mn, float& alpha) {
  constexpr float C = SCALE * 1.4426950408889634f;
  float pmax = p0[0];
#pragma unroll
  for (int r = 1; r < 16; ++r) pmax = fmaxf(pmax, p0[r]);
#pragma unroll
  for (int r = 0; r < 16; ++r) pmax = fmaxf(pmax, p1[r]);
  { auto rr = __builtin_amdgcn_permlane32_swap(__float_as_uint(pmax), __float_as_uint(pmax), false, false);
    pmax = fmaxf(__uint_as_float(rr[0]), __uint_as_float(rr[1])); }
  if (__builtin_expect(__all(pmax - m_reg <= THR / SCALE), 1)) { mn = m_reg; alpha = 1.f; }
  else { mn = fmaxf(m_reg, pmax); alpha = __builtin_amdgcn_exp2f((m_reg - mn) * C); m_reg = mn; }
  float mnC = -mn * C;
#pragma unroll
  for (int r = 0; r < 16; ++r) p0[r] = fmaf(p0[r], C, mnC);
#pragma unroll
  for (int r = 0; r < 16; ++r) p1[r] = fmaf(p1[r], C, mnC);
#pragma unroll
  for (int r = 0; r < 16; ++r) p0[r] = __builtin_amdgcn_exp2f(p0[r]);
}
__device__ __forceinline__ void finishSM(f32x16& p0, f32x16& p1, float alpha, float& l_reg, bf16x8& pa0, bf16x8& pa1, bf16x8& pa2, bf16x8& pa3) {
#pragma unroll
  for (int r = 0; r < 16; ++r) p1[r] = __builtin_amdgcn_exp2f(p1[r]);
  float ps = 0;
#pragma unroll
  for (int r = 0; r < 16; ++r) ps += p0[r];
#pragma unroll
  for (int r = 0; r < 16; ++r) ps += p1[r];
  { auto rr = __builtin_amdgcn_permlane32_swap(__float_as_uint(ps), __float_as_uint(ps), false, false);
    ps = __uint_as_float(rr[0]) + __uint_as_float(rr[1]); }
  l_reg = l_reg * alpha + ps;
#define PK4(P, BASE, OUT) do { unsigned a0 = cvtpk(P[BASE + 0], P[BASE + 1]), a1 = cvtpk(P[BASE + 2], P[BASE + 3]);   \
    unsigned b0 = cvtpk(P[BASE + 4], P[BASE + 5]), b1 = cvtpk(P[BASE + 6], P[BASE + 7]);                              \
    auto r0 = __builtin_amdgcn_permlane32_swap(a0, b0, false, false); auto r1 = __builtin_amdgcn_permlane32_swap(a1, b1, false, false); \
    u32x4 w = {r0[0], r1[0], r0[1], r1[1]}; OUT = *reinterpret_cast<bf16x8*>(&w); } while (0)
  PK4(p0, 0, pa0); PK4(p0, 8, pa1); PK4(p1, 0, pa2); PK4(p1, 8, pa3);
#undef PK4
}
__device__ __forceinline__ void qkt(f32x16& p0, f32x16& p1, const bf16_t* Ks, const bf16x8* qr, int r32, int hi) {
  p0 = f32x16{}; p1 = f32x16{};
#pragma unroll
  for (int d0 = 0; d0 < 8; ++d0) { int cb = (d0 * 16 + hi * 8) * 2;
    bf16x8 b0 = *reinterpret_cast<const bf16x8*>((const char*)Ks + KSWZ(r32, cb));
    bf16x8 b1 = *reinterpret_cast<const bf16x8*>((const char*)Ks + KSWZ(32 + r32, cb));
    p0 = __builtin_amdgcn_mfma_f32_32x32x16_bf16(b0, qr[d0], p0, 0, 0, 0);
    p1 = __builtin_amdgcn_mfma_f32_32x32x16_bf16(b1, qr[d0], p1, 0, 0, 0); }
}
__device__ __forceinline__ int v_st(int k, int c) { const int kk = (k & ~0xC) | ((k & 4) << 1) | ((k & 8) >> 1); return ((kk >> 3) * 4 + (c >> 5)) * 512 + ((kk & 7) * 32 + (c & 31)) * 2; }
__device__ __forceinline__ int v_rd_base(int lane) { return ((lane & 3) << 3) | (((lane >> 2) & 3) << 6) | (((lane >> 4) & 1) << 5) | (((lane >> 5) & 1) << 8); }
constexpr int v_rd_off(int d0, int ks, int half) { return d0 * 512 + ks * 4096 + half * 2048; }
template <int OFF> __device__ __forceinline__ s16x4 tr_read(int vb) {
  s16x4 r; asm volatile("ds_read_b64_tr_b16 %0, %1 offset:%2" : "=&v"(r) : "v"(vb), "i"(OFF) : "memory"); return r;
}
template <int D0> __device__ __forceinline__ void pv_one(f32x16& od, int vb, bf16x8 pa0, bf16x8 pa1, bf16x8 pa2, bf16x8 pa3) {
  const s16x4 l0 = tr_read<v_rd_off(D0, 0, 0)>(vb), h0 = tr_read<v_rd_off(D0, 0, 1)>(vb), l1 = tr_read<v_rd_off(D0, 1, 0)>(vb), h1 = tr_read<v_rd_off(D0, 1, 1)>(vb);
  const s16x4 l2 = tr_read<v_rd_off(D0, 2, 0)>(vb), h2 = tr_read<v_rd_off(D0, 2, 1)>(vb), l3 = tr_read<v_rd_off(D0, 3, 0)>(vb), h3 = tr_read<v_rd_off(D0, 3, 1)>(vb);
  asm volatile("s_waitcnt lgkmcnt(0)" ::: "memory"); SBAR();
#define PK(L, H) (bf16x8){L[0], L[1], L[2], L[3], H[0], H[1], H[2], H[3]}
  od = __builtin_amdgcn_mfma_f32_32x32x16_bf16(pa0, PK(l0, h0), od, 0, 0, 0);
  od = __builtin_amdgcn_mfma_f32_32x32x16_bf16(pa1, PK(l1, h1), od, 0, 0, 0);
  od = __builtin_amdgcn_mfma_f32_32x32x16_bf16(pa2, PK(l2, h2), od, 0, 0, 0);
  od = __builtin_amdgcn_mfma_f32_32x32x16_bf16(pa3, PK(l3, h3), od, 0, 0, 0);
#undef PK
}
__device__ __forceinline__ void pv_d0(f32x16* o, int vb, bf16x8 pa0, bf16x8 pa1, bf16x8 pa2, bf16x8 pa3) {
  pv_one<0>(o[0], vb, pa0, pa1, pa2, pa3); pv_one<1>(o[1], vb, pa0, pa1, pa2, pa3); pv_one<2>(o[2], vb, pa0, pa1, pa2, pa3); pv_one<3>(o[3], vb, pa0, pa1, pa2, pa3);
}

__device__ __forceinline__ void attn_dense_body(const bf16_t* __restrict__ Qb, const bf16_t* __restrict__ Kh, const bf16_t* __restrict__ Vh,
                                                bf16_t* Ob, int seq, char* lds, int wave_) {
  constexpr int SDEPTH = 2;
  int tid_ = wave_ * 64 + lane_id_fresh();
  const int tid = tid_, wid = tid >> 6, lane = tid & 63, r32 = lane & 31, hi = lane >> 5;
  bf16_t* V_lds = (bf16_t*)lds; bf16_t* K_lds = (bf16_t*)(lds + 2 * SHM_V);
  float* ws = (float*)(lds + 2 * SHM_V + 2 * SHM_K) + wid * 64; float* li_l = ws; float* al_l = ws + 32;
  float m_reg = -1e30f, l_reg = 0; f32x16 o[4] = {}; bf16x8 qr[8];
  const bf16_t* Qw = Qb + (long)(wid * QBLK + r32) * LDQ + hi * 8;
#pragma unroll
  for (int d0 = 0; d0 < 8; ++d0) qr[d0] = ld8(Qw + d0 * 16);
  const int sr = tid >> 4, sc = (tid & 15) * 8, vst0 = v_st(sr, sc), vst1 = v_st(32 + sr, sc);
  const int vb0 = (int)(uintptr_t)V_lds + v_rd_base(lane);
  struct { bf16x8 vs0, vs1, ks0, ks1; } sr_[SDEPTH];
#define SLOAD(i, k0) do { sr_[i].vs0 = ld8(&Vh[(long)((k0) + sr) * LDK + sc]); sr_[i].vs1 = ld8(&Vh[(long)((k0) + 32 + sr) * LDK + sc]); \
    sr_[i].ks0 = ld8(&Kh[(long)((k0) + sr) * LDK + sc]); sr_[i].ks1 = ld8(&Kh[(long)((k0) + 32 + sr) * LDK + sc]); } while (0)
#define SWRITE(b, i) do { *(bf16x8*)((char*)V_lds + (b) * SHM_V + vst0) = sr_[i].vs0;          \
    *(bf16x8*)((char*)V_lds + (b) * SHM_V + vst1) = sr_[i].vs1; int kc = sc * 2;               \
    *(bf16x8*)((char*)K_lds + (b) * SHM_K + KSWZ(sr, kc)) = sr_[i].ks0;                       \
    *(bf16x8*)((char*)K_lds + (b) * SHM_K + KSWZ(32 + sr, kc)) = sr_[i].ks1; } while (0)
#define SWAIT() asm volatile("s_waitcnt vmcnt(4)" ::: "memory")
#define RESC(a) do { if (__any((a) < 1.f)) { if (hi == 0) al_l[r32] = (a); asm volatile("s_waitcnt lgkmcnt(0)" ::: "memory"); \
    _Pragma("unroll") for (int d = 0; d < 4; ++d) _Pragma("unroll") for (int r = 0; r < 16; ++r) o[d][r] *= al_l[crow(r, hi)]; } } while (0)
  f32x16 pA0, pA1, pB0, pB1; float mnA, mnB, alA, alB; bf16x8 pa0, pa1, pa2, pa3; const int NT = seq / KVBLK;
  constexpr int SE = 0, SO = SDEPTH - 1;
  SLOAD(SE, 0); asm volatile("s_waitcnt vmcnt(0)" ::: "memory"); SWRITE(0, SE); __syncthreads();
  qkt(pA0, pA1, K_lds, qr, r32, hi); partialSM(pA0, pA1, m_reg, mnA, alA);
  SLOAD(SO, KVBLK); if (2 < NT) SLOAD(SE, 2 * KVBLK);
  SWAIT(); SWRITE(1, SO); __syncthreads();
  for (int j = 1; j + 1 < NT; j += 2) {
    SBAR(); qkt(pB0, pB1, (bf16_t*)((char*)K_lds + SHM_K), qr, r32, hi);
    finishSM(pA0, pA1, alA, l_reg, pa0, pa1, pa2, pa3); SBAR();
    SLOAD(SO, (j + SDEPTH) * KVBLK); SBAR();
    pv_d0(o, vb0, pa0, pa1, pa2, pa3); partialSM(pB0, pB1, m_reg, mnB, alB);
    __syncthreads(); SWAIT(); SWRITE(0, SE);
    RESC(alB); __syncthreads();
    SBAR(); qkt(pA0, pA1, K_lds, qr, r32, hi);
    finishSM(pB0, pB1, alB, l_reg, pa0, pa1, pa2, pa3); SBAR();
    if (j + 3 < NT) SLOAD(SE, (j + 1 + SDEPTH) * KVBLK); SBAR();
    pv_d0(o, vb0 + (int)SHM_V, pa0, pa1, pa2, pa3); partialSM(pA0, pA1, m_reg, mnA, alA);
    __syncthreads(); SWAIT(); SWRITE(1, SO);
    RESC(alA); __syncthreads();
  }
  SBAR(); qkt(pB0, pB1, (bf16_t*)((char*)K_lds + SHM_K), qr, r32, hi);
  finishSM(pA0, pA1, alA, l_reg, pa0, pa1, pa2, pa3); SBAR();
  pv_d0(o, vb0, pa0, pa1, pa2, pa3); partialSM(pB0, pB1, m_reg, mnB, alB);
  __syncthreads(); RESC(alB);
  finishSM(pB0, pB1, alB, l_reg, pa0, pa1, pa2, pa3); SBAR();
  pv_d0(o, vb0 + (int)SHM_V, pa0, pa1, pa2, pa3);
  if (hi == 0) li_l[r32] = l_reg; asm volatile("s_waitcnt lgkmcnt(0)" ::: "memory");
  float rli[16];
#pragma unroll
  for (int r = 0; r < 16; ++r) rli[r] = __builtin_amdgcn_rcpf(li_l[crow(r, hi)]);
  bf16_t* Ow = Ob + (long)(wid * QBLK) * LDO;
#pragma unroll
  for (int r = 0; r < 16; ++r) { int orow = crow(r, hi);
#pragma unroll
    for (int d0 = 0; d0 < 4; ++d0) Ow[(long)orow * LDO + d0 * 32 + r32] = f2bf(o[d0][r] * rli[r]); }
  __syncthreads();
#undef SLOAD
#undef SWRITE
#undef SWAIT
#undef RESC
}
#undef KSWZ
#undef SBAR
}
#define CAS __attribute__((address_space(4)))
#define INP(i) ((const float*)(GAS const float*)in[i])
struct Ctx {
    float* out; unsigned char* ws;
    LAS unsigned char* lds; int tid, lane, wave, wg, G;
};
enum { I_X = 0, I_C, I_CTX, I_CCTX, I_WMOD, I_BMOD, I_NMIX, I_NFFN, I_WIN, I_QN, I_KN, I_LCW, I_LCB, I_LWA, I_LBA, I_LWX, I_LBX, I_LLAM, I_SCW, I_SCB,
       I_WOA, I_WOL, I_WOS, I_WOUT, I_PWQ, I_PK1, I_PK2, I_PU, I_PV };

__device__ __forceinline__ float* xrow_ptr(const Ctx& c, int r) {
    return r < MLAT ? c.out + (size_t)r * DM : (float*)(c.ws + WS_CTXS) + (size_t)(r - MLAT) * DM;
}

template <bool I8 = false>
__device__ __forceinline__ void transpose_item(const float* W, int K, int N, bf16_t* WT, LAS float* scr, int item, int lane, const float* cmax = nullptr, float* wdq = nullptr, LAS float* scol = nullptr) {
    const int nblk = N / 64, kb = item / nblk, nb = item % nblk, k0 = 64 * kb, n0 = 64 * nb;
    if constexpr (I8) { float mx = 0.f;
#pragma unroll 8
        for (int kc = 0; kc < 32; ++kc) mx = fmaxf(mx, cmax[(size_t)kc * N + n0 + lane]);
        scol[lane] = mx > 0.f ? 127.f / mx : 0.f;
        if (kb == 0) wdq[n0 + lane] = mx * (1.f / 127.f); }
    const float* src = W + (size_t)(k0 + (lane >> 4)) * N + n0 + (lane & 15) * 4;
    f32x4 v[16];
#pragma unroll
    for (int i = 0; i < 16; ++i) v[i] = *(const f32x4*)(src + (size_t)(4 * i) * N);
    LAS float* d = scr + (lane >> 4) * 65 + (lane & 15) * 4;
#pragma unroll
    for (int i = 0; i < 16; ++i) { d[(4 * i) * 65 + 0] = v[i][0]; d[(4 * i) * 65 + 1] = v[i][1]; d[(4 * i) * 65 + 2] = v[i][2]; d[(4 * i) * 65 + 3] = v[i][3]; }
    LDS_WAIT(); asm volatile("" ::: "memory");
    const int c = lane & 7;
#pragma unroll
    for (int j = 0; j < 8; ++j) { const int n = (lane >> 3) + 8 * j; const LAS float* s = scr + (8 * c) * 65 + n;
        if constexpr (I8) { const float q_ = scol[n]; u32x2 o; o.x = pk4_i8(s[0 * 65] * q_, s[1 * 65] * q_, s[2 * 65] * q_, s[3 * 65] * q_); o.y = pk4_i8(s[4 * 65] * q_, s[5 * 65] * q_, s[6 * 65] * q_, s[7 * 65] * q_);
            *(u32x2*)((unsigned char*)WT + (size_t)(n0 + n) * K + k0 + 8 * c) = o; }
        else { u32x4 o; o.x = cvt_pk_bf16(s[0 * 65], s[1 * 65]); o.y = cvt_pk_bf16(s[2 * 65], s[3 * 65]); o.z = cvt_pk_bf16(s[4 * 65], s[5 * 65]); o.w = cvt_pk_bf16(s[6 * 65], s[7 * 65]);
            *(u32x4*)(WT + (size_t)(n0 + n) * K + k0 + 8 * c) = o; } }
    LDS_WAIT(); asm volatile("" ::: "memory");
}

__device__ __forceinline__ void mod_unit(const Ctx& c, CAS const unsigned long long* in, int l, int cb) {
    LAS float* sv = (LAS float*)c.lds;
    LAS float* red = sv + 3 * DM;
    { const float* cc = INP(I_C); const float* cx = INP(I_CCTX);
      for (int i = c.tid; i < 3 * DM; i += NTHREADS) { const int v = i / DM, k = i % DM; const float x = v < 2 ? cc[v * DM + k] : cx[k]; sv[i] = x * sigmoidf_(x); } }
    __syncthreads();
    const int j4 = (c.tid & 31) * 4, kg = c.tid >> 5;
    const float* w = INP(I_WMOD) + (size_t)l * DM * NMOD + (size_t)(kg * 128) * NMOD + cb * 128 + j4;
    f32x4 a0 = {0.f, 0.f, 0.f, 0.f}, a1 = a0, a2 = a0;
#pragma unroll 8
    for (int k = 0; k < 128; ++k) { const f32x4 wv = *(const f32x4*)(w + (size_t)k * NMOD); const int kk = kg * 128 + k; a0 += wv * sv[kk]; a1 += wv * sv[DM + kk]; a2 += wv * sv[2 * DM + kk]; }
    *(LAS f32x4*)(red + (kg * 3 + 0) * 128 + j4) = a0; *(LAS f32x4*)(red + (kg * 3 + 1) * 128 + j4) = a1; *(LAS f32x4*)(red + (kg * 3 + 2) * 128 + j4) = a2;
    __syncthreads();
    if (c.tid < 384) { const int v = c.tid >> 7, jj = c.tid & 127; float s = INP(I_BMOD)[l * NMOD + cb * 128 + jj];
#pragma unroll
        for (int g = 0; g < 16; ++g) s += red[(g * 3 + v) * 128 + jj];
        ((float*)(c.ws + WS_MOD))[((size_t)l * 3 + v) * NMOD + cb * 128 + jj] = s; }
    __syncthreads();
}

__device__ __forceinline__ void wsc_unit(const Ctx& c, CAS const unsigned long long* in, int l, int u) {
    const int hh = u >> 4, kb = u & 15, h = hh >> 1, half = hh & 1, k0 = kb * 128;
    LAS float* kkL = (LAS float*)c.lds;
    LAS float* wqL = kkL + 128 * 132;
    const float* ksrc = INP(half ? I_PK2 : I_PK1) + ((size_t)(l * 8 + h) * 128) * 128;
    const float* qsrc = INP(I_PWQ) + (size_t)l * DM * DM + (size_t)k0 * DM + hh * 128;
    for (int i = c.tid; i < 128 * 32; i += NTHREADS) { const int r = i >> 5, c4 = (i & 31) * 4;
        *(LAS f32x4*)(kkL + r * 132 + c4) = *(const f32x4*)(ksrc + (size_t)r * 128 + c4);
        *(LAS f32x4*)(wqL + r * 132 + c4) = *(const f32x4*)(qsrc + (size_t)r * DM + c4); }
    __syncthreads();
    const int k = c.tid & 127, ng = c.tid >> 7;
    float acc[32];
#pragma unroll
    for (int j = 0; j < 32; ++j) acc[j] = 0.f;
    for (int d4 = 0; d4 < 32; ++d4) {
        const f32x4 a = *(const LAS f32x4*)(wqL + k * 132 + d4 * 4);
#pragma unroll
        for (int j = 0; j < 32; ++j) { const f32x4 b = *(const LAS f32x4*)(kkL + (ng * 32 + j) * 132 + d4 * 4); acc[j] += (a[0] * b[0] + a[1] * b[1]) + (a[2] * b[2] + a[3] * b[3]); }
    }
    bf16_t* dst = (bf16_t*)(c.ws + ws_wsc(l)) + (size_t)(hh * 128 + ng * 32) * DM + k0 + k;
#pragma unroll
    for (int j = 0; j < 32; ++j) dst[(size_t)j * DM] = f2bf(acc[j]);
    __syncthreads();
}

#define GET_IN() unsigned long long kai_ = (unsigned long long)__builtin_amdgcn_kernarg_segment_ptr(); asm volatile("" : "+s"(kai_)); CAS const unsigned long long* in = (CAS const unsigned long long*)kai_
__device__ __forceinline__ void conv_units(const Ctx& c, int l) {
    GET_IN();
    if (l == 0) for (int u = c.wg; u < 2 * 96; u += c.G) mod_unit(c, in, u / 96, u % 96);
    for (int u = c.wg; u < 256; u += c.G) wsc_unit(c, in, l, u);
}
enum { CV_WIN = 1, CV_WO = 2, CV_WOUT = 4, CV_PU = 8, CV_PV = 16, CV_LRU = 32, CV_ALL = 63 };
__device__ __forceinline__ void conv_transposes(const Ctx& c, int l, int what = CV_ALL) {
    GET_IN();
    const int gw = c.wg * NWAVES + c.wave, NGW = c.G * NWAVES;
    LAS float* scr = (LAS float*)(c.lds + c.wave * 16640);
    constexpr int I_IN = (DM / 64) * (NIN / 64), I_SQ = (DM / 64) * (DM / 64);
    const float* win = INP(I_WIN) + (size_t)l * DM * NIN;
    if (what & CV_WIN) for (int it = gw; it < I_IN; it += NGW)
        transpose_item<true>(win, DM, NIN, (bf16_t*)(c.ws + WS_WIN), scr, it, c.lane, (const float*)(c.ws + WS_CMAX) + (size_t)l * 32 * NIN, (float*)(c.ws + WS_WDQ), (LAS float*)(c.lds + 8 * 16640 + c.wave * 256));
    for (int s = 0; s < 4; ++s) { if (!(what & (s < 3 ? CV_WO : CV_WOUT))) continue;
        const float* src = INP(s == 0 ? I_WOA : s == 1 ? I_WOL : s == 2 ? I_WOS : I_WOUT) + (size_t)l * DM * DM;
        bf16_t* dst = s < 3 ? (bf16_t*)(c.ws + WS_WO) + (size_t)s * DM * DM : (bf16_t*)(c.ws + WS_WOUT);
        for (int it = gw; it < I_SQ; it += NGW) transpose_item(src, DM, DM, dst, scr, it, c.lane);
    }
}
__device__ __forceinline__ void conv_colmax(const Ctx& c) {
    GET_IN();
    const size_t gt = (size_t)c.wg * NTHREADS + c.tid, NT = (size_t)c.G * NTHREADS;
    constexpr int C4 = NIN / 4;
    for (size_t u = gt; u < (size_t)NLAYER * 32 * C4; u += NT) { const int c4 = (int)(u % C4), lk = (int)(u / C4);
        const float* src = INP(I_WIN) + (size_t)lk * 64 * NIN + c4 * 4;
        f32x4 m = {0.f, 0.f, 0.f, 0.f};
#pragma unroll 16
        for (int k = 0; k < 64; ++k) { const f32x4 v = *(const f32x4*)(src + (size_t)k * NIN); m[0] = fmaxf(m[0], fabsf(v[0])); m[1] = fmaxf(m[1], fabsf(v[1])); m[2] = fmaxf(m[2], fabsf(v[2])); m[3] = fmaxf(m[3], fabsf(v[3])); }
        *(f32x4*)((float*)(c.ws + WS_CMAX) + (size_t)lk * NIN + c4 * 4) = m; }
}
__device__ __forceinline__ void conv_tables(const Ctx& c, int l, int what = CV_ALL) {
    GET_IN();
    const size_t gt = (size_t)c.wg * NTHREADS + c.tid, NT = (size_t)c.G * NTHREADS;
    constexpr size_t NG16 = (size_t)16384 * DM / 16;
    if (what & CV_PU) {
        const int gw = c.wg * NWAVES + c.wave, NGW = c.G * NWAVES;
        const float* srcb = INP(I_PU) + (size_t)l * 16384 * DM; unsigned char* dstb = (unsigned char*)(c.ws + ws_pu(l)); float* usc = (float*)(c.ws + WS_USC) + (size_t)l * 16384;
#pragma unroll 1
        for (int e = gw; e < 16384; e += NGW) { const float* src = srcb + (size_t)e * DM + c.lane * 16;
            f32x4 v[8]; float mx = 0.f;
#pragma unroll
            for (int i = 0; i < 8; ++i) { v[i] = *(const f32x4*)(src + (i >> 2) * 1024 + (i & 3) * 4); mx = fmaxf(fmaxf(mx, fmaxf(fabsf(v[i][0]), fabsf(v[i][1]))), fmaxf(fabsf(v[i][2]), fabsf(v[i][3]))); }
#pragma unroll
            for (int o = 32; o > 0; o >>= 1) mx = fmaxf(mx, __shfl_xor(mx, o));
            const float q_ = mx > 0.f ? 127.f / mx : 0.f;
            if (c.lane == 0) usc[e] = mx * (1.f / 127.f);
            u32x4 o0, o1;
#pragma unroll
            for (int i = 0; i < 4; ++i) { o0[i] = pk4_i8(v[i][0] * q_, v[i][1] * q_, v[i][2] * q_, v[i][3] * q_); o1[i] = pk4_i8(v[4 + i][0] * q_, v[4 + i][1] * q_, v[4 + i][2] * q_, v[4 + i][3] * q_); }
            *(u32x4*)(dstb + (size_t)e * DM + c.lane * 16) = o0; *(u32x4*)(dstb + (size_t)e * DM + 1024 + c.lane * 16) = o1; } }
#pragma unroll 1
    for (int tb = 1; tb < 2; ++tb) { if (!(what & (tb ? CV_PV : CV_PU))) continue;
        const float* srcb = INP(tb ? I_PV : I_PU) + (size_t)l * 16384 * DM; unsigned char* dstb = (unsigned char*)(c.ws + (tb ? ws_pv(l) : ws_pu(l)));
        const float sc = tb ? 1.f : 32.f;
        for (size_t j = gt; j < NG16; j += 2 * NT) {
            const size_t j2 = j + NT; const bool has2 = j2 < NG16;
            f32x4 a[4], b[4];
#pragma unroll
            for (int d = 0; d < 4; ++d) a[d] = *(const f32x4*)(srcb + j * 16 + d * 4);
#pragma unroll
            for (int d = 0; d < 4; ++d) b[d] = has2 ? *(const f32x4*)(srcb + j2 * 16 + d * 4) : (f32x4){0.f, 0.f, 0.f, 0.f};
            u32x4 o, o2;
#pragma unroll
            for (int d = 0; d < 4; ++d) { const f32x4 x = a[d] * sc, y = b[d] * sc;
                int w = __builtin_amdgcn_cvt_pk_fp8_f32(x[0], x[1], 0, false); w = __builtin_amdgcn_cvt_pk_fp8_f32(x[2], x[3], w, true); o[d] = (unsigned)w;
                int w2 = __builtin_amdgcn_cvt_pk_fp8_f32(y[0], y[1], 0, false); w2 = __builtin_amdgcn_cvt_pk_fp8_f32(y[2], y[3], w2, true); o2[d] = (unsigned)w2; }
            if (tb == 0) { *(u32x4*)(dstb + j * 16) = o; if (has2) *(u32x4*)(dstb + j2 * 16) = o2; }
            else {
                *(u32x4*)(dstb + (size_t)((j & 127) >> 3) * ((size_t)16384 * 128) + (j >> 7) * 128 + (j & 7) * 16) = o;
                if (has2) *(u32x4*)(dstb + (size_t)((j2 & 127) >> 3) * ((size_t)16384 * 128) + (j2 >> 7) * 128 + (j2 & 7) * 16) = o2; } }
    }
    if (what & CV_LRU) for (size_t i = gt; i < (size_t)16 * 512 * 128; i += NT) { const int ci = (int)(i & 127), j = (int)((i >> 7) & 511), n = (int)(i >> 16), d = j >> 8, which = (j >> 7) & 1, dd = j & 127;
        const float* src = INP(which ? I_LWX : I_LWA) + ((((size_t)(l * 2 + d) * 16 + n) * 128 + ci) * 128 + dd);
        ((bf16_t*)(c.ws + WS_WLRU))[i] = f2bf(*src); }
}
__device__ __forceinline__ void sp_copy(const Ctx& c, const float* src, int sp_off, int n) {
    const size_t gt = (size_t)c.wg * NTHREADS + c.tid, NT = (size_t)c.G * NTHREADS;
    for (size_t i = gt; i < (size_t)n; i += NT) ((float*)(c.ws + WS_SP))[sp_off + i] = src[i];
}
__device__ __forceinline__ void conv_small(const Ctx& c, int l) {
    GET_IN();
    const size_t gt = (size_t)c.wg * NTHREADS + c.tid, NT = (size_t)c.G * NTHREADS;
    sp_copy(c, INP(I_NMIX) + l * DM, SP_NMIX, DM); sp_copy(c, INP(I_NFFN) + l * DM, SP_NFFN, DM);
    sp_copy(c, INP(I_QN) + l * 128, SP_QN, 128); sp_copy(c, INP(I_KN) + l * 128, SP_KN, 128);
    sp_copy(c, INP(I_LCW) + l * 4 * DM, SP_LCW, 4 * DM); sp_copy(c, INP(I_LCB) + l * DM, SP_LCB, DM);
    sp_copy(c, INP(I_LBA) + l * 2 * DM, SP_LBA, 2 * DM); sp_copy(c, INP(I_LBX) + l * 2 * DM, SP_LBX, 2 * DM);
    sp_copy(c, INP(I_SCW) + l * 3 * DM, SP_SCW, 3 * DM); sp_copy(c, INP(I_SCB) + l * DM, SP_SCB, DM);
    { const float* lam = INP(I_LLAM) + l * 2 * DM;
      for (size_t i = gt; i < (size_t)2 * DM; i += NT) ((float*)(c.ws + WS_SP))[SP_LSP + i] = 8.f * log1pf(expf(-lam[i])); }
}
__device__ __forceinline__ void conv_once(const Ctx& c) {
    const size_t gt = (size_t)c.wg * NTHREADS + c.tid, NT = (size_t)c.G * NTHREADS;
    for (size_t i = gt; i < 128 * 32; i += NT) { const int pos = (int)(i >> 5), p = (int)(i & 31);
        const float inv = exp2f(-(float)p * (13.287712379549449f / 32.f)); const float ang = (float)pos * inv;
        float sn, cs; sincosf(ang, &sn, &cs);
        ((float*)(c.ws + WS_ROPE))[i] = cs; ((float*)(c.ws + WS_ROPE))[128 * 32 + i] = sn; }
}

template <bool I8 = false>
__device__ __forceinline__ void phase_norm(const Ctx& c, int l, int nrows, int sp_gain, int slot_shift, const float* xin = nullptr, const float* cin = nullptr) {
    const int gw = c.wg * NWAVES + c.wave, NGW = c.G * NWAVES;
    const float* modl = (const float*)(c.ws + WS_MOD) + (size_t)l * 3 * NMOD;
    bf16_t* HX = (bf16_t*)(c.ws + WS_HX); const float* gain = (const float*)(c.ws + WS_SP) + sp_gain;
    for (int r = gw; r < nrows; r += NGW) {
        const int vec = r < SEQ ? 0 : (r < MLAT ? 1 : 2);
        const float* xr = xin ? (r < MLAT ? xin + (size_t)r * DM : cin + (size_t)(r - MLAT) * DM) : xrow_ptr(c, r); const float* sh = modl + (size_t)vec * NMOD + slot_shift * DM; const float* sc = sh + DM;
        f32x4 v[8]; float ss = 0.f;
#pragma unroll
        for (int j = 0; j < 8; ++j) { v[j] = *(const f32x4*)(xr + j * 256 + c.lane * 4); ss += (v[j][0] * v[j][0] + v[j][1] * v[j][1]) + (v[j][2] * v[j][2] + v[j][3] * v[j][3]); }
        const float rs = rsqrtf(wave_sum(ss) * (1.f / DM) + EPS);
        if constexpr (I8) { float mx = 0.f;
#pragma unroll
            for (int j = 0; j < 8; ++j) { const int col = j * 256 + c.lane * 4;
                const f32x4 g = *(const f32x4*)(gain + col), s1 = *(const f32x4*)(sc + col), s0 = *(const f32x4*)(sh + col);
                v[j] = (v[j] * rs * g) * (s1 + 1.f) + s0;
                mx = fmaxf(fmaxf(mx, fmaxf(fabsf(v[j][0]), fabsf(v[j][1]))), fmaxf(fabsf(v[j][2]), fabsf(v[j][3]))); }
#pragma unroll
            for (int o = 32; o > 0; o >>= 1) mx = fmaxf(mx, __shfl_xor(mx, o));
            const float q_ = mx > 0.f ? 127.f / mx : 0.f;
            if (c.lane == 0) ((float*)(c.ws + WS_ADQ))[r] = mx * (1.f / 127.f);
#pragma unroll
            for (int j = 0; j < 8; ++j) *(unsigned*)((unsigned char*)HX + (size_t)r * DM + j * 256 + c.lane * 4) = pk4_i8(v[j][0] * q_, v[j][1] * q_, v[j][2] * q_, v[j][3] * q_);
        } else {
#pragma unroll
        for (int j = 0; j < 8; ++j) { const int col = j * 256 + c.lane * 4;
            const f32x4 g = *(const f32x4*)(gain + col), s1 = *(const f32x4*)(sc + col), s0 = *(const f32x4*)(sh + col);
            const f32x4 y = (v[j] * rs * g) * (s1 + 1.f) + s0;
            u32x2 o; o.x = cvt_pk_bf16(y[0], y[1]); o.y = cvt_pk_bf16(y[2], y[3]);
            *(u32x2*)(HX + (size_t)r * DM + col) = o; } }
    }
}
__device__ __forceinline__ void seg_of_row(int r, bool& is_ctx, int& b, int& t) {
    is_ctx = r >= MLAT; b = is_ctx ? (r - MLAT) >> 8 : r >> 13; t = is_ctx ? (r - MLAT) & 255 : r & (SEQ - 1);
}
__device__ __forceinline__ void qk_row(const Ctx& c, int l, int r, bool do_q, bool dry) {
    bool is_ctx; int b, t; seg_of_row(r, is_ctx, b, t);
    const int key = is_ctx ? t : CTXL + t;
    bf16_t* prow = (bf16_t*)(c.ws + WS_P) + (size_t)r * NIN;
    bf16_t* KC = (bf16_t*)(c.ws + WS_KC); bf16_t* VC = (bf16_t*)(c.ws + WS_VC);
    const int hs = c.lane >> 4, ax = (c.lane >> 3) & 1, p0 = (c.lane & 7) * 4;
    f32x4 cs = {1.f, 1.f, 1.f, 1.f}, sn = {0.f, 0.f, 0.f, 0.f};
    if (!is_ctx) { const int pos = ax ? (t & 63) : (t >> 6); const float* rt = (const float*)(c.ws + WS_ROPE) + pos * 32 + p0; cs = *(const f32x4*)rt; sn = *(const f32x4*)(rt + 128 * 32); }
    u32x2 w1[5], w2[5];
#pragma unroll
    for (int g = 0; g < 5; ++g) { const bool is_k = (g == 4); const int head = is_k ? hs : g * 4 + hs;
        const bf16_t* src = prow + (is_k ? CK : CQ) + head * 128 + ax * 64 + p0;
        if (is_k || do_q) { w1[g] = *(const u32x2*)src; w2[g] = *(const u32x2*)(src + 32); } else { w1[g] = (u32x2){0u, 0u}; w2[g] = (u32x2){0u, 0u}; } }
    const u32x4 vw = *(const u32x4*)(prow + CV + (c.lane >> 4) * 128 + (c.lane & 15) * 8);
#pragma unroll
    for (int g = 0; g < 5; ++g) {
        const bool is_k = (g == 4);
        if (!is_k && !do_q) continue;
        const int head = is_k ? hs : g * 4 + hs;
        bf16_t* src = prow + (is_k ? CK : CQ) + head * 128 + ax * 64 + p0;
        f32x4 t1 = {bf_lo(w1[g].x), bf_hi(w1[g].x), bf_lo(w1[g].y), bf_hi(w1[g].y)}, t2 = {bf_lo(w2[g].x), bf_hi(w2[g].x), bf_lo(w2[g].y), bf_hi(w2[g].y)};
        float ss = (t1[0] * t1[0] + t1[1] * t1[1]) + (t1[2] * t1[2] + t1[3] * t1[3]) + (t2[0] * t2[0] + t2[1] * t2[1]) + (t2[2] * t2[2] + t2[3] * t2[3]);
        ss += DPPF(ss, 0xB1); ss += DPPF(ss, 0x4E); ss += DPPF(ss, 0x141); ss += DPPF(ss, 0x140);
        const float rs = rsqrtf(ss * (1.f / 128.f) + EPS);
        const float* gn = (const float*)(c.ws + WS_SP) + (is_k ? SP_KN : SP_QN) + ax * 64 + p0;
        const f32x4 g1 = *(const f32x4*)gn, g2 = *(const f32x4*)(gn + 32);
        const f32x4 y1 = t1 * rs * g1, y2 = t2 * rs * g2;
        const f32x4 o1 = y1 * cs - y2 * sn, o2 = y2 * cs + y1 * sn;
        bf16_t* dst = is_k ? KC + ((size_t)(b * 4 + head) * NKEY + key) * 128 + ax * 64 + p0 : (dry ? (bf16_t*)(c.ws + WS_YF) + (size_t)r * DM + head * 128 + ax * 64 + p0 : src);
        u32x2 a; a.x = cvt_pk_bf16(o1[0], o1[1]); a.y = cvt_pk_bf16(o1[2], o1[3]);
        u32x2 bq; bq.x = cvt_pk_bf16(o2[0], o2[1]); bq.y = cvt_pk_bf16(o2[2], o2[3]);
        *(u32x2*)dst = a; *(u32x2*)(dst + 32) = bq;
    }
    { const int hv = c.lane >> 4, dd = (c.lane & 15) * 8;
      *(u32x4*)(VC + ((size_t)(b * 4 + hv) * NKEY + key) * 128 + dd) = vw; }
}
__device__ __forceinline__ void unpack8(const u32x4 w, float (&f)[8]) {
    f[0] = bf_lo(w.x); f[1] = bf_hi(w.x); f[2] = bf_lo(w.y); f[3] = bf_hi(w.y); f[4] = bf_lo(w.z); f[5] = bf_hi(w.z); f[6] = bf_lo(w.w); f[7] = bf_hi(w.w);
}
__device__ __forceinline__ void sc_row(const Ctx& c, int l, int r, bool dry) {
    bool is_ctx; int b, t; seg_of_row(r, is_ctx, b, t);
    const int seglen = is_ctx ? CTXL : SEQ;
    bf16_t* prow = (bf16_t*)(c.ws + WS_P) + (size_t)r * NIN;
    const bool hp = t > 0, hn = t < seglen - 1;
    const float* w = (const float*)(c.ws + WS_SP) + SP_SCW; const float* bias = (const float*)(c.ws + WS_SP) + SP_SCB;
    u32x4 xb[4], xc0[4], xu0[4], xcp[4], xup[4], xcn[4], xun[4];
    const u32x4 z = {0u, 0u, 0u, 0u};
#pragma unroll
    for (int it = 0; it < 4; ++it) { const int col = it * 512 + c.lane * 8;
        xb[it] = *(const u32x4*)(prow + CBG + col); xc0[it] = *(const u32x4*)(prow + CCG + col); xu0[it] = *(const u32x4*)(prow + CU + col);
        xcp[it] = hp ? *(const u32x4*)(prow - NIN + CCG + col) : z; xup[it] = hp ? *(const u32x4*)(prow - NIN + CU + col) : z;
        xcn[it] = hn ? *(const u32x4*)(prow + NIN + CCG + col) : z; xun[it] = hn ? *(const u32x4*)(prow + NIN + CU + col) : z; }
#pragma unroll
    for (int it = 0; it < 4; ++it) {
        const int col = it * 512 + c.lane * 8;
        float bg[8], c0[8], u0[8], cp[8], up[8], cn[8], un[8];
        unpack8(xb[it], bg); unpack8(xc0[it], c0); unpack8(xu0[it], u0); unpack8(xcp[it], cp); unpack8(xup[it], up); unpack8(xcn[it], cn); unpack8(xun[it], un);
        float o[8];
#pragma unroll
        for (int hq = 0; hq < 2; ++hq) { const f32x4 w0 = *(const f32x4*)(w + col + hq * 4), w1 = *(const f32x4*)(w + DM + col + hq * 4), w2 = *(const f32x4*)(w + 2 * DM + col + hq * 4), bi = *(const f32x4*)(bias + col + hq * 4);
#pragma unroll
            for (int e = 0; e < 4; ++e) { const int k = hq * 4 + e; o[k] = bg[k] * (bi[e] + w0[e] * (cp[k] * up[k]) + w1[e] * (c0[k] * u0[k]) + w2[e] * (cn[k] * un[k])); } }
        u32x4 ow; ow.x = cvt_pk_bf16(o[0], o[1]); ow.y = cvt_pk_bf16(o[2], o[3]); ow.z = cvt_pk_bf16(o[4], o[5]); ow.w = cvt_pk_bf16(o[6], o[7]);
        *(u32x4*)((dry ? (bf16_t*)(c.ws + WS_YF) + (size_t)(MALL + r) * DM : prow + CBG) + col) = ow;
    }
}

constexpr size_t lsum_idx(int which, int dir, int b, int j) { return ((((size_t)which * 2 + dir) * NB + b) * NCHUNK + j) * DM; }
template <int DIR, int PASS>
__device__ __forceinline__ void lru_chunk(const LAS bf16_t* ub, const LAS float* uf, LAS float* hsd, const bf16x8 (&bfr)[4][4], const float (&ba)[2], const float (&bx)[2], const float (&sp8)[2],
                                          const float (&cin)[2], float (&Atot)[2], float (&Hend)[2], int q, int col16, int quad) {
    float st[2] = {cin[0], cin[1]}, at[2] = {1.f, 1.f};
    const int mysg = DIR ? 3 - quad : quad;
    for (int smt = 0; smt < 4; ++smt) {
        const int mt = DIR ? 3 - smt : smt;
        f32x4 acc[4];
#pragma unroll
        for (int nt = 0; nt < 4; ++nt) acc[nt] = (f32x4){0.f, 0.f, 0.f, 0.f};
#pragma unroll
        for (int ks = 0; ks < 4; ++ks) { const bf16x8 a = *(const LAS bf16x8*)(ub + (mt * 16 + col16) * 136 + ks * 32 + quad * 8);
#pragma unroll
            for (int nt = 0; nt < 4; ++nt) acc[nt] = __builtin_amdgcn_mfma_f32_16x16x32_bf16(a, bfr[nt][ks], acc[nt], 0, 0, 0); }
#pragma unroll
        for (int ct = 0; ct < 2; ++ct) {
            const int ch = q * 32 + ct * 16 + col16;
            float av[4], dv[4];
#pragma unroll
            for (int reg = 0; reg < 4; ++reg) { const int tl = mt * 16 + quad * 4 + reg;
                const float r = sigmoidf_(acc[ct][reg] + ba[ct]), ig = sigmoidf_(acc[2 + ct][reg] + bx[ct]);
                const float a = __expf(-sp8[ct] * r);
                av[reg] = a; dv[reg] = __builtin_amdgcn_sqrtf(fmaxf(1.f - a * a, 0.f)) * ig * uf[tl * 132 + ch]; }
            float Al = 1.f, Hl = 0.f;
#pragma unroll
            for (int sr = 0; sr < 4; ++sr) { const int reg = DIR ? 3 - sr : sr; Hl = av[reg] * Hl + dv[reg]; Al *= av[reg]; }
            float se = st[ct], so = st[ct], ap = 1.f;
#pragma unroll
            for (int sg = 0; sg < 4; ++sg) { const int qp = DIR ? 3 - sg : sg; const float Ag = __shfl(Al, col16 + 16 * qp), Hg = __shfl(Hl, col16 + 16 * qp);
                const float nx = Ag * so + Hg; so = nx; if (sg < mysg) se = nx; ap *= Ag; }
            if (PASS == 2) { float h = se;
#pragma unroll
                for (int sr = 0; sr < 4; ++sr) { const int reg = DIR ? 3 - sr : sr; h = av[reg] * h + dv[reg]; hsd[(mt * 16 + quad * 4 + reg) * 132 + ch] = h; } }
            else at[ct] *= ap;
            st[ct] = so;
        }
    }
    Atot[0] = at[0]; Atot[1] = at[1]; Hend[0] = st[0]; Hend[1] = st[1];
}

template <int PASS>
__device__ __forceinline__ void lru_run(const Ctx& c, int l, int unit, bool dry = false) {
    const int b = unit >> 7, n = (unit >> 3) & 15, run = unit & 7;
    const int c0 = run * 16 + (run < 4 ? run : 4), len = 16 + (run < 4 ? 1 : 0);
    LAS float* xl = (LAS float*)c.lds;
    LAS float* uf = (LAS float*)(c.lds + 34816);
    LAS bf16_t* ub = (LAS bf16_t*)(c.lds + 34816 + 33792);
    LAS float* car = (LAS float*)(c.lds + 34816 + 33792 + 17408);
    LAS float* hsr = (LAS float*)(c.lds + 34816 + 33792 + 17408 + 17408);
    const int d = c.wave >> 2, q = c.wave & 3, col16 = c.lane & 15, quad = c.lane >> 4;
    float* LS = (float*)(c.ws + WS_LSUM);
    bf16_t* P = (bf16_t*)(c.ws + WS_P);
    bf16x8 bfr[4][4];
#pragma unroll
    for (int nt = 0; nt < 4; ++nt) { const int j = d * 256 + (nt >> 1) * 128 + q * 32 + (nt & 1) * 16 + col16;
#pragma unroll
        for (int ks = 0; ks < 4; ++ks) bfr[nt][ks] = *(const bf16x8*)((const bf16_t*)(c.ws + WS_WLRU) + ((size_t)(n * 512 + j) * 128 + ks * 32 + quad * 8)); }
    float ba[2], bx[2], sp8[2];
#pragma unroll
    for (int ct = 0; ct < 2; ++ct) { const int cidx = n * 128 + q * 32 + ct * 16 + col16; const float* sp = (const float*)(c.ws + WS_SP) + d * DM + cidx;
        ba[ct] = sp[SP_LBA]; bx[ct] = sp[SP_LBX]; sp8[ct] = sp[SP_LSP]; }
    if (PASS == 2) {
        if (c.tid < 256) { const int dir = c.tid >> 7, ch = c.tid & 127, cidx = n * 128 + ch; float st = 0.f;
#pragma unroll 1
            for (int k0 = 0; k0 < NCHUNK; k0 += 12) {
                float av[12], hv[12];
#pragma unroll
                for (int kk = 0; kk < 12; ++kk) { const int k = k0 + kk, j = dir ? (k < 4 ? 3 - k : 135 - k) : k; av[kk] = LS[lsum_idx(0, dir, b, j) + cidx]; hv[kk] = LS[lsum_idx(1, dir, b, j) + cidx]; }
#pragma unroll
                for (int kk = 0; kk < 12; ++kk) { const int k = k0 + kk, j = dir ? (k < 4 ? 3 - k : 135 - k) : k;
                    if (j >= c0 && j < c0 + len) car[(dir * 17 + (j - c0)) * 128 + ch] = st;
                    st = av[kk] * st + hv[kk]; } } }
        __syncthreads();
    }
    const float* cw = (const float*)(c.ws + WS_SP) + SP_LCW + n * 128; const float* cb = (const float*)(c.ws + WS_SP) + SP_LCB + n * 128;
#define LRU_GEOM(ci_, jc, is_ctx, rb, t0, seglen) const int jc = c0 + (ci_); const bool is_ctx = jc < 4; \
        const int rb = is_ctx ? MLAT + b * CTXL : b * SEQ, t0 = is_ctx ? jc * 64 : (jc - 4) * 64, seglen = is_ctx ? CTXL : SEQ
#define LRU_LOAD(ci_, XR, LG) do { LRU_GEOM(ci_, jc_, ic_, rb_, t0_, sl_); (void)ic_; \
        _Pragma("unroll") for (int ps = 0; ps < 3; ++ps) { const int i = ps * 32 + (c.tid >> 4); const int t = t0_ - 2 + i; XR[ps] = (u32x4){0u, 0u, 0u, 0u}; \
            if (i < 68 && t >= 0 && t < sl_) XR[ps] = *(const u32x4*)(P + (size_t)(rb_ + t) * NIN + CLX + n * 128 + (c.tid & 15) * 8); } \
        if (PASS == 2) { const bf16_t* gp_ = P + (size_t)(rb_ + t0_ + (c.tid >> 3)) * NIN + CLG + n * 128 + (c.tid & 7) * 16; LG[0] = *(const u32x4*)gp_; LG[1] = *(const u32x4*)(gp_ + 8); } } while (0)
    u32x4 xr[3], lgc[2] = {{0u, 0u, 0u, 0u}, {0u, 0u, 0u, 0u}}, lgn[2] = {{0u, 0u, 0u, 0u}, {0u, 0u, 0u, 0u}};
    LRU_LOAD(0, xr, lgn);
    for (int ci = 0; ci < len; ++ci) {
        LRU_GEOM(ci, jc, is_ctx, rb, t0, seglen); (void)is_ctx; (void)seglen;
#pragma unroll
        for (int ps = 0; ps < 3; ++ps) { const int i = ps * 32 + (c.tid >> 4);
            if (i < 68) { float f[8]; unpack8(xr[ps], f);
                *(LAS f32x4*)(xl + i * 128 + (c.tid & 15) * 8) = (f32x4){f[0], f[1], f[2], f[3]}; *(LAS f32x4*)(xl + i * 128 + (c.tid & 15) * 8 + 4) = (f32x4){f[4], f[5], f[6], f[7]}; } }
        lgc[0] = lgn[0]; lgc[1] = lgn[1];
        __syncthreads();
        if (ci + 1 < len) LRU_LOAD(ci + 1, xr, lgn);
        { const int ch = c.tid & 127, tq = c.tid >> 7; const float w0 = cw[ch], w1 = cw[DM + ch], w2 = cw[2 * DM + ch], w3 = cw[3 * DM + ch], bb = cb[ch];
#pragma unroll 4
          for (int tt = 0; tt < 16; ++tt) { const int tl = tq * 16 + tt;
              const float u = bb + w0 * xl[tl * 128 + ch] + w1 * xl[(tl + 1) * 128 + ch] + w2 * xl[(tl + 2) * 128 + ch] + w3 * xl[(tl + 3) * 128 + ch];
              uf[tl * 132 + ch] = u; ub[tl * 136 + ch] = f2bf(u); } }
        __syncthreads();
        float cin[2] = {0.f, 0.f}, At[2], He[2];
        if (PASS == 2) { cin[0] = car[(d * 17 + ci) * 128 + q * 32 + col16]; cin[1] = car[(d * 17 + ci) * 128 + q * 32 + 16 + col16]; }
        if (d == 0) lru_chunk<0, PASS>(ub, uf, xl, bfr, ba, bx, sp8, cin, At, He, q, col16, quad);
        else lru_chunk<1, PASS>(ub, uf, hsr, bfr, ba, bx, sp8, cin, At, He, q, col16, quad);
        if (PASS == 1) {
            if (quad == 0) {
#pragma unroll
                for (int ct = 0; ct < 2; ++ct) { const int cidx = n * 128 + q * 32 + ct * 16 + col16;
                    LS[lsum_idx(0, d, b, jc) + cidx] = At[ct]; LS[lsum_idx(1, d, b, jc) + cidx] = He[ct]; } }
            __syncthreads();
        } else {
            __syncthreads();
            { const int row = c.tid >> 3, cs = (c.tid & 7) * 16;
              bf16_t* gp = P + (size_t)(rb + t0 + row) * NIN + CLG + n * 128 + cs;
#pragma unroll
              for (int hseg = 0; hseg < 2; ++hseg) { float g[8]; unpack8(lgc[hseg], g);
                  const int o = row * 132 + cs + hseg * 8;
                  const f32x4 h0 = *(const LAS f32x4*)(xl + o) + *(const LAS f32x4*)(hsr + o), h1 = *(const LAS f32x4*)(xl + o + 4) + *(const LAS f32x4*)(hsr + o + 4);
                  u32x4 ow; ow.x = cvt_pk_bf16(h0[0] * gelu_tanh(g[0]), h0[1] * gelu_tanh(g[1])); ow.y = cvt_pk_bf16(h0[2] * gelu_tanh(g[2]), h0[3] * gelu_tanh(g[3]));
                  ow.z = cvt_pk_bf16(h1[0] * gelu_tanh(g[4]), h1[1] * gelu_tanh(g[5])); ow.w = cvt_pk_bf16(h1[2] * gelu_tanh(g[6]), h1[3] * gelu_tanh(g[7]));
                  *(u32x4*)((dry ? gp - CLG + CU : gp) + hseg * 8) = ow; } }
            __syncthreads();
        }
    }
#undef LRU_GEOM
#undef LRU_LOAD
}

__device__ __forceinline__ void phase_qk(const Ctx& c, int l, bool dry = false) {
    const int gw = c.wg * NWAVES + c.wave, NGW = c.G * NWAVES;
    for (int r = gw; r < MALL; r += NGW) qk_row(c, l, r, l == 0 || r < MLAT, dry);
}
__device__ __forceinline__ void sc_block8(const Ctx& c, int r0, bool dry) {
    const int t0 = r0 & (SEQ - 1);
    bf16_t* prow0 = (bf16_t*)(c.ws + WS_P) + (size_t)r0 * NIN;
    const float* w = (const float*)(c.ws + WS_SP) + SP_SCW; const float* bias = (const float*)(c.ws + WS_SP) + SP_SCB;
    const u32x4 z = {0u, 0u, 0u, 0u};
#pragma unroll 1
    for (int it = 0; it < 4; ++it) {
        const int col = it * 512 + c.lane * 8;
        float w0[8], w1[8], w2[8], bi[8];
#pragma unroll
        for (int hq = 0; hq < 2; ++hq) { const f32x4 a = *(const f32x4*)(w + col + hq * 4), b = *(const f32x4*)(w + DM + col + hq * 4), d = *(const f32x4*)(w + 2 * DM + col + hq * 4), e = *(const f32x4*)(bias + col + hq * 4);
#pragma unroll
            for (int k = 0; k < 4; ++k) { w0[hq * 4 + k] = a[k]; w1[hq * 4 + k] = b[k]; w2[hq * 4 + k] = d[k]; bi[hq * 4 + k] = e[k]; } }
        u32x4 xc[10], xu[10], xb[8];
#pragma unroll
        for (int j = 0; j < 10; ++j) { const int t = t0 - 1 + j; const bool in = t >= 0 && t < SEQ; const bf16_t* pr = prow0 + (ptrdiff_t)(j - 1) * NIN;
            xc[j] = in ? *(const u32x4*)(pr + CCG + col) : z; xu[j] = in ? *(const u32x4*)(pr + CU + col) : z; }
#pragma unroll
        for (int j = 0; j < 8; ++j) xb[j] = *(const u32x4*)(prow0 + (size_t)j * NIN + CBG + col);
        float zp[8], zc[8];
        { float a[8], b[8]; unpack8(xc[0], a); unpack8(xu[0], b);
#pragma unroll
          for (int k = 0; k < 8; ++k) zp[k] = a[k] * b[k];
          unpack8(xc[1], a); unpack8(xu[1], b);
#pragma unroll
          for (int k = 0; k < 8; ++k) zc[k] = a[k] * b[k]; }
#pragma unroll
        for (int j = 0; j < 8; ++j) {
            float a[8], b[8], bg[8], zn[8], o[8]; unpack8(xc[j + 2], a); unpack8(xu[j + 2], b); unpack8(xb[j], bg);
#pragma unroll
            for (int k = 0; k < 8; ++k) { zn[k] = a[k] * b[k]; o[k] = bg[k] * (bi[k] + w0[k] * zp[k] + w1[k] * zc[k] + w2[k] * zn[k]); zp[k] = zc[k]; zc[k] = zn[k]; }
            u32x4 ow; ow.x = cvt_pk_bf16(o[0], o[1]); ow.y = cvt_pk_bf16(o[2], o[3]); ow.z = cvt_pk_bf16(o[4], o[5]); ow.w = cvt_pk_bf16(o[6], o[7]);
            *(u32x4*)((dry ? (bf16_t*)(c.ws + WS_YF) + (size_t)(MALL + r0 + j) * DM : prow0 + (size_t)j * NIN + CBG) + col) = ow; }
    }
}
__device__ __forceinline__ void phase_sc(const Ctx& c, int l, bool dry = false) {
    const int gw = c.wg * NWAVES + c.wave, NGW = c.G * NWAVES;
    for (int r0 = gw * 8; r0 < MLAT; r0 += NGW * 8) sc_block8(c, r0, dry);
    if (l == 0) for (int r = MLAT + gw; r < MALL; r += NGW) sc_row(c, l, r, dry);
}
__device__ __forceinline__ void phase_lru1(const Ctx& c, int l) {
    for (int u = c.wg; u < 256; u += c.G) lru_run<1>(c, l, u);
}

__device__ __forceinline__ void phase_m2(const Ctx& c, int l, bool dry = false) {
    bf16_t* P = (bf16_t*)(c.ws + WS_P); const bf16_t* KC = (const bf16_t*)(c.ws + WS_KC); const bf16_t* VC = (const bf16_t*)(c.ws + WS_VC);
    const int ntot = 1024 + (l == 0 ? 32 : 0);
    for (int i = 0; i * c.G + c.wg < ntot; ++i) {
        const int L = i * c.G + c.wg; int b, h, seq; size_t qrow;
        if (L < 1024) { int grp, qb;
            if (c.G == 256) { grp = i * 8 + (c.wg & 7); qb = c.wg >> 3; } else { grp = L >> 5; qb = L & 31; }
            b = grp >> 4; h = grp & 15; qrow = (size_t)(b * SEQ + qb * 256); seq = NKEY; }
        else { const int u = L - 1024; b = u >> 4; h = u & 15; qrow = (size_t)(MLAT + b * CTXL); seq = CTXL; }
        bf16_t* q = P + qrow * NIN + CQ + h * 128;
        const size_t kvo = (size_t)(b * 4 + (h >> 2)) * NKEY * 128;
        att::attn_dense_body(q, KC + kvo, VC + kvo, dry ? q - CQ + CCG : q, seq, (char*)c.lds, c.wave);
    }
}
__device__ __forceinline__ void phase_lru2(const Ctx& c, int l, bool dry = false) {
    for (int u = c.wg; u < 256; u += c.G) lru_run<2>(c, l, u, dry);
}
constexpr float NEGBIG = -3.0e38f;
constexpr float PU_SCALE = 32.f;
__device__ __forceinline__ float wave_max_dpp(float v) {
    v = fmaxf(v, DPPF(v, 0xB1)); v = fmaxf(v, DPPF(v, 0x4E)); v = fmaxf(v, DPPF(v, 0x141)); v = fmaxf(v, DPPF(v, 0x140));
    const float a = __int_as_float(__builtin_amdgcn_readlane(__float_as_int(v), 0)), b = __int_as_float(__builtin_amdgcn_readlane(__float_as_int(v), 16));
    const float c = __int_as_float(__builtin_amdgcn_readlane(__float_as_int(v), 32)), d = __int_as_float(__builtin_amdgcn_readlane(__float_as_int(v), 48));
    return fmaxf(fmaxf(a, b), fmaxf(c, d));
}
#define SWZ_XOR(v, m) __int_as_float(__builtin_amdgcn_ds_swizzle(__float_as_int(v), ((m) << 10) | 0x1F))
__device__ __forceinline__ unsigned fkey(float x) { const unsigned u = __float_as_uint(x); return (u & 0x80000000u) ? ~u : (u | 0x80000000u); }
#define DPPU(v, ctrl) ((unsigned)__builtin_amdgcn_update_dpp(0, (int)(v), ctrl, 0xF, 0xF, true))
__device__ __forceinline__ unsigned wave_max_u32(unsigned v) {
    v = max(v, DPPU(v, 0xB1)); v = max(v, DPPU(v, 0x4E)); v = max(v, DPPU(v, 0x141)); v = max(v, DPPU(v, 0x140));
    const unsigned a = (unsigned)__builtin_amdgcn_readlane((int)v, 0), b = (unsigned)__builtin_amdgcn_readlane((int)v, 16), c = (unsigned)__builtin_amdgcn_readlane((int)v, 32), d = (unsigned)__builtin_amdgcn_readlane((int)v, 48);
    return max(max(a, b), max(c, d));
}
__device__ __forceinline__ unsigned topk16_keys2(unsigned k0, unsigned k1, int lane) {
    unsigned res = 0u;
    for (int it = 0; it < 16; ++it) { const unsigned m = wave_max_u32(max(k0, k1)); k0 = (k0 == m) ? 0u : k0; k1 = (k1 == m) ? 0u : k1; res = (lane == it) ? m : res; }
    return res;
}
__device__ __forceinline__ unsigned topk16_keys1(unsigned k0, int lane) {
    unsigned res = 0u;
    for (int it = 0; it < 16; ++it) { const unsigned m = wave_max_u32(k0); k0 = (k0 == m) ? 0u : k0; res = (lane == it) ? m : res; }
    return res;
}
__device__ __forceinline__ void unpack_fp8x16(const u32x4 w, float (&f)[16]) {
#pragma unroll
    for (int d = 0; d < 4; ++d) { const f32x2 lo = __builtin_amdgcn_cvt_pk_f32_fp8((int)w[d], false), hi = __builtin_amdgcn_cvt_pk_f32_fp8((int)w[d], true);
        f[4 * d] = lo.x; f[4 * d + 1] = lo.y; f[4 * d + 2] = hi.x; f[4 * d + 3] = hi.y; }
}

__device__ __forceinline__ unsigned half_max_u32(unsigned v, bool hi_half) {
    v = max(v, DPPU(v, 0xB1)); v = max(v, DPPU(v, 0x4E)); v = max(v, DPPU(v, 0x141)); v = max(v, DPPU(v, 0x140));
    const unsigned a = max((unsigned)__builtin_amdgcn_readlane((int)v, 0), (unsigned)__builtin_amdgcn_readlane((int)v, 16));
    const unsigned b = max((unsigned)__builtin_amdgcn_readlane((int)v, 32), (unsigned)__builtin_amdgcn_readlane((int)v, 48));
    return hi_half ? b : a;
}
__device__ __forceinline__ unsigned topk16_half4(unsigned (&k)[4], int hl, bool hi_half) {
    unsigned res = 0u;
    for (int it = 0; it < 16; ++it) { const unsigned m = half_max_u32(max(max(k[0], k[1]), max(k[2], k[3])), hi_half);
#pragma unroll
        for (int j = 0; j < 4; ++j) k[j] = (k[j] == m) ? 0u : k[j];
        res = (hl == it) ? m : res; }
    return res;
}
__device__ __forceinline__ unsigned topk16_half2(unsigned k0, unsigned k1, int hl, bool hi_half) {
    unsigned res = 0u;
    for (int it = 0; it < 16; ++it) { const unsigned m = half_max_u32(max(k0, k1), hi_half); k0 = (k0 == m) ? 0u : k0; k1 = (k1 == m) ? 0u : k1; res = (hl == it) ? m : res; }
    return res;
}
__device__ __forceinline__ void cand_ab(int cidx50, int& a, int& b) {
    a = cidx50 < 16 ? 0 : cidx50 < 24 ? 1 : cidx50 < 29 ? 2 : cidx50 < 33 ? 3 : cidx50 < 36 ? 4 : cidx50 < 38 ? 5 : cidx50 < 40 ? 6 : cidx50 < 42 ? 7 : cidx50 - 34;
    const int st = cidx50 < 16 ? 0 : cidx50 < 24 ? 16 : cidx50 < 29 ? 24 : cidx50 < 33 ? 29 : cidx50 < 36 ? 33 : cidx50 < 38 ? 36 : cidx50 < 40 ? 38 : cidx50 < 42 ? 40 : cidx50;
    b = cidx50 - st;
}
__device__ __forceinline__ void peer_topk_pair(const LAS float* srow, int hp, LAS float* gsc, LAS int* isc, int lane) {
    const int hl = lane & 31, hb = lane & 32; const bool hi_half = lane >= 32; const int h = 2 * hp + (hi_half ? 1 : 0);
    const LAS float* sh = srow + h * 256;
    unsigned k1[4], k2[4];
#pragma unroll
    for (int j = 0; j < 4; ++j) { const int idx = hl + 32 * j; k1[j] = (fkey(sh[idx]) & ~127u) | (unsigned)(127 - idx); k2[j] = (fkey(sh[128 + idx]) & ~127u) | (unsigned)(127 - idx); }
    const unsigned r1 = topk16_half4(k1, hl, hi_half), r2 = topk16_half4(k2, hl, hi_half);
    const int i1 = 127 - (int)(r1 & 127u), i2 = 127 - (int)(r2 & 127u);
    const float v1 = sh[i1], v2 = sh[128 + i2];
    int a0, b0, a1, b1; cand_ab(hl, a0, b0); cand_ab(hl + 32, a1, b1);
    const float c0 = __shfl(v1, hb + a0) + __shfl(v2, hb + b0), c1 = __shfl(v1, hb + (a1 & 15)) + __shfl(v2, hb + (b1 & 15));
    const unsigned q0 = (fkey(c0) & ~255u) | (unsigned)(255 - (a0 * 16 + b0)), q1 = (hl + 32 < 50) ? ((fkey(c1) & ~255u) | (unsigned)(255 - (a1 * 16 + b1))) : 0u;
    const unsigned r3 = topk16_half2(q0, q1, hl, hi_half);
    const int ci = 255 - (int)(r3 & 255u);
    const float sc = __shfl(v1, hb + (ci >> 4)) + __shfl(v2, hb + (ci & 15));
    const int e = __shfl(i1, hb + (ci >> 4)) * 128 + __shfl(i2, hb + (ci & 15));
    const float mxa = __int_as_float(__builtin_amdgcn_readlane(__float_as_int(sc), 0)), mxb = __int_as_float(__builtin_amdgcn_readlane(__float_as_int(sc), 32));
    const float ex = hl < 16 ? __expf(sc - (hi_half ? mxb : mxa)) : 0.f;
    float sm = ex; sm += DPPF(sm, 0xB1); sm += DPPF(sm, 0x4E); sm += DPPF(sm, 0x141); sm += DPPF(sm, 0x140);
    if (hl < 16) { gsc[h * 16 + hl] = ex / sm; isc[h * 16 + hl] = e; }
}

__device__ __forceinline__ unsigned row_max_u32(unsigned v) { v = max(v, DPPU(v, 0xB1)); v = max(v, DPPU(v, 0x4E)); v = max(v, DPPU(v, 0x141)); v = max(v, DPPU(v, 0x140)); return v; }
#define CSWAP(a, b) do { const unsigned hi_ = max(a, b), lo_ = min(a, b); a = hi_; b = lo_; } while (0)
__device__ __forceinline__ unsigned topk16_row8(unsigned (&k)[8], int rl) {
    CSWAP(k[0], k[1]); CSWAP(k[2], k[3]); CSWAP(k[4], k[5]); CSWAP(k[6], k[7]);
    CSWAP(k[0], k[2]); CSWAP(k[1], k[3]); CSWAP(k[4], k[6]); CSWAP(k[5], k[7]);
    CSWAP(k[1], k[2]); CSWAP(k[5], k[6]); CSWAP(k[0], k[4]); CSWAP(k[3], k[7]);
    CSWAP(k[1], k[5]); CSWAP(k[2], k[6]);
    CSWAP(k[1], k[4]); CSWAP(k[3], k[6]);
    CSWAP(k[2], k[4]); CSWAP(k[3], k[5]);
    CSWAP(k[3], k[4]);
    unsigned res = 0u;
    for (int it = 0; it < 16; ++it) { const unsigned m = row_max_u32(k[0]); const bool mine = (k[0] == m);
#pragma unroll
        for (int j = 0; j < 7; ++j) k[j] = mine ? k[j + 1] : k[j];
        k[7] = mine ? 0u : k[7];
        res = (rl == it) ? m : res; }
    return res;
}
__device__ __forceinline__ void topk16_row8x2(unsigned (&k)[8], unsigned (&g)[8], int rl, unsigned& rk, unsigned& rg) {
#define CSWAP2(a, b) do { const unsigned hi_ = max(k[a], k[b]), lo_ = min(k[a], k[b]); k[a] = hi_; k[b] = lo_; const unsigned hj_ = max(g[a], g[b]), lj_ = min(g[a], g[b]); g[a] = hj_; g[b] = lj_; } while (0)
    CSWAP2(0, 1); CSWAP2(2, 3); CSWAP2(4, 5); CSWAP2(6, 7);
    CSWAP2(0, 2); CSWAP2(1, 3); CSWAP2(4, 6); CSWAP2(5, 7);
    CSWAP2(1, 2); CSWAP2(5, 6); CSWAP2(0, 4); CSWAP2(3, 7);
    CSWAP2(1, 5); CSWAP2(2, 6);
    CSWAP2(1, 4); CSWAP2(3, 6);
    CSWAP2(2, 4); CSWAP2(3, 5);
    CSWAP2(3, 4);
#undef CSWAP2
    unsigned res = 0u, reg = 0u;
#pragma unroll
    for (int it = 0; it < 16; ++it) {
        unsigned m = k[0], n = g[0];
        m = max(m, DPPU(m, 0xB1)); n = max(n, DPPU(n, 0xB1)); m = max(m, DPPU(m, 0x4E)); n = max(n, DPPU(n, 0x4E));
        m = max(m, DPPU(m, 0x141)); n = max(n, DPPU(n, 0x141)); m = max(m, DPPU(m, 0x140)); n = max(n, DPPU(n, 0x140));
        const bool mine = (k[0] == m), nine = (g[0] == n);
#pragma unroll
        for (int j = 0; j < 7; ++j) { k[j] = mine ? k[j + 1] : k[j]; g[j] = nine ? g[j + 1] : g[j]; }
        k[7] = mine ? 0u : k[7]; g[7] = nine ? 0u : g[7];
        res = (rl == it) ? m : res; reg = (rl == it) ? n : reg; }
    rk = res; rg = reg;
}
__device__ __forceinline__ unsigned topk16_row4(unsigned (&k)[4], int rl) {
    CSWAP(k[0], k[1]); CSWAP(k[2], k[3]); CSWAP(k[0], k[2]); CSWAP(k[1], k[3]); CSWAP(k[1], k[2]);
    unsigned res = 0u;
    for (int it = 0; it < 16; ++it) { const unsigned m = row_max_u32(k[0]); const bool mine = (k[0] == m);
#pragma unroll
        for (int j = 0; j < 3; ++j) k[j] = mine ? k[j + 1] : k[j];
        k[3] = mine ? 0u : k[3];
        res = (rl == it) ? m : res; }
    return res;
}
#undef CSWAP
__device__ __forceinline__ void peer_topk_quad(const LAS float* srow, int hq, LAS float* gsc, LAS int* isc, int lane) {
    const int rl = lane & 15, rb = lane & 48, h = 4 * hq + (lane >> 4);
    const LAS float* sh = srow + h * 256;
    unsigned k1[8], k2[8];
#pragma unroll
    for (int j = 0; j < 8; ++j) { const int idx = rl + 16 * j; k1[j] = (fkey(sh[idx]) & ~127u) | (unsigned)(127 - idx); k2[j] = (fkey(sh[128 + idx]) & ~127u) | (unsigned)(127 - idx); }
    unsigned r1, r2; topk16_row8x2(k1, k2, rl, r1, r2);
    const int i1 = 127 - (int)(r1 & 127u), i2 = 127 - (int)(r2 & 127u);
    const float v1 = sh[i1], v2 = sh[128 + i2];
    unsigned q[4];
#pragma unroll
    for (int j = 0; j < 4; ++j) { const int cidx = rl + 16 * j; int a, b; cand_ab(cidx < 50 ? cidx : 0, a, b);
        const float cs = __shfl(v1, rb + (a & 15)) + __shfl(v2, rb + (b & 15));
        q[j] = (cidx < 50) ? ((fkey(cs) & ~255u) | (unsigned)(255 - (a * 16 + b))) : 0u; }
    const unsigned r3 = topk16_row4(q, rl);
    const int ci = 255 - (int)(r3 & 255u);
    const float sc = __shfl(v1, rb + (ci >> 4)) + __shfl(v2, rb + (ci & 15));
    const int e = __shfl(i1, rb + (ci >> 4)) * 128 + __shfl(i2, rb + (ci & 15));
    const float mx = __shfl(sc, rb);
    const float ex = __expf(sc - mx);
    float sm = ex; sm += DPPF(sm, 0xB1); sm += DPPF(sm, 0x4E); sm += DPPF(sm, 0x141); sm += DPPF(sm, 0x140);
    gsc[h * 16 + rl] = ex / sm; isc[h * 16 + rl] = e;
}

constexpr size_t WS_PE_E = WS_P + 160 * MiB, WS_PE_CF = WS_PE_E + (size_t)MALL * 128 * 4;
constexpr int NSL = 16, SLW = 128;
constexpr size_t SLICE_BYTES = (size_t)16384 * SLW;
__device__ __forceinline__ void peer_token(const Ctx& c, int l, int r, int rn, int b, bool dry) {
    LAS float* gsc = (LAS float*)(c.lds + c.wave * 2048 + b * 1024);
    LAS int* isc = (LAS int*)(c.lds + c.wave * 2048 + b * 1024 + 512);
    LAS float* gscn = (LAS float*)(c.lds + c.wave * 2048 + (b ^ 1) * 1024); LAS int* iscn = (LAS int*)(c.lds + c.wave * 2048 + (b ^ 1) * 1024 + 512);
    const float* Sn = (const float*)(c.ws + WS_P) + (size_t)(rn < 0 ? r : rn) * DM;
    const int lane = c.lane;
    LAS float* snb = (LAS float*)(c.lds + 16384 + c.wave * 8192);
    f32x4 sv[8];
#pragma unroll
    for (int q = 0; q < 8; ++q) sv[q] = (rn >= 0) ? *(const f32x4*)(Sn + q * 256 + lane * 4) : (f32x4){0.f, 0.f, 0.f, 0.f};
    LDS_WAIT(); asm volatile("" ::: "memory");
    const bf16_t* hx = (const bf16_t*)(c.ws + WS_HX) + (size_t)r * DM;
    int hq[2][4]; float hdq;
    { float hv[2][16]; float mx = 0.f;
#pragma unroll
      for (int j = 0; j < 2; ++j) { float t0[8], t1[8]; unpack8(*(const u32x4*)(hx + j * 1024 + lane * 16), t0); unpack8(*(const u32x4*)(hx + j * 1024 + lane * 16 + 8), t1);
#pragma unroll
          for (int k = 0; k < 8; ++k) { hv[j][k] = t0[k]; hv[j][8 + k] = t1[k]; mx = fmaxf(mx, fmaxf(fabsf(t0[k]), fabsf(t1[k]))); } }
#pragma unroll
      for (int o = 32; o > 0; o >>= 1) mx = fmaxf(mx, __shfl_xor(mx, o));
      const float q_ = mx > 0.f ? 127.f / mx : 0.f; hdq = mx * (1.f / 127.f);
#pragma unroll
      for (int j = 0; j < 2; ++j)
#pragma unroll
          for (int d = 0; d < 4; ++d) hq[j][d] = (int)pk4_i8(hv[j][4 * d] * q_, hv[j][4 * d + 1] * q_, hv[j][4 * d + 2] * q_, hv[j][4 * d + 3] * q_); }
    const float* USC = (const float*)(c.ws + WS_USC) + (size_t)l * 16384;
    const unsigned char* PU = (const unsigned char*)(c.ws + ws_pu(l)); const unsigned char* PV = (const unsigned char*)(c.ws + ws_pv(l));
#define PEER_LOADROW(tab, wk, e_) do { const unsigned char* row_ = (tab) + (size_t)__builtin_amdgcn_readfirstlane(e_) * DM + lane * 16; wk[0] = *(const u32x4*)row_; wk[1] = *(const u32x4*)(row_ + 1024); } while (0)
#define PEER_IDX8(dst, i_) const u32x4 ia_##dst = *(const LAS u32x4*)(isc + (i_)), ib_##dst = *(const LAS u32x4*)(isc + (i_) + 4); \
        const int dst[8] = {(int)ia_##dst[0], (int)ia_##dst[1], (int)ia_##dst[2], (int)ia_##dst[3], (int)ib_##dst[0], (int)ib_##dst[1], (int)ib_##dst[2], (int)ib_##dst[3]}
    u32x4 w[8][2];
    float usc_ = USC[isc[lane & 7]];
    { PEER_IDX8(e0, 0);
#pragma unroll
      for (int k = 0; k < 8; ++k) PEER_LOADROW(PU, w[k], e0[k]); }
    if (rn >= 0) {
#pragma unroll
        for (int q = 0; q < 8; ++q) *(LAS f32x4*)(snb + q * 256 + lane * 4) = sv[q];
        LDS_WAIT(); asm volatile("" ::: "memory"); }
#pragma unroll 1
    for (int i = 0; i < 128; i += 8) {
        const bool has_next = i + 8 < 128;
        PEER_IDX8(en, has_next ? i + 8 : i);
        const float uscn_ = USC[isc[(has_next ? i + 8 : i) + (lane & 7)]];
        if (rn >= 0 && (i & 56) == 0) peer_topk_quad(snb, i >> 6, gscn, iscn, lane);
        float p[8];
#pragma unroll
        for (int k = 0; k < 8; ++k) {
            asm volatile("" : "+v"(w[k][0]), "+v"(w[k][1]));
            int s = 0;
#pragma unroll
            for (int j = 0; j < 2; ++j)
#pragma unroll
                for (int d = 0; d < 4; ++d) s = __builtin_amdgcn_sdot4((int)w[k][j][d], hq[j][d], s, false);
            p[k] = (float)s; asm volatile("" : "+v"(p[k]));
            if (has_next) PEER_LOADROW(PU, w[k], en[k]); }
        const bool b0 = lane & 1, b1 = lane & 2, b2 = lane & 4;
        float q[4], t[2];
#pragma unroll
        for (int m = 0; m < 4; ++m) q[m] = (b0 ? p[2 * m + 1] : p[2 * m]) + DPPF(b0 ? p[2 * m] : p[2 * m + 1], 0xB1);
#pragma unroll
        for (int m = 0; m < 2; ++m) t[m] = (b1 ? q[2 * m + 1] : q[2 * m]) + DPPF(b1 ? q[2 * m] : q[2 * m + 1], 0x4E);
        float s = (b2 ? t[1] : t[0]) + SWZ_XOR(b2 ? t[0] : t[1], 4);
        s += SWZ_XOR(s, 8); s += SWZ_XOR(s, 16); s += __shfl_xor(s, 32);
        if (lane < 8) gsc[i + lane] = gsc[i + lane] * gelu_tanh(s * (usc_ * hdq));
        usc_ = uscn_;
    }
#undef PEER_LOADROW
#undef PEER_IDX8
    LDS_WAIT(); asm volatile("" ::: "memory");
    { int* E = (int*)(c.ws + WS_PE_E) + (size_t)r * 128; float* CF = (float*)(c.ws + WS_PE_CF) + (size_t)r * 128;
      E[lane] = isc[lane]; E[64 + lane] = isc[64 + lane]; CF[lane] = gsc[lane]; CF[64 + lane] = gsc[64 + lane]; }
    LDS_WAIT(); asm volatile("" ::: "memory");
}
__device__ __forceinline__ void phase_peer(const Ctx& c, int l, int nrows, bool dry = false) {
    const int gw = c.wg * NWAVES + c.wave, NGW = c.G * NWAVES;
    int r = gw; if (r >= nrows) return;
    { const float* S0 = (const float*)(c.ws + WS_P) + (size_t)r * DM; LAS float* snb0 = (LAS float*)(c.lds + 16384 + c.wave * 8192);
#pragma unroll
      for (int q = 0; q < 8; ++q) *(LAS f32x4*)(snb0 + q * 256 + c.lane * 4) = *(const f32x4*)(S0 + q * 256 + c.lane * 4);
      LDS_WAIT(); asm volatile("" ::: "memory");
#pragma unroll 1
      for (int hq = 0; hq < 2; ++hq) peer_topk_quad(snb0, hq, (LAS float*)(c.lds + c.wave * 2048), (LAS int*)(c.lds + c.wave * 2048 + 512), c.lane);
      LDS_WAIT(); asm volatile("" ::: "memory"); }
    int b = 0;
#pragma unroll 1
    for (; r < nrows; r += NGW, b ^= 1) { const int rn = r + NGW; peer_token(c, l, r, rn < nrows ? rn : -1, b, dry); }
}
#define PEER_SLICE_BEGIN() { const int grp = c.wg & 7, wi = (c.wg >> 3) * NWAVES + c.wave, nwi = ((c.G - grp + 7) >> 3) * NWAVES; \
    _Pragma("unroll 1") for (int ps = 0; ps < 2; ++ps) { const int s = grp + 8 * ps; _Pragma("unroll 1") for (int r = wi; r < nrows; r += nwi) {
#define PEER_SLICE_END() } } }
__device__ __forceinline__ void phase_peer_v(const Ctx& c, int l, int nrows, bool dry) {
    const int lane = c.lane, rg = lane >> 3, ch = lane & 7;
    const int* Eb = (const int*)(c.ws + WS_PE_E); const float* CF = (const float*)(c.ws + WS_PE_CF);
    const bool b3 = lane & 8, b4 = lane & 16, b5 = lane & 32;
    const int grp = c.wg & 7, wi = (c.wg >> 3) * NWAVES + c.wave, nwi = ((c.G - grp + 7) >> 3) * NWAVES;
#define V_META(r_, e0_, e1_, c0_, c1_) do { if ((r_) < nrows) { e0_ = Eb[(size_t)(r_) * 128 + lane]; e1_ = Eb[(size_t)(r_) * 128 + 64 + lane]; c0_ = CF[(size_t)(r_) * 128 + lane]; c1_ = CF[(size_t)(r_) * 128 + 64 + lane]; } } while (0)
#pragma unroll 1
    for (int ps = 0; ps < 2; ++ps) { const int s = grp + 8 * ps;
        const unsigned char* tab = (const unsigned char*)(c.ws + ws_pv(l)) + (size_t)s * SLICE_BYTES + ch * 16;
        const int col = s * SLW + ch * 16 + (b3 ? 8 : 0) + (b4 ? 4 : 0) + (b5 ? 2 : 0);
        int r = wi; int e0 = 0, e1 = 0; float c0 = 0.f, c1 = 0.f;
        V_META(r, e0, e1, c0, c1);
#pragma unroll 1
        for (; r < nrows; r += nwi) {
            u32x4 w[16];
#pragma unroll
            for (int i = 0; i < 16; ++i) { const int e = __shfl(i < 8 ? e0 : e1, (8 * i + rg) & 63); w[i] = *(const u32x4*)(tab + (size_t)e * SLW); }
            int f0 = 0, f1 = 0; float d0 = 0.f, d1 = 0.f; V_META(r + nwi, f0, f1, d0, d1);
            const int vec = r < SEQ ? 0 : (r < MLAT ? 1 : 2);
            float* xr = (dry ? (float*)(c.ws + WS_YF) + (size_t)r * DM : xrow_ptr(c, r)) + col;
            const f32x2 gg = *(const f32x2*)((const float*)(c.ws + WS_MOD) + ((size_t)l * 3 + vec) * NMOD + 5 * DM + col); f32x2 xx = *(const f32x2*)xr;
            h16x2 o2[8];
#pragma unroll
            for (int j = 0; j < 8; ++j) o2[j] = (h16x2){(_Float16)0.f, (_Float16)0.f};
#pragma unroll
            for (int i = 0; i < 16; ++i) {
                asm volatile("" : "+v"(w[i]));
                const float ci_ = __shfl(i < 8 ? c0 : c1, (8 * i + rg) & 63);
                const h16x2 ci2 = {(_Float16)ci_, (_Float16)ci_};
#pragma unroll
                for (int d = 0; d < 4; ++d) {
                    const h16x2 lo_ = __builtin_bit_cast(h16x2, __builtin_amdgcn_cvt_scalef32_pk_f16_fp8((int)w[i][d], 1.0f, false)), hi_ = __builtin_bit_cast(h16x2, __builtin_amdgcn_cvt_scalef32_pk_f16_fp8((int)w[i][d], 1.0f, true));
                    o2[2 * d] = __builtin_elementwise_fma(lo_, ci2, o2[2 * d]); o2[2 * d + 1] = __builtin_elementwise_fma(hi_, ci2, o2[2 * d + 1]); }
                asm volatile("" : "+v"(o2[0])); }
            float o[16];
#pragma unroll
            for (int j = 0; j < 8; ++j) { o[2 * j] = (float)o2[j][0]; o[2 * j + 1] = (float)o2[j][1]; }
            float q8[8], q4[4], q2[2];
#pragma unroll
            for (int j = 0; j < 8; ++j) q8[j] = (b3 ? o[8 + j] : o[j]) + DPPF(b3 ? o[j] : o[8 + j], 0x128);
#pragma unroll
            for (int j = 0; j < 4; ++j) q4[j] = (b4 ? q8[4 + j] : q8[j]) + SWZ_XOR(b4 ? q8[j] : q8[4 + j], 16);
#pragma unroll
            for (int j = 0; j < 2; ++j) q2[j] = (b5 ? q4[2 + j] : q4[j]) + __shfl_xor(b5 ? q4[j] : q4[2 + j], 32);
            xx[0] += gg[0] * q2[0]; xx[1] += gg[1] * q2[1];
            *(f32x2*)xr = xx;
            e0 = f0; e1 = f1; c0 = d0; c1 = d1;
        }
    }
#undef V_META
}
struct Args { const float* in[29]; float* out; unsigned char* ws; int ph_lo, ph_hi; };
constexpr int PH_PER_LAYER = 10, N_PHASES = NLAYER * PH_PER_LAYER;
#ifndef G1_WGM
#define G1_WGM 3
#endif
constexpr int CW_BAR = 4096;

__global__ void __launch_bounds__(NTHREADS, 2) mk_fwd(Args args) {
    extern __shared__ __attribute__((aligned(16))) unsigned char lds_raw[];
    Ctx c0;
    c0.out = args.out; c0.ws = args.ws; c0.lds = (LAS unsigned char*)lds_raw;
    c0.tid = threadIdx.x; c0.lane = c0.tid & 63; c0.wave = __builtin_amdgcn_readfirstlane((int)(threadIdx.x >> 6)); c0.wg = blockIdx.x; c0.G = gridDim.x;
    volatile LAS unsigned* MISC = (volatile LAS unsigned*)(c0.lds + MISC_OFF);
    if (c0.tid < 64) MISC[c0.tid] = 0u;
    __syncthreads();
    const int lo = args.ph_lo, hi = args.ph_hi;
    XcdBarrier bar; bar.bar = (unsigned*)(c0.ws + WS_CTL) + CW_BAR; bar.x = 0; bar.st = MISC + 8;
    if (hi - lo > 1) bar = xcd_barrier_post((unsigned*)(c0.ws + WS_CTL) + CW_BAR, MISC + 8);
#ifndef ONLY_PH
#define ONLY_PH -1
#endif
#define IN(k) ((ONLY_PH < 0 || ((k) % PH_PER_LAYER) == ONLY_PH) && lo <= (k) && (k) < hi)
#define PH_BEGIN() Ctx c = c0; unsigned long long wsi_ = (unsigned long long)c0.ws, outi_ = (unsigned long long)c0.out; asm volatile("" : "+s"(wsi_), "+s"(outi_), "+s"(c.wg), "+s"(c.G), "+s"(c.wave)); \
    c.lane = lane_id_fresh(); c.tid = c.wave * 64 + c.lane; c.ws = (unsigned char*)(GAS unsigned char*)wsi_; c.out = (float*)(GAS float*)outi_;     \
    bf16_t* P = (bf16_t*)(c.ws + WS_P); bf16_t* HX = (bf16_t*)(c.ws + WS_HX); float* YF = (float*)(c.ws + WS_YF); (void)P; (void)HX; (void)YF
#ifndef PROBE_DUP
#define PROBE_DUP -1
#endif
#define REPS(k) for (int rep = 0, dry = (PROBE_DUP == (k)); rep < (PROBE_DUP == (k) ? 2 : 1); ++rep, dry = 0)
#define SEAM(k) do { if (IN(k) && IN((k) + 1)) { xcd_barrier(bar, c0.wave); if (PROBE_DUP == 20) xcd_barrier(bar, c0.wave); } } while (0)
    const bool early = (c0.G == 256);
#define TAIL_BEGIN() PH_BEGIN(); c.wg -= 32; c.G -= 32
    for (int l = 0; l < NLAYER; ++l) {
        const int pb = l * PH_PER_LAYER;
        const int mrows = (l == 0) ? MALL : MLAT;
        if (IN(pb + 0) && !(l == 1 && early)) REPS(0) {
            if (l == 0) { PH_BEGIN(); conv_colmax(c); }
            { PH_BEGIN(); conv_units(c, l); } { PH_BEGIN(); conv_tables(c, l); } { PH_BEGIN(); conv_small(c, l); }
            if (l == 0) { { PH_BEGIN(); conv_once(c); } xcd_barrier(bar, c0.wave); }
            { PH_BEGIN(); conv_transposes(c, l); } }
        if (!(l == 1 && early)) SEAM(pb + 0);
        if (IN(pb + 1)) REPS(1) { PH_BEGIN();
            if (l == 0) { GET_IN(); phase_norm<true>(c, l, MALL, SP_NMIX, 0, INP(I_X), INP(I_CTX)); } else phase_norm<true>(c, l, MALL, SP_NMIX, 0); }
        SEAM(pb + 1);
        if (IN(pb + 2)) REPS(2) { PH_BEGIN();
            pg8::Gemm g{HX, (const bf16_t*)(c.ws + WS_WIN), MALL, NIN, DM, DM, DM}; pg8::StaticOrder S; S.init(MALL, NIN, c.G, c.wg, G1_WGM);
            pg8::EpiI8 E{P, NIN, (const float*)(c.ws + WS_ADQ), (const float*)(c.ws + WS_WDQ)};
            pg8::gemm_phase<pg8::EpiI8, pg8::StaticOrder, true, true, false, true>(c.lds, g, S, E, c.wave);
        }
        SEAM(pb + 2);
        if (IN(pb + 3)) REPS(3) {
            int flip_ = (c0.wg >> 3) & 1; asm volatile("" : "+s"(flip_));
#pragma unroll 1
            for (int st = 0; st < 2; ++st) {
                if ((st ^ flip_) == 0) { { PH_BEGIN(); phase_qk(c, l, dry); } { PH_BEGIN(); phase_sc(c, l, dry); } }
                else { PH_BEGIN(); phase_lru1(c, l); }
                __syncthreads(); }
            if (PROBE_DUP == 30) { PH_BEGIN(); phase_lru1(c, l); } }
        SEAM(pb + 3);
        if (IN(pb + 4)) REPS(4) { { PH_BEGIN(); phase_m2(c, l, dry); } __syncthreads(); if (PROBE_DUP == 31) { PH_BEGIN(); phase_lru2(c, l, true); } { PH_BEGIN(); phase_lru2(c, l, dry); } }
        SEAM(pb + 4);
        if (IN(pb + 5)) REPS(5) { { PH_BEGIN();
            pg8::MixOrder S; S.init(mrows, c.G, c.wg);
            const bf16_t* WO = (const bf16_t*)(c.ws + WS_WO);
            { pg8::Gemm g{P + CQ, WO, mrows, DM, DM, NIN, DM}; pg8::EpiMerge<0> E{P + CGT, NIN, (bf16_t*)YF, HX};
              pg8::gemm_phase<pg8::EpiMerge<0>, pg8::MixOrder, true, true, true>(c.lds, g, S, E, c.wave); }
            { pg8::Gemm g{P + CLG, WO + (size_t)DM * DM, mrows, DM, DM, NIN, DM}; pg8::EpiMerge<1> E{P + CGT + DM, NIN, (bf16_t*)YF, HX};
              pg8::gemm_phase<pg8::EpiMerge<1>, pg8::MixOrder, true, true, true>(c.lds, g, S, E, c.wave); }
            { pg8::Gemm g{P + CBG, WO + (size_t)2 * DM * DM, mrows, DM, DM, NIN, DM}; pg8::EpiMerge<2> E{P + CGT + 2 * DM, NIN, (bf16_t*)YF, HX};
              pg8::gemm_phase<pg8::EpiMerge<2>, pg8::MixOrder, true, true, true>(c.lds, g, S, E, c.wave); }
            }
            if (l == 0 && early && c0.wg >= 32 && !dry) { { TAIL_BEGIN(); conv_transposes(c, 1, CV_WIN); } { TAIL_BEGIN(); conv_tables(c, 1, CV_PU); } }
        }
        SEAM(pb + 5);
        if (IN(pb + 6)) REPS(6) { { PH_BEGIN();
            pg8::Gemm g{HX, (const bf16_t*)(c.ws + WS_WOUT), mrows, DM, DM, DM, DM}; pg8::MixOrder S; S.init(mrows, c.G, c.wg);
            float* xl_ = dry ? YF : c.out; float* xc_ = dry ? YF + (size_t)MLAT * DM : (float*)(c.ws + WS_CTXS);
            const float* sl_ = xl_; const float* sc_ = xc_;
            if (l == 0 && !dry) { GET_IN(); sl_ = INP(I_X); sc_ = INP(I_CTX); }
            pg8::EpiResid E{xl_, xc_, (const float*)(c.ws + WS_MOD) + (size_t)l * 3 * NMOD + 2 * DM, sl_, sc_};
            pg8::gemm_phase<pg8::EpiResid, pg8::MixOrder, true, true, true>(c.lds, g, S, E, c.wave);
            }
            if (l == 0 && early && c0.wg >= 32 && !dry) { { TAIL_BEGIN(); conv_units(c, 1); } { TAIL_BEGIN(); conv_transposes(c, 1, CV_WO); } }
        }
        SEAM(pb + 6);
        if (IN(pb + 7)) REPS(7) { PH_BEGIN(); phase_norm(c, l, mrows, SP_NFFN, 3); }
        SEAM(pb + 7);
        if (IN(pb + 8)) REPS(8) { { PH_BEGIN();
            pg8::Gemm g{HX, (const bf16_t*)(c.ws + ws_wsc(l)), mrows, DM, DM, DM, DM}; pg8::MixOrder S; S.init(mrows, c.G, c.wg);
            pg8::EpiF32 E{(float*)(c.ws + WS_P), DM};
            pg8::gemm_phase<pg8::EpiF32, pg8::MixOrder, true, true, true>(c.lds, g, S, E, c.wave);
            }
            if (l == 0 && early && c0.wg >= 32 && !dry) { { TAIL_BEGIN(); conv_transposes(c, 1, CV_WOUT); } { TAIL_BEGIN(); conv_tables(c, 1, CV_PV | CV_LRU); } { TAIL_BEGIN(); conv_small(c, 1); } }
        }
        SEAM(pb + 8);
        if (IN(pb + 9)) REPS(9) {
            { PH_BEGIN(); phase_peer(c, l, mrows, dry); } xcd_barrier(bar, c0.wave);
            { PH_BEGIN(); phase_peer_v(c, l, mrows, dry); } }
        SEAM(pb + 9);
    }
#undef IN
#undef SEAM
}

extern "C" void kernel_launch(void* const* d_in, const int* in_sizes, int n_in, void* d_out, int out_size, void* d_ws, size_t ws_size, hipStream_t stream) {
    static int grid = 0;
    if (grid == 0) {
        if (n_in != 29 || in_sizes[0] != MLAT * DM || out_size != MLAT * DM || ws_size < WS_END) {
            fprintf(stderr, "kernel_launch: built for 29 inputs, x/out of %d floats, >= %zu bytes of workspace; got n_in %d, in0 %d, out %d, ws %zu; nothing launched\n", MLAT * DM, (size_t)WS_END, n_in, n_in > 0 ? in_sizes[0] : -1, out_size, ws_size);
            grid = -1; return; }
        int dev = 0, cus = 0, per_cu = 0;
        if (hipGetDevice(&dev) != hipSuccess || hipDeviceGetAttribute(&cus, hipDeviceAttributeMultiprocessorCount, dev) != hipSuccess) { fprintf(stderr, "kernel_launch: device query failed\n"); grid = -1; return; }
        if (hipFuncSetAttribute((const void*)mk_fwd, hipFuncAttributeMaxDynamicSharedMemorySize, LDS_BYTES) != hipSuccess) { fprintf(stderr, "kernel_launch: hipFuncSetAttribute failed\n"); grid = -1; return; }
        if (hipOccupancyMaxActiveBlocksPerMultiprocessor(&per_cu, (const void*)mk_fwd, NTHREADS, LDS_BYTES) != hipSuccess || per_cu < 1)
            fprintf(stderr, "kernel_launch: note: occupancy query reports %d workgroups per CU\n", per_cu);
        (void)hipGetLastError();
        grid = cus;
    }
    if (grid < 0) return;
    if (hipMemsetAsync((char*)d_ws + WS_CTL, 0, CTL_ZERO_BYTES, stream) != hipSuccess) { fprintf(stderr, "kernel_launch: memset failed\n"); return; }
    Args a{};
    for (int i = 0; i < 29; ++i) a.in[i] = (const float*)d_in[i];
    a.out = (float*)d_out; a.ws = (unsigned char*)d_ws;
#if MK_N_LAUNCHES == 1
    a.ph_lo = 0; a.ph_hi = N_PHASES;
    hipLaunchKernelGGL(mk_fwd, dim3(grid), dim3(NTHREADS), LDS_BYTES, stream, a);
#else
    for (int k = 0; k < N_PHASES; ++k) { a.ph_lo = k; a.ph_hi = k + 1; hipLaunchKernelGGL(mk_fwd, dim3(grid), dim3(NTHREADS), LDS_BYTES, stream, a); }
#endif
    const hipError_t le = hipPeekAtLastError();
    if (le != hipSuccess) fprintf(stderr, "kernel_launch: launch failed: %s\n", hipGetErrorName(le));
}
```

```cpp
#include <hip/hip_runtime.h>
#include <cstdio>
#include <cstdint>

#ifndef MK_N_LAUNCHES
#define MK_N_LAUNCHES 1
#endif
#if MK_N_LAUNCHES != 1
#error "the PEER phase carries a grid barrier of its own: this kernel is one launch only"
#endif

#define GAS __attribute__((address_space(1)))
#define LAS __attribute__((address_space(3)))
typedef unsigned short bf16_t;
typedef short bf16x8 __attribute__((ext_vector_type(8)));
typedef short s16x4 __attribute__((ext_vector_type(4)));
typedef float f32x2 __attribute__((ext_vector_type(2)));
typedef _Float16 h16x2 __attribute__((ext_vector_type(2)));
typedef float f32x4 __attribute__((ext_vector_type(4)));
typedef float f32x8 __attribute__((ext_vector_type(8)));
typedef float f32x16 __attribute__((ext_vector_type(16)));
typedef unsigned u32x2 __attribute__((ext_vector_type(2)));
typedef unsigned u32x4 __attribute__((ext_vector_type(4)));
typedef int i32x4 __attribute__((ext_vector_type(4)));

constexpr int DM = 2048, NB = 2, SEQ = 8192, NLAYER = 2, CTXL = 256;
constexpr int MLAT = NB * SEQ, MCTX = NB * CTXL, MALL = MLAT + MCTX;
constexpr int NIN = 19456;
constexpr int CQ = 0, CK = 2048, CV = 2560, CLX = 3072, CLG = 5120, CBG = 7168, CCG = 9216, CU = 11264, CGT = 13312;
constexpr int NKEY = SEQ + CTXL;
constexpr int NCHUNK = NKEY / 64;
constexpr int NMOD = 6 * DM;
constexpr float EPS = 1e-6f;
constexpr int NWAVES = 8, NTHREADS = 512;

constexpr size_t MiB = 1u << 20;
constexpr size_t al256(size_t x) { return (x + 255) / 256 * 256; }
constexpr size_t WS_CTL = 0, CTL_ZERO_BYTES = 1 * MiB;
constexpr size_t WS_MOD = WS_CTL + CTL_ZERO_BYTES;
constexpr size_t WS_ROPE = WS_MOD + al256((size_t)NLAYER * 3 * NMOD * 4);
constexpr size_t WS_SP = WS_ROPE + al256(2 * 128 * 32 * 4);
constexpr size_t WS_CTXS = WS_SP + al256(36864 * 4);
constexpr size_t WS_LSUM = WS_CTXS + al256((size_t)MCTX * DM * 4);
constexpr size_t WS_WLRU = WS_LSUM + al256((size_t)2 * 2 * NB * NCHUNK * DM * 4);
constexpr size_t WS_KC = WS_WLRU + al256((size_t)16 * 512 * 128 * 2);
constexpr size_t WS_VC = WS_KC + al256((size_t)NB * 4 * NKEY * 128 * 2);
constexpr size_t WS_WIN = WS_VC + al256((size_t)NB * 4 * NKEY * 128 * 2);
constexpr size_t WS_CMAX = WS_WIN + (size_t)NIN * DM;
constexpr size_t WS_WDQ = WS_CMAX + al256((size_t)2 * 32 * NIN * 4);
constexpr size_t WS_ADQ = WS_WDQ + al256((size_t)NIN * 4);
constexpr size_t WS_WO = WS_WIN + al256((size_t)NIN * DM * 2);
constexpr size_t WS_WOUT = WS_WO + al256((size_t)3 * DM * DM * 2);
constexpr size_t WS_WSC = WS_WOUT + al256((size_t)DM * DM * 2);
constexpr size_t WS_PU = WS_WSC + al256((size_t)DM * DM * 2);
constexpr size_t WS_PV = WS_PU + al256((size_t)16384 * DM);
constexpr size_t WS_HX = WS_PV + al256((size_t)16384 * DM);
constexpr size_t WS_YF = WS_HX + al256((size_t)MALL * DM * 2);
constexpr size_t WS_P = WS_YF + al256((size_t)MALL * DM * 4);
static_assert(WS_ADQ + (size_t)MALL * 4 <= WS_WO, "the int8 side tables must fit the spare half of the w_in region");
constexpr size_t WS_PU2 = WS_P + al256((size_t)MALL * NIN * 2);
constexpr size_t WS_PV2 = WS_PU2 + al256((size_t)16384 * DM);
constexpr size_t WS_WSC2 = WS_PV2 + al256((size_t)16384 * DM);
constexpr size_t WS_USC = WS_WSC2 + al256((size_t)DM * DM * 2);
constexpr size_t WS_END = WS_USC + al256((size_t)2 * 16384 * 4);
__host__ __device__ constexpr size_t ws_pu(int l) { return l ? WS_PU2 : WS_PU; }
__host__ __device__ constexpr size_t ws_pv(int l) { return l ? WS_PV2 : WS_PV; }
__host__ __device__ constexpr size_t ws_wsc(int l) { return l ? WS_WSC2 : WS_WSC; }

constexpr int SP_NMIX = 0, SP_NFFN = 2048, SP_QN = 4096, SP_KN = 4224, SP_LCW = 4352, SP_LCB = 12544, SP_LBA = 14592, SP_LBX = 18688, SP_LSP = 22784, SP_SCW = 26880, SP_SCB = 33024, SP_END = 35072;

constexpr int LDS_BYTES = 147456;
constexpr int MISC_OFF = 147456 - 256;
constexpr int LDS_WORK = MISC_OFF;

__device__ __forceinline__ unsigned cvt_pk_bf16(float lo, float hi) { unsigned r; asm volatile("v_cvt_pk_bf16_f32 %0, %1, %2" : "=v"(r) : "v"(lo), "v"(hi)); return r; }
__device__ __forceinline__ unsigned pk4_i8(float a, float b, float c, float d) {
    const int ia = (int)__builtin_rintf(a), ib = (int)__builtin_rintf(b), ic = (int)__builtin_rintf(c), id = (int)__builtin_rintf(d);
    return ((unsigned)ia & 255u) | (((unsigned)ib & 255u) << 8) | (((unsigned)ic & 255u) << 16) | ((unsigned)id << 24); }
__device__ __forceinline__ float bf_lo(unsigned w) { return __uint_as_float(w << 16); }
__device__ __forceinline__ float bf_hi(unsigned w) { return __uint_as_float(w & 0xffff0000u); }
__device__ __forceinline__ float bf1(bf16_t h) { return __uint_as_float(((unsigned)h) << 16); }
__device__ __forceinline__ bf16_t f2bf(float f) { return (bf16_t)(cvt_pk_bf16(f, 0.f) & 0xffffu); }
__device__ __forceinline__ float sigmoidf_(float x) { return __builtin_amdgcn_rcpf(1.f + __expf(-x)); }
__device__ __forceinline__ float gelu_tanh(float x) { const float z = 0.7978845608028654f * (x + 0.044715f * x * x * x); const float e = __expf(2.f * z); return 0.5f * x * (2.f - 2.f * __builtin_amdgcn_rcpf(e + 1.f)); }
__device__ __forceinline__ float wave_sum(float v) {
#pragma unroll
    for (int o = 1; o < 64; o <<= 1) v += __shfl_xor(v, o);
    return v;
}
__device__ __forceinline__ float wave_max(float v) {
#pragma unroll
    for (int o = 1; o < 64; o <<= 1) v = fmaxf(v, __shfl_xor(v, o));
    return v;
}
template <class T> __device__ __forceinline__ T* as_global(T* p) { return (T*)(GAS T*)p; }
__device__ __forceinline__ int lane_id_fresh() { int l; asm volatile("v_mbcnt_lo_u32_b32 %0, -1, 0\n\tv_mbcnt_hi_u32_b32 %0, -1, %0" : "=v"(l)); return l; }
#define DPPF(v, ctrl) __int_as_float(__builtin_amdgcn_update_dpp(0, __float_as_int(v), ctrl, 0xF, 0xF, true))
#define LDS_WAIT() asm volatile("s_waitcnt lgkmcnt(0)" ::: "memory")
#define VM_WAIT() asm volatile("s_waitcnt vmcnt(0)" ::: "memory")

#define XB_TMO      128
#define XB_XCNT(j)  (256  + 64 * (j))
#define XB_XSUB(j)  (1280 + 64 * (j))
#define XB_XGEN(j)  (2304 + 64 * (j))
#define XB_TOP      3328
#define XB_TOPGEN   3392
#define XCD_BAR_WORDS 3456
#define XB_SPIN_CAP (1u << 23)
__device__ __forceinline__ unsigned xb_ld(unsigned* p)              { return __hip_atomic_load(p, __ATOMIC_RELAXED, __HIP_MEMORY_SCOPE_AGENT); }
__device__ __forceinline__ unsigned xb_add(unsigned* p, unsigned v) { return __hip_atomic_fetch_add(p, v, __ATOMIC_RELAXED, __HIP_MEMORY_SCOPE_AGENT); }
__device__ __forceinline__ unsigned xb_xcc_id() { return (unsigned)__builtin_amdgcn_s_getreg((3 << 11) | 20) & 0xFu; }
#define XB_SPIN(cond, bar) do { unsigned _sp = 0; while (cond) { __builtin_amdgcn_s_sleep(1); \
    if ((++_sp & 255u) == 0u) { if (xb_ld(&(bar)[XB_TMO])) break; if (_sp > XB_SPIN_CAP) { atomicAdd(&(bar)[XB_TMO], 1u); break; } } } } while (0)
struct XcdBarrier { unsigned* bar; unsigned x; volatile LAS unsigned* st; };
__device__ __forceinline__ XcdBarrier xcd_barrier_post(unsigned* bar, volatile LAS unsigned* st) {
    XcdBarrier b; b.bar = bar; b.x = xb_xcc_id(); b.st = st;
    if (threadIdx.x == 0) (void)xb_add(&bar[XB_XCNT(b.x)], 1u);
    return b;
}
__device__ __forceinline__ void xcd_barrier_complete(unsigned* bar, unsigned x, unsigned& nloc, unsigned& nx) {
    const unsigned G = gridDim.x * gridDim.y * gridDim.z;
    unsigned sum, cnt, mine, sp = 0u;
    for (;;) {
        sum = 0u; cnt = 0u; mine = 0u;
#pragma unroll
        for (unsigned j = 0; j < 16; ++j) { const unsigned c = xb_ld(&bar[XB_XCNT(j)]); sum += c; cnt += (c > 0u) ? 1u : 0u; mine = (j == x) ? c : mine; }
        if (sum == G) break;
        __builtin_amdgcn_s_sleep(1);
        if ((++sp & 255u) == 0u) { if (xb_ld(&bar[XB_TMO])) break; if (sp > XB_SPIN_CAP) { atomicAdd(&bar[XB_TMO], 1u); break; } }
    }
    nloc = mine > 0u ? mine : 1u; nx = cnt > 0u ? cnt : 1u;
}
__device__ __forceinline__ void xcd_barrier(const XcdBarrier& b, int wave) {
    asm volatile("s_waitcnt vmcnt(0)" ::: "memory");
    __syncthreads();
    if (wave == 0 && lane_id_fresh() == 0) {
        unsigned* bar = b.bar;
        __builtin_amdgcn_s_waitcnt(0);
        unsigned nloc = b.st[0], nx = b.st[1];
        if (nloc == 0u) { xcd_barrier_complete(bar, b.x, nloc, nx); b.st[0] = nloc; b.st[1] = nx; }
        const unsigned old = xb_add(&bar[XB_XSUB(b.x)], 1u);
        const unsigned gen = old / nloc;
        if (old + 1u == (gen + 1u) * nloc) {
            __builtin_amdgcn_fence(__ATOMIC_RELEASE, "agent");
            asm volatile("s_waitcnt vmcnt(0)" ::: "memory");
            const unsigned og = xb_add(&bar[XB_TOP], 1u);
            const unsigned tg = og / nx;
            if (og + 1u == (tg + 1u) * nx) xb_add(&bar[XB_TOPGEN], 1u);
            else XB_SPIN(xb_ld(&bar[XB_TOPGEN]) == tg, bar);
            __builtin_amdgcn_fence(__ATOMIC_ACQUIRE, "agent");
            xb_add(&bar[XB_XGEN(b.x)], 1u);
            asm volatile("s_waitcnt vmcnt(0)" ::: "memory");
        } else {
            XB_SPIN(xb_ld(&bar[XB_XGEN(b.x)]) == gen, bar);
            __builtin_amdgcn_fence(__ATOMIC_ACQUIRE, "agent");
            asm volatile("s_waitcnt vmcnt(0)" ::: "memory");
        }
    }
    __syncthreads();
}
#ifndef MIX_WGM
#define MIX_WGM 8
#endif
namespace pg8 {
#define PG8_LAS __attribute__((address_space(3)))
constexpr int BM = 256, BK = 64, HALF = 128, HTB = HALF * BK * 2, STAGE_BYTES = 8 * HTB, NXCD = 8, WGM = 8;
__host__ __device__ __forceinline__ int lds_byte(int r, int c) { const int st = (r >> 4) * 2 + (c >> 5), rr = r & 15, cc = c & 31, ob = rr * 64 + cc * 2; return st * 1024 + (ob ^ (((ob >> 9) & 1) << 5)); }
__host__ __device__ __forceinline__ void stage_rc(int b, int& R, int& C) { const int st = b / 1024, sb = b % 1024, swz = sb ^ (((sb >> 9) & 1) << 5); R = (st >> 1) * 16 + swz / 64; C = (st & 1) * 32 + (swz % 64) / 2; }
__host__ __device__ __forceinline__ int perm32(int rho) { const int n = rho >> 4, i = rho & 15; return 8 * (i >> 2) + 4 * n + (i & 3); }

struct Unit { int pm, pn, nh; };
struct Gemm { const bf16_t* A; const bf16_t* Bt; int M, N, K, lda, ldb; };

struct StaticOrder {
    int nM, nN, nwg, G, c, wgm = WGM;
    __host__ __device__ void init(int M, int N, int G_, int c_, int wgm_ = WGM) { nM = M / BM; nN = N / BM; nwg = nM * nN; G = G_; c = c_; wgm = wgm_; }
    __host__ __device__ bool next(int i, Unit& u) const {
        const long L = (long)i * G + c; if (L >= nwg) return false;
        int wgid = (int)L; { const int q = nwg / NXCD, r = nwg % NXCD, xcd = wgid % NXCD, off = wgid / NXCD; wgid = (xcd < r ? xcd * (q + 1) : r * (q + 1) + (xcd - r) * q) + off; }
        const int nig = wgm * nN, gid = wgid / nig, fm = gid * wgm, gsz = (nM - fm) < wgm ? (nM - fm) : wgm;
        u.pm = 2 * (fm + ((wgid % nig) % gsz)); u.pn = (wgid % nig) / gsz; u.nh = 2; return true;
    }
    __device__ __forceinline__ void a_ready(const Unit&) const {}
    __device__ __forceinline__ void done(const Unit&) const {}
};

struct MixOrder {
    StaticOrder lat; int nhalf;
    __host__ __device__ void init(int mrows, int G_, int c_) { lat.init(MLAT, 2048, G_, c_, MIX_WGM); nhalf = ((mrows - MLAT) / HALF) * 8; }
    __host__ __device__ bool next(int i, Unit& u) const {
        if (lat.next(i, u)) return true;
        const long h = (long)i * lat.G + lat.c - lat.nwg; if (h < 0 || h >= nhalf) return false;
        u.pm = MLAT / HALF + (int)(h >> 3); u.pn = (int)(h & 7); u.nh = 1; return true;
    }
    __device__ __forceinline__ void a_ready(const Unit&) const {}
    __device__ __forceinline__ void done(const Unit&) const {}
};

struct EpiBf16 {
    static constexpr bool PERM = true, AFTER_DRAIN = false;
    bf16_t* O; int ldc;
    __device__ __forceinline__ void operator()(const f32x4 (&acc)[2][2][4][2], const Unit& u, int wr, int wc, int fr, int fq) const {
        const int row0 = u.pm * HALF + wr * 64 + fr, col0 = u.pn * BM + wc * 32 + 8 * fq;
#pragma unroll
        for (int ai = 0; ai < 2; ++ai) if (ai < u.nh)
#pragma unroll
            for (int m = 0; m < 4; ++m) { bf16_t* rowp = O + (size_t)(row0 + ai * HALF + m * 16) * ldc + col0;
#pragma unroll
                for (int bj = 0; bj < 2; ++bj) { const f32x4 v0 = acc[ai][bj][m][0], v1 = acc[ai][bj][m][1];
                    u32x4 w; w.x = cvt_pk_bf16(v0[0], v0[1]); w.y = cvt_pk_bf16(v0[2], v0[3]); w.z = cvt_pk_bf16(v1[0], v1[1]); w.w = cvt_pk_bf16(v1[2], v1[3]);
                    *(u32x4*)(rowp + bj * HALF) = w; } }
    }
};
struct EpiI8 {
    static constexpr bool PERM = true, AFTER_DRAIN = false;
    bf16_t* O; int ldc; const float* rstep; const float* cstep;
    __device__ __forceinline__ void operator()(const f32x4 (&acc)[2][2][4][2], const Unit& u, int wr, int wc, int fr, int fq) const {
        const int row0 = u.pm * HALF + wr * 64 + fr, col0 = u.pn * BM + wc * 32 + 8 * fq;
        f32x4 cs[2][2];
#pragma unroll
        for (int bj = 0; bj < 2; ++bj) { cs[bj][0] = *(const f32x4*)(cstep + col0 + bj * HALF); cs[bj][1] = *(const f32x4*)(cstep + col0 + bj * HALF + 4); }
#pragma unroll
        for (int ai = 0; ai < 2; ++ai) if (ai < u.nh)
#pragma unroll
            for (int m = 0; m < 4; ++m) { const int r = row0 + ai * HALF + m * 16; bf16_t* rowp = O + (size_t)r * ldc + col0; const float rs = rstep[r];
#pragma unroll
                for (int bj = 0; bj < 2; ++bj) {
                    const f32x4 v0 = __builtin_convertvector(__builtin_bit_cast(i32x4, acc[ai][bj][m][0]), f32x4) * (cs[bj][0] * rs), v1 = __builtin_convertvector(__builtin_bit_cast(i32x4, acc[ai][bj][m][1]), f32x4) * (cs[bj][1] * rs);
                    u32x4 w; w.x = cvt_pk_bf16(v0[0], v0[1]); w.y = cvt_pk_bf16(v0[2], v0[3]); w.z = cvt_pk_bf16(v1[0], v1[1]); w.w = cvt_pk_bf16(v1[2], v1[3]);
                    *(u32x4*)(rowp + bj * HALF) = w; } }
    }
};
struct EpiF32 {
    static constexpr bool PERM = false, AFTER_DRAIN = false;
    float* C; int ldc;
    __device__ __forceinline__ void operator()(const f32x4 (&acc)[2][2][4][2], const Unit& u, int wr, int wc, int fr, int fq) const {
        const int row0 = u.pm * HALF + wr * 64 + fr, col0 = u.pn * BM + wc * 32 + 4 * fq;
#pragma unroll
        for (int ai = 0; ai < 2; ++ai) if (ai < u.nh)
#pragma unroll
            for (int m = 0; m < 4; ++m) { float* rowp = C + (size_t)(row0 + ai * HALF + m * 16) * ldc + col0;
#pragma unroll
                for (int bj = 0; bj < 2; ++bj)
#pragma unroll
                    for (int n = 0; n < 2; ++n) *(f32x4*)(rowp + bj * HALF + n * 16) = acc[ai][bj][m][n]; }
    }
};
template <int MODE> struct EpiMerge {
    static constexpr bool PERM = true, AFTER_DRAIN = false;
    const bf16_t* Gt; int ldg; bf16_t* Y; bf16_t* YB;
    __device__ __forceinline__ void operator()(const f32x4 (&acc)[2][2][4][2], const Unit& u, int wr, int wc, int fr, int fq) const {
        const int row0 = u.pm * HALF + wr * 64 + fr, col0 = u.pn * BM + wc * 32 + 8 * fq;
#pragma unroll
        for (int ai = 0; ai < 2; ++ai) if (ai < u.nh)
#pragma unroll
            for (int m = 0; m < 4; ++m) { const size_t r = (size_t)(row0 + ai * HALF + m * 16);
#pragma unroll
                for (int bj = 0; bj < 2; ++bj) { const int c = col0 + bj * HALF;
                    const u32x4 gw = *(const u32x4*)(Gt + r * ldg + c);
                    f32x4 g0, g1;
                    g0[0] = sigmoidf_(bf_lo(gw.x)); g0[1] = sigmoidf_(bf_hi(gw.x)); g0[2] = sigmoidf_(bf_lo(gw.y)); g0[3] = sigmoidf_(bf_hi(gw.y));
                    g1[0] = sigmoidf_(bf_lo(gw.z)); g1[1] = sigmoidf_(bf_hi(gw.z)); g1[2] = sigmoidf_(bf_lo(gw.w)); g1[3] = sigmoidf_(bf_hi(gw.w));
                    f32x4 y0 = g0 * acc[ai][bj][m][0], y1 = g1 * acc[ai][bj][m][1];
                    if (MODE != 0) { const u32x4 yw = *(const u32x4*)(Y + r * 2048 + c);
                        y0 += (f32x4){bf_lo(yw.x), bf_hi(yw.x), bf_lo(yw.y), bf_hi(yw.y)}; y1 += (f32x4){bf_lo(yw.z), bf_hi(yw.z), bf_lo(yw.w), bf_hi(yw.w)}; }
                    u32x4 w; w.x = cvt_pk_bf16(y0[0], y0[1]); w.y = cvt_pk_bf16(y0[2], y0[3]); w.z = cvt_pk_bf16(y1[0], y1[1]); w.w = cvt_pk_bf16(y1[2], y1[3]);
                    *(u32x4*)((MODE != 2 ? Y : YB) + r * 2048 + c) = w; } }
    }
};
struct EpiResid {
    static constexpr bool PERM = true, AFTER_DRAIN = false;
    float* xlat; float* xctx; const float* gate;
    const float* slat; const float* sctx;
    __device__ __forceinline__ void operator()(const f32x4 (&acc)[2][2][4][2], const Unit& u, int wr, int wc, int fr, int fq) const {
        const int vec = u.pm < 64 ? 0 : (u.pm < 128 ? 1 : 2);
        float* xb = u.pm < 128 ? xlat + (size_t)u.pm * HALF * 2048 : xctx + (size_t)(u.pm - 128) * HALF * 2048;
        const float* sb = u.pm < 128 ? slat + (size_t)u.pm * HALF * 2048 : sctx + (size_t)(u.pm - 128) * HALF * 2048;
        const int lrow0 = wr * 64 + fr, col0 = u.pn * BM + wc * 32 + 8 * fq;
        const float* gp = gate + (size_t)vec * 12288 + col0;
#pragma unroll
        for (int bj = 0; bj < 2; ++bj) { const f32x4 g0 = *(const f32x4*)(gp + bj * HALF), g1 = *(const f32x4*)(gp + bj * HALF + 4);
#pragma unroll
            for (int ai = 0; ai < 2; ++ai) if (ai < u.nh)
#pragma unroll
                for (int m = 0; m < 4; ++m) { const size_t off = (size_t)(lrow0 + ai * HALF + m * 16) * 2048 + col0 + bj * HALF; float* xp = xb + off; const float* sp = sb + off;
                    const f32x4 x0 = *(const f32x4*)sp + g0 * acc[ai][bj][m][0], x1 = *(const f32x4*)(sp + 4) + g1 * acc[ai][bj][m][1];
                    *(f32x4*)xp = x0; *(f32x4*)(xp + 4) = x1; } }
    }
};

template <class Epi, class Sched, bool ALIGN_EPI = false, bool SP2 = false, bool HALFU = false, bool I8 = false>
__device__ __forceinline__ void gemm_phase(PG8_LAS unsigned char* lds, const Gemm g, const Sched& S, const Epi& E, int wave_) {
    int tid_ = wave_ * 64 + lane_id_fresh();
    const int tid = tid_, wid = __builtin_amdgcn_readfirstlane(tid >> 6), lane = tid & 63, wr = wid >> 2, wc = wid & 3, fr = lane & 15, fq = lane >> 4;
    constexpr int ES = I8 ? 1 : 2;
    const int K = g.K, nt = K * ES / (BK * 2);
    unsigned voffA[2], voffB[2];
#pragma unroll
    for (int i = 0; i < 2; ++i) { int R, C; stage_rc(tid * 16 + i * 8192, R, C); const int Rb = Epi::PERM ? ((R & ~31) + perm32(R & 31)) : R;
        voffA[i] = (unsigned)(R * g.lda * ES + C * 2); voffB[i] = (unsigned)(Rb * g.ldb * ES + C * 2); }
    const size_t kstep = (size_t)(BK * 2);
    const size_t hstepA = (size_t)HALF * g.lda * ES, hstepB = (size_t)HALF * g.ldb * ES;
    const size_t tstepB = 2 * hstepB;
    const unsigned ldsw = (unsigned)wid * 1024u;
    const int aoff = lds_byte(wr * 64 + fr, fq * 8), boff = lds_byte(wc * 32 + fr, fq * 8);
#define PG8_SA(b, h) (((b) * 2 + (h)) * HTB)
#define PG8_SB(b, h) ((4 + (b) * 2 + (h)) * HTB)
#define PG8_STAGE(bufoff, gbase, voff) do { _Pragma("unroll") for (int _i = 0; _i < 2; ++_i) \
        __builtin_amdgcn_global_load_lds((const unsigned*)((const char*)(gbase) + (voff)[_i]), (PG8_LAS unsigned*)(lds + (bufoff) + ldsw + _i * 8192), 16, 0, 0); } while (0)
#define PG8_LDA(dst, b, h) do { _Pragma("unroll") for (int m = 0; m < 4; ++m) _Pragma("unroll") for (int k = 0; k < 2; ++k) dst[m][k] = *(const PG8_LAS bf16x8*)(lds + PG8_SA(b, h) + aoff + m * 2048 + k * 1024); } while (0)
#define PG8_LDB(dst, b, h) do { _Pragma("unroll") for (int n = 0; n < 2; ++n) _Pragma("unroll") for (int k = 0; k < 2; ++k) dst[n][k] = *(const PG8_LAS bf16x8*)(lds + PG8_SB(b, h) + boff + n * 2048 + k * 1024); } while (0)
#define PG8_MMA(ai, bj, At, Bt) do { __builtin_amdgcn_s_setprio(1); _Pragma("unroll") for (int m = 0; m < 4; ++m) _Pragma("unroll") for (int n = 0; n < 2; ++n) _Pragma("unroll") for (int k = 0; k < 2; ++k) \
        { if constexpr (I8) acc[ai][bj][m][n] = __builtin_bit_cast(f32x4, __builtin_amdgcn_mfma_i32_16x16x64_i8(__builtin_bit_cast(i32x4, Bt[n][k]), __builtin_bit_cast(i32x4, At[m][k]), __builtin_bit_cast(i32x4, acc[ai][bj][m][n]), 0, 0, 0)); \
          else acc[ai][bj][m][n] = __builtin_amdgcn_mfma_f32_16x16x32_bf16(Bt[n][k], At[m][k], acc[ai][bj][m][n], 0, 0, 0); } __builtin_amdgcn_s_setprio(0); } while (0)
#define PG8_WAIT_V(n) asm volatile("s_waitcnt vmcnt(" #n ")" ::: "memory")
#define PG8_WAIT_L(n) asm volatile("s_waitcnt lgkmcnt(" #n ")" ::: "memory")
#define PG8_BAR __builtin_amdgcn_s_barrier()
#define PG8_SCHED __builtin_amdgcn_sched_barrier(0)
    Unit cur, nxt; int ui = 0;
    if (!S.next(0, cur)) return;
    f32x4 acc[2][2][4][2];
#pragma unroll
    for (int a = 0; a < 2; ++a)
#pragma unroll
        for (int b = 0; b < 2; ++b)
#pragma unroll
            for (int m = 0; m < 4; ++m)
#pragma unroll
                for (int n = 0; n < 2; ++n) acc[a][b][m][n] = (f32x4){0.f, 0.f, 0.f, 0.f};
    bf16x8 At[4][2], B0[2][2], B1[2][2];
    const char* cA = (const char*)g.A + (size_t)cur.pm * hstepA; const char* cB = (const char*)g.Bt + (size_t)cur.pn * tstepB;
    size_t chA = (!HALFU || cur.nh == 2) ? hstepA : 0;
    S.a_ready(cur);
    if constexpr (SP2) {
        PG8_STAGE(PG8_SB(0, 0), cB, voffB); PG8_STAGE(PG8_SB(0, 1), cB + hstepB, voffB); PG8_STAGE(PG8_SA(0, 0), cA, voffA); PG8_STAGE(PG8_SA(0, 1), cA + chA, voffA);
        if (wr == 1) PG8_BAR;
        PG8_WAIT_V(2); PG8_BAR;
        PG8_STAGE(PG8_SB(1, 0), cB + kstep, voffB); PG8_STAGE(PG8_SA(1, 0), cA + kstep, voffA); PG8_STAGE(PG8_SB(1, 1), cB + hstepB + kstep, voffB);
        PG8_WAIT_V(6); PG8_BAR;
    } else {
        PG8_STAGE(PG8_SB(0, 0), cB, voffB); PG8_STAGE(PG8_SA(0, 0), cA, voffA); PG8_STAGE(PG8_SB(0, 1), cB + hstepB, voffB); PG8_STAGE(PG8_SA(0, 1), cA + chA, voffA);
        if (wr == 1) PG8_BAR;
        PG8_WAIT_V(4); PG8_BAR;
        PG8_STAGE(PG8_SB(1, 0), cB + kstep, voffB); PG8_STAGE(PG8_SA(1, 0), cA + kstep, voffA); PG8_STAGE(PG8_SB(1, 1), cB + hstepB + kstep, voffB);
        PG8_WAIT_V(6); PG8_BAR;
    }
    for (;;) {
        const bool has_next = S.next(ui + 1, nxt);
        const char* nA = has_next ? (const char*)g.A + (size_t)nxt.pm * hstepA : cA; const size_t nhA = has_next ? ((!HALFU || nxt.nh == 2) ? hstepA : 0) : chA; const bool full = (!HALFU || cur.nh == 2);
        const char* nA_ = nA; (void)nA_; const char* nB = has_next ? (const char*)g.Bt + (size_t)nxt.pn * tstepB : cB;
        for (int t = 0; t < nt; t += 2) {
            const bool last = (t == nt - 2);
            const char* a1 = cA + (size_t)(t + 1) * kstep;
            const char* a2 = last ? nA : cA + (size_t)(t + 2) * kstep; const char* b2 = last ? nB : cB + (size_t)(t + 2) * kstep;
            const char* a3 = a2 + kstep; const char* b3 = b2 + kstep;
            const size_t h2A = last ? nhA : chA;
            if (last && has_next) S.a_ready(nxt);
            if constexpr (SP2) {
            PG8_LDB(B0, 0, 0); PG8_LDB(B1, 0, 1); PG8_SCHED; PG8_LDA(At, 0, 0); PG8_STAGE(PG8_SA(1, 1), a1 + chA, voffA);
            PG8_WAIT_V(8); PG8_WAIT_L(0); PG8_BAR; PG8_MMA(0, 0, At, B0); PG8_MMA(0, 1, At, B1); PG8_BAR; PG8_SCHED;
            PG8_LDA(At, 0, 1); PG8_STAGE(PG8_SB(0, 0), b2, voffB); PG8_STAGE(PG8_SB(0, 1), b2 + hstepB, voffB); PG8_STAGE(PG8_SA(0, 0), a2, voffA);
            PG8_WAIT_V(8); PG8_WAIT_L(0); PG8_BAR; if (full) { PG8_MMA(1, 0, At, B0); PG8_MMA(1, 1, At, B1); } PG8_BAR; PG8_SCHED;
            PG8_LDB(B0, 1, 0); PG8_LDB(B1, 1, 1); PG8_SCHED; PG8_LDA(At, 1, 0); PG8_STAGE(PG8_SA(0, 1), a2 + h2A, voffA);
            PG8_WAIT_V(8); PG8_WAIT_L(0); PG8_BAR; PG8_MMA(0, 0, At, B0); PG8_MMA(0, 1, At, B1); PG8_BAR; PG8_SCHED;
            PG8_LDA(At, 1, 1); PG8_STAGE(PG8_SB(1, 0), b3, voffB); PG8_STAGE(PG8_SB(1, 1), b3 + hstepB, voffB); PG8_STAGE(PG8_SA(1, 0), a3, voffA);
            PG8_WAIT_V(8); PG8_WAIT_L(0); PG8_BAR; if (full) { PG8_MMA(1, 0, At, B0); PG8_MMA(1, 1, At, B1); } PG8_BAR; PG8_SCHED;
            } else {
            PG8_LDB(B0, 0, 0); PG8_SCHED; PG8_LDA(At, 0, 0); PG8_STAGE(PG8_SA(1, 1), a1 + chA, voffA);
            PG8_WAIT_L(8); PG8_BAR; PG8_WAIT_L(0); PG8_MMA(0, 0, At, B0); PG8_BAR; PG8_SCHED;
            PG8_LDB(B1, 0, 1); PG8_STAGE(PG8_SB(0, 0), b2, voffB);
            PG8_BAR; PG8_WAIT_L(0); PG8_MMA(0, 1, At, B1); PG8_BAR;
            PG8_LDA(At, 0, 1); PG8_STAGE(PG8_SA(0, 0), a2, voffA);
            PG8_BAR; PG8_WAIT_L(0); if (full) PG8_MMA(1, 0, At, B0); PG8_BAR; PG8_SCHED;
            PG8_STAGE(PG8_SB(0, 1), b2 + hstepB, voffB);
            PG8_WAIT_V(6); PG8_BAR; if (full) PG8_MMA(1, 1, At, B1); PG8_BAR;
            PG8_LDB(B0, 1, 0); PG8_SCHED; PG8_LDA(At, 1, 0); PG8_STAGE(PG8_SA(0, 1), a2 + h2A, voffA);
            PG8_WAIT_L(8); PG8_BAR; PG8_WAIT_L(0); PG8_MMA(0, 0, At, B0); PG8_BAR; PG8_SCHED;
            PG8_LDB(B1, 1, 1); PG8_STAGE(PG8_SB(1, 0), b3, voffB);
            PG8_BAR; PG8_WAIT_L(0); PG8_MMA(0, 1, At, B1); PG8_BAR;
            PG8_LDA(At, 1, 1); PG8_STAGE(PG8_SA(1, 0), a3, voffA);
            PG8_BAR; PG8_WAIT_L(0); if (full) PG8_MMA(1, 0, At, B0); PG8_BAR; PG8_SCHED;
            PG8_STAGE(PG8_SB(1, 1), b3 + hstepB, voffB);
            PG8_WAIT_V(6); PG8_BAR; if (full) PG8_MMA(1, 1, At, B1); PG8_BAR;
            }
        }
        if constexpr (ALIGN_EPI) { if (wr == 0) PG8_BAR; }
        if constexpr (!Epi::AFTER_DRAIN) { E(acc, cur, wr, wc, fr, fq); S.done(cur); }
        if (!has_next) break;
#pragma unroll
        for (int a = 0; a < 2; ++a)
#pragma unroll
            for (int b = 0; b < 2; ++b)
#pragma unroll
                for (int m = 0; m < 4; ++m)
#pragma unroll
                    for (int n = 0; n < 2; ++n) acc[a][b][m][n] = (f32x4){0.f, 0.f, 0.f, 0.f};
        cur = nxt; cA = nA; cB = nB; chA = nhA; ++ui;
        if constexpr (ALIGN_EPI) { if (wr == 1) PG8_BAR; }
    }
    PG8_WAIT_V(0);
    if constexpr (!ALIGN_EPI) { if (wr == 0) PG8_BAR; }
    PG8_BAR;
#undef PG8_SA
#undef PG8_SB
#undef PG8_STAGE
#undef PG8_LDA
#undef PG8_LDB
#undef PG8_MMA
#undef PG8_WAIT_V
#undef PG8_WAIT_L
#undef PG8_BAR
#undef PG8_SCHED
}
}
namespace att {
constexpr int D = 128, NW = 8, QBLK = 32, KVBLK = 64;
constexpr float SCALE = 0.088388347648318440f;
constexpr float THR = 8.f;
constexpr int LDQ = NIN, LDK = 128, LDO = NIN;
constexpr size_t SHM_V = KVBLK * D * 2, SHM_K = KVBLK * D * 2, SHM_ATTN = 2 * SHM_V + 2 * SHM_K + NW * 64 * 4;
#define KSWZ(row, colB) ((row) * 256 + ((colB) ^ (((row) & 7) << 4)))
#define SBAR() __builtin_amdgcn_sched_barrier(0)
__device__ __forceinline__ int crow(int r, int hi) { return (r & 3) + 8 * (r >> 2) + 4 * hi; }
__device__ __forceinline__ unsigned cvtpk(float lo, float hi) { unsigned r; asm volatile("v_cvt_pk_bf16_f32 %0, %1, %2" : "=v"(r) : "v"(lo), "v"(hi)); return r; }
__device__ __forceinline__ bf16x8 ld8(const bf16_t* p) { return *reinterpret_cast<const bf16x8*>(p); }

__device__ __forceinline__ void partialSM(f32x16& p0, f32x16& p1, float& m_reg, float& mn, float& alpha) {
  constexpr float C = SCALE * 1.4426950408889634f;
  float pmax = p0[0];
#pragma unroll
  for (int r = 1; r < 16; ++r) pmax = fmaxf(pmax, p0[r]);
#pragma unroll
  for (int r = 0; r < 16; ++r) pmax = fmaxf(pmax, p1[r]);
  { auto rr = __builtin_amdgcn_permlane32_swap(__float_as_uint(pmax), __float_as_uint(pmax), false, false);
    pmax = fmaxf(__uint_as_float(rr[0]), __uint_as_float(rr[1])); }
  if (__builtin_expect(__all(pmax - m_reg <= THR / SCALE), 1)) { mn = m_reg; alpha = 1.f; }
  else { mn = fmaxf(m_reg, pmax); alpha = __builtin_amdgcn_exp2f((m_reg - mn) * C); m_reg = mn; }
  float mnC = -mn * C;
#pragma unroll
  for (int r = 0; r < 16; ++r) p0[r] = fmaf(p0[r], C, mnC);
#pragma unroll
  for (int r = 0; r < 16; ++r) p1[r] = fmaf(p1[r], C, mnC);
#pragma unroll
  for (int r = 0; r < 16; ++r) p0[r] = __builtin_amdgcn_exp2f(p0[r]);
}
__device__ __forceinline__ void finishSM(f32x16& p0, f32x16& p1, float alpha, float& l_reg, bf16x8& pa0, bf16x8& pa1, bf16x8& pa2, bf16x8& pa3) {
#pragma unroll
  for (int r = 0; r < 16; ++r) p1[r] = __builtin_amdgcn_exp2f(p1[r]);
  float ps = 0;
#pragma unroll
  for (int r = 0; r < 16; ++r) ps += p0[r];
#pragma unroll
  for (int r = 0; r < 16; ++r) ps += p1[r];
  { auto rr = __builtin_amdgcn_permlane32_swap(__float_as_uint(ps), __float_as_uint(ps), false, false);
    ps = __uint_as_float(rr[0]) + __uint_as_float(rr[1]); }
  l_reg = l_reg * alpha + ps;
#define PK4(P, BASE, OUT) do { unsigned a0 = cvtpk(P[BASE + 0], P[BASE + 1]), a1 = cvtpk(P[BASE + 2], P[BASE + 3]);   \
    unsigned b0 = cvtpk(P[BASE + 4], P[BASE + 5]), b1 = cvtpk(P[BASE + 6], P[BASE + 7]);                              \
    auto r0 = __builtin_amdgcn_permlane32_swap(a0, b0, false, false); auto r1 = __builtin_amdgcn_permlane32_swap(a1, b1, false, false); \
    u32x4 w = {r0[0], r1[0], r0[1], r1[1]}; OUT = *reinterpret_cast<bf16x8*>(&w); } while (0)
  PK4(p0, 0, pa0); PK4(p0, 8, pa1); PK4(p1, 0, pa2); PK4(p1, 8, pa3);
#undef PK4
}
__device__ __forceinline__ void qkt(f32x16& p0, f32x16& p1, const bf16_t* Ks, const bf16x8* qr, int r32, int hi) {
  p0 = f32x16{}; p1 = f32x16{};
#pragma unroll
  for (int d0 = 0; d0 < 8; ++d0) { int cb = (d0 * 16 + hi * 8) * 2;
    bf16x8 b0 = *reinterpret_cast<const bf16x8*>((const char*)Ks + KSWZ(r32, cb));
    bf16x8 b1 = *reinterpret_cast<const bf16x8*>((const char*)Ks + KSWZ(32 + r32, cb));
    p0 = __builtin_amdgcn_mfma_f32_32x32x16_bf16(b0, qr[d0], p0, 0, 0, 0);
    p1 = __builtin_amdgcn_mfma_f32_32x32x16_bf16(b1, qr[d0], p1, 0, 0, 0); }
}
__device__ __forceinline__ int v_st(int k, int c) { const int kk = (k & ~0xC) | ((k & 4) << 1) | ((k & 8) >> 1); return ((kk >> 3) * 4 + (c >> 5)) * 512 + ((kk & 7) * 32 + (c & 31)) * 2; }
__device__ __forceinline__ int v_rd_base(int lane) { return ((lane & 3) << 3) | (((lane >> 2) & 3) << 6) | (((lane >> 4) & 1) << 5) | (((lane >> 5) & 1) << 8); }
constexpr int v_rd_off(int d0, int ks, int half) { return d0 * 512 + ks * 4096 + half * 2048; }
template <int OFF> __device__ __forceinline__ s16x4 tr_read(int vb) {
  s16x4 r; asm volatile("ds_read_b64_tr_b16 %0, %1 offset:%2" : "=&v"(r) : "v"(vb), "i"(OFF) : "memory"); return r;
}
template <int D0> __device__ __forceinline__ void pv_one(f32x16& od, int vb, bf16x8 pa0, bf16x8 pa1, bf16x8 pa2, bf16x8 pa3) {
  const s16x4 l0 = tr_read<v_rd_off(D0, 0, 0)>(vb), h0 = tr_read<v_rd_off(D0, 0, 1)>(vb), l1 = tr_read<v_rd_off(D0, 1, 0)>(vb), h1 = tr_read<v_rd_off(D0, 1, 1)>(vb);
  const s16x4 l2 = tr_read<v_rd_off(D0, 2, 0)>(vb), h2 = tr_read<v_rd_off(D0, 2, 1)>(vb), l3 = tr_read<v_rd_off(D0, 3, 0)>(vb), h3 = tr_read<v_rd_off(D0, 3, 1)>(vb);
  asm volatile("s_waitcnt lgkmcnt(0)" ::: "memory"); SBAR();
#define PK(L, H) (bf16x8){L[0], L[1], L[2], L[3], H[0], H[1], H[2], H[3]}
  od = __builtin_amdgcn_mfma_f32_32x32x16_bf16(pa0, PK(l0, h0), od, 0, 0, 0);
  od = __builtin_amdgcn_mfma_f32_32x32x16_bf16(pa1, PK(l1, h1), od, 0, 0, 0);
  od = __builtin_amdgcn_mfma_f32_32x32x16_bf16(pa2, PK(l2, h2), od, 0, 0, 0);
  od = __builtin_amdgcn_mfma_f32_32x32x16_bf16(pa3, PK(l3, h3), od, 0, 0, 0);
#undef PK
}
__device__ __forceinline__ void pv_d0(f32x16* o, int vb, bf16x8 pa0, bf16x8 pa1, bf16x8 pa2, bf16x8 pa3) {
  pv_one<0>(o[0], vb, pa0, pa1, pa2, pa3); pv_one<1>(o[1], vb, pa0, pa1, pa2, pa3); pv_one<2>(o[2], vb, pa0, pa1, pa2, pa3); pv_one<3>(o[3], vb, pa0, pa1, pa2, pa3);
}

__device__ __forceinline__ void attn_dense_body(const bf16_t* __restrict__ Qb, const bf16_t* __restrict__ Kh, const bf16_t* __restrict__ Vh,
                                                bf16_t* Ob, int seq, char* lds, int wave_) {
  constexpr int SDEPTH = 2;
  int tid_ = wave_ * 64 + lane_id_fresh();
  const int tid = tid_, wid = tid >> 6, lane = tid & 63, r32 = lane & 31, hi = lane >> 5;
  bf16_t* V_lds = (bf16_t*)lds; bf16_t* K_lds = (bf16_t*)(lds + 2 * SHM_V);
  float* ws = (float*)(lds + 2 * SHM_V + 2 * SHM_K) + wid * 64; float* li_l = ws; float* al_l = ws + 32;
  float m_reg = -1e30f, l_reg = 0; f32x16 o[4] = {}; bf16x8 qr[8];
  const bf16_t* Qw = Qb + (long)(wid * QBLK + r32) * LDQ + hi * 8;
#pragma unroll
  for (int d0 = 0; d0 < 8; ++d0) qr[d0] = ld8(Qw + d0 * 16);
  const int sr = tid >> 4, sc = (tid & 15) * 8, vst0 = v_st(sr, sc), vst1 = v_st(32 + sr, sc);
  const int vb0 = (int)(uintptr_t)V_lds + v_rd_base(lane);
  struct { bf16x8 vs0, vs1, ks0, ks1; } sr_[SDEPTH];
#define SLOAD(i, k0) do { sr_[i].vs0 = ld8(&Vh[(long)((k0) + sr) * LDK + sc]); sr_[i].vs1 = ld8(&Vh[(long)((k0) + 32 + sr) * LDK + sc]); \
    sr_[i].ks0 = ld8(&Kh[(long)((k0) + sr) * LDK + sc]); sr_[i].ks1 = ld8(&Kh[(long)((k0) + 32 + sr) * LDK + sc]); } while (0)
#define SWRITE(b, i) do { *(bf16x8*)((char*)V_lds + (b) * SHM_V + vst0) = sr_[i].vs0;          \
    *(bf16x8*)((char*)V_lds + (b) * SHM_V + vst1) = sr_[i].vs1; int kc = sc * 2;               \
    *(bf16x8*)((char*)K_lds + (b) * SHM_K + KSWZ(sr, kc)) = sr_[i].ks0;                       \
    *(bf16x8*)((char*)K_lds + (b) * SHM_K + KSWZ(32 + sr, kc)) = sr_[i].ks1; } while (0)
#define SWAIT() asm volatile("s_waitcnt vmcnt(4)" ::: "memory")
#define RESC(a) do { if (__any((a) < 1.f)) { if (hi == 0) al_l[r32] = (a); asm volatile("s_waitcnt lgkmcnt(0)" ::: "memory"); \
    _Pragma("unroll") for (int d = 0; d < 4; ++d) _Pragma("unroll") for (int r = 0; r < 16; ++r) o[d][r] *= al_l[crow(r, hi)]; } } while (0)
  f32x16 pA0, pA1, pB0, pB1; float mnA, mnB, alA, alB; bf16x8 pa0, pa1, pa2, pa3; const int NT = seq / KVBLK;
  constexpr int SE = 0, SO = SDEPTH - 1;
  SLOAD(SE, 0); asm volatile("s_waitcnt vmcnt(0)" ::: "memory"); SWRITE(0, SE); __syncthreads();
  qkt(pA0, pA1, K_lds, qr, r32, hi); partialSM(pA0, pA1, m_reg, mnA, alA);
  SLOAD(SO, KVBLK); if (2 < NT) SLOAD(SE, 2 * KVBLK);
  SWAIT(); SWRITE(1, SO); __syncthreads();
  for (int j = 1; j + 1 < NT; j += 2) {
    SBAR(); qkt(pB0, pB1, (bf16_t*)((char*)K_lds + SHM_K), qr, r32, hi);
    finishSM(pA0, pA1, alA, l_reg, pa0, pa1, pa2, pa3); SBAR();
    SLOAD(SO, (j + SDEPTH) * KVBLK); SBAR();
    pv_d0(o, vb0, pa0, pa1, pa2, pa3); partialSM(pB0, pB1, m_reg, mnB, alB);
    __syncthreads(); SWAIT(); SWRITE(0, SE);
    RESC(alB); __syncthreads();
    SBAR(); qkt(pA0, pA1, K_lds, qr, r32, hi);
    finishSM(pB0, pB1, alB, l_reg, pa0, pa1, pa2, pa3); SBAR();
    if (j + 3 < NT) SLOAD(SE, (j + 1 + SDEPTH) * KVBLK); SBAR();
    pv_d0(o, vb0 + (int)SHM_V, pa0, pa1, pa2, pa3); partialSM(pA0, pA1, m_reg, mnA, alA);
    __syncthreads(); SWAIT(); SWRITE(1, SO);
    RESC(alA); __syncthreads();
  }
  SBAR(); qkt(pB0, pB1, (bf16_t*)((char*)K_lds + SHM_K), qr, r32, hi);
  finishSM(pA0, pA1, alA, l_reg, pa0, pa1, pa2, pa3); SBAR();
  pv_d0(o, vb0, pa0, pa1, pa2, pa3); partialSM(pB0, pB1, m_reg, mnB, alB);
  __syncthreads(); RESC(alB);
  finishSM(pB0, pB1, alB, l_reg, pa0, pa1, pa2, pa3); SBAR();
  pv_d0(o, vb0 + (int)SHM_V, pa0, pa1, pa2, pa3);
  if (hi == 0) li_l[r32] = l_reg; asm volatile("s_waitcnt lgkmcnt(0)" ::: "memory");
  float rli[16];
#pragma unroll
  for (int r = 0; r < 16; ++r) rli[r] = __builtin_amdgcn_rcpf(li_l[crow(r, hi)]);
  bf16_t* Ow = Ob + (long)(wid * QBLK) * LDO;
#pragma unroll
  for (int r = 0; r < 16; ++r) { int orow = crow(r, hi);
#pragma unroll
    for (int d0 = 0; d0 < 4; ++d0) Ow[(long)orow * LDO + d0 * 32 + r32] = f2bf(o[d0][r] * rli[r]); }
  __syncthreads();
#undef SLOAD
#undef SWRITE
#undef SWAIT
#undef RESC
}
#undef KSWZ
#undef SBAR
}
#define CAS __attribute__((address_space(4)))
#define INP(i) ((const float*)(GAS const float*)in[i])
struct Ctx {
    float* out; unsigned char* ws;
    LAS unsigned char* lds; int tid, lane, wave, wg, G;
};
enum { I_X = 0, I_C, I_CTX, I_CCTX, I_WMOD, I_BMOD, I_NMIX, I_NFFN, I_WIN, I_QN, I_KN, I_LCW, I_LCB, I_LWA, I_LBA, I_LWX, I_LBX, I_LLAM, I_SCW, I_SCB,
       I_WOA, I_WOL, I_WOS, I_WOUT, I_PWQ, I_PK1, I_PK2, I_PU, I_PV };

__device__ __forceinline__ float* xrow_ptr(const Ctx& c, int r) {
    return r < MLAT ? c.out + (size_t)r * DM : (float*)(c.ws + WS_CTXS) + (size_t)(r - MLAT) * DM;
}

template <bool I8 = false>
__device__ __forceinline__ void transpose_item(const float* W, int K, int N, bf16_t* WT, LAS float* scr, int item, int lane, const float* cmax = nullptr, float* wdq = nullptr, LAS float* scol = nullptr) {
    const int nblk = N / 64, kb = item / nblk, nb = item % nblk, k0 = 64 * kb, n0 = 64 * nb;
    if constexpr (I8) { float mx = 0.f;
#pragma unroll 8
        for (int kc = 0; kc < 32; ++kc) mx = fmaxf(mx, cmax[(size_t)kc * N + n0 + lane]);
        scol[lane] = mx > 0.f ? 127.f / mx : 0.f;
        if (kb == 0) wdq[n0 + lane] = mx * (1.f / 127.f); }
    const float* src = W + (size_t)(k0 + (lane >> 4)) * N + n0 + (lane & 15) * 4;
    f32x4 v[16];
#pragma unroll
    for (int i = 0; i < 16; ++i) v[i] = *(const f32x4*)(src + (size_t)(4 * i) * N);
    LAS float* d = scr + (lane >> 4) * 65 + (lane & 15) * 4;
#pragma unroll
    for (int i = 0; i < 16; ++i) { d[(4 * i) * 65 + 0] = v[i][0]; d[(4 * i) * 65 + 1] = v[i][1]; d[(4 * i) * 65 + 2] = v[i][2]; d[(4 * i) * 65 + 3] = v[i][3]; }
    LDS_WAIT(); asm volatile("" ::: "memory");
    const int c = lane & 7;
#pragma unroll
    for (int j = 0; j < 8; ++j) { const int n = (lane >> 3) + 8 * j; const LAS float* s = scr + (8 * c) * 65 + n;
        if constexpr (I8) { const float q_ = scol[n]; u32x2 o; o.x = pk4_i8(s[0 * 65] * q_, s[1 * 65] * q_, s[2 * 65] * q_, s[3 * 65] * q_); o.y = pk4_i8(s[4 * 65] * q_, s[5 * 65] * q_, s[6 * 65] * q_, s[7 * 65] * q_);
            *(u32x2*)((unsigned char*)WT + (size_t)(n0 + n) * K + k0 + 8 * c) = o; }
        else { u32x4 o; o.x = cvt_pk_bf16(s[0 * 65], s[1 * 65]); o.y = cvt_pk_bf16(s[2 * 65], s[3 * 65]); o.z = cvt_pk_bf16(s[4 * 65], s[5 * 65]); o.w = cvt_pk_bf16(s[6 * 65], s[7 * 65]);
            *(u32x4*)(WT + (size_t)(n0 + n) * K + k0 + 8 * c) = o; } }
    LDS_WAIT(); asm volatile("" ::: "memory");
}

__device__ __forceinline__ void mod_unit(const Ctx& c, CAS const unsigned long long* in, int l, int cb) {
    LAS float* sv = (LAS float*)c.lds;
    LAS float* red = sv + 3 * DM;
    { const float* cc = INP(I_C); const float* cx = INP(I_CCTX);
      for (int i = c.tid; i < 3 * DM; i += NTHREADS) { const int v = i / DM, k = i % DM; const float x = v < 2 ? cc[v * DM + k] : cx[k]; sv[i] = x * sigmoidf_(x); } }
    __syncthreads();
    const int j4 = (c.tid & 31) * 4, kg = c.tid >> 5;
    const float* w = INP(I_WMOD) + (size_t)l * DM * NMOD + (size_t)(kg * 128) * NMOD + cb * 128 + j4;
    f32x4 a0 = {0.f, 0.f, 0.f, 0.f}, a1 = a0, a2 = a0;
#pragma unroll 8
    for (int k = 0; k < 128; ++k) { const f32x4 wv = *(const f32x4*)(w + (size_t)k * NMOD); const int kk = kg * 128 + k; a0 += wv * sv[kk]; a1 += wv * sv[DM + kk]; a2 += wv * sv[2 * DM + kk]; }
    *(LAS f32x4*)(red + (kg * 3 + 0) * 128 + j4) = a0; *(LAS f32x4*)(red + (kg * 3 + 1) * 128 + j4) = a1; *(LAS f32x4*)(red + (kg * 3 + 2) * 128 + j4) = a2;
    __syncthreads();
    if (c.tid < 384) { const int v = c.tid >> 7, jj = c.tid & 127; float s = INP(I_BMOD)[l * NMOD + cb * 128 + jj];
#pragma unroll
        for (int g = 0; g < 16; ++g) s += red[(g * 3 + v) * 128 + jj];
        ((float*)(c.ws + WS_MOD))[((size_t)l * 3 + v) * NMOD + cb * 128 + jj] = s; }
    __syncthreads();
}

__device__ __forceinline__ void wsc_unit(const Ctx& c, CAS const unsigned long long* in, int l, int u) {
    const int hh = u >> 4, kb = u & 15, h = hh >> 1, half = hh & 1, k0 = kb * 128;
    LAS float* kkL = (LAS float*)c.lds;
    LAS float* wqL = kkL + 128 * 132;
    const float* ksrc = INP(half ? I_PK2 : I_PK1) + ((size_t)(l * 8 + h) * 128) * 128;
    const float* qsrc = INP(I_PWQ) + (size_t)l * DM * DM + (size_t)k0 * DM + hh * 128;
    for (int i = c.tid; i < 128 * 32; i += NTHREADS) { const int r = i >> 5, c4 = (i & 31) * 4;
        *(LAS f32x4*)(kkL + r * 132 + c4) = *(const f32x4*)(ksrc + (size_t)r * 128 + c4);
        *(LAS f32x4*)(wqL + r * 132 + c4) = *(const f32x4*)(qsrc + (size_t)r * DM + c4); }
    __syncthreads();
    const int k = c.tid & 127, ng = c.tid >> 7;
    float acc[32];
#pragma unroll
    for (int j = 0; j < 32; ++j) acc[j] = 0.f;
    for (int d4 = 0; d4 < 32; ++d4) {
        const f32x4 a = *(const LAS f32x4*)(wqL + k * 132 + d4 * 4);
#pragma unroll
        for (int j = 0; j < 32; ++j) { const f32x4 b = *(const LAS f32x4*)(kkL + (ng * 32 + j) * 132 + d4 * 4); acc[j] += (a[0] * b[0] + a[1] * b[1]) + (a[2] * b[2] + a[3] * b[3]); }
    }
    bf16_t* dst = (bf16_t*)(c.ws + ws_wsc(l)) + (size_t)(hh * 128 + ng * 32) * DM + k0 + k;
#pragma unroll
    for (int j = 0; j < 32; ++j) dst[(size_t)j * DM] = f2bf(acc[j]);
    __syncthreads();
}

#define GET_IN() unsigned long long kai_ = (unsigned long long)__builtin_amdgcn_kernarg_segment_ptr(); asm volatile("" : "+s"(kai_)); CAS const unsigned long long* in = (CAS const unsigned long long*)kai_
__device__ __forceinline__ void conv_units(const Ctx& c, int l) {
    GET_IN();
    if (l == 0) for (int u = c.wg; u < 2 * 96; u += c.G) mod_unit(c, in, u / 96, u % 96);
    for (int u = c.wg; u < 256; u += c.G) wsc_unit(c, in, l, u);
}
enum { CV_WIN = 1, CV_WO = 2, CV_WOUT = 4, CV_PU = 8, CV_PV = 16, CV_LRU = 32, CV_ALL = 63 };
__device__ __forceinline__ void conv_transposes(const Ctx& c, int l, int what = CV_ALL) {
    GET_IN();
    const int gw = c.wg * NWAVES + c.wave, NGW = c.G * NWAVES;
    LAS float* scr = (LAS float*)(c.lds + c.wave * 16640);
    constexpr int I_IN = (DM / 64) * (NIN / 64), I_SQ = (DM / 64) * (DM / 64);
    const float* win = INP(I_WIN) + (size_t)l * DM * NIN;
    if (what & CV_WIN) for (int it = gw; it < I_IN; it += NGW)
        transpose_item<true>(win, DM, NIN, (bf16_t*)(c.ws + WS_WIN), scr, it, c.lane, (const float*)(c.ws + WS_CMAX) + (size_t)l * 32 * NIN, (float*)(c.ws + WS_WDQ), (LAS float*)(c.lds + 8 * 16640 + c.wave * 256));
    for (int s = 0; s < 4; ++s) { if (!(what & (s < 3 ? CV_WO : CV_WOUT))) continue;
        const float* src = INP(s == 0 ? I_WOA : s == 1 ? I_WOL : s == 2 ? I_WOS : I_WOUT) + (size_t)l * DM * DM;
        bf16_t* dst = s < 3 ? (bf16_t*)(c.ws + WS_WO) + (size_t)s * DM * DM : (bf16_t*)(c.ws + WS_WOUT);
        for (int it = gw; it < I_SQ; it += NGW) transpose_item(src, DM, DM, dst, scr, it, c.lane);
    }
}
__device__ __forceinline__ void conv_colmax(const Ctx& c) {
    GET_IN();
    const size_t gt = (size_t)c.wg * NTHREADS + c.tid, NT = (size_t)c.G * NTHREADS;
    constexpr int C4 = NIN / 4;
    for (size_t u = gt; u < (size_t)NLAYER * 32 * C4; u += NT) { const int c4 = (int)(u % C4), lk = (int)(u / C4);
        const float* src = INP(I_WIN) + (size_t)lk * 64 * NIN + c4 * 4;
        f32x4 m = {0.f, 0.f, 0.f, 0.f};
#pragma unroll 16
        for (int k = 0; k < 64; ++k) { const f32x4 v = *(const f32x4*)(src + (size_t)k * NIN); m[0] = fmaxf(m[0], fabsf(v[0])); m[1] = fmaxf(m[1], fabsf(v[1])); m[2] = fmaxf(m[2], fabsf(v[2])); m[3] = fmaxf(m[3], fabsf(v[3])); }
        *(f32x4*)((float*)(c.ws + WS_CMAX) + (size_t)lk * NIN + c4 * 4) = m; }
}
__device__ __forceinline__ void conv_tables(const Ctx& c, int l, int what = CV_ALL) {
    GET_IN();
    const size_t gt = (size_t)c.wg * NTHREADS + c.tid, NT = (size_t)c.G * NTHREADS;
    constexpr size_t NG16 = (size_t)16384 * DM / 16;
    if (what & CV_PU) {
        const int gw = c.wg * NWAVES + c.wave, NGW = c.G * NWAVES;
        const float* srcb = INP(I_PU) + (size_t)l * 16384 * DM; unsigned char* dstb = (unsigned char*)(c.ws + ws_pu(l)); float* usc = (float*)(c.ws + WS_USC) + (size_t)l * 16384;
#pragma unroll 1
        for (int e = gw; e < 16384; e += NGW) { const float* src = srcb + (size_t)e * DM + c.lane * 32;
            f32x4 v[8]; float mx = 0.f;
#pragma unroll
            for (int i = 0; i < 8; ++i) { v[i] = *(const f32x4*)(src + i * 4); mx = fmaxf(fmaxf(mx, fmaxf(fabsf(v[i][0]), fabsf(v[i][1]))), fmaxf(fabsf(v[i][2]), fabsf(v[i][3]))); }
#pragma unroll
            for (int o = 32; o > 0; o >>= 1) mx = fmaxf(mx, __shfl_xor(mx, o));
            const float q_ = mx > 0.f ? 7.f / mx : 0.f;
            if (c.lane == 0) usc[e] = mx * (1.f / 7.f);
            u32x4 o4;
#pragma unroll
            for (int d = 0; d < 4; ++d) { unsigned w_ = 0u;
#pragma unroll
                for (int t = 0; t < 4; ++t) { const unsigned lo_ = (unsigned)(int)__builtin_rintf(v[2 * d][t] * q_) & 15u, hi_ = (unsigned)(int)__builtin_rintf(v[2 * d + 1][t] * q_) & 15u; w_ |= (lo_ << (8 * t)) | (hi_ << (8 * t + 4)); }
                o4[d] = w_; }
            *(u32x4*)(dstb + (size_t)e * 1024 + c.lane * 16) = o4; } }
#pragma unroll 1
    for (int tb = 1; tb < 2; ++tb) { if (!(what & (tb ? CV_PV : CV_PU))) continue;
        const float* srcb = INP(tb ? I_PV : I_PU) + (size_t)l * 16384 * DM; unsigned char* dstb = (unsigned char*)(c.ws + (tb ? ws_pv(l) : ws_pu(l)));
        const float sc = tb ? 1.f : 32.f;
        for (size_t j = gt; j < NG16; j += 2 * NT) {
            const size_t j2 = j + NT; const bool has2 = j2 < NG16;
            f32x4 a[4], b[4];
#pragma unroll
            for (int d = 0; d < 4; ++d) a[d] = *(const f32x4*)(srcb + j * 16 + d * 4);
#pragma unroll
            for (int d = 0; d < 4; ++d) b[d] = has2 ? *(const f32x4*)(srcb + j2 * 16 + d * 4) : (f32x4){0.f, 0.f, 0.f, 0.f};
            u32x4 o, o2;
#pragma unroll
            for (int d = 0; d < 4; ++d) { const f32x4 x = a[d] * sc, y = b[d] * sc;
                int w = __builtin_amdgcn_cvt_pk_fp8_f32(x[0], x[1], 0, false); w = __builtin_amdgcn_cvt_pk_fp8_f32(x[2], x[3], w, true); o[d] = (unsigned)w;
                int w2 = __builtin_amdgcn_cvt_pk_fp8_f32(y[0], y[1], 0, false); w2 = __builtin_amdgcn_cvt_pk_fp8_f32(y[2], y[3], w2, true); o2[d] = (unsigned)w2; }
            if (tb == 0) { *(u32x4*)(dstb + j * 16) = o; if (has2) *(u32x4*)(dstb + j2 * 16) = o2; }
            else {
                *(u32x4*)(dstb + (size_t)((j & 127) >> 3) * ((size_t)16384 * 128) + (j >> 7) * 128 + (j & 7) * 16) = o;
                if (has2) *(u32x4*)(dstb + (size_t)((j2 & 127) >> 3) * ((size_t)16384 * 128) + (j2 >> 7) * 128 + (j2 & 7) * 16) = o2; } }
    }
    if (what & CV_LRU) for (size_t i = gt; i < (size_t)16 * 512 * 128; i += NT) { const int ci = (int)(i & 127), j = (int)((i >> 7) & 511), n = (int)(i >> 16), d = j >> 8, which = (j >> 7) & 1, dd = j & 127;
        const float* src = INP(which ? I_LWX : I_LWA) + ((((size_t)(l * 2 + d) * 16 + n) * 128 + ci) * 128 + dd);
        ((bf16_t*)(c.ws + WS_WLRU))[i] = f2bf(*src); }
}
__device__ __forceinline__ void sp_copy(const Ctx& c, const float* src, int sp_off, int n) {
    const size_t gt = (size_t)c.wg * NTHREADS + c.tid, NT = (size_t)c.G * NTHREADS;
    for (size_t i = gt; i < (size_t)n; i += NT) ((float*)(c.ws + WS_SP))[sp_off + i] = src[i];
}
__device__ __forceinline__ void conv_small(const Ctx& c, int l) {
    GET_IN();
    const size_t gt = (size_t)c.wg * NTHREADS + c.tid, NT = (size_t)c.G * NTHREADS;
    sp_copy(c, INP(I_NMIX) + l * DM, SP_NMIX, DM); sp_copy(c, INP(I_NFFN) + l * DM, SP_NFFN, DM);
    sp_copy(c, INP(I_QN) + l * 128, SP_QN, 128); sp_copy(c, INP(I_KN) + l * 128, SP_KN, 128);
    sp_copy(c, INP(I_LCW) + l * 4 * DM, SP_LCW, 4 * DM); sp_copy(c, INP(I_LCB) + l * DM, SP_LCB, DM);
    sp_copy(c, INP(I_LBA) + l * 2 * DM, SP_LBA, 2 * DM); sp_copy(c, INP(I_LBX) + l * 2 * DM, SP_LBX, 2 * DM);
    sp_copy(c, INP(I_SCW) + l * 3 * DM, SP_SCW, 3 * DM); sp_copy(c, INP(I_SCB) + l * DM, SP_SCB, DM);
    { const float* lam = INP(I_LLAM) + l * 2 * DM;
      for (size_t i = gt; i < (size_t)2 * DM; i += NT) ((float*)(c.ws + WS_SP))[SP_LSP + i] = 8.f * log1pf(expf(-lam[i])); }
}
__device__ __forceinline__ void conv_once(const Ctx& c) {
    const size_t gt = (size_t)c.wg * NTHREADS + c.tid, NT = (size_t)c.G * NTHREADS;
    for (size_t i = gt; i < 128 * 32; i += NT) { const int pos = (int)(i >> 5), p = (int)(i & 31);
        const float inv = exp2f(-(float)p * (13.287712379549449f / 32.f)); const float ang = (float)pos * inv;
        float sn, cs; sincosf(ang, &sn, &cs);
        ((float*)(c.ws + WS_ROPE))[i] = cs; ((float*)(c.ws + WS_ROPE))[128 * 32 + i] = sn; }
}

template <bool I8 = false>
__device__ __forceinline__ void phase_norm(const Ctx& c, int l, int nrows, int sp_gain, int slot_shift, const float* xin = nullptr, const float* cin = nullptr) {
    const int gw = c.wg * NWAVES + c.wave, NGW = c.G * NWAVES;
    const float* modl = (const float*)(c.ws + WS_MOD) + (size_t)l * 3 * NMOD;
    bf16_t* HX = (bf16_t*)(c.ws + WS_HX); const float* gain = (const float*)(c.ws + WS_SP) + sp_gain;
    for (int r = gw; r < nrows; r += NGW) {
        const int vec = r < SEQ ? 0 : (r < MLAT ? 1 : 2);
        const float* xr = xin ? (r < MLAT ? xin + (size_t)r * DM : cin + (size_t)(r - MLAT) * DM) : xrow_ptr(c, r); const float* sh = modl + (size_t)vec * NMOD + slot_shift * DM; const float* sc = sh + DM;
        f32x4 v[8]; float ss = 0.f;
#pragma unroll
        for (int j = 0; j < 8; ++j) { v[j] = *(const f32x4*)(xr + j * 256 + c.lane * 4); ss += (v[j][0] * v[j][0] + v[j][1] * v[j][1]) + (v[j][2] * v[j][2] + v[j][3] * v[j][3]); }
        const float rs = rsqrtf(wave_sum(ss) * (1.f / DM) + EPS);
        if constexpr (I8) { float mx = 0.f;
#pragma unroll
            for (int j = 0; j < 8; ++j) { const int col = j * 256 + c.lane * 4;
                const f32x4 g = *(const f32x4*)(gain + col), s1 = *(const f32x4*)(sc + col), s0 = *(const f32x4*)(sh + col);
                v[j] = (v[j] * rs * g) * (s1 + 1.f) + s0;
                mx = fmaxf(fmaxf(mx, fmaxf(fabsf(v[j][0]), fabsf(v[j][1]))), fmaxf(fabsf(v[j][2]), fabsf(v[j][3]))); }
#pragma unroll
            for (int o = 32; o > 0; o >>= 1) mx = fmaxf(mx, __shfl_xor(mx, o));
            const float q_ = mx > 0.f ? 127.f / mx : 0.f;
            if (c.lane == 0) ((float*)(c.ws + WS_ADQ))[r] = mx * (1.f / 127.f);
#pragma unroll
            for (int j = 0; j < 8; ++j) *(unsigned*)((unsigned char*)HX + (size_t)r * DM + j * 256 + c.lane * 4) = pk4_i8(v[j][0] * q_, v[j][1] * q_, v[j][2] * q_, v[j][3] * q_);
        } else {
#pragma unroll
        for (int j = 0; j < 8; ++j) { const int col = j * 256 + c.lane * 4;
            const f32x4 g = *(const f32x4*)(gain + col), s1 = *(const f32x4*)(sc + col), s0 = *(const f32x4*)(sh + col);
            const f32x4 y = (v[j] * rs * g) * (s1 + 1.f) + s0;
            u32x2 o; o.x = cvt_pk_bf16(y[0], y[1]); o.y = cvt_pk_bf16(y[2], y[3]);
            *(u32x2*)(HX + (size_t)r * DM + col) = o; } }
    }
}
__device__ __forceinline__ void seg_of_row(int r, bool& is_ctx, int& b, int& t) {
    is_ctx = r >= MLAT; b = is_ctx ? (r - MLAT) >> 8 : r >> 13; t = is_ctx ? (r - MLAT) & 255 : r & (SEQ - 1);
}
__device__ __forceinline__ void qk_row(const Ctx& c, int l, int r, bool do_q, bool dry) {
    bool is_ctx; int b, t; seg_of_row(r, is_ctx, b, t);
    const int key = is_ctx ? t : CTXL + t;
    bf16_t* prow = (bf16_t*)(c.ws + WS_P) + (size_t)r * NIN;
    bf16_t* KC = (bf16_t*)(c.ws + WS_KC); bf16_t* VC = (bf16_t*)(c.ws + WS_VC);
    const int hs = c.lane >> 4, ax = (c.lane >> 3) & 1, p0 = (c.lane & 7) * 4;
    f32x4 cs = {1.f, 1.f, 1.f, 1.f}, sn = {0.f, 0.f, 0.f, 0.f};
    if (!is_ctx) { const int pos = ax ? (t & 63) : (t >> 6); const float* rt = (const float*)(c.ws + WS_ROPE) + pos * 32 + p0; cs = *(const f32x4*)rt; sn = *(const f32x4*)(rt + 128 * 32); }
    u32x2 w1[5], w2[5];
#pragma unroll
    for (int g = 0; g < 5; ++g) { const bool is_k = (g == 4); const int head = is_k ? hs : g * 4 + hs;
        const bf16_t* src = prow + (is_k ? CK : CQ) + head * 128 + ax * 64 + p0;
        if (is_k || do_q) { w1[g] = *(const u32x2*)src; w2[g] = *(const u32x2*)(src + 32); } else { w1[g] = (u32x2){0u, 0u}; w2[g] = (u32x2){0u, 0u}; } }
    const u32x4 vw = *(const u32x4*)(prow + CV + (c.lane >> 4) * 128 + (c.lane & 15) * 8);
#pragma unroll
    for (int g = 0; g < 5; ++g) {
        const bool is_k = (g == 4);
        if (!is_k && !do_q) continue;
        const int head = is_k ? hs : g * 4 + hs;
        bf16_t* src = prow + (is_k ? CK : CQ) + head * 128 + ax * 64 + p0;
        f32x4 t1 = {bf_lo(w1[g].x), bf_hi(w1[g].x), bf_lo(w1[g].y), bf_hi(w1[g].y)}, t2 = {bf_lo(w2[g].x), bf_hi(w2[g].x), bf_lo(w2[g].y), bf_hi(w2[g].y)};
        float ss = (t1[0] * t1[0] + t1[1] * t1[1]) + (t1[2] * t1[2] + t1[3] * t1[3]) + (t2[0] * t2[0] + t2[1] * t2[1]) + (t2[2] * t2[2] + t2[3] * t2[3]);
        ss += DPPF(ss, 0xB1); ss += DPPF(ss, 0x4E); ss += DPPF(ss, 0x141); ss += DPPF(ss, 0x140);
        const float rs = rsqrtf(ss * (1.f / 128.f) + EPS);
        const float* gn = (const float*)(c.ws + WS_SP) + (is_k ? SP_KN : SP_QN) + ax * 64 + p0;
        const f32x4 g1 = *(const f32x4*)gn, g2 = *(const f32x4*)(gn + 32);
        const f32x4 y1 = t1 * rs * g1, y2 = t2 * rs * g2;
        const f32x4 o1 = y1 * cs - y2 * sn, o2 = y2 * cs + y1 * sn;
        bf16_t* dst = is_k ? KC + ((size_t)(b * 4 + head) * NKEY + key) * 128 + ax * 64 + p0 : (dry ? (bf16_t*)(c.ws + WS_YF) + (size_t)r * DM + head * 128 + ax * 64 + p0 : src);
        u32x2 a; a.x = cvt_pk_bf16(o1[0], o1[1]); a.y = cvt_pk_bf16(o1[2], o1[3]);
        u32x2 bq; bq.x = cvt_pk_bf16(o2[0], o2[1]); bq.y = cvt_pk_bf16(o2[2], o2[3]);
        *(u32x2*)dst = a; *(u32x2*)(dst + 32) = bq;
    }
    { const int hv = c.lane >> 4, dd = (c.lane & 15) * 8;
      *(u32x4*)(VC + ((size_t)(b * 4 + hv) * NKEY + key) * 128 + dd) = vw; }
}
__device__ __forceinline__ void unpack8(const u32x4 w, float (&f)[8]) {
    f[0] = bf_lo(w.x); f[1] = bf_hi(w.x); f[2] = bf_lo(w.y); f[3] = bf_hi(w.y); f[4] = bf_lo(w.z); f[5] = bf_hi(w.z); f[6] = bf_lo(w.w); f[7] = bf_hi(w.w);
}
__device__ __forceinline__ void sc_row(const Ctx& c, int l, int r, bool dry) {
    bool is_ctx; int b, t; seg_of_row(r, is_ctx, b, t);
    const int seglen = is_ctx ? CTXL : SEQ;
    bf16_t* prow = (bf16_t*)(c.ws + WS_P) + (size_t)r * NIN;
    const bool hp = t > 0, hn = t < seglen - 1;
    const float* w = (const float*)(c.ws + WS_SP) + SP_SCW; const float* bias = (const float*)(c.ws + WS_SP) + SP_SCB;
    u32x4 xb[4], xc0[4], xu0[4], xcp[4], xup[4], xcn[4], xun[4];
    const u32x4 z = {0u, 0u, 0u, 0u};
#pragma unroll
    for (int it = 0; it < 4; ++it) { const int col = it * 512 + c.lane * 8;
        xb[it] = *(const u32x4*)(prow + CBG + col); xc0[it] = *(const u32x4*)(prow + CCG + col); xu0[it] = *(const u32x4*)(prow + CU + col);
        xcp[it] = hp ? *(const u32x4*)(prow - NIN + CCG + col) : z; xup[it] = hp ? *(const u32x4*)(prow - NIN + CU + col) : z;
        xcn[it] = hn ? *(const u32x4*)(prow + NIN + CCG + col) : z; xun[it] = hn ? *(const u32x4*)(prow + NIN + CU + col) : z; }
#pragma unroll
    for (int it = 0; it < 4; ++it) {
        const int col = it * 512 + c.lane * 8;
        float bg[8], c0[8], u0[8], cp[8], up[8], cn[8], un[8];
        unpack8(xb[it], bg); unpack8(xc0[it], c0); unpack8(xu0[it], u0); unpack8(xcp[it], cp); unpack8(xup[it], up); unpack8(xcn[it], cn); unpack8(xun[it], un);
        float o[8];
#pragma unroll
        for (int hq = 0; hq < 2; ++hq) { const f32x4 w0 = *(const f32x4*)(w + col + hq * 4), w1 = *(const f32x4*)(w + DM + col + hq * 4), w2 = *(const f32x4*)(w + 2 * DM + col + hq * 4), bi = *(const f32x4*)(bias + col + hq * 4);
#pragma unroll
            for (int e = 0; e < 4; ++e) { const int k = hq * 4 + e; o[k] = bg[k] * (bi[e] + w0[e] * (cp[k] * up[k]) + w1[e] * (c0[k] * u0[k]) + w2[e] * (cn[k] * un[k])); } }
        u32x4 ow; ow.x = cvt_pk_bf16(o[0], o[1]); ow.y = cvt_pk_bf16(o[2], o[3]); ow.z = cvt_pk_bf16(o[4], o[5]); ow.w = cvt_pk_bf16(o[6], o[7]);
        *(u32x4*)((dry ? (bf16_t*)(c.ws + WS_YF) + (size_t)(MALL + r) * DM : prow + CBG) + col) = ow;
    }
}

constexpr size_t lsum_idx(int which, int dir, int b, int j) { return ((((size_t)which * 2 + dir) * NB + b) * NCHUNK + j) * DM; }
template <int DIR, int PASS>
__device__ __forceinline__ void lru_chunk(const LAS bf16_t* ub, const LAS float* uf, LAS float* hsd, const bf16x8 (&bfr)[4][4], const float (&ba)[2], const float (&bx)[2], const float (&sp8)[2],
                                          const float (&cin)[2], float (&Atot)[2], float (&Hend)[2], int q, int col16, int quad) {
    float st[2] = {cin[0], cin[1]}, at[2] = {1.f, 1.f};
    const int mysg = DIR ? 3 - quad : quad;
    for (int smt = 0; smt < 4; ++smt) {
        const int mt = DIR ? 3 - smt : smt;
        f32x4 acc[4];
#pragma unroll
        for (int nt = 0; nt < 4; ++nt) acc[nt] = (f32x4){0.f, 0.f, 0.f, 0.f};
#pragma unroll
        for (int ks = 0; ks < 4; ++ks) { const bf16x8 a = *(const LAS bf16x8*)(ub + (mt * 16 + col16) * 136 + ks * 32 + quad * 8);
#pragma unroll
            for (int nt = 0; nt < 4; ++nt) acc[nt] = __builtin_amdgcn_mfma_f32_16x16x32_bf16(a, bfr[nt][ks], acc[nt], 0, 0, 0); }
#pragma unroll
        for (int ct = 0; ct < 2; ++ct) {
            const int ch = q * 32 + ct * 16 + col16;
            float av[4], dv[4];
#pragma unroll
            for (int reg = 0; reg < 4; ++reg) { const int tl = mt * 16 + quad * 4 + reg;
                const float r = sigmoidf_(acc[ct][reg] + ba[ct]), ig = sigmoidf_(acc[2 + ct][reg] + bx[ct]);
                const float a = __expf(-sp8[ct] * r);
                av[reg] = a; dv[reg] = __builtin_amdgcn_sqrtf(fmaxf(1.f - a * a, 0.f)) * ig * uf[tl * 132 + ch]; }
            float Al = 1.f, Hl = 0.f;
#pragma unroll
            for (int sr = 0; sr < 4; ++sr) { const int reg = DIR ? 3 - sr : sr; Hl = av[reg] * Hl + dv[reg]; Al *= av[reg]; }
            float se = st[ct], so = st[ct], ap = 1.f;
#pragma unroll
            for (int sg = 0; sg < 4; ++sg) { const int qp = DIR ? 3 - sg : sg; const float Ag = __shfl(Al, col16 + 16 * qp), Hg = __shfl(Hl, col16 + 16 * qp);
                const float nx = Ag * so + Hg; so = nx; if (sg < mysg) se = nx; ap *= Ag; }
            if (PASS == 2) { float h = se;
#pragma unroll
                for (int sr = 0; sr < 4; ++sr) { const int reg = DIR ? 3 - sr : sr; h = av[reg] * h + dv[reg]; hsd[(mt * 16 + quad * 4 + reg) * 132 + ch] = h; } }
            else at[ct] *= ap;
            st[ct] = so;
        }
    }
    Atot[0] = at[0]; Atot[1] = at[1]; Hend[0] = st[0]; Hend[1] = st[1];
}

template <int PASS>
__device__ __forceinline__ void lru_run(const Ctx& c, int l, int unit, bool dry = false) {
    const int b = unit >> 7, n = (unit >> 3) & 15, run = unit & 7;
    const int c0 = run * 16 + (run < 4 ? run : 4), len = 16 + (run < 4 ? 1 : 0);
    LAS float* xl = (LAS float*)c.lds;
    LAS float* uf = (LAS float*)(c.lds + 34816);
    LAS bf16_t* ub = (LAS bf16_t*)(c.lds + 34816 + 33792);
    LAS float* car = (LAS float*)(c.lds + 34816 + 33792 + 17408);
    LAS float* hsr = (LAS float*)(c.lds + 34816 + 33792 + 17408 + 17408);
    const int d = c.wave >> 2, q = c.wave & 3, col16 = c.lane & 15, quad = c.lane >> 4;
    float* LS = (float*)(c.ws + WS_LSUM);
    bf16_t* P = (bf16_t*)(c.ws + WS_P);
    bf16x8 bfr[4][4];
#pragma unroll
    for (int nt = 0; nt < 4; ++nt) { const int j = d * 256 + (nt >> 1) * 128 + q * 32 + (nt & 1) * 16 + col16;
#pragma unroll
        for (int ks = 0; ks < 4; ++ks) bfr[nt][ks] = *(const bf16x8*)((const bf16_t*)(c.ws + WS_WLRU) + ((size_t)(n * 512 + j) * 128 + ks * 32 + quad * 8)); }
    float ba[2], bx[2], sp8[2];
#pragma unroll
    for (int ct = 0; ct < 2; ++ct) { const int cidx = n * 128 + q * 32 + ct * 16 + col16; const float* sp = (const float*)(c.ws + WS_SP) + d * DM + cidx;
        ba[ct] = sp[SP_LBA]; bx[ct] = sp[SP_LBX]; sp8[ct] = sp[SP_LSP]; }
    if (PASS == 2) {
        if (c.tid < 256) { const int dir = c.tid >> 7, ch = c.tid & 127, cidx = n * 128 + ch; float st = 0.f;
#pragma unroll 1
            for (int k0 = 0; k0 < NCHUNK; k0 += 12) {
                float av[12], hv[12];
#pragma unroll
                for (int kk = 0; kk < 12; ++kk) { const int k = k0 + kk, j = dir ? (k < 4 ? 3 - k : 135 - k) : k; av[kk] = LS[lsum_idx(0, dir, b, j) + cidx]; hv[kk] = LS[lsum_idx(1, dir, b, j) + cidx]; }
#pragma unroll
                for (int kk = 0; kk < 12; ++kk) { const int k = k0 + kk, j = dir ? (k < 4 ? 3 - k : 135 - k) : k;
                    if (j >= c0 && j < c0 + len) car[(dir * 17 + (j - c0)) * 128 + ch] = st;
                    st = av[kk] * st + hv[kk]; } } }
        __syncthreads();
    }
    const float* cw = (const float*)(c.ws + WS_SP) + SP_LCW + n * 128; const float* cb = (const float*)(c.ws + WS_SP) + SP_LCB + n * 128;
#define LRU_GEOM(ci_, jc, is_ctx, rb, t0, seglen) const int jc = c0 + (ci_); const bool is_ctx = jc < 4; \
        const int rb = is_ctx ? MLAT + b * CTXL : b * SEQ, t0 = is_ctx ? jc * 64 : (jc - 4) * 64, seglen = is_ctx ? CTXL : SEQ
#define LRU_LOAD(ci_, XR, LG) do { LRU_GEOM(ci_, jc_, ic_, rb_, t0_, sl_); (void)ic_; \
        _Pragma("unroll") for (int ps = 0; ps < 3; ++ps) { const int i = ps * 32 + (c.tid >> 4); const int t = t0_ - 2 + i; XR[ps] = (u32x4){0u, 0u, 0u, 0u}; \
            if (i < 68 && t >= 0 && t < sl_) XR[ps] = *(const u32x4*)(P + (size_t)(rb_ + t) * NIN + CLX + n * 128 + (c.tid & 15) * 8); } \
        if (PASS == 2) { const bf16_t* gp_ = P + (size_t)(rb_ + t0_ + (c.tid >> 3)) * NIN + CLG + n * 128 + (c.tid & 7) * 16; LG[0] = *(const u32x4*)gp_; LG[1] = *(const u32x4*)(gp_ + 8); } } while (0)
    u32x4 xr[3], lgc[2] = {{0u, 0u, 0u, 0u}, {0u, 0u, 0u, 0u}}, lgn[2] = {{0u, 0u, 0u, 0u}, {0u, 0u, 0u, 0u}};
    LRU_LOAD(0, xr, lgn);
    for (int ci = 0; ci < len; ++ci) {
        LRU_GEOM(ci, jc, is_ctx, rb, t0, seglen); (void)is_ctx; (void)seglen;
#pragma unroll
        for (int ps = 0; ps < 3; ++ps) { const int i = ps * 32 + (c.tid >> 4);
            if (i < 68) { float f[8]; unpack8(xr[ps], f);
                *(LAS f32x4*)(xl + i * 128 + (c.tid & 15) * 8) = (f32x4){f[0], f[1], f[2], f[3]}; *(LAS f32x4*)(xl + i * 128 + (c.tid & 15) * 8 + 4) = (f32x4){f[4], f[5], f[6], f[7]}; } }
        lgc[0] = lgn[0]; lgc[1] = lgn[1];
        __syncthreads();
        if (ci + 1 < len) LRU_LOAD(ci + 1, xr, lgn);
        { const int ch = c.tid & 127, tq = c.tid >> 7; const float w0 = cw[ch], w1 = cw[DM + ch], w2 = cw[2 * DM + ch], w3 = cw[3 * DM + ch], bb = cb[ch];
#pragma unroll 4
          for (int tt = 0; tt < 16; ++tt) { const int tl = tq * 16 + tt;
              const float u = bb + w0 * xl[tl * 128 + ch] + w1 * xl[(tl + 1) * 128 + ch] + w2 * xl[(tl + 2) * 128 + ch] + w3 * xl[(tl + 3) * 128 + ch];
              uf[tl * 132 + ch] = u; ub[tl * 136 + ch] = f2bf(u); } }
        __syncthreads();
        float cin[2] = {0.f, 0.f}, At[2], He[2];
        if (PASS == 2) { cin[0] = car[(d * 17 + ci) * 128 + q * 32 + col16]; cin[1] = car[(d * 17 + ci) * 128 + q * 32 + 16 + col16]; }
        if (d == 0) lru_chunk<0, PASS>(ub, uf, xl, bfr, ba, bx, sp8, cin, At, He, q, col16, quad);
        else lru_chunk<1, PASS>(ub, uf, hsr, bfr, ba, bx, sp8, cin, At, He, q, col16, quad);
        if (PASS == 1) {
            if (quad == 0) {
#pragma unroll
                for (int ct = 0; ct < 2; ++ct) { const int cidx = n * 128 + q * 32 + ct * 16 + col16;
                    LS[lsum_idx(0, d, b, jc) + cidx] = At[ct]; LS[lsum_idx(1, d, b, jc) + cidx] = He[ct]; } }
            __syncthreads();
        } else {
            __syncthreads();
            { const int row = c.tid >> 3, cs = (c.tid & 7) * 16;
              bf16_t* gp = P + (size_t)(rb + t0 + row) * NIN + CLG + n * 128 + cs;
#pragma unroll
              for (int hseg = 0; hseg < 2; ++hseg) { float g[8]; unpack8(lgc[hseg], g);
                  const int o = row * 132 + cs + hseg * 8;
                  const f32x4 h0 = *(const LAS f32x4*)(xl + o) + *(const LAS f32x4*)(hsr + o), h1 = *(const LAS f32x4*)(xl + o + 4) + *(const LAS f32x4*)(hsr + o + 4);
                  u32x4 ow; ow.x = cvt_pk_bf16(h0[0] * gelu_tanh(g[0]), h0[1] * gelu_tanh(g[1])); ow.y = cvt_pk_bf16(h0[2] * gelu_tanh(g[2]), h0[3] * gelu_tanh(g[3]));
                  ow.z = cvt_pk_bf16(h1[0] * gelu_tanh(g[4]), h1[1] * gelu_tanh(g[5])); ow.w = cvt_pk_bf16(h1[2] * gelu_tanh(g[6]), h1[3] * gelu_tanh(g[7]));
                  *(u32x4*)((dry ? gp - CLG + CU : gp) + hseg * 8) = ow; } }
            __syncthreads();
        }
    }
#undef LRU_GEOM
#undef LRU_LOAD
}

__device__ __forceinline__ void phase_qk(const Ctx& c, int l, bool dry = false) {
    const int gw = c.wg * NWAVES + c.wave, NGW = c.G * NWAVES;
    for (int r = gw; r < MALL; r += NGW) qk_row(c, l, r, l == 0 || r < MLAT, dry);
}
__device__ __forceinline__ void sc_block8(const Ctx& c, int r0, bool dry) {
    const int t0 = r0 & (SEQ - 1);
    bf16_t* prow0 = (bf16_t*)(c.ws + WS_P) + (size_t)r0 * NIN;
    const float* w = (const float*)(c.ws + WS_SP) + SP_SCW; const float* bias = (const float*)(c.ws + WS_SP) + SP_SCB;
    const u32x4 z = {0u, 0u, 0u, 0u};
#pragma unroll 1
    for (int it = 0; it < 4; ++it) {
        const int col = it * 512 + c.lane * 8;
        float w0[8], w1[8], w2[8], bi[8];
#pragma unroll
        for (int hq = 0; hq < 2; ++hq) { const f32x4 a = *(const f32x4*)(w + col + hq * 4), b = *(const f32x4*)(w + DM + col + hq * 4), d = *(const f32x4*)(w + 2 * DM + col + hq * 4), e = *(const f32x4*)(bias + col + hq * 4);
#pragma unroll
            for (int k = 0; k < 4; ++k) { w0[hq * 4 + k] = a[k]; w1[hq * 4 + k] = b[k]; w2[hq * 4 + k] = d[k]; bi[hq * 4 + k] = e[k]; } }
        u32x4 xc[10], xu[10], xb[8];
#pragma unroll
        for (int j = 0; j < 10; ++j) { const int t = t0 - 1 + j; const bool in = t >= 0 && t < SEQ; const bf16_t* pr = prow0 + (ptrdiff_t)(j - 1) * NIN;
            xc[j] = in ? *(const u32x4*)(pr + CCG + col) : z; xu[j] = in ? *(const u32x4*)(pr + CU + col) : z; }
#pragma unroll
        for (int j = 0; j < 8; ++j) xb[j] = *(const u32x4*)(prow0 + (size_t)j * NIN + CBG + col);
        float zp[8], zc[8];
        { float a[8], b[8]; unpack8(xc[0], a); unpack8(xu[0], b);
#pragma unroll
          for (int k = 0; k < 8; ++k) zp[k] = a[k] * b[k];
          unpack8(xc[1], a); unpack8(xu[1], b);
#pragma unroll
          for (int k = 0; k < 8; ++k) zc[k] = a[k] * b[k]; }
#pragma unroll
        for (int j = 0; j < 8; ++j) {
            float a[8], b[8], bg[8], zn[8], o[8]; unpack8(xc[j + 2], a); unpack8(xu[j + 2], b); unpack8(xb[j], bg);
#pragma unroll
            for (int k = 0; k < 8; ++k) { zn[k] = a[k] * b[k]; o[k] = bg[k] * (bi[k] + w0[k] * zp[k] + w1[k] * zc[k] + w2[k] * zn[k]); zp[k] = zc[k]; zc[k] = zn[k]; }
            u32x4 ow; ow.x = cvt_pk_bf16(o[0], o[1]); ow.y = cvt_pk_bf16(o[2], o[3]); ow.z = cvt_pk_bf16(o[4], o[5]); ow.w = cvt_pk_bf16(o[6], o[7]);
            *(u32x4*)((dry ? (bf16_t*)(c.ws + WS_YF) + (size_t)(MALL + r0 + j) * DM : prow0 + (size_t)j * NIN + CBG) + col) = ow; }
    }
}
__device__ __forceinline__ void phase_sc(const Ctx& c, int l, bool dry = false) {
    const int gw = c.wg * NWAVES + c.wave, NGW = c.G * NWAVES;
    for (int r0 = gw * 8; r0 < MLAT; r0 += NGW * 8) sc_block8(c, r0, dry);
    if (l == 0) for (int r = MLAT + gw; r < MALL; r += NGW) sc_row(c, l, r, dry);
}
__device__ __forceinline__ void phase_lru1(const Ctx& c, int l) {
    for (int u = c.wg; u < 256; u += c.G) lru_run<1>(c, l, u);
}

__device__ __forceinline__ void phase_m2(const Ctx& c, int l, bool dry = false) {
    bf16_t* P = (bf16_t*)(c.ws + WS_P); const bf16_t* KC = (const bf16_t*)(c.ws + WS_KC); const bf16_t* VC = (const bf16_t*)(c.ws + WS_VC);
    const int ntot = 1024 + (l == 0 ? 32 : 0);
    for (int i = 0; i * c.G + c.wg < ntot; ++i) {
        const int L = i * c.G + c.wg; int b, h, seq; size_t qrow;
        if (L < 1024) { int grp, qb;
            if (c.G == 256) { grp = i * 8 + (c.wg & 7); qb = c.wg >> 3; } else { grp = L >> 5; qb = L & 31; }
            b = grp >> 4; h = grp & 15; qrow = (size_t)(b * SEQ + qb * 256); seq = NKEY; }
        else { const int u = L - 1024; b = u >> 4; h = u & 15; qrow = (size_t)(MLAT + b * CTXL); seq = CTXL; }
        bf16_t* q = P + qrow * NIN + CQ + h * 128;
        const size_t kvo = (size_t)(b * 4 + (h >> 2)) * NKEY * 128;
        att::attn_dense_body(q, KC + kvo, VC + kvo, dry ? q - CQ + CCG : q, seq, (char*)c.lds, c.wave);
    }
}
__device__ __forceinline__ void phase_lru2(const Ctx& c, int l, bool dry = false) {
    for (int u = c.wg; u < 256; u += c.G) lru_run<2>(c, l, u, dry);
}
constexpr float NEGBIG = -3.0e38f;
constexpr float PU_SCALE = 32.f;
__device__ __forceinline__ float wave_max_dpp(float v) {
    v = fmaxf(v, DPPF(v, 0xB1)); v = fmaxf(v, DPPF(v, 0x4E)); v = fmaxf(v, DPPF(v, 0x141)); v = fmaxf(v, DPPF(v, 0x140));
    const float a = __int_as_float(__builtin_amdgcn_readlane(__float_as_int(v), 0)), b = __int_as_float(__builtin_amdgcn_readlane(__float_as_int(v), 16));
    const float c = __int_as_float(__builtin_amdgcn_readlane(__float_as_int(v), 32)), d = __int_as_float(__builtin_amdgcn_readlane(__float_as_int(v), 48));
    return fmaxf(fmaxf(a, b), fmaxf(c, d));
}
#define SWZ_XOR(v, m) __int_as_float(__builtin_amdgcn_ds_swizzle(__float_as_int(v), ((m) << 10) | 0x1F))
__device__ __forceinline__ unsigned fkey(float x) { const unsigned u = __float_as_uint(x); return (u & 0x80000000u) ? ~u : (u | 0x80000000u); }
#define DPPU(v, ctrl) ((unsigned)__builtin_amdgcn_update_dpp(0, (int)(v), ctrl, 0xF, 0xF, true))
__device__ __forceinline__ unsigned wave_max_u32(unsigned v) {
    v = max(v, DPPU(v, 0xB1)); v = max(v, DPPU(v, 0x4E)); v = max(v, DPPU(v, 0x141)); v = max(v, DPPU(v, 0x140));
    const unsigned a = (unsigned)__builtin_amdgcn_readlane((int)v, 0), b = (unsigned)__builtin_amdgcn_readlane((int)v, 16), c = (unsigned)__builtin_amdgcn_readlane((int)v, 32), d = (unsigned)__builtin_amdgcn_readlane((int)v, 48);
    return max(max(a, b), max(c, d));
}
__device__ __forceinline__ unsigned topk16_keys2(unsigned k0, unsigned k1, int lane) {
    unsigned res = 0u;
    for (int it = 0; it < 16; ++it) { const unsigned m = wave_max_u32(max(k0, k1)); k0 = (k0 == m) ? 0u : k0; k1 = (k1 == m) ? 0u : k1; res = (lane == it) ? m : res; }
    return res;
}
__device__ __forceinline__ unsigned topk16_keys1(unsigned k0, int lane) {
    unsigned res = 0u;
    for (int it = 0; it < 16; ++it) { const unsigned m = wave_max_u32(k0); k0 = (k0 == m) ? 0u : k0; res = (lane == it) ? m : res; }
    return res;
}
__device__ __forceinline__ void unpack_fp8x16(const u32x4 w, float (&f)[16]) {
#pragma unroll
    for (int d = 0; d < 4; ++d) { const f32x2 lo = __builtin_amdgcn_cvt_pk_f32_fp8((int)w[d], false), hi = __builtin_amdgcn_cvt_pk_f32_fp8((int)w[d], true);
        f[4 * d] = lo.x; f[4 * d + 1] = lo.y; f[4 * d + 2] = hi.x; f[4 * d + 3] = hi.y; }
}

__device__ __forceinline__ unsigned half_max_u32(unsigned v, bool hi_half) {
    v = max(v, DPPU(v, 0xB1)); v = max(v, DPPU(v, 0x4E)); v = max(v, DPPU(v, 0x141)); v = max(v, DPPU(v, 0x140));
    const unsigned a = max((unsigned)__builtin_amdgcn_readlane((int)v, 0), (unsigned)__builtin_amdgcn_readlane((int)v, 16));
    const unsigned b = max((unsigned)__builtin_amdgcn_readlane((int)v, 32), (unsigned)__builtin_amdgcn_readlane((int)v, 48));
    return hi_half ? b : a;
}
__device__ __forceinline__ unsigned topk16_half4(unsigned (&k)[4], int hl, bool hi_half) {
    unsigned res = 0u;
    for (int it = 0; it < 16; ++it) { const unsigned m = half_max_u32(max(max(k[0], k[1]), max(k[2], k[3])), hi_half);
#pragma unroll
        for (int j = 0; j < 4; ++j) k[j] = (k[j] == m) ? 0u : k[j];
        res = (hl == it) ? m : res; }
    return res;
}
__device__ __forceinline__ unsigned topk16_half2(unsigned k0, unsigned k1, int hl, bool hi_half) {
    unsigned res = 0u;
    for (int it = 0; it < 16; ++it) { const unsigned m = half_max_u32(max(k0, k1), hi_half); k0 = (k0 == m) ? 0u : k0; k1 = (k1 == m) ? 0u : k1; res = (hl == it) ? m : res; }
    return res;
}
__device__ __forceinline__ void cand_ab(int cidx50, int& a, int& b) {
    a = cidx50 < 16 ? 0 : cidx50 < 24 ? 1 : cidx50 < 29 ? 2 : cidx50 < 33 ? 3 : cidx50 < 36 ? 4 : cidx50 < 38 ? 5 : cidx50 < 40 ? 6 : cidx50 < 42 ? 7 : cidx50 - 34;
    const int st = cidx50 < 16 ? 0 : cidx50 < 24 ? 16 : cidx50 < 29 ? 24 : cidx50 < 33 ? 29 : cidx50 < 36 ? 33 : cidx50 < 38 ? 36 : cidx50 < 40 ? 38 : cidx50 < 42 ? 40 : cidx50;
    b = cidx50 - st;
}
__device__ __forceinline__ void peer_topk_pair(const LAS float* srow, int hp, LAS float* gsc, LAS int* isc, int lane) {
    const int hl = lane & 31, hb = lane & 32; const bool hi_half = lane >= 32; const int h = 2 * hp + (hi_half ? 1 : 0);
    const LAS float* sh = srow + h * 256;
    unsigned k1[4], k2[4];
#pragma unroll
    for (int j = 0; j < 4; ++j) { const int idx = hl + 32 * j; k1[j] = (fkey(sh[idx]) & ~127u) | (unsigned)(127 - idx); k2[j] = (fkey(sh[128 + idx]) & ~127u) | (unsigned)(127 - idx); }
    const unsigned r1 = topk16_half4(k1, hl, hi_half), r2 = topk16_half4(k2, hl, hi_half);
    const int i1 = 127 - (int)(r1 & 127u), i2 = 127 - (int)(r2 & 127u);
    const float v1 = sh[i1], v2 = sh[128 + i2];
    int a0, b0, a1, b1; cand_ab(hl, a0, b0); cand_ab(hl + 32, a1, b1);
    const float c0 = __shfl(v1, hb + a0) + __shfl(v2, hb + b0), c1 = __shfl(v1, hb + (a1 & 15)) + __shfl(v2, hb + (b1 & 15));
    const unsigned q0 = (fkey(c0) & ~255u) | (unsigned)(255 - (a0 * 16 + b0)), q1 = (hl + 32 < 50) ? ((fkey(c1) & ~255u) | (unsigned)(255 - (a1 * 16 + b1))) : 0u;
    const unsigned r3 = topk16_half2(q0, q1, hl, hi_half);
    const int ci = 255 - (int)(r3 & 255u);
    const float sc = __shfl(v1, hb + (ci >> 4)) + __shfl(v2, hb + (ci & 15));
    const int e = __shfl(i1, hb + (ci >> 4)) * 128 + __shfl(i2, hb + (ci & 15));
    const float mxa = __int_as_float(__builtin_amdgcn_readlane(__float_as_int(sc), 0)), mxb = __int_as_float(__builtin_amdgcn_readlane(__float_as_int(sc), 32));
    const float ex = hl < 16 ? __expf(sc - (hi_half ? mxb : mxa)) : 0.f;
    float sm = ex; sm += DPPF(sm, 0xB1); sm += DPPF(sm, 0x4E); sm += DPPF(sm, 0x141); sm += DPPF(sm, 0x140);
    if (hl < 16) { gsc[h * 16 + hl] = ex / sm; isc[h * 16 + hl] = e; }
}

__device__ __forceinline__ unsigned row_max_u32(unsigned v) { v = max(v, DPPU(v, 0xB1)); v = max(v, DPPU(v, 0x4E)); v = max(v, DPPU(v, 0x141)); v = max(v, DPPU(v, 0x140)); return v; }
#define CSWAP(a, b) do { const unsigned hi_ = max(a, b), lo_ = min(a, b); a = hi_; b = lo_; } while (0)
__device__ __forceinline__ unsigned topk16_row8(unsigned (&k)[8], int rl) {
    CSWAP(k[0], k[1]); CSWAP(k[2], k[3]); CSWAP(k[4], k[5]); CSWAP(k[6], k[7]);
    CSWAP(k[0], k[2]); CSWAP(k[1], k[3]); CSWAP(k[4], k[6]); CSWAP(k[5], k[7]);
    CSWAP(k[1], k[2]); CSWAP(k[5], k[6]); CSWAP(k[0], k[4]); CSWAP(k[3], k[7]);
    CSWAP(k[1], k[5]); CSWAP(k[2], k[6]);
    CSWAP(k[1], k[4]); CSWAP(k[3], k[6]);
    CSWAP(k[2], k[4]); CSWAP(k[3], k[5]);
    CSWAP(k[3], k[4]);
    unsigned res = 0u;
    for (int it = 0; it < 16; ++it) { const unsigned m = row_max_u32(k[0]); const bool mine = (k[0] == m);
#pragma unroll
        for (int j = 0; j < 7; ++j) k[j] = mine ? k[j + 1] : k[j];
        k[7] = mine ? 0u : k[7];
        res = (rl == it) ? m : res; }
    return res;
}
__device__ __forceinline__ void topk16_row8x2(unsigned (&k)[8], unsigned (&g)[8], int rl, unsigned& rk, unsigned& rg) {
#define CSWAP2(a, b) do { const unsigned hi_ = max(k[a], k[b]), lo_ = min(k[a], k[b]); k[a] = hi_; k[b] = lo_; const unsigned hj_ = max(g[a], g[b]), lj_ = min(g[a], g[b]); g[a] = hj_; g[b] = lj_; } while (0)
    CSWAP2(0, 1); CSWAP2(2, 3); CSWAP2(4, 5); CSWAP2(6, 7);
    CSWAP2(0, 2); CSWAP2(1, 3); CSWAP2(4, 6); CSWAP2(5, 7);
    CSWAP2(1, 2); CSWAP2(5, 6); CSWAP2(0, 4); CSWAP2(3, 7);
    CSWAP2(1, 5); CSWAP2(2, 6);
    CSWAP2(1, 4); CSWAP2(3, 6);
    CSWAP2(2, 4); CSWAP2(3, 5);
    CSWAP2(3, 4);
#undef CSWAP2
    unsigned res = 0u, reg = 0u;
#pragma unroll
    for (int it = 0; it < 16; ++it) {
        unsigned m = k[0], n = g[0];
        m = max(m, DPPU(m, 0xB1)); n = max(n, DPPU(n, 0xB1)); m = max(m, DPPU(m, 0x4E)); n = max(n, DPPU(n, 0x4E));
        m = max(m, DPPU(m, 0x141)); n = max(n, DPPU(n, 0x141)); m = max(m, DPPU(m, 0x140)); n = max(n, DPPU(n, 0x140));
        const bool mine = (k[0] == m), nine = (g[0] == n);
#pragma unroll
        for (int j = 0; j < 7; ++j) { k[j] = mine ? k[j + 1] : k[j]; g[j] = nine ? g[j + 1] : g[j]; }
        k[7] = mine ? 0u : k[7]; g[7] = nine ? 0u : g[7];
        res = (rl == it) ? m : res; reg = (rl == it) ? n : reg; }
    rk = res; rg = reg;
}
__device__ __forceinline__ unsigned topk16_row4(unsigned (&k)[4], int rl) {
    CSWAP(k[0], k[1]); CSWAP(k[2], k[3]); CSWAP(k[0], k[2]); CSWAP(k[1], k[3]); CSWAP(k[1], k[2]);
    unsigned res = 0u;
    for (int it = 0; it < 16; ++it) { const unsigned m = row_max_u32(k[0]); const bool mine = (k[0] == m);
#pragma unroll
        for (int j = 0; j < 3; ++j) k[j] = mine ? k[j + 1] : k[j];
        k[3] = mine ? 0u : k[3];
        res = (rl == it) ? m : res; }
    return res;
}
#undef CSWAP
__device__ __forceinline__ void peer_topk_quad(const LAS float* srow, int hq, LAS float* gsc, LAS int* isc, int lane) {
    const int rl = lane & 15, rb = lane & 48, h = 4 * hq + (lane >> 4);
    const LAS float* sh = srow + h * 256;
    unsigned k1[8], k2[8];
#pragma unroll
    for (int j = 0; j < 8; ++j) { const int idx = rl + 16 * j; k1[j] = (fkey(sh[idx]) & ~127u) | (unsigned)(127 - idx); k2[j] = (fkey(sh[128 + idx]) & ~127u) | (unsigned)(127 - idx); }
    unsigned r1, r2; topk16_row8x2(k1, k2, rl, r1, r2);
    const int i1 = 127 - (int)(r1 & 127u), i2 = 127 - (int)(r2 & 127u);
    const float v1 = sh[i1], v2 = sh[128 + i2];
    unsigned q[4];
#pragma unroll
    for (int j = 0; j < 4; ++j) { const int cidx = rl + 16 * j; int a, b; cand_ab(cidx < 50 ? cidx : 0, a, b);
        const float cs = __shfl(v1, rb + (a & 15)) + __shfl(v2, rb + (b & 15));
        q[j] = (cidx < 50) ? ((fkey(cs) & ~255u) | (unsigned)(255 - (a * 16 + b))) : 0u; }
    const unsigned r3 = topk16_row4(q, rl);
    const int ci = 255 - (int)(r3 & 255u);
    const float sc = __shfl(v1, rb + (ci >> 4)) + __shfl(v2, rb + (ci & 15));
    const int e = __shfl(i1, rb + (ci >> 4)) * 128 + __shfl(i2, rb + (ci & 15));
    const float mx = __shfl(sc, rb);
    const float ex = __expf(sc - mx);
    float sm = ex; sm += DPPF(sm, 0xB1); sm += DPPF(sm, 0x4E); sm += DPPF(sm, 0x141); sm += DPPF(sm, 0x140);
    gsc[h * 16 + rl] = ex / sm; isc[h * 16 + rl] = e;
}

constexpr size_t WS_PE_E = WS_P + 160 * MiB, WS_PE_CF = WS_PE_E + (size_t)MALL * 128 * 4;
constexpr int NSL = 16, SLW = 128;
constexpr size_t SLICE_BYTES = (size_t)16384 * SLW;
__device__ __forceinline__ void peer_token(const Ctx& c, int l, int r, int rn, int b, bool dry) {
    LAS float* gsc = (LAS float*)(c.lds + c.wave * 2048 + b * 1024);
    LAS int* isc = (LAS int*)(c.lds + c.wave * 2048 + b * 1024 + 512);
    LAS float* gscn = (LAS float*)(c.lds + c.wave * 2048 + (b ^ 1) * 1024); LAS int* iscn = (LAS int*)(c.lds + c.wave * 2048 + (b ^ 1) * 1024 + 512);
    const float* Sn = (const float*)(c.ws + WS_P) + (size_t)(rn < 0 ? r : rn) * DM;
    const int lane = c.lane;
    LAS float* snb = (LAS float*)(c.lds + 16384 + c.wave * 8192);
    f32x4 sv[8];
#pragma unroll
    for (int q = 0; q < 8; ++q) sv[q] = (rn >= 0) ? *(const f32x4*)(Sn + q * 256 + lane * 4) : (f32x4){0.f, 0.f, 0.f, 0.f};
    LDS_WAIT(); asm volatile("" ::: "memory");
    const bf16_t* hx = (const bf16_t*)(c.ws + WS_HX) + (size_t)r * DM;
    int hq[8]; float hdq;
    { float hv[32]; float mx = 0.f;
#pragma unroll
      for (int j = 0; j < 4; ++j) { float t0[8]; unpack8(*(const u32x4*)(hx + lane * 32 + j * 8), t0);
#pragma unroll
          for (int k = 0; k < 8; ++k) { hv[j * 8 + k] = t0[k]; mx = fmaxf(mx, fabsf(t0[k])); } }
#pragma unroll
      for (int o = 32; o > 0; o >>= 1) mx = fmaxf(mx, __shfl_xor(mx, o));
      const float q_ = mx > 0.f ? 127.f / mx : 0.f; hdq = mx * (1.f / (127.f * 16.f));
#pragma unroll
      for (int d = 0; d < 8; ++d) hq[d] = (int)pk4_i8(hv[4 * d] * q_, hv[4 * d + 1] * q_, hv[4 * d + 2] * q_, hv[4 * d + 3] * q_); }
    const float* USC = (const float*)(c.ws + WS_USC) + (size_t)l * 16384;
    const unsigned char* PU = (const unsigned char*)(c.ws + ws_pu(l)); const unsigned char* PV = (const unsigned char*)(c.ws + ws_pv(l));
#define PEER_LOADROW(tab, wk, e_) do { wk = *(const u32x4*)((tab) + (size_t)__builtin_amdgcn_readfirstlane(e_) * 1024 + lane * 16); } while (0)
#define PEER_IDX8(dst, i_) const u32x4 ia_##dst = *(const LAS u32x4*)(isc + (i_)), ib_##dst = *(const LAS u32x4*)(isc + (i_) + 4); \
        const int dst[8] = {(int)ia_##dst[0], (int)ia_##dst[1], (int)ia_##dst[2], (int)ia_##dst[3], (int)ib_##dst[0], (int)ib_##dst[1], (int)ib_##dst[2], (int)ib_##dst[3]}
    u32x4 w[8];
    float usc_ = USC[isc[lane & 7]];
    { PEER_IDX8(e0, 0);
#pragma unroll
      for (int k = 0; k < 8; ++k) PEER_LOADROW(PU, w[k], e0[k]); }
    if (rn >= 0) {
#pragma unroll
        for (int q = 0; q < 8; ++q) *(LAS f32x4*)(snb + q * 256 + lane * 4) = sv[q];
        LDS_WAIT(); asm volatile("" ::: "memory"); }
#pragma unroll 1
    for (int i = 0; i < 128; i += 8) {
        const bool has_next = i + 8 < 128;
        PEER_IDX8(en, has_next ? i + 8 : i);
        const float uscn_ = USC[isc[(has_next ? i + 8 : i) + (lane & 7)]];
        if (rn >= 0 && (i & 56) == 0) peer_topk_quad(snb, i >> 6, gscn, iscn, lane);
        float p[8];
#pragma unroll
        for (int k = 0; k < 8; ++k) {
            asm volatile("" : "+v"(w[k]));
            int s = 0;
#pragma unroll
            for (int d = 0; d < 4; ++d) { s = __builtin_amdgcn_sdot4((int)((w[k][d] << 4) & 0xF0F0F0F0u), hq[2 * d], s, false); s = __builtin_amdgcn_sdot4((int)(w[k][d] & 0xF0F0F0F0u), hq[2 * d + 1], s, false); }
            p[k] = (float)s; asm volatile("" : "+v"(p[k]));
            if (has_next) PEER_LOADROW(PU, w[k], en[k]); }
        const bool b0 = lane & 1, b1 = lane & 2, b2 = lane & 4;
        float q[4], t[2];
#pragma unroll
        for (int m = 0; m < 4; ++m) q[m] = (b0 ? p[2 * m + 1] : p[2 * m]) + DPPF(b0 ? p[2 * m] : p[2 * m + 1], 0xB1);
#pragma unroll
        for (int m = 0; m < 2; ++m) t[m] = (b1 ? q[2 * m + 1] : q[2 * m]) + DPPF(b1 ? q[2 * m] : q[2 * m + 1], 0x4E);
        float s = (b2 ? t[1] : t[0]) + SWZ_XOR(b2 ? t[0] : t[1], 4);
        s += SWZ_XOR(s, 8); s += SWZ_XOR(s, 16); s += __shfl_xor(s, 32);
        if (lane < 8) gsc[i + lane] = gsc[i + lane] * gelu_tanh(s * (usc_ * hdq));
        usc_ = uscn_;
    }
#undef PEER_LOADROW
#undef PEER_IDX8
    LDS_WAIT(); asm volatile("" ::: "memory");
    { int* E = (int*)(c.ws + WS_PE_E) + (size_t)r * 128; float* CF = (float*)(c.ws + WS_PE_CF) + (size_t)r * 128;
      E[lane] = isc[lane]; E[64 + lane] = isc[64 + lane]; CF[lane] = gsc[lane]; CF[64 + lane] = gsc[64 + lane]; }
    LDS_WAIT(); asm volatile("" ::: "memory");
}
__device__ __forceinline__ void phase_peer(const Ctx& c, int l, int nrows, bool dry = false) {
    const int gw = c.wg * NWAVES + c.wave, NGW = c.G * NWAVES;
    int r = gw; if (r >= nrows) return;
    { const float* S0 = (const float*)(c.ws + WS_P) + (size_t)r * DM; LAS float* snb0 = (LAS float*)(c.lds + 16384 + c.wave * 8192);
#pragma unroll
      for (int q = 0; q < 8; ++q) *(LAS f32x4*)(snb0 + q * 256 + c.lane * 4) = *(const f32x4*)(S0 + q * 256 + c.lane * 4);
      LDS_WAIT(); asm volatile("" ::: "memory");
#pragma unroll 1
      for (int hq = 0; hq < 2; ++hq) peer_topk_quad(snb0, hq, (LAS float*)(c.lds + c.wave * 2048), (LAS int*)(c.lds + c.wave * 2048 + 512), c.lane);
      LDS_WAIT(); asm volatile("" ::: "memory"); }
    int b = 0;
#pragma unroll 1
    for (; r < nrows; r += NGW, b ^= 1) { const int rn = r + NGW; peer_token(c, l, r, rn < nrows ? rn : -1, b, dry); }
}
#define PEER_SLICE_BEGIN() { const int grp = c.wg & 7, wi = (c.wg >> 3) * NWAVES + c.wave, nwi = ((c.G - grp + 7) >> 3) * NWAVES; \
    _Pragma("unroll 1") for (int ps = 0; ps < 2; ++ps) { const int s = grp + 8 * ps; _Pragma("unroll 1") for (int r = wi; r < nrows; r += nwi) {
#define PEER_SLICE_END() } } }
__device__ __forceinline__ void phase_peer_v(const Ctx& c, int l, int nrows, bool dry) {
    const int lane = c.lane, rg = lane >> 3, ch = lane & 7;
    const int* Eb = (const int*)(c.ws + WS_PE_E); const float* CF = (const float*)(c.ws + WS_PE_CF);
    const bool b3 = lane & 8, b4 = lane & 16, b5 = lane & 32;
    const int grp = c.wg & 7, wi = (c.wg >> 3) * NWAVES + c.wave, nwi = ((c.G - grp + 7) >> 3) * NWAVES;
#define V_META(r_, e0_, e1_, c0_, c1_) do { if ((r_) < nrows) { e0_ = Eb[(size_t)(r_) * 128 + lane]; e1_ = Eb[(size_t)(r_) * 128 + 64 + lane]; c0_ = CF[(size_t)(r_) * 128 + lane]; c1_ = CF[(size_t)(r_) * 128 + 64 + lane]; } } while (0)
#pragma unroll 1
    for (int ps = 0; ps < 2; ++ps) { const int s = grp + 8 * ps;
        const unsigned char* tab = (const unsigned char*)(c.ws + ws_pv(l)) + (size_t)s * SLICE_BYTES + ch * 16;
        const int col = s * SLW + ch * 16 + (b3 ? 8 : 0) + (b4 ? 4 : 0) + (b5 ? 2 : 0);
        int r = wi; int e0 = 0, e1 = 0; float c0 = 0.f, c1 = 0.f;
        V_META(r, e0, e1, c0, c1);
#pragma unroll 1
        for (; r < nrows; r += nwi) {
            u32x4 w[16];
#pragma unroll
            for (int i = 0; i < 16; ++i) { const int e = __shfl(i < 8 ? e0 : e1, (8 * i + rg) & 63); w[i] = *(const u32x4*)(tab + (size_t)e * SLW); }
            int f0 = 0, f1 = 0; float d0 = 0.f, d1 = 0.f; V_META(r + nwi, f0, f1, d0, d1);
            const int vec = r < SEQ ? 0 : (r < MLAT ? 1 : 2);
            float* xr = (dry ? (float*)(c.ws + WS_YF) + (size_t)r * DM : xrow_ptr(c, r)) + col;
            const f32x2 gg = *(const f32x2*)((const float*)(c.ws + WS_MOD) + ((size_t)l * 3 + vec) * NMOD + 5 * DM + col); f32x2 xx = *(const f32x2*)xr;
            h16x2 o2[8];
#pragma unroll
            for (int j = 0; j < 8; ++j) o2[j] = (h16x2){(_Float16)0.f, (_Float16)0.f};
#pragma unroll
            for (int i = 0; i < 16; ++i) {
                asm volatile("" : "+v"(w[i]));
                const float ci_ = __shfl(i < 8 ? c0 : c1, (8 * i + rg) & 63);
                const h16x2 ci2 = {(_Float16)ci_, (_Float16)ci_};
#pragma unroll
                for (int d = 0; d < 4; ++d) {
                    const h16x2 lo_ = __builtin_bit_cast(h16x2, __builtin_amdgcn_cvt_scalef32_pk_f16_fp8((int)w[i][d], 1.0f, false)), hi_ = __builtin_bit_cast(h16x2, __builtin_amdgcn_cvt_scalef32_pk_f16_fp8((int)w[i][d], 1.0f, true));
                    o2[2 * d] = __builtin_elementwise_fma(lo_, ci2, o2[2 * d]); o2[2 * d + 1] = __builtin_elementwise_fma(hi_, ci2, o2[2 * d + 1]); }
                asm volatile("" : "+v"(o2[0])); }
            float o[16];
#pragma unroll
            for (int j = 0; j < 8; ++j) { o[2 * j] = (float)o2[j][0]; o[2 * j + 1] = (float)o2[j][1]; }
            float q8[8], q4[4], q2[2];
#pragma unroll
            for (int j = 0; j < 8; ++j) q8[j] = (b3 ? o[8 + j] : o[j]) + DPPF(b3 ? o[j] : o[8 + j], 0x128);
#pragma unroll
            for (int j = 0; j < 4; ++j) q4[j] = (b4 ? q8[4 + j] : q8[j]) + SWZ_XOR(b4 ? q8[j] : q8[4 + j], 16);
#pragma unroll
            for (int j = 0; j < 2; ++j) q2[j] = (b5 ? q4[2 + j] : q4[j]) + __shfl_xor(b5 ? q4[j] : q4[2 + j], 32);
            xx[0] += gg[0] * q2[0]; xx[1] += gg[1] * q2[1];
            *(f32x2*)xr = xx;
            e0 = f0; e1 = f1; c0 = d0; c1 = d1;
        }
    }
#undef V_META
}
struct Args { const float* in[29]; float* out; unsigned char* ws; int ph_lo, ph_hi; };
constexpr int PH_PER_LAYER = 10, N_PHASES = NLAYER * PH_PER_LAYER;
#ifndef G1_WGM
#define G1_WGM 3
#endif
constexpr int CW_BAR = 4096;

__global__ void __launch_bounds__(NTHREADS, 2) mk_fwd(Args args) {
    extern __shared__ __attribute__((aligned(16))) unsigned char lds_raw[];
    Ctx c0;
    c0.out = args.out; c0.ws = args.ws; c0.lds = (LAS unsigned char*)lds_raw;
    c0.tid = threadIdx.x; c0.lane = c0.tid & 63; c0.wave = __builtin_amdgcn_readfirstlane((int)(threadIdx.x >> 6)); c0.wg = blockIdx.x; c0.G = gridDim.x;
    volatile LAS unsigned* MISC = (volatile LAS unsigned*)(c0.lds + MISC_OFF);
    if (c0.tid < 64) MISC[c0.tid] = 0u;
    __syncthreads();
    const int lo = args.ph_lo, hi = args.ph_hi;
    XcdBarrier bar; bar.bar = (unsigned*)(c0.ws + WS_CTL) + CW_BAR; bar.x = 0; bar.st = MISC + 8;
    if (hi - lo > 1) bar = xcd_barrier_post((unsigned*)(c0.ws + WS_CTL) + CW_BAR, MISC + 8);
#ifndef ONLY_PH
#define ONLY_PH -1
#endif
#define IN(k) ((ONLY_PH < 0 || ((k) % PH_PER_LAYER) == ONLY_PH) && lo <= (k) && (k) < hi)
#define PH_BEGIN() Ctx c = c0; unsigned long long wsi_ = (unsigned long long)c0.ws, outi_ = (unsigned long long)c0.out; asm volatile("" : "+s"(wsi_), "+s"(outi_), "+s"(c.wg), "+s"(c.G), "+s"(c.wave)); \
    c.lane = lane_id_fresh(); c.tid = c.wave * 64 + c.lane; c.ws = (unsigned char*)(GAS unsigned char*)wsi_; c.out = (float*)(GAS float*)outi_;     \
    bf16_t* P = (bf16_t*)(c.ws + WS_P); bf16_t* HX = (bf16_t*)(c.ws + WS_HX); float* YF = (float*)(c.ws + WS_YF); (void)P; (void)HX; (void)YF
#ifndef PROBE_DUP
#define PROBE_DUP -1
#endif
#define REPS(k) for (int rep = 0, dry = (PROBE_DUP == (k)); rep < (PROBE_DUP == (k) ? 2 : 1); ++rep, dry = 0)
#define SEAM(k) do { if (IN(k) && IN((k) + 1)) { xcd_barrier(bar, c0.wave); if (PROBE_DUP == 20) xcd_barrier(bar, c0.wave); } } while (0)
    const bool early = (c0.G == 256);
#define TAIL_BEGIN() PH_BEGIN(); c.wg -= 32; c.G -= 32
    for (int l = 0; l < NLAYER; ++l) {
        const int pb = l * PH_PER_LAYER;
        const int mrows = (l == 0) ? MALL : MLAT;
        if (IN(pb + 0) && !(l == 1 && early)) REPS(0) {
            if (l == 0) { PH_BEGIN(); conv_colmax(c); }
            { PH_BEGIN(); conv_units(c, l); } { PH_BEGIN(); conv_tables(c, l); } { PH_BEGIN(); conv_small(c, l); }
            if (l == 0) { { PH_BEGIN(); conv_once(c); } xcd_barrier(bar, c0.wave); }
            { PH_BEGIN(); conv_transposes(c, l); } }
        if (!(l == 1 && early)) SEAM(pb + 0);
        if (IN(pb + 1)) REPS(1) { PH_BEGIN();
            if (l == 0) { GET_IN(); phase_norm<true>(c, l, MALL, SP_NMIX, 0, INP(I_X), INP(I_CTX)); } else phase_norm<true>(c, l, MALL, SP_NMIX, 0); }
        SEAM(pb + 1);
        if (IN(pb + 2)) REPS(2) { PH_BEGIN();
            pg8::Gemm g{HX, (const bf16_t*)(c.ws + WS_WIN), MALL, NIN, DM, DM, DM}; pg8::StaticOrder S; S.init(MALL, NIN, c.G, c.wg, G1_WGM);
            pg8::EpiI8 E{P, NIN, (const float*)(c.ws + WS_ADQ), (const float*)(c.ws + WS_WDQ)};
            pg8::gemm_phase<pg8::EpiI8, pg8::StaticOrder, true, true, false, true>(c.lds, g, S, E, c.wave);
        }
        SEAM(pb + 2);
        if (IN(pb + 3)) REPS(3) {
            int flip_ = (c0.wg >> 3) & 1; asm volatile("" : "+s"(flip_));
#pragma unroll 1
            for (int st = 0; st < 2; ++st) {
                if ((st ^ flip_) == 0) { { PH_BEGIN(); phase_qk(c, l, dry); } { PH_BEGIN(); phase_sc(c, l, dry); } }
                else { PH_BEGIN(); phase_lru1(c, l); }
                __syncthreads(); }
            if (PROBE_DUP == 30) { PH_BEGIN(); phase_lru1(c, l); } }
        SEAM(pb + 3);
        if (IN(pb + 4)) REPS(4) { { PH_BEGIN(); phase_m2(c, l, dry); } __syncthreads(); if (PROBE_DUP == 31) { PH_BEGIN(); phase_lru2(c, l, true); } { PH_BEGIN(); phase_lru2(c, l, dry); } }
        SEAM(pb + 4);
        if (IN(pb + 5)) REPS(5) { { PH_BEGIN();
            pg8::MixOrder S; S.init(mrows, c.G, c.wg);
            const bf16_t* WO = (const bf16_t*)(c.ws + WS_WO);
            { pg8::Gemm g{P + CQ, WO, mrows, DM, DM, NIN, DM}; pg8::EpiMerge<0> E{P + CGT, NIN, (bf16_t*)YF, HX};
              pg8::gemm_phase<pg8::EpiMerge<0>, pg8::MixOrder, true, true, true>(c.lds, g, S, E, c.wave); }
            { pg8::Gemm g{P + CLG, WO + (size_t)DM * DM, mrows, DM, DM, NIN, DM}; pg8::EpiMerge<1> E{P + CGT + DM, NIN, (bf16_t*)YF, HX};
              pg8::gemm_phase<pg8::EpiMerge<1>, pg8::MixOrder, true, true, true>(c.lds, g, S, E, c.wave); }
            { pg8::Gemm g{P + CBG, WO + (size_t)2 * DM * DM, mrows, DM, DM, NIN, DM}; pg8::EpiMerge<2> E{P + CGT + 2 * DM, NIN, (bf16_t*)YF, HX};
              pg8::gemm_phase<pg8::EpiMerge<2>, pg8::MixOrder, true, true, true>(c.lds, g, S, E, c.wave); }
            }
            if (l == 0 && early && c0.wg >= 32 && !dry) { { TAIL_BEGIN(); conv_transposes(c, 1, CV_WIN); } { TAIL_BEGIN(); conv_tables(c, 1, CV_PU); } }
        }
        SEAM(pb + 5);
        if (IN(pb + 6)) REPS(6) { { PH_BEGIN();
            pg8::Gemm g{HX, (const bf16_t*)(c.ws + WS_WOUT), mrows, DM, DM, DM, DM}; pg8::MixOrder S; S.init(mrows, c.G, c.wg);
            float* xl_ = dry ? YF : c.out; float* xc_ = dry ? YF + (size_t)MLAT * DM : (float*)(c.ws + WS_CTXS);
            const float* sl_ = xl_; const float* sc_ = xc_;
            if (l == 0 && !dry) { GET_IN(); sl_ = INP(I_X); sc_ = INP(I_CTX); }
            pg8::EpiResid E{xl_, xc_, (const float*)(c.ws + WS_MOD) + (size_t)l * 3 * NMOD + 2 * DM, sl_, sc_};
            pg8::gemm_phase<pg8::EpiResid, pg8::MixOrder, true, true, true>(c.lds, g, S, E, c.wave);
            }
            if (l == 0 && early && c0.wg >= 32 && !dry) { { TAIL_BEGIN(); conv_units(c, 1); } { TAIL_BEGIN(); conv_transposes(c, 1, CV_WO); } }
        }
        SEAM(pb + 6);
        if (IN(pb + 7)) REPS(7) { PH_BEGIN(); phase_norm(c, l, mrows, SP_NFFN, 3); }
        SEAM(pb + 7);
        if (IN(pb + 8)) REPS(8) { { PH_BEGIN();
            pg8::Gemm g{HX, (const bf16_t*)(c.ws + ws_wsc(l)), mrows, DM, DM, DM, DM}; pg8::MixOrder S; S.init(mrows, c.G, c.wg);
            pg8::EpiF32 E{(float*)(c.ws + WS_P), DM};
            pg8::gemm_phase<pg8::EpiF32, pg8::MixOrder, true, true, true>(c.lds, g, S, E, c.wave);
            }
            if (l == 0 && early && c0.wg >= 32 && !dry) { { TAIL_BEGIN(); conv_transposes(c, 1, CV_WOUT); } { TAIL_BEGIN(); conv_tables(c, 1, CV_PV | CV_LRU); } { TAIL_BEGIN(); conv_small(c, 1); } }
        }
        SEAM(pb + 8);
        if (IN(pb + 9)) REPS(9) {
            { PH_BEGIN(); phase_peer(c, l, mrows, dry); } xcd_barrier(bar, c0.wave);
            { PH_BEGIN(); phase_peer_v(c, l, mrows, dry); } }
        SEAM(pb + 9);
    }
#undef IN
#undef SEAM
}

extern "C" void kernel_launch(void* const* d_in, const int* in_sizes, int n_in, void* d_out, int out_size, void* d_ws, size_t ws_size, hipStream_t stream) {
    static int grid = 0;
    if (grid == 0) {
        if (n_in != 29 || in_sizes[0] != MLAT * DM || out_size != MLAT * DM || ws_size < WS_END) {
            fprintf(stderr, "kernel_launch: built for 29 inputs, x/out of %d floats, >= %zu bytes of workspace; got n_in %d, in0 %d, out %d, ws %zu; nothing launched\n", MLAT * DM, (size_t)WS_END, n_in, n_in > 0 ? in_sizes[0] : -1, out_size, ws_size);
            grid = -1; return; }
        int dev = 0, cus = 0, per_cu = 0;
        if (hipGetDevice(&dev) != hipSuccess || hipDeviceGetAttribute(&cus, hipDeviceAttributeMultiprocessorCount, dev) != hipSuccess) { fprintf(stderr, "kernel_launch: device query failed\n"); grid = -1; return; }
        if (hipFuncSetAttribute((const void*)mk_fwd, hipFuncAttributeMaxDynamicSharedMemorySize, LDS_BYTES) != hipSuccess) { fprintf(stderr, "kernel_launch: hipFuncSetAttribute failed\n"); grid = -1; return; }
        if (hipOccupancyMaxActiveBlocksPerMultiprocessor(&per_cu, (const void*)mk_fwd, NTHREADS, LDS_BYTES) != hipSuccess || per_cu < 1)
            fprintf(stderr, "kernel_launch: note: occupancy query reports %d workgroups per CU\n", per_cu);
        (void)hipGetLastError();
        grid = cus;
    }
    if (grid < 0) return;
    if (hipMemsetAsync((char*)d_ws + WS_CTL, 0, CTL_ZERO_BYTES, stream) != hipSuccess) { fprintf(stderr, "kernel_launch: memset failed\n"); return; }
    Args a{};
    for (int i = 0; i < 29; ++i) a.in[i] = (const float*)d_in[i];
    a.out = (float*)d_out; a.ws = (unsigned char*)d_ws;
#if MK_N_LAUNCHES == 1
    a.ph_lo = 0; a.ph_hi = N_PHASES;
    hipLaunchKernelGGL(mk_fwd, dim3(grid), dim3(NTHREADS), LDS_BYTES, stream, a);
#else
    for (int k = 0; k < N_PHASES; ++k) { a.ph_lo = k; a.ph_hi = k + 1; hipLaunchKernelGGL(mk_fwd, dim3(grid), dim3(NTHREADS), LDS_BYTES, stream, a); }
#endif
    const hipError_t le = hipPeekAtLastError();
    if (le != hipSuccess) fprintf(stderr, "kernel_launch: launch failed: %s\n", hipGetErrorName(le));
}
```

```cpp
#include <hip/hip_runtime.h>
#include <cstdio>
#include <cstdint>

#ifndef MK_N_LAUNCHES
#define MK_N_LAUNCHES 1
#endif
#if MK_N_LAUNCHES != 1
#error "the PEER phase carries a grid barrier of its own: this kernel is one launch only"
#endif

#define GAS __attribute__((address_space(1)))
#define LAS __attribute__((address_space(3)))
typedef unsigned short bf16_t;
typedef short bf16x8 __attribute__((ext_vector_type(8)));
typedef short s16x4 __attribute__((ext_vector_type(4)));
typedef float f32x2 __attribute__((ext_vector_type(2)));
typedef _Float16 h16x2 __attribute__((ext_vector_type(2)));
typedef float f32x4 __attribute__((ext_vector_type(4)));
typedef float f32x8 __attribute__((ext_vector_type(8)));
typedef float f32x16 __attribute__((ext_vector_type(16)));
typedef unsigned u32x2 __attribute__((ext_vector_type(2)));
typedef unsigned u32x4 __attribute__((ext_vector_type(4)));
typedef int i32x4 __attribute__((ext_vector_type(4)));

constexpr int DM = 2048, NB = 2, SEQ = 8192, NLAYER = 2, CTXL = 256;
constexpr int MLAT = NB * SEQ, MCTX = NB * CTXL, MALL = MLAT + MCTX;
constexpr int NIN = 19456;
constexpr int CQ = 0, CK = 2048, CV = 2560, CLX = 3072, CLG = 5120, CBG = 7168, CCG = 9216, CU = 11264, CGT = 13312;
constexpr int NKEY = SEQ + CTXL;
constexpr int NCHUNK = NKEY / 64;
constexpr int NMOD = 6 * DM;
constexpr float EPS = 1e-6f;
constexpr int NWAVES = 8, NTHREADS = 512;

constexpr size_t MiB = 1u << 20;
constexpr size_t al256(size_t x) { return (x + 255) / 256 * 256; }
constexpr size_t WS_CTL = 0, CTL_ZERO_BYTES = 1 * MiB;
constexpr size_t WS_MOD = WS_CTL + CTL_ZERO_BYTES;
constexpr size_t WS_ROPE = WS_MOD + al256((size_t)NLAYER * 3 * NMOD * 4);
constexpr size_t WS_SP = WS_ROPE + al256(2 * 128 * 32 * 4);
constexpr size_t WS_CTXS = WS_SP + al256(36864 * 4);
constexpr size_t WS_LSUM = WS_CTXS + al256((size_t)MCTX * DM * 4);
constexpr size_t WS_WLRU = WS_LSUM + al256((size_t)2 * 2 * NB * NCHUNK * DM * 4);
constexpr size_t WS_KC = WS_WLRU + al256((size_t)16 * 512 * 128 * 2);
constexpr size_t WS_VC = WS_KC + al256((size_t)NB * 4 * NKEY * 128 * 2);
constexpr size_t WS_WIN = WS_VC + al256((size_t)NB * 4 * NKEY * 128 * 2);
constexpr size_t WS_CMAX = WS_WIN + (size_t)NIN * DM;
constexpr size_t WS_WDQ = WS_CMAX + al256((size_t)2 * 32 * NIN * 4);
constexpr size_t WS_ADQ = WS_WDQ + al256((size_t)NIN * 4);
constexpr size_t WS_WO = WS_WIN + al256((size_t)NIN * DM * 2);
constexpr size_t WS_WOUT = WS_WO + al256((size_t)3 * DM * DM * 2);
constexpr size_t WS_WSC = WS_WOUT + al256((size_t)DM * DM * 2);
constexpr size_t WS_PU = WS_WSC + al256((size_t)DM * DM * 2);
constexpr size_t WS_PV = WS_PU + al256((size_t)16384 * DM);
constexpr size_t WS_HX = WS_PV + al256((size_t)16384 * DM);
constexpr size_t WS_YF = WS_HX + al256((size_t)MALL * DM * 2);
constexpr size_t WS_P = WS_YF + al256((size_t)MALL * DM * 4);
static_assert(WS_ADQ + (size_t)MALL * 4 <= WS_WO, "the int8 side tables must fit the spare half of the w_in region");
constexpr size_t WS_PU2 = WS_P + al256((size_t)MALL * NIN * 2);
constexpr size_t WS_PV2 = WS_PU2 + al256((size_t)16384 * DM);
constexpr size_t WS_WSC2 = WS_PV2 + al256((size_t)16384 * DM);
constexpr size_t WS_USC = WS_WSC2 + al256((size_t)DM * DM * 2);
constexpr size_t WS_END = WS_USC + al256((size_t)2 * 16384 * 4);
__host__ __device__ constexpr size_t ws_pu(int l) { return l ? WS_PU2 : WS_PU; }
__host__ __device__ constexpr size_t ws_pv(int l) { return l ? WS_PV2 : WS_PV; }
__host__ __device__ constexpr size_t ws_wsc(int l) { return l ? WS_WSC2 : WS_WSC; }

constexpr int SP_NMIX = 0, SP_NFFN = 2048, SP_QN = 4096, SP_KN = 4224, SP_LCW = 4352, SP_LCB = 12544, SP_LBA = 14592, SP_LBX = 18688, SP_LSP = 22784, SP_SCW = 26880, SP_SCB = 33024, SP_END = 35072;

constexpr int LDS_BYTES = 147456;
constexpr int MISC_OFF = 147456 - 256;
constexpr int LDS_WORK = MISC_OFF;

__device__ __forceinline__ unsigned cvt_pk_bf16(float lo, float hi) { unsigned r; asm volatile("v_cvt_pk_bf16_f32 %0, %1, %2" : "=v"(r) : "v"(lo), "v"(hi)); return r; }
__device__ __forceinline__ unsigned pk4_i8(float a, float b, float c, float d) {
    const int ia = (int)__builtin_rintf(a), ib = (int)__builtin_rintf(b), ic = (int)__builtin_rintf(c), id = (int)__builtin_rintf(d);
    return ((unsigned)ia & 255u) | (((unsigned)ib & 255u) << 8) | (((unsigned)ic & 255u) << 16) | ((unsigned)id << 24); }
__device__ __forceinline__ float bf_lo(unsigned w) { return __uint_as_float(w << 16); }
__device__ __forceinline__ float bf_hi(unsigned w) { return __uint_as_float(w & 0xffff0000u); }
__device__ __forceinline__ float bf1(bf16_t h) { return __uint_as_float(((unsigned)h) << 16); }
__device__ __forceinline__ bf16_t f2bf(float f) { return (bf16_t)(cvt_pk_bf16(f, 0.f) & 0xffffu); }
__device__ __forceinline__ float sigmoidf_(float x) { return __builtin_amdgcn_rcpf(1.f + __expf(-x)); }
__device__ __forceinline__ float gelu_tanh(float x) { const float z = 0.7978845608028654f * (x + 0.044715f * x * x * x); const float e = __expf(2.f * z); return 0.5f * x * (2.f - 2.f * __builtin_amdgcn_rcpf(e + 1.f)); }
__device__ __forceinline__ float wave_sum(float v) {
#pragma unroll
    for (int o = 1; o < 64; o <<= 1) v += __shfl_xor(v, o);
    return v;
}
__device__ __forceinline__ float wave_max(float v) {
#pragma unroll
    for (int o = 1; o < 64; o <<= 1) v = fmaxf(v, __shfl_xor(v, o));
    return v;
}
template <class T> __device__ __forceinline__ T* as_global(T* p) { return (T*)(GAS T*)p; }
__device__ __forceinline__ int lane_id_fresh() { int l; asm volatile("v_mbcnt_lo_u32_b32 %0, -1, 0\n\tv_mbcnt_hi_u32_b32 %0, -1, %0" : "=v"(l)); return l; }
#define DPPF(v, ctrl) __int_as_float(__builtin_amdgcn_update_dpp(0, __float_as_int(v), ctrl, 0xF, 0xF, true))
#define LDS_WAIT() asm volatile("s_waitcnt lgkmcnt(0)" ::: "memory")
#define VM_WAIT() asm volatile("s_waitcnt vmcnt(0)" ::: "memory")

#define XB_TMO      128
#define XB_XCNT(j)  (256  + 64 * (j))
#define XB_XSUB(j)  (1280 + 64 * (j))
#define XB_XGEN(j)  (2304 + 64 * (j))
#define XB_TOP      3328
#define XB_TOPGEN   3392
#define XCD_BAR_WORDS 3456
#define XB_SPIN_CAP (1u << 23)
__device__ __forceinline__ unsigned xb_ld(unsigned* p)              { return __hip_atomic_load(p, __ATOMIC_RELAXED, __HIP_MEMORY_SCOPE_AGENT); }
__device__ __forceinline__ unsigned xb_add(unsigned* p, unsigned v) { return __hip_atomic_fetch_add(p, v, __ATOMIC_RELAXED, __HIP_MEMORY_SCOPE_AGENT); }
__device__ __forceinline__ unsigned xb_xcc_id() { return (unsigned)__builtin_amdgcn_s_getreg((3 << 11) | 20) & 0xFu; }
#define XB_SPIN(cond, bar) do { unsigned _sp = 0; while (cond) { __builtin_amdgcn_s_sleep(1); \
    if ((++_sp & 255u) == 0u) { if (xb_ld(&(bar)[XB_TMO])) break; if (_sp > XB_SPIN_CAP) { atomicAdd(&(bar)[XB_TMO], 1u); break; } } } } while (0)
struct XcdBarrier { unsigned* bar; unsigned x; volatile LAS unsigned* st; };
__device__ __forceinline__ XcdBarrier xcd_barrier_post(unsigned* bar, volatile LAS unsigned* st) {
    XcdBarrier b; b.bar = bar; b.x = xb_xcc_id(); b.st = st;
    if (threadIdx.x == 0) (void)xb_add(&bar[XB_XCNT(b.x)], 1u);
    return b;
}
__device__ __forceinline__ void xcd_barrier_complete(unsigned* bar, unsigned x, unsigned& nloc, unsigned& nx) {
    const unsigned G = gridDim.x * gridDim.y * gridDim.z;
    unsigned sum, cnt, mine, sp = 0u;
    for (;;) {
        sum = 0u; cnt = 0u; mine = 0u;
#pragma unroll
        for (unsigned j = 0; j < 16; ++j) { const unsigned c = xb_ld(&bar[XB_XCNT(j)]); sum += c; cnt += (c > 0u) ? 1u : 0u; mine = (j == x) ? c : mine; }
        if (sum == G) break;
        __builtin_amdgcn_s_sleep(1);
        if ((++sp & 255u) == 0u) { if (xb_ld(&bar[XB_TMO])) break; if (sp > XB_SPIN_CAP) { atomicAdd(&bar[XB_TMO], 1u); break; } }
    }
    nloc = mine > 0u ? mine : 1u; nx = cnt > 0u ? cnt : 1u;
}
__device__ __forceinline__ void xcd_barrier(const XcdBarrier& b, int wave) {
    asm volatile("s_waitcnt vmcnt(0)" ::: "memory");
    __syncthreads();
    if (wave == 0 && lane_id_fresh() == 0) {
        unsigned* bar = b.bar;
        __builtin_amdgcn_s_waitcnt(0);
        unsigned nloc = b.st[0], nx = b.st[1];
        if (nloc == 0u) { xcd_barrier_complete(bar, b.x, nloc, nx); b.st[0] = nloc; b.st[1] = nx; }
        const unsigned old = xb_add(&bar[XB_XSUB(b.x)], 1u);
        const unsigned gen = old / nloc;
        if (old + 1u == (gen + 1u) * nloc) {
            __builtin_amdgcn_fence(__ATOMIC_RELEASE, "agent");
            asm volatile("s_waitcnt vmcnt(0)" ::: "memory");
            const unsigned og = xb_add(&bar[XB_TOP], 1u);
            const unsigned tg = og / nx;
            if (og + 1u == (tg + 1u) * nx) xb_add(&bar[XB_TOPGEN], 1u);
            else XB_SPIN(xb_ld(&bar[XB_TOPGEN]) == tg, bar);
            __builtin_amdgcn_fence(__ATOMIC_ACQUIRE, "agent");
            xb_add(&bar[XB_XGEN(b.x)], 1u);
            asm volatile("s_waitcnt vmcnt(0)" ::: "memory");
        } else {
            XB_SPIN(xb_ld(&bar[XB_XGEN(b.x)]) == gen, bar);
            __builtin_amdgcn_fence(__ATOMIC_ACQUIRE, "agent");
            asm volatile("s_waitcnt vmcnt(0)" ::: "memory");
        }
    }
    __syncthreads();
}
#ifndef MIX_WGM
#define MIX_WGM 8
#endif
namespace pg8 {
#define PG8_LAS __attribute__((address_space(3)))
constexpr int BM = 256, BK = 64, HALF = 128, HTB = HALF * BK * 2, STAGE_BYTES = 8 * HTB, NXCD = 8, WGM = 8;
__host__ __device__ __forceinline__ int lds_byte(int r, int c) { const int st = (r >> 4) * 2 + (c >> 5), rr = r & 15, cc = c & 31, ob = rr * 64 + cc * 2; return st * 1024 + (ob ^ (((ob >> 9) & 1) << 5)); }
__host__ __device__ __forceinline__ void stage_rc(int b, int& R, int& C) { const int st = b / 1024, sb = b % 1024, swz = sb ^ (((sb >> 9) & 1) << 5); R = (st >> 1) * 16 + swz / 64; C = (st & 1) * 32 + (swz % 64) / 2; }
__host__ __device__ __forceinline__ int perm32(int rho) { const int n = rho >> 4, i = rho & 15; return 8 * (i >> 2) + 4 * n + (i & 3); }

struct Unit { int pm, pn, nh; };
struct Gemm { const bf16_t* A; const bf16_t* Bt; int M, N, K, lda, ldb; };

struct StaticOrder {
    int nM, nN, nwg, G, c, wgm = WGM;
    __host__ __device__ void init(int M, int N, int G_, int c_, int wgm_ = WGM) { nM = M / BM; nN = N / BM; nwg = nM * nN; G = G_; c = c_; wgm = wgm_; }
    __host__ __device__ bool next(int i, Unit& u) const {
        const long L = (long)i * G + c; if (L >= nwg) return false;
        int wgid = (int)L; { const int q = nwg / NXCD, r = nwg % NXCD, xcd = wgid % NXCD, off = wgid / NXCD; wgid = (xcd < r ? xcd * (q + 1) : r * (q + 1) + (xcd - r) * q) + off; }
        const int nig = wgm * nN, gid = wgid / nig, fm = gid * wgm, gsz = (nM - fm) < wgm ? (nM - fm) : wgm;
        u.pm = 2 * (fm + ((wgid % nig) % gsz)); u.pn = (wgid % nig) / gsz; u.nh = 2; return true;
    }
    __device__ __forceinline__ void a_ready(const Unit&) const {}
    __device__ __forceinline__ void done(const Unit&) const {}
};

struct MixOrder {
    StaticOrder lat; int nhalf;
    __host__ __device__ void init(int mrows, int G_, int c_) { lat.init(MLAT, 2048, G_, c_, MIX_WGM); nhalf = ((mrows - MLAT) / HALF) * 8; }
    __host__ __device__ bool next(int i, Unit& u) const {
        if (lat.next(i, u)) return true;
        const long h = (long)i * lat.G + lat.c - lat.nwg; if (h < 0 || h >= nhalf) return false;
        u.pm = MLAT / HALF + (int)(h >> 3); u.pn = (int)(h & 7); u.nh = 1; return true;
    }
    __device__ __forceinline__ void a_ready(const Unit&) const {}
    __device__ __forceinline__ void done(const Unit&) const {}
};

struct EpiBf16 {
    static constexpr bool PERM = true, AFTER_DRAIN = false;
    bf16_t* O; int ldc;
    __device__ __forceinline__ void operator()(const f32x4 (&acc)[2][2][4][2], const Unit& u, int wr, int wc, int fr, int fq) const {
        const int row0 = u.pm * HALF + wr * 64 + fr, col0 = u.pn * BM + wc * 32 + 8 * fq;
#pragma unroll
        for (int ai = 0; ai < 2; ++ai) if (ai < u.nh)
#pragma unroll
            for (int m = 0; m < 4; ++m) { bf16_t* rowp = O + (size_t)(row0 + ai * HALF + m * 16) * ldc + col0;
#pragma unroll
                for (int bj = 0; bj < 2; ++bj) { const f32x4 v0 = acc[ai][bj][m][0], v1 = acc[ai][bj][m][1];
                    u32x4 w; w.x = cvt_pk_bf16(v0[0], v0[1]); w.y = cvt_pk_bf16(v0[2], v0[3]); w.z = cvt_pk_bf16(v1[0], v1[1]); w.w = cvt_pk_bf16(v1[2], v1[3]);
                    *(u32x4*)(rowp + bj * HALF) = w; } }
    }
};
struct EpiI8 {
    static constexpr bool PERM = true, AFTER_DRAIN = false;
    bf16_t* O; int ldc; const float* rstep; const float* cstep;
    __device__ __forceinline__ void operator()(const f32x4 (&acc)[2][2][4][2], const Unit& u, int wr, int wc, int fr, int fq) const {
        const int row0 = u.pm * HALF + wr * 64 + fr, col0 = u.pn * BM + wc * 32 + 8 * fq;
        f32x4 cs[2][2];
#pragma unroll
        for (int bj = 0; bj < 2; ++bj) { cs[bj][0] = *(const f32x4*)(cstep + col0 + bj * HALF); cs[bj][1] = *(const f32x4*)(cstep + col0 + bj * HALF + 4); }
#pragma unroll
        for (int ai = 0; ai < 2; ++ai) if (ai < u.nh)
#pragma unroll
            for (int m = 0; m < 4; ++m) { const int r = row0 + ai * HALF + m * 16; bf16_t* rowp = O + (size_t)r * ldc + col0; const float rs = rstep[r];
#pragma unroll
                for (int bj = 0; bj < 2; ++bj) {
                    const f32x4 v0 = __builtin_convertvector(__builtin_bit_cast(i32x4, acc[ai][bj][m][0]), f32x4) * (cs[bj][0] * rs), v1 = __builtin_convertvector(__builtin_bit_cast(i32x4, acc[ai][bj][m][1]), f32x4) * (cs[bj][1] * rs);
                    u32x4 w; w.x = cvt_pk_bf16(v0[0], v0[1]); w.y = cvt_pk_bf16(v0[2], v0[3]); w.z = cvt_pk_bf16(v1[0], v1[1]); w.w = cvt_pk_bf16(v1[2], v1[3]);
                    *(u32x4*)(rowp + bj * HALF) = w; } }
    }
};
struct EpiF32 {
    static constexpr bool PERM = false, AFTER_DRAIN = false;
    float* C; int ldc;
    __device__ __forceinline__ void operator()(const f32x4 (&acc)[2][2][4][2], const Unit& u, int wr, int wc, int fr, int fq) const {
        const int row0 = u.pm * HALF + wr * 64 + fr, col0 = u.pn * BM + wc * 32 + 4 * fq;
#pragma unroll
        for (int ai = 0; ai < 2; ++ai) if (ai < u.nh)
#pragma unroll
            for (int m = 0; m < 4; ++m) { float* rowp = C + (size_t)(row0 + ai * HALF + m * 16) * ldc + col0;
#pragma unroll
                for (int bj = 0; bj < 2; ++bj)
#pragma unroll
                    for (int n = 0; n < 2; ++n) *(f32x4*)(rowp + bj * HALF + n * 16) = acc[ai][bj][m][n]; }
    }
};
template <int MODE> struct EpiMerge {
    static constexpr bool PERM = true, AFTER_DRAIN = false;
    const bf16_t* Gt; int ldg; bf16_t* Y; bf16_t* YB;
    __device__ __forceinline__ void operator()(const f32x4 (&acc)[2][2][4][2], const Unit& u, int wr, int wc, int fr, int fq) const {
        const int row0 = u.pm * HALF + wr * 64 + fr, col0 = u.pn * BM + wc * 32 + 8 * fq;
#pragma unroll
        for (int ai = 0; ai < 2; ++ai) if (ai < u.nh)
#pragma unroll
            for (int m = 0; m < 4; ++m) { const size_t r = (size_t)(row0 + ai * HALF + m * 16);
#pragma unroll
                for (int bj = 0; bj < 2; ++bj) { const int c = col0 + bj * HALF;
                    const u32x4 gw = *(const u32x4*)(Gt + r * ldg + c);
                    f32x4 g0, g1;
                    g0[0] = sigmoidf_(bf_lo(gw.x)); g0[1] = sigmoidf_(bf_hi(gw.x)); g0[2] = sigmoidf_(bf_lo(gw.y)); g0[3] = sigmoidf_(bf_hi(gw.y));
                    g1[0] = sigmoidf_(bf_lo(gw.z)); g1[1] = sigmoidf_(bf_hi(gw.z)); g1[2] = sigmoidf_(bf_lo(gw.w)); g1[3] = sigmoidf_(bf_hi(gw.w));
                    f32x4 y0 = g0 * acc[ai][bj][m][0], y1 = g1 * acc[ai][bj][m][1];
                    if (MODE != 0) { const u32x4 yw = *(const u32x4*)(Y + r * 2048 + c);
                        y0 += (f32x4){bf_lo(yw.x), bf_hi(yw.x), bf_lo(yw.y), bf_hi(yw.y)}; y1 += (f32x4){bf_lo(yw.z), bf_hi(yw.z), bf_lo(yw.w), bf_hi(yw.w)}; }
                    u32x4 w; w.x = cvt_pk_bf16(y0[0], y0[1]); w.y = cvt_pk_bf16(y0[2], y0[3]); w.z = cvt_pk_bf16(y1[0], y1[1]); w.w = cvt_pk_bf16(y1[2], y1[3]);
                    *(u32x4*)((MODE != 2 ? Y : YB) + r * 2048 + c) = w; } }
    }
};
struct EpiResid {
    static constexpr bool PERM = true, AFTER_DRAIN = false;
    float* xlat; float* xctx; const float* gate;
    const float* slat; const float* sctx;
    __device__ __forceinline__ void operator()(const f32x4 (&acc)[2][2][4][2], const Unit& u, int wr, int wc, int fr, int fq) const {
        const int vec = u.pm < 64 ? 0 : (u.pm < 128 ? 1 : 2);
        float* xb = u.pm < 128 ? xlat + (size_t)u.pm * HALF * 2048 : xctx + (size_t)(u.pm - 128) * HALF * 2048;
        const float* sb = u.pm < 128 ? slat + (size_t)u.pm * HALF * 2048 : sctx + (size_t)(u.pm - 128) * HALF * 2048;
        const int lrow0 = wr * 64 + fr, col0 = u.pn * BM + wc * 32 + 8 * fq;
        const float* gp = gate + (size_t)vec * 12288 + col0;
#pragma unroll
        for (int bj = 0; bj < 2; ++bj) { const f32x4 g0 = *(const f32x4*)(gp + bj * HALF), g1 = *(const f32x4*)(gp + bj * HALF + 4);
#pragma unroll
            for (int ai = 0; ai < 2; ++ai) if (ai < u.nh)
#pragma unroll
                for (int m = 0; m < 4; ++m) { const size_t off = (size_t)(lrow0 + ai * HALF + m * 16) * 2048 + col0 + bj * HALF; float* xp = xb + off; const float* sp = sb + off;
                    const f32x4 x0 = *(const f32x4*)sp + g0 * acc[ai][bj][m][0], x1 = *(const f32x4*)(sp + 4) + g1 * acc[ai][bj][m][1];
                    *(f32x4*)xp = x0; *(f32x4*)(xp + 4) = x1; } }
    }
};

template <class Epi, class Sched, bool ALIGN_EPI = false, bool SP2 = false, bool HALFU = false, bool I8 = false>
__device__ __forceinline__ void gemm_phase(PG8_LAS unsigned char* lds, const Gemm g, const Sched& S, const Epi& E, int wave_) {
    int tid_ = wave_ * 64 + lane_id_fresh();
    const int tid = tid_, wid = __builtin_amdgcn_readfirstlane(tid >> 6), lane = tid & 63, wr = wid >> 2, wc = wid & 3, fr = lane & 15, fq = lane >> 4;
    constexpr int ES = I8 ? 1 : 2;
    const int K = g.K, nt = K * ES / (BK * 2);
    unsigned voffA[2], voffB[2];
#pragma unroll
    for (int i = 0; i < 2; ++i) { int R, C; stage_rc(tid * 16 + i * 8192, R, C); const int Rb = Epi::PERM ? ((R & ~31) + perm32(R & 31)) : R;
        voffA[i] = (unsigned)(R * g.lda * ES + C * 2); voffB[i] = (unsigned)(Rb * g.ldb * ES + C * 2); }
    const size_t kstep = (size_t)(BK * 2);
    const size_t hstepA = (size_t)HALF * g.lda * ES, hstepB = (size_t)HALF * g.ldb * ES;
    const size_t tstepB = 2 * hstepB;
    const unsigned ldsw = (unsigned)wid * 1024u;
    const int aoff = lds_byte(wr * 64 + fr, fq * 8), boff = lds_byte(wc * 32 + fr, fq * 8);
#define PG8_SA(b, h) (((b) * 2 + (h)) * HTB)
#define PG8_SB(b, h) ((4 + (b) * 2 + (h)) * HTB)
#define PG8_STAGE(bufoff, gbase, voff) do { _Pragma("unroll") for (int _i = 0; _i < 2; ++_i) \
        __builtin_amdgcn_global_load_lds((const unsigned*)((const char*)(gbase) + (voff)[_i]), (PG8_LAS unsigned*)(lds + (bufoff) + ldsw + _i * 8192), 16, 0, 0); } while (0)
#define PG8_LDA(dst, b, h) do { _Pragma("unroll") for (int m = 0; m < 4; ++m) _Pragma("unroll") for (int k = 0; k < 2; ++k) dst[m][k] = *(const PG8_LAS bf16x8*)(lds + PG8_SA(b, h) + aoff + m * 2048 + k * 1024); } while (0)
#define PG8_LDB(dst, b, h) do { _Pragma("unroll") for (int n = 0; n < 2; ++n) _Pragma("unroll") for (int k = 0; k < 2; ++k) dst[n][k] = *(const PG8_LAS bf16x8*)(lds + PG8_SB(b, h) + boff + n * 2048 + k * 1024); } while (0)
#define PG8_MMA(ai, bj, At, Bt) do { __builtin_amdgcn_s_setprio(1); _Pragma("unroll") for (int m = 0; m < 4; ++m) _Pragma("unroll") for (int n = 0; n < 2; ++n) _Pragma("unroll") for (int k = 0; k < 2; ++k) \
        { if constexpr (I8) acc[ai][bj][m][n] = __builtin_bit_cast(f32x4, __builtin_amdgcn_mfma_i32_16x16x64_i8(__builtin_bit_cast(i32x4, Bt[n][k]), __builtin_bit_cast(i32x4, At[m][k]), __builtin_bit_cast(i32x4, acc[ai][bj][m][n]), 0, 0, 0)); \
          else acc[ai][bj][m][n] = __builtin_amdgcn_mfma_f32_16x16x32_bf16(Bt[n][k], At[m][k], acc[ai][bj][m][n], 0, 0, 0); } __builtin_amdgcn_s_setprio(0); } while (0)
#define PG8_WAIT_V(n) asm volatile("s_waitcnt vmcnt(" #n ")" ::: "memory")
#define PG8_WAIT_L(n) asm volatile("s_waitcnt lgkmcnt(" #n ")" ::: "memory")
#define PG8_BAR __builtin_amdgcn_s_barrier()
#define PG8_SCHED __builtin_amdgcn_sched_barrier(0)
    Unit cur, nxt; int ui = 0;
    if (!S.next(0, cur)) return;
    f32x4 acc[2][2][4][2];
#pragma unroll
    for (int a = 0; a < 2; ++a)
#pragma unroll
        for (int b = 0; b < 2; ++b)
#pragma unroll
            for (int m = 0; m < 4; ++m)
#pragma unroll
                for (int n = 0; n < 2; ++n) acc[a][b][m][n] = (f32x4){0.f, 0.f, 0.f, 0.f};
    bf16x8 At[4][2], B0[2][2], B1[2][2];
    const char* cA = (const char*)g.A + (size_t)cur.pm * hstepA; const char* cB = (const char*)g.Bt + (size_t)cur.pn * tstepB;
    size_t chA = (!HALFU || cur.nh == 2) ? hstepA : 0;
    S.a_ready(cur);
    if constexpr (SP2) {
        PG8_STAGE(PG8_SB(0, 0), cB, voffB); PG8_STAGE(PG8_SB(0, 1), cB + hstepB, voffB); PG8_STAGE(PG8_SA(0, 0), cA, voffA); PG8_STAGE(PG8_SA(0, 1), cA + chA, voffA);
        if (wr == 1) PG8_BAR;
        PG8_WAIT_V(2); PG8_BAR;
        PG8_STAGE(PG8_SB(1, 0), cB + kstep, voffB); PG8_STAGE(PG8_SA(1, 0), cA + kstep, voffA); PG8_STAGE(PG8_SB(1, 1), cB + hstepB + kstep, voffB);
        PG8_WAIT_V(6); PG8_BAR;
    } else {
        PG8_STAGE(PG8_SB(0, 0), cB, voffB); PG8_STAGE(PG8_SA(0, 0), cA, voffA); PG8_STAGE(PG8_SB(0, 1), cB + hstepB, voffB); PG8_STAGE(PG8_SA(0, 1), cA + chA, voffA);
        if (wr == 1) PG8_BAR;
        PG8_WAIT_V(4); PG8_BAR;
        PG8_STAGE(PG8_SB(1, 0), cB + kstep, voffB); PG8_STAGE(PG8_SA(1, 0), cA + kstep, voffA); PG8_STAGE(PG8_SB(1, 1), cB + hstepB + kstep, voffB);
        PG8_WAIT_V(6); PG8_BAR;
    }
    for (;;) {
        const bool has_next = S.next(ui + 1, nxt);
        const char* nA = has_next ? (const char*)g.A + (size_t)nxt.pm * hstepA : cA; const size_t nhA = has_next ? ((!HALFU || nxt.nh == 2) ? hstepA : 0) : chA; const bool full = (!HALFU || cur.nh == 2);
        const char* nA_ = nA; (void)nA_; const char* nB = has_next ? (const char*)g.Bt + (size_t)nxt.pn * tstepB : cB;
        for (int t = 0; t < nt; t += 2) {
            const bool last = (t == nt - 2);
            const char* a1 = cA + (size_t)(t + 1) * kstep;
            const char* a2 = last ? nA : cA + (size_t)(t + 2) * kstep; const char* b2 = last ? nB : cB + (size_t)(t + 2) * kstep;
            const char* a3 = a2 + kstep; const char* b3 = b2 + kstep;
            const size_t h2A = last ? nhA : chA;
            if (last && has_next) S.a_ready(nxt);
            if constexpr (SP2) {
            PG8_LDB(B0, 0, 0); PG8_LDB(B1, 0, 1); PG8_SCHED; PG8_LDA(At, 0, 0); PG8_STAGE(PG8_SA(1, 1), a1 + chA, voffA);
            PG8_WAIT_V(8); PG8_WAIT_L(0); PG8_BAR; PG8_MMA(0, 0, At, B0); PG8_MMA(0, 1, At, B1); PG8_BAR; PG8_SCHED;
            PG8_LDA(At, 0, 1); PG8_STAGE(PG8_SB(0, 0), b2, voffB); PG8_STAGE(PG8_SB(0, 1), b2 + hstepB, voffB); PG8_STAGE(PG8_SA(0, 0), a2, voffA);
            PG8_WAIT_V(8); PG8_WAIT_L(0); PG8_BAR; if (full) { PG8_MMA(1, 0, At, B0); PG8_MMA(1, 1, At, B1); } PG8_BAR; PG8_SCHED;
            PG8_LDB(B0, 1, 0); PG8_LDB(B1, 1, 1); PG8_SCHED; PG8_LDA(At, 1, 0); PG8_STAGE(PG8_SA(0, 1), a2 + h2A, voffA);
            PG8_WAIT_V(8); PG8_WAIT_L(0); PG8_BAR; PG8_MMA(0, 0, At, B0); PG8_MMA(0, 1, At, B1); PG8_BAR; PG8_SCHED;
            PG8_LDA(At, 1, 1); PG8_STAGE(PG8_SB(1, 0), b3, voffB); PG8_STAGE(PG8_SB(1, 1), b3 + hstepB, voffB); PG8_STAGE(PG8_SA(1, 0), a3, voffA);
            PG8_WAIT_V(8); PG8_WAIT_L(0); PG8_BAR; if (full) { PG8_MMA(1, 0, At, B0); PG8_MMA(1, 1, At, B1); } PG8_BAR; PG8_SCHED;
            } else {
            PG8_LDB(B0, 0, 0); PG8_SCHED; PG8_LDA(At, 0, 0); PG8_STAGE(PG8_SA(1, 1), a1 + chA, voffA);
            PG8_WAIT_L(8); PG8_BAR; PG8_WAIT_L(0); PG8_MMA(0, 0, At, B0); PG8_BAR; PG8_SCHED;
            PG8_LDB(B1, 0, 1); PG8_STAGE(PG8_SB(0, 0), b2, voffB);
            PG8_BAR; PG8_WAIT_L(0); PG8_MMA(0, 1, At, B1); PG8_BAR;
            PG8_LDA(At, 0, 1); PG8_STAGE(PG8_SA(0, 0), a2, voffA);
            PG8_BAR; PG8_WAIT_L(0); if (full) PG8_MMA(1, 0, At, B0); PG8_BAR; PG8_SCHED;
            PG8_STAGE(PG8_SB(0, 1), b2 + hstepB, voffB);
            PG8_WAIT_V(6); PG8_BAR; if (full) PG8_MMA(1, 1, At, B1); PG8_BAR;
            PG8_LDB(B0, 1, 0); PG8_SCHED; PG8_LDA(At, 1, 0); PG8_STAGE(PG8_SA(0, 1), a2 + h2A, voffA);
            PG8_WAIT_L(8); PG8_BAR; PG8_WAIT_L(0); PG8_MMA(0, 0, At, B0); PG8_BAR; PG8_SCHED;
            PG8_LDB(B1, 1, 1); PG8_STAGE(PG8_SB(1, 0), b3, voffB);
            PG8_BAR; PG8_WAIT_L(0); PG8_MMA(0, 1, At, B1); PG8_BAR;
            PG8_LDA(At, 1, 1); PG8_STAGE(PG8_SA(1, 0), a3, voffA);
            PG8_BAR; PG8_WAIT_L(0); if (full) PG8_MMA(1, 0, At, B0); PG8_BAR; PG8_SCHED;
            PG8_STAGE(PG8_SB(1, 1), b3 + hstepB, voffB);
            PG8_WAIT_V(6); PG8_BAR; if (full) PG8_MMA(1, 1, At, B1); PG8_BAR;
            }
        }
        if constexpr (ALIGN_EPI) { if (wr == 0) PG8_BAR; }
        if constexpr (!Epi::AFTER_DRAIN) { E(acc, cur, wr, wc, fr, fq); S.done(cur); }
        if (!has_next) break;
#pragma unroll
        for (int a = 0; a < 2; ++a)
#pragma unroll
            for (int b = 0; b < 2; ++b)
#pragma unroll
                for (int m = 0; m < 4; ++m)
#pragma unroll
                    for (int n = 0; n < 2; ++n) acc[a][b][m][n] = (f32x4){0.f, 0.f, 0.f, 0.f};
        cur = nxt; cA = nA; cB = nB; chA = nhA; ++ui;
        if constexpr (ALIGN_EPI) { if (wr == 1) PG8_BAR; }
    }
    PG8_WAIT_V(0);
    if constexpr (!ALIGN_EPI) { if (wr == 0) PG8_BAR; }
    PG8_BAR;
#undef PG8_SA
#undef PG8_SB
#undef PG8_STAGE
#undef PG8_LDA
#undef PG8_LDB
#undef PG8_MMA
#undef PG8_WAIT_V
#undef PG8_WAIT_L
#undef PG8_BAR
#undef PG8_SCHED
}
}
namespace att {
constexpr int D = 128, NW = 8, QBLK = 32, KVBLK = 64;
constexpr float SCALE = 0.088388347648318440f;
constexpr float THR = 8.f;
constexpr int LDQ = NIN, LDK = 128, LDO = NIN;
constexpr size_t SHM_V = KVBLK * D * 2, SHM_K = KVBLK * D * 2, SHM_ATTN = 2 * SHM_V + 2 * SHM_K + NW * 64 * 4;
#define KSWZ(row, colB) ((row) * 256 + ((colB) ^ (((row) & 7) << 4)))
#define SBAR() __builtin_amdgcn_sched_barrier(0)
__device__ __forceinline__ int crow(int r, int hi) { return (r & 3) + 8 * (r >> 2) + 4 * hi; }
__device__ __forceinline__ unsigned cvtpk(float lo, float hi) { unsigned r; asm volatile("v_cvt_pk_bf16_f32 %0, %1, %2" : "=v"(r) : "v"(lo), "v"(hi)); return r; }
__device__ __forceinline__ bf16x8 ld8(const bf16_t* p) { return *reinterpret_cast<const bf16x8*>(p); }

__device__ __forceinline__ void partialSM(f32x16& p0, f32x16& p1, float& m_reg, float& mn, float& alpha) {
  constexpr float C = SCALE * 1.4426950408889634f;
  float pmax = p0[0];
#pragma unroll
  for (int r = 1; r < 16; ++r) pmax = fmaxf(pmax, p0[r]);
#pragma unroll
  for (int r = 0; r < 16; ++r) pmax = fmaxf(pmax, p1[r]);
  { auto rr = __builtin_amdgcn_permlane32_swap(__float_as_uint(pmax), __float_as_uint(pmax), false, false);
    pmax = fmaxf(__uint_as_float(rr[0]), __uint_as_float(rr[1])); }
  if (__builtin_expect(__all(pmax - m_reg <= THR / SCALE), 1)) { mn = m_reg; alpha = 1.f; }
  else { mn = fmaxf(m_reg, pmax); alpha = __builtin_amdgcn_exp2f((m_reg - mn) * C); m_reg = mn; }
  float mnC = -mn * C;
#pragma unroll
  for (int r = 0; r < 16; ++r) p0[r] = fmaf(p0[r], C, mnC);
#pragma unroll
  for (int r = 0; r < 16; ++r) p1[r] = fmaf(p1[r], C, mnC);
#pragma unroll
  for (int r = 0; r < 16; ++r) p0[r] = __builtin_amdgcn_exp2f(p0[r]);
}
__device__ __forceinline__ void finishSM(f32x16& p0, f32x16& p1, float alpha, float& l_reg, bf16x8& pa0, bf16x8& pa1, bf16x8& pa2, bf16x8& pa3) {
#pragma unroll
  for (int r = 0; r < 16; ++r) p1[r] = __builtin_amdgcn_exp2f(p1[r]);
  float ps = 0;
#pragma unroll
  for (int r = 0; r < 16; ++r) ps += p0[r];
#pragma unroll
  for (int r = 0; r < 16; ++r) ps += p1[r];
  { auto rr = __builtin_amdgcn_permlane32_swap(__float_as_uint(ps), __float_as_uint(ps), false, false);
    ps = __uint_as_float(rr[0]) + __uint_as_float(rr[1]); }
  l_reg = l_reg * alpha + ps;
#define PK4(P, BASE, OUT) do { unsigned a0 = cvtpk(P[BASE + 0], P[BASE + 1]), a1 = cvtpk(P[BASE + 2], P[BASE + 3]);   \
    unsigned b0 = cvtpk(P[BASE + 4], P[BASE + 5]), b1 = cvtpk(P[BASE + 6], P[BASE + 7]);                              \
    auto r0 = __builtin_amdgcn_permlane32_swap(a0, b0, false, false); auto r1 = __builtin_amdgcn_permlane32_swap(a1, b1, false, false); \
    u32x4 w = {r0[0], r1[0], r0[1], r1[1]}; OUT = *reinterpret_cast<bf16x8*>(&w); } while (0)
  PK4(p0, 0, pa0); PK4(p0, 8, pa1); PK4(p1, 0, pa2); PK4(p1, 8, pa3);
#undef PK4
}
__device__ __forceinline__ void qkt(f32x16& p0, f32x16& p1, const bf16_t* Ks, const bf16x8* qr, int r32, int hi) {
  p0 = f32x16{}; p1 = f32x16{};
#pragma unroll
  for (int d0 = 0; d0 < 8; ++d0) { int cb = (d0 * 16 + hi * 8) * 2;
    bf16x8 b0 = *reinterpret_cast<const bf16x8*>((const char*)Ks + KSWZ(r32, cb));
    bf16x8 b1 = *reinterpret_cast<const bf16x8*>((const char*)Ks + KSWZ(32 + r32, cb));
    p0 = __builtin_amdgcn_mfma_f32_32x32x16_bf16(b0, qr[d0], p0, 0, 0, 0);
    p1 = __builtin_amdgcn_mfma_f32_32x32x16_bf16(b1, qr[d0], p1, 0, 0, 0); }
}
__device__ __forceinline__ int v_st(int k, int c) { const int kk = (k & ~0xC) | ((k & 4) << 1) | ((k & 8) >> 1); return ((kk >> 3) * 4 + (c >> 5)) * 512 + ((kk & 7) * 32 + (c & 31)) * 2; }
__device__ __forceinline__ int v_rd_base(int lane) { return ((lane & 3) << 3) | (((lane >> 2) & 3) << 6) | (((lane >> 4) & 1) << 5) | (((lane >> 5) & 1) << 8); }
constexpr int v_rd_off(int d0, int ks, int half) { return d0 * 512 + ks * 4096 + half * 2048; }
template <int OFF> __device__ __forceinline__ s16x4 tr_read(int vb) {
  s16x4 r; asm volatile("ds_read_b64_tr_b16 %0, %1 offset:%2" : "=&v"(r) : "v"(vb), "i"(OFF) : "memory"); return r;
}
template <int D0> __device__ __forceinline__ void pv_one(f32x16& od, int vb, bf16x8 pa0, bf16x8 pa1, bf16x8 pa2, bf16x8 pa3) {
  const s16x4 l0 = tr_read<v_rd_off(D0, 0, 0)>(vb), h0 = tr_read<v_rd_off(D0, 0, 1)>(vb), l1 = tr_read<v_rd_off(D0, 1, 0)>(vb), h1 = tr_read<v_rd_off(D0, 1, 1)>(vb);
  const s16x4 l2 = tr_read<v_rd_off(D0, 2, 0)>(vb), h2 = tr_read<v_rd_off(D0, 2, 1)>(vb), l3 = tr_read<v_rd_off(D0, 3, 0)>(vb), h3 = tr_read<v_rd_off(D0, 3, 1)>(vb);
  asm volatile("s_waitcnt lgkmcnt(0)" ::: "memory"); SBAR();
#define PK(L, H) (bf16x8){L[0], L[1], L[2], L[3], H[0], H[1], H[2], H[3]}
  od = __builtin_amdgcn_mfma_f32_32x32x16_bf16(pa0, PK(l0, h0), od, 0, 0, 0);
  od = __builtin_amdgcn_mfma_f32_32x32x16_bf16(pa1, PK(l1, h1), od, 0, 0, 0);
  od = __builtin_amdgcn_mfma_f32_32x32x16_bf16(pa2, PK(l2, h2), od, 0, 0, 0);
  od = __builtin_amdgcn_mfma_f32_32x32x16_bf16(pa3, PK(l3, h3), od, 0, 0, 0);
#undef PK
}
__device__ __forceinline__ void pv_d0(f32x16* o, int vb, bf16x8 pa0, bf16x8 pa1, bf16x8 pa2, bf16x8 pa3) {
  pv_one<0>(o[0], vb, pa0, pa1, pa2, pa3); pv_one<1>(o[1], vb, pa0, pa1, pa2, pa3); pv_one<2>(o[2], vb, pa0, pa1, pa2, pa3); pv_one<3>(o[3], vb, pa0, pa1, pa2, pa3);
}

__device__ __forceinline__ void attn_dense_body(const bf16_t* __restrict__ Qb, const bf16_t* __restrict__ Kh, const bf16_t* __restrict__ Vh,
                                                bf16_t* Ob, int seq, char* lds, int wave_) {
  constexpr int SDEPTH = 2;
  int tid_ = wave_ * 64 + lane_id_fresh();
  const int tid = tid_, wid = tid >> 6, lane = tid & 63, r32 = lane & 31, hi = lane >> 5;
  bf16_t* V_lds = (bf16_t*)lds; bf16_t* K_lds = (bf16_t*)(lds + 2 * SHM_V);
  float* ws = (float*)(lds + 2 * SHM_V + 2 * SHM_K) + wid * 64; float* li_l = ws; float* al_l = ws + 32;
  float m_reg = -1e30f, l_reg = 0; f32x16 o[4] = {}; bf16x8 qr[8];
  const bf16_t* Qw = Qb + (long)(wid * QBLK + r32) * LDQ + hi * 8;
#pragma unroll
  for (int d0 = 0; d0 < 8; ++d0) qr[d0] = ld8(Qw + d0 * 16);
  const int sr = tid >> 4, sc = (tid & 15) * 8, vst0 = v_st(sr, sc), vst1 = v_st(32 + sr, sc);
  const int vb0 = (int)(uintptr_t)V_lds + v_rd_base(lane);
  struct { bf16x8 vs0, vs1, ks0, ks1; } sr_[SDEPTH];
#define SLOAD(i, k0) do { sr_[i].vs0 = ld8(&Vh[(long)((k0) + sr) * LDK + sc]); sr_[i].vs1 = ld8(&Vh[(long)((k0) + 32 + sr) * LDK + sc]); \
    sr_[i].ks0 = ld8(&Kh[(long)((k0) + sr) * LDK + sc]); sr_[i].ks1 = ld8(&Kh[(long)((k0) + 32 + sr) * LDK + sc]); } while (0)
#define SWRITE(b, i) do { *(bf16x8*)((char*)V_lds + (b) * SHM_V + vst0) = sr_[i].vs0;          \
    *(bf16x8*)((char*)V_lds + (b) * SHM_V + vst1) = sr_[i].vs1; int kc = sc * 2;               \
    *(bf16x8*)((char*)K_lds + (b) * SHM_K + KSWZ(sr, kc)) = sr_[i].ks0;                       \
    *(bf16x8*)((char*)K_lds + (b) * SHM_K + KSWZ(32 + sr, kc)) = sr_[i].ks1; } while (0)
#define SWAIT() asm volatile("s_waitcnt vmcnt(4)" ::: "memory")
#define RESC(a) do { if (__any((a) < 1.f)) { if (hi == 0) al_l[r32] = (a); asm volatile("s_waitcnt lgkmcnt(0)" ::: "memory"); \
    _Pragma("unroll") for (int d = 0; d < 4; ++d) _Pragma("unroll") for (int r = 0; r < 16; ++r) o[d][r] *= al_l[crow(r, hi)]; } } while (0)
  f32x16 pA0, pA1, pB0, pB1; float mnA, mnB, alA, alB; bf16x8 pa0, pa1, pa2, pa3; const int NT = seq / KVBLK;
  constexpr int SE = 0, SO = SDEPTH - 1;
  SLOAD(SE, 0); asm volatile("s_waitcnt vmcnt(0)" ::: "memory"); SWRITE(0, SE); __syncthreads();
  qkt(pA0, pA1, K_lds, qr, r32, hi); partialSM(pA0, pA1, m_reg, mnA, alA);
  SLOAD(SO, KVBLK); if (2 < NT) SLOAD(SE, 2 * KVBLK);
  SWAIT(); SWRITE(1, SO); __syncthreads();
  for (int j = 1; j + 1 < NT; j += 2) {
    SBAR(); qkt(pB0, pB1, (bf16_t*)((char*)K_lds + SHM_K), qr, r32, hi);
    finishSM(pA0, pA1, alA, l_reg, pa0, pa1, pa2, pa3); SBAR();
    SLOAD(SO, (j + SDEPTH) * KVBLK); SBAR();
    pv_d0(o, vb0, pa0, pa1, pa2, pa3); partialSM(pB0, pB1, m_reg, mnB, alB);
    __syncthreads(); SWAIT(); SWRITE(0, SE);
    RESC(alB); __syncthreads();
    SBAR(); qkt(pA0, pA1, K_lds, qr, r32, hi);
    finishSM(pB0, pB1, alB, l_reg, pa0, pa1, pa2, pa3); SBAR();
    if (j + 3 < NT) SLOAD(SE, (j + 1 + SDEPTH) * KVBLK); SBAR();
    pv_d0(o, vb0 + (int)SHM_V, pa0, pa1, pa2, pa3); partialSM(pA0, pA1, m_reg, mnA, alA);
    __syncthreads(); SWAIT(); SWRITE(1, SO);
    RESC(alA); __syncthreads();
  }
  SBAR(); qkt(pB0, pB1, (bf16_t*)((char*)K_lds + SHM_K), qr, r32, hi);
  finishSM(pA0, pA1, alA, l_reg, pa0, pa1, pa2, pa3); SBAR();
  pv_d0(o, vb0, pa0, pa1, pa2, pa3); partialSM(pB0, pB1, m_reg, mnB, alB);
  __syncthreads(); RESC(alB);
  finishSM(pB0, pB1, alB, l_reg, pa0, pa1, pa2, pa3); SBAR();
  pv_d0(o, vb0 + (int)SHM_V, pa0, pa1, pa2, pa3);
  if (hi == 0) li_l[r32] = l_reg; asm volatile("s_waitcnt lgkmcnt(0)" ::: "memory");
  float rli[16];
#pragma unroll
  for (int r = 0; r < 16; ++r) rli[r] = __builtin_amdgcn_rcpf(li_l[crow(r, hi)]);
  bf16_t* Ow = Ob + (long)(wid * QBLK) * LDO;
#pragma unroll
  for (int r = 0; r < 16; ++r) { int orow = crow(r, hi);
#pragma unroll
    for (int d0 = 0; d0 < 4; ++d0) Ow[(long)orow * LDO + d0 * 32 + r32] = f2bf(o[d0][r] * rli[r]); }
  __syncthreads();
#undef SLOAD
#undef SWRITE
#undef SWAIT
#undef RESC
}
#undef KSWZ
#undef SBAR
}
#define CAS __attribute__((address_space(4)))
#define INP(i) ((const float*)(GAS const float*)in[i])
struct Ctx {
    float* out; unsigned char* ws;
    LAS unsigned char* lds; int tid, lane, wave, wg, G;
};
enum { I_X = 0, I_C, I_CTX, I_CCTX, I_WMOD, I_BMOD, I_NMIX, I_NFFN, I_WIN, I_QN, I_KN, I_LCW, I_LCB, I_LWA, I_LBA, I_LWX, I_LBX, I_LLAM, I_SCW, I_SCB,
       I_WOA, I_WOL, I_WOS, I_WOUT, I_PWQ, I_PK1, I_PK2, I_PU, I_PV };

__device__ __forceinline__ float* xrow_ptr(const Ctx& c, int r) {
    return r < MLAT ? c.out + (size_t)r * DM : (float*)(c.ws + WS_CTXS) + (size_t)(r - MLAT) * DM;
}

template <bool I8 = false>
__device__ __forceinline__ void transpose_item(const float* W, int K, int N, bf16_t* WT, LAS float* scr, int item, int lane, const float* cmax = nullptr, float* wdq = nullptr, LAS float* scol = nullptr) {
    const int nblk = N / 64, kb = item / nblk, nb = item % nblk, k0 = 64 * kb, n0 = 64 * nb;
    if constexpr (I8) { float mx = 0.f;
#pragma unroll 8
        for (int kc = 0; kc < 32; ++kc) mx = fmaxf(mx, cmax[(size_t)kc * N + n0 + lane]);
        scol[lane] = mx > 0.f ? 127.f / mx : 0.f;
        if (kb == 0) wdq[n0 + lane] = mx * (1.f / 127.f); }
    const float* src = W + (size_t)(k0 + (lane >> 4)) * N + n0 + (lane & 15) * 4;
    f32x4 v[16];
#pragma unroll
    for (int i = 0; i < 16; ++i) v[i] = *(const f32x4*)(src + (size_t)(4 * i) * N);
    LAS float* d = scr + (lane >> 4) * 65 + (lane & 15) * 4;
#pragma unroll
    for (int i = 0; i < 16; ++i) { d[(4 * i) * 65 + 0] = v[i][0]; d[(4 * i) * 65 + 1] = v[i][1]; d[(4 * i) * 65 + 2] = v[i][2]; d[(4 * i) * 65 + 3] = v[i][3]; }
    LDS_WAIT(); asm volatile("" ::: "memory");
    const int c = lane & 7;
#pragma unroll
    for (int j = 0; j < 8; ++j) { const int n = (lane >> 3) + 8 * j; const LAS float* s = scr + (8 * c) * 65 + n;
        if constexpr (I8) { const float q_ = scol[n]; u32x2 o; o.x = pk4_i8(s[0 * 65] * q_, s[1 * 65] * q_, s[2 * 65] * q_, s[3 * 65] * q_); o.y = pk4_i8(s[4 * 65] * q_, s[5 * 65] * q_, s[6 * 65] * q_, s[7 * 65] * q_);
            *(u32x2*)((unsigned char*)WT + (size_t)(n0 + n) * K + k0 + 8 * c) = o; }
        else { u32x4 o; o.x = cvt_pk_bf16(s[0 * 65], s[1 * 65]); o.y = cvt_pk_bf16(s[2 * 65], s[3 * 65]); o.z = cvt_pk_bf16(s[4 * 65], s[5 * 65]); o.w = cvt_pk_bf16(s[6 * 65], s[7 * 65]);
            *(u32x4*)(WT + (size_t)(n0 + n) * K + k0 + 8 * c) = o; } }
    LDS_WAIT(); asm volatile("" ::: "memory");
}

__device__ __forceinline__ void mod_unit(const Ctx& c, CAS const unsigned long long* in, int l, int cb) {
    LAS float* sv = (LAS float*)c.lds;
    LAS float* red = sv + 3 * DM;
    { const float* cc = INP(I_C); const float* cx = INP(I_CCTX);
      for (int i = c.tid; i < 3 * DM; i += NTHREADS) { const int v = i / DM, k = i % DM; const float x = v < 2 ? cc[v * DM + k] : cx[k]; sv[i] = x * sigmoidf_(x); } }
    __syncthreads();
    const int j4 = (c.tid & 31) * 4, kg = c.tid >> 5;
    const float* w = INP(I_WMOD) + (size_t)l * DM * NMOD + (size_t)(kg * 128) * NMOD + cb * 128 + j4;
    f32x4 a0 = {0.f, 0.f, 0.f, 0.f}, a1 = a0, a2 = a0;
#pragma unroll 8
    for (int k = 0; k < 128; ++k) { const f32x4 wv = *(const f32x4*)(w + (size_t)k * NMOD); const int kk = kg * 128 + k; a0 += wv * sv[kk]; a1 += wv * sv[DM + kk]; a2 += wv * sv[2 * DM + kk]; }
    *(LAS f32x4*)(red + (kg * 3 + 0) * 128 + j4) = a0; *(LAS f32x4*)(red + (kg * 3 + 1) * 128 + j4) = a1; *(LAS f32x4*)(red + (kg * 3 + 2) * 128 + j4) = a2;
    __syncthreads();
    if (c.tid < 384) { const int v = c.tid >> 7, jj = c.tid & 127; float s = INP(I_BMOD)[l * NMOD + cb * 128 + jj];
#pragma unroll
        for (int g = 0; g < 16; ++g) s += red[(g * 3 + v) * 128 + jj];
        ((float*)(c.ws + WS_MOD))[((size_t)l * 3 + v) * NMOD + cb * 128 + jj] = s; }
    __syncthreads();
}

__device__ __forceinline__ void wsc_unit(const Ctx& c, CAS const unsigned long long* in, int l, int u) {
    const int hh = u >> 4, kb = u & 15, h = hh >> 1, half = hh & 1, k0 = kb * 128;
    LAS float* kkL = (LAS float*)c.lds;
    LAS float* wqL = kkL + 128 * 132;
    const float* ksrc = INP(half ? I_PK2 : I_PK1) + ((size_t)(l * 8 + h) * 128) * 128;
    const float* qsrc = INP(I_PWQ) + (size_t)l * DM * DM + (size_t)k0 * DM + hh * 128;
    for (int i = c.tid; i < 128 * 32; i += NTHREADS) { const int r = i >> 5, c4 = (i & 31) * 4;
        *(LAS f32x4*)(kkL + r * 132 + c4) = *(const f32x4*)(ksrc + (size_t)r * 128 + c4);
        *(LAS f32x4*)(wqL + r * 132 + c4) = *(const f32x4*)(qsrc + (size_t)r * DM + c4); }
    __syncthreads();
    const int k = c.tid & 127, ng = c.tid >> 7;
    float acc[32];
#pragma unroll
    for (int j = 0; j < 32; ++j) acc[j] = 0.f;
    for (int d4 = 0; d4 < 32; ++d4) {
        const f32x4 a = *(const LAS f32x4*)(wqL + k * 132 + d4 * 4);
#pragma unroll
        for (int j = 0; j < 32; ++j) { const f32x4 b = *(const LAS f32x4*)(kkL + (ng * 32 + j) * 132 + d4 * 4); acc[j] += (a[0] * b[0] + a[1] * b[1]) + (a[2] * b[2] + a[3] * b[3]); }
    }
    bf16_t* dst = (bf16_t*)(c.ws + ws_wsc(l)) + (size_t)(hh * 128 + ng * 32) * DM + k0 + k;
#pragma unroll
    for (int j = 0; j < 32; ++j) dst[(size_t)j * DM] = f2bf(acc[j]);
    __syncthreads();
}

#define GET_IN() unsigned long long kai_ = (unsigned long long)__builtin_amdgcn_kernarg_segment_ptr(); asm volatile("" : "+s"(kai_)); CAS const unsigned long long* in = (CAS const unsigned long long*)kai_
__device__ __forceinline__ void conv_units(const Ctx& c, int l) {
    GET_IN();
    if (l == 0) for (int u = c.wg; u < 2 * 96; u += c.G) mod_unit(c, in, u / 96, u % 96);
    for (int u = c.wg; u < 256; u += c.G) wsc_unit(c, in, l, u);
}
enum { CV_WIN = 1, CV_WO = 2, CV_WOUT = 4, CV_PU = 8, CV_PV = 16, CV_LRU = 32, CV_ALL = 63 };
__device__ __forceinline__ void conv_transposes(const Ctx& c, int l, int what = CV_ALL) {
    GET_IN();
    const int gw = c.wg * NWAVES + c.wave, NGW = c.G * NWAVES;
    LAS float* scr = (LAS float*)(c.lds + c.wave * 16640);
    constexpr int I_IN = (DM / 64) * (NIN / 64), I_SQ = (DM / 64) * (DM / 64);
    const float* win = INP(I_WIN) + (size_t)l * DM * NIN;
    if (what & CV_WIN) for (int it = gw; it < I_IN; it += NGW)
        transpose_item<true>(win, DM, NIN, (bf16_t*)(c.ws + WS_WIN), scr, it, c.lane, (const float*)(c.ws + WS_CMAX) + (size_t)l * 32 * NIN, (float*)(c.ws + WS_WDQ), (LAS float*)(c.lds + 8 * 16640 + c.wave * 256));
    for (int s = 0; s < 4; ++s) { if (!(what & (s < 3 ? CV_WO : CV_WOUT))) continue;
        const float* src = INP(s == 0 ? I_WOA : s == 1 ? I_WOL : s == 2 ? I_WOS : I_WOUT) + (size_t)l * DM * DM;
        bf16_t* dst = s < 3 ? (bf16_t*)(c.ws + WS_WO) + (size_t)s * DM * DM : (bf16_t*)(c.ws + WS_WOUT);
        for (int it = gw; it < I_SQ; it += NGW) transpose_item(src, DM, DM, dst, scr, it, c.lane);
    }
}
__device__ __forceinline__ void conv_colmax(const Ctx& c) {
    GET_IN();
    const size_t gt = (size_t)c.wg * NTHREADS + c.tid, NT = (size_t)c.G * NTHREADS;
    constexpr int C4 = NIN / 4;
    for (size_t u = gt; u < (size_t)NLAYER * 32 * C4; u += NT) { const int c4 = (int)(u % C4), lk = (int)(u / C4);
        const float* src = INP(I_WIN) + (size_t)lk * 64 * NIN + c4 * 4;
        f32x4 m = {0.f, 0.f, 0.f, 0.f};
#pragma unroll 16
        for (int k = 0; k < 64; ++k) { const f32x4 v = *(const f32x4*)(src + (size_t)k * NIN); m[0] = fmaxf(m[0], fabsf(v[0])); m[1] = fmaxf(m[1], fabsf(v[1])); m[2] = fmaxf(m[2], fabsf(v[2])); m[3] = fmaxf(m[3], fabsf(v[3])); }
        *(f32x4*)((float*)(c.ws + WS_CMAX) + (size_t)lk * NIN + c4 * 4) = m; }
}
__device__ __forceinline__ void conv_tables(const Ctx& c, int l, int what = CV_ALL) {
    GET_IN();
    const size_t gt = (size_t)c.wg * NTHREADS + c.tid, NT = (size_t)c.G * NTHREADS;
    constexpr size_t NG16 = (size_t)16384 * DM / 16;
    if (what & CV_PU) {
        const int gw = c.wg * NWAVES + c.wave, NGW = c.G * NWAVES;
        const float* srcb = INP(I_PU) + (size_t)l * 16384 * DM; unsigned char* dstb = (unsigned char*)(c.ws + ws_pu(l)); float* usc = (float*)(c.ws + WS_USC) + (size_t)l * 16384;
#pragma unroll 1
        for (int e = gw; e < 16384; e += NGW) { const float* src = srcb + (size_t)e * DM + c.lane * 32;
            f32x4 v[8]; float mx = 0.f;
#pragma unroll
            for (int i = 0; i < 8; ++i) { v[i] = *(const f32x4*)(src + i * 4); mx = fmaxf(fmaxf(mx, fmaxf(fabsf(v[i][0]), fabsf(v[i][1]))), fmaxf(fabsf(v[i][2]), fabsf(v[i][3]))); }
#pragma unroll
            for (int o = 32; o > 0; o >>= 1) mx = fmaxf(mx, __shfl_xor(mx, o));
            const float st_ = mx * (0.72f / 7.f);
            const float q_ = st_ > 0.f ? 1.f / st_ : 0.f;
            if (c.lane == 0) usc[e] = st_;
            u32x4 o4;
#pragma unroll
            for (int d = 0; d < 4; ++d) { unsigned w_ = 0u;
#pragma unroll
                for (int t = 0; t < 4; ++t) { const unsigned lo_ = (unsigned)min(max((int)__builtin_rintf(v[2 * d][t] * q_), -7), 7) & 15u, hi_ = (unsigned)min(max((int)__builtin_rintf(v[2 * d + 1][t] * q_), -7), 7) & 15u; w_ |= (lo_ << (8 * t)) | (hi_ << (8 * t + 4)); }
                o4[d] = w_; }
            *(u32x4*)(dstb + (size_t)e * 1024 + c.lane * 16) = o4; } }
#pragma unroll 1
    for (int tb = 1; tb < 2; ++tb) { if (!(what & (tb ? CV_PV : CV_PU))) continue;
        const float* srcb = INP(tb ? I_PV : I_PU) + (size_t)l * 16384 * DM; unsigned char* dstb = (unsigned char*)(c.ws + (tb ? ws_pv(l) : ws_pu(l)));
        const float sc = tb ? 1.f : 32.f;
        for (size_t j = gt; j < NG16; j += 2 * NT) {
            const size_t j2 = j + NT; const bool has2 = j2 < NG16;
            f32x4 a[4], b[4];
#pragma unroll
            for (int d = 0; d < 4; ++d) a[d] = *(const f32x4*)(srcb + j * 16 + d * 4);
#pragma unroll
            for (int d = 0; d < 4; ++d) b[d] = has2 ? *(const f32x4*)(srcb + j2 * 16 + d * 4) : (f32x4){0.f, 0.f, 0.f, 0.f};
            u32x4 o, o2;
#pragma unroll
            for (int d = 0; d < 4; ++d) { const f32x4 x = a[d] * sc, y = b[d] * sc;
                int w = __builtin_amdgcn_cvt_pk_fp8_f32(x[0], x[1], 0, false); w = __builtin_amdgcn_cvt_pk_fp8_f32(x[2], x[3], w, true); o[d] = (unsigned)w;
                int w2 = __builtin_amdgcn_cvt_pk_fp8_f32(y[0], y[1], 0, false); w2 = __builtin_amdgcn_cvt_pk_fp8_f32(y[2], y[3], w2, true); o2[d] = (unsigned)w2; }
            if (tb == 0) { *(u32x4*)(dstb + j * 16) = o; if (has2) *(u32x4*)(dstb + j2 * 16) = o2; }
            else {
                *(u32x4*)(dstb + (size_t)((j & 127) >> 3) * ((size_t)16384 * 128) + (j >> 7) * 128 + (j & 7) * 16) = o;
                if (has2) *(u32x4*)(dstb + (size_t)((j2 & 127) >> 3) * ((size_t)16384 * 128) + (j2 >> 7) * 128 + (j2 & 7) * 16) = o2; } }
    }
    if (what & CV_LRU) for (size_t i = gt; i < (size_t)16 * 512 * 128; i += NT) { const int ci = (int)(i & 127), j = (int)((i >> 7) & 511), n = (int)(i >> 16), d = j >> 8, which = (j >> 7) & 1, dd = j & 127;
        const float* src = INP(which ? I_LWX : I_LWA) + ((((size_t)(l * 2 + d) * 16 + n) * 128 + ci) * 128 + dd);
        ((bf16_t*)(c.ws + WS_WLRU))[i] = f2bf(*src); }
}
__device__ __forceinline__ void sp_copy(const Ctx& c, const float* src, int sp_off, int n) {
    const size_t gt = (size_t)c.wg * NTHREADS + c.tid, NT = (size_t)c.G * NTHREADS;
    for (size_t i = gt; i < (size_t)n; i += NT) ((float*)(c.ws + WS_SP))[sp_off + i] = src[i];
}
__device__ __forceinline__ void conv_small(const Ctx& c, int l) {
    GET_IN();
    const size_t gt = (size_t)c.wg * NTHREADS + c.tid, NT = (size_t)c.G * NTHREADS;
    sp_copy(c, INP(I_NMIX) + l * DM, SP_NMIX, DM); sp_copy(c, INP(I_NFFN) + l * DM, SP_NFFN, DM);
    sp_copy(c, INP(I_QN) + l * 128, SP_QN, 128); sp_copy(c, INP(I_KN) + l * 128, SP_KN, 128);
    sp_copy(c, INP(I_LCW) + l * 4 * DM, SP_LCW, 4 * DM); sp_copy(c, INP(I_LCB) + l * DM, SP_LCB, DM);
    sp_copy(c, INP(I_LBA) + l * 2 * DM, SP_LBA, 2 * DM); sp_copy(c, INP(I_LBX) + l * 2 * DM, SP_LBX, 2 * DM);
    sp_copy(c, INP(I_SCW) + l * 3 * DM, SP_SCW, 3 * DM); sp_copy(c, INP(I_SCB) + l * DM, SP_SCB, DM);
    { const float* lam = INP(I_LLAM) + l * 2 * DM;
      for (size_t i = gt; i < (size_t)2 * DM; i += NT) ((float*)(c.ws + WS_SP))[SP_LSP + i] = 8.f * log1pf(expf(-lam[i])); }
}
__device__ __forceinline__ void conv_once(const Ctx& c) {
    const size_t gt = (size_t)c.wg * NTHREADS + c.tid, NT = (size_t)c.G * NTHREADS;
    for (size_t i = gt; i < 128 * 32; i += NT) { const int pos = (int)(i >> 5), p = (int)(i & 31);
        const float inv = exp2f(-(float)p * (13.287712379549449f / 32.f)); const float ang = (float)pos * inv;
        float sn, cs; sincosf(ang, &sn, &cs);
        ((float*)(c.ws + WS_ROPE))[i] = cs; ((float*)(c.ws + WS_ROPE))[128 * 32 + i] = sn; }
}

template <bool I8 = false>
__device__ __forceinline__ void phase_norm(const Ctx& c, int l, int nrows, int sp_gain, int slot_shift, const float* xin = nullptr, const float* cin = nullptr) {
    const int gw = c.wg * NWAVES + c.wave, NGW = c.G * NWAVES;
    const float* modl = (const float*)(c.ws + WS_MOD) + (size_t)l * 3 * NMOD;
    bf16_t* HX = (bf16_t*)(c.ws + WS_HX); const float* gain = (const float*)(c.ws + WS_SP) + sp_gain;
    for (int r = gw; r < nrows; r += NGW) {
        const int vec = r < SEQ ? 0 : (r < MLAT ? 1 : 2);
        const float* xr = xin ? (r < MLAT ? xin + (size_t)r * DM : cin + (size_t)(r - MLAT) * DM) : xrow_ptr(c, r); const float* sh = modl + (size_t)vec * NMOD + slot_shift * DM; const float* sc = sh + DM;
        f32x4 v[8]; float ss = 0.f;
#pragma unroll
        for (int j = 0; j < 8; ++j) { v[j] = *(const f32x4*)(xr + j * 256 + c.lane * 4); ss += (v[j][0] * v[j][0] + v[j][1] * v[j][1]) + (v[j][2] * v[j][2] + v[j][3] * v[j][3]); }
        const float rs = rsqrtf(wave_sum(ss) * (1.f / DM) + EPS);
        if constexpr (I8) { float mx = 0.f;
#pragma unroll
            for (int j = 0; j < 8; ++j) { const int col = j * 256 + c.lane * 4;
                const f32x4 g = *(const f32x4*)(gain + col), s1 = *(const f32x4*)(sc + col), s0 = *(const f32x4*)(sh + col);
                v[j] = (v[j] * rs * g) * (s1 + 1.f) + s0;
                mx = fmaxf(fmaxf(mx, fmaxf(fabsf(v[j][0]), fabsf(v[j][1]))), fmaxf(fabsf(v[j][2]), fabsf(v[j][3]))); }
#pragma unroll
            for (int o = 32; o > 0; o >>= 1) mx = fmaxf(mx, __shfl_xor(mx, o));
            const float q_ = mx > 0.f ? 127.f / mx : 0.f;
            if (c.lane == 0) ((float*)(c.ws + WS_ADQ))[r] = mx * (1.f / 127.f);
#pragma unroll
            for (int j = 0; j < 8; ++j) *(unsigned*)((unsigned char*)HX + (size_t)r * DM + j * 256 + c.lane * 4) = pk4_i8(v[j][0] * q_, v[j][1] * q_, v[j][2] * q_, v[j][3] * q_);
        } else {
#pragma unroll
        for (int j = 0; j < 8; ++j) { const int col = j * 256 + c.lane * 4;
            const f32x4 g = *(const f32x4*)(gain + col), s1 = *(const f32x4*)(sc + col), s0 = *(const f32x4*)(sh + col);
            const f32x4 y = (v[j] * rs * g) * (s1 + 1.f) + s0;
            u32x2 o; o.x = cvt_pk_bf16(y[0], y[1]); o.y = cvt_pk_bf16(y[2], y[3]);
            *(u32x2*)(HX + (size_t)r * DM + col) = o; } }
    }
}
__device__ __forceinline__ void seg_of_row(int r, bool& is_ctx, int& b, int& t) {
    is_ctx = r >= MLAT; b = is_ctx ? (r - MLAT) >> 8 : r >> 13; t = is_ctx ? (r - MLAT) & 255 : r & (SEQ - 1);
}
__device__ __forceinline__ void qk_row(const Ctx& c, int l, int r, bool do_q, bool dry) {
    bool is_ctx; int b, t; seg_of_row(r, is_ctx, b, t);
    const int key = is_ctx ? t : CTXL + t;
    bf16_t* prow = (bf16_t*)(c.ws + WS_P) + (size_t)r * NIN;
    bf16_t* KC = (bf16_t*)(c.ws + WS_KC); bf16_t* VC = (bf16_t*)(c.ws + WS_VC);
    const int hs = c.lane >> 4, ax = (c.lane >> 3) & 1, p0 = (c.lane & 7) * 4;
    f32x4 cs = {1.f, 1.f, 1.f, 1.f}, sn = {0.f, 0.f, 0.f, 0.f};
    if (!is_ctx) { const int pos = ax ? (t & 63) : (t >> 6); const float* rt = (const float*)(c.ws + WS_ROPE) + pos * 32 + p0; cs = *(const f32x4*)rt; sn = *(const f32x4*)(rt + 128 * 32); }
    u32x2 w1[5], w2[5];
#pragma unroll
    for (int g = 0; g < 5; ++g) { const bool is_k = (g == 4); const int head = is_k ? hs : g * 4 + hs;
        const bf16_t* src = prow + (is_k ? CK : CQ) + head * 128 + ax * 64 + p0;
        if (is_k || do_q) { w1[g] = *(const u32x2*)src; w2[g] = *(const u32x2*)(src + 32); } else { w1[g] = (u32x2){0u, 0u}; w2[g] = (u32x2){0u, 0u}; } }
    const u32x4 vw = *(const u32x4*)(prow + CV + (c.lane >> 4) * 128 + (c.lane & 15) * 8);
#pragma unroll
    for (int g = 0; g < 5; ++g) {
        const bool is_k = (g == 4);
        if (!is_k && !do_q) continue;
        const int head = is_k ? hs : g * 4 + hs;
        bf16_t* src = prow + (is_k ? CK : CQ) + head * 128 + ax * 64 + p0;
        f32x4 t1 = {bf_lo(w1[g].x), bf_hi(w1[g].x), bf_lo(w1[g].y), bf_hi(w1[g].y)}, t2 = {bf_lo(w2[g].x), bf_hi(w2[g].x), bf_lo(w2[g].y), bf_hi(w2[g].y)};
        float ss = (t1[0] * t1[0] + t1[1] * t1[1]) + (t1[2] * t1[2] + t1[3] * t1[3]) + (t2[0] * t2[0] + t2[1] * t2[1]) + (t2[2] * t2[2] + t2[3] * t2[3]);
        ss += DPPF(ss, 0xB1); ss += DPPF(ss, 0x4E); ss += DPPF(ss, 0x141); ss += DPPF(ss, 0x140);
        const float rs = rsqrtf(ss * (1.f / 128.f) + EPS);
        const float* gn = (const float*)(c.ws + WS_SP) + (is_k ? SP_KN : SP_QN) + ax * 64 + p0;
        const f32x4 g1 = *(const f32x4*)gn, g2 = *(const f32x4*)(gn + 32);
        const f32x4 y1 = t1 * rs * g1, y2 = t2 * rs * g2;
        const f32x4 o1 = y1 * cs - y2 * sn, o2 = y2 * cs + y1 * sn;
        bf16_t* dst = is_k ? KC + ((size_t)(b * 4 + head) * NKEY + key) * 128 + ax * 64 + p0 : (dry ? (bf16_t*)(c.ws + WS_YF) + (size_t)r * DM + head * 128 + ax * 64 + p0 : src);
        u32x2 a; a.x = cvt_pk_bf16(o1[0], o1[1]); a.y = cvt_pk_bf16(o1[2], o1[3]);
        u32x2 bq; bq.x = cvt_pk_bf16(o2[0], o2[1]); bq.y = cvt_pk_bf16(o2[2], o2[3]);
        *(u32x2*)dst = a; *(u32x2*)(dst + 32) = bq;
    }
    { const int hv = c.lane >> 4, dd = (c.lane & 15) * 8;
      *(u32x4*)(VC + ((size_t)(b * 4 + hv) * NKEY + key) * 128 + dd) = vw; }
}
__device__ __forceinline__ void unpack8(const u32x4 w, float (&f)[8]) {
    f[0] = bf_lo(w.x); f[1] = bf_hi(w.x); f[2] = bf_lo(w.y); f[3] = bf_hi(w.y); f[4] = bf_lo(w.z); f[5] = bf_hi(w.z); f[6] = bf_lo(w.w); f[7] = bf_hi(w.w);
}
__device__ __forceinline__ void sc_row(const Ctx& c, int l, int r, bool dry) {
    bool is_ctx; int b, t; seg_of_row(r, is_ctx, b, t);
    const int seglen = is_ctx ? CTXL : SEQ;
    bf16_t* prow = (bf16_t*)(c.ws + WS_P) + (size_t)r * NIN;
    const bool hp = t > 0, hn = t < seglen - 1;
    const float* w = (const float*)(c.ws + WS_SP) + SP_SCW; const float* bias = (const float*)(c.ws + WS_SP) + SP_SCB;
    u32x4 xb[4], xc0[4], xu0[4], xcp[4], xup[4], xcn[4], xun[4];
    const u32x4 z = {0u, 0u, 0u, 0u};
#pragma unroll
    for (int it = 0; it < 4; ++it) { const int col = it * 512 + c.lane * 8;
        xb[it] = *(const u32x4*)(prow + CBG + col); xc0[it] = *(const u32x4*)(prow + CCG + col); xu0[it] = *(const u32x4*)(prow + CU + col);
        xcp[it] = hp ? *(const u32x4*)(prow - NIN + CCG + col) : z; xup[it] = hp ? *(const u32x4*)(prow - NIN + CU + col) : z;
        xcn[it] = hn ? *(const u32x4*)(prow + NIN + CCG + col) : z; xun[it] = hn ? *(const u32x4*)(prow + NIN + CU + col) : z; }
#pragma unroll
    for (int it = 0; it < 4; ++it) {
        const int col = it * 512 + c.lane * 8;
        float bg[8], c0[8], u0[8], cp[8], up[8], cn[8], un[8];
        unpack8(xb[it], bg); unpack8(xc0[it], c0); unpack8(xu0[it], u0); unpack8(xcp[it], cp); unpack8(xup[it], up); unpack8(xcn[it], cn); unpack8(xun[it], un);
        float o[8];
#pragma unroll
        for (int hq = 0; hq < 2; ++hq) { const f32x4 w0 = *(const f32x4*)(w + col + hq * 4), w1 = *(const f32x4*)(w + DM + col + hq * 4), w2 = *(const f32x4*)(w + 2 * DM + col + hq * 4), bi = *(const f32x4*)(bias + col + hq * 4);
#pragma unroll
            for (int e = 0; e < 4; ++e) { const int k = hq * 4 + e; o[k] = bg[k] * (bi[e] + w0[e] * (cp[k] * up[k]) + w1[e] * (c0[k] * u0[k]) + w2[e] * (cn[k] * un[k])); } }
        u32x4 ow; ow.x = cvt_pk_bf16(o[0], o[1]); ow.y = cvt_pk_bf16(o[2], o[3]); ow.z = cvt_pk_bf16(o[4], o[5]); ow.w = cvt_pk_bf16(o[6], o[7]);
        *(u32x4*)((dry ? (bf16_t*)(c.ws + WS_YF) + (size_t)(MALL + r) * DM : prow + CBG) + col) = ow;
    }
}

constexpr size_t lsum_idx(int which, int dir, int b, int j) { return ((((size_t)which * 2 + dir) * NB + b) * NCHUNK + j) * DM; }
template <int DIR, int PASS>
__device__ __forceinline__ void lru_chunk(const LAS bf16_t* ub, const LAS float* uf, LAS float* hsd, const bf16x8 (&bfr)[4][4], const float (&ba)[2], const float (&bx)[2], const float (&sp8)[2],
                                          const float (&cin)[2], float (&Atot)[2], float (&Hend)[2], int q, int col16, int quad) {
    float st[2] = {cin[0], cin[1]}, at[2] = {1.f, 1.f};
    const int mysg = DIR ? 3 - quad : quad;
    for (int smt = 0; smt < 4; ++smt) {
        const int mt = DIR ? 3 - smt : smt;
        f32x4 acc[4];
#pragma unroll
        for (int nt = 0; nt < 4; ++nt) acc[nt] = (f32x4){0.f, 0.f, 0.f, 0.f};
#pragma unroll
        for (int ks = 0; ks < 4; ++ks) { const bf16x8 a = *(const LAS bf16x8*)(ub + (mt * 16 + col16) * 136 + ks * 32 + quad * 8);
#pragma unroll
            for (int nt = 0; nt < 4; ++nt) acc[nt] = __builtin_amdgcn_mfma_f32_16x16x32_bf16(a, bfr[nt][ks], acc[nt], 0, 0, 0); }
#pragma unroll
        for (int ct = 0; ct < 2; ++ct) {
            const int ch = q * 32 + ct * 16 + col16;
            float av[4], dv[4];
#pragma unroll
            for (int reg = 0; reg < 4; ++reg) { const int tl = mt * 16 + quad * 4 + reg;
                const float r = sigmoidf_(acc[ct][reg] + ba[ct]), ig = sigmoidf_(acc[2 + ct][reg] + bx[ct]);
                const float a = __expf(-sp8[ct] * r);
                av[reg] = a; dv[reg] = __builtin_amdgcn_sqrtf(fmaxf(1.f - a * a, 0.f)) * ig * uf[tl * 132 + ch]; }
            float Al = 1.f, Hl = 0.f;
#pragma unroll
            for (int sr = 0; sr < 4; ++sr) { const int reg = DIR ? 3 - sr : sr; Hl = av[reg] * Hl + dv[reg]; Al *= av[reg]; }
            float se = st[ct], so = st[ct], ap = 1.f;
#pragma unroll
            for (int sg = 0; sg < 4; ++sg) { const int qp = DIR ? 3 - sg : sg; const float Ag = __shfl(Al, col16 + 16 * qp), Hg = __shfl(Hl, col16 + 16 * qp);
                const float nx = Ag * so + Hg; so = nx; if (sg < mysg) se = nx; ap *= Ag; }
            if (PASS == 2) { float h = se;
#pragma unroll
                for (int sr = 0; sr < 4; ++sr) { const int reg = DIR ? 3 - sr : sr; h = av[reg] * h + dv[reg]; hsd[(mt * 16 + quad * 4 + reg) * 132 + ch] = h; } }
            else at[ct] *= ap;
            st[ct] = so;
        }
    }
    Atot[0] = at[0]; Atot[1] = at[1]; Hend[0] = st[0]; Hend[1] = st[1];
}

template <int PASS>
__device__ __forceinline__ void lru_run(const Ctx& c, int l, int unit, bool dry = false) {
    const int b = unit >> 7, n = (unit >> 3) & 15, run = unit & 7;
    const int c0 = run * 16 + (run < 4 ? run : 4), len = 16 + (run < 4 ? 1 : 0);
    LAS float* xl = (LAS float*)c.lds;
    LAS float* uf = (LAS float*)(c.lds + 34816);
    LAS bf16_t* ub = (LAS bf16_t*)(c.lds + 34816 + 33792);
    LAS float* car = (LAS float*)(c.lds + 34816 + 33792 + 17408);
    LAS float* hsr = (LAS float*)(c.lds + 34816 + 33792 + 17408 + 17408);
    const int d = c.wave >> 2, q = c.wave & 3, col16 = c.lane & 15, quad = c.lane >> 4;
    float* LS = (float*)(c.ws + WS_LSUM);
    bf16_t* P = (bf16_t*)(c.ws + WS_P);
    bf16x8 bfr[4][4];
#pragma unroll
    for (int nt = 0; nt < 4; ++nt) { const int j = d * 256 + (nt >> 1) * 128 + q * 32 + (nt & 1) * 16 + col16;
#pragma unroll
        for (int ks = 0; ks < 4; ++ks) bfr[nt][ks] = *(const bf16x8*)((const bf16_t*)(c.ws + WS_WLRU) + ((size_t)(n * 512 + j) * 128 + ks * 32 + quad * 8)); }
    float ba[2], bx[2], sp8[2];
#pragma unroll
    for (int ct = 0; ct < 2; ++ct) { const int cidx = n * 128 + q * 32 + ct * 16 + col16; const float* sp = (const float*)(c.ws + WS_SP) + d * DM + cidx;
        ba[ct] = sp[SP_LBA]; bx[ct] = sp[SP_LBX]; sp8[ct] = sp[SP_LSP]; }
    if (PASS == 2) {
        if (c.tid < 256) { const int dir = c.tid >> 7, ch = c.tid & 127, cidx = n * 128 + ch; float st = 0.f;
#pragma unroll 1
            for (int k0 = 0; k0 < NCHUNK; k0 += 12) {
                float av[12], hv[12];
#pragma unroll
                for (int kk = 0; kk < 12; ++kk) { const int k = k0 + kk, j = dir ? (k < 4 ? 3 - k : 135 - k) : k; av[kk] = LS[lsum_idx(0, dir, b, j) + cidx]; hv[kk] = LS[lsum_idx(1, dir, b, j) + cidx]; }
#pragma unroll
                for (int kk = 0; kk < 12; ++kk) { const int k = k0 + kk, j = dir ? (k < 4 ? 3 - k : 135 - k) : k;
                    if (j >= c0 && j < c0 + len) car[(dir * 17 + (j - c0)) * 128 + ch] = st;
                    st = av[kk] * st + hv[kk]; } } }
        __syncthreads();
    }
    const float* cw = (const float*)(c.ws + WS_SP) + SP_LCW + n * 128; const float* cb = (const float*)(c.ws + WS_SP) + SP_LCB + n * 128;
#define LRU_GEOM(ci_, jc, is_ctx, rb, t0, seglen) const int jc = c0 + (ci_); const bool is_ctx = jc < 4; \
        const int rb = is_ctx ? MLAT + b * CTXL : b * SEQ, t0 = is_ctx ? jc * 64 : (jc - 4) * 64, seglen = is_ctx ? CTXL : SEQ
#define LRU_LOAD(ci_, XR, LG) do { LRU_GEOM(ci_, jc_, ic_, rb_, t0_, sl_); (void)ic_; \
        _Pragma("unroll") for (int ps = 0; ps < 3; ++ps) { const int i = ps * 32 + (c.tid >> 4); const int t = t0_ - 2 + i; XR[ps] = (u32x4){0u, 0u, 0u, 0u}; \
            if (i < 68 && t >= 0 && t < sl_) XR[ps] = *(const u32x4*)(P + (size_t)(rb_ + t) * NIN + CLX + n * 128 + (c.tid & 15) * 8); } \
        if (PASS == 2) { const bf16_t* gp_ = P + (size_t)(rb_ + t0_ + (c.tid >> 3)) * NIN + CLG + n * 128 + (c.tid & 7) * 16; LG[0] = *(const u32x4*)gp_; LG[1] = *(const u32x4*)(gp_ + 8); } } while (0)
    u32x4 xr[3], lgc[2] = {{0u, 0u, 0u, 0u}, {0u, 0u, 0u, 0u}}, lgn[2] = {{0u, 0u, 0u, 0u}, {0u, 0u, 0u, 0u}};
    LRU_LOAD(0, xr, lgn);
    for (int ci = 0; ci < len; ++ci) {
        LRU_GEOM(ci, jc, is_ctx, rb, t0, seglen); (void)is_ctx; (void)seglen;
#pragma unroll
        for (int ps = 0; ps < 3; ++ps) { const int i = ps * 32 + (c.tid >> 4);
            if (i < 68) { float f[8]; unpack8(xr[ps], f);
                *(LAS f32x4*)(xl + i * 128 + (c.tid & 15) * 8) = (f32x4){f[0], f[1], f[2], f[3]}; *(LAS f32x4*)(xl + i * 128 + (c.tid & 15) * 8 + 4) = (f32x4){f[4], f[5], f[6], f[7]}; } }
        lgc[0] = lgn[0]; lgc[1] = lgn[1];
        __syncthreads();
        if (ci + 1 < len) LRU_LOAD(ci + 1, xr, lgn);
        { const int ch = c.tid & 127, tq = c.tid >> 7; const float w0 = cw[ch], w1 = cw[DM + ch], w2 = cw[2 * DM + ch], w3 = cw[3 * DM + ch], bb = cb[ch];
#pragma unroll 4
          for (int tt = 0; tt < 16; ++tt) { const int tl = tq * 16 + tt;
              const float u = bb + w0 * xl[tl * 128 + ch] + w1 * xl[(tl + 1) * 128 + ch] + w2 * xl[(tl + 2) * 128 + ch] + w3 * xl[(tl + 3) * 128 + ch];
              uf[tl * 132 + ch] = u; ub[tl * 136 + ch] = f2bf(u); } }
        __syncthreads();
        float cin[2] = {0.f, 0.f}, At[2], He[2];
        if (PASS == 2) { cin[0] = car[(d * 17 + ci) * 128 + q * 32 + col16]; cin[1] = car[(d * 17 + ci) * 128 + q * 32 + 16 + col16]; }
        if (d == 0) lru_chunk<0, PASS>(ub, uf, xl, bfr, ba, bx, sp8, cin, At, He, q, col16, quad);
        else lru_chunk<1, PASS>(ub, uf, hsr, bfr, ba, bx, sp8, cin, At, He, q, col16, quad);
        if (PASS == 1) {
            if (quad == 0) {
#pragma unroll
                for (int ct = 0; ct < 2; ++ct) { const int cidx = n * 128 + q * 32 + ct * 16 + col16;
                    LS[lsum_idx(0, d, b, jc) + cidx] = At[ct]; LS[lsum_idx(1, d, b, jc) + cidx] = He[ct]; } }
            __syncthreads();
        } else {
            __syncthreads();
            { const int row = c.tid >> 3, cs = (c.tid & 7) * 16;
              bf16_t* gp = P + (size_t)(rb + t0 + row) * NIN + CLG + n * 128 + cs;
#pragma unroll
              for (int hseg = 0; hseg < 2; ++hseg) { float g[8]; unpack8(lgc[hseg], g);
                  const int o = row * 132 + cs + hseg * 8;
                  const f32x4 h0 = *(const LAS f32x4*)(xl + o) + *(const LAS f32x4*)(hsr + o), h1 = *(const LAS f32x4*)(xl + o + 4) + *(const LAS f32x4*)(hsr + o + 4);
                  u32x4 ow; ow.x = cvt_pk_bf16(h0[0] * gelu_tanh(g[0]), h0[1] * gelu_tanh(g[1])); ow.y = cvt_pk_bf16(h0[2] * gelu_tanh(g[2]), h0[3] * gelu_tanh(g[3]));
                  ow.z = cvt_pk_bf16(h1[0] * gelu_tanh(g[4]), h1[1] * gelu_tanh(g[5])); ow.w = cvt_pk_bf16(h1[2] * gelu_tanh(g[6]), h1[3] * gelu_tanh(g[7]));
                  *(u32x4*)((dry ? gp - CLG + CU : gp) + hseg * 8) = ow; } }
            __syncthreads();
        }
    }
#undef LRU_GEOM
#undef LRU_LOAD
}

__device__ __forceinline__ void phase_qk(const Ctx& c, int l, bool dry = false) {
    const int gw = c.wg * NWAVES + c.wave, NGW = c.G * NWAVES;
    for (int r = gw; r < MALL; r += NGW) qk_row(c, l, r, l == 0 || r < MLAT, dry);
}
__device__ __forceinline__ void sc_block8(const Ctx& c, int r0, bool dry) {
    const int t0 = r0 & (SEQ - 1);
    bf16_t* prow0 = (bf16_t*)(c.ws + WS_P) + (size_t)r0 * NIN;
    const float* w = (const float*)(c.ws + WS_SP) + SP_SCW; const float* bias = (const float*)(c.ws + WS_SP) + SP_SCB;
    const u32x4 z = {0u, 0u, 0u, 0u};
#pragma unroll 1
    for (int it = 0; it < 4; ++it) {
        const int col = it * 512 + c.lane * 8;
        float w0[8], w1[8], w2[8], bi[8];
#pragma unroll
        for (int hq = 0; hq < 2; ++hq) { const f32x4 a = *(const f32x4*)(w + col + hq * 4), b = *(const f32x4*)(w + DM + col + hq * 4), d = *(const f32x4*)(w + 2 * DM + col + hq * 4), e = *(const f32x4*)(bias + col + hq * 4);
#pragma unroll
            for (int k = 0; k < 4; ++k) { w0[hq * 4 + k] = a[k]; w1[hq * 4 + k] = b[k]; w2[hq * 4 + k] = d[k]; bi[hq * 4 + k] = e[k]; } }
        u32x4 xc[10], xu[10], xb[8];
#pragma unroll
        for (int j = 0; j < 10; ++j) { const int t = t0 - 1 + j; const bool in = t >= 0 && t < SEQ; const bf16_t* pr = prow0 + (ptrdiff_t)(j - 1) * NIN;
            xc[j] = in ? *(const u32x4*)(pr + CCG + col) : z; xu[j] = in ? *(const u32x4*)(pr + CU + col) : z; }
#pragma unroll
        for (int j = 0; j < 8; ++j) xb[j] = *(const u32x4*)(prow0 + (size_t)j * NIN + CBG + col);
        float zp[8], zc[8];
        { float a[8], b[8]; unpack8(xc[0], a); unpack8(xu[0], b);
#pragma unroll
          for (int k = 0; k < 8; ++k) zp[k] = a[k] * b[k];
          unpack8(xc[1], a); unpack8(xu[1], b);
#pragma unroll
          for (int k = 0; k < 8; ++k) zc[k] = a[k] * b[k]; }
#pragma unroll
        for (int j = 0; j < 8; ++j) {
            float a[8], b[8], bg[8], zn[8], o[8]; unpack8(xc[j + 2], a); unpack8(xu[j + 2], b); unpack8(xb[j], bg);
#pragma unroll
            for (int k = 0; k < 8; ++k) { zn[k] = a[k] * b[k]; o[k] = bg[k] * (bi[k] + w0[k] * zp[k] + w1[k] * zc[k] + w2[k] * zn[k]); zp[k] = zc[k]; zc[k] = zn[k]; }
            u32x4 ow; ow.x = cvt_pk_bf16(o[0], o[1]); ow.y = cvt_pk_bf16(o[2], o[3]); ow.z = cvt_pk_bf16(o[4], o[5]); ow.w = cvt_pk_bf16(o[6], o[7]);
            *(u32x4*)((dry ? (bf16_t*)(c.ws + WS_YF) + (size_t)(MALL + r0 + j) * DM : prow0 + (size_t)j * NIN + CBG) + col) = ow; }
    }
}
__device__ __forceinline__ void phase_sc(const Ctx& c, int l, bool dry = false) {
    const int gw = c.wg * NWAVES + c.wave, NGW = c.G * NWAVES;
    for (int r0 = gw * 8; r0 < MLAT; r0 += NGW * 8) sc_block8(c, r0, dry);
    if (l == 0) for (int r = MLAT + gw; r < MALL; r += NGW) sc_row(c, l, r, dry);
}
__device__ __forceinline__ void phase_lru1(const Ctx& c, int l) {
    for (int u = c.wg; u < 256; u += c.G) lru_run<1>(c, l, u);
}

__device__ __forceinline__ void phase_m2(const Ctx& c, int l, bool dry = false) {
    bf16_t* P = (bf16_t*)(c.ws + WS_P); const bf16_t* KC = (const bf16_t*)(c.ws + WS_KC); const bf16_t* VC = (const bf16_t*)(c.ws + WS_VC);
    const int ntot = 1024 + (l == 0 ? 32 : 0);
    for (int i = 0; i * c.G + c.wg < ntot; ++i) {
        const int L = i * c.G + c.wg; int b, h, seq; size_t qrow;
        if (L < 1024) { int grp, qb;
            if (c.G == 256) { grp = i * 8 + (c.wg & 7); qb = c.wg >> 3; } else { grp = L >> 5; qb = L & 31; }
            b = grp >> 4; h = grp & 15; qrow = (size_t)(b * SEQ + qb * 256); seq = NKEY; }
        else { const int u = L - 1024; b = u >> 4; h = u & 15; qrow = (size_t)(MLAT + b * CTXL); seq = CTXL; }
        bf16_t* q = P + qrow * NIN + CQ + h * 128;
        const size_t kvo = (size_t)(b * 4 + (h >> 2)) * NKEY * 128;
        att::attn_dense_body(q, KC + kvo, VC + kvo, dry ? q - CQ + CCG : q, seq, (char*)c.lds, c.wave);
    }
}
__device__ __forceinline__ void phase_lru2(const Ctx& c, int l, bool dry = false) {
    for (int u = c.wg; u < 256; u += c.G) lru_run<2>(c, l, u, dry);
}
constexpr float NEGBIG = -3.0e38f;
constexpr float PU_SCALE = 32.f;
__device__ __forceinline__ float wave_max_dpp(float v) {
    v = fmaxf(v, DPPF(v, 0xB1)); v = fmaxf(v, DPPF(v, 0x4E)); v = fmaxf(v, DPPF(v, 0x141)); v = fmaxf(v, DPPF(v, 0x140));
    const float a = __int_as_float(__builtin_amdgcn_readlane(__float_as_int(v), 0)), b = __int_as_float(__builtin_amdgcn_readlane(__float_as_int(v), 16));
    const float c = __int_as_float(__builtin_amdgcn_readlane(__float_as_int(v), 32)), d = __int_as_float(__builtin_amdgcn_readlane(__float_as_int(v), 48));
    return fmaxf(fmaxf(a, b), fmaxf(c, d));
}
#define SWZ_XOR(v, m) __int_as_float(__builtin_amdgcn_ds_swizzle(__float_as_int(v), ((m) << 10) | 0x1F))
__device__ __forceinline__ unsigned fkey(float x) { const unsigned u = __float_as_uint(x); return (u & 0x80000000u) ? ~u : (u | 0x80000000u); }
#define DPPU(v, ctrl) ((unsigned)__builtin_amdgcn_update_dpp(0, (int)(v), ctrl, 0xF, 0xF, true))
__device__ __forceinline__ unsigned wave_max_u32(unsigned v) {
    v = max(v, DPPU(v, 0xB1)); v = max(v, DPPU(v, 0x4E)); v = max(v, DPPU(v, 0x141)); v = max(v, DPPU(v, 0x140));
    const unsigned a = (unsigned)__builtin_amdgcn_readlane((int)v, 0), b = (unsigned)__builtin_amdgcn_readlane((int)v, 16), c = (unsigned)__builtin_amdgcn_readlane((int)v, 32), d = (unsigned)__builtin_amdgcn_readlane((int)v, 48);
    return max(max(a, b), max(c, d));
}
__device__ __forceinline__ unsigned topk16_keys2(unsigned k0, unsigned k1, int lane) {
    unsigned res = 0u;
    for (int it = 0; it < 16; ++it) { const unsigned m = wave_max_u32(max(k0, k1)); k0 = (k0 == m) ? 0u : k0; k1 = (k1 == m) ? 0u : k1; res = (lane == it) ? m : res; }
    return res;
}
__device__ __forceinline__ unsigned topk16_keys1(unsigned k0, int lane) {
    unsigned res = 0u;
    for (int it = 0; it < 16; ++it) { const unsigned m = wave_max_u32(k0); k0 = (k0 == m) ? 0u : k0; res = (lane == it) ? m : res; }
    return res;
}
__device__ __forceinline__ void unpack_fp8x16(const u32x4 w, float (&f)[16]) {
#pragma unroll
    for (int d = 0; d < 4; ++d) { const f32x2 lo = __builtin_amdgcn_cvt_pk_f32_fp8((int)w[d], false), hi = __builtin_amdgcn_cvt_pk_f32_fp8((int)w[d], true);
        f[4 * d] = lo.x; f[4 * d + 1] = lo.y; f[4 * d + 2] = hi.x; f[4 * d + 3] = hi.y; }
}

__device__ __forceinline__ unsigned half_max_u32(unsigned v, bool hi_half) {
    v = max(v, DPPU(v, 0xB1)); v = max(v, DPPU(v, 0x4E)); v = max(v, DPPU(v, 0x141)); v = max(v, DPPU(v, 0x140));
    const unsigned a = max((unsigned)__builtin_amdgcn_readlane((int)v, 0), (unsigned)__builtin_amdgcn_readlane((int)v, 16));
    const unsigned b = max((unsigned)__builtin_amdgcn_readlane((int)v, 32), (unsigned)__builtin_amdgcn_readlane((int)v, 48));
    return hi_half ? b : a;
}
__device__ __forceinline__ unsigned topk16_half4(unsigned (&k)[4], int hl, bool hi_half) {
    unsigned res = 0u;
    for (int it = 0; it < 16; ++it) { const unsigned m = half_max_u32(max(max(k[0], k[1]), max(k[2], k[3])), hi_half);
#pragma unroll
        for (int j = 0; j < 4; ++j) k[j] = (k[j] == m) ? 0u : k[j];
        res = (hl == it) ? m : res; }
    return res;
}
__device__ __forceinline__ unsigned topk16_half2(unsigned k0, unsigned k1, int hl, bool hi_half) {
    unsigned res = 0u;
    for (int it = 0; it < 16; ++it) { const unsigned m = half_max_u32(max(k0, k1), hi_half); k0 = (k0 == m) ? 0u : k0; k1 = (k1 == m) ? 0u : k1; res = (hl == it) ? m : res; }
    return res;
}
__device__ __forceinline__ void cand_ab(int cidx50, int& a, int& b) {
    a = cidx50 < 16 ? 0 : cidx50 < 24 ? 1 : cidx50 < 29 ? 2 : cidx50 < 33 ? 3 : cidx50 < 36 ? 4 : cidx50 < 38 ? 5 : cidx50 < 40 ? 6 : cidx50 < 42 ? 7 : cidx50 - 34;
    const int st = cidx50 < 16 ? 0 : cidx50 < 24 ? 16 : cidx50 < 29 ? 24 : cidx50 < 33 ? 29 : cidx50 < 36 ? 33 : cidx50 < 38 ? 36 : cidx50 < 40 ? 38 : cidx50 < 42 ? 40 : cidx50;
    b = cidx50 - st;
}
__device__ __forceinline__ void peer_topk_pair(const LAS float* srow, int hp, LAS float* gsc, LAS int* isc, int lane) {
    const int hl = lane & 31, hb = lane & 32; const bool hi_half = lane >= 32; const int h = 2 * hp + (hi_half ? 1 : 0);
    const LAS float* sh = srow + h * 256;
    unsigned k1[4], k2[4];
#pragma unroll
    for (int j = 0; j < 4; ++j) { const int idx = hl + 32 * j; k1[j] = (fkey(sh[idx]) & ~127u) | (unsigned)(127 - idx); k2[j] = (fkey(sh[128 + idx]) & ~127u) | (unsigned)(127 - idx); }
    const unsigned r1 = topk16_half4(k1, hl, hi_half), r2 = topk16_half4(k2, hl, hi_half);
    const int i1 = 127 - (int)(r1 & 127u), i2 = 127 - (int)(r2 & 127u);
    const float v1 = sh[i1], v2 = sh[128 + i2];
    int a0, b0, a1, b1; cand_ab(hl, a0, b0); cand_ab(hl + 32, a1, b1);
    const float c0 = __shfl(v1, hb + a0) + __shfl(v2, hb + b0), c1 = __shfl(v1, hb + (a1 & 15)) + __shfl(v2, hb + (b1 & 15));
    const unsigned q0 = (fkey(c0) & ~255u) | (unsigned)(255 - (a0 * 16 + b0)), q1 = (hl + 32 < 50) ? ((fkey(c1) & ~255u) | (unsigned)(255 - (a1 * 16 + b1))) : 0u;
    const unsigned r3 = topk16_half2(q0, q1, hl, hi_half);
    const int ci = 255 - (int)(r3 & 255u);
    const float sc = __shfl(v1, hb + (ci >> 4)) + __shfl(v2, hb + (ci & 15));
    const int e = __shfl(i1, hb + (ci >> 4)) * 128 + __shfl(i2, hb + (ci & 15));
    const float mxa = __int_as_float(__builtin_amdgcn_readlane(__float_as_int(sc), 0)), mxb = __int_as_float(__builtin_amdgcn_readlane(__float_as_int(sc), 32));
    const float ex = hl < 16 ? __expf(sc - (hi_half ? mxb : mxa)) : 0.f;
    float sm = ex; sm += DPPF(sm, 0xB1); sm += DPPF(sm, 0x4E); sm += DPPF(sm, 0x141); sm += DPPF(sm, 0x140);
    if (hl < 16) { gsc[h * 16 + hl] = ex / sm; isc[h * 16 + hl] = e; }
}

__device__ __forceinline__ unsigned row_max_u32(unsigned v) { v = max(v, DPPU(v, 0xB1)); v = max(v, DPPU(v, 0x4E)); v = max(v, DPPU(v, 0x141)); v = max(v, DPPU(v, 0x140)); return v; }
#define CSWAP(a, b) do { const unsigned hi_ = max(a, b), lo_ = min(a, b); a = hi_; b = lo_; } while (0)
__device__ __forceinline__ unsigned topk16_row8(unsigned (&k)[8], int rl) {
    CSWAP(k[0], k[1]); CSWAP(k[2], k[3]); CSWAP(k[4], k[5]); CSWAP(k[6], k[7]);
    CSWAP(k[0], k[2]); CSWAP(k[1], k[3]); CSWAP(k[4], k[6]); CSWAP(k[5], k[7]);
    CSWAP(k[1], k[2]); CSWAP(k[5], k[6]); CSWAP(k[0], k[4]); CSWAP(k[3], k[7]);
    CSWAP(k[1], k[5]); CSWAP(k[2], k[6]);
    CSWAP(k[1], k[4]); CSWAP(k[3], k[6]);
    CSWAP(k[2], k[4]); CSWAP(k[3], k[5]);
    CSWAP(k[3], k[4]);
    unsigned res = 0u;
    for (int it = 0; it < 16; ++it) { const unsigned m = row_max_u32(k[0]); const bool mine = (k[0] == m);
#pragma unroll
        for (int j = 0; j < 7; ++j) k[j] = mine ? k[j + 1] : k[j];
        k[7] = mine ? 0u : k[7];
        res = (rl == it) ? m : res; }
    return res;
}
__device__ __forceinline__ void topk16_row8x2(unsigned (&k)[8], unsigned (&g)[8], int rl, unsigned& rk, unsigned& rg) {
#define CSWAP2(a, b) do { const unsigned hi_ = max(k[a], k[b]), lo_ = min(k[a], k[b]); k[a] = hi_; k[b] = lo_; const unsigned hj_ = max(g[a], g[b]), lj_ = min(g[a], g[b]); g[a] = hj_; g[b] = lj_; } while (0)
    CSWAP2(0, 1); CSWAP2(2, 3); CSWAP2(4, 5); CSWAP2(6, 7);
    CSWAP2(0, 2); CSWAP2(1, 3); CSWAP2(4, 6); CSWAP2(5, 7);
    CSWAP2(1, 2); CSWAP2(5, 6); CSWAP2(0, 4); CSWAP2(3, 7);
    CSWAP2(1, 5); CSWAP2(2, 6);
    CSWAP2(1, 4); CSWAP2(3, 6);
    CSWAP2(2, 4); CSWAP2(3, 5);
    CSWAP2(3, 4);
#undef CSWAP2
    unsigned res = 0u, reg = 0u;
#pragma unroll
    for (int it = 0; it < 16; ++it) {
        unsigned m = k[0], n = g[0];
        m = max(m, DPPU(m, 0xB1)); n = max(n, DPPU(n, 0xB1)); m = max(m, DPPU(m, 0x4E)); n = max(n, DPPU(n, 0x4E));
        m = max(m, DPPU(m, 0x141)); n = max(n, DPPU(n, 0x141)); m = max(m, DPPU(m, 0x140)); n = max(n, DPPU(n, 0x140));
        const bool mine = (k[0] == m), nine = (g[0] == n);
#pragma unroll
        for (int j = 0; j < 7; ++j) { k[j] = mine ? k[j + 1] : k[j]; g[j] = nine ? g[j + 1] : g[j]; }
        k[7] = mine ? 0u : k[7]; g[7] = nine ? 0u : g[7];
        res = (rl == it) ? m : res; reg = (rl == it) ? n : reg; }
    rk = res; rg = reg;
}
__device__ __forceinline__ unsigned topk16_row4(unsigned (&k)[4], int rl) {
    CSWAP(k[0], k[1]); CSWAP(k[2], k[3]); CSWAP(k[0], k[2]); CSWAP(k[1], k[3]); CSWAP(k[1], k[2]);
    unsigned res = 0u;
    for (int it = 0; it < 16; ++it) { const unsigned m = row_max_u32(k[0]); const bool mine = (k[0] == m);
#pragma unroll
        for (int j = 0; j < 3; ++j) k[j] = mine ? k[j + 1] : k[j];
        k[3] = mine ? 0u : k[3];
        res = (rl == it) ? m : res; }
    return res;
}
#undef CSWAP
__device__ __forceinline__ void peer_topk_quad(const LAS float* srow, int hq, LAS float* gsc, LAS int* isc, int lane) {
    const int rl = lane & 15, rb = lane & 48, h = 4 * hq + (lane >> 4);
    const LAS float* sh = srow + h * 256;
    unsigned k1[8], k2[8];
#pragma unroll
    for (int j = 0; j < 8; ++j) { const int idx = rl + 16 * j; k1[j] = (fkey(sh[idx]) & ~127u) | (unsigned)(127 - idx); k2[j] = (fkey(sh[128 + idx]) & ~127u) | (unsigned)(127 - idx); }
    unsigned r1, r2; topk16_row8x2(k1, k2, rl, r1, r2);
    const int i1 = 127 - (int)(r1 & 127u), i2 = 127 - (int)(r2 & 127u);
    const float v1 = sh[i1], v2 = sh[128 + i2];
    unsigned q[4];
#pragma unroll
    for (int j = 0; j < 4; ++j) { const int cidx = rl + 16 * j; int a, b; cand_ab(cidx < 50 ? cidx : 0, a, b);
        const float cs = __shfl(v1, rb + (a & 15)) + __shfl(v2, rb + (b & 15));
        q[j] = (cidx < 50) ? ((fkey(cs) & ~255u) | (unsigned)(255 - (a * 16 + b))) : 0u; }
    const unsigned r3 = topk16_row4(q, rl);
    const int ci = 255 - (int)(r3 & 255u);
    const float sc = __shfl(v1, rb + (ci >> 4)) + __shfl(v2, rb + (ci & 15));
    const int e = __shfl(i1, rb + (ci >> 4)) * 128 + __shfl(i2, rb + (ci & 15));
    const float mx = __shfl(sc, rb);
    const float ex = __expf(sc - mx);
    float sm = ex; sm += DPPF(sm, 0xB1); sm += DPPF(sm, 0x4E); sm += DPPF(sm, 0x141); sm += DPPF(sm, 0x140);
    gsc[h * 16 + rl] = ex / sm; isc[h * 16 + rl] = e;
}

constexpr size_t WS_PE_E = WS_P + 160 * MiB, WS_PE_CF = WS_PE_E + (size_t)MALL * 128 * 4;
constexpr int NSL = 16, SLW = 128;
constexpr size_t SLICE_BYTES = (size_t)16384 * SLW;
__device__ __forceinline__ void peer_token(const Ctx& c, int l, int r, int rn, int b, bool dry) {
    LAS float* gsc = (LAS float*)(c.lds + c.wave * 2048 + b * 1024);
    LAS int* isc = (LAS int*)(c.lds + c.wave * 2048 + b * 1024 + 512);
    LAS float* gscn = (LAS float*)(c.lds + c.wave * 2048 + (b ^ 1) * 1024); LAS int* iscn = (LAS int*)(c.lds + c.wave * 2048 + (b ^ 1) * 1024 + 512);
    const float* Sn = (const float*)(c.ws + WS_P) + (size_t)(rn < 0 ? r : rn) * DM;
    const int lane = c.lane;
    LAS float* snb = (LAS float*)(c.lds + 16384 + c.wave * 8192);
    f32x4 sv[8];
#pragma unroll
    for (int q = 0; q < 8; ++q) sv[q] = (rn >= 0) ? *(const f32x4*)(Sn + q * 256 + lane * 4) : (f32x4){0.f, 0.f, 0.f, 0.f};
    LDS_WAIT(); asm volatile("" ::: "memory");
    const bf16_t* hx = (const bf16_t*)(c.ws + WS_HX) + (size_t)r * DM;
    int hq[8]; float hdq;
    { float hv[32]; float mx = 0.f;
#pragma unroll
      for (int j = 0; j < 4; ++j) { float t0[8]; unpack8(*(const u32x4*)(hx + lane * 32 + j * 8), t0);
#pragma unroll
          for (int k = 0; k < 8; ++k) { hv[j * 8 + k] = t0[k]; mx = fmaxf(mx, fabsf(t0[k])); } }
#pragma unroll
      for (int o = 32; o > 0; o >>= 1) mx = fmaxf(mx, __shfl_xor(mx, o));
      const float q_ = mx > 0.f ? 127.f / mx : 0.f; hdq = mx * (1.f / (127.f * 16.f));
#pragma unroll
      for (int d = 0; d < 8; ++d) hq[d] = (int)pk4_i8(hv[4 * d] * q_, hv[4 * d + 1] * q_, hv[4 * d + 2] * q_, hv[4 * d + 3] * q_); }
    const float* USC = (const float*)(c.ws + WS_USC) + (size_t)l * 16384;
    const unsigned char* PU = (const unsigned char*)(c.ws + ws_pu(l)); const unsigned char* PV = (const unsigned char*)(c.ws + ws_pv(l));
#define PEER_LOADROW(tab, wk, e_) do { wk = *(const u32x4*)((tab) + (size_t)__builtin_amdgcn_readfirstlane(e_) * 1024 + lane * 16); } while (0)
#define PEER_IDX8(dst, i_) const u32x4 ia_##dst = *(const LAS u32x4*)(isc + (i_)), ib_##dst = *(const LAS u32x4*)(isc + (i_) + 4); \
        const int dst[8] = {(int)ia_##dst[0], (int)ia_##dst[1], (int)ia_##dst[2], (int)ia_##dst[3], (int)ib_##dst[0], (int)ib_##dst[1], (int)ib_##dst[2], (int)ib_##dst[3]}
    u32x4 w[16];
    float usc_ = USC[isc[lane & 7]], usc1_ = USC[isc[8 + (lane & 7)]];
    { PEER_IDX8(e0, 0);
#pragma unroll
      for (int k = 0; k < 8; ++k) PEER_LOADROW(PU, w[k], e0[k]); }
    { PEER_IDX8(e1, 8);
#pragma unroll
      for (int k = 0; k < 8; ++k) PEER_LOADROW(PU, w[8 + k], e1[k]); }
    if (rn >= 0) {
#pragma unroll
        for (int q = 0; q < 8; ++q) *(LAS f32x4*)(snb + q * 256 + lane * 4) = sv[q];
        LDS_WAIT(); asm volatile("" ::: "memory"); }
#define PEER_BATCH(SB, ib, USV) { \
        const bool has_next = (ib) + 16 < 128; \
        PEER_IDX8(en, has_next ? (ib) + 16 : (ib)); \
        const float uscn_ = USC[isc[(has_next ? (ib) + 16 : (ib)) + (lane & 7)]]; \
        float p[8]; \
        _Pragma("unroll") for (int k = 0; k < 8; ++k) { \
            asm volatile("" : "+v"(w[(SB) + k])); \
            int s = 0; \
            _Pragma("unroll") for (int d = 0; d < 4; ++d) { s = __builtin_amdgcn_sdot4((int)((w[(SB) + k][d] << 4) & 0xF0F0F0F0u), hq[2 * d], s, false); s = __builtin_amdgcn_sdot4((int)(w[(SB) + k][d] & 0xF0F0F0F0u), hq[2 * d + 1], s, false); } \
            p[k] = (float)s; asm volatile("" : "+v"(p[k])); \
            if (has_next) PEER_LOADROW(PU, w[(SB) + k], en[k]); } \
          \
        const bool b0 = lane & 1, b1 = lane & 2, b2 = lane & 4; \
        float q[4], t[2]; \
        _Pragma("unroll") for (int m = 0; m < 4; ++m) q[m] = (b0 ? p[2 * m + 1] : p[2 * m]) + DPPF(b0 ? p[2 * m] : p[2 * m + 1], 0xB1); \
        _Pragma("unroll") for (int m = 0; m < 2; ++m) t[m] = (b1 ? q[2 * m + 1] : q[2 * m]) + DPPF(b1 ? q[2 * m] : q[2 * m + 1], 0x4E); \
        float s = (b2 ? t[1] : t[0]) + SWZ_XOR(b2 ? t[0] : t[1], 4); \
        s += SWZ_XOR(s, 8); s += SWZ_XOR(s, 16); s += __shfl_xor(s, 32); \
        if (lane < 8) gsc[(ib) + lane] = gsc[(ib) + lane] * gelu_tanh(s * (USV * hdq)); \
        USV = uscn_; }
#pragma unroll 1
    for (int i = 0; i < 128; i += 16) {
        if (rn >= 0 && (i & 63) == 0) peer_topk_quad(snb, i >> 6, gscn, iscn, lane);
        PEER_BATCH(0, i, usc_)
        PEER_BATCH(8, i + 8, usc1_)
    }
#undef PEER_BATCH
#undef PEER_LOADROW
#undef PEER_IDX8
    LDS_WAIT(); asm volatile("" ::: "memory");
    { int* E = (int*)(c.ws + WS_PE_E) + (size_t)r * 128; float* CF = (float*)(c.ws + WS_PE_CF) + (size_t)r * 128;
      E[lane] = isc[lane]; E[64 + lane] = isc[64 + lane]; CF[lane] = gsc[lane]; CF[64 + lane] = gsc[64 + lane]; }
    LDS_WAIT(); asm volatile("" ::: "memory");
}
__device__ __forceinline__ void phase_peer(const Ctx& c, int l, int nrows, bool dry = false) {
    const int gw = c.wg * NWAVES + c.wave, NGW = c.G * NWAVES;
    int r = gw; if (r >= nrows) return;
    { const float* S0 = (const float*)(c.ws + WS_P) + (size_t)r * DM; LAS float* snb0 = (LAS float*)(c.lds + 16384 + c.wave * 8192);
#pragma unroll
      for (int q = 0; q < 8; ++q) *(LAS f32x4*)(snb0 + q * 256 + c.lane * 4) = *(const f32x4*)(S0 + q * 256 + c.lane * 4);
      LDS_WAIT(); asm volatile("" ::: "memory");
#pragma unroll 1
      for (int hq = 0; hq < 2; ++hq) peer_topk_quad(snb0, hq, (LAS float*)(c.lds + c.wave * 2048), (LAS int*)(c.lds + c.wave * 2048 + 512), c.lane);
      LDS_WAIT(); asm volatile("" ::: "memory"); }
    int b = 0;
#pragma unroll 1
    for (; r < nrows; r += NGW, b ^= 1) { const int rn = r + NGW; peer_token(c, l, r, rn < nrows ? rn : -1, b, dry); }
}
#define PEER_SLICE_BEGIN() { const int grp = c.wg & 7, wi = (c.wg >> 3) * NWAVES + c.wave, nwi = ((c.G - grp + 7) >> 3) * NWAVES; \
    _Pragma("unroll 1") for (int ps = 0; ps < 2; ++ps) { const int s = grp + 8 * ps; _Pragma("unroll 1") for (int r = wi; r < nrows; r += nwi) {
#define PEER_SLICE_END() } } }
__device__ __forceinline__ void phase_peer_v(const Ctx& c, int l, int nrows, bool dry) {
    const int lane = c.lane, rg = lane >> 3, ch = lane & 7;
    const int* Eb = (const int*)(c.ws + WS_PE_E); const float* CF = (const float*)(c.ws + WS_PE_CF);
    const bool b3 = lane & 8, b4 = lane & 16, b5 = lane & 32;
    const int grp = c.wg & 7, wi = (c.wg >> 3) * NWAVES + c.wave, nwi = ((c.G - grp + 7) >> 3) * NWAVES;
#define V_META(r_, e0_, e1_, c0_, c1_) do { if ((r_) < nrows) { e0_ = Eb[(size_t)(r_) * 128 + lane]; e1_ = Eb[(size_t)(r_) * 128 + 64 + lane]; c0_ = CF[(size_t)(r_) * 128 + lane]; c1_ = CF[(size_t)(r_) * 128 + 64 + lane]; } } while (0)
#pragma unroll 1
    for (int ps = 0; ps < 2; ++ps) { const int s = grp + 8 * ps;
        const unsigned char* tab = (const unsigned char*)(c.ws + ws_pv(l)) + (size_t)s * SLICE_BYTES + ch * 16;
        const int col = s * SLW + ch * 16 + (b3 ? 8 : 0) + (b4 ? 4 : 0) + (b5 ? 2 : 0);
        int r = wi; int e0 = 0, e1 = 0; float c0 = 0.f, c1 = 0.f;
        V_META(r, e0, e1, c0, c1);
#pragma unroll 1
        for (; r < nrows; r += nwi) {
            u32x4 w[16];
#pragma unroll
            for (int i = 0; i < 16; ++i) { const int e = __shfl(i < 8 ? e0 : e1, (8 * i + rg) & 63); w[i] = *(const u32x4*)(tab + (size_t)e * SLW); }
            int f0 = 0, f1 = 0; float d0 = 0.f, d1 = 0.f; V_META(r + nwi, f0, f1, d0, d1);
            const int vec = r < SEQ ? 0 : (r < MLAT ? 1 : 2);
            float* xr = (dry ? (float*)(c.ws + WS_YF) + (size_t)r * DM : xrow_ptr(c, r)) + col;
            const f32x2 gg = *(const f32x2*)((const float*)(c.ws + WS_MOD) + ((size_t)l * 3 + vec) * NMOD + 5 * DM + col); f32x2 xx = *(const f32x2*)xr;
            h16x2 o2[8];
#pragma unroll
            for (int j = 0; j < 8; ++j) o2[j] = (h16x2){(_Float16)0.f, (_Float16)0.f};
#pragma unroll
            for (int i = 0; i < 16; ++i) {
                asm volatile("" : "+v"(w[i]));
                const float ci_ = __shfl(i < 8 ? c0 : c1, (8 * i + rg) & 63);
                const h16x2 ci2 = {(_Float16)ci_, (_Float16)ci_};
#pragma unroll
                for (int d = 0; d < 4; ++d) {
                    const h16x2 lo_ = __builtin_bit_cast(h16x2, __builtin_amdgcn_cvt_scalef32_pk_f16_fp8((int)w[i][d], 1.0f, false)), hi_ = __builtin_bit_cast(h16x2, __builtin_amdgcn_cvt_scalef32_pk_f16_fp8((int)w[i][d], 1.0f, true));
                    o2[2 * d] = __builtin_elementwise_fma(lo_, ci2, o2[2 * d]); o2[2 * d + 1] = __builtin_elementwise_fma(hi_, ci2, o2[2 * d + 1]); }
                asm volatile("" : "+v"(o2[0])); }
            float o[16];
#pragma unroll
            for (int j = 0; j < 8; ++j) { o[2 * j] = (float)o2[j][0]; o[2 * j + 1] = (float)o2[j][1]; }
            float q8[8], q4[4], q2[2];
#pragma unroll
            for (int j = 0; j < 8; ++j) q8[j] = (b3 ? o[8 + j] : o[j]) + DPPF(b3 ? o[j] : o[8 + j], 0x128);
#pragma unroll
            for (int j = 0; j < 4; ++j) q4[j] = (b4 ? q8[4 + j] : q8[j]) + SWZ_XOR(b4 ? q8[j] : q8[4 + j], 16);
#pragma unroll
            for (int j = 0; j < 2; ++j) q2[j] = (b5 ? q4[2 + j] : q4[j]) + __shfl_xor(b5 ? q4[j] : q4[2 + j], 32);
            xx[0] += gg[0] * q2[0]; xx[1] += gg[1] * q2[1];
            *(f32x2*)xr = xx;
            e0 = f0; e1 = f1; c0 = d0; c1 = d1;
        }
    }
#undef V_META
}
struct Args { const float* in[29]; float* out; unsigned char* ws; int ph_lo, ph_hi; };
constexpr int PH_PER_LAYER = 10, N_PHASES = NLAYER * PH_PER_LAYER;
#ifndef G1_WGM
#define G1_WGM 3
#endif
constexpr int CW_BAR = 4096;

__global__ void __launch_bounds__(NTHREADS, 2) mk_fwd(Args args) {
    extern __shared__ __attribute__((aligned(16))) unsigned char lds_raw[];
    Ctx c0;
    c0.out = args.out; c0.ws = args.ws; c0.lds = (LAS unsigned char*)lds_raw;
    c0.tid = threadIdx.x; c0.lane = c0.tid & 63; c0.wave = __builtin_amdgcn_readfirstlane((int)(threadIdx.x >> 6)); c0.wg = blockIdx.x; c0.G = gridDim.x;
    volatile LAS unsigned* MISC = (volatile LAS unsigned*)(c0.lds + MISC_OFF);
    if (c0.tid < 64) MISC[c0.tid] = 0u;
    __syncthreads();
    const int lo = args.ph_lo, hi = args.ph_hi;
    XcdBarrier bar; bar.bar = (unsigned*)(c0.ws + WS_CTL) + CW_BAR; bar.x = 0; bar.st = MISC + 8;
    if (hi - lo > 1) bar = xcd_barrier_post((unsigned*)(c0.ws + WS_CTL) + CW_BAR, MISC + 8);
#ifndef ONLY_PH
#define ONLY_PH -1
#endif
#define IN(k) ((ONLY_PH < 0 || ((k) % PH_PER_LAYER) == ONLY_PH) && lo <= (k) && (k) < hi)
#define PH_BEGIN() Ctx c = c0; unsigned long long wsi_ = (unsigned long long)c0.ws, outi_ = (unsigned long long)c0.out; asm volatile("" : "+s"(wsi_), "+s"(outi_), "+s"(c.wg), "+s"(c.G), "+s"(c.wave)); \
    c.lane = lane_id_fresh(); c.tid = c.wave * 64 + c.lane; c.ws = (unsigned char*)(GAS unsigned char*)wsi_; c.out = (float*)(GAS float*)outi_;     \
    bf16_t* P = (bf16_t*)(c.ws + WS_P); bf16_t* HX = (bf16_t*)(c.ws + WS_HX); float* YF = (float*)(c.ws + WS_YF); (void)P; (void)HX; (void)YF
#ifndef PROBE_DUP
#define PROBE_DUP -1
#endif
#define REPS(k) for (int rep = 0, dry = (PROBE_DUP == (k)); rep < (PROBE_DUP == (k) ? 2 : 1); ++rep, dry = 0)
#define SEAM(k) do { if (IN(k) && IN((k) + 1)) { xcd_barrier(bar, c0.wave); if (PROBE_DUP == 20) xcd_barrier(bar, c0.wave); } } while (0)
    const bool early = (c0.G == 256);
#define TAIL_BEGIN() PH_BEGIN(); c.wg -= 32; c.G -= 32
    for (int l = 0; l < NLAYER; ++l) {
        const int pb = l * PH_PER_LAYER;
        const int mrows = (l == 0) ? MALL : MLAT;
        if (IN(pb + 0) && !(l == 1 && early)) REPS(0) {
            if (l == 0) { PH_BEGIN(); conv_colmax(c); }
            { PH_BEGIN(); conv_units(c, l); } { PH_BEGIN(); conv_tables(c, l); } { PH_BEGIN(); conv_small(c, l); }
            if (l == 0) { { PH_BEGIN(); conv_once(c); } xcd_barrier(bar, c0.wave); }
            { PH_BEGIN(); conv_transposes(c, l); } }
        if (!(l == 1 && early)) SEAM(pb + 0);
        if (IN(pb + 1)) REPS(1) { PH_BEGIN();
            if (l == 0) { GET_IN(); phase_norm<true>(c, l, MALL, SP_NMIX, 0, INP(I_X), INP(I_CTX)); } else phase_norm<true>(c, l, MALL, SP_NMIX, 0); }
        SEAM(pb + 1);
        if (IN(pb + 2)) REPS(2) { PH_BEGIN();
            pg8::Gemm g{HX, (const bf16_t*)(c.ws + WS_WIN), MALL, NIN, DM, DM, DM}; pg8::StaticOrder S; S.init(MALL, NIN, c.G, c.wg, G1_WGM);
            pg8::EpiI8 E{P, NIN, (const float*)(c.ws + WS_ADQ), (const float*)(c.ws + WS_WDQ)};
            pg8::gemm_phase<pg8::EpiI8, pg8::StaticOrder, true, true, false, true>(c.lds, g, S, E, c.wave);
        }
        SEAM(pb + 2);
        if (IN(pb + 3)) REPS(3) {
            int flip_ = (c0.wg >> 3) & 1; asm volatile("" : "+s"(flip_));
#pragma unroll 1
            for (int st = 0; st < 2; ++st) {
                if ((st ^ flip_) == 0) { { PH_BEGIN(); phase_qk(c, l, dry); } { PH_BEGIN(); phase_sc(c, l, dry); } }
                else { PH_BEGIN(); phase_lru1(c, l); }
                __syncthreads(); }
            if (PROBE_DUP == 30) { PH_BEGIN(); phase_lru1(c, l); } }
        SEAM(pb + 3);
        if (IN(pb + 4)) REPS(4) { { PH_BEGIN(); phase_m2(c, l, dry); } __syncthreads(); if (PROBE_DUP == 31) { PH_BEGIN(); phase_lru2(c, l, true); } { PH_BEGIN(); phase_lru2(c, l, dry); } }
        SEAM(pb + 4);
        if (IN(pb + 5)) REPS(5) { { PH_BEGIN();
            pg8::MixOrder S; S.init(mrows, c.G, c.wg);
            const bf16_t* WO = (const bf16_t*)(c.ws + WS_WO);
            { pg8::Gemm g{P + CQ, WO, mrows, DM, DM, NIN, DM}; pg8::EpiMerge<0> E{P + CGT, NIN, (bf16_t*)YF, HX};
              pg8::gemm_phase<pg8::EpiMerge<0>, pg8::MixOrder, true, true, true>(c.lds, g, S, E, c.wave); }
            { pg8::Gemm g{P + CLG, WO + (size_t)DM * DM, mrows, DM, DM, NIN, DM}; pg8::EpiMerge<1> E{P + CGT + DM, NIN, (bf16_t*)YF, HX};
              pg8::gemm_phase<pg8::EpiMerge<1>, pg8::MixOrder, true, true, true>(c.lds, g, S, E, c.wave); }
            { pg8::Gemm g{P + CBG, WO + (size_t)2 * DM * DM, mrows, DM, DM, NIN, DM}; pg8::EpiMerge<2> E{P + CGT + 2 * DM, NIN, (bf16_t*)YF, HX};
              pg8::gemm_phase<pg8::EpiMerge<2>, pg8::MixOrder, true, true, true>(c.lds, g, S, E, c.wave); }
            }
            if (l == 0 && early && c0.wg >= 32 && !dry) { { TAIL_BEGIN(); conv_transposes(c, 1, CV_WIN); } { TAIL_BEGIN(); conv_tables(c, 1, CV_PU); } }
        }
        SEAM(pb + 5);
        if (IN(pb + 6)) REPS(6) { { PH_BEGIN();
            pg8::Gemm g{HX, (const bf16_t*)(c.ws + WS_WOUT), mrows, DM, DM, DM, DM}; pg8::MixOrder S; S.init(mrows, c.G, c.wg);
            float* xl_ = dry ? YF : c.out; float* xc_ = dry ? YF + (size_t)MLAT * DM : (float*)(c.ws + WS_CTXS);
            const float* sl_ = xl_; const float* sc_ = xc_;
            if (l == 0 && !dry) { GET_IN(); sl_ = INP(I_X); sc_ = INP(I_CTX); }
            pg8::EpiResid E{xl_, xc_, (const float*)(c.ws + WS_MOD) + (size_t)l * 3 * NMOD + 2 * DM, sl_, sc_};
            pg8::gemm_phase<pg8::EpiResid, pg8::MixOrder, true, true, true>(c.lds, g, S, E, c.wave);
            }
            if (l == 0 && early && c0.wg >= 32 && !dry) { { TAIL_BEGIN(); conv_units(c, 1); } { TAIL_BEGIN(); conv_transposes(c, 1, CV_WO); } }
        }
        SEAM(pb + 6);
        if (IN(pb + 7)) REPS(7) { PH_BEGIN(); phase_norm(c, l, mrows, SP_NFFN, 3); }
        SEAM(pb + 7);
        if (IN(pb + 8)) REPS(8) { { PH_BEGIN();
            pg8::Gemm g{HX, (const bf16_t*)(c.ws + ws_wsc(l)), mrows, DM, DM, DM, DM}; pg8::MixOrder S; S.init(mrows, c.G, c.wg);
            pg8::EpiF32 E{(float*)(c.ws + WS_P), DM};
            pg8::gemm_phase<pg8::EpiF32, pg8::MixOrder, true, true, true>(c.lds, g, S, E, c.wave);
            }
            if (l == 0 && early && c0.wg >= 32 && !dry) { { TAIL_BEGIN(); conv_transposes(c, 1, CV_WOUT); } { TAIL_BEGIN(); conv_tables(c, 1, CV_PV | CV_LRU); } { TAIL_BEGIN(); conv_small(c, 1); } }
        }
        SEAM(pb + 8);
        if (IN(pb + 9)) REPS(9) {
            { PH_BEGIN(); phase_peer(c, l, mrows, dry); } xcd_barrier(bar, c0.wave);
            { PH_BEGIN(); phase_peer_v(c, l, mrows, dry); } }
        SEAM(pb + 9);
    }
#undef IN
#undef SEAM
}

extern "C" void kernel_launch(void* const* d_in, const int* in_sizes, int n_in, void* d_out, int out_size, void* d_ws, size_t ws_size, hipStream_t stream) {
    static int grid = 0;
    if (grid == 0) {
        if (n_in != 29 || in_sizes[0] != MLAT * DM || out_size != MLAT * DM || ws_size < WS_END) {
            fprintf(stderr, "kernel_launch: built for 29 inputs, x/out of %d floats, >= %zu bytes of workspace; got n_in %d, in0 %d, out %d, ws %zu; nothing launched\n", MLAT * DM, (size_t)WS_END, n_in, n_in > 0 ? in_sizes[0] : -1, out_size, ws_size);
            grid = -1; return; }
        int dev = 0, cus = 0, per_cu = 0;
        if (hipGetDevice(&dev) != hipSuccess || hipDeviceGetAttribute(&cus, hipDeviceAttributeMultiprocessorCount, dev) != hipSuccess) { fprintf(stderr, "kernel_launch: device query failed\n"); grid = -1; return; }
        if (hipFuncSetAttribute((const void*)mk_fwd, hipFuncAttributeMaxDynamicSharedMemorySize, LDS_BYTES) != hipSuccess) { fprintf(stderr, "kernel_launch: hipFuncSetAttribute failed\n"); grid = -1; return; }
        if (hipOccupancyMaxActiveBlocksPerMultiprocessor(&per_cu, (const void*)mk_fwd, NTHREADS, LDS_BYTES) != hipSuccess || per_cu < 1)
            fprintf(stderr, "kernel_launch: note: occupancy query reports %d workgroups per CU\n", per_cu);
        (void)hipGetLastError();
        grid = cus;
    }
    if (grid < 0) return;
    if (hipMemsetAsync((char*)d_ws + WS_CTL, 0, CTL_ZERO_BYTES, stream) != hipSuccess) { fprintf(stderr, "kernel_launch: memset failed\n"); return; }
    Args a{};
    for (int i = 0; i < 29; ++i) a.in[i] = (const float*)d_in[i];
    a.out = (float*)d_out; a.ws = (unsigned char*)d_ws;
#if MK_N_LAUNCHES == 1
    a.ph_lo = 0; a.ph_hi = N_PHASES;
    hipLaunchKernelGGL(mk_fwd, dim3(grid), dim3(NTHREADS), LDS_BYTES, stream, a);
#else
    for (int k = 0; k < N_PHASES; ++k) { a.ph_lo = k; a.ph_hi = k + 1; hipLaunchKernelGGL(mk_fwd, dim3(grid), dim3(NTHREADS), LDS_BYTES, stream, a); }
#endif
    const hipError_t le = hipPeekAtLastError();
    if (le != hipSuccess) fprintf(stderr, "kernel_launch: launch failed: %s\n", hipGetErrorName(le));
}
```

```cpp
#include <hip/hip_runtime.h>
#include <cstdio>
#include <cstdint>

#ifndef MK_N_LAUNCHES
#define MK_N_LAUNCHES 1
#endif
#if MK_N_LAUNCHES != 1
#error "the PEER phase carries a grid barrier of its own: this kernel is one launch only"
#endif

#define GAS __attribute__((address_space(1)))
#define LAS __attribute__((address_space(3)))
typedef unsigned short bf16_t;
typedef short bf16x8 __attribute__((ext_vector_type(8)));
typedef short s16x4 __attribute__((ext_vector_type(4)));
typedef float f32x2 __attribute__((ext_vector_type(2)));
typedef _Float16 h16x2 __attribute__((ext_vector_type(2)));
typedef float f32x4 __attribute__((ext_vector_type(4)));
typedef float f32x8 __attribute__((ext_vector_type(8)));
typedef float f32x16 __attribute__((ext_vector_type(16)));
typedef unsigned u32x2 __attribute__((ext_vector_type(2)));
typedef unsigned u32x4 __attribute__((ext_vector_type(4)));
typedef int i32x4 __attribute__((ext_vector_type(4)));

constexpr int DM = 2048, NB = 2, SEQ = 8192, NLAYER = 2, CTXL = 256;
constexpr int MLAT = NB * SEQ, MCTX = NB * CTXL, MALL = MLAT + MCTX;
constexpr int NIN = 19456;
constexpr int CQ = 0, CK = 2048, CV = 2560, CLX = 3072, CLG = 5120, CBG = 7168, CCG = 9216, CU = 11264, CGT = 13312;
constexpr int NKEY = SEQ + CTXL;
constexpr int NCHUNK = NKEY / 64;
constexpr int NMOD = 6 * DM;
constexpr float EPS = 1e-6f;
constexpr int NWAVES = 8, NTHREADS = 512;

constexpr size_t MiB = 1u << 20;
constexpr size_t al256(size_t x) { return (x + 255) / 256 * 256; }
constexpr size_t WS_CTL = 0, CTL_ZERO_BYTES = 1 * MiB;
constexpr size_t WS_MOD = WS_CTL + CTL_ZERO_BYTES;
constexpr size_t WS_ROPE = WS_MOD + al256((size_t)NLAYER * 3 * NMOD * 4);
constexpr size_t WS_SP = WS_ROPE + al256(2 * 128 * 32 * 4);
constexpr size_t WS_CTXS = WS_SP + al256(36864 * 4);
constexpr size_t WS_LSUM = WS_CTXS + al256((size_t)MCTX * DM * 4);
constexpr size_t WS_WLRU = WS_LSUM + al256((size_t)2 * 2 * NB * NCHUNK * DM * 4);
constexpr size_t WS_KC = WS_WLRU + al256((size_t)16 * 512 * 128 * 2);
constexpr size_t WS_VC = WS_KC + al256((size_t)NB * 4 * NKEY * 128 * 2);
constexpr size_t WS_WIN = WS_VC + al256((size_t)NB * 4 * NKEY * 128 * 2);
constexpr size_t WS_CMAX = WS_WIN + (size_t)NIN * DM;
constexpr size_t WS_WDQ = WS_CMAX + al256((size_t)2 * 32 * NIN * 4);
constexpr size_t WS_ADQ = WS_WDQ + al256((size_t)NIN * 4);
constexpr size_t WS_WO = WS_WIN + al256((size_t)NIN * DM * 2);
constexpr size_t WS_WOUT = WS_WO + al256((size_t)3 * DM * DM * 2);
constexpr size_t WS_WSC = WS_WOUT + al256((size_t)DM * DM * 2);
constexpr size_t WS_PU = WS_WSC + al256((size_t)DM * DM * 2);
constexpr size_t WS_PV = WS_PU + al256((size_t)16384 * DM);
constexpr size_t WS_HX = WS_PV + al256((size_t)16384 * DM);
constexpr size_t WS_YF = WS_HX + al256((size_t)MALL * DM * 2);
constexpr size_t WS_P = WS_YF + al256((size_t)MALL * DM * 4);
static_assert(WS_ADQ + (size_t)MALL * 4 <= WS_WO, "the int8 side tables must fit the spare half of the w_in region");
constexpr size_t WS_PU2 = WS_P + al256((size_t)MALL * NIN * 2);
constexpr size_t WS_PV2 = WS_PU2 + al256((size_t)16384 * DM);
constexpr size_t WS_WSC2 = WS_PV2 + al256((size_t)16384 * DM);
constexpr size_t WS_USC = WS_WSC2 + al256((size_t)DM * DM * 2);
constexpr size_t WS_END = WS_USC + al256((size_t)2 * 16384 * 4);
__host__ __device__ constexpr size_t ws_pu(int l) { return l ? WS_PU2 : WS_PU; }
__host__ __device__ constexpr size_t ws_pv(int l) { return l ? WS_PV2 : WS_PV; }
__host__ __device__ constexpr size_t ws_wsc(int l) { return l ? WS_WSC2 : WS_WSC; }

constexpr int SP_NMIX = 0, SP_NFFN = 2048, SP_QN = 4096, SP_KN = 4224, SP_LCW = 4352, SP_LCB = 12544, SP_LBA = 14592, SP_LBX = 18688, SP_LSP = 22784, SP_SCW = 26880, SP_SCB = 33024, SP_END = 35072;

constexpr int LDS_BYTES = 147456;
constexpr int MISC_OFF = 147456 - 256;
constexpr int LDS_WORK = MISC_OFF;

__device__ __forceinline__ unsigned cvt_pk_bf16(float lo, float hi) { unsigned r; asm volatile("v_cvt_pk_bf16_f32 %0, %1, %2" : "=v"(r) : "v"(lo), "v"(hi)); return r; }
__device__ __forceinline__ unsigned pk4_i8(float a, float b, float c, float d) {
    const int ia = (int)__builtin_rintf(a), ib = (int)__builtin_rintf(b), ic = (int)__builtin_rintf(c), id = (int)__builtin_rintf(d);
    return ((unsigned)ia & 255u) | (((unsigned)ib & 255u) << 8) | (((unsigned)ic & 255u) << 16) | ((unsigned)id << 24); }
__device__ __forceinline__ float bf_lo(unsigned w) { return __uint_as_float(w << 16); }
__device__ __forceinline__ float bf_hi(unsigned w) { return __uint_as_float(w & 0xffff0000u); }
__device__ __forceinline__ float bf1(bf16_t h) { return __uint_as_float(((unsigned)h) << 16); }
__device__ __forceinline__ bf16_t f2bf(float f) { return (bf16_t)(cvt_pk_bf16(f, 0.f) & 0xffffu); }
__device__ __forceinline__ float sigmoidf_(float x) { return __builtin_amdgcn_rcpf(1.f + __expf(-x)); }
__device__ __forceinline__ float gelu_tanh(float x) { const float z = 0.7978845608028654f * (x + 0.044715f * x * x * x); const float e = __expf(2.f * z); return 0.5f * x * (2.f - 2.f * __builtin_amdgcn_rcpf(e + 1.f)); }
__device__ __forceinline__ float wave_sum(float v) {
#pragma unroll
    for (int o = 1; o < 64; o <<= 1) v += __shfl_xor(v, o);
    return v;
}
__device__ __forceinline__ float wave_max(float v) {
#pragma unroll
    for (int o = 1; o < 64; o <<= 1) v = fmaxf(v, __shfl_xor(v, o));
    return v;
}
template <class T> __device__ __forceinline__ T* as_global(T* p) { return (T*)(GAS T*)p; }
__device__ __forceinline__ int lane_id_fresh() { int l; asm volatile("v_mbcnt_lo_u32_b32 %0, -1, 0\n\tv_mbcnt_hi_u32_b32 %0, -1, %0" : "=v"(l)); return l; }
#define DPPF(v, ctrl) __int_as_float(__builtin_amdgcn_update_dpp(0, __float_as_int(v), ctrl, 0xF, 0xF, true))
#define LDS_WAIT() asm volatile("s_waitcnt lgkmcnt(0)" ::: "memory")
#define VM_WAIT() asm volatile("s_waitcnt vmcnt(0)" ::: "memory")

#define XB_TMO      128
#define XB_XCNT(j)  (256  + 64 * (j))
#define XB_XSUB(j)  (1280 + 64 * (j))
#define XB_XGEN(j)  (2304 + 64 * (j))
#define XB_TOP      3328
#define XB_TOPGEN   3392
#define XCD_BAR_WORDS 3456
#define XB_SPIN_CAP (1u << 23)
__device__ __forceinline__ unsigned xb_ld(unsigned* p)              { return __hip_atomic_load(p, __ATOMIC_RELAXED, __HIP_MEMORY_SCOPE_AGENT); }
__device__ __forceinline__ unsigned xb_add(unsigned* p, unsigned v) { return __hip_atomic_fetch_add(p, v, __ATOMIC_RELAXED, __HIP_MEMORY_SCOPE_AGENT); }
__device__ __forceinline__ unsigned xb_xcc_id() { return (unsigned)__builtin_amdgcn_s_getreg((3 << 11) | 20) & 0xFu; }
#define XB_SPIN(cond, bar) do { unsigned _sp = 0; while (cond) { __builtin_amdgcn_s_sleep(1); \
    if ((++_sp & 255u) == 0u) { if (xb_ld(&(bar)[XB_TMO])) break; if (_sp > XB_SPIN_CAP) { atomicAdd(&(bar)[XB_TMO], 1u); break; } } } } while (0)
struct XcdBarrier { unsigned* bar; unsigned x; volatile LAS unsigned* st; };
__device__ __forceinline__ XcdBarrier xcd_barrier_post(unsigned* bar, volatile LAS unsigned* st) {
    XcdBarrier b; b.bar = bar; b.x = xb_xcc_id(); b.st = st;
    if (threadIdx.x == 0) (void)xb_add(&bar[XB_XCNT(b.x)], 1u);
    return b;
}
__device__ __forceinline__ void xcd_barrier_complete(unsigned* bar, unsigned x, unsigned& nloc, unsigned& nx) {
    const unsigned G = gridDim.x * gridDim.y * gridDim.z;
    unsigned sum, cnt, mine, sp = 0u;
    for (;;) {
        sum = 0u; cnt = 0u; mine = 0u;
#pragma unroll
        for (unsigned j = 0; j < 16; ++j) { const unsigned c = xb_ld(&bar[XB_XCNT(j)]); sum += c; cnt += (c > 0u) ? 1u : 0u; mine = (j == x) ? c : mine; }
        if (sum == G) break;
        __builtin_amdgcn_s_sleep(1);
        if ((++sp & 255u) == 0u) { if (xb_ld(&bar[XB_TMO])) break; if (sp > XB_SPIN_CAP) { atomicAdd(&bar[XB_TMO], 1u); break; } }
    }
    nloc = mine > 0u ? mine : 1u; nx = cnt > 0u ? cnt : 1u;
}
__device__ __forceinline__ void xcd_barrier(const XcdBarrier& b, int wave) {
    asm volatile("s_waitcnt vmcnt(0)" ::: "memory");
    __syncthreads();
    if (wave == 0 && lane_id_fresh() == 0) {
        unsigned* bar = b.bar;
        __builtin_amdgcn_s_waitcnt(0);
        unsigned nloc = b.st[0], nx = b.st[1];
        if (nloc == 0u) { xcd_barrier_complete(bar, b.x, nloc, nx); b.st[0] = nloc; b.st[1] = nx; }
        const unsigned old = xb_add(&bar[XB_XSUB(b.x)], 1u);
        const unsigned gen = old / nloc;
        if (old + 1u == (gen + 1u) * nloc) {
            __builtin_amdgcn_fence(__ATOMIC_RELEASE, "agent");
            asm volatile("s_waitcnt vmcnt(0)" ::: "memory");
            const unsigned og = xb_add(&bar[XB_TOP], 1u);
            const unsigned tg = og / nx;
            if (og + 1u == (tg + 1u) * nx) xb_add(&bar[XB_TOPGEN], 1u);
            else XB_SPIN(xb_ld(&bar[XB_TOPGEN]) == tg, bar);
            __builtin_amdgcn_fence(__ATOMIC_ACQUIRE, "agent");
            xb_add(&bar[XB_XGEN(b.x)], 1u);
            asm volatile("s_waitcnt vmcnt(0)" ::: "memory");
        } else {
            XB_SPIN(xb_ld(&bar[XB_XGEN(b.x)]) == gen, bar);
            __builtin_amdgcn_fence(__ATOMIC_ACQUIRE, "agent");
            asm volatile("s_waitcnt vmcnt(0)" ::: "memory");
        }
    }
    __syncthreads();
}
#ifndef MIX_WGM
#define MIX_WGM 8
#endif
namespace pg8 {
#define PG8_LAS __attribute__((address_space(3)))
constexpr int BM = 256, BK = 64, HALF = 128, HTB = HALF * BK * 2, STAGE_BYTES = 8 * HTB, NXCD = 8, WGM = 8;
__host__ __device__ __forceinline__ int lds_byte(int r, int c) { const int st = (r >> 4) * 2 + (c >> 5), rr = r & 15, cc = c & 31, ob = rr * 64 + cc * 2; return st * 1024 + (ob ^ (((ob >> 9) & 1) << 5)); }
__host__ __device__ __forceinline__ void stage_rc(int b, int& R, int& C) { const int st = b / 1024, sb = b % 1024, swz = sb ^ (((sb >> 9) & 1) << 5); R = (st >> 1) * 16 + swz / 64; C = (st & 1) * 32 + (swz % 64) / 2; }
__host__ __device__ __forceinline__ int perm32(int rho) { const int n = rho >> 4, i = rho & 15; return 8 * (i >> 2) + 4 * n + (i & 3); }

struct Unit { int pm, pn, nh; };
struct Gemm { const bf16_t* A; const bf16_t* Bt; int M, N, K, lda, ldb; };

struct StaticOrder {
    int nM, nN, nwg, G, c, wgm = WGM;
    __host__ __device__ void init(int M, int N, int G_, int c_, int wgm_ = WGM) { nM = M / BM; nN = N / BM; nwg = nM * nN; G = G_; c = c_; wgm = wgm_; }
    __host__ __device__ bool next(int i, Unit& u) const {
        const long L = (long)i * G + c; if (L >= nwg) return false;
        int wgid = (int)L; { const int q = nwg / NXCD, r = nwg % NXCD, xcd = wgid % NXCD, off = wgid / NXCD; wgid = (xcd < r ? xcd * (q + 1) : r * (q + 1) + (xcd - r) * q) + off; }
        const int nig = wgm * nN, gid = wgid / nig, fm = gid * wgm, gsz = (nM - fm) < wgm ? (nM - fm) : wgm;
        u.pm = 2 * (fm + ((wgid % nig) % gsz)); u.pn = (wgid % nig) / gsz; u.nh = 2; return true;
    }
    __device__ __forceinline__ void a_ready(const Unit&) const {}
    __device__ __forceinline__ void done(const Unit&) const {}
};

struct MixOrder {
    StaticOrder lat; int nhalf;
    __host__ __device__ void init(int mrows, int G_, int c_) { lat.init(MLAT, 2048, G_, c_, MIX_WGM); nhalf = ((mrows - MLAT) / HALF) * 8; }
    __host__ __device__ bool next(int i, Unit& u) const {
        if (lat.next(i, u)) return true;
        const long h = (long)i * lat.G + lat.c - lat.nwg; if (h < 0 || h >= nhalf) return false;
        u.pm = MLAT / HALF + (int)(h >> 3); u.pn = (int)(h & 7); u.nh = 1; return true;
    }
    __device__ __forceinline__ void a_ready(const Unit&) const {}
    __device__ __forceinline__ void done(const Unit&) const {}
};

struct EpiBf16 {
    static constexpr bool PERM = true, AFTER_DRAIN = false;
    bf16_t* O; int ldc;
    __device__ __forceinline__ void operator()(const f32x4 (&acc)[2][2][4][2], const Unit& u, int wr, int wc, int fr, int fq) const {
        const int row0 = u.pm * HALF + wr * 64 + fr, col0 = u.pn * BM + wc * 32 + 8 * fq;
#pragma unroll
        for (int ai = 0; ai < 2; ++ai) if (ai < u.nh)
#pragma unroll
            for (int m = 0; m < 4; ++m) { bf16_t* rowp = O + (size_t)(row0 + ai * HALF + m * 16) * ldc + col0;
#pragma unroll
                for (int bj = 0; bj < 2; ++bj) { const f32x4 v0 = acc[ai][bj][m][0], v1 = acc[ai][bj][m][1];
                    u32x4 w; w.x = cvt_pk_bf16(v0[0], v0[1]); w.y = cvt_pk_bf16(v0[2], v0[3]); w.z = cvt_pk_bf16(v1[0], v1[1]); w.w = cvt_pk_bf16(v1[2], v1[3]);
                    *(u32x4*)(rowp + bj * HALF) = w; } }
    }
};
struct EpiI8 {
    static constexpr bool PERM = true, AFTER_DRAIN = false;
    bf16_t* O; int ldc; const float* rstep; const float* cstep;
    __device__ __forceinline__ void operator()(const f32x4 (&acc)[2][2][4][2], const Unit& u, int wr, int wc, int fr, int fq) const {
        const int row0 = u.pm * HALF + wr * 64 + fr, col0 = u.pn * BM + wc * 32 + 8 * fq;
        f32x4 cs[2][2];
#pragma unroll
        for (int bj = 0; bj < 2; ++bj) { cs[bj][0] = *(const f32x4*)(cstep + col0 + bj * HALF); cs[bj][1] = *(const f32x4*)(cstep + col0 + bj * HALF + 4); }
#pragma unroll
        for (int ai = 0; ai < 2; ++ai) if (ai < u.nh)
#pragma unroll
            for (int m = 0; m < 4; ++m) { const int r = row0 + ai * HALF + m * 16; bf16_t* rowp = O + (size_t)r * ldc + col0; const float rs = rstep[r];
#pragma unroll
                for (int bj = 0; bj < 2; ++bj) {
                    const f32x4 v0 = __builtin_convertvector(__builtin_bit_cast(i32x4, acc[ai][bj][m][0]), f32x4) * (cs[bj][0] * rs), v1 = __builtin_convertvector(__builtin_bit_cast(i32x4, acc[ai][bj][m][1]), f32x4) * (cs[bj][1] * rs);
                    u32x4 w; w.x = cvt_pk_bf16(v0[0], v0[1]); w.y = cvt_pk_bf16(v0[2], v0[3]); w.z = cvt_pk_bf16(v1[0], v1[1]); w.w = cvt_pk_bf16(v1[2], v1[3]);
                    *(u32x4*)(rowp + bj * HALF) = w; } }
    }
};
struct EpiF32 {
    static constexpr bool PERM = false, AFTER_DRAIN = false;
    float* C; int ldc;
    __device__ __forceinline__ void operator()(const f32x4 (&acc)[2][2][4][2], const Unit& u, int wr, int wc, int fr, int fq) const {
        const int row0 = u.pm * HALF + wr * 64 + fr, col0 = u.pn * BM + wc * 32 + 4 * fq;
#pragma unroll
        for (int ai = 0; ai < 2; ++ai) if (ai < u.nh)
#pragma unroll
            for (int m = 0; m < 4; ++m) { float* rowp = C + (size_t)(row0 + ai * HALF + m * 16) * ldc + col0;
#pragma unroll
                for (int bj = 0; bj < 2; ++bj)
#pragma unroll
                    for (int n = 0; n < 2; ++n) *(f32x4*)(rowp + bj * HALF + n * 16) = acc[ai][bj][m][n]; }
    }
};
template <int MODE> struct EpiMerge {
    static constexpr bool PERM = true, AFTER_DRAIN = false;
    const bf16_t* Gt; int ldg; bf16_t* Y; bf16_t* YB;
    __device__ __forceinline__ void operator()(const f32x4 (&acc)[2][2][4][2], const Unit& u, int wr, int wc, int fr, int fq) const {
        const int row0 = u.pm * HALF + wr * 64 + fr, col0 = u.pn * BM + wc * 32 + 8 * fq;
#pragma unroll
        for (int ai = 0; ai < 2; ++ai) if (ai < u.nh)
#pragma unroll
            for (int m = 0; m < 4; ++m) { const size_t r = (size_t)(row0 + ai * HALF + m * 16);
#pragma unroll
                for (int bj = 0; bj < 2; ++bj) { const int c = col0 + bj * HALF;
                    const u32x4 gw = *(const u32x4*)(Gt + r * ldg + c);
                    f32x4 g0, g1;
                    g0[0] = sigmoidf_(bf_lo(gw.x)); g0[1] = sigmoidf_(bf_hi(gw.x)); g0[2] = sigmoidf_(bf_lo(gw.y)); g0[3] = sigmoidf_(bf_hi(gw.y));
                    g1[0] = sigmoidf_(bf_lo(gw.z)); g1[1] = sigmoidf_(bf_hi(gw.z)); g1[2] = sigmoidf_(bf_lo(gw.w)); g1[3] = sigmoidf_(bf_hi(gw.w));
                    f32x4 y0 = g0 * acc[ai][bj][m][0], y1 = g1 * acc[ai][bj][m][1];
                    if (MODE != 0) { const u32x4 yw = *(const u32x4*)(Y + r * 2048 + c);
                        y0 += (f32x4){bf_lo(yw.x), bf_hi(yw.x), bf_lo(yw.y), bf_hi(yw.y)}; y1 += (f32x4){bf_lo(yw.z), bf_hi(yw.z), bf_lo(yw.w), bf_hi(yw.w)}; }
                    u32x4 w; w.x = cvt_pk_bf16(y0[0], y0[1]); w.y = cvt_pk_bf16(y0[2], y0[3]); w.z = cvt_pk_bf16(y1[0], y1[1]); w.w = cvt_pk_bf16(y1[2], y1[3]);
                    *(u32x4*)((MODE != 2 ? Y : YB) + r * 2048 + c) = w; } }
    }
};
struct EpiResid {
    static constexpr bool PERM = true, AFTER_DRAIN = false;
    float* xlat; float* xctx; const float* gate;
    const float* slat; const float* sctx;
    __device__ __forceinline__ void operator()(const f32x4 (&acc)[2][2][4][2], const Unit& u, int wr, int wc, int fr, int fq) const {
        const int vec = u.pm < 64 ? 0 : (u.pm < 128 ? 1 : 2);
        float* xb = u.pm < 128 ? xlat + (size_t)u.pm * HALF * 2048 : xctx + (size_t)(u.pm - 128) * HALF * 2048;
        const float* sb = u.pm < 128 ? slat + (size_t)u.pm * HALF * 2048 : sctx + (size_t)(u.pm - 128) * HALF * 2048;
        const int lrow0 = wr * 64 + fr, col0 = u.pn * BM + wc * 32 + 8 * fq;
        const float* gp = gate + (size_t)vec * 12288 + col0;
#pragma unroll
        for (int bj = 0; bj < 2; ++bj) { const f32x4 g0 = *(const f32x4*)(gp + bj * HALF), g1 = *(const f32x4*)(gp + bj * HALF + 4);
#pragma unroll
            for (int ai = 0; ai < 2; ++ai) if (ai < u.nh)
#pragma unroll
                for (int m = 0; m < 4; ++m) { const size_t off = (size_t)(lrow0 + ai * HALF + m * 16) * 2048 + col0 + bj * HALF; float* xp = xb + off; const float* sp = sb + off;
                    const f32x4 x0 = *(const f32x4*)sp + g0 * acc[ai][bj][m][0], x1 = *(const f32x4*)(sp + 4) + g1 * acc[ai][bj][m][1];
                    *(f32x4*)xp = x0; *(f32x4*)(xp + 4) = x1; } }
    }
};

template <class Epi, class Sched, bool ALIGN_EPI = false, bool SP2 = false, bool HALFU = false, bool I8 = false>
__device__ __forceinline__ void gemm_phase(PG8_LAS unsigned char* lds, const Gemm g, const Sched& S, const Epi& E, int wave_) {
    int tid_ = wave_ * 64 + lane_id_fresh();
    const int tid = tid_, wid = __builtin_amdgcn_readfirstlane(tid >> 6), lane = tid & 63, wr = wid >> 2, wc = wid & 3, fr = lane & 15, fq = lane >> 4;
    constexpr int ES = I8 ? 1 : 2;
    const int K = g.K, nt = K * ES / (BK * 2);
    unsigned voffA[2], voffB[2];
#pragma unroll
    for (int i = 0; i < 2; ++i) { int R, C; stage_rc(tid * 16 + i * 8192, R, C); const int Rb = Epi::PERM ? ((R & ~31) + perm32(R & 31)) : R;
        voffA[i] = (unsigned)(R * g.lda * ES + C * 2); voffB[i] = (unsigned)(Rb * g.ldb * ES + C * 2); }
    const size_t kstep = (size_t)(BK * 2);
    const size_t hstepA = (size_t)HALF * g.lda * ES, hstepB = (size_t)HALF * g.ldb * ES;
    const size_t tstepB = 2 * hstepB;
    const unsigned ldsw = (unsigned)wid * 1024u;
    const int aoff = lds_byte(wr * 64 + fr, fq * 8), boff = lds_byte(wc * 32 + fr, fq * 8);
#define PG8_SA(b, h) (((b) * 2 + (h)) * HTB)
#define PG8_SB(b, h) ((4 + (b) * 2 + (h)) * HTB)
#define PG8_STAGE(bufoff, gbase, voff) do { _Pragma("unroll") for (int _i = 0; _i < 2; ++_i) \
        __builtin_amdgcn_global_load_lds((const unsigned*)((const char*)(gbase) + (voff)[_i]), (PG8_LAS unsigned*)(lds + (bufoff) + ldsw + _i * 8192), 16, 0, 0); } while (0)
#define PG8_LDA(dst, b, h) do { _Pragma("unroll") for (int m = 0; m < 4; ++m) _Pragma("unroll") for (int k = 0; k < 2; ++k) dst[m][k] = *(const PG8_LAS bf16x8*)(lds + PG8_SA(b, h) + aoff + m * 2048 + k * 1024); } while (0)
#define PG8_LDB(dst, b, h) do { _Pragma("unroll") for (int n = 0; n < 2; ++n) _Pragma("unroll") for (int k = 0; k < 2; ++k) dst[n][k] = *(const PG8_LAS bf16x8*)(lds + PG8_SB(b, h) + boff + n * 2048 + k * 1024); } while (0)
#define PG8_MMA(ai, bj, At, Bt) do { __builtin_amdgcn_s_setprio(1); _Pragma("unroll") for (int m = 0; m < 4; ++m) _Pragma("unroll") for (int n = 0; n < 2; ++n) _Pragma("unroll") for (int k = 0; k < 2; ++k) \
        { if constexpr (I8) acc[ai][bj][m][n] = __builtin_bit_cast(f32x4, __builtin_amdgcn_mfma_i32_16x16x64_i8(__builtin_bit_cast(i32x4, Bt[n][k]), __builtin_bit_cast(i32x4, At[m][k]), __builtin_bit_cast(i32x4, acc[ai][bj][m][n]), 0, 0, 0)); \
          else acc[ai][bj][m][n] = __builtin_amdgcn_mfma_f32_16x16x32_bf16(Bt[n][k], At[m][k], acc[ai][bj][m][n], 0, 0, 0); } __builtin_amdgcn_s_setprio(0); } while (0)
#define PG8_WAIT_V(n) asm volatile("s_waitcnt vmcnt(" #n ")" ::: "memory")
#define PG8_WAIT_L(n) asm volatile("s_waitcnt lgkmcnt(" #n ")" ::: "memory")
#define PG8_BAR __builtin_amdgcn_s_barrier()
#define PG8_SCHED __builtin_amdgcn_sched_barrier(0)
    Unit cur, nxt; int ui = 0;
    if (!S.next(0, cur)) return;
    f32x4 acc[2][2][4][2];
#pragma unroll
    for (int a = 0; a < 2; ++a)
#pragma unroll
        for (int b = 0; b < 2; ++b)
#pragma unroll
            for (int m = 0; m < 4; ++m)
#pragma unroll
                for (int n = 0; n < 2; ++n) acc[a][b][m][n] = (f32x4){0.f, 0.f, 0.f, 0.f};
    bf16x8 At[4][2], B0[2][2], B1[2][2];
    const char* cA = (const char*)g.A + (size_t)cur.pm * hstepA; const char* cB = (const char*)g.Bt + (size_t)cur.pn * tstepB;
    size_t chA = (!HALFU || cur.nh == 2) ? hstepA : 0;
    S.a_ready(cur);
    if constexpr (SP2) {
        PG8_STAGE(PG8_SB(0, 0), cB, voffB); PG8_STAGE(PG8_SB(0, 1), cB + hstepB, voffB); PG8_STAGE(PG8_SA(0, 0), cA, voffA); PG8_STAGE(PG8_SA(0, 1), cA + chA, voffA);
        if (wr == 1) PG8_BAR;
        PG8_WAIT_V(2); PG8_BAR;
        PG8_STAGE(PG8_SB(1, 0), cB + kstep, voffB); PG8_STAGE(PG8_SA(1, 0), cA + kstep, voffA); PG8_STAGE(PG8_SB(1, 1), cB + hstepB + kstep, voffB);
        PG8_WAIT_V(6); PG8_BAR;
    } else {
        PG8_STAGE(PG8_SB(0, 0), cB, voffB); PG8_STAGE(PG8_SA(0, 0), cA, voffA); PG8_STAGE(PG8_SB(0, 1), cB + hstepB, voffB); PG8_STAGE(PG8_SA(0, 1), cA + chA, voffA);
        if (wr == 1) PG8_BAR;
        PG8_WAIT_V(4); PG8_BAR;
        PG8_STAGE(PG8_SB(1, 0), cB + kstep, voffB); PG8_STAGE(PG8_SA(1, 0), cA + kstep, voffA); PG8_STAGE(PG8_SB(1, 1), cB + hstepB + kstep, voffB);
        PG8_WAIT_V(6); PG8_BAR;
    }
    for (;;) {
        const bool has_next = S.next(ui + 1, nxt);
        const char* nA = has_next ? (const char*)g.A + (size_t)nxt.pm * hstepA : cA; const size_t nhA = has_next ? ((!HALFU || nxt.nh == 2) ? hstepA : 0) : chA; const bool full = (!HALFU || cur.nh == 2);
        const char* nA_ = nA; (void)nA_; const char* nB = has_next ? (const char*)g.Bt + (size_t)nxt.pn * tstepB : cB;
        for (int t = 0; t < nt; t += 2) {
            const bool last = (t == nt - 2);
            const char* a1 = cA + (size_t)(t + 1) * kstep;
            const char* a2 = last ? nA : cA + (size_t)(t + 2) * kstep; const char* b2 = last ? nB : cB + (size_t)(t + 2) * kstep;
            const char* a3 = a2 + kstep; const char* b3 = b2 + kstep;
            const size_t h2A = last ? nhA : chA;
            if (last && has_next) S.a_ready(nxt);
            if constexpr (SP2) {
            PG8_LDB(B0, 0, 0); PG8_LDB(B1, 0, 1); PG8_SCHED; PG8_LDA(At, 0, 0); PG8_STAGE(PG8_SA(1, 1), a1 + chA, voffA);
            PG8_WAIT_V(8); PG8_WAIT_L(0); PG8_BAR; PG8_MMA(0, 0, At, B0); PG8_MMA(0, 1, At, B1); PG8_BAR; PG8_SCHED;
            PG8_LDA(At, 0, 1); PG8_STAGE(PG8_SB(0, 0), b2, voffB); PG8_STAGE(PG8_SB(0, 1), b2 + hstepB, voffB); PG8_STAGE(PG8_SA(0, 0), a2, voffA);
            PG8_WAIT_V(8); PG8_WAIT_L(0); PG8_BAR; if (full) { PG8_MMA(1, 0, At, B0); PG8_MMA(1, 1, At, B1); } PG8_BAR; PG8_SCHED;
            PG8_LDB(B0, 1, 0); PG8_LDB(B1, 1, 1); PG8_SCHED; PG8_LDA(At, 1, 0); PG8_STAGE(PG8_SA(0, 1), a2 + h2A, voffA);
            PG8_WAIT_V(8); PG8_WAIT_L(0); PG8_BAR; PG8_MMA(0, 0, At, B0); PG8_MMA(0, 1, At, B1); PG8_BAR; PG8_SCHED;
            PG8_LDA(At, 1, 1); PG8_STAGE(PG8_SB(1, 0), b3, voffB); PG8_STAGE(PG8_SB(1, 1), b3 + hstepB, voffB); PG8_STAGE(PG8_SA(1, 0), a3, voffA);
            PG8_WAIT_V(8); PG8_WAIT_L(0); PG8_BAR; if (full) { PG8_MMA(1, 0, At, B0); PG8_MMA(1, 1, At, B1); } PG8_BAR; PG8_SCHED;
            } else {
            PG8_LDB(B0, 0, 0); PG8_SCHED; PG8_LDA(At, 0, 0); PG8_STAGE(PG8_SA(1, 1), a1 + chA, voffA);
            PG8_WAIT_L(8); PG8_BAR; PG8_WAIT_L(0); PG8_MMA(0, 0, At, B0); PG8_BAR; PG8_SCHED;
            PG8_LDB(B1, 0, 1); PG8_STAGE(PG8_SB(0, 0), b2, voffB);
            PG8_BAR; PG8_WAIT_L(0); PG8_MMA(0, 1, At, B1); PG8_BAR;
            PG8_LDA(At, 0, 1); PG8_STAGE(PG8_SA(0, 0), a2, voffA);
            PG8_BAR; PG8_WAIT_L(0); if (full) PG8_MMA(1, 0, At, B0); PG8_BAR; PG8_SCHED;
            PG8_STAGE(PG8_SB(0, 1), b2 + hstepB, voffB);
            PG8_WAIT_V(6); PG8_BAR; if (full) PG8_MMA(1, 1, At, B1); PG8_BAR;
            PG8_LDB(B0, 1, 0); PG8_SCHED; PG8_LDA(At, 1, 0); PG8_STAGE(PG8_SA(0, 1), a2 + h2A, voffA);
            PG8_WAIT_L(8); PG8_BAR; PG8_WAIT_L(0); PG8_MMA(0, 0, At, B0); PG8_BAR; PG8_SCHED;
            PG8_LDB(B1, 1, 1); PG8_STAGE(PG8_SB(1, 0), b3, voffB);
            PG8_BAR; PG8_WAIT_L(0); PG8_MMA(0, 1, At, B1); PG8_BAR;
            PG8_LDA(At, 1, 1); PG8_STAGE(PG8_SA(1, 0), a3, voffA);
            PG8_BAR; PG8_WAIT_L(0); if (full) PG8_MMA(1, 0, At, B0); PG8_BAR; PG8_SCHED;
            PG8_STAGE(PG8_SB(1, 1), b3 + hstepB, voffB);
            PG8_WAIT_V(6); PG8_BAR; if (full) PG8_MMA(1, 1, At, B1); PG8_BAR;
            }
        }
        if constexpr (ALIGN_EPI) { if (wr == 0) PG8_BAR; }
        if constexpr (!Epi::AFTER_DRAIN) { E(acc, cur, wr, wc, fr, fq); S.done(cur); }
        if (!has_next) break;
#pragma unroll
        for (int a = 0; a < 2; ++a)
#pragma unroll
            for (int b = 0; b < 2; ++b)
#pragma unroll
                for (int m = 0; m < 4; ++m)
#pragma unroll
                    for (int n = 0; n < 2; ++n) acc[a][b][m][n] = (f32x4){0.f, 0.f, 0.f, 0.f};
        cur = nxt; cA = nA; cB = nB; chA = nhA; ++ui;
        if constexpr (ALIGN_EPI) { if (wr == 1) PG8_BAR; }
    }
    PG8_WAIT_V(0);
    if constexpr (!ALIGN_EPI) { if (wr == 0) PG8_BAR; }
    PG8_BAR;
#undef PG8_SA
#undef PG8_SB
#undef PG8_STAGE
#undef PG8_LDA
#undef PG8_LDB
#undef PG8_MMA
#undef PG8_WAIT_V
#undef PG8_WAIT_L
#undef PG8_BAR
#undef PG8_SCHED
}
}
namespace att {
constexpr int D = 128, NW = 8, QBLK = 32, KVBLK = 64;
constexpr float SCALE = 0.088388347648318440f;
constexpr float THR = 8.f;
constexpr int LDQ = NIN, LDK = 128, LDO = NIN;
constexpr size_t SHM_V = KVBLK * D * 2, SHM_K = KVBLK * D * 2, SHM_ATTN = 2 * SHM_V + 2 * SHM_K + NW * 64 * 4;
#define KSWZ(row, colB) ((row) * 256 + ((colB) ^ (((row) & 7) << 4)))
#define SBAR() __builtin_amdgcn_sched_barrier(0)
__device__ __forceinline__ int crow(int r, int hi) { return (r & 3) + 8 * (r >> 2) + 4 * hi; }
__device__ __forceinline__ unsigned cvtpk(float lo, float hi) { unsigned r; asm volatile("v_cvt_pk_bf16_f32 %0, %1, %2" : "=v"(r) : "v"(lo), "v"(hi)); return r; }
__device__ __forceinline__ bf16x8 ld8(const bf16_t* p) { return *reinterpret_cast<const bf16x8*>(p); }

__device__ __forceinline__ void partialSM(f32x16& p0, f32x16& p1, float& m_reg, float& mn, float& alpha) {
  constexpr float C = SCALE * 1.4426950408889634f;
  float pmax = p0[0];
#pragma unroll
  for (int r = 1; r < 16; ++r) pmax = fmaxf(pmax, p0[r]);
#pragma unroll
  for (int r = 0; r < 16; ++r) pmax = fmaxf(pmax, p1[r]);
  { auto rr = __builtin_amdgcn_permlane32_swap(__float_as_uint(pmax), __float_as_uint(pmax), false, false);
    pmax = fmaxf(__uint_as_float(rr[0]), __uint_as_float(rr[1])); }
  if (__builtin_expect(__all(pmax - m_reg <= THR / SCALE), 1)) { mn = m_reg; alpha = 1.f; }
  else { mn = fmaxf(m_reg, pmax); alpha = __builtin_amdgcn_exp2f((m_reg - mn) * C); m_reg = mn; }
  float mnC = -mn * C;
#pragma unroll
  for (int r = 0; r < 16; ++r) p0[r] = fmaf(p0[r], C, mnC);
#pragma unroll
  for (int r = 0; r < 16; ++r) p1[r] = fmaf(p1[r], C, mnC);
#pragma unroll
  for (int r = 0; r < 16; ++r) p0[r] = __builtin_amdgcn_exp2f(p0[r]);
}
__device__ __forceinline__ void finishSM(f32x16& p0, f32x16& p1, float alpha, float& l_reg, bf16x8& pa0, bf16x8& pa1, bf16x8& pa2, bf16x8& pa3) {
#pragma unroll
  for (int r = 0; r < 16; ++r) p1[r] = __builtin_amdgcn_exp2f(p1[r]);
  float ps = 0;
#pragma unroll
  for (int r = 0; r < 16; ++r) ps += p0[r];
#pragma unroll
  for (int r = 0; r < 16; ++r) ps += p1[r];
  { auto rr = __builtin_amdgcn_permlane32_swap(__float_as_uint(ps), __float_as_uint(ps), false, false);
    ps = __uint_as_float(rr[0]) + __uint_as_float(rr[1]); }
  l_reg = l_reg * alpha + ps;
#define PK4(P, BASE, OUT) do { unsigned a0 = cvtpk(P[BASE + 0], P[BASE + 1]), a1 = cvtpk(P[BASE + 2], P[BASE + 3]);   \
    unsigned b0 = cvtpk(P[BASE + 4], P[BASE + 5]), b1 = cvtpk(P[BASE + 6], P[BASE + 7]);                              \
    auto r0 = __builtin_amdgcn_permlane32_swap(a0, b0, false, false); auto r1 = __builtin_amdgcn_permlane32_swap(a1, b1, false, false); \
    u32x4 w = {r0[0], r1[0], r0[1], r1[1]}; OUT = *reinterpret_cast<bf16x8*>(&w); } while (0)
  PK4(p0, 0, pa0); PK4(p0, 8, pa1); PK4(p1, 0, pa2); PK4(p1, 8, pa3);
#undef PK4
}
__device__ __forceinline__ void qkt(f32x16& p0, f32x16& p1, const bf16_t* Ks, const bf16x8* qr, int r32, int hi) {
  p0 = f32x16{}; p1 = f32x16{};
#pragma unroll
  for (int d0 = 0; d0 < 8; ++d0) { int cb = (d0 * 16 + hi * 8) * 2;
    bf16x8 b0 = *reinterpret_cast<const bf16x8*>((const char*)Ks + KSWZ(r32, cb));
    bf16x8 b1 = *reinterpret_cast<const bf16x8*>((const char*)Ks + KSWZ(32 + r32, cb));
    p0 = __builtin_amdgcn_mfma_f32_32x32x16_bf16(b0, qr[d0], p0, 0, 0, 0);
    p1 = __builtin_amdgcn_mfma_f32_32x32x16_bf16(b1, qr[d0], p1, 0, 0, 0); }
}
__device__ __forceinline__ int v_st(int k, int c) { const int kk = (k & ~0xC) | ((k & 4) << 1) | ((k & 8) >> 1); return ((kk >> 3) * 4 + (c >> 5)) * 512 + ((kk & 7) * 32 + (c & 31)) * 2; }
__device__ __forceinline__ int v_rd_base(int lane) { return ((lane & 3) << 3) | (((lane >> 2) & 3) << 6) | (((lane >> 4) & 1) << 5) | (((lane >> 5) & 1) << 8); }
constexpr int v_rd_off(int d0, int ks, int half) { return d0 * 512 + ks * 4096 + half * 2048; }
template <int OFF> __device__ __forceinline__ s16x4 tr_read(int vb) {
  s16x4 r; asm volatile("ds_read_b64_tr_b16 %0, %1 offset:%2" : "=&v"(r) : "v"(vb), "i"(OFF) : "memory"); return r;
}
template <int D0> __device__ __forceinline__ void pv_one(f32x16& od, int vb, bf16x8 pa0, bf16x8 pa1, bf16x8 pa2, bf16x8 pa3) {
  const s16x4 l0 = tr_read<v_rd_off(D0, 0, 0)>(vb), h0 = tr_read<v_rd_off(D0, 0, 1)>(vb), l1 = tr_read<v_rd_off(D0, 1, 0)>(vb), h1 = tr_read<v_rd_off(D0, 1, 1)>(vb);
  const s16x4 l2 = tr_read<v_rd_off(D0, 2, 0)>(vb), h2 = tr_read<v_rd_off(D0, 2, 1)>(vb), l3 = tr_read<v_rd_off(D0, 3, 0)>(vb), h3 = tr_read<v_rd_off(D0, 3, 1)>(vb);
  asm volatile("s_waitcnt lgkmcnt(0)" ::: "memory"); SBAR();
#define PK(L, H) (bf16x8){L[0], L[1], L[2], L[3], H[0], H[1], H[2], H[3]}
  od = __builtin_amdgcn_mfma_f32_32x32x16_bf16(pa0, PK(l0, h0), od, 0, 0, 0);
  od = __builtin_amdgcn_mfma_f32_32x32x16_bf16(pa1, PK(l1, h1), od, 0, 0, 0);
  od = __builtin_amdgcn_mfma_f32_32x32x16_bf16(pa2, PK(l2, h2), od, 0, 0, 0);
  od = __builtin_amdgcn_mfma_f32_32x32x16_bf16(pa3, PK(l3, h3), od, 0, 0, 0);
#undef PK
}
__device__ __forceinline__ void pv_d0(f32x16* o, int vb, bf16x8 pa0, bf16x8 pa1, bf16x8 pa2, bf16x8 pa3) {
  pv_one<0>(o[0], vb, pa0, pa1, pa2, pa3); pv_one<1>(o[1], vb, pa0, pa1, pa2, pa3); pv_one<2>(o[2], vb, pa0, pa1, pa2, pa3); pv_one<3>(o[3], vb, pa0, pa1, pa2, pa3);
}

__device__ __forceinline__ void attn_dense_body(const bf16_t* __restrict__ Qb, const bf16_t* __restrict__ Kh, const bf16_t* __restrict__ Vh,
                                                bf16_t* Ob, int seq, char* lds, int wave_) {
  constexpr int SDEPTH = 2;
  int tid_ = wave_ * 64 + lane_id_fresh();
  const int tid = tid_, wid = tid >> 6, lane = tid & 63, r32 = lane & 31, hi = lane >> 5;
  bf16_t* V_lds = (bf16_t*)lds; bf16_t* K_lds = (bf16_t*)(lds + 2 * SHM_V);
  float* ws = (float*)(lds + 2 * SHM_V + 2 * SHM_K) + wid * 64; float* li_l = ws; float* al_l = ws + 32;
  float m_reg = -1e30f, l_reg = 0; f32x16 o[4] = {}; bf16x8 qr[8];
  const bf16_t* Qw = Qb + (long)(wid * QBLK + r32) * LDQ + hi * 8;
#pragma unroll
  for (int d0 = 0; d0 < 8; ++d0) qr[d0] = ld8(Qw + d0 * 16);
  const int sr = tid >> 4, sc = (tid & 15) * 8, vst0 = v_st(sr, sc), vst1 = v_st(32 + sr, sc);
  const int vb0 = (int)(uintptr_t)V_lds + v_rd_base(lane);
  struct { bf16x8 vs0, vs1, ks0, ks1; } sr_[SDEPTH];
#define SLOAD(i, k0) do { sr_[i].vs0 = ld8(&Vh[(long)((k0) + sr) * LDK + sc]); sr_[i].vs1 = ld8(&Vh[(long)((k0) + 32 + sr) * LDK + sc]); \
    sr_[i].ks0 = ld8(&Kh[(long)((k0) + sr) * LDK + sc]); sr_[i].ks1 = ld8(&Kh[(long)((k0) + 32 + sr) * LDK + sc]); } while (0)
#define SWRITE(b, i) do { *(bf16x8*)((char*)V_lds + (b) * SHM_V + vst0) = sr_[i].vs0;          \
    *(bf16x8*)((char*)V_lds + (b) * SHM_V + vst1) = sr_[i].vs1; int kc = sc * 2;               \
    *(bf16x8*)((char*)K_lds + (b) * SHM_K + KSWZ(sr, kc)) = sr_[i].ks0;                       \
    *(bf16x8*)((char*)K_lds + (b) * SHM_K + KSWZ(32 + sr, kc)) = sr_[i].ks1; } while (0)
#define SWAIT() asm volatile("s_waitcnt vmcnt(4)" ::: "memory")
#define RESC(a) do { if (__any((a) < 1.f)) { if (hi == 0) al_l[r32] = (a); asm volatile("s_waitcnt lgkmcnt(0)" ::: "memory"); \
    _Pragma("unroll") for (int d = 0; d < 4; ++d) _Pragma("unroll") for (int r = 0; r < 16; ++r) o[d][r] *= al_l[crow(r, hi)]; } } while (0)
  f32x16 pA0, pA1, pB0, pB1; float mnA, mnB, alA, alB; bf16x8 pa0, pa1, pa2, pa3; const int NT = seq / KVBLK;
  constexpr int SE = 0, SO = SDEPTH - 1;
  SLOAD(SE, 0); asm volatile("s_waitcnt vmcnt(0)" ::: "memory"); SWRITE(0, SE); __syncthreads();
  qkt(pA0, pA1, K_lds, qr, r32, hi); partialSM(pA0, pA1, m_reg, mnA, alA);
  SLOAD(SO, KVBLK); if (2 < NT) SLOAD(SE, 2 * KVBLK);
  SWAIT(); SWRITE(1, SO); __syncthreads();
  for (int j = 1; j + 1 < NT; j += 2) {
    SBAR(); qkt(pB0, pB1, (bf16_t*)((char*)K_lds + SHM_K), qr, r32, hi);
    finishSM(pA0, pA1, alA, l_reg, pa0, pa1, pa2, pa3); SBAR();
    SLOAD(SO, (j + SDEPTH) * KVBLK); SBAR();
    pv_d0(o, vb0, pa0, pa1, pa2, pa3); partialSM(pB0, pB1, m_reg, mnB, alB);
    __syncthreads(); SWAIT(); SWRITE(0, SE);
    RESC(alB); __syncthreads();
    SBAR(); qkt(pA0, pA1, K_lds, qr, r32, hi);
    finishSM(pB0, pB1, alB, l_reg, pa0, pa1, pa2, pa3); SBAR();
    if (j + 3 < NT) SLOAD(SE, (j + 1 + SDEPTH) * KVBLK); SBAR();
    pv_d0(o, vb0 + (int)SHM_V, pa0, pa1, pa2, pa3); partialSM(pA0, pA1, m_reg, mnA, alA);
    __syncthreads(); SWAIT(); SWRITE(1, SO);
    RESC(alA); __syncthreads();
  }
  SBAR(); qkt(pB0, pB1, (bf16_t*)((char*)K_lds + SHM_K), qr, r32, hi);
  finishSM(pA0, pA1, alA, l_reg, pa0, pa1, pa2, pa3); SBAR();
  pv_d0(o, vb0, pa0, pa1, pa2, pa3); partialSM(pB0, pB1, m_reg, mnB, alB);
  __syncthreads(); RESC(alB);
  finishSM(pB0, pB1, alB, l_reg, pa0, pa1, pa2, pa3); SBAR();
  pv_d0(o, vb0 + (int)SHM_V, pa0, pa1, pa2, pa3);
  if (hi == 0) li_l[r32] = l_reg; asm volatile("s_waitcnt lgkmcnt(0)" ::: "memory");
  float rli[16];
#pragma unroll
  for (int r = 0; r < 16; ++r) rli[r] = __builtin_amdgcn_rcpf(li_l[crow(r, hi)]);
  bf16_t* Ow = Ob + (long)(wid * QBLK) * LDO;
#pragma unroll
  for (int r = 0; r < 16; ++r) { int orow = crow(r, hi);
#pragma unroll
    for (int d0 = 0; d0 < 4; ++d0) Ow[(long)orow * LDO + d0 * 32 + r32] = f2bf(o[d0][r] * rli[r]); }
  __syncthreads();
#undef SLOAD
#undef SWRITE
#undef SWAIT
#undef RESC
}
#undef KSWZ
#undef SBAR
}
#define CAS __attribute__((address_space(4)))
#define INP(i) ((const float*)(GAS const float*)in[i])
struct Ctx {
    float* out; unsigned char* ws;
    LAS unsigned char* lds; int tid, lane, wave, wg, G;
};
enum { I_X = 0, I_C, I_CTX, I_CCTX, I_WMOD, I_BMOD, I_NMIX, I_NFFN, I_WIN, I_QN, I_KN, I_LCW, I_LCB, I_LWA, I_LBA, I_LWX, I_LBX, I_LLAM, I_SCW, I_SCB,
       I_WOA, I_WOL, I_WOS, I_WOUT, I_PWQ, I_PK1, I_PK2, I_PU, I_PV };

__device__ __forceinline__ float* xrow_ptr(const Ctx& c, int r) {
    return r < MLAT ? c.out + (size_t)r * DM : (float*)(c.ws + WS_CTXS) + (size_t)(r - MLAT) * DM;
}

template <bool I8 = false>
__device__ __forceinline__ void transpose_item(const float* W, int K, int N, bf16_t* WT, LAS float* scr, int item, int lane, const float* cmax = nullptr, float* wdq = nullptr, LAS float* scol = nullptr) {
    const int nblk = N / 64, kb = item / nblk, nb = item % nblk, k0 = 64 * kb, n0 = 64 * nb;
    if constexpr (I8) { float mx = 0.f;
#pragma unroll 8
        for (int kc = 0; kc < 32; ++kc) mx = fmaxf(mx, cmax[(size_t)kc * N + n0 + lane]);
        scol[lane] = mx > 0.f ? 127.f / mx : 0.f;
        if (kb == 0) wdq[n0 + lane] = mx * (1.f / 127.f); }
    const float* src = W + (size_t)(k0 + (lane >> 4)) * N + n0 + (lane & 15) * 4;
    f32x4 v[16];
#pragma unroll
    for (int i = 0; i < 16; ++i) v[i] = *(const f32x4*)(src + (size_t)(4 * i) * N);
    LAS float* d = scr + (lane >> 4) * 65 + (lane & 15) * 4;
#pragma unroll
    for (int i = 0; i < 16; ++i) { d[(4 * i) * 65 + 0] = v[i][0]; d[(4 * i) * 65 + 1] = v[i][1]; d[(4 * i) * 65 + 2] = v[i][2]; d[(4 * i) * 65 + 3] = v[i][3]; }
    LDS_WAIT(); asm volatile("" ::: "memory");
    const int c = lane & 7;
#pragma unroll
    for (int j = 0; j < 8; ++j) { const int n = (lane >> 3) + 8 * j; const LAS float* s = scr + (8 * c) * 65 + n;
        if constexpr (I8) { const float q_ = scol[n]; u32x2 o; o.x = pk4_i8(s[0 * 65] * q_, s[1 * 65] * q_, s[2 * 65] * q_, s[3 * 65] * q_); o.y = pk4_i8(s[4 * 65] * q_, s[5 * 65] * q_, s[6 * 65] * q_, s[7 * 65] * q_);
            *(u32x2*)((unsigned char*)WT + (size_t)(n0 + n) * K + k0 + 8 * c) = o; }
        else { u32x4 o; o.x = cvt_pk_bf16(s[0 * 65], s[1 * 65]); o.y = cvt_pk_bf16(s[2 * 65], s[3 * 65]); o.z = cvt_pk_bf16(s[4 * 65], s[5 * 65]); o.w = cvt_pk_bf16(s[6 * 65], s[7 * 65]);
            *(u32x4*)(WT + (size_t)(n0 + n) * K + k0 + 8 * c) = o; } }
    LDS_WAIT(); asm volatile("" ::: "memory");
}

__device__ __forceinline__ void mod_unit(const Ctx& c, CAS const unsigned long long* in, int l, int cb) {
    LAS float* sv = (LAS float*)c.lds;
    LAS float* red = sv + 3 * DM;
    { const float* cc = INP(I_C); const float* cx = INP(I_CCTX);
      for (int i = c.tid; i < 3 * DM; i += NTHREADS) { const int v = i / DM, k = i % DM; const float x = v < 2 ? cc[v * DM + k] : cx[k]; sv[i] = x * sigmoidf_(x); } }
    __syncthreads();
    const int j4 = (c.tid & 31) * 4, kg = c.tid >> 5;
    const float* w = INP(I_WMOD) + (size_t)l * DM * NMOD + (size_t)(kg * 128) * NMOD + cb * 128 + j4;
    f32x4 a0 = {0.f, 0.f, 0.f, 0.f}, a1 = a0, a2 = a0;
#pragma unroll 8
    for (int k = 0; k < 128; ++k) { const f32x4 wv = *(const f32x4*)(w + (size_t)k * NMOD); const int kk = kg * 128 + k; a0 += wv * sv[kk]; a1 += wv * sv[DM + kk]; a2 += wv * sv[2 * DM + kk]; }
    *(LAS f32x4*)(red + (kg * 3 + 0) * 128 + j4) = a0; *(LAS f32x4*)(red + (kg * 3 + 1) * 128 + j4) = a1; *(LAS f32x4*)(red + (kg * 3 + 2) * 128 + j4) = a2;
    __syncthreads();
    if (c.tid < 384) { const int v = c.tid >> 7, jj = c.tid & 127; float s = INP(I_BMOD)[l * NMOD + cb * 128 + jj];
#pragma unroll
        for (int g = 0; g < 16; ++g) s += red[(g * 3 + v) * 128 + jj];
        ((float*)(c.ws + WS_MOD))[((size_t)l * 3 + v) * NMOD + cb * 128 + jj] = s; }
    __syncthreads();
}

__device__ __forceinline__ void wsc_unit(const Ctx& c, CAS const unsigned long long* in, int l, int u) {
    const int hh = u >> 4, kb = u & 15, h = hh >> 1, half = hh & 1, k0 = kb * 128;
    LAS float* kkL = (LAS float*)c.lds;
    LAS float* wqL = kkL + 128 * 132;
    const float* ksrc = INP(half ? I_PK2 : I_PK1) + ((size_t)(l * 8 + h) * 128) * 128;
    const float* qsrc = INP(I_PWQ) + (size_t)l * DM * DM + (size_t)k0 * DM + hh * 128;
    for (int i = c.tid; i < 128 * 32; i += NTHREADS) { const int r = i >> 5, c4 = (i & 31) * 4;
        *(LAS f32x4*)(kkL + r * 132 + c4) = *(const f32x4*)(ksrc + (size_t)r * 128 + c4);
        *(LAS f32x4*)(wqL + r * 132 + c4) = *(const f32x4*)(qsrc + (size_t)r * DM + c4); }
    __syncthreads();
    const int k = c.tid & 127, ng = c.tid >> 7;
    float acc[32];
#pragma unroll
    for (int j = 0; j < 32; ++j) acc[j] = 0.f;
    for (int d4 = 0; d4 < 32; ++d4) {
        const f32x4 a = *(const LAS f32x4*)(wqL + k * 132 + d4 * 4);
#pragma unroll
        for (int j = 0; j < 32; ++j) { const f32x4 b = *(const LAS f32x4*)(kkL + (ng * 32 + j) * 132 + d4 * 4); acc[j] += (a[0] * b[0] + a[1] * b[1]) + (a[2] * b[2] + a[3] * b[3]); }
    }
    bf16_t* dst = (bf16_t*)(c.ws + ws_wsc(l)) + (size_t)(hh * 128 + ng * 32) * DM + k0 + k;
#pragma unroll
    for (int j = 0; j < 32; ++j) dst[(size_t)j * DM] = f2bf(acc[j]);
    __syncthreads();
}

#define GET_IN() unsigned long long kai_ = (unsigned long long)__builtin_amdgcn_kernarg_segment_ptr(); asm volatile("" : "+s"(kai_)); CAS const unsigned long long* in = (CAS const unsigned long long*)kai_
__device__ __forceinline__ void conv_units(const Ctx& c, int l) {
    GET_IN();
    if (l == 0) for (int u = c.wg; u < 2 * 96; u += c.G) mod_unit(c, in, u / 96, u % 96);
    for (int u = c.wg; u < 256; u += c.G) wsc_unit(c, in, l, u);
}
enum { CV_WIN = 1, CV_WO = 2, CV_WOUT = 4, CV_PU = 8, CV_PV = 16, CV_LRU = 32, CV_ALL = 63 };
__device__ __forceinline__ void conv_transposes(const Ctx& c, int l, int what = CV_ALL) {
    GET_IN();
    const int gw = c.wg * NWAVES + c.wave, NGW = c.G * NWAVES;
    LAS float* scr = (LAS float*)(c.lds + c.wave * 16640);
    constexpr int I_IN = (DM / 64) * (NIN / 64), I_SQ = (DM / 64) * (DM / 64);
    const float* win = INP(I_WIN) + (size_t)l * DM * NIN;
    if (what & CV_WIN) for (int it = gw; it < I_IN; it += NGW)
        transpose_item<true>(win, DM, NIN, (bf16_t*)(c.ws + WS_WIN), scr, it, c.lane, (const float*)(c.ws + WS_CMAX) + (size_t)l * 32 * NIN, (float*)(c.ws + WS_WDQ), (LAS float*)(c.lds + 8 * 16640 + c.wave * 256));
    for (int s = 0; s < 4; ++s) { if (!(what & (s < 3 ? CV_WO : CV_WOUT))) continue;
        const float* src = INP(s == 0 ? I_WOA : s == 1 ? I_WOL : s == 2 ? I_WOS : I_WOUT) + (size_t)l * DM * DM;
        bf16_t* dst = s < 3 ? (bf16_t*)(c.ws + WS_WO) + (size_t)s * DM * DM : (bf16_t*)(c.ws + WS_WOUT);
        for (int it = gw; it < I_SQ; it += NGW) transpose_item(src, DM, DM, dst, scr, it, c.lane);
    }
}
__device__ __forceinline__ void conv_colmax(const Ctx& c) {
    GET_IN();
    const size_t gt = (size_t)c.wg * NTHREADS + c.tid, NT = (size_t)c.G * NTHREADS;
    constexpr int C4 = NIN / 4;
    for (size_t u = gt; u < (size_t)NLAYER * 32 * C4; u += NT) { const int c4 = (int)(u % C4), lk = (int)(u / C4);
        const float* src = INP(I_WIN) + (size_t)lk * 64 * NIN + c4 * 4;
        f32x4 m = {0.f, 0.f, 0.f, 0.f};
#pragma unroll 16
        for (int k = 0; k < 64; ++k) { const f32x4 v = *(const f32x4*)(src + (size_t)k * NIN); m[0] = fmaxf(m[0], fabsf(v[0])); m[1] = fmaxf(m[1], fabsf(v[1])); m[2] = fmaxf(m[2], fabsf(v[2])); m[3] = fmaxf(m[3], fabsf(v[3])); }
        *(f32x4*)((float*)(c.ws + WS_CMAX) + (size_t)lk * NIN + c4 * 4) = m; }
}
__device__ __forceinline__ void conv_tables(const Ctx& c, int l, int what = CV_ALL) {
    GET_IN();
    const size_t gt = (size_t)c.wg * NTHREADS + c.tid, NT = (size_t)c.G * NTHREADS;
    constexpr size_t NG16 = (size_t)16384 * DM / 16;
    if (what & CV_PU) {
        const int gw = c.wg * NWAVES + c.wave, NGW = c.G * NWAVES;
        const float* srcb = INP(I_PU) + (size_t)l * 16384 * DM; unsigned char* dstb = (unsigned char*)(c.ws + ws_pu(l)); float* usc = (float*)(c.ws + WS_USC) + (size_t)l * 16384;
#pragma unroll 1
        for (int e = gw; e < 16384; e += NGW) { const float* src = srcb + (size_t)e * DM + c.lane * 32;
            f32x4 v[8]; float mx = 0.f;
#pragma unroll
            for (int i = 0; i < 8; ++i) { v[i] = *(const f32x4*)(src + i * 4); mx = fmaxf(fmaxf(mx, fmaxf(fabsf(v[i][0]), fabsf(v[i][1]))), fmaxf(fabsf(v[i][2]), fabsf(v[i][3]))); }
#pragma unroll
            for (int o = 32; o > 0; o >>= 1) mx = fmaxf(mx, __shfl_xor(mx, o));
            const float st_ = mx * (0.72f / 7.f);
            const float q_ = st_ > 0.f ? 1.f / st_ : 0.f;
            if (c.lane == 0) usc[e] = st_;
            u32x4 o4;
#pragma unroll
            for (int d = 0; d < 4; ++d) { unsigned w_ = 0u;
#pragma unroll
                for (int t = 0; t < 4; ++t) { const unsigned lo_ = (unsigned)min(max((int)__builtin_rintf(v[2 * d][t] * q_), -7), 7) & 15u, hi_ = (unsigned)min(max((int)__builtin_rintf(v[2 * d + 1][t] * q_), -7), 7) & 15u; w_ |= (lo_ << (8 * t)) | (hi_ << (8 * t + 4)); }
                o4[d] = w_; }
            *(u32x4*)(dstb + (size_t)e * 1024 + c.lane * 16) = o4; } }
#pragma unroll 1
    for (int tb = 1; tb < 2; ++tb) { if (!(what & (tb ? CV_PV : CV_PU))) continue;
        const float* srcb = INP(tb ? I_PV : I_PU) + (size_t)l * 16384 * DM; unsigned char* dstb = (unsigned char*)(c.ws + (tb ? ws_pv(l) : ws_pu(l)));
        const float sc = tb ? 1.f : 32.f;
        for (size_t j = gt; j < NG16; j += 2 * NT) {
            const size_t j2 = j + NT; const bool has2 = j2 < NG16;
            f32x4 a[4], b[4];
#pragma unroll
            for (int d = 0; d < 4; ++d) a[d] = *(const f32x4*)(srcb + j * 16 + d * 4);
#pragma unroll
            for (int d = 0; d < 4; ++d) b[d] = has2 ? *(const f32x4*)(srcb + j2 * 16 + d * 4) : (f32x4){0.f, 0.f, 0.f, 0.f};
            u32x4 o, o2;
#pragma unroll
            for (int d = 0; d < 4; ++d) { const f32x4 x = a[d] * sc, y = b[d] * sc;
                int w = __builtin_amdgcn_cvt_pk_fp8_f32(x[0], x[1], 0, false); w = __builtin_amdgcn_cvt_pk_fp8_f32(x[2], x[3], w, true); o[d] = (unsigned)w;
                int w2 = __builtin_amdgcn_cvt_pk_fp8_f32(y[0], y[1], 0, false); w2 = __builtin_amdgcn_cvt_pk_fp8_f32(y[2], y[3], w2, true); o2[d] = (unsigned)w2; }
            if (tb == 0) { *(u32x4*)(dstb + j * 16) = o; if (has2) *(u32x4*)(dstb + j2 * 16) = o2; }
            else {
                *(u32x4*)(dstb + (size_t)((j & 127) >> 3) * ((size_t)16384 * 128) + (j >> 7) * 128 + (j & 7) * 16) = o;
                if (has2) *(u32x4*)(dstb + (size_t)((j2 & 127) >> 3) * ((size_t)16384 * 128) + (j2 >> 7) * 128 + (j2 & 7) * 16) = o2; } }
    }
    if (what & CV_LRU) for (size_t i = gt; i < (size_t)16 * 512 * 128; i += NT) { const int ci = (int)(i & 127), j = (int)((i >> 7) & 511), n = (int)(i >> 16), d = j >> 8, which = (j >> 7) & 1, dd = j & 127;
        const float* src = INP(which ? I_LWX : I_LWA) + ((((size_t)(l * 2 + d) * 16 + n) * 128 + ci) * 128 + dd);
        ((bf16_t*)(c.ws + WS_WLRU))[i] = f2bf(*src); }
}
__device__ __forceinline__ void sp_copy(const Ctx& c, const float* src, int sp_off, int n) {
    const size_t gt = (size_t)c.wg * NTHREADS + c.tid, NT = (size_t)c.G * NTHREADS;
    for (size_t i = gt; i < (size_t)n; i += NT) ((float*)(c.ws + WS_SP))[sp_off + i] = src[i];
}
__device__ __forceinline__ void conv_small(const Ctx& c, int l) {
    GET_IN();
    const size_t gt = (size_t)c.wg * NTHREADS + c.tid, NT = (size_t)c.G * NTHREADS;
    sp_copy(c, INP(I_NMIX) + l * DM, SP_NMIX, DM); sp_copy(c, INP(I_NFFN) + l * DM, SP_NFFN, DM);
    sp_copy(c, INP(I_QN) + l * 128, SP_QN, 128); sp_copy(c, INP(I_KN) + l * 128, SP_KN, 128);
    sp_copy(c, INP(I_LCW) + l * 4 * DM, SP_LCW, 4 * DM); sp_copy(c, INP(I_LCB) + l * DM, SP_LCB, DM);
    sp_copy(c, INP(I_LBA) + l * 2 * DM, SP_LBA, 2 * DM); sp_copy(c, INP(I_LBX) + l * 2 * DM, SP_LBX, 2 * DM);
    sp_copy(c, INP(I_SCW) + l * 3 * DM, SP_SCW, 3 * DM); sp_copy(c, INP(I_SCB) + l * DM, SP_SCB, DM);
    { const float* lam = INP(I_LLAM) + l * 2 * DM;
      for (size_t i = gt; i < (size_t)2 * DM; i += NT) ((float*)(c.ws + WS_SP))[SP_LSP + i] = 8.f * log1pf(expf(-lam[i])); }
}
__device__ __forceinline__ void conv_once(const Ctx& c) {
    const size_t gt = (size_t)c.wg * NTHREADS + c.tid, NT = (size_t)c.G * NTHREADS;
    for (size_t i = gt; i < 128 * 32; i += NT) { const int pos = (int)(i >> 5), p = (int)(i & 31);
        const float inv = exp2f(-(float)p * (13.287712379549449f / 32.f)); const float ang = (float)pos * inv;
        float sn, cs; sincosf(ang, &sn, &cs);
        ((float*)(c.ws + WS_ROPE))[i] = cs; ((float*)(c.ws + WS_ROPE))[128 * 32 + i] = sn; }
}

template <bool I8 = false>
__device__ __forceinline__ void phase_norm(const Ctx& c, int l, int nrows, int sp_gain, int slot_shift, const float* xin = nullptr, const float* cin = nullptr) {
    const int gw = c.wg * NWAVES + c.wave, NGW = c.G * NWAVES;
    const float* modl = (const float*)(c.ws + WS_MOD) + (size_t)l * 3 * NMOD;
    bf16_t* HX = (bf16_t*)(c.ws + WS_HX); const float* gain = (const float*)(c.ws + WS_SP) + sp_gain;
    for (int r = gw; r < nrows; r += NGW) {
        const int vec = r < SEQ ? 0 : (r < MLAT ? 1 : 2);
        const float* xr = xin ? (r < MLAT ? xin + (size_t)r * DM : cin + (size_t)(r - MLAT) * DM) : xrow_ptr(c, r); const float* sh = modl + (size_t)vec * NMOD + slot_shift * DM; const float* sc = sh + DM;
        f32x4 v[8]; float ss = 0.f;
#pragma unroll
        for (int j = 0; j < 8; ++j) { v[j] = *(const f32x4*)(xr + j * 256 + c.lane * 4); ss += (v[j][0] * v[j][0] + v[j][1] * v[j][1]) + (v[j][2] * v[j][2] + v[j][3] * v[j][3]); }
        const float rs = rsqrtf(wave_sum(ss) * (1.f / DM) + EPS);
        if constexpr (I8) { float mx = 0.f;
#pragma unroll
            for (int j = 0; j < 8; ++j) { const int col = j * 256 + c.lane * 4;
                const f32x4 g = *(const f32x4*)(gain + col), s1 = *(const f32x4*)(sc + col), s0 = *(const f32x4*)(sh + col);
                v[j] = (v[j] * rs * g) * (s1 + 1.f) + s0;
                mx = fmaxf(fmaxf(mx, fmaxf(fabsf(v[j][0]), fabsf(v[j][1]))), fmaxf(fabsf(v[j][2]), fabsf(v[j][3]))); }
#pragma unroll
            for (int o = 32; o > 0; o >>= 1) mx = fmaxf(mx, __shfl_xor(mx, o));
            const float q_ = mx > 0.f ? 127.f / mx : 0.f;
            if (c.lane == 0) ((float*)(c.ws + WS_ADQ))[r] = mx * (1.f / 127.f);
#pragma unroll
            for (int j = 0; j < 8; ++j) *(unsigned*)((unsigned char*)HX + (size_t)r * DM + j * 256 + c.lane * 4) = pk4_i8(v[j][0] * q_, v[j][1] * q_, v[j][2] * q_, v[j][3] * q_);
        } else {
#pragma unroll
        for (int j = 0; j < 8; ++j) { const int col = j * 256 + c.lane * 4;
            const f32x4 g = *(const f32x4*)(gain + col), s1 = *(const f32x4*)(sc + col), s0 = *(const f32x4*)(sh + col);
            const f32x4 y = (v[j] * rs * g) * (s1 + 1.f) + s0;
            u32x2 o; o.x = cvt_pk_bf16(y[0], y[1]); o.y = cvt_pk_bf16(y[2], y[3]);
            *(u32x2*)(HX + (size_t)r * DM + col) = o; } }
    }
}
__device__ __forceinline__ void seg_of_row(int r, bool& is_ctx, int& b, int& t) {
    is_ctx = r >= MLAT; b = is_ctx ? (r - MLAT) >> 8 : r >> 13; t = is_ctx ? (r - MLAT) & 255 : r & (SEQ - 1);
}
__device__ __forceinline__ void qk_row(const Ctx& c, int l, int r, bool do_q, bool dry) {
    bool is_ctx; int b, t; seg_of_row(r, is_ctx, b, t);
    const int key = is_ctx ? t : CTXL + t;
    bf16_t* prow = (bf16_t*)(c.ws + WS_P) + (size_t)r * NIN;
    bf16_t* KC = (bf16_t*)(c.ws + WS_KC); bf16_t* VC = (bf16_t*)(c.ws + WS_VC);
    const int hs = c.lane >> 4, ax = (c.lane >> 3) & 1, p0 = (c.lane & 7) * 4;
    f32x4 cs = {1.f, 1.f, 1.f, 1.f}, sn = {0.f, 0.f, 0.f, 0.f};
    if (!is_ctx) { const int pos = ax ? (t & 63) : (t >> 6); const float* rt = (const float*)(c.ws + WS_ROPE) + pos * 32 + p0; cs = *(const f32x4*)rt; sn = *(const f32x4*)(rt + 128 * 32); }
    u32x2 w1[5], w2[5];
#pragma unroll
    for (int g = 0; g < 5; ++g) { const bool is_k = (g == 4); const int head = is_k ? hs : g * 4 + hs;
        const bf16_t* src = prow + (is_k ? CK : CQ) + head * 128 + ax * 64 + p0;
        if (is_k || do_q) { w1[g] = *(const u32x2*)src; w2[g] = *(const u32x2*)(src + 32); } else { w1[g] = (u32x2){0u, 0u}; w2[g] = (u32x2){0u, 0u}; } }
    const u32x4 vw = *(const u32x4*)(prow + CV + (c.lane >> 4) * 128 + (c.lane & 15) * 8);
#pragma unroll
    for (int g = 0; g < 5; ++g) {
        const bool is_k = (g == 4);
        if (!is_k && !do_q) continue;
        const int head = is_k ? hs : g * 4 + hs;
        bf16_t* src = prow + (is_k ? CK : CQ) + head * 128 + ax * 64 + p0;
        f32x4 t1 = {bf_lo(w1[g].x), bf_hi(w1[g].x), bf_lo(w1[g].y), bf_hi(w1[g].y)}, t2 = {bf_lo(w2[g].x), bf_hi(w2[g].x), bf_lo(w2[g].y), bf_hi(w2[g].y)};
        float ss = (t1[0] * t1[0] + t1[1] * t1[1]) + (t1[2] * t1[2] + t1[3] * t1[3]) + (t2[0] * t2[0] + t2[1] * t2[1]) + (t2[2] * t2[2] + t2[3] * t2[3]);
        ss += DPPF(ss, 0xB1); ss += DPPF(ss, 0x4E); ss += DPPF(ss, 0x141); ss += DPPF(ss, 0x140);
        const float rs = rsqrtf(ss * (1.f / 128.f) + EPS);
        const float* gn = (const float*)(c.ws + WS_SP) + (is_k ? SP_KN : SP_QN) + ax * 64 + p0;
        const f32x4 g1 = *(const f32x4*)gn, g2 = *(const f32x4*)(gn + 32);
        const f32x4 y1 = t1 * rs * g1, y2 = t2 * rs * g2;
        const f32x4 o1 = y1 * cs - y2 * sn, o2 = y2 * cs + y1 * sn;
        bf16_t* dst = is_k ? KC + ((size_t)(b * 4 + head) * NKEY + key) * 128 + ax * 64 + p0 : (dry ? (bf16_t*)(c.ws + WS_YF) + (size_t)r * DM + head * 128 + ax * 64 + p0 : src);
        u32x2 a; a.x = cvt_pk_bf16(o1[0], o1[1]); a.y = cvt_pk_bf16(o1[2], o1[3]);
        u32x2 bq; bq.x = cvt_pk_bf16(o2[0], o2[1]); bq.y = cvt_pk_bf16(o2[2], o2[3]);
        *(u32x2*)dst = a; *(u32x2*)(dst + 32) = bq;
    }
    { const int hv = c.lane >> 4, dd = (c.lane & 15) * 8;
      *(u32x4*)(VC + ((size_t)(b * 4 + hv) * NKEY + key) * 128 + dd) = vw; }
}
__device__ __forceinline__ void unpack8(const u32x4 w, float (&f)[8]) {
    f[0] = bf_lo(w.x); f[1] = bf_hi(w.x); f[2] = bf_lo(w.y); f[3] = bf_hi(w.y); f[4] = bf_lo(w.z); f[5] = bf_hi(w.z); f[6] = bf_lo(w.w); f[7] = bf_hi(w.w);
}
__device__ __forceinline__ void sc_row(const Ctx& c, int l, int r, bool dry) {
    bool is_ctx; int b, t; seg_of_row(r, is_ctx, b, t);
    const int seglen = is_ctx ? CTXL : SEQ;
    bf16_t* prow = (bf16_t*)(c.ws + WS_P) + (size_t)r * NIN;
    const bool hp = t > 0, hn = t < seglen - 1;
    const float* w = (const float*)(c.ws + WS_SP) + SP_SCW; const float* bias = (const float*)(c.ws + WS_SP) + SP_SCB;
    u32x4 xb[4], xc0[4], xu0[4], xcp[4], xup[4], xcn[4], xun[4];
    const u32x4 z = {0u, 0u, 0u, 0u};
#pragma unroll
    for (int it = 0; it < 4; ++it) { const int col = it * 512 + c.lane * 8;
        xb[it] = *(const u32x4*)(prow + CBG + col); xc0[it] = *(const u32x4*)(prow + CCG + col); xu0[it] = *(const u32x4*)(prow + CU + col);
        xcp[it] = hp ? *(const u32x4*)(prow - NIN + CCG + col) : z; xup[it] = hp ? *(const u32x4*)(prow - NIN + CU + col) : z;
        xcn[it] = hn ? *(const u32x4*)(prow + NIN + CCG + col) : z; xun[it] = hn ? *(const u32x4*)(prow + NIN + CU + col) : z; }
#pragma unroll
    for (int it = 0; it < 4; ++it) {
        const int col = it * 512 + c.lane * 8;
        float bg[8], c0[8], u0[8], cp[8], up[8], cn[8], un[8];
        unpack8(xb[it], bg); unpack8(xc0[it], c0); unpack8(xu0[it], u0); unpack8(xcp[it], cp); unpack8(xup[it], up); unpack8(xcn[it], cn); unpack8(xun[it], un);
        float o[8];
#pragma unroll
        for (int hq = 0; hq < 2; ++hq) { const f32x4 w0 = *(const f32x4*)(w + col + hq * 4), w1 = *(const f32x4*)(w + DM + col + hq * 4), w2 = *(const f32x4*)(w + 2 * DM + col + hq * 4), bi = *(const f32x4*)(bias + col + hq * 4);
#pragma unroll
            for (int e = 0; e < 4; ++e) { const int k = hq * 4 + e; o[k] = bg[k] * (bi[e] + w0[e] * (cp[k] * up[k]) + w1[e] * (c0[k] * u0[k]) + w2[e] * (cn[k] * un[k])); } }
        u32x4 ow; ow.x = cvt_pk_bf16(o[0], o[1]); ow.y = cvt_pk_bf16(o[2], o[3]); ow.z = cvt_pk_bf16(o[4], o[5]); ow.w = cvt_pk_bf16(o[6], o[7]);
        *(u32x4*)((dry ? (bf16_t*)(c.ws + WS_YF) + (size_t)(MALL + r) * DM : prow + CBG) + col) = ow;
    }
}

constexpr size_t lsum_idx(int which, int dir, int b, int j) { return ((((size_t)which * 2 + dir) * NB + b) * NCHUNK + j) * DM; }
template <int DIR, int PASS>
__device__ __forceinline__ void lru_chunk(const LAS bf16_t* ub, const LAS float* uf, LAS float* hsd, const bf16x8 (&bfr)[4][4], const float (&ba)[2], const float (&bx)[2], const float (&sp8)[2],
                                          const float (&cin)[2], float (&Atot)[2], float (&Hend)[2], int q, int col16, int quad) {
    float st[2] = {cin[0], cin[1]}, at[2] = {1.f, 1.f};
    const int mysg = DIR ? 3 - quad : quad;
    for (int smt = 0; smt < 4; ++smt) {
        const int mt = DIR ? 3 - smt : smt;
        f32x4 acc[4];
#pragma unroll
        for (int nt = 0; nt < 4; ++nt) acc[nt] = (f32x4){0.f, 0.f, 0.f, 0.f};
#pragma unroll
        for (int ks = 0; ks < 4; ++ks) { const bf16x8 a = *(const LAS bf16x8*)(ub + (mt * 16 + col16) * 136 + ks * 32 + quad * 8);
#pragma unroll
            for (int nt = 0; nt < 4; ++nt) acc[nt] = __builtin_amdgcn_mfma_f32_16x16x32_bf16(a, bfr[nt][ks], acc[nt], 0, 0, 0); }
#pragma unroll
        for (int ct = 0; ct < 2; ++ct) {
            const int ch = q * 32 + ct * 16 + col16;
            float av[4], dv[4];
#pragma unroll
            for (int reg = 0; reg < 4; ++reg) { const int tl = mt * 16 + quad * 4 + reg;
                const float r = sigmoidf_(acc[ct][reg] + ba[ct]), ig = sigmoidf_(acc[2 + ct][reg] + bx[ct]);
                const float a = __expf(-sp8[ct] * r);
                av[reg] = a; dv[reg] = __builtin_amdgcn_sqrtf(fmaxf(1.f - a * a, 0.f)) * ig * uf[tl * 132 + ch]; }
            float Al = 1.f, Hl = 0.f;
#pragma unroll
            for (int sr = 0; sr < 4; ++sr) { const int reg = DIR ? 3 - sr : sr; Hl = av[reg] * Hl + dv[reg]; Al *= av[reg]; }
            float se = st[ct], so = st[ct], ap = 1.f;
#pragma unroll
            for (int sg = 0; sg < 4; ++sg) { const int qp = DIR ? 3 - sg : sg; const float Ag = __shfl(Al, col16 + 16 * qp), Hg = __shfl(Hl, col16 + 16 * qp);
                const float nx = Ag * so + Hg; so = nx; if (sg < mysg) se = nx; ap *= Ag; }
            if (PASS == 2) { float h = se;
#pragma unroll
                for (int sr = 0; sr < 4; ++sr) { const int reg = DIR ? 3 - sr : sr; h = av[reg] * h + dv[reg]; hsd[(mt * 16 + quad * 4 + reg) * 132 + ch] = h; } }
            else at[ct] *= ap;
            st[ct] = so;
        }
    }
    Atot[0] = at[0]; Atot[1] = at[1]; Hend[0] = st[0]; Hend[1] = st[1];
}

template <int PASS>
__device__ __forceinline__ void lru_run(const Ctx& c, int l, int unit, bool dry = false) {
    const int b = unit >> 7, n = (unit >> 3) & 15, run = unit & 7;
    const int c0 = run * 16 + (run < 4 ? run : 4), len = 16 + (run < 4 ? 1 : 0);
    LAS float* xl = (LAS float*)c.lds;
    LAS float* uf = (LAS float*)(c.lds + 34816);
    LAS bf16_t* ub = (LAS bf16_t*)(c.lds + 34816 + 33792);
    LAS float* car = (LAS float*)(c.lds + 34816 + 33792 + 17408);
    LAS float* hsr = (LAS float*)(c.lds + 34816 + 33792 + 17408 + 17408);
    const int d = c.wave >> 2, q = c.wave & 3, col16 = c.lane & 15, quad = c.lane >> 4;
    float* LS = (float*)(c.ws + WS_LSUM);
    bf16_t* P = (bf16_t*)(c.ws + WS_P);
    bf16x8 bfr[4][4];
#pragma unroll
    for (int nt = 0; nt < 4; ++nt) { const int j = d * 256 + (nt >> 1) * 128 + q * 32 + (nt & 1) * 16 + col16;
#pragma unroll
        for (int ks = 0; ks < 4; ++ks) bfr[nt][ks] = *(const bf16x8*)((const bf16_t*)(c.ws + WS_WLRU) + ((size_t)(n * 512 + j) * 128 + ks * 32 + quad * 8)); }
    float ba[2], bx[2], sp8[2];
#pragma unroll
    for (int ct = 0; ct < 2; ++ct) { const int cidx = n * 128 + q * 32 + ct * 16 + col16; const float* sp = (const float*)(c.ws + WS_SP) + d * DM + cidx;
        ba[ct] = sp[SP_LBA]; bx[ct] = sp[SP_LBX]; sp8[ct] = sp[SP_LSP]; }
    if (PASS == 2) {
        if (c.tid < 256) { const int dir = c.tid >> 7, ch = c.tid & 127, cidx = n * 128 + ch; float st = 0.f;
#pragma unroll 1
            for (int k0 = 0; k0 < NCHUNK; k0 += 12) {
                float av[12], hv[12];
#pragma unroll
                for (int kk = 0; kk < 12; ++kk) { const int k = k0 + kk, j = dir ? (k < 4 ? 3 - k : 135 - k) : k; av[kk] = LS[lsum_idx(0, dir, b, j) + cidx]; hv[kk] = LS[lsum_idx(1, dir, b, j) + cidx]; }
#pragma unroll
                for (int kk = 0; kk < 12; ++kk) { const int k = k0 + kk, j = dir ? (k < 4 ? 3 - k : 135 - k) : k;
                    if (j >= c0 && j < c0 + len) car[(dir * 17 + (j - c0)) * 128 + ch] = st;
                    st = av[kk] * st + hv[kk]; } } }
        __syncthreads();
    }
    const float* cw = (const float*)(c.ws + WS_SP) + SP_LCW + n * 128; const float* cb = (const float*)(c.ws + WS_SP) + SP_LCB + n * 128;
#define LRU_GEOM(ci_, jc, is_ctx, rb, t0, seglen) const int jc = c0 + (ci_); const bool is_ctx = jc < 4; \
        const int rb = is_ctx ? MLAT + b * CTXL : b * SEQ, t0 = is_ctx ? jc * 64 : (jc - 4) * 64, seglen = is_ctx ? CTXL : SEQ
#define LRU_LOAD(ci_, XR, LG) do { LRU_GEOM(ci_, jc_, ic_, rb_, t0_, sl_); (void)ic_; \
        _Pragma("unroll") for (int ps = 0; ps < 3; ++ps) { const int i = ps * 32 + (c.tid >> 4); const int t = t0_ - 2 + i; XR[ps] = (u32x4){0u, 0u, 0u, 0u}; \
            if (i < 68 && t >= 0 && t < sl_) XR[ps] = *(const u32x4*)(P + (size_t)(rb_ + t) * NIN + CLX + n * 128 + (c.tid & 15) * 8); } \
        if (PASS == 2) { const bf16_t* gp_ = P + (size_t)(rb_ + t0_ + (c.tid >> 3)) * NIN + CLG + n * 128 + (c.tid & 7) * 16; LG[0] = *(const u32x4*)gp_; LG[1] = *(const u32x4*)(gp_ + 8); } } while (0)
    u32x4 xr[3], lgc[2] = {{0u, 0u, 0u, 0u}, {0u, 0u, 0u, 0u}}, lgn[2] = {{0u, 0u, 0u, 0u}, {0u, 0u, 0u, 0u}};
    LRU_LOAD(0, xr, lgn);
    for (int ci = 0; ci < len; ++ci) {
        LRU_GEOM(ci, jc, is_ctx, rb, t0, seglen); (void)is_ctx; (void)seglen;
#pragma unroll
        for (int ps = 0; ps < 3; ++ps) { const int i = ps * 32 + (c.tid >> 4);
            if (i < 68) { float f[8]; unpack8(xr[ps], f);
                *(LAS f32x4*)(xl + i * 128 + (c.tid & 15) * 8) = (f32x4){f[0], f[1], f[2], f[3]}; *(LAS f32x4*)(xl + i * 128 + (c.tid & 15) * 8 + 4) = (f32x4){f[4], f[5], f[6], f[7]}; } }
        lgc[0] = lgn[0]; lgc[1] = lgn[1];
        __syncthreads();
        if (ci + 1 < len) LRU_LOAD(ci + 1, xr, lgn);
        { const int ch = c.tid & 127, tq = c.tid >> 7; const float w0 = cw[ch], w1 = cw[DM + ch], w2 = cw[2 * DM + ch], w3 = cw[3 * DM + ch], bb = cb[ch];
#pragma unroll 4
          for (int tt = 0; tt < 16; ++tt) { const int tl = tq * 16 + tt;
              const float u = bb + w0 * xl[tl * 128 + ch] + w1 * xl[(tl + 1) * 128 + ch] + w2 * xl[(tl + 2) * 128 + ch] + w3 * xl[(tl + 3) * 128 + ch];
              uf[tl * 132 + ch] = u; ub[tl * 136 + ch] = f2bf(u); } }
        __syncthreads();
        float cin[2] = {0.f, 0.f}, At[2], He[2];
        if (PASS == 2) { cin[0] = car[(d * 17 + ci) * 128 + q * 32 + col16]; cin[1] = car[(d * 17 + ci) * 128 + q * 32 + 16 + col16]; }
        if (d == 0) lru_chunk<0, PASS>(ub, uf, xl, bfr, ba, bx, sp8, cin, At, He, q, col16, quad);
        else lru_chunk<1, PASS>(ub, uf, hsr, bfr, ba, bx, sp8, cin, At, He, q, col16, quad);
        if (PASS == 1) {
            if (quad == 0) {
#pragma unroll
                for (int ct = 0; ct < 2; ++ct) { const int cidx = n * 128 + q * 32 + ct * 16 + col16;
                    LS[lsum_idx(0, d, b, jc) + cidx] = At[ct]; LS[lsum_idx(1, d, b, jc) + cidx] = He[ct]; } }
            __syncthreads();
        } else {
            __syncthreads();
            { const int row = c.tid >> 3, cs = (c.tid & 7) * 16;
              bf16_t* gp = P + (size_t)(rb + t0 + row) * NIN + CLG + n * 128 + cs;
#pragma unroll
              for (int hseg = 0; hseg < 2; ++hseg) { float g[8]; unpack8(lgc[hseg], g);
                  const int o = row * 132 + cs + hseg * 8;
                  const f32x4 h0 = *(const LAS f32x4*)(xl + o) + *(const LAS f32x4*)(hsr + o), h1 = *(const LAS f32x4*)(xl + o + 4) + *(const LAS f32x4*)(hsr + o + 4);
                  u32x4 ow; ow.x = cvt_pk_bf16(h0[0] * gelu_tanh(g[0]), h0[1] * gelu_tanh(g[1])); ow.y = cvt_pk_bf16(h0[2] * gelu_tanh(g[2]), h0[3] * gelu_tanh(g[3]));
                  ow.z = cvt_pk_bf16(h1[0] * gelu_tanh(g[4]), h1[1] * gelu_tanh(g[5])); ow.w = cvt_pk_bf16(h1[2] * gelu_tanh(g[6]), h1[3] * gelu_tanh(g[7]));
                  *(u32x4*)((dry ? gp - CLG + CU : gp) + hseg * 8) = ow; } }
            __syncthreads();
        }
    }
#undef LRU_GEOM
#undef LRU_LOAD
}

__device__ __forceinline__ void phase_qk(const Ctx& c, int l, bool dry = false) {
    const int gw = c.wg * NWAVES + c.wave, NGW = c.G * NWAVES;
    for (int r = gw; r < MALL; r += NGW) qk_row(c, l, r, l == 0 || r < MLAT, dry);
}
__device__ __forceinline__ void sc_block8(const Ctx& c, int r0, bool dry) {
    const int t0 = r0 & (SEQ - 1);
    bf16_t* prow0 = (bf16_t*)(c.ws + WS_P) + (size_t)r0 * NIN;
    const float* w = (const float*)(c.ws + WS_SP) + SP_SCW; const float* bias = (const float*)(c.ws + WS_SP) + SP_SCB;
    const u32x4 z = {0u, 0u, 0u, 0u};
#pragma unroll 1
    for (int it = 0; it < 4; ++it) {
        const int col = it * 512 + c.lane * 8;
        float w0[8], w1[8], w2[8], bi[8];
#pragma unroll
        for (int hq = 0; hq < 2; ++hq) { const f32x4 a = *(const f32x4*)(w + col + hq * 4), b = *(const f32x4*)(w + DM + col + hq * 4), d = *(const f32x4*)(w + 2 * DM + col + hq * 4), e = *(const f32x4*)(bias + col + hq * 4);
#pragma unroll
            for (int k = 0; k < 4; ++k) { w0[hq * 4 + k] = a[k]; w1[hq * 4 + k] = b[k]; w2[hq * 4 + k] = d[k]; bi[hq * 4 + k] = e[k]; } }
        u32x4 xc[10], xu[10], xb[8];
#pragma unroll
        for (int j = 0; j < 10; ++j) { const int t = t0 - 1 + j; const bool in = t >= 0 && t < SEQ; const bf16_t* pr = prow0 + (ptrdiff_t)(j - 1) * NIN;
            xc[j] = in ? *(const u32x4*)(pr + CCG + col) : z; xu[j] = in ? *(const u32x4*)(pr + CU + col) : z; }
#pragma unroll
        for (int j = 0; j < 8; ++j) xb[j] = *(const u32x4*)(prow0 + (size_t)j * NIN + CBG + col);
        float zp[8], zc[8];
        { float a[8], b[8]; unpack8(xc[0], a); unpack8(xu[0], b);
#pragma unroll
          for (int k = 0; k < 8; ++k) zp[k] = a[k] * b[k];
          unpack8(xc[1], a); unpack8(xu[1], b);
#pragma unroll
          for (int k = 0; k < 8; ++k) zc[k] = a[k] * b[k]; }
#pragma unroll
        for (int j = 0; j < 8; ++j) {
            float a[8], b[8], bg[8], zn[8], o[8]; unpack8(xc[j + 2], a); unpack8(xu[j + 2], b); unpack8(xb[j], bg);
#pragma unroll
            for (int k = 0; k < 8; ++k) { zn[k] = a[k] * b[k]; o[k] = bg[k] * (bi[k] + w0[k] * zp[k] + w1[k] * zc[k] + w2[k] * zn[k]); zp[k] = zc[k]; zc[k] = zn[k]; }
            u32x4 ow; ow.x = cvt_pk_bf16(o[0], o[1]); ow.y = cvt_pk_bf16(o[2], o[3]); ow.z = cvt_pk_bf16(o[4], o[5]); ow.w = cvt_pk_bf16(o[6], o[7]);
            *(u32x4*)((dry ? (bf16_t*)(c.ws + WS_YF) + (size_t)(MALL + r0 + j) * DM : prow0 + (size_t)j * NIN + CBG) + col) = ow; }
    }
}
__device__ __forceinline__ void phase_sc(const Ctx& c, int l, bool dry = false) {
    const int gw = c.wg * NWAVES + c.wave, NGW = c.G * NWAVES;
    for (int r0 = gw * 8; r0 < MLAT; r0 += NGW * 8) sc_block8(c, r0, dry);
    if (l == 0) for (int r = MLAT + gw; r < MALL; r += NGW) sc_row(c, l, r, dry);
}
__device__ __forceinline__ void phase_lru1(const Ctx& c, int l) {
    for (int u = c.wg; u < 256; u += c.G) lru_run<1>(c, l, u);
}

__device__ __forceinline__ void phase_m2(const Ctx& c, int l, bool dry = false) {
    bf16_t* P = (bf16_t*)(c.ws + WS_P); const bf16_t* KC = (const bf16_t*)(c.ws + WS_KC); const bf16_t* VC = (const bf16_t*)(c.ws + WS_VC);
    const int ntot = 1024 + (l == 0 ? 32 : 0);
    for (int i = 0; i * c.G + c.wg < ntot; ++i) {
        const int L = i * c.G + c.wg; int b, h, seq; size_t qrow;
        if (L < 1024) { int grp, qb;
            if (c.G == 256) { grp = i * 8 + (c.wg & 7); qb = c.wg >> 3; } else { grp = L >> 5; qb = L & 31; }
            b = grp >> 4; h = grp & 15; qrow = (size_t)(b * SEQ + qb * 256); seq = NKEY; }
        else { const int u = L - 1024; b = u >> 4; h = u & 15; qrow = (size_t)(MLAT + b * CTXL); seq = CTXL; }
        bf16_t* q = P + qrow * NIN + CQ + h * 128;
        const size_t kvo = (size_t)(b * 4 + (h >> 2)) * NKEY * 128;
        att::attn_dense_body(q, KC + kvo, VC + kvo, dry ? q - CQ + CCG : q, seq, (char*)c.lds, c.wave);
    }
}
__device__ __forceinline__ void phase_lru2(const Ctx& c, int l, bool dry = false) {
    for (int u = c.wg; u < 256; u += c.G) lru_run<2>(c, l, u, dry);
}
constexpr float NEGBIG = -3.0e38f;
constexpr float PU_SCALE = 32.f;
__device__ __forceinline__ float wave_max_dpp(float v) {
    v = fmaxf(v, DPPF(v, 0xB1)); v = fmaxf(v, DPPF(v, 0x4E)); v = fmaxf(v, DPPF(v, 0x141)); v = fmaxf(v, DPPF(v, 0x140));
    const float a = __int_as_float(__builtin_amdgcn_readlane(__float_as_int(v), 0)), b = __int_as_float(__builtin_amdgcn_readlane(__float_as_int(v), 16));
    const float c = __int_as_float(__builtin_amdgcn_readlane(__float_as_int(v), 32)), d = __int_as_float(__builtin_amdgcn_readlane(__float_as_int(v), 48));
    return fmaxf(fmaxf(a, b), fmaxf(c, d));
}
#define SWZ_XOR(v, m) __int_as_float(__builtin_amdgcn_ds_swizzle(__float_as_int(v), ((m) << 10) | 0x1F))
__device__ __forceinline__ unsigned fkey(float x) { const unsigned u = __float_as_uint(x); return (u & 0x80000000u) ? ~u : (u | 0x80000000u); }
#define DPPU(v, ctrl) ((unsigned)__builtin_amdgcn_update_dpp(0, (int)(v), ctrl, 0xF, 0xF, true))
__device__ __forceinline__ unsigned wave_max_u32(unsigned v) {
    v = max(v, DPPU(v, 0xB1)); v = max(v, DPPU(v, 0x4E)); v = max(v, DPPU(v, 0x141)); v = max(v, DPPU(v, 0x140));
    const unsigned a = (unsigned)__builtin_amdgcn_readlane((int)v, 0), b = (unsigned)__builtin_amdgcn_readlane((int)v, 16), c = (unsigned)__builtin_amdgcn_readlane((int)v, 32), d = (unsigned)__builtin_amdgcn_readlane((int)v, 48);
    return max(max(a, b), max(c, d));
}
__device__ __forceinline__ unsigned topk16_keys2(unsigned k0, unsigned k1, int lane) {
    unsigned res = 0u;
    for (int it = 0; it < 16; ++it) { const unsigned m = wave_max_u32(max(k0, k1)); k0 = (k0 == m) ? 0u : k0; k1 = (k1 == m) ? 0u : k1; res = (lane == it) ? m : res; }
    return res;
}
__device__ __forceinline__ unsigned topk16_keys1(unsigned k0, int lane) {
    unsigned res = 0u;
    for (int it = 0; it < 16; ++it) { const unsigned m = wave_max_u32(k0); k0 = (k0 == m) ? 0u : k0; res = (lane == it) ? m : res; }
    return res;
}
__device__ __forceinline__ void unpack_fp8x16(const u32x4 w, float (&f)[16]) {
#pragma unroll
    for (int d = 0; d < 4; ++d) { const f32x2 lo = __builtin_amdgcn_cvt_pk_f32_fp8((int)w[d], false), hi = __builtin_amdgcn_cvt_pk_f32_fp8((int)w[d], true);
        f[4 * d] = lo.x; f[4 * d + 1] = lo.y; f[4 * d + 2] = hi.x; f[4 * d + 3] = hi.y; }
}

__device__ __forceinline__ unsigned half_max_u32(unsigned v, bool hi_half) {
    v = max(v, DPPU(v, 0xB1)); v = max(v, DPPU(v, 0x4E)); v = max(v, DPPU(v, 0x141)); v = max(v, DPPU(v, 0x140));
    const unsigned a = max((unsigned)__builtin_amdgcn_readlane((int)v, 0), (unsigned)__builtin_amdgcn_readlane((int)v, 16));
    const unsigned b = max((unsigned)__builtin_amdgcn_readlane((int)v, 32), (unsigned)__builtin_amdgcn_readlane((int)v, 48));
    return hi_half ? b : a;
}
__device__ __forceinline__ unsigned topk16_half4(unsigned (&k)[4], int hl, bool hi_half) {
    unsigned res = 0u;
    for (int it = 0; it < 16; ++it) { const unsigned m = half_max_u32(max(max(k[0], k[1]), max(k[2], k[3])), hi_half);
#pragma unroll
        for (int j = 0; j < 4; ++j) k[j] = (k[j] == m) ? 0u : k[j];
        res = (hl == it) ? m : res; }
    return res;
}
__device__ __forceinline__ unsigned topk16_half2(unsigned k0, unsigned k1, int hl, bool hi_half) {
    unsigned res = 0u;
    for (int it = 0; it < 16; ++it) { const unsigned m = half_max_u32(max(k0, k1), hi_half); k0 = (k0 == m) ? 0u : k0; k1 = (k1 == m) ? 0u : k1; res = (hl == it) ? m : res; }
    return res;
}
__device__ __forceinline__ void cand_ab(int cidx50, int& a, int& b) {
    a = cidx50 < 16 ? 0 : cidx50 < 24 ? 1 : cidx50 < 29 ? 2 : cidx50 < 33 ? 3 : cidx50 < 36 ? 4 : cidx50 < 38 ? 5 : cidx50 < 40 ? 6 : cidx50 < 42 ? 7 : cidx50 - 34;
    const int st = cidx50 < 16 ? 0 : cidx50 < 24 ? 16 : cidx50 < 29 ? 24 : cidx50 < 33 ? 29 : cidx50 < 36 ? 33 : cidx50 < 38 ? 36 : cidx50 < 40 ? 38 : cidx50 < 42 ? 40 : cidx50;
    b = cidx50 - st;
}
__device__ __forceinline__ void peer_topk_pair(const LAS float* srow, int hp, LAS float* gsc, LAS int* isc, int lane) {
    const int hl = lane & 31, hb = lane & 32; const bool hi_half = lane >= 32; const int h = 2 * hp + (hi_half ? 1 : 0);
    const LAS float* sh = srow + h * 256;
    unsigned k1[4], k2[4];
#pragma unroll
    for (int j = 0; j < 4; ++j) { const int idx = hl + 32 * j; k1[j] = (fkey(sh[idx]) & ~127u) | (unsigned)(127 - idx); k2[j] = (fkey(sh[128 + idx]) & ~127u) | (unsigned)(127 - idx); }
    const unsigned r1 = topk16_half4(k1, hl, hi_half), r2 = topk16_half4(k2, hl, hi_half);
    const int i1 = 127 - (int)(r1 & 127u), i2 = 127 - (int)(r2 & 127u);
    const float v1 = sh[i1], v2 = sh[128 + i2];
    int a0, b0, a1, b1; cand_ab(hl, a0, b0); cand_ab(hl + 32, a1, b1);
    const float c0 = __shfl(v1, hb + a0) + __shfl(v2, hb + b0), c1 = __shfl(v1, hb + (a1 & 15)) + __shfl(v2, hb + (b1 & 15));
    const unsigned q0 = (fkey(c0) & ~255u) | (unsigned)(255 - (a0 * 16 + b0)), q1 = (hl + 32 < 50) ? ((fkey(c1) & ~255u) | (unsigned)(255 - (a1 * 16 + b1))) : 0u;
    const unsigned r3 = topk16_half2(q0, q1, hl, hi_half);
    const int ci = 255 - (int)(r3 & 255u);
    const float sc = __shfl(v1, hb + (ci >> 4)) + __shfl(v2, hb + (ci & 15));
    const int e = __shfl(i1, hb + (ci >> 4)) * 128 + __shfl(i2, hb + (ci & 15));
    const float mxa = __int_as_float(__builtin_amdgcn_readlane(__float_as_int(sc), 0)), mxb = __int_as_float(__builtin_amdgcn_readlane(__float_as_int(sc), 32));
    const float ex = hl < 16 ? __expf(sc - (hi_half ? mxb : mxa)) : 0.f;
    float sm = ex; sm += DPPF(sm, 0xB1); sm += DPPF(sm, 0x4E); sm += DPPF(sm, 0x141); sm += DPPF(sm, 0x140);
    if (hl < 16) { gsc[h * 16 + hl] = ex / sm; isc[h * 16 + hl] = e; }
}

__device__ __forceinline__ unsigned row_max_u32(unsigned v) { v = max(v, DPPU(v, 0xB1)); v = max(v, DPPU(v, 0x4E)); v = max(v, DPPU(v, 0x141)); v = max(v, DPPU(v, 0x140)); return v; }
#define CSWAP(a, b) do { const unsigned hi_ = max(a, b), lo_ = min(a, b); a = hi_; b = lo_; } while (0)
__device__ __forceinline__ unsigned topk16_row8(unsigned (&k)[8], int rl) {
    CSWAP(k[0], k[1]); CSWAP(k[2], k[3]); CSWAP(k[4], k[5]); CSWAP(k[6], k[7]);
    CSWAP(k[0], k[2]); CSWAP(k[1], k[3]); CSWAP(k[4], k[6]); CSWAP(k[5], k[7]);
    CSWAP(k[1], k[2]); CSWAP(k[5], k[6]); CSWAP(k[0], k[4]); CSWAP(k[3], k[7]);
    CSWAP(k[1], k[5]); CSWAP(k[2], k[6]);
    CSWAP(k[1], k[4]); CSWAP(k[3], k[6]);
    CSWAP(k[2], k[4]); CSWAP(k[3], k[5]);
    CSWAP(k[3], k[4]);
    unsigned res = 0u;
    for (int it = 0; it < 16; ++it) { const unsigned m = row_max_u32(k[0]); const bool mine = (k[0] == m);
#pragma unroll
        for (int j = 0; j < 7; ++j) k[j] = mine ? k[j + 1] : k[j];
        k[7] = mine ? 0u : k[7];
        res = (rl == it) ? m : res; }
    return res;
}
__device__ __forceinline__ void topk16_row8x2(unsigned (&k)[8], unsigned (&g)[8], int rl, unsigned& rk, unsigned& rg) {
#define CSWAP2(a, b) do { const unsigned hi_ = max(k[a], k[b]), lo_ = min(k[a], k[b]); k[a] = hi_; k[b] = lo_; const unsigned hj_ = max(g[a], g[b]), lj_ = min(g[a], g[b]); g[a] = hj_; g[b] = lj_; } while (0)
    CSWAP2(0, 1); CSWAP2(2, 3); CSWAP2(4, 5); CSWAP2(6, 7);
    CSWAP2(0, 2); CSWAP2(1, 3); CSWAP2(4, 6); CSWAP2(5, 7);
    CSWAP2(1, 2); CSWAP2(5, 6); CSWAP2(0, 4); CSWAP2(3, 7);
    CSWAP2(1, 5); CSWAP2(2, 6);
    CSWAP2(1, 4); CSWAP2(3, 6);
    CSWAP2(2, 4); CSWAP2(3, 5);
    CSWAP2(3, 4);
#undef CSWAP2
    unsigned res = 0u, reg = 0u;
#pragma unroll
    for (int it = 0; it < 16; ++it) {
        unsigned m = k[0], n = g[0];
        m = max(m, DPPU(m, 0xB1)); n = max(n, DPPU(n, 0xB1)); m = max(m, DPPU(m, 0x4E)); n = max(n, DPPU(n, 0x4E));
        m = max(m, DPPU(m, 0x141)); n = max(n, DPPU(n, 0x141)); m = max(m, DPPU(m, 0x140)); n = max(n, DPPU(n, 0x140));
        const bool mine = (k[0] == m), nine = (g[0] == n);
#pragma unroll
        for (int j = 0; j < 7; ++j) { k[j] = mine ? k[j + 1] : k[j]; g[j] = nine ? g[j + 1] : g[j]; }
        k[7] = mine ? 0u : k[7]; g[7] = nine ? 0u : g[7];
        res = (rl == it) ? m : res; reg = (rl == it) ? n : reg; }
    rk = res; rg = reg;
}
__device__ __forceinline__ unsigned topk16_row4(unsigned (&k)[4], int rl) {
    CSWAP(k[0], k[1]); CSWAP(k[2], k[3]); CSWAP(k[0], k[2]); CSWAP(k[1], k[3]); CSWAP(k[1], k[2]);
    unsigned res = 0u;
    for (int it = 0; it < 16; ++it) { const unsigned m = row_max_u32(k[0]); const bool mine = (k[0] == m);
#pragma unroll
        for (int j = 0; j < 3; ++j) k[j] = mine ? k[j + 1] : k[j];
        k[3] = mine ? 0u : k[3];
        res = (rl == it) ? m : res; }
    return res;
}
#undef CSWAP
__device__ __forceinline__ void peer_topk_quad(const LAS float* srow, int hq, LAS float* gsc, LAS int* isc, int lane) {
    const int rl = lane & 15, rb = lane & 48, h = 4 * hq + (lane >> 4);
    const LAS float* sh = srow + h * 256;
    unsigned k1[8], k2[8];
#pragma unroll
    for (int j = 0; j < 8; ++j) { const int idx = rl + 16 * j; k1[j] = (fkey(sh[idx]) & ~127u) | (unsigned)(127 - idx); k2[j] = (fkey(sh[128 + idx]) & ~127u) | (unsigned)(127 - idx); }
    unsigned r1, r2; topk16_row8x2(k1, k2, rl, r1, r2);
    const int i1 = 127 - (int)(r1 & 127u), i2 = 127 - (int)(r2 & 127u);
    const float v1 = sh[i1], v2 = sh[128 + i2];
    unsigned q[4];
#pragma unroll
    for (int j = 0; j < 4; ++j) { const int cidx = rl + 16 * j; int a, b; cand_ab(cidx < 50 ? cidx : 0, a, b);
        const float cs = __shfl(v1, rb + (a & 15)) + __shfl(v2, rb + (b & 15));
        q[j] = (cidx < 50) ? ((fkey(cs) & ~255u) | (unsigned)(255 - (a * 16 + b))) : 0u; }
    const unsigned r3 = topk16_row4(q, rl);
    const int ci = 255 - (int)(r3 & 255u);
    const float sc = __shfl(v1, rb + (ci >> 4)) + __shfl(v2, rb + (ci & 15));
    const int e = __shfl(i1, rb + (ci >> 4)) * 128 + __shfl(i2, rb + (ci & 15));
    const float mx = __shfl(sc, rb);
    const float ex = __expf(sc - mx);
    float sm = ex; sm += DPPF(sm, 0xB1); sm += DPPF(sm, 0x4E); sm += DPPF(sm, 0x141); sm += DPPF(sm, 0x140);
    gsc[h * 16 + rl] = ex / sm; isc[h * 16 + rl] = e;
}

constexpr size_t WS_PE_E = WS_P + 160 * MiB, WS_PE_CF = WS_PE_E + (size_t)MALL * 128 * 4;
constexpr int NSL = 16, SLW = 128;
constexpr size_t SLICE_BYTES = (size_t)16384 * SLW;
__device__ __forceinline__ void peer_token(const Ctx& c, int l, int r, int rn, int b, bool dry) {
    LAS float* gsc = (LAS float*)(c.lds + c.wave * 2048 + b * 1024);
    LAS int* isc = (LAS int*)(c.lds + c.wave * 2048 + b * 1024 + 512);
    LAS float* gscn = (LAS float*)(c.lds + c.wave * 2048 + (b ^ 1) * 1024); LAS int* iscn = (LAS int*)(c.lds + c.wave * 2048 + (b ^ 1) * 1024 + 512);
    const float* Sn = (const float*)(c.ws + WS_P) + (size_t)(rn < 0 ? r : rn) * DM;
    const int lane = c.lane;
    LAS float* snb = (LAS float*)(c.lds + 16384 + c.wave * 8192);
    f32x4 sv[8];
#pragma unroll
    for (int q = 0; q < 8; ++q) sv[q] = (rn >= 0) ? *(const f32x4*)(Sn + q * 256 + lane * 4) : (f32x4){0.f, 0.f, 0.f, 0.f};
    LDS_WAIT(); asm volatile("" ::: "memory");
    const bf16_t* hx = (const bf16_t*)(c.ws + WS_HX) + (size_t)r * DM;
    int hq[8]; float hdq;
    { float hv[32]; float mx = 0.f;
#pragma unroll
      for (int j = 0; j < 4; ++j) { float t0[8]; unpack8(*(const u32x4*)(hx + lane * 32 + j * 8), t0);
#pragma unroll
          for (int k = 0; k < 8; ++k) { hv[j * 8 + k] = t0[k]; mx = fmaxf(mx, fabsf(t0[k])); } }
#pragma unroll
      for (int o = 32; o > 0; o >>= 1) mx = fmaxf(mx, __shfl_xor(mx, o));
      const float q_ = mx > 0.f ? 127.f / mx : 0.f; hdq = mx * (1.f / (127.f * 16.f));
#pragma unroll
      for (int d = 0; d < 8; ++d) hq[d] = (int)pk4_i8(hv[4 * d] * q_, hv[4 * d + 1] * q_, hv[4 * d + 2] * q_, hv[4 * d + 3] * q_); }
    const float* USC = (const float*)(c.ws + WS_USC) + (size_t)l * 16384;
    const unsigned char* PU = (const unsigned char*)(c.ws + ws_pu(l)); const unsigned char* PV = (const unsigned char*)(c.ws + ws_pv(l));
#define PEER_LOADROW(tab, wk, e_) do { wk = *(const u32x4*)((tab) + (size_t)__builtin_amdgcn_readfirstlane(e_) * 1024 + lane * 16); } while (0)
#define PEER_IDX8(dst, i_) const u32x4 ia_##dst = *(const LAS u32x4*)(isc + (i_)), ib_##dst = *(const LAS u32x4*)(isc + (i_) + 4); \
        const int dst[8] = {(int)ia_##dst[0], (int)ia_##dst[1], (int)ia_##dst[2], (int)ia_##dst[3], (int)ib_##dst[0], (int)ib_##dst[1], (int)ib_##dst[2], (int)ib_##dst[3]}
    u32x4 w[16];
    float usc_ = USC[isc[lane & 7]], usc1_ = USC[isc[8 + (lane & 7)]];
    { PEER_IDX8(e0, 0);
#pragma unroll
      for (int k = 0; k < 8; ++k) PEER_LOADROW(PU, w[k], e0[k]); }
    { PEER_IDX8(e1, 8);
#pragma unroll
      for (int k = 0; k < 8; ++k) PEER_LOADROW(PU, w[8 + k], e1[k]); }
    if (rn >= 0) {
#pragma unroll
        for (int q = 0; q < 8; ++q) *(LAS f32x4*)(snb + q * 256 + lane * 4) = sv[q];
        LDS_WAIT(); asm volatile("" ::: "memory"); }
#define PEER_BATCH(SB, ib, USV) { \
        const bool has_next = (ib) + 16 < 128; \
        PEER_IDX8(en, has_next ? (ib) + 16 : (ib)); \
        const float uscn_ = USC[isc[(has_next ? (ib) + 16 : (ib)) + (lane & 7)]]; \
        float p[8]; \
        _Pragma("unroll") for (int k = 0; k < 8; ++k) { \
            asm volatile("" : "+v"(w[(SB) + k])); \
            int s = 0; \
            _Pragma("unroll") for (int d = 0; d < 4; ++d) { s = __builtin_amdgcn_sdot4((int)((w[(SB) + k][d] << 4) & 0xF0F0F0F0u), hq[2 * d], s, false); s = __builtin_amdgcn_sdot4((int)(w[(SB) + k][d] & 0xF0F0F0F0u), hq[2 * d + 1], s, false); } \
            p[k] = (float)s; asm volatile("" : "+v"(p[k])); \
            if (has_next) PEER_LOADROW(PU, w[(SB) + k], en[k]); } \
          \
        const bool b0 = lane & 1, b1 = lane & 2, b2 = lane & 4; \
        float q[4], t[2]; \
        _Pragma("unroll") for (int m = 0; m < 4; ++m) q[m] = (b0 ? p[2 * m + 1] : p[2 * m]) + DPPF(b0 ? p[2 * m] : p[2 * m + 1], 0xB1); \
        _Pragma("unroll") for (int m = 0; m < 2; ++m) t[m] = (b1 ? q[2 * m + 1] : q[2 * m]) + DPPF(b1 ? q[2 * m] : q[2 * m + 1], 0x4E); \
        float s = (b2 ? t[1] : t[0]) + SWZ_XOR(b2 ? t[0] : t[1], 4); \
        s += SWZ_XOR(s, 8); s += SWZ_XOR(s, 16); s += __shfl_xor(s, 32); \
        if (lane < 8) gsc[(ib) + lane] = gsc[(ib) + lane] * gelu_tanh(s * (USV * hdq)); \
        USV = uscn_; }
#pragma unroll 1
    for (int i = 0; i < 128; i += 16) {
        if (rn >= 0 && (i & 63) == 0) peer_topk_quad(snb, i >> 6, gscn, iscn, lane);
        PEER_BATCH(0, i, usc_)
        PEER_BATCH(8, i + 8, usc1_)
    }
#undef PEER_BATCH
#undef PEER_LOADROW
#undef PEER_IDX8
    LDS_WAIT(); asm volatile("" ::: "memory");
    { int* E = (int*)(c.ws + WS_PE_E) + (size_t)r * 128; float* CF = (float*)(c.ws + WS_PE_CF) + (size_t)r * 128;
      E[lane] = isc[lane]; E[64 + lane] = isc[64 + lane]; CF[lane] = gsc[lane]; CF[64 + lane] = gsc[64 + lane]; }
    LDS_WAIT(); asm volatile("" ::: "memory");
}
__device__ __forceinline__ void phase_peer(const Ctx& c, int l, int nrows, bool dry = false) {
    const int gw = c.wg * NWAVES + c.wave, NGW = c.G * NWAVES;
    int r = gw; if (r >= nrows) return;
    { const float* S0 = (const float*)(c.ws + WS_P) + (size_t)r * DM; LAS float* snb0 = (LAS float*)(c.lds + 16384 + c.wave * 8192);
#pragma unroll
      for (int q = 0; q < 8; ++q) *(LAS f32x4*)(snb0 + q * 256 + c.lane * 4) = *(const f32x4*)(S0 + q * 256 + c.lane * 4);
      LDS_WAIT(); asm volatile("" ::: "memory");
#pragma unroll 1
      for (int hq = 0; hq < 2; ++hq) peer_topk_quad(snb0, hq, (LAS float*)(c.lds + c.wave * 2048), (LAS int*)(c.lds + c.wave * 2048 + 512), c.lane);
      LDS_WAIT(); asm volatile("" ::: "memory"); }
    int b = 0;
#pragma unroll 1
    for (; r < nrows; r += NGW, b ^= 1) { const int rn = r + NGW; peer_token(c, l, r, rn < nrows ? rn : -1, b, dry); }
}
#define PEER_SLICE_BEGIN() { const int grp = c.wg & 7, wi = (c.wg >> 3) * NWAVES + c.wave, nwi = ((c.G - grp + 7) >> 3) * NWAVES; \
    _Pragma("unroll 1") for (int ps = 0; ps < 2; ++ps) { const int s = grp + 8 * ps; _Pragma("unroll 1") for (int r = wi; r < nrows; r += nwi) {
#define PEER_SLICE_END() } } }
__device__ __forceinline__ void phase_peer_v(const Ctx& c, int l, int nrows, bool dry) {
    const int lane = c.lane, rg = lane >> 3, ch = lane & 7;
    const int* Eb = (const int*)(c.ws + WS_PE_E); const float* CF = (const float*)(c.ws + WS_PE_CF);
    const bool b3 = lane & 8, b4 = lane & 16, b5 = lane & 32;
    const int grp = c.wg & 7, wi = (c.wg >> 3) * NWAVES + c.wave, nwi = ((c.G - grp + 7) >> 3) * NWAVES;
#define V_META(r_, e0_, e1_, c0_, c1_) do { if ((r_) < nrows) { e0_ = Eb[(size_t)(r_) * 128 + lane]; e1_ = Eb[(size_t)(r_) * 128 + 64 + lane]; c0_ = CF[(size_t)(r_) * 128 + lane]; c1_ = CF[(size_t)(r_) * 128 + 64 + lane]; } } while (0)
#pragma unroll 1
    for (int ps = 0; ps < 2; ++ps) { const int s = grp + 8 * ps;
        const unsigned char* tab = (const unsigned char*)(c.ws + ws_pv(l)) + (size_t)s * SLICE_BYTES;
        const unsigned cho = (unsigned)ch * 16u;
        const int col = s * SLW + ch * 16 + (b3 ? 8 : 0) + (b4 ? 4 : 0) + (b5 ? 2 : 0);
        int r = wi; int e0 = 0, e1 = 0; float c0 = 0.f, c1 = 0.f;
        V_META(r, e0, e1, c0, c1);
#pragma unroll 1
        for (; r < nrows; r += nwi) {
            u32x4 w[16];
#pragma unroll
            for (int i = 0; i < 16; ++i) { const int e = __shfl(i < 8 ? e0 : e1, (8 * i + rg) & 63); w[i] = *(const u32x4*)(tab + ((unsigned)e * (unsigned)SLW + cho)); }
            int f0 = 0, f1 = 0; float d0 = 0.f, d1 = 0.f; V_META(r + nwi, f0, f1, d0, d1);
            const int vec = r < SEQ ? 0 : (r < MLAT ? 1 : 2);
            float* xr = (dry ? (float*)(c.ws + WS_YF) + (size_t)r * DM : xrow_ptr(c, r)) + col;
            const f32x2 gg = *(const f32x2*)((const float*)(c.ws + WS_MOD) + ((size_t)l * 3 + vec) * NMOD + 5 * DM + col); f32x2 xx = *(const f32x2*)xr;
            const h16x2 c0h = {(_Float16)c0, (_Float16)c0}, c1h = {(_Float16)c1, (_Float16)c1};
            const int c0p = __builtin_bit_cast(int, c0h), c1p = __builtin_bit_cast(int, c1h);
            h16x2 o2[8];
#pragma unroll
            for (int j = 0; j < 8; ++j) o2[j] = (h16x2){(_Float16)0.f, (_Float16)0.f};
#pragma unroll
            for (int i = 0; i < 16; ++i) {
                asm volatile("" : "+v"(w[i]));
                const h16x2 ci2 = __builtin_bit_cast(h16x2, __shfl(i < 8 ? c0p : c1p, (8 * i + rg) & 63));
#pragma unroll
                for (int d = 0; d < 4; ++d) {
                    const h16x2 lo_ = __builtin_bit_cast(h16x2, __builtin_amdgcn_cvt_scalef32_pk_f16_fp8((int)w[i][d], 1.0f, false)), hi_ = __builtin_bit_cast(h16x2, __builtin_amdgcn_cvt_scalef32_pk_f16_fp8((int)w[i][d], 1.0f, true));
                    o2[2 * d] = __builtin_elementwise_fma(lo_, ci2, o2[2 * d]); o2[2 * d + 1] = __builtin_elementwise_fma(hi_, ci2, o2[2 * d + 1]); }
                asm volatile("" : "+v"(o2[0])); }
            float o[16];
#pragma unroll
            for (int j = 0; j < 8; ++j) { o[2 * j] = (float)o2[j][0]; o[2 * j + 1] = (float)o2[j][1]; }
            float q8[8], q4[4], q2[2];
#pragma unroll
            for (int j = 0; j < 8; ++j) q8[j] = (b3 ? o[8 + j] : o[j]) + DPPF(b3 ? o[j] : o[8 + j], 0x128);
#pragma unroll
            for (int j = 0; j < 4; ++j) q4[j] = (b4 ? q8[4 + j] : q8[j]) + SWZ_XOR(b4 ? q8[j] : q8[4 + j], 16);
#pragma unroll
            for (int j = 0; j < 2; ++j) q2[j] = (b5 ? q4[2 + j] : q4[j]) + __shfl_xor(b5 ? q4[j] : q4[2 + j], 32);
            xx[0] += gg[0] * q2[0]; xx[1] += gg[1] * q2[1];
            *(f32x2*)xr = xx;
            e0 = f0; e1 = f1; c0 = d0; c1 = d1;
        }
    }
#undef V_META
}
struct Args { const float* in[29]; float* out; unsigned char* ws; int ph_lo, ph_hi; };
constexpr int PH_PER_LAYER = 10, N_PHASES = NLAYER * PH_PER_LAYER;
#ifndef G1_WGM
#define G1_WGM 3
#endif
constexpr int CW_BAR = 4096;

__global__ void __launch_bounds__(NTHREADS, 2) mk_fwd(Args args) {
    extern __shared__ __attribute__((aligned(16))) unsigned char lds_raw[];
    Ctx c0;
    c0.out = args.out; c0.ws = args.ws; c0.lds = (LAS unsigned char*)lds_raw;
    c0.tid = threadIdx.x; c0.lane = c0.tid & 63; c0.wave = __builtin_amdgcn_readfirstlane((int)(threadIdx.x >> 6)); c0.wg = blockIdx.x; c0.G = gridDim.x;
    volatile LAS unsigned* MISC = (volatile LAS unsigned*)(c0.lds + MISC_OFF);
    if (c0.tid < 64) MISC[c0.tid] = 0u;
    __syncthreads();
    const int lo = args.ph_lo, hi = args.ph_hi;
    XcdBarrier bar; bar.bar = (unsigned*)(c0.ws + WS_CTL) + CW_BAR; bar.x = 0; bar.st = MISC + 8;
    if (hi - lo > 1) bar = xcd_barrier_post((unsigned*)(c0.ws + WS_CTL) + CW_BAR, MISC + 8);
#ifndef ONLY_PH
#define ONLY_PH -1
#endif
#define IN(k) ((ONLY_PH < 0 || ((k) % PH_PER_LAYER) == ONLY_PH) && lo <= (k) && (k) < hi)
#define PH_BEGIN() Ctx c = c0; unsigned long long wsi_ = (unsigned long long)c0.ws, outi_ = (unsigned long long)c0.out; asm volatile("" : "+s"(wsi_), "+s"(outi_), "+s"(c.wg), "+s"(c.G), "+s"(c.wave)); \
    c.lane = lane_id_fresh(); c.tid = c.wave * 64 + c.lane; c.ws = (unsigned char*)(GAS unsigned char*)wsi_; c.out = (float*)(GAS float*)outi_;     \
    bf16_t* P = (bf16_t*)(c.ws + WS_P); bf16_t* HX = (bf16_t*)(c.ws + WS_HX); float* YF = (float*)(c.ws + WS_YF); (void)P; (void)HX; (void)YF
#ifndef PROBE_DUP
#define PROBE_DUP -1
#endif
#define REPS(k) for (int rep = 0, dry = (PROBE_DUP == (k)); rep < (PROBE_DUP == (k) ? 2 : 1); ++rep, dry = 0)
#define SEAM(k) do { if (IN(k) && IN((k) + 1)) { xcd_barrier(bar, c0.wave); if (PROBE_DUP == 20) xcd_barrier(bar, c0.wave); } } while (0)
    const bool early = (c0.G == 256);
#define TAIL_BEGIN() PH_BEGIN(); c.wg -= 32; c.G -= 32
    for (int l = 0; l < NLAYER; ++l) {
        const int pb = l * PH_PER_LAYER;
        const int mrows = (l == 0) ? MALL : MLAT;
        if (IN(pb + 0) && !(l == 1 && early)) REPS(0) {
            if (l == 0) { PH_BEGIN(); conv_colmax(c); }
            { PH_BEGIN(); conv_units(c, l); } { PH_BEGIN(); conv_tables(c, l); } { PH_BEGIN(); conv_small(c, l); }
            if (l == 0) { { PH_BEGIN(); conv_once(c); } xcd_barrier(bar, c0.wave); }
            { PH_BEGIN(); conv_transposes(c, l); } }
        if (!(l == 1 && early)) SEAM(pb + 0);
        if (IN(pb + 1)) REPS(1) { PH_BEGIN();
            if (l == 0) { GET_IN(); phase_norm<true>(c, l, MALL, SP_NMIX, 0, INP(I_X), INP(I_CTX)); } else phase_norm<true>(c, l, MALL, SP_NMIX, 0); }
        SEAM(pb + 1);
        if (IN(pb + 2)) REPS(2) { PH_BEGIN();
            pg8::Gemm g{HX, (const bf16_t*)(c.ws + WS_WIN), MALL, NIN, DM, DM, DM}; pg8::StaticOrder S; S.init(MALL, NIN, c.G, c.wg, G1_WGM);
            pg8::EpiI8 E{P, NIN, (const float*)(c.ws + WS_ADQ), (const float*)(c.ws + WS_WDQ)};
            pg8::gemm_phase<pg8::EpiI8, pg8::StaticOrder, true, true, false, true>(c.lds, g, S, E, c.wave);
        }
        SEAM(pb + 2);
        if (IN(pb + 3)) REPS(3) {
            int flip_ = (c0.wg >> 3) & 1; asm volatile("" : "+s"(flip_));
#pragma unroll 1
            for (int st = 0; st < 2; ++st) {
                if ((st ^ flip_) == 0) { { PH_BEGIN(); phase_qk(c, l, dry); } { PH_BEGIN(); phase_sc(c, l, dry); } }
                else { PH_BEGIN(); phase_lru1(c, l); }
                __syncthreads(); }
            if (PROBE_DUP == 30) { PH_BEGIN(); phase_lru1(c, l); } }
        SEAM(pb + 3);
        if (IN(pb + 4)) REPS(4) { { PH_BEGIN(); phase_m2(c, l, dry); } __syncthreads(); if (PROBE_DUP == 31) { PH_BEGIN(); phase_lru2(c, l, true); } { PH_BEGIN(); phase_lru2(c, l, dry); } }
        SEAM(pb + 4);
        if (IN(pb + 5)) REPS(5) { { PH_BEGIN();
            pg8::MixOrder S; S.init(mrows, c.G, c.wg);
            const bf16_t* WO = (const bf16_t*)(c.ws + WS_WO);
            { pg8::Gemm g{P + CQ, WO, mrows, DM, DM, NIN, DM}; pg8::EpiMerge<0> E{P + CGT, NIN, (bf16_t*)YF, HX};
              pg8::gemm_phase<pg8::EpiMerge<0>, pg8::MixOrder, true, true, true>(c.lds, g, S, E, c.wave); }
            { pg8::Gemm g{P + CLG, WO + (size_t)DM * DM, mrows, DM, DM, NIN, DM}; pg8::EpiMerge<1> E{P + CGT + DM, NIN, (bf16_t*)YF, HX};
              pg8::gemm_phase<pg8::EpiMerge<1>, pg8::MixOrder, true, true, true>(c.lds, g, S, E, c.wave); }
            { pg8::Gemm g{P + CBG, WO + (size_t)2 * DM * DM, mrows, DM, DM, NIN, DM}; pg8::EpiMerge<2> E{P + CGT + 2 * DM, NIN, (bf16_t*)YF, HX};
              pg8::gemm_phase<pg8::EpiMerge<2>, pg8::MixOrder, true, true, true>(c.lds, g, S, E, c.wave); }
            }
            if (l == 0 && early && c0.wg >= 32 && !dry) { { TAIL_BEGIN(); conv_transposes(c, 1, CV_WIN); } { TAIL_BEGIN(); conv_tables(c, 1, CV_PU); } }
        }
        SEAM(pb + 5);
        if (IN(pb + 6)) REPS(6) { { PH_BEGIN();
            pg8::Gemm g{HX, (const bf16_t*)(c.ws + WS_WOUT), mrows, DM, DM, DM, DM}; pg8::MixOrder S; S.init(mrows, c.G, c.wg);
            float* xl_ = dry ? YF : c.out; float* xc_ = dry ? YF + (size_t)MLAT * DM : (float*)(c.ws + WS_CTXS);
            const float* sl_ = xl_; const float* sc_ = xc_;
            if (l == 0 && !dry) { GET_IN(); sl_ = INP(I_X); sc_ = INP(I_CTX); }
            pg8::EpiResid E{xl_, xc_, (const float*)(c.ws + WS_MOD) + (size_t)l * 3 * NMOD + 2 * DM, sl_, sc_};
            pg8::gemm_phase<pg8::EpiResid, pg8::MixOrder, true, true, true>(c.lds, g, S, E, c.wave);
            }
            if (l == 0 && early && c0.wg >= 32 && !dry) { { TAIL_BEGIN(); conv_units(c, 1); } { TAIL_BEGIN(); conv_transposes(c, 1, CV_WO); } }
        }
        SEAM(pb + 6);
        if (IN(pb + 7)) REPS(7) { PH_BEGIN(); phase_norm(c, l, mrows, SP_NFFN, 3); }
        SEAM(pb + 7);
        if (IN(pb + 8)) REPS(8) { { PH_BEGIN();
            pg8::Gemm g{HX, (const bf16_t*)(c.ws + ws_wsc(l)), mrows, DM, DM, DM, DM}; pg8::MixOrder S; S.init(mrows, c.G, c.wg);
            pg8::EpiF32 E{(float*)(c.ws + WS_P), DM};
            pg8::gemm_phase<pg8::EpiF32, pg8::MixOrder, true, true, true>(c.lds, g, S, E, c.wave);
            }
            if (l == 0 && early && c0.wg >= 32 && !dry) { { TAIL_BEGIN(); conv_transposes(c, 1, CV_WOUT); } { TAIL_BEGIN(); conv_tables(c, 1, CV_PV | CV_LRU); } { TAIL_BEGIN(); conv_small(c, 1); } }
        }
        SEAM(pb + 8);
        if (IN(pb + 9)) REPS(9) {
            { PH_BEGIN(); phase_peer(c, l, mrows, dry); } xcd_barrier(bar, c0.wave);
            { PH_BEGIN(); phase_peer_v(c, l, mrows, dry); } }
        SEAM(pb + 9);
    }
#undef IN
#undef SEAM
}

extern "C" void kernel_launch(void* const* d_in, const int* in_sizes, int n_in, void* d_out, int out_size, void* d_ws, size_t ws_size, hipStream_t stream) {
    static int grid = 0;
    if (grid == 0) {
        if (n_in != 29 || in_sizes[0] != MLAT * DM || out_size != MLAT * DM || ws_size < WS_END) {
            fprintf(stderr, "kernel_launch: built for 29 inputs, x/out of %d floats, >= %zu bytes of workspace; got n_in %d, in0 %d, out %d, ws %zu; nothing launched\n", MLAT * DM, (size_t)WS_END, n_in, n_in > 0 ? in_sizes[0] : -1, out_size, ws_size);
            grid = -1; return; }
        int dev = 0, cus = 0, per_cu = 0;
        if (hipGetDevice(&dev) != hipSuccess || hipDeviceGetAttribute(&cus, hipDeviceAttributeMultiprocessorCount, dev) != hipSuccess) { fprintf(stderr, "kernel_launch: device query failed\n"); grid = -1; return; }
        if (hipFuncSetAttribute((const void*)mk_fwd, hipFuncAttributeMaxDynamicSharedMemorySize, LDS_BYTES) != hipSuccess) { fprintf(stderr, "kernel_launch: hipFuncSetAttribute failed\n"); grid = -1; return; }
        if (hipOccupancyMaxActiveBlocksPerMultiprocessor(&per_cu, (const void*)mk_fwd, NTHREADS, LDS_BYTES) != hipSuccess || per_cu < 1)
            fprintf(stderr, "kernel_launch: note: occupancy query reports %d workgroups per CU\n", per_cu);
        (void)hipGetLastError();
        grid = cus;
    }
    if (grid < 0) return;
    if (hipMemsetAsync((char*)d_ws + WS_CTL, 0, CTL_ZERO_BYTES, stream) != hipSuccess) { fprintf(stderr, "kernel_launch: memset failed\n"); return; }
    Args a{};
    for (int i = 0; i < 29; ++i) a.in[i] = (const float*)d_in[i];
    a.out = (float*)d_out; a.ws = (unsigned char*)d_ws;
#if MK_N_LAUNCHES == 1
    a.ph_lo = 0; a.ph_hi = N_PHASES;
    hipLaunchKernelGGL(mk_fwd, dim3(grid), dim3(NTHREADS), LDS_BYTES, stream, a);
#else
    for (int k = 0; k < N_PHASES; ++k) { a.ph_lo = k; a.ph_hi = k + 1; hipLaunchKernelGGL(mk_fwd, dim3(grid), dim3(NTHREADS), LDS_BYTES, stream, a); }
#endif
    const hipError_t le = hipPeekAtLastError();
    if (le != hipSuccess) fprintf(stderr, "kernel_launch: launch failed: %s\n", hipGetErrorName(le));
}
```
